# Optimizing an MI355X kernel written in HIP

```python
import math
import jax
import jax.numpy as jnp
from jax import lax
import numpy as np

D_MODEL = 1024
BATCH = 4
SEQ = 4096
DEPTH = 4
DEC_BATCH = 2
DEC_SEQ = 16384
PAST_LEN = 128

N_EVEN = (DEPTH + 1) // 2
N_ODD = DEPTH // 2
MIX_WIDTH = D_MODEL
S5_WIDTH = D_MODEL // 2
S5_GROUP = 16
S5_GROUPS = S5_WIDTH // S5_GROUP
S5_STATE = 64
RW_WIDTH = D_MODEL // 2
RW_HEAD = 64
RW_HEADS = RW_WIDTH // RW_HEAD
RW_LORA = 32
RW_DECAY_SCALE = math.exp(-0.5)
RW_GN_EPS = 64e-5
EVEN_IN = 2 * S5_WIDTH + 4 * RW_WIDTH + 2 * RW_LORA
EVEN_SPLITS = (S5_WIDTH, 2 * S5_WIDTH, 2 * S5_WIDTH + RW_WIDTH, 2 * S5_WIDTH + 2 * RW_WIDTH, 2 * S5_WIDTH + 3 * RW_WIDTH, 2 * S5_WIDTH + 4 * RW_WIDTH, 2 * S5_WIDTH + 4 * RW_WIDTH + RW_LORA)
HY_WIDTH = D_MODEL
HY_ORDER = 2
HY_BANDS = 16
HY_EMB = 1 + 2 * HY_BANDS
HY_HIDDEN = 64
HY_FAST_DECAY = 0.3
HY_SLOW_DECAY = 1.5
HY_DECAY_TARGET = 1e-2
LN_EPS = 1e-5
DN_ALPHA = (2 * DEPTH) ** 0.25
DN_BETA = (8 * DEPTH) ** -0.25

kernel_name = "bidir_s5_rwkv7_hyena_encoder"


def layer_norm(x, g, b):
    xf = x.astype(jnp.float32)
    mean = jnp.mean(xf, -1, keepdims=True)
    var = jnp.mean(jnp.square(xf - mean), -1, keepdims=True)
    y = (xf - mean) * lax.rsqrt(var + LN_EPS) * g.astype(jnp.float32) + b.astype(jnp.float32)
    return y.astype(x.dtype)


def token_shift(x, mu):
    xp = jnp.pad(x, ((0, 0), (1, 1), (0, 0)))
    return x + mu * (0.5 * (xp[:, :-2] + xp[:, 2:]) - x)


def short_conv3(x, w, b):
    xp = jnp.pad(x, ((0, 0), (1, 1), (0, 0)))
    return xp[:, :-2] * w[0] + xp[:, 1:-1] * w[1] + xp[:, 2:] * w[2] + b


def diagonal_linear_scan(lam_bar, drive):
    decay = jnp.broadcast_to(lam_bar, (drive.shape[0], 1) + lam_bar.shape)

    def combine(left, right):
        a_l, b_l = left
        a_r, b_r = right
        return a_l * a_r, a_r * b_l + b_r

    _, states = lax.associative_scan(combine, (decay, drive), axis=0)
    return states


def s5_branch(u, p, i):
    f32 = jnp.float32
    bsz, L, _ = u.shape
    uf = u.astype(f32)
    b_mat = lax.complex(p["s5_b_re"][i].astype(f32), p["s5_b_im"][i].astype(f32))
    ug = uf.reshape(bsz, L, S5_GROUPS, S5_GROUP).astype(jnp.complex64)
    bu = jnp.einsum("blgp,gnp->lbgn", ug, b_mat)
    y = uf * p["s5_d"][i].astype(f32)
    for d in range(2):
        lam = lax.complex(p["s5_lambda_re"][i][d].astype(f32), p["s5_lambda_im"][i][d].astype(f32))
        dt = jnp.exp(p["s5_log_step"][i][d].astype(f32))[:, None]
        lam_bar = jnp.exp(lam * dt)
        drive = bu * ((lam_bar - 1.0) / lam)
        if d == 1:
            drive = jnp.flip(drive, 0)
        states = diagonal_linear_scan(lam_bar, drive)
        if d == 1:
            states = jnp.flip(states, 0)
        c_mat = lax.complex(p["s5_c_re"][i][d].astype(f32), p["s5_c_im"][i][d].astype(f32))
        y = y + jnp.einsum("lbgn,gpn->blgp", states, c_mat).real.reshape(bsz, L, S5_WIDTH)
    y = jax.nn.gelu(y)
    return y * jax.nn.sigmoid(y @ p["s5_glu_w"][i].astype(f32) + p["s5_glu_b"][i].astype(f32))


def rwkv7_scan(r, w, k, v, kk, b):
    bsz, L, H, N = r.shape

    def step(S, inp):
        r_t, w_t, k_t, v_t, kk_t, b_t = inp
        sa = jnp.einsum("bhvk,bhk->bhv", S, -kk_t)
        S = S * w_t[:, :, None, :] + sa[..., None] * b_t[:, :, None, :] + v_t[..., None] * k_t[:, :, None, :]
        y = jnp.einsum("bhvk,bhk->bhv", S, r_t)
        return S, y

    S0 = jnp.zeros((bsz, H, N, N), jnp.float32)
    xs = (jnp.moveaxis(r, 1, 0), jnp.moveaxis(w, 1, 0), jnp.moveaxis(k, 1, 0),
          jnp.moveaxis(v, 1, 0), jnp.moveaxis(kk, 1, 0), jnp.moveaxis(b, 1, 0))
    _, ys = lax.scan(step, S0, xs)
    return jnp.moveaxis(ys, 0, 1)


def rwkv7_branch(r, k, v, wd, ad, p, i):
    f32 = jnp.float32
    bsz, L, _ = r.shape
    hs = (bsz, L, RW_HEADS, RW_HEAD)
    mu = p["rw_mu_rkv"][i].astype(f32)
    mu_l = p["rw_mu_lora"][i].astype(f32)
    r = token_shift(r.astype(f32), mu[0])
    k = token_shift(k.astype(f32), mu[1])
    v = token_shift(v.astype(f32), mu[2])
    wt = jnp.tanh(token_shift(wd.astype(f32), mu_l[0]))
    at = token_shift(ad.astype(f32), mu_l[1])
    kk = (k * p["rw_k_k"][i].astype(f32)).reshape(hs)
    kk = kk / jnp.maximum(jnp.sqrt(jnp.sum(kk * kk, -1, keepdims=True)), 1e-12)
    rh = r.reshape(hs)
    vh = v.reshape(hs)
    k_a = p["rw_k_a"][i].astype(f32)
    outs = []
    for d in range(2):
        decay = jnp.exp(-RW_DECAY_SCALE * jax.nn.sigmoid(p["rw_w0"][i][d].astype(f32) + wt @ p["rw_w_up"][i][d].astype(f32)))
        a = jax.nn.sigmoid(p["rw_a0"][i][d].astype(f32) + at @ p["rw_a_up"][i].astype(f32))
        k_d = (k * (1.0 + (a - 1.0) * k_a)).reshape(hs)
        b_d = kk * a.reshape(hs)
        seq = (rh, decay.reshape(hs), k_d, vh, kk, b_d)
        if d == 1:
            seq = tuple(jnp.flip(t, 1) for t in seq)
        y_d = rwkv7_scan(*seq)
        outs.append(jnp.flip(y_d, 1) if d == 1 else y_d)
    y = outs[0] + outs[1]
    mean = jnp.mean(y, -1, keepdims=True)
    var = jnp.mean(jnp.square(y - mean), -1, keepdims=True)
    y = ((y - mean) * lax.rsqrt(var + RW_GN_EPS)).reshape(bsz, L, RW_WIDTH)
    y = y * p["rw_lnx_w"][i].astype(f32) + p["rw_lnx_b"][i].astype(f32)
    bonus = jnp.sum(rh * k.reshape(hs) * p["rw_r_k"][i].astype(f32), -1, keepdims=True) * vh
    return y + bonus.reshape(bsz, L, RW_WIDTH)


def even_mixer(x, p, i):
    f32 = jnp.float32
    proj = x @ p["ev_w_in"][i]
    u_a, z_a, r, k, v, z_b, wd, ad = jnp.split(proj, EVEN_SPLITS, axis=-1)
    y_a = s5_branch(u_a, p, i) * jax.nn.silu(z_a.astype(f32))
    y_b = rwkv7_branch(r, k, v, wd, ad, p, i) * jax.nn.silu(z_b.astype(f32))
    y = jnp.concatenate([y_a, y_b], axis=-1).astype(x.dtype)
    return y @ p["ev_w_out"][i]


def hyena_filters(L, p, i):
    f32 = jnp.float32
    t = jnp.linspace(0.0, 1.0, L, dtype=f32)[:, None]
    w = 2.0 * math.pi * jnp.arange(L, dtype=f32)[:, None] / L
    f = jnp.linspace(1e-4, HY_BANDS - 1, HY_BANDS, dtype=f32)[None, :]
    z = jnp.concatenate([t, jnp.cos(f * w), -jnp.sin(f * w)], axis=-1)
    freq = p["hy_f_freq"][i].astype(f32)
    h = jnp.sin(freq * (z @ p["hy_f_w1"][i].astype(f32) + p["hy_f_b1"][i].astype(f32)))
    h = jnp.sin(freq * (h @ p["hy_f_w2"][i].astype(f32) + p["hy_f_b2"][i].astype(f32)))
    h = (h @ p["hy_f_w3"][i].astype(f32)).reshape(L, 2, HY_ORDER, HY_WIDTH)
    deltas = jnp.abs(jnp.linspace(math.log(HY_DECAY_TARGET) / HY_SLOW_DECAY, math.log(HY_DECAY_TARGET) / HY_FAST_DECAY, HY_WIDTH, dtype=f32))
    h = h * jnp.exp(-t * deltas)[:, None, None, :]
    h = h * lax.rsqrt(jnp.sum(h * h, axis=(0, 1), keepdims=True))
    g = jnp.concatenate([h[:, 0], jnp.zeros((1, HY_ORDER, HY_WIDTH), f32), jnp.flip(h[1:, 1], 0)], axis=0)
    return jnp.fft.rfft(g, axis=0)


def hyena_mixer(x, p, i):
    f32 = jnp.float32
    bsz, L, _ = x.shape
    proj = x @ p["hy_w_in"][i]
    streams = short_conv3(proj[..., :3 * HY_WIDTH].astype(f32), p["hy_short_w"][i].astype(f32), p["hy_short_b"][i].astype(f32))
    v, x1, x2 = jnp.split(streams, 3, axis=-1)
    gate = proj[..., 3 * HY_WIDTH:].astype(f32)
    g_hat = hyena_filters(L, p, i)
    f_bias = p["hy_f_bias"][i].astype(f32)
    z = v
    for o, x_o in enumerate((x1, x2)):
        zc = jnp.fft.irfft(jnp.fft.rfft(z, n=2 * L, axis=1) * g_hat[:, o], n=2 * L, axis=1)[:, :L]
        z = x_o * (zc + z * f_bias[o])
    y = (z * jax.nn.silu(gate)).astype(x.dtype)
    return y @ p["hy_w_out"][i]


def encoder_trunk(x, p):
    for layer in range(DEPTH):
        i = layer // 2
        if layer % 2 == 0:
            f = even_mixer(x, p, i)
        else:
            f = hyena_mixer(x, p, i)
        x = layer_norm(DN_ALPHA * x + f, p["ln_g"][layer], p["ln_b"][layer])
    return x


def setup_inputs(seed: int = 0) -> dict:
    key = jax.random.key(seed)
    ks = iter(jax.random.split(key, 40))
    f32 = jnp.float32

    def nrm(shape, scale):
        return scale * jax.random.normal(next(ks), shape, f32)

    def unif(shape, lo, hi):
        return jax.random.uniform(next(ks), shape, f32, minval=lo, maxval=hi)

    NE, NO, G, N, P = N_EVEN, N_ODD, S5_GROUPS, S5_STATE, S5_GROUP
    return {
        "x_prompt": nrm((BATCH, SEQ, D_MODEL), 1.0),
        "x_sample": nrm((DEC_BATCH, DEC_SEQ, D_MODEL), 1.0),
        "ev_w_in": nrm((NE, D_MODEL, EVEN_IN), D_MODEL ** -0.5),
        "ev_w_out": nrm((NE, MIX_WIDTH, D_MODEL), DN_BETA * MIX_WIDTH ** -0.5),
        "s5_lambda_re": -0.5 * (1.0 + nrm((NE, 2, G, N), 0.02)),
        "s5_lambda_im": math.pi * jnp.arange(N, dtype=f32) + nrm((NE, 2, G, N), 0.01),
        "s5_log_step": unif((NE, 2, G), math.log(1e-3), math.log(1e-1)),
        "s5_b_re": nrm((NE, G, N, P), (2 * P) ** -0.5),
        "s5_b_im": nrm((NE, G, N, P), (2 * P) ** -0.5),
        "s5_c_re": nrm((NE, 2, G, P, N), (2 * N) ** -0.5),
        "s5_c_im": nrm((NE, 2, G, P, N), (2 * N) ** -0.5),
        "s5_d": nrm((NE, S5_WIDTH), 1.0),
        "s5_glu_w": nrm((NE, S5_WIDTH, S5_WIDTH), S5_WIDTH ** -0.5),
        "s5_glu_b": nrm((NE, S5_WIDTH), 0.01),
        "rw_mu_rkv": unif((NE, 3, RW_WIDTH), 0.0, 1.0),
        "rw_mu_lora": unif((NE, 2, RW_LORA), 0.0, 1.0),
        "rw_w0": jnp.linspace(-4.0, 2.0, RW_WIDTH, dtype=f32) + nrm((NE, 2, RW_WIDTH), 0.1),
        "rw_w_up": nrm((NE, 2, RW_LORA, RW_WIDTH), 0.1 * RW_LORA ** -0.5),
        "rw_a0": nrm((NE, 2, RW_WIDTH), 0.1),
        "rw_a_up": nrm((NE, RW_LORA, RW_WIDTH), 0.1 * RW_LORA ** -0.5),
        "rw_k_k": 0.85 + nrm((NE, RW_WIDTH), 0.02),
        "rw_k_a": 1.0 + nrm((NE, RW_WIDTH), 0.02),
        "rw_r_k": nrm((NE, RW_HEADS, RW_HEAD), 0.1),
        "rw_lnx_w": 1.0 + nrm((NE, RW_WIDTH), 0.02),
        "rw_lnx_b": nrm((NE, RW_WIDTH), 0.01),
        "hy_w_in": nrm((NO, D_MODEL, 4 * HY_WIDTH), D_MODEL ** -0.5),
        "hy_w_out": nrm((NO, HY_WIDTH, D_MODEL), DN_BETA * HY_WIDTH ** -0.5),
        "hy_short_w": nrm((NO, 3, 3 * HY_WIDTH), 3 ** -0.5),
        "hy_short_b": nrm((NO, 3 * HY_WIDTH), 0.01),
        "hy_f_w1": nrm((NO, HY_EMB, HY_HIDDEN), HY_EMB ** -0.5),
        "hy_f_b1": nrm((NO, HY_HIDDEN), 0.1),
        "hy_f_freq": 1.0 + nrm((NO, HY_HIDDEN), 0.02),
        "hy_f_w2": nrm((NO, HY_HIDDEN, HY_HIDDEN), HY_HIDDEN ** -0.5),
        "hy_f_b2": nrm((NO, HY_HIDDEN), 0.1),
        "hy_f_w3": nrm((NO, HY_HIDDEN, 2 * HY_ORDER * HY_WIDTH), HY_HIDDEN ** -0.5),
        "hy_f_bias": nrm((NO, HY_ORDER, HY_WIDTH), 1.0),
        "ln_g": 1.0 + nrm((DEPTH, D_MODEL), 0.02),
        "ln_b": nrm((DEPTH, D_MODEL), 0.01),
    }


def reference(x_prompt, x_sample, ev_w_in, ev_w_out, s5_lambda_re, s5_lambda_im, s5_log_step, s5_b_re, s5_b_im, s5_c_re, s5_c_im, s5_d, s5_glu_w, s5_glu_b, rw_mu_rkv, rw_mu_lora, rw_w0, rw_w_up, rw_a0, rw_a_up, rw_k_k, rw_k_a, rw_r_k, rw_lnx_w, rw_lnx_b, hy_w_in, hy_w_out, hy_short_w, hy_short_b, hy_f_w1, hy_f_b1, hy_f_freq, hy_f_w2, hy_f_b2, hy_f_w3, hy_f_bias, ln_g, ln_b):
    params = dict(
        ev_w_in=ev_w_in, ev_w_out=ev_w_out,
        s5_lambda_re=s5_lambda_re, s5_lambda_im=s5_lambda_im, s5_log_step=s5_log_step,
        s5_b_re=s5_b_re, s5_b_im=s5_b_im, s5_c_re=s5_c_re, s5_c_im=s5_c_im, s5_d=s5_d,
        s5_glu_w=s5_glu_w, s5_glu_b=s5_glu_b,
        rw_mu_rkv=rw_mu_rkv, rw_mu_lora=rw_mu_lora, rw_w0=rw_w0, rw_w_up=rw_w_up,
        rw_a0=rw_a0, rw_a_up=rw_a_up, rw_k_k=rw_k_k, rw_k_a=rw_k_a, rw_r_k=rw_r_k,
        rw_lnx_w=rw_lnx_w, rw_lnx_b=rw_lnx_b,
        hy_w_in=hy_w_in, hy_w_out=hy_w_out, hy_short_w=hy_short_w, hy_short_b=hy_short_b,
        hy_f_w1=hy_f_w1, hy_f_b1=hy_f_b1, hy_f_freq=hy_f_freq, hy_f_w2=hy_f_w2,
        hy_f_b2=hy_f_b2, hy_f_w3=hy_f_w3, hy_f_bias=hy_f_bias,
        ln_g=ln_g, ln_b=ln_b,
    )
    y_prompt = encoder_trunk(x_prompt, params)
    y_sample = encoder_trunk(x_sample, params)
    return (y_prompt, y_sample)
```

```cpp
#include <hip/hip_runtime.h>
#include <hip/hip_cooperative_groups.h>
#include <cstdio>
#include <cstdint>
namespace cg = cooperative_groups;

#ifndef ONE_LAUNCH
#define ONE_LAUNCH 0
#endif

#define DEVI __device__ __forceinline__
constexpr int NT = 512;
constexpr int T = 49152;
constexpr int TPROMPT = 16384;
constexpr int LDS_BYTES = 133120;
constexpr int NPH_EVEN = 11, NPH_ODD = 5;
constexpr int NPHASES = 2 * (NPH_EVEN + NPH_ODD);

typedef __attribute__((ext_vector_type(8))) short bf16x8;
typedef __attribute__((ext_vector_type(4))) float f32x4;
typedef unsigned short ushort_t;

struct Params { const float* in[38]; float* out; unsigned char* ws; int ph_lo; int ph_hi; };

enum { I_XP = 0, I_XS, I_EWIN, I_EWOUT, I_LRE, I_LIM, I_LSTEP, I_BRE, I_BIM, I_CRE, I_CIM, I_S5D, I_GLUW, I_GLUB,
       I_MURKV, I_MULORA, I_W0, I_WUP, I_A0, I_AUP, I_KK, I_KA, I_RK, I_LNXW, I_LNXB,
       I_HWIN, I_HWOUT, I_HSW, I_HSB, I_FW1, I_FB1, I_FFREQ, I_FW2, I_FB2, I_FW3, I_FBIAS, I_LNG, I_LNB };

constexpr size_t SZ1 = (size_t)T * 1024 * 2;
constexpr size_t OFF_PS5 = 0;
constexpr size_t OFF_PRW = OFF_PS5 + SZ1;
constexpr size_t OFF_Y = OFF_PRW + (size_t)T * 2112 * 2;
constexpr size_t OFF_YS = OFF_Y + SZ1;
constexpr size_t OFF_WB = OFF_YS + SZ1;
constexpr size_t OFF_CAR = OFF_WB + 10485760;
constexpr size_t WS_NEED = OFF_CAR + 6291456;
constexpr size_t OFF_PH = 0;
constexpr size_t OFF_GS = 4 * SZ1;
constexpr size_t GS_PER = 131328;
constexpr size_t OFF_Z1 = OFF_GS + 256 * 2 * GS_PER;
constexpr size_t OFF_H2 = OFF_Z1 + 256 * 65536;

DEVI int tidx() { int t = threadIdx.x; asm volatile("" : "+v"(t)); return t; }
DEVI int bidx() { int b = blockIdx.x; asm volatile("" : "+s"(b)); return b; }
DEVI ushort_t f2bf(float f) { unsigned u = __float_as_uint(f); u += 0x7fffu + ((u >> 16) & 1u); return (ushort_t)(u >> 16); }
DEVI float bf2f(ushort_t h) { return __uint_as_float(((unsigned)h) << 16); }
DEVI unsigned pack2(float a, float b) { return (unsigned)f2bf(a) | ((unsigned)f2bf(b) << 16); }
DEVI float wsum(float v) {
#pragma unroll
  for (int m = 32; m >= 1; m >>= 1) v += __shfl_xor(v, m);
  return v;
}
DEVI void wave_sync() { __builtin_amdgcn_fence(__ATOMIC_RELEASE, "wavefront"); __builtin_amdgcn_wave_barrier(); __builtin_amdgcn_fence(__ATOMIC_ACQUIRE, "wavefront"); }
DEVI void seq_of(int tok, int& s0, int& L) {
  if (tok < TPROMPT) { s0 = tok & ~4095; L = 4096; } else { s0 = TPROMPT + ((tok - TPROMPT) & ~16383); L = 16384; }
}
DEVI const float* xrow(const Params& p, int layer, int tok) {
  if (layer == 0) return tok < TPROMPT ? p.in[I_XP] + (size_t)tok * 1024 : p.in[I_XS] + (size_t)(tok - TPROMPT) * 1024;
  return p.out + (size_t)tok * 1024;
}
DEVI float sigmoidf_(float x) { return 1.f / (1.f + expf(-x)); }
DEVI float gelu_tanh(float x) { return 0.5f * x * (1.f + tanhf(0.7978845608f * (x + 0.044715f * x * x * x))); }

__device__ void transpose_bf16(const float* __restrict__ in, ushort_t* __restrict__ out, int K, int N, unsigned char* lds) {
  float* tile = (float*)lds;
  const int tid = tidx(), j = tid & 63, i0 = tid >> 6;
  const int tk = K / 64, tn = N / 64;
  for (int t = bidx(); t < tk * tn; t += gridDim.x) {
    const int k0 = (t / tn) * 64, n0 = (t % tn) * 64;
#pragma unroll
    for (int e = 0; e < 8; ++e) { int i = i0 + 8 * e; tile[i * 65 + j] = in[(size_t)(k0 + i) * N + n0 + j]; }
    __syncthreads();
#pragma unroll
    for (int e = 0; e < 8; ++e) { int i = i0 + 8 * e; out[(size_t)(n0 + i) * K + k0 + j] = f2bf(tile[j * 65 + i]); }
    __syncthreads();
  }
}

template <int AMODE, int EPI>
__device__ void gemm_phase(const Params& p, int layer, unsigned char* lds, const void* Aptr, const ushort_t* __restrict__ Bt,
                           int N, int K, void* O0, void* O1, const void* E0, const void* E1, const float* bias) {
  ushort_t* sA = (ushort_t*)lds;
  ushort_t* sB = sA + 2 * 128 * 72;
  const int tid = tidx(), lane = tid & 63, wave = tid >> 6, wm = wave >> 2, wn = wave & 3;
  const int NTl = (N + 127) / 128, MT = T / 128;
  const int lr = tid >> 2, lk = (tid & 3) * 16;
  const int nk = K / 64;
  for (int tile = bidx(); tile < MT * NTl; tile += gridDim.x) {
    const int mt = tile / NTl, nt = tile % NTl, m0 = mt * 128, n0 = nt * 128;
    f32x4 acc[4][2];
#pragma unroll
    for (int i = 0; i < 4; ++i)
#pragma unroll
      for (int j = 0; j < 2; ++j) acc[i][j] = f32x4{0.f, 0.f, 0.f, 0.f};
    uint4 ra0, ra1, rb0, rb1;
    int s0 = 0, L = 0;
    if (AMODE == 3) seq_of(m0, s0, L);
#define LOAD_AB(k0_)                                                                                                     \
    {                                                                                                                    \
      const int k0 = (k0_);                                                                                              \
      if (AMODE == 0 || AMODE == 2) {                                                                                    \
        const float* src = (AMODE == 0) ? (xrow(p, layer, m0 + lr) + k0 + lk) : ((const float*)Aptr + (size_t)(m0 + lr) * K + k0 + lk); \
        float4 f0 = ((const float4*)src)[0], f1 = ((const float4*)src)[1], f2 = ((const float4*)src)[2], f3 = ((const float4*)src)[3]; \
        if (AMODE == 2) {                                                                                                \
          f0.x = gelu_tanh(f0.x); f0.y = gelu_tanh(f0.y); f0.z = gelu_tanh(f0.z); f0.w = gelu_tanh(f0.w);                \
          f1.x = gelu_tanh(f1.x); f1.y = gelu_tanh(f1.y); f1.z = gelu_tanh(f1.z); f1.w = gelu_tanh(f1.w);                \
          f2.x = gelu_tanh(f2.x); f2.y = gelu_tanh(f2.y); f2.z = gelu_tanh(f2.z); f2.w = gelu_tanh(f2.w);                \
          f3.x = gelu_tanh(f3.x); f3.y = gelu_tanh(f3.y); f3.z = gelu_tanh(f3.z); f3.w = gelu_tanh(f3.w);                \
        }                                                                                                                \
        ra0 = uint4{pack2(f0.x, f0.y), pack2(f0.z, f0.w), pack2(f1.x, f1.y), pack2(f1.z, f1.w)};                         \
        ra1 = uint4{pack2(f2.x, f2.y), pack2(f2.z, f2.w), pack2(f3.x, f3.y), pack2(f3.z, f3.w)};                         \
      } else if (AMODE == 1) {                                                                                           \
        const uint4* src = (const uint4*)((const ushort_t*)Aptr + (size_t)(m0 + lr) * K + k0 + lk);                      \
        ra0 = src[0]; ra1 = src[1];                                                                                      \
      } else {                                                                                                           \
        const int kk = tid >> 3, ms = (tid & 7) * 16;                                                                    \
        const uint4* src = (const uint4*)((const ushort_t*)Aptr + (size_t)s0 * 1024 + (size_t)(k0 + kk) * L + (m0 - s0) + ms); \
        ra0 = src[0]; ra1 = src[1];                                                                                      \
      }                                                                                                                  \
      const int nn = n0 + lr;                                                                                            \
      if (nn < N) { const uint4* src = (const uint4*)(Bt + (size_t)nn * K + k0 + lk); rb0 = src[0]; rb1 = src[1]; }      \
      else { rb0 = uint4{0, 0, 0, 0}; rb1 = rb0; }                                                                       \
    }
#define STORE_LDS(b_)                                                                                                    \
    {                                                                                                                    \
      const int bb = (b_);                                                                                               \
      if (AMODE == 3) {                                                                                                  \
        const int kk = tid >> 3, ms = (tid & 7) * 16;                                                                    \
        ushort_t* d = sA + (size_t)(bb * 128 + ms) * 72 + kk;                                                            \
        d[0 * 72] = (ushort_t)(ra0.x & 0xffff); d[1 * 72] = (ushort_t)(ra0.x >> 16);                                     \
        d[2 * 72] = (ushort_t)(ra0.y & 0xffff); d[3 * 72] = (ushort_t)(ra0.y >> 16);                                     \
        d[4 * 72] = (ushort_t)(ra0.z & 0xffff); d[5 * 72] = (ushort_t)(ra0.z >> 16);                                     \
        d[6 * 72] = (ushort_t)(ra0.w & 0xffff); d[7 * 72] = (ushort_t)(ra0.w >> 16);                                     \
        d[8 * 72] = (ushort_t)(ra1.x & 0xffff); d[9 * 72] = (ushort_t)(ra1.x >> 16);                                     \
        d[10 * 72] = (ushort_t)(ra1.y & 0xffff); d[11 * 72] = (ushort_t)(ra1.y >> 16);                                   \
        d[12 * 72] = (ushort_t)(ra1.z & 0xffff); d[13 * 72] = (ushort_t)(ra1.z >> 16);                                   \
        d[14 * 72] = (ushort_t)(ra1.w & 0xffff); d[15 * 72] = (ushort_t)(ra1.w >> 16);                                   \
      } else {                                                                                                           \
        uint4* d = (uint4*)(sA + (size_t)(bb * 128 + lr) * 72 + lk);                                                     \
        d[0] = ra0; d[1] = ra1;                                                                                          \
      }                                                                                                                  \
      uint4* d2 = (uint4*)(sB + (size_t)(bb * 128 + lr) * 72 + lk);                                                      \
      d2[0] = rb0; d2[1] = rb1;                                                                                          \
    }
    LOAD_AB(0);
    STORE_LDS(0);
    __syncthreads();
    for (int kt = 0; kt < nk; ++kt) {
      const int b = kt & 1;
      if (kt + 1 < nk) LOAD_AB((kt + 1) * 64);
#pragma unroll
      for (int ks = 0; ks < 2; ++ks) {
        bf16x8 af[4], bfr[2];
#pragma unroll
        for (int i = 0; i < 4; ++i)
          af[i] = *(const bf16x8*)(sA + (size_t)(b * 128 + wm * 64 + i * 16 + (lane & 15)) * 72 + ks * 32 + (lane >> 4) * 8);
#pragma unroll
        for (int j = 0; j < 2; ++j)
          bfr[j] = *(const bf16x8*)(sB + (size_t)(b * 128 + wn * 32 + j * 16 + (lane & 15)) * 72 + ks * 32 + (lane >> 4) * 8);
#pragma unroll
        for (int i = 0; i < 4; ++i)
#pragma unroll
          for (int j = 0; j < 2; ++j) acc[i][j] = __builtin_amdgcn_mfma_f32_16x16x32_bf16(af[i], bfr[j], acc[i][j], 0, 0, 0);
      }
      if (kt + 1 < nk) STORE_LDS(b ^ 1);
      __syncthreads();
    }
#pragma unroll
    for (int i = 0; i < 4; ++i)
#pragma unroll
      for (int j = 0; j < 2; ++j) {
        const int mb = m0 + wm * 64 + i * 16 + (lane >> 4) * 4;
        const int n = n0 + wn * 32 + j * 16 + (lane & 15);
        if (n >= N) continue;
        if (EPI == 0) {
#pragma unroll
          for (int r = 0; r < 4; ++r) {
            const int m = mb + r;
            if (n < 1024) ((ushort_t*)O0)[(size_t)m * 1024 + n] = f2bf(acc[i][j][r]);
            else ((ushort_t*)O1)[(size_t)m * 2112 + (n - 1024)] = f2bf(acc[i][j][r]);
          }
        } else if (EPI == 1) {
          int s0e, Le; seq_of(mb, s0e, Le);
          const int st = n >> 10, c = n & 1023;
          ushort_t* dst = (ushort_t*)O0 + (size_t)st * T * 1024 + (size_t)s0e * 1024 + (size_t)c * Le + (mb - s0e);
          *(uint2*)dst = uint2{pack2(acc[i][j][0], acc[i][j][1]), pack2(acc[i][j][2], acc[i][j][3])};
        } else if (EPI == 2) {
#pragma unroll
          for (int r = 0; r < 4; ++r) {
            const int m = mb + r;
            const float a = gelu_tanh(((const float*)E0)[(size_t)m * 512 + n]);
            const float g = bf2f(((const ushort_t*)E1)[(size_t)m * 1024 + 512 + n]);
            const float v = a * sigmoidf_(acc[i][j][r] + bias[n]) * (g * sigmoidf_(g));
            ((ushort_t*)O0)[(size_t)m * 1024 + n] = f2bf(v);
          }
        } else {
#pragma unroll
          for (int r = 0; r < 4; ++r) ((float*)O0)[(size_t)(mb + r) * 1024 + n] = acc[i][j][r];
        }
      }
  }
}

__device__ void ln_phase(const Params& p, int layer, const float* __restrict__ F) {
  const int lane = tidx() & 63, gw = bidx() * (NT / 64) + (tidx() >> 6), nw = gridDim.x * (NT / 64);
  const float alpha = 1.681792830507429f;
  const float4* g4 = (const float4*)(p.in[I_LNG] + layer * 1024);
  const float4* b4 = (const float4*)(p.in[I_LNB] + layer * 1024);
  for (int row = gw; row < T; row += nw) {
    const float4* x4 = (const float4*)xrow(p, layer, row);
    const float4* f4 = (const float4*)(F + (size_t)row * 1024);
    float4 v[4];
    float s = 0.f;
#pragma unroll
    for (int e = 0; e < 4; ++e) {
      float4 a = x4[lane + 64 * e], f = f4[lane + 64 * e];
      v[e] = float4{alpha * a.x + f.x, alpha * a.y + f.y, alpha * a.z + f.z, alpha * a.w + f.w};
      s += v[e].x + v[e].y + v[e].z + v[e].w;
    }
    const float mean = wsum(s) * (1.f / 1024.f);
    float q = 0.f;
#pragma unroll
    for (int e = 0; e < 4; ++e) {
      v[e].x -= mean; v[e].y -= mean; v[e].z -= mean; v[e].w -= mean;
      q += v[e].x * v[e].x + v[e].y * v[e].y + v[e].z * v[e].z + v[e].w * v[e].w;
    }
    const float rs = rsqrtf(wsum(q) * (1.f / 1024.f) + 1e-5f);
    float4* o4 = (float4*)(p.out + (size_t)row * 1024);
#pragma unroll
    for (int e = 0; e < 4; ++e) {
      float4 g = g4[lane + 64 * e], b = b4[lane + 64 * e];
      o4[lane + 64 * e] = float4{v[e].x * rs * g.x + b.x, v[e].y * rs * g.y + b.y, v[e].z * rs * g.z + b.z, v[e].w * rs * g.w + b.w};
    }
  }
}

struct cplx { float x, y; };
DEVI cplx cmul(cplx a, cplx b) { return cplx{a.x * b.x - a.y * b.y, a.x * b.y + a.y * b.x}; }
DEVI void s5_consts(const Params& p, int i, int d, int g, int n, cplx& lb, cplx& coef) {
  const int idx = ((i * 2 + d) * 32 + g) * 64 + n;
  const float lre = p.in[I_LRE][idx], lim = p.in[I_LIM][idx];
  const float dt = expf(p.in[I_LSTEP][(i * 2 + d) * 32 + g]);
  const float mag = expf(lre * dt);
  float sn, cs; sincosf(lim * dt, &sn, &cs);
  lb = cplx{mag * cs, mag * sn};
  const float nr = lb.x - 1.f, ni = lb.y, den = 1.f / (lre * lre + lim * lim);
  coef = cplx{(nr * lre + ni * lim) * den, (ni * lre - nr * lim) * den};
}
DEVI void s5_stage_u(const ushort_t* PS5, int tok0, int g, float* U, int lane) {
  const uint4* src = (const uint4*)(PS5 + (size_t)(tok0 + lane) * 1024 + g * 16);
  uint4 a = src[0], b = src[1];
  float4* d = (float4*)(U + lane * 16);
  d[0] = float4{__uint_as_float(a.x << 16), __uint_as_float(a.x & 0xffff0000u), __uint_as_float(a.y << 16), __uint_as_float(a.y & 0xffff0000u)};
  d[1] = float4{__uint_as_float(a.z << 16), __uint_as_float(a.z & 0xffff0000u), __uint_as_float(a.w << 16), __uint_as_float(a.w & 0xffff0000u)};
  d[2] = float4{__uint_as_float(b.x << 16), __uint_as_float(b.x & 0xffff0000u), __uint_as_float(b.y << 16), __uint_as_float(b.y & 0xffff0000u)};
  d[3] = float4{__uint_as_float(b.z << 16), __uint_as_float(b.z & 0xffff0000u), __uint_as_float(b.w << 16), __uint_as_float(b.w & 0xffff0000u)};
}
#define S5_BU(Urow, bur, bui)                                                         \
  {                                                                                   \
    const float4* u4 = (const float4*)(Urow);                                         \
    bur = 0.f; bui = 0.f;                                                             \
    _Pragma("unroll") for (int pp = 0; pp < 4; ++pp) {                                \
      float4 u = u4[pp];                                                              \
      bur += Br[4 * pp] * u.x + Br[4 * pp + 1] * u.y + Br[4 * pp + 2] * u.z + Br[4 * pp + 3] * u.w; \
      bui += Bi[4 * pp] * u.x + Bi[4 * pp + 1] * u.y + Bi[4 * pp + 2] * u.z + Bi[4 * pp + 3] * u.w; \
    }                                                                                 \
  }

__device__ void s5_passA(const Params& p, int i, unsigned char* lds) {
  const ushort_t* PS5 = (const ushort_t*)(p.ws + OFF_PS5);
  cplx* CAR = (cplx*)(p.ws + OFF_CAR);
  const int lane = tidx() & 63, wave = tidx() >> 6;
  float* U = (float*)(lds + wave * 8448);
  for (int item = bidx() * 8 + wave; item < 192 * 32; item += gridDim.x * 8) {
    const int q = item >> 5, g = item & 31;
    cplx lb0, c0, lb1, c1;
    s5_consts(p, i, 0, g, lane, lb0, c0);
    s5_consts(p, i, 1, g, lane, lb1, c1);
    float Br[16], Bi[16];
#pragma unroll
    for (int pp = 0; pp < 16; ++pp) { Br[pp] = p.in[I_BRE][((i * 32 + g) * 64 + lane) * 16 + pp]; Bi[pp] = p.in[I_BIM][((i * 32 + g) * 64 + lane) * 16 + pp]; }
    cplx xf{0.f, 0.f}, xb{0.f, 0.f}, pw{1.f, 0.f};
    for (int sb = 0; sb < 4; ++sb) {
      wave_sync();
      s5_stage_u(PS5, q * 256 + sb * 64, g, U, lane);
      wave_sync();
      for (int t = 0; t < 64; ++t) {
        float bur, bui;
        S5_BU(U + t * 16, bur, bui);
        xf = cmul(lb0, xf); xf.x += bur; xf.y += bui;
        xb.x += pw.x * bur - pw.y * bui; xb.y += pw.x * bui + pw.y * bur;
        pw = cmul(pw, lb1);
      }
    }
    CAR[((size_t)(q * 32 + g) * 2 + 0) * 64 + lane] = cmul(xf, c0);
    CAR[((size_t)(q * 32 + g) * 2 + 1) * 64 + lane] = cmul(xb, c1);
  }
}

__device__ void s5_passC(const Params& p, int i, unsigned char* lds) {
  const ushort_t* PS5 = (const ushort_t*)(p.ws + OFF_PS5);
  const cplx* CAR = (const cplx*)(p.ws + OFF_CAR);
  float* YS = (float*)(p.ws + OFF_YS);
  const int lane = tidx() & 63, wave = tidx() >> 6;
  float* U = (float*)(lds + wave * 8448);
  ushort_t* X = (ushort_t*)(lds + wave * 8448 + 4096);
  for (int item = bidx() * 8 + wave; item < 192 * 32; item += gridDim.x * 8) {
    const int q = item >> 5, g = item & 31;
    int cs, ce;
    if (q < 64) { cs = q & ~15; ce = cs + 16; } else { cs = 64 + ((q - 64) & ~63); ce = cs + 64; }
    float Br[16], Bi[16];
#pragma unroll
    for (int pp = 0; pp < 16; ++pp) { Br[pp] = p.in[I_BRE][((i * 32 + g) * 64 + lane) * 16 + pp]; Bi[pp] = p.in[I_BIM][((i * 32 + g) * 64 + lane) * 16 + pp]; }
    const int pcol = lane & 15;
    const float dd = p.in[I_S5D][i * 512 + g * 16 + pcol];
    for (int d = 0; d < 2; ++d) {
      cplx lb, coef;
      s5_consts(p, i, d, g, lane, lb, coef);
      cplx lp = lb;
#pragma unroll
      for (int e = 0; e < 8; ++e) lp = cmul(lp, lp);
      cplx xs{0.f, 0.f};
      if (d == 0) { for (int j = cs; j < q; ++j) { xs = cmul(lp, xs); cplx c = CAR[((size_t)(j * 32 + g) * 2 + 0) * 64 + lane]; xs.x += c.x; xs.y += c.y; } }
      else { for (int j = ce - 1; j > q; --j) { xs = cmul(lp, xs); cplx c = CAR[((size_t)(j * 32 + g) * 2 + 1) * 64 + lane]; xs.x += c.x; xs.y += c.y; } }
      bf16x8 cf[4];
#pragma unroll
      for (int kk = 0; kk < 4; ++kk) {
        const int n0 = (kk & 1) * 32 + (lane >> 4) * 8;
        const float* src = (kk < 2 ? p.in[I_CRE] : p.in[I_CIM]) + (((size_t)(i * 2 + d) * 32 + g) * 16 + pcol) * 64 + n0;
        const float sg = kk < 2 ? 1.f : -1.f;
#pragma unroll
        for (int j = 0; j < 8; ++j) cf[kk][j] = (short)f2bf(sg * src[j]);
      }
      for (int sbi = 0; sbi < 4; ++sbi) {
        const int sb = d ? 3 - sbi : sbi;
        wave_sync();
        s5_stage_u(PS5, q * 256 + sb * 64, g, U, lane);
        wave_sync();
        for (int tbi = 0; tbi < 4; ++tbi) {
          const int tb = d ? 3 - tbi : tbi;
          for (int tti = 0; tti < 16; ++tti) {
            const int tt = d ? 15 - tti : tti;
            float bur, bui;
            S5_BU(U + (tb * 16 + tt) * 16, bur, bui);
            xs = cmul(lb, xs);
            xs.x += coef.x * bur - coef.y * bui;
            xs.y += coef.x * bui + coef.y * bur;
            X[tt * 136 + lane] = f2bf(xs.x);
            X[tt * 136 + 64 + lane] = f2bf(xs.y);
          }
          wave_sync();
          f32x4 acc{0.f, 0.f, 0.f, 0.f};
#pragma unroll
          for (int kk = 0; kk < 4; ++kk) {
            bf16x8 a = *(const bf16x8*)(X + (lane & 15) * 136 + kk * 32 + (lane >> 4) * 8);
            acc = __builtin_amdgcn_mfma_f32_16x16x32_bf16(a, cf[kk], acc, 0, 0, 0);
          }
          wave_sync();
#pragma unroll
          for (int r = 0; r < 4; ++r) {
            const int tl = tb * 16 + (lane >> 4) * 4 + r;
            const size_t o = (size_t)(q * 256 + sb * 64 + tl) * 512 + g * 16 + pcol;
            if (d == 0) YS[o] = acc[r] + dd * U[tl * 16 + pcol];
            else YS[o] += acc[r];
          }
        }
      }
    }
  }
}

struct RwConst { float mur, muk, muv, mul, w0, a0, kk, ka; };
DEVI void rw_prologue(const ushort_t* PRW, int tok, int h, int lane, const RwConst& c, const float* WU, const float* AU,
                      float* LT, float* Wd, float* KKd, float* BBd, float* KDd, float* RRd, float* VVd) {
  int s0, L; seq_of(tok, s0, L);
  const ushort_t* row = PRW + (size_t)tok * 2112;
  const bool hm = tok > s0, hp = tok + 1 < s0 + L;
  const int cc = h * 64 + lane;
  float r0 = bf2f(row[cc]), k0 = bf2f(row[512 + cc]), v0 = bf2f(row[1024 + cc]), l0 = bf2f(row[2048 + lane]);
  float rn = 0.f, kn = 0.f, vn = 0.f, ln = 0.f;
  if (hm) { const ushort_t* r2 = row - 2112; rn += bf2f(r2[cc]); kn += bf2f(r2[512 + cc]); vn += bf2f(r2[1024 + cc]); ln += bf2f(r2[2048 + lane]); }
  if (hp) { const ushort_t* r2 = row + 2112; rn += bf2f(r2[cc]); kn += bf2f(r2[512 + cc]); vn += bf2f(r2[1024 + cc]); ln += bf2f(r2[2048 + lane]); }
  const float rr = r0 + c.mur * (0.5f * rn - r0);
  const float kx = k0 + c.muk * (0.5f * kn - k0);
  const float vv = v0 + c.muv * (0.5f * vn - v0);
  float ll = l0 + c.mul * (0.5f * ln - l0);
  if (lane < 32) ll = tanhf(ll);
  wave_sync();
  LT[lane] = ll;
  wave_sync();
  float accw = c.w0, acca = c.a0;
#pragma unroll 1
  for (int j = 0; j < 32; j += 4) {
    float4 lw = *(const float4*)(LT + j), la = *(const float4*)(LT + 32 + j);
    accw += lw.x * WU[(j + 0) * 64 + lane] + lw.y * WU[(j + 1) * 64 + lane] + lw.z * WU[(j + 2) * 64 + lane] + lw.w * WU[(j + 3) * 64 + lane];
    acca += la.x * AU[(j + 0) * 64 + lane] + la.y * AU[(j + 1) * 64 + lane] + la.z * AU[(j + 2) * 64 + lane] + la.w * AU[(j + 3) * 64 + lane];
  }
  const float dec = expf(-0.6065306597126334f * sigmoidf_(accw));
  const float a = sigmoidf_(acca);
  const float kkr = kx * c.kk;
  const float ss = wsum(kkr * kkr);
  const float kkn = kkr / fmaxf(sqrtf(ss), 1e-12f);
  Wd[lane] = dec; KKd[lane] = kkn; BBd[lane] = kkn * a; KDd[lane] = kx * (1.f + (a - 1.f) * c.ka); RRd[lane] = rr; VVd[lane] = vv;
}

__device__ void rwkv_scan1(const Params& p, int i, unsigned char* lds) {
  const ushort_t* PRW = (const ushort_t*)(p.ws + OFF_PRW);
  float* CH = (float*)(p.ws + OFF_PS5);
  float* YR = (float*)(p.ws + OFF_YS);
  const int tid = tidx(), lane = tid & 63, wave = tid >> 6, pair = wave >> 1, role = wave & 1;
  float* TAB = (float*)lds;
  float* WV = (float*)(lds + 24576 + pair * 12800);
  float* Wd = WV, *KKd = WV + 512, *BBd = WV + 1024, *KDd = WV + 1536, *RRd = WV + 2048, *VVd = WV + 2560, *LT = WV + 3072 + role * 64;
  {
    float4* z = (float4*)YR;
    for (size_t e = (size_t)bidx() * NT + tid; e < (size_t)T * 512 / 4; e += (size_t)gridDim.x * NT) z[e] = float4{0.f, 0.f, 0.f, 0.f};
  }
  for (int bi = bidx(); bi < 768; bi += gridDim.x) {
    const int h = bi / 96, rem = bi % 96;
    const int dir = pair >> 1, q = rem * 2 + (pair & 1);
    __syncthreads();
    for (int e = tid; e < 3 * 2048; e += NT) {
      const int which = e >> 11, j = (e >> 6) & 31, c = e & 63;
      TAB[e] = which < 2 ? p.in[I_WUP][((size_t)(i * 2 + which) * 32 + j) * 512 + h * 64 + c] : p.in[I_AUP][((size_t)i * 32 + j) * 512 + h * 64 + c];
    }
    __syncthreads();
    const float* WU = TAB + dir * 2048;
    const float* AU = TAB + 2 * 2048;
    RwConst c;
    const int cc = h * 64 + lane;
    c.mur = p.in[I_MURKV][(i * 3 + 0) * 512 + cc]; c.muk = p.in[I_MURKV][(i * 3 + 1) * 512 + cc]; c.muv = p.in[I_MURKV][(i * 3 + 2) * 512 + cc];
    c.mul = p.in[I_MULORA][i * 64 + lane];
    c.w0 = p.in[I_W0][(i * 2 + dir) * 512 + cc]; c.a0 = p.in[I_A0][(i * 2 + dir) * 512 + cc];
    c.kk = p.in[I_KK][i * 512 + cc]; c.ka = p.in[I_KA][i * 512 + cc];
    const size_t it = ((size_t)(q * 8 + h) * 2 + dir);
    float* Op = CH + it * 8192 + (role ? 0 : 4096);
    float S[64];
#pragma unroll
    for (int k = 0; k < 64; ++k) S[k] = (role && k == lane) ? 1.f : 0.f;
    for (int blk = 0; blk < 32; ++blk) {
#pragma unroll 1
      for (int s = role * 4; s < role * 4 + 4; ++s) {
        const int st = blk * 8 + s;
        const int tok = dir ? (q * 256 + 255 - st) : (q * 256 + st);
        rw_prologue(PRW, tok, h, lane, c, WU, AU, LT, Wd + s * 64, KKd + s * 64, BBd + s * 64, KDd + s * 64, RRd + s * 64, VVd + s * 64);
      }
      __syncthreads();
#pragma unroll 1
      for (int s = 0; s < 8; ++s) {
        float sa = 0.f;
#pragma unroll
        for (int k4 = 0; k4 < 16; ++k4) {
          if ((k4 & 7) == 0) __builtin_amdgcn_sched_barrier(0);
          float4 kq = *(const float4*)(KKd + s * 64 + 4 * k4);
          sa -= S[4 * k4] * kq.x + S[4 * k4 + 1] * kq.y + S[4 * k4 + 2] * kq.z + S[4 * k4 + 3] * kq.w;
        }
        const float vv = role ? 0.f : VVd[s * 64 + lane];
#pragma unroll
        for (int k4 = 0; k4 < 16; ++k4) {
          if ((k4 & 3) == 0) __builtin_amdgcn_sched_barrier(0);
          float4 w = *(const float4*)(Wd + s * 64 + 4 * k4), b = *(const float4*)(BBd + s * 64 + 4 * k4), kd = *(const float4*)(KDd + s * 64 + 4 * k4);
          S[4 * k4 + 0] = S[4 * k4 + 0] * w.x + sa * b.x + vv * kd.x;
          S[4 * k4 + 1] = S[4 * k4 + 1] * w.y + sa * b.y + vv * kd.y;
          S[4 * k4 + 2] = S[4 * k4 + 2] * w.z + sa * b.z + vv * kd.z;
          S[4 * k4 + 3] = S[4 * k4 + 3] * w.w + sa * b.w + vv * kd.w;
        }
      }
      __syncthreads();
    }
#pragma unroll
    for (int k4 = 0; k4 < 16; ++k4) ((float4*)(Op + lane * 64))[k4] = float4{S[4 * k4], S[4 * k4 + 1], S[4 * k4 + 2], S[4 * k4 + 3]};
  }
}

__device__ void rwkv_scan3(const Params& p, int i, unsigned char* lds) {
  const ushort_t* PRW = (const ushort_t*)(p.ws + OFF_PRW);
  float* CH = (float*)(p.ws + OFF_PS5);
  float* YR = (float*)(p.ws + OFF_YS);
  const int tid = tidx(), lane = tid & 63, wave = tid >> 6;
  float* TAB = (float*)lds;
  float* WV = (float*)(lds + 24576 + wave * 12544);
  float* Wd = WV, *KKd = WV + 512, *BBd = WV + 1024, *KDd = WV + 1536, *RRd = WV + 2048, *VVd = WV + 2560, *LT = WV + 3072;
  for (int bi = bidx(); bi < 384; bi += gridDim.x) {
    const int h = bi / 48, cgp = bi % 48;
    const int dir = wave >> 2, q = cgp * 4 + (wave & 3);
    __syncthreads();
    for (int e = tid; e < 3 * 2048; e += NT) {
      const int which = e >> 11, j = (e >> 6) & 31, c = e & 63;
      TAB[e] = which < 2 ? p.in[I_WUP][((size_t)(i * 2 + which) * 32 + j) * 512 + h * 64 + c] : p.in[I_AUP][((size_t)i * 32 + j) * 512 + h * 64 + c];
    }
    __syncthreads();
    const float* WU = TAB + dir * 2048;
    const float* AU = TAB + 2 * 2048;
    RwConst c;
    const int cc = h * 64 + lane;
    c.mur = p.in[I_MURKV][(i * 3 + 0) * 512 + cc]; c.muk = p.in[I_MURKV][(i * 3 + 1) * 512 + cc]; c.muv = p.in[I_MURKV][(i * 3 + 2) * 512 + cc];
    c.mul = p.in[I_MULORA][i * 64 + lane];
    c.w0 = p.in[I_W0][(i * 2 + dir) * 512 + cc]; c.a0 = p.in[I_A0][(i * 2 + dir) * 512 + cc];
    c.kk = p.in[I_KK][i * 512 + cc]; c.ka = p.in[I_KA][i * 512 + cc];
    const size_t it = ((size_t)(q * 8 + h) * 2 + dir);
    const float* Qp = CH + it * 8192 + 4096;
    float S[64];
#pragma unroll
    for (int k4 = 0; k4 < 16; ++k4) { float4 v = ((const float4*)(Qp + lane * 64))[k4]; S[4 * k4] = v.x; S[4 * k4 + 1] = v.y; S[4 * k4 + 2] = v.z; S[4 * k4 + 3] = v.w; }
    for (int blk = 0; blk < 32; ++blk) {
#pragma unroll 1
      for (int s = 0; s < 8; ++s) {
        const int st = blk * 8 + s;
        const int tok = dir ? (q * 256 + 255 - st) : (q * 256 + st);
        rw_prologue(PRW, tok, h, lane, c, WU, AU, LT, Wd + s * 64, KKd + s * 64, BBd + s * 64, KDd + s * 64, RRd + s * 64, VVd + s * 64);
      }
      wave_sync();
#pragma unroll 1
      for (int s = 0; s < 8; ++s) {
        float sa = 0.f;
#pragma unroll
        for (int k4 = 0; k4 < 16; ++k4) {
          if ((k4 & 7) == 0) __builtin_amdgcn_sched_barrier(0);
          float4 kq = *(const float4*)(KKd + s * 64 + 4 * k4);
          sa -= S[4 * k4] * kq.x + S[4 * k4 + 1] * kq.y + S[4 * k4 + 2] * kq.z + S[4 * k4 + 3] * kq.w;
        }
        const float vv = VVd[s * 64 + lane];
        float y = 0.f;
#pragma unroll
        for (int k4 = 0; k4 < 16; ++k4) {
          if ((k4 & 3) == 0) __builtin_amdgcn_sched_barrier(0);
          float4 w = *(const float4*)(Wd + s * 64 + 4 * k4), b = *(const float4*)(BBd + s * 64 + 4 * k4), kd = *(const float4*)(KDd + s * 64 + 4 * k4);
          float4 r = *(const float4*)(RRd + s * 64 + 4 * k4);
          S[4 * k4 + 0] = S[4 * k4 + 0] * w.x + sa * b.x + vv * kd.x;
          S[4 * k4 + 1] = S[4 * k4 + 1] * w.y + sa * b.y + vv * kd.y;
          S[4 * k4 + 2] = S[4 * k4 + 2] * w.z + sa * b.z + vv * kd.z;
          S[4 * k4 + 3] = S[4 * k4 + 3] * w.w + sa * b.w + vv * kd.w;
          y += S[4 * k4] * r.x + S[4 * k4 + 1] * r.y + S[4 * k4 + 2] * r.z + S[4 * k4 + 3] * r.w;
        }
        const int st = blk * 8 + s;
        const int tok = dir ? (q * 256 + 255 - st) : (q * 256 + st);
        atomicAdd(YR + (size_t)tok * 512 + h * 64 + lane, y);
      }
      wave_sync();
    }
  }
}

__device__ void rwkv_carry(const Params& p, unsigned char* lds) {
  float* CH = (float*)(p.ws + OFF_PS5);
  float* Ps = (float*)lds;
  float* Ss = Ps + 4096;
  const int tid = tidx(), v = tid >> 4, ks = (tid & 15) * 4;
  for (int bi = bidx(); bi < 192; bi += gridDim.x) {
    const int half = bi & 1, dir = (bi >> 1) & 1, h = (bi >> 2) & 7, s = bi >> 5;
    int cs, n;
    if (s < 4) { cs = s * 16; n = 16; } else { cs = 64 + (s - 4) * 64; n = 64; }
    float4 cur{0.f, 0.f, 0.f, 0.f};
    for (int ci = 0; ci < n; ++ci) {
      const int q = dir ? (cs + n - 1 - ci) : (cs + ci);
      float* Pp = CH + ((size_t)(q * 8 + h) * 2 + dir) * 8192;
      float* Qrow = Pp + 4096 + (half * 32 + v) * 64 + ks;
      __syncthreads();
      float4 qv = *(const float4*)Qrow;
      *(float4*)Qrow = cur;
      if (ci == n - 1) break;
      *(float4*)(Ss + v * 64 + ks) = cur;
      ((float4*)Ps)[tid] = ((const float4*)Pp)[tid];
      ((float4*)Ps)[tid + 512] = ((const float4*)Pp)[tid + 512];
      __syncthreads();
      float4 acc = qv;
#pragma unroll 8
      for (int j = 0; j < 64; ++j) {
        const float sv = Ss[v * 64 + j];
        const float4 pr = *(const float4*)(Ps + j * 64 + ks);
        acc.x += sv * pr.x; acc.y += sv * pr.y; acc.z += sv * pr.z; acc.w += sv * pr.w;
      }
      cur = acc;
    }
    __syncthreads();
  }
}

__device__ void rwkv_post(const Params& p, int i) {
  const ushort_t* PRW = (const ushort_t*)(p.ws + OFF_PRW);
  const float* YR = (const float*)(p.ws + OFF_YS);
  ushort_t* Y = (ushort_t*)(p.ws + OFF_Y);
  const int lane = tidx() & 63, gw = bidx() * 8 + (tidx() >> 6), nw = gridDim.x * 8;
  for (int item = gw; item < T * 8; item += nw) {
    const int tok = item >> 3, h = item & 7, cc = h * 64 + lane;
    int s0, L; seq_of(tok, s0, L);
    const ushort_t* row = PRW + (size_t)tok * 2112;
    const bool hm = tok > s0, hp = tok + 1 < s0 + L;
    float r0 = bf2f(row[cc]), k0 = bf2f(row[512 + cc]), v0 = bf2f(row[1024 + cc]);
    float rn = 0.f, kn = 0.f, vn = 0.f;
    if (hm) { const ushort_t* r2 = row - 2112; rn += bf2f(r2[cc]); kn += bf2f(r2[512 + cc]); vn += bf2f(r2[1024 + cc]); }
    if (hp) { const ushort_t* r2 = row + 2112; rn += bf2f(r2[cc]); kn += bf2f(r2[512 + cc]); vn += bf2f(r2[1024 + cc]); }
    const float rr = r0 + p.in[I_MURKV][(i * 3 + 0) * 512 + cc] * (0.5f * rn - r0);
    const float kx = k0 + p.in[I_MURKV][(i * 3 + 1) * 512 + cc] * (0.5f * kn - k0);
    const float vv = v0 + p.in[I_MURKV][(i * 3 + 2) * 512 + cc] * (0.5f * vn - v0);
    const float y = YR[(size_t)tok * 512 + cc];
    const float mean = wsum(y) * (1.f / 64.f);
    const float dlt = y - mean;
    const float var = wsum(dlt * dlt) * (1.f / 64.f);
    const float yn = dlt * rsqrtf(var + 64e-5f) * p.in[I_LNXW][i * 512 + cc] + p.in[I_LNXB][i * 512 + cc];
    const float bonus = wsum(rr * kx * p.in[I_RK][i * 512 + cc]) * vv;
    const float g = bf2f(row[1536 + cc]);
    Y[(size_t)tok * 1024 + 512 + cc] = f2bf((yn + bonus) * (g * sigmoidf_(g)));
  }
}

__device__ void hy_filter_mlp(const Params& p, int i) {
  float* H2 = (float*)(p.ws + OFF_H2);
  const int lane = tidx() & 63, gw = bidx() * 8 + (tidx() >> 6), nw = gridDim.x * 8;
  const float fr = p.in[I_FFREQ][i * 64 + lane], b1 = p.in[I_FB1][i * 64 + lane], b2 = p.in[I_FB2][i * 64 + lane];
  for (int row = gw; row < 20480; row += nw) {
    const int L = row < 4096 ? 4096 : 16384, t = row < 4096 ? row : row - 4096;
    const float w = 6.283185307179586f * (float)t / (float)L;
    float z = 0.f;
    if (lane == 0) z = (float)t / (float)(L - 1);
    else if (lane <= 32) {
      const int bi = (lane - 1) & 15;
      const float f = 1e-4f + (float)bi * ((15.f - 1e-4f) / 15.f);
      z = lane <= 16 ? cosf(f * w) : -sinf(f * w);
    }
    float a = b1;
#pragma unroll 3
    for (int k = 0; k < 33; ++k) a += __shfl(z, k) * p.in[I_FW1][((size_t)i * 33 + k) * 64 + lane];
    const float h1 = sinf(fr * a);
    float c = b2;
#pragma unroll 8
    for (int k = 0; k < 64; ++k) c += __shfl(h1, k) * p.in[I_FW2][((size_t)i * 64 + k) * 64 + lane];
    H2[(size_t)row * 64 + lane] = sinf(fr * c);
  }
}

template <int LOGN>
__device__ void fft_dif(float2* buf) {
  constexpr int N = 1 << LOGN;
  const int tid = tidx();
  for (int h = N / 2; h >= 2; h >>= 2) {
    const int hh = h >> 1;
    for (int q = tid; q < N / 4; q += NT) {
      const int pos = q & (hh - 1), grp = q / hh;
      const int e0 = grp * 2 * h + pos;
      float2 x0 = buf[e0], x1 = buf[e0 + hh], x2 = buf[e0 + h], x3 = buf[e0 + h + hh];
      const float f1 = (float)pos / (float)(2 * h);
      const float c1 = __builtin_amdgcn_cosf(f1), s1 = -__builtin_amdgcn_sinf(f1);
      const float c2 = c1 * c1 - s1 * s1, s2 = 2.f * c1 * s1;
      float2 a0{x0.x + x2.x, x0.y + x2.y};
      float2 d2{x0.x - x2.x, x0.y - x2.y};
      float2 a2{d2.x * c1 - d2.y * s1, d2.x * s1 + d2.y * c1};
      float2 a1{x1.x + x3.x, x1.y + x3.y};
      float2 d3{x1.x - x3.x, x1.y - x3.y};
      float2 t3{d3.x * c1 - d3.y * s1, d3.x * s1 + d3.y * c1};
      float2 a3{t3.y, -t3.x};
      float2 y0{a0.x + a1.x, a0.y + a1.y};
      float2 e1{a0.x - a1.x, a0.y - a1.y};
      float2 y1{e1.x * c2 - e1.y * s2, e1.x * s2 + e1.y * c2};
      float2 y2{a2.x + a3.x, a2.y + a3.y};
      float2 e3{a2.x - a3.x, a2.y - a3.y};
      float2 y3{e3.x * c2 - e3.y * s2, e3.x * s2 + e3.y * c2};
      buf[e0] = y0; buf[e0 + hh] = y1; buf[e0 + h] = y2; buf[e0 + h + hh] = y3;
    }
    __syncthreads();
  }
}
template <int LOGN>
__device__ void fft_dit_inv(float2* buf) {
  constexpr int N = 1 << LOGN;
  const int tid = tidx();
  for (int h = 1; h < N; h <<= 2) {
    for (int q = tid; q < N / 4; q += NT) {
      const int pos = q & (h - 1), grp = q / h;
      const int e0 = grp * 4 * h + pos;
      float2 x0 = buf[e0], x1 = buf[e0 + h], x2 = buf[e0 + 2 * h], x3 = buf[e0 + 3 * h];
      const float f2 = (float)pos / (float)(4 * h);
      const float c2 = __builtin_amdgcn_cosf(f2), s2 = __builtin_amdgcn_sinf(f2);
      const float c1 = c2 * c2 - s2 * s2, s1 = 2.f * c2 * s2;
      float2 b1{x1.x * c1 - x1.y * s1, x1.x * s1 + x1.y * c1};
      float2 b3{x3.x * c1 - x3.y * s1, x3.x * s1 + x3.y * c1};
      float2 a0{x0.x + b1.x, x0.y + b1.y}, a1{x0.x - b1.x, x0.y - b1.y};
      float2 a2{x2.x + b3.x, x2.y + b3.y}, a3{x2.x - b3.x, x2.y - b3.y};
      float2 cc2{a2.x * c2 - a2.y * s2, a2.x * s2 + a2.y * c2};
      float2 t3{a3.x * c2 - a3.y * s2, a3.x * s2 + a3.y * c2};
      float2 cc3{-t3.y, t3.x};
      buf[e0] = float2{a0.x + cc2.x, a0.y + cc2.y};
      buf[e0 + 2 * h] = float2{a0.x - cc2.x, a0.y - cc2.y};
      buf[e0 + h] = float2{a1.x + cc3.x, a1.y + cc3.y};
      buf[e0 + 3 * h] = float2{a1.x - cc3.x, a1.y - cc3.y};
    }
    __syncthreads();
  }
}
template <int LOGN>
__device__ void spectrum_extract(const float2* buf, float2* __restrict__ G, float scale) {
  constexpr int Lc = 1 << LOGN;
  for (int k = tidx(); k <= Lc / 2; k += NT) {
    if (k == 0) {
      float2 c = buf[0];
      G[0] = float2{(c.x + c.y) * scale, 0.f};
      G[Lc] = float2{(c.x - c.y) * scale, 0.f};
    } else {
      const int k2 = Lc - k;
      const int p1 = __brev((unsigned)k) >> (32 - LOGN), p2 = __brev((unsigned)k2) >> (32 - LOGN);
      float2 C1 = buf[p1], C2 = buf[p2];
      float2 E{0.5f * (C1.x + C2.x), 0.5f * (C1.y - C2.y)}, D{0.5f * (C1.x - C2.x), 0.5f * (C1.y + C2.y)};
      float2 O{D.y, -D.x};
      const float f = (float)k / (float)(2 * Lc);
      const float wc = __builtin_amdgcn_cosf(f), wsn = -__builtin_amdgcn_sinf(f);
      float2 wO{wc * O.x - wsn * O.y, wc * O.y + wsn * O.x};
      G[k] = float2{(E.x + wO.x) * scale, (E.y + wO.y) * scale};
      G[k2] = float2{(E.x - wO.x) * scale, -(E.y - wO.y) * scale};
    }
  }
}
template <int LOGN>
__device__ void spectrum_mul(float2* buf, const float2* __restrict__ G) {
  constexpr int Lc = 1 << LOGN;
  for (int k = tidx(); k <= Lc / 2; k += NT) {
    if (k == 0) {
      float2 c = buf[0];
      const float Y0 = (c.x + c.y) * G[0].x, YL = (c.x - c.y) * G[Lc].x;
      buf[0] = float2{0.5f * (Y0 + YL), 0.5f * (Y0 - YL)};
    } else {
      const int k2 = Lc - k;
      const int p1 = __brev((unsigned)k) >> (32 - LOGN), p2 = __brev((unsigned)k2) >> (32 - LOGN);
      float2 C1 = buf[p1], C2 = buf[p2];
      float2 E{0.5f * (C1.x + C2.x), 0.5f * (C1.y - C2.y)}, D{0.5f * (C1.x - C2.x), 0.5f * (C1.y + C2.y)};
      float2 O{D.y, -D.x};
      const float f = (float)k / (float)(2 * Lc);
      const float wc = __builtin_amdgcn_cosf(f), wsn = -__builtin_amdgcn_sinf(f);
      float2 wO{wc * O.x - wsn * O.y, wc * O.y + wsn * O.x};
      float2 X1{E.x + wO.x, E.y + wO.y}, X2{E.x - wO.x, -(E.y - wO.y)};
      float2 g1 = G[k], g2 = G[k2];
      float2 Y1{X1.x * g1.x - X1.y * g1.y, X1.x * g1.y + X1.y * g1.x};
      float2 Y2{X2.x * g2.x - X2.y * g2.y, X2.x * g2.y + X2.y * g2.x};
      float2 Ye{0.5f * (Y1.x + Y2.x), 0.5f * (Y1.y - Y2.y)};
      float2 Dd{0.5f * (Y1.x - Y2.x), 0.5f * (Y1.y + Y2.y)};
      float2 Yo{wc * Dd.x + wsn * Dd.y, wc * Dd.y - wsn * Dd.x};
      float2 Z1{Ye.x - Yo.y, Ye.y + Yo.x};
      float2 Z2{Ye.x + Yo.y, -Ye.y + Yo.x};
      buf[p1] = Z1;
      buf[p2] = Z2;
    }
  }
}

template <int LOGN>
__device__ void hy_conv_item(const Params& p, int i, int c, unsigned char* lds) {
  constexpr int Lc = 1 << LOGN;
  constexpr int L = Lc;
  constexpr int NB = (LOGN == 14) ? 2 : 4;
  const int tid = tidx();
  float2* buf = (float2*)lds;
  float* bufF = (float*)lds;
  float* W3s = (float*)(lds + 131072);
  float* red = W3s + 128;
  float2* GS = (float2*)(p.ws + OFF_GS + (size_t)bidx() * 2 * GS_PER);
  float* Z1 = (float*)(p.ws + OFF_Z1 + (size_t)bidx() * 65536);
  const float* H2 = (const float*)(p.ws + OFF_H2) + (LOGN == 14 ? (size_t)4096 * 64 : 0);
  const ushort_t* PH = (const ushort_t*)(p.ws + OFF_PH);
  const float delta = 4.605170185988091f * (1.f / 1.5f + (1.f / 0.3f - 1.f / 1.5f) * (float)c / 1023.f);
  for (int o = 0; o < 2; ++o) {
    __syncthreads();
    if (tid < 128) {
      const int dirr = tid >> 6, j = tid & 63;
      W3s[tid] = p.in[I_FW3][((size_t)i * 64 + j) * 4096 + (dirr * 2 + o) * 1024 + c];
    }
    __syncthreads();
    float ss = 0.f;
    for (int t = tid; t < L; t += NT) {
      const float4* hr = (const float4*)(H2 + (size_t)t * 64);
      float d0 = 0.f, d1 = 0.f;
#pragma unroll
      for (int j4 = 0; j4 < 16; ++j4) {
        float4 hv = hr[j4];
        d0 += hv.x * W3s[4 * j4] + hv.y * W3s[4 * j4 + 1] + hv.z * W3s[4 * j4 + 2] + hv.w * W3s[4 * j4 + 3];
        d1 += hv.x * W3s[64 + 4 * j4] + hv.y * W3s[64 + 4 * j4 + 1] + hv.z * W3s[64 + 4 * j4 + 2] + hv.w * W3s[64 + 4 * j4 + 3];
      }
      const float dec = expf(-((float)t / (float)(L - 1)) * delta);
      d0 *= dec; d1 *= dec;
      ss += d0 * d0 + d1 * d1;
      bufF[t] = d0;
      if (t >= 1) bufF[2 * L - t] = d1; else bufF[L] = 0.f;
    }
    ss = wsum(ss);
    if ((tid & 63) == 0) red[tid >> 6] = ss;
    __syncthreads();
    float tot = 0.f;
#pragma unroll
    for (int w = 0; w < 8; ++w) tot += red[w];
    const float scale = rsqrtf(tot) / (float)Lc;
    fft_dif<LOGN>(buf);
    spectrum_extract<LOGN>(buf, GS + (size_t)o * (GS_PER / 8), scale);
  }
  __threadfence_block();
  __syncthreads();
  const float* sw = p.in[I_HSW] + (size_t)i * 3 * 3072;
  const float* sbias = p.in[I_HSB] + (size_t)i * 3072;
  float cw[3][3], cb[3];
#pragma unroll
  for (int st = 0; st < 3; ++st) {
#pragma unroll
    for (int k = 0; k < 3; ++k) cw[st][k] = sw[k * 3072 + st * 1024 + c];
    cb[st] = sbias[st * 1024 + c];
  }
  const float fb0 = p.in[I_FBIAS][((size_t)i * 2 + 0) * 1024 + c], fb1 = p.in[I_FBIAS][((size_t)i * 2 + 1) * 1024 + c];
  for (int b = 0; b < NB; ++b) {
    const int s0 = (LOGN == 14) ? (TPROMPT + b * 16384) : (b * 4096);
    const ushort_t* pv = PH + (size_t)s0 * 1024 + (size_t)c * L;
    const ushort_t* px1 = pv + (size_t)T * 1024;
    const ushort_t* px2 = px1 + (size_t)T * 1024;
    ushort_t* pg = (ushort_t*)px2 + (size_t)T * 1024;
    auto conv3 = [&](const ushort_t* s, int st, int t) -> float {
      const float a = t > 0 ? bf2f(s[t - 1]) : 0.f, m = bf2f(s[t]), n = t + 1 < L ? bf2f(s[t + 1]) : 0.f;
      return cw[st][0] * a + cw[st][1] * m + cw[st][2] * n + cb[st];
    };
    __syncthreads();
    for (int t = tid; t < L; t += NT) { bufF[t] = conv3(pv, 0, t); bufF[L + t] = 0.f; }
    __syncthreads();
    fft_dif<LOGN>(buf);
    spectrum_mul<LOGN>(buf, GS);
    __syncthreads();
    fft_dit_inv<LOGN>(buf);
    for (int t = tid; t < L; t += NT) {
      const float z0 = conv3(pv, 0, t);
      const float z1 = conv3(px1, 1, t) * (bufF[t] + z0 * fb0);
      bufF[t] = z1; Z1[t] = z1;
    }
    __syncthreads();
    for (int t = tid; t < L; t += NT) bufF[L + t] = 0.f;
    __syncthreads();
    fft_dif<LOGN>(buf);
    spectrum_mul<LOGN>(buf, GS + GS_PER / 8);
    __syncthreads();
    fft_dit_inv<LOGN>(buf);
    for (int t = tid; t < L; t += NT) {
      const float z2 = conv3(px2, 2, t) * (bufF[t] + Z1[t] * fb1);
      const float g = bf2f(pg[t]);
      pg[t] = f2bf(z2 * g * sigmoidf_(g));
    }
  }
}

__device__ void hy_conv_phase(const Params& p, int i, unsigned char* lds) {
  for (int it = bidx(); it < 2048; it += gridDim.x) {
    if (it < 1024) hy_conv_item<14>(p, i, it, lds);
    else hy_conv_item<12>(p, i, it - 1024, lds);
    __syncthreads();
  }
}

DEVI void run_phase(const Params& p, int ph, unsigned char* lds) {
  const int layer = ph < NPH_EVEN ? 0 : ph < NPH_EVEN + NPH_ODD ? 1 : ph < 2 * NPH_EVEN + NPH_ODD ? 2 : 3;
  const int base = layer == 0 ? 0 : layer == 1 ? NPH_EVEN : layer == 2 ? NPH_EVEN + NPH_ODD : 2 * NPH_EVEN + NPH_ODD;
  const int sp = ph - base, i = layer >> 1;
  unsigned char* ws = p.ws;
  ushort_t* WB = (ushort_t*)(ws + OFF_WB);
  if ((layer & 1) == 0) {
    ushort_t* WinT = WB; ushort_t* WoutT = WB + 3136 * 1024; ushort_t* GluT = WoutT + 1024 * 1024;
    switch (sp) {
      case 0:
        transpose_bf16(p.in[I_EWIN] + (size_t)i * 1024 * 3136, WinT, 1024, 3136, lds);
        transpose_bf16(p.in[I_EWOUT] + (size_t)i * 1024 * 1024, WoutT, 1024, 1024, lds);
        transpose_bf16(p.in[I_GLUW] + (size_t)i * 512 * 512, GluT, 512, 512, lds);
        break;
      case 1: gemm_phase<0, 0>(p, layer, lds, nullptr, WinT, 3136, 1024, ws + OFF_PS5, ws + OFF_PRW, nullptr, nullptr, nullptr); break;
      case 2: s5_passA(p, i, lds); break;
      case 3: s5_passC(p, i, lds); break;
      case 4: gemm_phase<2, 2>(p, layer, lds, ws + OFF_YS, GluT, 512, 512, ws + OFF_Y, nullptr, ws + OFF_YS, ws + OFF_PS5, p.in[I_GLUB] + i * 512); break;
      case 5: rwkv_scan1(p, i, lds); break;
      case 6: rwkv_carry(p, lds); break;
      case 7: rwkv_scan3(p, i, lds); break;
      case 8: rwkv_post(p, i); break;
      case 9: gemm_phase<1, 3>(p, layer, lds, ws + OFF_Y, WoutT, 1024, 1024, ws + OFF_PRW, nullptr, nullptr, nullptr, nullptr); break;
      case 10: ln_phase(p, layer, (const float*)(ws + OFF_PRW)); break;
    }
  } else {
    ushort_t* HinT = WB; ushort_t* HoutT = WB + 4096 * 1024;
    switch (sp) {
      case 0:
        transpose_bf16(p.in[I_HWIN] + (size_t)i * 1024 * 4096, HinT, 1024, 4096, lds);
        transpose_bf16(p.in[I_HWOUT] + (size_t)i * 1024 * 1024, HoutT, 1024, 1024, lds);
        hy_filter_mlp(p, i);
        break;
      case 1: gemm_phase<0, 1>(p, layer, lds, nullptr, HinT, 4096, 1024, ws + OFF_PH, nullptr, nullptr, nullptr, nullptr); break;
      case 2: hy_conv_phase(p, i, lds); break;
      case 3: gemm_phase<3, 3>(p, layer, lds, ws + OFF_PH + 3 * SZ1, HoutT, 1024, 1024, ws + OFF_PH, nullptr, nullptr, nullptr, nullptr); break;
      case 4: ln_phase(p, layer, (const float*)(ws + OFF_PH)); break;
    }
  }
}

#if ONE_LAUNCH
__global__ void __launch_bounds__(NT) fwd_kernel(Params p) {
  extern __shared__ __attribute__((aligned(16))) unsigned char lds[];
#if ONE_LAUNCH
  cg::grid_group grid = cg::this_grid();
#endif
  for (int ph = p.ph_lo; ph < p.ph_hi; ++ph) {
    run_phase(p, ph, lds);
#if ONE_LAUNCH
    if (ph + 1 < p.ph_hi) grid.sync();
#endif
  }
}
#endif

#if !ONE_LAUNCH
template <int PH> __global__ void __launch_bounds__(NT) phase_kernel(Params p) {
  extern __shared__ __attribute__((aligned(16))) unsigned char lds[];
  run_phase(p, PH, lds);
}
typedef void (*kfn_t)(Params);
#define PK(n) phase_kernel<n>
static kfn_t k_tab[NPHASES] = {PK(0), PK(1), PK(2), PK(3), PK(4), PK(5), PK(6), PK(7), PK(8), PK(9), PK(10), PK(11), PK(12), PK(13), PK(14), PK(15),
                               PK(16), PK(17), PK(18), PK(19), PK(20), PK(21), PK(22), PK(23), PK(24), PK(25), PK(26), PK(27), PK(28), PK(29), PK(30), PK(31)};
#endif

extern "C" void kernel_launch(void* const* d_in, const int* in_sizes, int n_in, void* d_out, int out_size, void* d_ws, size_t ws_size,
                              hipStream_t stream) {
  static int grid_blocks = 0;
  if (!grid_blocks) {
    if (n_in != 38 || ws_size < WS_NEED || out_size != T * 1024) {
      fprintf(stderr, "kernel_launch: unexpected shapes n_in=%d ws=%zu out=%d\n", n_in, ws_size, out_size);
      grid_blocks = -1; return;
    }
    int dev = 0, cus = 0, per_cu = 0;
    (void)hipGetDevice(&dev);
    (void)hipDeviceGetAttribute(&cus, hipDeviceAttributeMultiprocessorCount, dev);
#if ONE_LAUNCH
    if (hipFuncSetAttribute((const void*)fwd_kernel, hipFuncAttributeMaxDynamicSharedMemorySize, LDS_BYTES) != hipSuccess) {
      fprintf(stderr, "kernel_launch: hipFuncSetAttribute failed\n"); grid_blocks = -1; return;
    }
    (void)hipOccupancyMaxActiveBlocksPerMultiprocessor(&per_cu, (const void*)fwd_kernel, NT, LDS_BYTES);
#else
    for (int ph = 0; ph < NPHASES; ++ph)
      if (hipFuncSetAttribute((const void*)k_tab[ph], hipFuncAttributeMaxDynamicSharedMemorySize, LDS_BYTES) != hipSuccess) {
        fprintf(stderr, "kernel_launch: hipFuncSetAttribute failed\n"); grid_blocks = -1; return;
      }
    per_cu = 1;
#endif
    if (per_cu < 1) { fprintf(stderr, "kernel_launch: occupancy query returned %d\n", per_cu); per_cu = 1; }
    grid_blocks = cus * per_cu;
    if (grid_blocks > 256) grid_blocks = 256;
    if (grid_blocks < 1) grid_blocks = 256;
  }
  if (grid_blocks < 0) return;
  Params p{};
  for (int k = 0; k < 38; ++k) p.in[k] = (const float*)d_in[k];
  p.out = (float*)d_out; p.ws = (unsigned char*)d_ws;
#if ONE_LAUNCH
  p.ph_lo = 0; p.ph_hi = NPHASES;
  void* args[] = {&p};
  hipError_t e = hipLaunchCooperativeKernel((const void*)fwd_kernel, dim3(grid_blocks), dim3(NT), args, LDS_BYTES, stream);
  if (e != hipSuccess) fprintf(stderr, "cooperative launch failed: %s (grid %d)\n", hipGetErrorString(e), grid_blocks);
#else
  for (int ph = 0; ph < NPHASES; ++ph) {
    p.ph_lo = ph; p.ph_hi = ph + 1;
    hipLaunchKernelGGL(k_tab[ph], dim3(grid_blocks), dim3(NT), LDS_BYTES, stream, p);
  }
#endif
}
```

```cpp
#include <hip/hip_runtime.h>
#include <hip/hip_cooperative_groups.h>
#include <cstdio>
#include <cstdint>
namespace cg = cooperative_groups;

#ifndef ONE_LAUNCH
#define ONE_LAUNCH 1
#endif

#define DEVI __device__ __forceinline__
constexpr int NT = 512;
constexpr int T = 49152;
constexpr int TPROMPT = 16384;
constexpr int LDS_BYTES = 133120;
constexpr int NPH_EVEN = 11, NPH_ODD = 5;
constexpr int NPHASES = 2 * (NPH_EVEN + NPH_ODD);

typedef __attribute__((ext_vector_type(8))) short bf16x8;
typedef __attribute__((ext_vector_type(4))) float f32x4;
typedef unsigned short ushort_t;

struct Params { const float* in[38]; float* out; unsigned char* ws; int ph_lo; int ph_hi; };

enum { I_XP = 0, I_XS, I_EWIN, I_EWOUT, I_LRE, I_LIM, I_LSTEP, I_BRE, I_BIM, I_CRE, I_CIM, I_S5D, I_GLUW, I_GLUB,
       I_MURKV, I_MULORA, I_W0, I_WUP, I_A0, I_AUP, I_KK, I_KA, I_RK, I_LNXW, I_LNXB,
       I_HWIN, I_HWOUT, I_HSW, I_HSB, I_FW1, I_FB1, I_FFREQ, I_FW2, I_FB2, I_FW3, I_FBIAS, I_LNG, I_LNB };

constexpr size_t SZ1 = (size_t)T * 1024 * 2;
constexpr size_t OFF_PS5 = 0;
constexpr size_t OFF_PRW = OFF_PS5 + SZ1;
constexpr size_t OFF_Y = OFF_PRW + (size_t)T * 2112 * 2;
constexpr size_t OFF_YS = OFF_Y + SZ1;
constexpr size_t OFF_WB = OFF_YS + SZ1;
constexpr size_t OFF_CAR = OFF_WB + 10485760;
constexpr size_t WS_NEED = OFF_CAR + 6291456;
constexpr size_t OFF_PH = 0;
constexpr size_t OFF_GS = 4 * SZ1;
constexpr size_t GS_PER = 131328;
constexpr size_t OFF_Z1 = OFF_GS + 256 * 2 * GS_PER;
constexpr size_t OFF_H2 = OFF_Z1 + 256 * 65536;

DEVI int tidx() { int t = threadIdx.x; asm volatile("" : "+v"(t)); return t; }
DEVI int bidx() { int b = blockIdx.x; asm volatile("" : "+s"(b)); return b; }
DEVI ushort_t f2bf(float f) { unsigned u = __float_as_uint(f); u += 0x7fffu + ((u >> 16) & 1u); return (ushort_t)(u >> 16); }
DEVI float bf2f(ushort_t h) { return __uint_as_float(((unsigned)h) << 16); }
DEVI unsigned pack2(float a, float b) { return (unsigned)f2bf(a) | ((unsigned)f2bf(b) << 16); }
DEVI float wsum(float v) {
#pragma unroll
  for (int m = 32; m >= 1; m >>= 1) v += __shfl_xor(v, m);
  return v;
}
DEVI void wave_sync() { __builtin_amdgcn_fence(__ATOMIC_RELEASE, "wavefront"); __builtin_amdgcn_wave_barrier(); __builtin_amdgcn_fence(__ATOMIC_ACQUIRE, "wavefront"); }
DEVI void seq_of(int tok, int& s0, int& L) {
  if (tok < TPROMPT) { s0 = tok & ~4095; L = 4096; } else { s0 = TPROMPT + ((tok - TPROMPT) & ~16383); L = 16384; }
}
struct XSrc { const float* xp; const float* xs; const float* xo; };
DEVI XSrc xsrc(const Params& p) {
  XSrc x; x.xp = p.in[I_XP]; x.xs = p.in[I_XS]; x.xo = p.out;
  asm volatile("" : "+s"(x.xp), "+s"(x.xs), "+s"(x.xo));
  return x;
}
DEVI const float* xrow(const XSrc& x, int layer, int tok) {
  if (layer == 0) return tok < TPROMPT ? x.xp + (size_t)tok * 1024 : x.xs + (size_t)(tok - TPROMPT) * 1024;
  return x.xo + (size_t)tok * 1024;
}
DEVI float sigmoidf_(float x) { return 1.f / (1.f + expf(-x)); }
DEVI float gelu_tanh(float x) { return 0.5f * x * (1.f + tanhf(0.7978845608f * (x + 0.044715f * x * x * x))); }

__device__ void transpose_bf16(const float* __restrict__ in, ushort_t* __restrict__ out, int K, int N, unsigned char* lds) {
  float* tile = (float*)lds;
  const int tid = tidx(), j = tid & 63, i0 = tid >> 6;
  const int tk = K / 64, tn = N / 64;
  for (int t = bidx(); t < tk * tn; t += gridDim.x) {
    const int k0 = (t / tn) * 64, n0 = (t % tn) * 64;
#pragma unroll
    for (int e = 0; e < 8; ++e) { int i = i0 + 8 * e; tile[i * 65 + j] = in[(size_t)(k0 + i) * N + n0 + j]; }
    __syncthreads();
#pragma unroll
    for (int e = 0; e < 8; ++e) { int i = i0 + 8 * e; out[(size_t)(n0 + i) * K + k0 + j] = f2bf(tile[j * 65 + i]); }
    __syncthreads();
  }
}

template <int AMODE, int EPI>
__device__ void gemm_phase(const Params& p, int layer, unsigned char* lds, const void* Aptr, const ushort_t* __restrict__ Bt,
                           int N, int K, void* O0, void* O1, const void* E0, const void* E1, const float* bias) {
  ushort_t* sA = (ushort_t*)lds;
  ushort_t* sB = sA + 2 * 128 * 72;
  const int tid = tidx(), lane = tid & 63, wave = tid >> 6, wm = wave >> 2, wn = wave & 3;
  const int NTl = (N + 127) / 128, MT = T / 128;
  const int lr = tid >> 2, lk = (tid & 3) * 16;
  const int nk = K / 64;
  const XSrc xs_ = xsrc(p);
  for (int tile = bidx(); tile < MT * NTl; tile += gridDim.x) {
    const int mt = tile / NTl, nt = tile % NTl, m0 = mt * 128, n0 = nt * 128;
    f32x4 acc[4][2];
#pragma unroll
    for (int i = 0; i < 4; ++i)
#pragma unroll
      for (int j = 0; j < 2; ++j) acc[i][j] = f32x4{0.f, 0.f, 0.f, 0.f};
    uint4 ra0, ra1, rb0, rb1;
    int s0 = 0, L = 0;
    if (AMODE == 3) seq_of(m0, s0, L);
#define LOAD_AB(k0_)                                                                                                     \
    {                                                                                                                    \
      const int k0 = (k0_);                                                                                              \
      if (AMODE == 0 || AMODE == 2) {                                                                                    \
        const float* src = (AMODE == 0) ? (xrow(xs_, layer, m0 + lr) + k0 + lk) : ((const float*)Aptr + (size_t)(m0 + lr) * K + k0 + lk); \
        float4 f0 = ((const float4*)src)[0], f1 = ((const float4*)src)[1], f2 = ((const float4*)src)[2], f3 = ((const float4*)src)[3]; \
        if (AMODE == 2) {                                                                                                \
          f0.x = gelu_tanh(f0.x); f0.y = gelu_tanh(f0.y); f0.z = gelu_tanh(f0.z); f0.w = gelu_tanh(f0.w);                \
          f1.x = gelu_tanh(f1.x); f1.y = gelu_tanh(f1.y); f1.z = gelu_tanh(f1.z); f1.w = gelu_tanh(f1.w);                \
          f2.x = gelu_tanh(f2.x); f2.y = gelu_tanh(f2.y); f2.z = gelu_tanh(f2.z); f2.w = gelu_tanh(f2.w);                \
          f3.x = gelu_tanh(f3.x); f3.y = gelu_tanh(f3.y); f3.z = gelu_tanh(f3.z); f3.w = gelu_tanh(f3.w);                \
        }                                                                                                                \
        ra0 = uint4{pack2(f0.x, f0.y), pack2(f0.z, f0.w), pack2(f1.x, f1.y), pack2(f1.z, f1.w)};                         \
        ra1 = uint4{pack2(f2.x, f2.y), pack2(f2.z, f2.w), pack2(f3.x, f3.y), pack2(f3.z, f3.w)};                         \
      } else if (AMODE == 1) {                                                                                           \
        const uint4* src = (const uint4*)((const ushort_t*)Aptr + (size_t)(m0 + lr) * K + k0 + lk);                      \
        ra0 = src[0]; ra1 = src[1];                                                                                      \
      } else {                                                                                                           \
        const int kk = tid >> 3, ms = (tid & 7) * 16;                                                                    \
        const uint4* src = (const uint4*)((const ushort_t*)Aptr + (size_t)s0 * 1024 + (size_t)(k0 + kk) * L + (m0 - s0) + ms); \
        ra0 = src[0]; ra1 = src[1];                                                                                      \
      }                                                                                                                  \
      const int nn = n0 + lr;                                                                                            \
      if (nn < N) { const uint4* src = (const uint4*)(Bt + (size_t)nn * K + k0 + lk); rb0 = src[0]; rb1 = src[1]; }      \
      else { rb0 = uint4{0, 0, 0, 0}; rb1 = rb0; }                                                                       \
    }
#define STORE_LDS(b_)                                                                                                    \
    {                                                                                                                    \
      const int bb = (b_);                                                                                               \
      if (AMODE == 3) {                                                                                                  \
        const int kk = tid >> 3, ms = (tid & 7) * 16;                                                                    \
        ushort_t* d = sA + (size_t)(bb * 128 + ms) * 72 + kk;                                                            \
        d[0 * 72] = (ushort_t)(ra0.x & 0xffff); d[1 * 72] = (ushort_t)(ra0.x >> 16);                                     \
        d[2 * 72] = (ushort_t)(ra0.y & 0xffff); d[3 * 72] = (ushort_t)(ra0.y >> 16);                                     \
        d[4 * 72] = (ushort_t)(ra0.z & 0xffff); d[5 * 72] = (ushort_t)(ra0.z >> 16);                                     \
        d[6 * 72] = (ushort_t)(ra0.w & 0xffff); d[7 * 72] = (ushort_t)(ra0.w >> 16);                                     \
        d[8 * 72] = (ushort_t)(ra1.x & 0xffff); d[9 * 72] = (ushort_t)(ra1.x >> 16);                                     \
        d[10 * 72] = (ushort_t)(ra1.y & 0xffff); d[11 * 72] = (ushort_t)(ra1.y >> 16);                                   \
        d[12 * 72] = (ushort_t)(ra1.z & 0xffff); d[13 * 72] = (ushort_t)(ra1.z >> 16);                                   \
        d[14 * 72] = (ushort_t)(ra1.w & 0xffff); d[15 * 72] = (ushort_t)(ra1.w >> 16);                                   \
      } else {                                                                                                           \
        uint4* d = (uint4*)(sA + (size_t)(bb * 128 + lr) * 72 + lk);                                                     \
        d[0] = ra0; d[1] = ra1;                                                                                          \
      }                                                                                                                  \
      uint4* d2 = (uint4*)(sB + (size_t)(bb * 128 + lr) * 72 + lk);                                                      \
      d2[0] = rb0; d2[1] = rb1;                                                                                          \
    }
    LOAD_AB(0);
    STORE_LDS(0);
    __syncthreads();
    for (int kt = 0; kt < nk; ++kt) {
      const int b = kt & 1;
      if (kt + 1 < nk) LOAD_AB((kt + 1) * 64);
#pragma unroll
      for (int ks = 0; ks < 2; ++ks) {
        bf16x8 af[4], bfr[2];
#pragma unroll
        for (int i = 0; i < 4; ++i)
          af[i] = *(const bf16x8*)(sA + (size_t)(b * 128 + wm * 64 + i * 16 + (lane & 15)) * 72 + ks * 32 + (lane >> 4) * 8);
#pragma unroll
        for (int j = 0; j < 2; ++j)
          bfr[j] = *(const bf16x8*)(sB + (size_t)(b * 128 + wn * 32 + j * 16 + (lane & 15)) * 72 + ks * 32 + (lane >> 4) * 8);
#pragma unroll
        for (int i = 0; i < 4; ++i)
#pragma unroll
          for (int j = 0; j < 2; ++j) acc[i][j] = __builtin_amdgcn_mfma_f32_16x16x32_bf16(af[i], bfr[j], acc[i][j], 0, 0, 0);
      }
      if (kt + 1 < nk) STORE_LDS(b ^ 1);
      __syncthreads();
    }
#pragma unroll
    for (int i = 0; i < 4; ++i)
#pragma unroll
      for (int j = 0; j < 2; ++j) {
        const int mb = m0 + wm * 64 + i * 16 + (lane >> 4) * 4;
        const int n = n0 + wn * 32 + j * 16 + (lane & 15);
        if (n >= N) continue;
        if (EPI == 0) {
#pragma unroll
          for (int r = 0; r < 4; ++r) {
            const int m = mb + r;
            if (n < 1024) ((ushort_t*)O0)[(size_t)m * 1024 + n] = f2bf(acc[i][j][r]);
            else ((ushort_t*)O1)[(size_t)m * 2112 + (n - 1024)] = f2bf(acc[i][j][r]);
          }
        } else if (EPI == 1) {
          int s0e, Le; seq_of(mb, s0e, Le);
          const int st = n >> 10, c = n & 1023;
          ushort_t* dst = (ushort_t*)O0 + (size_t)st * T * 1024 + (size_t)s0e * 1024 + (size_t)c * Le + (mb - s0e);
          *(uint2*)dst = uint2{pack2(acc[i][j][0], acc[i][j][1]), pack2(acc[i][j][2], acc[i][j][3])};
        } else if (EPI == 2) {
#pragma unroll
          for (int r = 0; r < 4; ++r) {
            const int m = mb + r;
            const float a = gelu_tanh(((const float*)E0)[(size_t)m * 512 + n]);
            const float g = bf2f(((const ushort_t*)E1)[(size_t)m * 1024 + 512 + n]);
            const float v = a * sigmoidf_(acc[i][j][r] + bias[n]) * (g * sigmoidf_(g));
            ((ushort_t*)O0)[(size_t)m * 1024 + n] = f2bf(v);
          }
        } else {
#pragma unroll
          for (int r = 0; r < 4; ++r) ((float*)O0)[(size_t)(mb + r) * 1024 + n] = acc[i][j][r];
        }
      }
  }
}

__device__ void ln_phase(const Params& p, int layer, const float* __restrict__ F) {
  const int lane = tidx() & 63, gw = bidx() * (NT / 64) + (tidx() >> 6), nw = gridDim.x * (NT / 64);
  const float alpha = 1.681792830507429f;
  const float4* g4 = (const float4*)(p.in[I_LNG] + layer * 1024);
  const float4* b4 = (const float4*)(p.in[I_LNB] + layer * 1024);
  const XSrc xs_ = xsrc(p);
  for (int row = gw; row < T; row += nw) {
    const float4* x4 = (const float4*)xrow(xs_, layer, row);
    const float4* f4 = (const float4*)(F + (size_t)row * 1024);
    float4 v[4];
    float s = 0.f;
#pragma unroll
    for (int e = 0; e < 4; ++e) {
      float4 a = x4[lane + 64 * e], f = f4[lane + 64 * e];
      v[e] = float4{alpha * a.x + f.x, alpha * a.y + f.y, alpha * a.z + f.z, alpha * a.w + f.w};
      s += v[e].x + v[e].y + v[e].z + v[e].w;
    }
    const float mean = wsum(s) * (1.f / 1024.f);
    float q = 0.f;
#pragma unroll
    for (int e = 0; e < 4; ++e) {
      v[e].x -= mean; v[e].y -= mean; v[e].z -= mean; v[e].w -= mean;
      q += v[e].x * v[e].x + v[e].y * v[e].y + v[e].z * v[e].z + v[e].w * v[e].w;
    }
    const float rs = rsqrtf(wsum(q) * (1.f / 1024.f) + 1e-5f);
    float4* o4 = (float4*)(p.out + (size_t)row * 1024);
#pragma unroll
    for (int e = 0; e < 4; ++e) {
      float4 g = g4[lane + 64 * e], b = b4[lane + 64 * e];
      o4[lane + 64 * e] = float4{v[e].x * rs * g.x + b.x, v[e].y * rs * g.y + b.y, v[e].z * rs * g.z + b.z, v[e].w * rs * g.w + b.w};
    }
  }
}

struct cplx { float x, y; };
DEVI cplx cmul(cplx a, cplx b) { return cplx{a.x * b.x - a.y * b.y, a.x * b.y + a.y * b.x}; }
DEVI void s5_consts(const Params& p, int i, int d, int g, int n, cplx& lb, cplx& coef) {
  const int idx = ((i * 2 + d) * 32 + g) * 64 + n;
  const float lre = p.in[I_LRE][idx], lim = p.in[I_LIM][idx];
  const float dt = expf(p.in[I_LSTEP][(i * 2 + d) * 32 + g]);
  const float mag = expf(lre * dt);
  float sn, cs; sincosf(lim * dt, &sn, &cs);
  lb = cplx{mag * cs, mag * sn};
  const float nr = lb.x - 1.f, ni = lb.y, den = 1.f / (lre * lre + lim * lim);
  coef = cplx{(nr * lre + ni * lim) * den, (ni * lre - nr * lim) * den};
}
DEVI void s5_stage_u(const ushort_t* PS5, int tok0, int g, float* U, int lane) {
  const uint4* src = (const uint4*)(PS5 + (size_t)(tok0 + lane) * 1024 + g * 16);
  uint4 a = src[0], b = src[1];
  float4* d = (float4*)(U + lane * 16);
  d[0] = float4{__uint_as_float(a.x << 16), __uint_as_float(a.x & 0xffff0000u), __uint_as_float(a.y << 16), __uint_as_float(a.y & 0xffff0000u)};
  d[1] = float4{__uint_as_float(a.z << 16), __uint_as_float(a.z & 0xffff0000u), __uint_as_float(a.w << 16), __uint_as_float(a.w & 0xffff0000u)};
  d[2] = float4{__uint_as_float(b.x << 16), __uint_as_float(b.x & 0xffff0000u), __uint_as_float(b.y << 16), __uint_as_float(b.y & 0xffff0000u)};
  d[3] = float4{__uint_as_float(b.z << 16), __uint_as_float(b.z & 0xffff0000u), __uint_as_float(b.w << 16), __uint_as_float(b.w & 0xffff0000u)};
}
#define S5_BU(Urow, bur, bui)                                                         \
  {                                                                                   \
    const float4* u4 = (const float4*)(Urow);                                         \
    bur = 0.f; bui = 0.f;                                                             \
    _Pragma("unroll") for (int pp = 0; pp < 4; ++pp) {                                \
      float4 u = u4[pp];                                                              \
      bur += Br[4 * pp] * u.x + Br[4 * pp + 1] * u.y + Br[4 * pp + 2] * u.z + Br[4 * pp + 3] * u.w; \
      bui += Bi[4 * pp] * u.x + Bi[4 * pp + 1] * u.y + Bi[4 * pp + 2] * u.z + Bi[4 * pp + 3] * u.w; \
    }                                                                                 \
  }

__device__ void s5_passA(const Params& p, int i, unsigned char* lds) {
  const ushort_t* PS5 = (const ushort_t*)(p.ws + OFF_PS5);
  cplx* CAR = (cplx*)(p.ws + OFF_CAR);
  const int lane = tidx() & 63, wave = tidx() >> 6;
  float* U = (float*)(lds + wave * 8448);
  for (int item = bidx() * 8 + wave; item < 192 * 32; item += gridDim.x * 8) {
    const int q = item >> 5, g = item & 31;
    cplx lb0, c0, lb1, c1;
    s5_consts(p, i, 0, g, lane, lb0, c0);
    s5_consts(p, i, 1, g, lane, lb1, c1);
    float Br[16], Bi[16];
#pragma unroll
    for (int pp = 0; pp < 16; ++pp) { Br[pp] = p.in[I_BRE][((i * 32 + g) * 64 + lane) * 16 + pp]; Bi[pp] = p.in[I_BIM][((i * 32 + g) * 64 + lane) * 16 + pp]; }
    cplx xf{0.f, 0.f}, xb{0.f, 0.f}, pw{1.f, 0.f};
    for (int sb = 0; sb < 4; ++sb) {
      wave_sync();
      s5_stage_u(PS5, q * 256 + sb * 64, g, U, lane);
      wave_sync();
      for (int t = 0; t < 64; ++t) {
        float bur, bui;
        S5_BU(U + t * 16, bur, bui);
        xf = cmul(lb0, xf); xf.x += bur; xf.y += bui;
        xb.x += pw.x * bur - pw.y * bui; xb.y += pw.x * bui + pw.y * bur;
        pw = cmul(pw, lb1);
      }
    }
    CAR[((size_t)(q * 32 + g) * 2 + 0) * 64 + lane] = cmul(xf, c0);
    CAR[((size_t)(q * 32 + g) * 2 + 1) * 64 + lane] = cmul(xb, c1);
  }
}

__device__ void s5_passC(const Params& p, int i, unsigned char* lds) {
  const ushort_t* PS5 = (const ushort_t*)(p.ws + OFF_PS5);
  const cplx* CAR = (const cplx*)(p.ws + OFF_CAR);
  float* YS = (float*)(p.ws + OFF_YS);
  const int lane = tidx() & 63, wave = tidx() >> 6;
  float* U = (float*)(lds + wave * 8448);
  ushort_t* X = (ushort_t*)(lds + wave * 8448 + 4096);
  for (int item = bidx() * 8 + wave; item < 192 * 32; item += gridDim.x * 8) {
    const int q = item >> 5, g = item & 31;
    int cs, ce;
    if (q < 64) { cs = q & ~15; ce = cs + 16; } else { cs = 64 + ((q - 64) & ~63); ce = cs + 64; }
    float Br[16], Bi[16];
#pragma unroll
    for (int pp = 0; pp < 16; ++pp) { Br[pp] = p.in[I_BRE][((i * 32 + g) * 64 + lane) * 16 + pp]; Bi[pp] = p.in[I_BIM][((i * 32 + g) * 64 + lane) * 16 + pp]; }
    const int pcol = lane & 15;
    const float dd = p.in[I_S5D][i * 512 + g * 16 + pcol];
    for (int d = 0; d < 2; ++d) {
      cplx lb, coef;
      s5_consts(p, i, d, g, lane, lb, coef);
      cplx lp = lb;
#pragma unroll
      for (int e = 0; e < 8; ++e) lp = cmul(lp, lp);
      cplx xs{0.f, 0.f};
      if (d == 0) { for (int j = cs; j < q; ++j) { xs = cmul(lp, xs); cplx c = CAR[((size_t)(j * 32 + g) * 2 + 0) * 64 + lane]; xs.x += c.x; xs.y += c.y; } }
      else { for (int j = ce - 1; j > q; --j) { xs = cmul(lp, xs); cplx c = CAR[((size_t)(j * 32 + g) * 2 + 1) * 64 + lane]; xs.x += c.x; xs.y += c.y; } }
      bf16x8 cf[4];
#pragma unroll
      for (int kk = 0; kk < 4; ++kk) {
        const int n0 = (kk & 1) * 32 + (lane >> 4) * 8;
        const float* src = (kk < 2 ? p.in[I_CRE] : p.in[I_CIM]) + (((size_t)(i * 2 + d) * 32 + g) * 16 + pcol) * 64 + n0;
        const float sg = kk < 2 ? 1.f : -1.f;
#pragma unroll
        for (int j = 0; j < 8; ++j) cf[kk][j] = (short)f2bf(sg * src[j]);
      }
      for (int sbi = 0; sbi < 4; ++sbi) {
        const int sb = d ? 3 - sbi : sbi;
        wave_sync();
        s5_stage_u(PS5, q * 256 + sb * 64, g, U, lane);
        wave_sync();
        for (int tbi = 0; tbi < 4; ++tbi) {
          const int tb = d ? 3 - tbi : tbi;
          for (int tti = 0; tti < 16; ++tti) {
            const int tt = d ? 15 - tti : tti;
            float bur, bui;
            S5_BU(U + (tb * 16 + tt) * 16, bur, bui);
            xs = cmul(lb, xs);
            xs.x += coef.x * bur - coef.y * bui;
            xs.y += coef.x * bui + coef.y * bur;
            X[tt * 136 + lane] = f2bf(xs.x);
            X[tt * 136 + 64 + lane] = f2bf(xs.y);
          }
          wave_sync();
          f32x4 acc{0.f, 0.f, 0.f, 0.f};
#pragma unroll
          for (int kk = 0; kk < 4; ++kk) {
            bf16x8 a = *(const bf16x8*)(X + (lane & 15) * 136 + kk * 32 + (lane >> 4) * 8);
            acc = __builtin_amdgcn_mfma_f32_16x16x32_bf16(a, cf[kk], acc, 0, 0, 0);
          }
          wave_sync();
#pragma unroll
          for (int r = 0; r < 4; ++r) {
            const int tl = tb * 16 + (lane >> 4) * 4 + r;
            const size_t o = (size_t)(q * 256 + sb * 64 + tl) * 512 + g * 16 + pcol;
            if (d == 0) YS[o] = acc[r] + dd * U[tl * 16 + pcol];
            else YS[o] += acc[r];
          }
        }
      }
    }
  }
}

struct RwConst { float mur, muk, muv, mul, w0, a0, kk, ka; };
DEVI void rw_prologue(const ushort_t* PRW, int tok, int h, int lane, const RwConst& c, const float* WU, const float* AU,
                      float* LT, float* Wd, float* KKd, float* BBd, float* KDd, float* RRd, float* VVd) {
  int s0, L; seq_of(tok, s0, L);
  const ushort_t* row = PRW + (size_t)tok * 2112;
  const bool hm = tok > s0, hp = tok + 1 < s0 + L;
  const int cc = h * 64 + lane;
  float r0 = bf2f(row[cc]), k0 = bf2f(row[512 + cc]), v0 = bf2f(row[1024 + cc]), l0 = bf2f(row[2048 + lane]);
  float rn = 0.f, kn = 0.f, vn = 0.f, ln = 0.f;
  if (hm) { const ushort_t* r2 = row - 2112; rn += bf2f(r2[cc]); kn += bf2f(r2[512 + cc]); vn += bf2f(r2[1024 + cc]); ln += bf2f(r2[2048 + lane]); }
  if (hp) { const ushort_t* r2 = row + 2112; rn += bf2f(r2[cc]); kn += bf2f(r2[512 + cc]); vn += bf2f(r2[1024 + cc]); ln += bf2f(r2[2048 + lane]); }
  const float rr = r0 + c.mur * (0.5f * rn - r0);
  const float kx = k0 + c.muk * (0.5f * kn - k0);
  const float vv = v0 + c.muv * (0.5f * vn - v0);
  float ll = l0 + c.mul * (0.5f * ln - l0);
  if (lane < 32) ll = tanhf(ll);
  wave_sync();
  LT[lane] = ll;
  wave_sync();
  float accw = c.w0, acca = c.a0;
#pragma unroll 1
  for (int j = 0; j < 32; j += 4) {
    float4 lw = *(const float4*)(LT + j), la = *(const float4*)(LT + 32 + j);
    accw += lw.x * WU[(j + 0) * 64 + lane] + lw.y * WU[(j + 1) * 64 + lane] + lw.z * WU[(j + 2) * 64 + lane] + lw.w * WU[(j + 3) * 64 + lane];
    acca += la.x * AU[(j + 0) * 64 + lane] + la.y * AU[(j + 1) * 64 + lane] + la.z * AU[(j + 2) * 64 + lane] + la.w * AU[(j + 3) * 64 + lane];
  }
  const float dec = expf(-0.6065306597126334f * sigmoidf_(accw));
  const float a = sigmoidf_(acca);
  const float kkr = kx * c.kk;
  const float ss = wsum(kkr * kkr);
  const float kkn = kkr / fmaxf(sqrtf(ss), 1e-12f);
  Wd[lane] = dec; KKd[lane] = kkn; BBd[lane] = kkn * a; KDd[lane] = kx * (1.f + (a - 1.f) * c.ka); RRd[lane] = rr; VVd[lane] = vv;
}

__device__ void rwkv_scan1(const Params& p, int i, unsigned char* lds) {
  const ushort_t* PRW = (const ushort_t*)(p.ws + OFF_PRW);
  float* CH = (float*)(p.ws + OFF_PS5);
  float* YR = (float*)(p.ws + OFF_YS);
  const int tid = tidx(), lane = tid & 63, wave = tid >> 6, pair = wave >> 1, role = wave & 1;
  float* TAB = (float*)lds;
  float* WV = (float*)(lds + 24576 + pair * 12800);
  float* Wd = WV, *KKd = WV + 512, *BBd = WV + 1024, *KDd = WV + 1536, *RRd = WV + 2048, *VVd = WV + 2560, *LT = WV + 3072 + role * 64;
  {
    float4* z = (float4*)YR;
    for (size_t e = (size_t)bidx() * NT + tid; e < (size_t)T * 512 / 4; e += (size_t)gridDim.x * NT) z[e] = float4{0.f, 0.f, 0.f, 0.f};
  }
  for (int bi = bidx(); bi < 768; bi += gridDim.x) {
    const int h = bi / 96, rem = bi % 96;
    const int dir = pair >> 1, q = rem * 2 + (pair & 1);
    __syncthreads();
    for (int e = tid; e < 3 * 2048; e += NT) {
      const int which = e >> 11, j = (e >> 6) & 31, c = e & 63;
      TAB[e] = which < 2 ? p.in[I_WUP][((size_t)(i * 2 + which) * 32 + j) * 512 + h * 64 + c] : p.in[I_AUP][((size_t)i * 32 + j) * 512 + h * 64 + c];
    }
    __syncthreads();
    const float* WU = TAB + dir * 2048;
    const float* AU = TAB + 2 * 2048;
    RwConst c;
    const int cc = h * 64 + lane;
    c.mur = p.in[I_MURKV][(i * 3 + 0) * 512 + cc]; c.muk = p.in[I_MURKV][(i * 3 + 1) * 512 + cc]; c.muv = p.in[I_MURKV][(i * 3 + 2) * 512 + cc];
    c.mul = p.in[I_MULORA][i * 64 + lane];
    c.w0 = p.in[I_W0][(i * 2 + dir) * 512 + cc]; c.a0 = p.in[I_A0][(i * 2 + dir) * 512 + cc];
    c.kk = p.in[I_KK][i * 512 + cc]; c.ka = p.in[I_KA][i * 512 + cc];
    const size_t it = ((size_t)(q * 8 + h) * 2 + dir);
    float* Op = CH + it * 8192 + (role ? 0 : 4096);
    float S[64];
    int lane_o = role ? lane : -1;
    asm volatile("" : "+v"(lane_o));
#pragma unroll
    for (int k = 0; k < 64; ++k) S[k] = (k == lane_o) ? 1.f : 0.f;
    for (int blk = 0; blk < 32; ++blk) {
#pragma unroll 1
      for (int s = role * 4; s < role * 4 + 4; ++s) {
        const int st = blk * 8 + s;
        const int tok = dir ? (q * 256 + 255 - st) : (q * 256 + st);
        rw_prologue(PRW, tok, h, lane, c, WU, AU, LT, Wd + s * 64, KKd + s * 64, BBd + s * 64, KDd + s * 64, RRd + s * 64, VVd + s * 64);
      }
      __syncthreads();
#pragma unroll 1
      for (int s = 0; s < 8; ++s) {
        float sa = 0.f;
#pragma unroll
        for (int k4 = 0; k4 < 16; ++k4) {
          if ((k4 & 7) == 0) __builtin_amdgcn_sched_barrier(0);
          float4 kq = *(const float4*)(KKd + s * 64 + 4 * k4);
          sa -= S[4 * k4] * kq.x + S[4 * k4 + 1] * kq.y + S[4 * k4 + 2] * kq.z + S[4 * k4 + 3] * kq.w;
        }
        const float vv = role ? 0.f : VVd[s * 64 + lane];
#pragma unroll
        for (int k4 = 0; k4 < 16; ++k4) {
          if ((k4 & 3) == 0) __builtin_amdgcn_sched_barrier(0);
          float4 w = *(const float4*)(Wd + s * 64 + 4 * k4), b = *(const float4*)(BBd + s * 64 + 4 * k4), kd = *(const float4*)(KDd + s * 64 + 4 * k4);
          S[4 * k4 + 0] = S[4 * k4 + 0] * w.x + sa * b.x + vv * kd.x;
          S[4 * k4 + 1] = S[4 * k4 + 1] * w.y + sa * b.y + vv * kd.y;
          S[4 * k4 + 2] = S[4 * k4 + 2] * w.z + sa * b.z + vv * kd.z;
          S[4 * k4 + 3] = S[4 * k4 + 3] * w.w + sa * b.w + vv * kd.w;
        }
      }
      __syncthreads();
    }
#pragma unroll
    for (int k4 = 0; k4 < 16; ++k4) ((float4*)(Op + lane * 64))[k4] = float4{S[4 * k4], S[4 * k4 + 1], S[4 * k4 + 2], S[4 * k4 + 3]};
  }
}

__device__ void rwkv_scan3(const Params& p, int i, unsigned char* lds) {
  const ushort_t* PRW = (const ushort_t*)(p.ws + OFF_PRW);
  float* CH = (float*)(p.ws + OFF_PS5);
  float* YR = (float*)(p.ws + OFF_YS);
  const int tid = tidx(), lane = tid & 63, wave = tid >> 6;
  float* TAB = (float*)lds;
  float* WV = (float*)(lds + 24576 + wave * 12544);
  float* Wd = WV, *KKd = WV + 512, *BBd = WV + 1024, *KDd = WV + 1536, *RRd = WV + 2048, *VVd = WV + 2560, *LT = WV + 3072;
  for (int bi = bidx(); bi < 384; bi += gridDim.x) {
    const int h = bi / 48, cgp = bi % 48;
    const int dir = wave >> 2, q = cgp * 4 + (wave & 3);
    __syncthreads();
    for (int e = tid; e < 3 * 2048; e += NT) {
      const int which = e >> 11, j = (e >> 6) & 31, c = e & 63;
      TAB[e] = which < 2 ? p.in[I_WUP][((size_t)(i * 2 + which) * 32 + j) * 512 + h * 64 + c] : p.in[I_AUP][((size_t)i * 32 + j) * 512 + h * 64 + c];
    }
    __syncthreads();
    const float* WU = TAB + dir * 2048;
    const float* AU = TAB + 2 * 2048;
    RwConst c;
    const int cc = h * 64 + lane;
    c.mur = p.in[I_MURKV][(i * 3 + 0) * 512 + cc]; c.muk = p.in[I_MURKV][(i * 3 + 1) * 512 + cc]; c.muv = p.in[I_MURKV][(i * 3 + 2) * 512 + cc];
    c.mul = p.in[I_MULORA][i * 64 + lane];
    c.w0 = p.in[I_W0][(i * 2 + dir) * 512 + cc]; c.a0 = p.in[I_A0][(i * 2 + dir) * 512 + cc];
    c.kk = p.in[I_KK][i * 512 + cc]; c.ka = p.in[I_KA][i * 512 + cc];
    const size_t it = ((size_t)(q * 8 + h) * 2 + dir);
    const float* Qp = CH + it * 8192 + 4096;
    float S[64];
#pragma unroll
    for (int k4 = 0; k4 < 16; ++k4) { float4 v = ((const float4*)(Qp + lane * 64))[k4]; S[4 * k4] = v.x; S[4 * k4 + 1] = v.y; S[4 * k4 + 2] = v.z; S[4 * k4 + 3] = v.w; }
    for (int blk = 0; blk < 32; ++blk) {
#pragma unroll 1
      for (int s = 0; s < 8; ++s) {
        const int st = blk * 8 + s;
        const int tok = dir ? (q * 256 + 255 - st) : (q * 256 + st);
        rw_prologue(PRW, tok, h, lane, c, WU, AU, LT, Wd + s * 64, KKd + s * 64, BBd + s * 64, KDd + s * 64, RRd + s * 64, VVd + s * 64);
      }
      wave_sync();
#pragma unroll 1
      for (int s = 0; s < 8; ++s) {
        float sa = 0.f;
#pragma unroll
        for (int k4 = 0; k4 < 16; ++k4) {
          if ((k4 & 7) == 0) __builtin_amdgcn_sched_barrier(0);
          float4 kq = *(const float4*)(KKd + s * 64 + 4 * k4);
          sa -= S[4 * k4] * kq.x + S[4 * k4 + 1] * kq.y + S[4 * k4 + 2] * kq.z + S[4 * k4 + 3] * kq.w;
        }
        const float vv = VVd[s * 64 + lane];
        float y = 0.f;
#pragma unroll
        for (int k4 = 0; k4 < 16; ++k4) {
          if ((k4 & 3) == 0) __builtin_amdgcn_sched_barrier(0);
          float4 w = *(const float4*)(Wd + s * 64 + 4 * k4), b = *(const float4*)(BBd + s * 64 + 4 * k4), kd = *(const float4*)(KDd + s * 64 + 4 * k4);
          float4 r = *(const float4*)(RRd + s * 64 + 4 * k4);
          S[4 * k4 + 0] = S[4 * k4 + 0] * w.x + sa * b.x + vv * kd.x;
          S[4 * k4 + 1] = S[4 * k4 + 1] * w.y + sa * b.y + vv * kd.y;
          S[4 * k4 + 2] = S[4 * k4 + 2] * w.z + sa * b.z + vv * kd.z;
          S[4 * k4 + 3] = S[4 * k4 + 3] * w.w + sa * b.w + vv * kd.w;
          y += S[4 * k4] * r.x + S[4 * k4 + 1] * r.y + S[4 * k4 + 2] * r.z + S[4 * k4 + 3] * r.w;
        }
        const int st = blk * 8 + s;
        const int tok = dir ? (q * 256 + 255 - st) : (q * 256 + st);
        atomicAdd(YR + (size_t)tok * 512 + h * 64 + lane, y);
      }
      wave_sync();
    }
  }
}

__device__ void rwkv_carry(const Params& p, unsigned char* lds) {
  float* CH = (float*)(p.ws + OFF_PS5);
  float* Ps = (float*)lds;
  float* Ss = Ps + 4096;
  const int tid = tidx(), v = tid >> 4, ks = (tid & 15) * 4;
  for (int bi = bidx(); bi < 192; bi += gridDim.x) {
    const int half = bi & 1, dir = (bi >> 1) & 1, h = (bi >> 2) & 7, s = bi >> 5;
    int cs, n;
    if (s < 4) { cs = s * 16; n = 16; } else { cs = 64 + (s - 4) * 64; n = 64; }
    float4 cur{0.f, 0.f, 0.f, 0.f};
    for (int ci = 0; ci < n; ++ci) {
      const int q = dir ? (cs + n - 1 - ci) : (cs + ci);
      float* Pp = CH + ((size_t)(q * 8 + h) * 2 + dir) * 8192;
      float* Qrow = Pp + 4096 + (half * 32 + v) * 64 + ks;
      __syncthreads();
      float4 qv = *(const float4*)Qrow;
      *(float4*)Qrow = cur;
      if (ci == n - 1) break;
      *(float4*)(Ss + v * 64 + ks) = cur;
      ((float4*)Ps)[tid] = ((const float4*)Pp)[tid];
      ((float4*)Ps)[tid + 512] = ((const float4*)Pp)[tid + 512];
      __syncthreads();
      float4 acc = qv;
#pragma unroll 8
      for (int j = 0; j < 64; ++j) {
        const float sv = Ss[v * 64 + j];
        const float4 pr = *(const float4*)(Ps + j * 64 + ks);
        acc.x += sv * pr.x; acc.y += sv * pr.y; acc.z += sv * pr.z; acc.w += sv * pr.w;
      }
      cur = acc;
    }
    __syncthreads();
  }
}

__device__ void rwkv_post(const Params& p, int i) {
  const ushort_t* PRW = (const ushort_t*)(p.ws + OFF_PRW);
  const float* YR = (const float*)(p.ws + OFF_YS);
  ushort_t* Y = (ushort_t*)(p.ws + OFF_Y);
  const int lane = tidx() & 63, gw = bidx() * 8 + (tidx() >> 6), nw = gridDim.x * 8;
  for (int item = gw; item < T * 8; item += nw) {
    const int tok = item >> 3, h = item & 7, cc = h * 64 + lane;
    int s0, L; seq_of(tok, s0, L);
    const ushort_t* row = PRW + (size_t)tok * 2112;
    const bool hm = tok > s0, hp = tok + 1 < s0 + L;
    float r0 = bf2f(row[cc]), k0 = bf2f(row[512 + cc]), v0 = bf2f(row[1024 + cc]);
    float rn = 0.f, kn = 0.f, vn = 0.f;
    if (hm) { const ushort_t* r2 = row - 2112; rn += bf2f(r2[cc]); kn += bf2f(r2[512 + cc]); vn += bf2f(r2[1024 + cc]); }
    if (hp) { const ushort_t* r2 = row + 2112; rn += bf2f(r2[cc]); kn += bf2f(r2[512 + cc]); vn += bf2f(r2[1024 + cc]); }
    const float rr = r0 + p.in[I_MURKV][(i * 3 + 0) * 512 + cc] * (0.5f * rn - r0);
    const float kx = k0 + p.in[I_MURKV][(i * 3 + 1) * 512 + cc] * (0.5f * kn - k0);
    const float vv = v0 + p.in[I_MURKV][(i * 3 + 2) * 512 + cc] * (0.5f * vn - v0);
    const float y = YR[(size_t)tok * 512 + cc];
    const float mean = wsum(y) * (1.f / 64.f);
    const float dlt = y - mean;
    const float var = wsum(dlt * dlt) * (1.f / 64.f);
    const float yn = dlt * rsqrtf(var + 64e-5f) * p.in[I_LNXW][i * 512 + cc] + p.in[I_LNXB][i * 512 + cc];
    const float bonus = wsum(rr * kx * p.in[I_RK][i * 512 + cc]) * vv;
    const float g = bf2f(row[1536 + cc]);
    Y[(size_t)tok * 1024 + 512 + cc] = f2bf((yn + bonus) * (g * sigmoidf_(g)));
  }
}

__device__ void hy_filter_mlp(const Params& p, int i) {
  float* H2 = (float*)(p.ws + OFF_H2);
  const int lane = tidx() & 63, gw = bidx() * 8 + (tidx() >> 6), nw = gridDim.x * 8;
  const float fr = p.in[I_FFREQ][i * 64 + lane], b1 = p.in[I_FB1][i * 64 + lane], b2 = p.in[I_FB2][i * 64 + lane];
  for (int row = gw; row < 20480; row += nw) {
    const int L = row < 4096 ? 4096 : 16384, t = row < 4096 ? row : row - 4096;
    const float w = 6.283185307179586f * (float)t / (float)L;
    float z = 0.f;
    if (lane == 0) z = (float)t / (float)(L - 1);
    else if (lane <= 32) {
      const int bi = (lane - 1) & 15;
      const float f = 1e-4f + (float)bi * ((15.f - 1e-4f) / 15.f);
      z = lane <= 16 ? cosf(f * w) : -sinf(f * w);
    }
    float a = b1;
#pragma unroll 3
    for (int k = 0; k < 33; ++k) a += __shfl(z, k) * p.in[I_FW1][((size_t)i * 33 + k) * 64 + lane];
    const float h1 = sinf(fr * a);
    float c = b2;
#pragma unroll 8
    for (int k = 0; k < 64; ++k) c += __shfl(h1, k) * p.in[I_FW2][((size_t)i * 64 + k) * 64 + lane];
    H2[(size_t)row * 64 + lane] = sinf(fr * c);
  }
}

template <int LOGN>
__device__ void fft_dif(float2* buf) {
  constexpr int N = 1 << LOGN;
  const int tid = tidx();
  for (int h = N / 2; h >= 2; h >>= 2) {
    const int hh = h >> 1;
    for (int q = tid; q < N / 4; q += NT) {
      const int pos = q & (hh - 1), grp = q / hh;
      const int e0 = grp * 2 * h + pos;
      float2 x0 = buf[e0], x1 = buf[e0 + hh], x2 = buf[e0 + h], x3 = buf[e0 + h + hh];
      const float f1 = (float)pos / (float)(2 * h);
      const float c1 = __builtin_amdgcn_cosf(f1), s1 = -__builtin_amdgcn_sinf(f1);
      const float c2 = c1 * c1 - s1 * s1, s2 = 2.f * c1 * s1;
      float2 a0{x0.x + x2.x, x0.y + x2.y};
      float2 d2{x0.x - x2.x, x0.y - x2.y};
      float2 a2{d2.x * c1 - d2.y * s1, d2.x * s1 + d2.y * c1};
      float2 a1{x1.x + x3.x, x1.y + x3.y};
      float2 d3{x1.x - x3.x, x1.y - x3.y};
      float2 t3{d3.x * c1 - d3.y * s1, d3.x * s1 + d3.y * c1};
      float2 a3{t3.y, -t3.x};
      float2 y0{a0.x + a1.x, a0.y + a1.y};
      float2 e1{a0.x - a1.x, a0.y - a1.y};
      float2 y1{e1.x * c2 - e1.y * s2, e1.x * s2 + e1.y * c2};
      float2 y2{a2.x + a3.x, a2.y + a3.y};
      float2 e3{a2.x - a3.x, a2.y - a3.y};
      float2 y3{e3.x * c2 - e3.y * s2, e3.x * s2 + e3.y * c2};
      buf[e0] = y0; buf[e0 + hh] = y1; buf[e0 + h] = y2; buf[e0 + h + hh] = y3;
    }
    __syncthreads();
  }
}
template <int LOGN>
__device__ void fft_dit_inv(float2* buf) {
  constexpr int N = 1 << LOGN;
  const int tid = tidx();
  for (int h = 1; h < N; h <<= 2) {
    for (int q = tid; q < N / 4; q += NT) {
      const int pos = q & (h - 1), grp = q / h;
      const int e0 = grp * 4 * h + pos;
      float2 x0 = buf[e0], x1 = buf[e0 + h], x2 = buf[e0 + 2 * h], x3 = buf[e0 + 3 * h];
      const float f2 = (float)pos / (float)(4 * h);
      const float c2 = __builtin_amdgcn_cosf(f2), s2 = __builtin_amdgcn_sinf(f2);
      const float c1 = c2 * c2 - s2 * s2, s1 = 2.f * c2 * s2;
      float2 b1{x1.x * c1 - x1.y * s1, x1.x * s1 + x1.y * c1};
      float2 b3{x3.x * c1 - x3.y * s1, x3.x * s1 + x3.y * c1};
      float2 a0{x0.x + b1.x, x0.y + b1.y}, a1{x0.x - b1.x, x0.y - b1.y};
      float2 a2{x2.x + b3.x, x2.y + b3.y}, a3{x2.x - b3.x, x2.y - b3.y};
      float2 cc2{a2.x * c2 - a2.y * s2, a2.x * s2 + a2.y * c2};
      float2 t3{a3.x * c2 - a3.y * s2, a3.x * s2 + a3.y * c2};
      float2 cc3{-t3.y, t3.x};
      buf[e0] = float2{a0.x + cc2.x, a0.y + cc2.y};
      buf[e0 + 2 * h] = float2{a0.x - cc2.x, a0.y - cc2.y};
      buf[e0 + h] = float2{a1.x + cc3.x, a1.y + cc3.y};
      buf[e0 + 3 * h] = float2{a1.x - cc3.x, a1.y - cc3.y};
    }
    __syncthreads();
  }
}
template <int LOGN>
__device__ void spectrum_extract(const float2* buf, float2* __restrict__ G, float scale) {
  constexpr int Lc = 1 << LOGN;
  for (int k = tidx(); k <= Lc / 2; k += NT) {
    if (k == 0) {
      float2 c = buf[0];
      G[0] = float2{(c.x + c.y) * scale, 0.f};
      G[Lc] = float2{(c.x - c.y) * scale, 0.f};
    } else {
      const int k2 = Lc - k;
      const int p1 = __brev((unsigned)k) >> (32 - LOGN), p2 = __brev((unsigned)k2) >> (32 - LOGN);
      float2 C1 = buf[p1], C2 = buf[p2];
      float2 E{0.5f * (C1.x + C2.x), 0.5f * (C1.y - C2.y)}, D{0.5f * (C1.x - C2.x), 0.5f * (C1.y + C2.y)};
      float2 O{D.y, -D.x};
      const float f = (float)k / (float)(2 * Lc);
      const float wc = __builtin_amdgcn_cosf(f), wsn = -__builtin_amdgcn_sinf(f);
      float2 wO{wc * O.x - wsn * O.y, wc * O.y + wsn * O.x};
      G[k] = float2{(E.x + wO.x) * scale, (E.y + wO.y) * scale};
      G[k2] = float2{(E.x - wO.x) * scale, -(E.y - wO.y) * scale};
    }
  }
}
template <int LOGN>
__device__ void spectrum_mul(float2* buf, const float2* __restrict__ G) {
  constexpr int Lc = 1 << LOGN;
  for (int k = tidx(); k <= Lc / 2; k += NT) {
    if (k == 0) {
      float2 c = buf[0];
      const float Y0 = (c.x + c.y) * G[0].x, YL = (c.x - c.y) * G[Lc].x;
      buf[0] = float2{0.5f * (Y0 + YL), 0.5f * (Y0 - YL)};
    } else {
      const int k2 = Lc - k;
      const int p1 = __brev((unsigned)k) >> (32 - LOGN), p2 = __brev((unsigned)k2) >> (32 - LOGN);
      float2 C1 = buf[p1], C2 = buf[p2];
      float2 E{0.5f * (C1.x + C2.x), 0.5f * (C1.y - C2.y)}, D{0.5f * (C1.x - C2.x), 0.5f * (C1.y + C2.y)};
      float2 O{D.y, -D.x};
      const float f = (float)k / (float)(2 * Lc);
      const float wc = __builtin_amdgcn_cosf(f), wsn = -__builtin_amdgcn_sinf(f);
      float2 wO{wc * O.x - wsn * O.y, wc * O.y + wsn * O.x};
      float2 X1{E.x + wO.x, E.y + wO.y}, X2{E.x - wO.x, -(E.y - wO.y)};
      float2 g1 = G[k], g2 = G[k2];
      float2 Y1{X1.x * g1.x - X1.y * g1.y, X1.x * g1.y + X1.y * g1.x};
      float2 Y2{X2.x * g2.x - X2.y * g2.y, X2.x * g2.y + X2.y * g2.x};
      float2 Ye{0.5f * (Y1.x + Y2.x), 0.5f * (Y1.y - Y2.y)};
      float2 Dd{0.5f * (Y1.x - Y2.x), 0.5f * (Y1.y + Y2.y)};
      float2 Yo{wc * Dd.x + wsn * Dd.y, wc * Dd.y - wsn * Dd.x};
      float2 Z1{Ye.x - Yo.y, Ye.y + Yo.x};
      float2 Z2{Ye.x + Yo.y, -Ye.y + Yo.x};
      buf[p1] = Z1;
      buf[p2] = Z2;
    }
  }
}

template <int LOGN>
__device__ void hy_conv_item(const Params& p, int i, int c, unsigned char* lds) {
  constexpr int Lc = 1 << LOGN;
  constexpr int L = Lc;
  constexpr int NB = (LOGN == 14) ? 2 : 4;
  const int tid = tidx();
  float2* buf = (float2*)lds;
  float* bufF = (float*)lds;
  float* W3s = (float*)(lds + 131072);
  float* red = W3s + 128;
  float2* GS = (float2*)(p.ws + OFF_GS + (size_t)bidx() * 2 * GS_PER);
  float* Z1 = (float*)(p.ws + OFF_Z1 + (size_t)bidx() * 65536);
  const float* H2 = (const float*)(p.ws + OFF_H2) + (LOGN == 14 ? (size_t)4096 * 64 : 0);
  const ushort_t* PH = (const ushort_t*)(p.ws + OFF_PH);
  const float delta = 4.605170185988091f * (1.f / 1.5f + (1.f / 0.3f - 1.f / 1.5f) * (float)c / 1023.f);
  for (int o = 0; o < 2; ++o) {
    __syncthreads();
    if (tid < 128) {
      const int dirr = tid >> 6, j = tid & 63;
      W3s[tid] = p.in[I_FW3][((size_t)i * 64 + j) * 4096 + (dirr * 2 + o) * 1024 + c];
    }
    __syncthreads();
    float ss = 0.f;
    for (int t = tid; t < L; t += NT) {
      const float4* hr = (const float4*)(H2 + (size_t)t * 64);
      float d0 = 0.f, d1 = 0.f;
#pragma unroll
      for (int j4 = 0; j4 < 16; ++j4) {
        float4 hv = hr[j4];
        d0 += hv.x * W3s[4 * j4] + hv.y * W3s[4 * j4 + 1] + hv.z * W3s[4 * j4 + 2] + hv.w * W3s[4 * j4 + 3];
        d1 += hv.x * W3s[64 + 4 * j4] + hv.y * W3s[64 + 4 * j4 + 1] + hv.z * W3s[64 + 4 * j4 + 2] + hv.w * W3s[64 + 4 * j4 + 3];
      }
      const float dec = expf(-((float)t / (float)(L - 1)) * delta);
      d0 *= dec; d1 *= dec;
      ss += d0 * d0 + d1 * d1;
      bufF[t] = d0;
      if (t >= 1) bufF[2 * L - t] = d1; else bufF[L] = 0.f;
    }
    ss = wsum(ss);
    if ((tid & 63) == 0) red[tid >> 6] = ss;
    __syncthreads();
    float tot = 0.f;
#pragma unroll
    for (int w = 0; w < 8; ++w) tot += red[w];
    const float scale = rsqrtf(tot) / (float)Lc;
    fft_dif<LOGN>(buf);
    spectrum_extract<LOGN>(buf, GS + (size_t)o * (GS_PER / 8), scale);
  }
  __threadfence_block();
  __syncthreads();
  const float* sw = p.in[I_HSW] + (size_t)i * 3 * 3072;
  const float* sbias = p.in[I_HSB] + (size_t)i * 3072;
  float cw[3][3], cb[3];
#pragma unroll
  for (int st = 0; st < 3; ++st) {
#pragma unroll
    for (int k = 0; k < 3; ++k) cw[st][k] = sw[k * 3072 + st * 1024 + c];
    cb[st] = sbias[st * 1024 + c];
  }
  const float fb0 = p.in[I_FBIAS][((size_t)i * 2 + 0) * 1024 + c], fb1 = p.in[I_FBIAS][((size_t)i * 2 + 1) * 1024 + c];
  for (int b = 0; b < NB; ++b) {
    const int s0 = (LOGN == 14) ? (TPROMPT + b * 16384) : (b * 4096);
    const ushort_t* pv = PH + (size_t)s0 * 1024 + (size_t)c * L;
    const ushort_t* px1 = pv + (size_t)T * 1024;
    const ushort_t* px2 = px1 + (size_t)T * 1024;
    ushort_t* pg = (ushort_t*)px2 + (size_t)T * 1024;
    auto conv3 = [&](const ushort_t* s, int st, int t) -> float {
      const float a = t > 0 ? bf2f(s[t - 1]) : 0.f, m = bf2f(s[t]), n = t + 1 < L ? bf2f(s[t + 1]) : 0.f;
      return cw[st][0] * a + cw[st][1] * m + cw[st][2] * n + cb[st];
    };
    __syncthreads();
    for (int t = tid; t < L; t += NT) { bufF[t] = conv3(pv, 0, t); bufF[L + t] = 0.f; }
    __syncthreads();
    fft_dif<LOGN>(buf);
    spectrum_mul<LOGN>(buf, GS);
    __syncthreads();
    fft_dit_inv<LOGN>(buf);
    for (int t = tid; t < L; t += NT) {
      const float z0 = conv3(pv, 0, t);
      const float z1 = conv3(px1, 1, t) * (bufF[t] + z0 * fb0);
      bufF[t] = z1; Z1[t] = z1;
    }
    __syncthreads();
    for (int t = tid; t < L; t += NT) bufF[L + t] = 0.f;
    __syncthreads();
    fft_dif<LOGN>(buf);
    spectrum_mul<LOGN>(buf, GS + GS_PER / 8);
    __syncthreads();
    fft_dit_inv<LOGN>(buf);
    for (int t = tid; t < L; t += NT) {
      const float z2 = conv3(px2, 2, t) * (bufF[t] + Z1[t] * fb1);
      const float g = bf2f(pg[t]);
      pg[t] = f2bf(z2 * g * sigmoidf_(g));
    }
  }
}

__device__ void hy_conv_phase(const Params& p, int i, unsigned char* lds) {
  for (int it = bidx(); it < 2048; it += gridDim.x) {
    if (it < 1024) hy_conv_item<14>(p, i, it, lds);
    else hy_conv_item<12>(p, i, it - 1024, lds);
    __syncthreads();
  }
}

#ifndef PH_MASK
#define PH_MASK 0xffff
#endif
#define PHM(n) ((PH_MASK >> (n)) & 1)
DEVI void run_phase(const Params& p, int ph, unsigned char* lds) {
  const int layer = ph < NPH_EVEN ? 0 : ph < NPH_EVEN + NPH_ODD ? 1 : ph < 2 * NPH_EVEN + NPH_ODD ? 2 : 3;
  const int base = layer == 0 ? 0 : layer == 1 ? NPH_EVEN : layer == 2 ? NPH_EVEN + NPH_ODD : 2 * NPH_EVEN + NPH_ODD;
  const int sp = ph - base, i = layer >> 1;
  unsigned char* ws = p.ws;
  ushort_t* WB = (ushort_t*)(ws + OFF_WB);
  if ((layer & 1) == 0) {
    ushort_t* WinT = WB; ushort_t* WoutT = WB + 3136 * 1024; ushort_t* GluT = WoutT + 1024 * 1024;
    switch (sp) {
      case 0: if (PHM(0)) {
        transpose_bf16(p.in[I_EWIN] + (size_t)i * 1024 * 3136, WinT, 1024, 3136, lds);
        transpose_bf16(p.in[I_EWOUT] + (size_t)i * 1024 * 1024, WoutT, 1024, 1024, lds);
        transpose_bf16(p.in[I_GLUW] + (size_t)i * 512 * 512, GluT, 512, 512, lds);
        } break;
      case 1: if (PHM(1)) gemm_phase<0, 0>(p, layer, lds, nullptr, WinT, 3136, 1024, ws + OFF_PS5, ws + OFF_PRW, nullptr, nullptr, nullptr); break;
      case 2: if (PHM(2)) s5_passA(p, i, lds); break;
      case 3: if (PHM(3)) s5_passC(p, i, lds); break;
      case 4: if (PHM(4)) gemm_phase<2, 2>(p, layer, lds, ws + OFF_YS, GluT, 512, 512, ws + OFF_Y, nullptr, ws + OFF_YS, ws + OFF_PS5, p.in[I_GLUB] + i * 512); break;
      case 5: if (PHM(5)) rwkv_scan1(p, i, lds); break;
      case 6: if (PHM(6)) rwkv_carry(p, lds); break;
      case 7: if (PHM(7)) rwkv_scan3(p, i, lds); break;
      case 8: if (PHM(8)) rwkv_post(p, i); break;
      case 9: if (PHM(9)) gemm_phase<1, 3>(p, layer, lds, ws + OFF_Y, WoutT, 1024, 1024, ws + OFF_PRW, nullptr, nullptr, nullptr, nullptr); break;
      case 10: if (PHM(10)) ln_phase(p, layer, (const float*)(ws + OFF_PRW)); break;
    }
  } else {
    ushort_t* HinT = WB; ushort_t* HoutT = WB + 4096 * 1024;
    switch (sp) {
      case 0: if (PHM(11)) {
        transpose_bf16(p.in[I_HWIN] + (size_t)i * 1024 * 4096, HinT, 1024, 4096, lds);
        transpose_bf16(p.in[I_HWOUT] + (size_t)i * 1024 * 1024, HoutT, 1024, 1024, lds);
        hy_filter_mlp(p, i);
        } break;
      case 1: if (PHM(12)) gemm_phase<0, 1>(p, layer, lds, nullptr, HinT, 4096, 1024, ws + OFF_PH, nullptr, nullptr, nullptr, nullptr); break;
      case 2: if (PHM(13)) hy_conv_phase(p, i, lds); break;
      case 3: if (PHM(14)) gemm_phase<3, 3>(p, layer, lds, ws + OFF_PH + 3 * SZ1, HoutT, 1024, 1024, ws + OFF_PH, nullptr, nullptr, nullptr, nullptr); break;
      case 4: if (PHM(15)) ln_phase(p, layer, (const float*)(ws + OFF_PH)); break;
    }
  }
}

#if ONE_LAUNCH
__global__ void __launch_bounds__(NT) fwd_kernel(Params p) {
  extern __shared__ __attribute__((aligned(16))) unsigned char lds[];
#if ONE_LAUNCH
  cg::grid_group grid = cg::this_grid();
#endif
  for (int ph = p.ph_lo; ph < p.ph_hi; ++ph) {
    run_phase(p, ph, lds);
#if ONE_LAUNCH
    if (ph + 1 < p.ph_hi) grid.sync();
#endif
  }
}
#endif

#if !ONE_LAUNCH
template <int PH> __global__ void __launch_bounds__(NT) phase_kernel(Params p) {
  extern __shared__ __attribute__((aligned(16))) unsigned char lds[];
  run_phase(p, PH, lds);
}
typedef void (*kfn_t)(Params);
#define PK(n) phase_kernel<n>
static kfn_t k_tab[NPHASES] = {PK(0), PK(1), PK(2), PK(3), PK(4), PK(5), PK(6), PK(7), PK(8), PK(9), PK(10), PK(11), PK(12), PK(13), PK(14), PK(15),
                               PK(16), PK(17), PK(18), PK(19), PK(20), PK(21), PK(22), PK(23), PK(24), PK(25), PK(26), PK(27), PK(28), PK(29), PK(30), PK(31)};
#endif

extern "C" void kernel_launch(void* const* d_in, const int* in_sizes, int n_in, void* d_out, int out_size, void* d_ws, size_t ws_size,
                              hipStream_t stream) {
  static int grid_blocks = 0;
  if (!grid_blocks) {
    if (n_in != 38 || ws_size < WS_NEED || out_size != T * 1024) {
      fprintf(stderr, "kernel_launch: unexpected shapes n_in=%d ws=%zu out=%d\n", n_in, ws_size, out_size);
      grid_blocks = -1; return;
    }
    int dev = 0, cus = 0, per_cu = 0;
    (void)hipGetDevice(&dev);
    (void)hipDeviceGetAttribute(&cus, hipDeviceAttributeMultiprocessorCount, dev);
#if ONE_LAUNCH
    if (hipFuncSetAttribute((const void*)fwd_kernel, hipFuncAttributeMaxDynamicSharedMemorySize, LDS_BYTES) != hipSuccess) {
      fprintf(stderr, "kernel_launch: hipFuncSetAttribute failed\n"); grid_blocks = -1; return;
    }
    (void)hipOccupancyMaxActiveBlocksPerMultiprocessor(&per_cu, (const void*)fwd_kernel, NT, LDS_BYTES);
#else
    for (int ph = 0; ph < NPHASES; ++ph)
      if (hipFuncSetAttribute((const void*)k_tab[ph], hipFuncAttributeMaxDynamicSharedMemorySize, LDS_BYTES) != hipSuccess) {
        fprintf(stderr, "kernel_launch: hipFuncSetAttribute failed\n"); grid_blocks = -1; return;
      }
    per_cu = 1;
#endif
    if (per_cu < 1) { fprintf(stderr, "kernel_launch: occupancy query returned %d\n", per_cu); per_cu = 1; }
    grid_blocks = cus * per_cu;
    if (grid_blocks > 256) grid_blocks = 256;
    if (grid_blocks < 1) grid_blocks = 256;
  }
  if (grid_blocks < 0) return;
  Params p{};
  for (int k = 0; k < 38; ++k) p.in[k] = (const float*)d_in[k];
  p.out = (float*)d_out; p.ws = (unsigned char*)d_ws;
#if ONE_LAUNCH
  p.ph_lo = 0; p.ph_hi = NPHASES;
  void* args[] = {&p};
  hipError_t e = hipLaunchCooperativeKernel((const void*)fwd_kernel, dim3(grid_blocks), dim3(NT), args, LDS_BYTES, stream);
  if (e != hipSuccess) fprintf(stderr, "cooperative launch failed: %s (grid %d)\n", hipGetErrorString(e), grid_blocks);
#else
  for (int ph = 0; ph < NPHASES; ++ph) {
    p.ph_lo = ph; p.ph_hi = ph + 1;
    hipLaunchKernelGGL(k_tab[ph], dim3(grid_blocks), dim3(NT), LDS_BYTES, stream, p);
  }
#endif
}
```

```cpp
#include <hip/hip_runtime.h>
#include <hip/hip_cooperative_groups.h>
#include <cstdio>
#include <cstdint>
namespace cg = cooperative_groups;

#ifndef ONE_LAUNCH
#define ONE_LAUNCH 1
#endif

#define DEVI __device__ __forceinline__
constexpr int NT = 512;
constexpr int T = 49152;
constexpr int TPROMPT = 16384;
constexpr int LDS_BYTES = 133120;
constexpr int NPH_EVEN = 11, NPH_ODD = 6;
constexpr int NPHASES = 2 * (NPH_EVEN + NPH_ODD);

typedef __attribute__((ext_vector_type(8))) short bf16x8;
typedef __attribute__((ext_vector_type(4))) float f32x4;
typedef unsigned short ushort_t;

struct Params { const float* in[38]; float* out; unsigned char* ws; int ph_lo; int ph_hi; };

enum { I_XP = 0, I_XS, I_EWIN, I_EWOUT, I_LRE, I_LIM, I_LSTEP, I_BRE, I_BIM, I_CRE, I_CIM, I_S5D, I_GLUW, I_GLUB,
       I_MURKV, I_MULORA, I_W0, I_WUP, I_A0, I_AUP, I_KK, I_KA, I_RK, I_LNXW, I_LNXB,
       I_HWIN, I_HWOUT, I_HSW, I_HSB, I_FW1, I_FB1, I_FFREQ, I_FW2, I_FB2, I_FW3, I_FBIAS, I_LNG, I_LNB };

constexpr size_t SZ1 = (size_t)T * 1024 * 2;
constexpr size_t OFF_PS5 = 0;
constexpr size_t OFF_PRW = OFF_PS5 + SZ1;
constexpr size_t OFF_Y = OFF_PRW + (size_t)T * 2112 * 2;
constexpr size_t OFF_YS = OFF_Y + SZ1;
constexpr size_t OFF_WB = OFF_YS + SZ1;
constexpr size_t OFF_CAR = OFF_WB + 10485760;
constexpr size_t WS_NEED = OFF_CAR + 6291456;
constexpr size_t OFF_PH = 0;
constexpr size_t OFF_GS = 4 * SZ1;
constexpr size_t GS_PER = 131328;
constexpr size_t OFF_Z1 = OFF_GS + 256 * 2 * GS_PER;
constexpr size_t OFF_XB_ODD = 4 * SZ1;
constexpr size_t OFF_H2 = OFF_XB_ODD + SZ1;

DEVI int tidx() { int t = threadIdx.x; asm volatile("" : "+v"(t)); return t; }
DEVI int bidx() { int b = blockIdx.x; asm volatile("" : "+s"(b)); return b; }
DEVI ushort_t f2bf(float f) { unsigned u = __float_as_uint(f); u += 0x7fffu + ((u >> 16) & 1u); return (ushort_t)(u >> 16); }
DEVI float bf2f(ushort_t h) { return __uint_as_float(((unsigned)h) << 16); }
DEVI unsigned pack2(float a, float b) { return (unsigned)f2bf(a) | ((unsigned)f2bf(b) << 16); }
DEVI float wsum(float v) {
#pragma unroll
  for (int m = 32; m >= 1; m >>= 1) v += __shfl_xor(v, m);
  return v;
}
DEVI void wave_sync() { __builtin_amdgcn_fence(__ATOMIC_RELEASE, "wavefront"); __builtin_amdgcn_wave_barrier(); __builtin_amdgcn_fence(__ATOMIC_ACQUIRE, "wavefront"); }
DEVI void seq_of(int tok, int& s0, int& L) {
  if (tok < TPROMPT) { s0 = tok & ~4095; L = 4096; } else { s0 = TPROMPT + ((tok - TPROMPT) & ~16383); L = 16384; }
}
struct XSrc { const float* xp; const float* xs; const float* xo; };
DEVI XSrc xsrc(const Params& p) {
  XSrc x; x.xp = p.in[I_XP]; x.xs = p.in[I_XS]; x.xo = p.out;
  asm volatile("" : "+s"(x.xp), "+s"(x.xs), "+s"(x.xo));
  return x;
}
DEVI const float* xrow(const XSrc& x, int layer, int tok) {
  if (layer == 0) return tok < TPROMPT ? x.xp + (size_t)tok * 1024 : x.xs + (size_t)(tok - TPROMPT) * 1024;
  return x.xo + (size_t)tok * 1024;
}
DEVI float sigmoidf_(float x) { return 1.f / (1.f + expf(-x)); }
DEVI float fast_sigmoid(float x) { return __builtin_amdgcn_rcpf(1.f + __builtin_amdgcn_exp2f(-1.4426950408889634f * x)); }
DEVI float fast_tanh(float x) { return 1.f - 2.f * __builtin_amdgcn_rcpf(1.f + __builtin_amdgcn_exp2f(2.8853900817779268f * x)); }
DEVI float dpp_mov_f(float x, const int sel) {
  int xi = __builtin_bit_cast(int, x), r;
  if (sel == 0) r = __builtin_amdgcn_mov_dpp(xi, 0xB1, 0xf, 0xf, true);
  else if (sel == 1) r = __builtin_amdgcn_mov_dpp(xi, 0x4E, 0xf, 0xf, true);
  else if (sel == 2) r = __builtin_amdgcn_mov_dpp(xi, 0x141, 0xf, 0xf, true);
  else r = __builtin_amdgcn_mov_dpp(xi, 0x140, 0xf, 0xf, true);
  return __builtin_bit_cast(float, r);
}
DEVI float wsum_fast(float v) {
  v += dpp_mov_f(v, 0); v += dpp_mov_f(v, 1); v += dpp_mov_f(v, 2); v += dpp_mov_f(v, 3);
  const int vi = __builtin_bit_cast(int, v);
  return __builtin_bit_cast(float, __builtin_amdgcn_readlane(vi, 0)) + __builtin_bit_cast(float, __builtin_amdgcn_readlane(vi, 16)) +
         __builtin_bit_cast(float, __builtin_amdgcn_readlane(vi, 32)) + __builtin_bit_cast(float, __builtin_amdgcn_readlane(vi, 48));
}
DEVI float gelu_tanh(float x) { return 0.5f * x * (1.f + tanhf(0.7978845608f * (x + 0.044715f * x * x * x))); }

__device__ void transpose_bf16(const float* __restrict__ in, ushort_t* __restrict__ out, int K, int N, unsigned char* lds) {
  float* tile = (float*)lds;
  const int tid = tidx(), j = tid & 63, i0 = tid >> 6;
  const int tk = K / 64, tn = N / 64;
  for (int t = bidx(); t < tk * tn; t += gridDim.x) {
    const int k0 = (t / tn) * 64, n0 = (t % tn) * 64;
#pragma unroll
    for (int e = 0; e < 8; ++e) { int i = i0 + 8 * e; tile[i * 65 + j] = in[(size_t)(k0 + i) * N + n0 + j]; }
    __syncthreads();
#pragma unroll
    for (int e = 0; e < 8; ++e) { int i = i0 + 8 * e; out[(size_t)(n0 + i) * K + k0 + j] = f2bf(tile[j * 65 + i]); }
    __syncthreads();
  }
}

namespace pg8 {
#define PG8_LAS __attribute__((address_space(3)))
typedef unsigned u32x4 __attribute__((ext_vector_type(4)));
constexpr int BM = 256, BK = 64, HALF = 128, HTB = HALF * BK * 2, STAGE_BYTES = 8 * HTB, NXCD = 8, WGM = 8;
DEVI int lds_byte(int r, int c) { const int st = (r >> 4) * 2 + (c >> 5), rr = r & 15, cc = c & 31, ob = rr * 64 + cc * 2; return st * 1024 + (ob ^ (((ob >> 9) & 1) << 5)); }
DEVI void stage_rc(int b, int& R, int& C) { const int st = b / 1024, sb = b % 1024, swz = sb ^ (((sb >> 9) & 1) << 5); R = (st >> 1) * 16 + swz / 64; C = (st & 1) * 32 + (swz % 64) / 2; }
DEVI int perm32(int rho) { const int n = rho >> 4, i = rho & 15; return 8 * (i >> 2) + 4 * n + (i & 3); }
struct Unit { int pm, pn; };
struct Gemm { const ushort_t* A; const ushort_t* Bt; int M, N, K, lda; };
struct StaticOrder {
  int nM, nN, nwg, G, c;
  DEVI void init(int M, int N, int G_, int c_) { nM = M / BM; nN = N / BM; nwg = nM * nN; G = G_; c = c_; }
  DEVI bool next(int i, Unit& u) const {
    const long L = (long)i * G + c; if (L >= nwg) return false;
    int wgid = (int)L; { const int q = nwg / NXCD, r = nwg % NXCD, xcd = wgid % NXCD, off = wgid / NXCD; wgid = (xcd < r ? xcd * (q + 1) : r * (q + 1) + (xcd - r) * q) + off; }
    const int nig = WGM * nN, gid = wgid / nig, fm = gid * WGM, gsz = (nM - fm) < WGM ? (nM - fm) : WGM;
    u.pm = fm + ((wgid % nig) % gsz); u.pn = (wgid % nig) / gsz; return true;
  }
};
DEVI unsigned cvt_pk_bf16(float lo, float hi) { unsigned r; asm volatile("v_cvt_pk_bf16_f32 %0, %1, %2" : "=v"(r) : "v"(lo), "v"(hi)); return r; }

template <class Epi>
DEVI void gemm_phase(PG8_LAS unsigned char* lds, const Gemm g, const StaticOrder& S, const Epi& E) {
  const int tid = tidx(), wid = __builtin_amdgcn_readfirstlane(tid >> 6), lane = tid & 63, wr = wid >> 2, wc = wid & 3, fr = lane & 15, fq = lane >> 4;
  const int K = g.K, nt = K / BK, lda = g.lda;
  unsigned voffA[2], voffB[2];
#pragma unroll
  for (int i = 0; i < 2; ++i) { int R, C; stage_rc(tid * 16 + i * 8192, R, C); const int Rb = Epi::PERM ? ((R & ~31) + perm32(R & 31)) : R;
    voffA[i] = (unsigned)(R * lda + C) * 2u; voffB[i] = (unsigned)(Rb * K + C) * 2u; }
  const size_t kstep = (size_t)(BK * 2);
  const size_t hstepA = (size_t)HALF * lda * 2, hstepB = (size_t)HALF * K * 2;
  const size_t tstepA = 2 * hstepA, tstepB = 2 * hstepB;
  const unsigned ldsw = (unsigned)wid * 1024u;
  const int aoff = lds_byte(wr * 64 + fr, fq * 8), boff = lds_byte(wc * 32 + fr, fq * 8);
#define PG8_SA(b, h) (((b) * 2 + (h)) * HTB)
#define PG8_SB(b, h) ((4 + (b) * 2 + (h)) * HTB)
#define PG8_STAGE(bufoff, gbase, voff) do { _Pragma("unroll") for (int _i = 0; _i < 2; ++_i) \
    __builtin_amdgcn_global_load_lds((const unsigned*)((const char*)(gbase) + (voff)[_i]), (PG8_LAS unsigned*)(lds + (bufoff) + ldsw + _i * 8192), 16, 0, 0); } while (0)
#define PG8_LDA(dst, b, h) do { _Pragma("unroll") for (int m = 0; m < 4; ++m) _Pragma("unroll") for (int k = 0; k < 2; ++k) dst[m][k] = *(const PG8_LAS bf16x8*)(lds + PG8_SA(b, h) + aoff + m * 2048 + k * 1024); } while (0)
#define PG8_LDB(dst, b, h) do { _Pragma("unroll") for (int n = 0; n < 2; ++n) _Pragma("unroll") for (int k = 0; k < 2; ++k) dst[n][k] = *(const PG8_LAS bf16x8*)(lds + PG8_SB(b, h) + boff + n * 2048 + k * 1024); } while (0)
#define PG8_MMA(ai, bj, At, Bt) do { __builtin_amdgcn_s_setprio(1); _Pragma("unroll") for (int m = 0; m < 4; ++m) _Pragma("unroll") for (int n = 0; n < 2; ++n) _Pragma("unroll") for (int k = 0; k < 2; ++k) \
    acc[ai][bj][m][n] = Epi::TRANS ? __builtin_amdgcn_mfma_f32_16x16x32_bf16(Bt[n][k], At[m][k], acc[ai][bj][m][n], 0, 0, 0) \
                                   : __builtin_amdgcn_mfma_f32_16x16x32_bf16(At[m][k], Bt[n][k], acc[ai][bj][m][n], 0, 0, 0); __builtin_amdgcn_s_setprio(0); } while (0)
#define PG8_WAIT_V(n) asm volatile("s_waitcnt vmcnt(" #n ")" ::: "memory")
#define PG8_WAIT_L(n) asm volatile("s_waitcnt lgkmcnt(" #n ")" ::: "memory")
#define PG8_BAR __builtin_amdgcn_s_barrier()
#define PG8_SCHED __builtin_amdgcn_sched_barrier(0)
  Unit cur, nxt; int ui = 0;
  if (!S.next(0, cur)) return;
  f32x4 acc[2][2][4][2];
#pragma unroll
  for (int a = 0; a < 2; ++a)
#pragma unroll
    for (int b = 0; b < 2; ++b)
#pragma unroll
      for (int m = 0; m < 4; ++m)
#pragma unroll
        for (int n = 0; n < 2; ++n) acc[a][b][m][n] = (f32x4){0.f, 0.f, 0.f, 0.f};
  bf16x8 At[4][2], B0[2][2], B1[2][2];
  const char* cA = (const char*)g.A + (size_t)cur.pm * tstepA; const char* cB = (const char*)g.Bt + (size_t)cur.pn * tstepB;
  PG8_STAGE(PG8_SB(0, 0), cB, voffB); PG8_STAGE(PG8_SA(0, 0), cA, voffA); PG8_STAGE(PG8_SB(0, 1), cB + hstepB, voffB); PG8_STAGE(PG8_SA(0, 1), cA + hstepA, voffA);
  if (wr == 1) PG8_BAR;
  PG8_WAIT_V(4); PG8_BAR;
  PG8_STAGE(PG8_SB(1, 0), cB + kstep, voffB); PG8_STAGE(PG8_SA(1, 0), cA + kstep, voffA); PG8_STAGE(PG8_SB(1, 1), cB + hstepB + kstep, voffB);
  PG8_WAIT_V(6); PG8_BAR;
  for (;;) {
    const bool has_next = S.next(ui + 1, nxt);
    const char* nA = has_next ? (const char*)g.A + (size_t)nxt.pm * tstepA : cA; const char* nB = has_next ? (const char*)g.Bt + (size_t)nxt.pn * tstepB : cB;
    for (int t = 0; t < nt; t += 2) {
      const bool last = (t == nt - 2);
      const char* a1 = cA + (size_t)(t + 1) * kstep;
      const char* a2 = last ? nA : cA + (size_t)(t + 2) * kstep; const char* b2 = last ? nB : cB + (size_t)(t + 2) * kstep;
      const char* a3 = a2 + kstep; const char* b3 = b2 + kstep;
      PG8_LDB(B0, 0, 0); PG8_SCHED; PG8_LDA(At, 0, 0); PG8_STAGE(PG8_SA(1, 1), a1 + hstepA, voffA);
      PG8_WAIT_L(8); PG8_BAR; PG8_WAIT_L(0); PG8_MMA(0, 0, At, B0); PG8_BAR; PG8_SCHED;
      PG8_LDB(B1, 0, 1); PG8_STAGE(PG8_SB(0, 0), b2, voffB);
      PG8_BAR; PG8_WAIT_L(0); PG8_MMA(0, 1, At, B1); PG8_BAR;
      PG8_LDA(At, 0, 1); PG8_STAGE(PG8_SA(0, 0), a2, voffA);
      PG8_BAR; PG8_WAIT_L(0); PG8_MMA(1, 0, At, B0); PG8_BAR; PG8_SCHED;
      PG8_STAGE(PG8_SB(0, 1), b2 + hstepB, voffB);
      PG8_WAIT_V(6); PG8_BAR; PG8_MMA(1, 1, At, B1); PG8_BAR;
      PG8_LDB(B0, 1, 0); PG8_SCHED; PG8_LDA(At, 1, 0); PG8_STAGE(PG8_SA(0, 1), a2 + hstepA, voffA);
      PG8_WAIT_L(8); PG8_BAR; PG8_WAIT_L(0); PG8_MMA(0, 0, At, B0); PG8_BAR; PG8_SCHED;
      PG8_LDB(B1, 1, 1); PG8_STAGE(PG8_SB(1, 0), b3, voffB);
      PG8_BAR; PG8_WAIT_L(0); PG8_MMA(0, 1, At, B1); PG8_BAR;
      PG8_LDA(At, 1, 1); PG8_STAGE(PG8_SA(1, 0), a3, voffA);
      PG8_BAR; PG8_WAIT_L(0); PG8_MMA(1, 0, At, B0); PG8_BAR; PG8_SCHED;
      PG8_STAGE(PG8_SB(1, 1), b3 + hstepB, voffB);
      PG8_WAIT_V(6); PG8_BAR; PG8_MMA(1, 1, At, B1); PG8_BAR;
    }
    E(acc, cur, wr, wc, fr, fq);
    if (!has_next) break;
#pragma unroll
    for (int a = 0; a < 2; ++a)
#pragma unroll
      for (int b = 0; b < 2; ++b)
#pragma unroll
        for (int m = 0; m < 4; ++m)
#pragma unroll
          for (int n = 0; n < 2; ++n) acc[a][b][m][n] = (f32x4){0.f, 0.f, 0.f, 0.f};
    cur = nxt; cA = nA; cB = nB; ++ui;
  }
  PG8_WAIT_V(0);
  if (wr == 0) PG8_BAR;
  PG8_BAR;
#undef PG8_SA
#undef PG8_SB
#undef PG8_STAGE
#undef PG8_LDA
#undef PG8_LDB
#undef PG8_MMA
#undef PG8_WAIT_V
#undef PG8_WAIT_L
#undef PG8_BAR
#undef PG8_SCHED
}

struct EpiEvenIn {
  static constexpr bool PERM = true, TRANS = true;
  ushort_t* ps5; ushort_t* prw;
  DEVI void operator()(const f32x4 (&acc)[2][2][4][2], const Unit& u, int wr, int wc, int fr, int fq) const {
#pragma unroll
    for (int ai = 0; ai < 2; ++ai)
#pragma unroll
      for (int m = 0; m < 4; ++m) {
        const size_t row = (size_t)u.pm * BM + ai * HALF + wr * 64 + m * 16 + fr;
#pragma unroll
        for (int bj = 0; bj < 2; ++bj) {
          const int c0 = u.pn * BM + bj * HALF + wc * 32 + 8 * fq;
          const f32x4 v0 = acc[ai][bj][m][0], v1 = acc[ai][bj][m][1];
          u32x4 o = {cvt_pk_bf16(v0[0], v0[1]), cvt_pk_bf16(v0[2], v0[3]), cvt_pk_bf16(v1[0], v1[1]), cvt_pk_bf16(v1[2], v1[3])};
          if (c0 < 1024) *(u32x4*)(ps5 + row * 1024 + c0) = o;
          else if (c0 < 3136) *(u32x4*)(prw + row * 2112 + (c0 - 1024)) = o;
        }
      }
  }
};
struct EpiHyIn {
  static constexpr bool PERM = false, TRANS = false;
  ushort_t* ph;
  DEVI void operator()(const f32x4 (&acc)[2][2][4][2], const Unit& u, int wr, int wc, int fr, int fq) const {
    int s0, L; seq_of(u.pm * BM, s0, L);
#pragma unroll
    for (int ai = 0; ai < 2; ++ai)
#pragma unroll
      for (int m = 0; m < 4; ++m) {
        const int tok = u.pm * BM + ai * HALF + wr * 64 + m * 16 + 4 * fq;
#pragma unroll
        for (int bj = 0; bj < 2; ++bj)
#pragma unroll
          for (int n = 0; n < 2; ++n) {
            const int col = u.pn * BM + bj * HALF + wc * 32 + 16 * n + fr;
            const int st = col >> 10, c = col & 1023;
            const f32x4 v = acc[ai][bj][m][n];
            ushort_t* dst = ph + (size_t)st * T * 1024 + (size_t)s0 * 1024 + (size_t)c * L + (tok - s0);
            *(uint2*)dst = uint2{cvt_pk_bf16(v[0], v[1]), cvt_pk_bf16(v[2], v[3])};
          }
      }
  }
};
struct EpiGlu {
  static constexpr bool PERM = true, TRANS = true;
  ushort_t* y; const ushort_t* ps5; const float* bias;
  DEVI void operator()(const f32x4 (&acc)[2][2][4][2], const Unit& u, int wr, int wc, int fr, int fq) const {
#pragma unroll
    for (int ai = 0; ai < 2; ++ai)
#pragma unroll
      for (int m = 0; m < 4; ++m) {
        const size_t row = (size_t)u.pm * BM + ai * HALF + wr * 64 + m * 16 + fr;
#pragma unroll
        for (int bj = 0; bj < 2; ++bj) {
          const int c0 = u.pn * BM + bj * HALF + wc * 32 + 8 * fq;
          const u32x4 a8 = *(const u32x4*)(y + row * 1024 + 512 + c0);
          const u32x4 g8 = *(const u32x4*)(ps5 + row * 1024 + 512 + c0);
          const f32x4 b0 = *(const f32x4*)(bias + c0), b1 = *(const f32x4*)(bias + c0 + 4);
          float v[8];
#pragma unroll
          for (int e = 0; e < 4; ++e) { v[e] = acc[ai][bj][m][0][e] + b0[e]; v[4 + e] = acc[ai][bj][m][1][e] + b1[e]; }
          unsigned o[4];
#pragma unroll
          for (int e = 0; e < 4; ++e) {
            const float a_lo = __uint_as_float(a8[e] << 16), a_hi = __uint_as_float(a8[e] & 0xffff0000u);
            const float g_lo = __uint_as_float(g8[e] << 16), g_hi = __uint_as_float(g8[e] & 0xffff0000u);
            const float r_lo = a_lo * sigmoidf_(v[2 * e]) * (g_lo * sigmoidf_(g_lo));
            const float r_hi = a_hi * sigmoidf_(v[2 * e + 1]) * (g_hi * sigmoidf_(g_hi));
            o[e] = cvt_pk_bf16(r_lo, r_hi);
          }
          *(u32x4*)(y + row * 1024 + c0) = u32x4{o[0], o[1], o[2], o[3]};
        }
      }
  }
};
struct EpiF32 {
  static constexpr bool PERM = false, TRANS = true;
  float* C;
  DEVI void operator()(const f32x4 (&acc)[2][2][4][2], const Unit& u, int wr, int wc, int fr, int fq) const {
#pragma unroll
    for (int ai = 0; ai < 2; ++ai)
#pragma unroll
      for (int m = 0; m < 4; ++m) {
        float* rowp = C + ((size_t)u.pm * BM + ai * HALF + wr * 64 + m * 16 + fr) * 1024 + u.pn * BM + wc * 32 + 4 * fq;
#pragma unroll
        for (int bj = 0; bj < 2; ++bj)
#pragma unroll
          for (int n = 0; n < 2; ++n) *(f32x4*)(rowp + bj * HALF + n * 16) = acc[ai][bj][m][n];
      }
  }
};
}

template <class Epi>
DEVI void run_gemm(unsigned char* lds, const ushort_t* A, int lda, const ushort_t* Bt, int N, int K, const Epi& E) {
  pg8::Gemm g; g.A = A; g.Bt = Bt; g.M = T; g.N = N; g.K = K; g.lda = lda;
  pg8::StaticOrder S; S.init(T, N, (int)gridDim.x, bidx());
  __syncthreads();
  pg8::gemm_phase<Epi>((PG8_LAS unsigned char*)lds, g, S, E);
  __syncthreads();
}

__device__ void xb_convert(const Params& p, ushort_t* XB) {
  const size_t n4 = (size_t)T * 1024 / 4, np4 = (size_t)TPROMPT * 1024 / 4;
  const float4* xp = (const float4*)p.in[I_XP]; const float4* xs = (const float4*)p.in[I_XS];
  for (size_t e = (size_t)bidx() * NT + tidx(); e < n4; e += (size_t)gridDim.x * NT) {
    const float4 v = e < np4 ? xp[e] : xs[e - np4];
    ((uint2*)XB)[e] = uint2{pack2(v.x, v.y), pack2(v.z, v.w)};
  }
}
__device__ void zero_fill(ushort_t* dst, size_t n) {
  for (size_t e = (size_t)bidx() * NT + tidx(); e < n / 8; e += (size_t)gridDim.x * NT) ((uint4*)dst)[e] = uint4{0, 0, 0, 0};
}
__device__ void hy_transpose(const ushort_t* __restrict__ PH3, ushort_t* __restrict__ Y, unsigned char* lds) {
  ushort_t* tile = (ushort_t*)lds;
  const int tid = tidx(), j = tid & 63, i0 = tid >> 6;
  for (int t = bidx(); t < (T / 64) * 16; t += gridDim.x) {
    const int tok0 = (t >> 4) * 64, c0 = (t & 15) * 64;
    int s0, L; seq_of(tok0, s0, L);
    __syncthreads();
#pragma unroll
    for (int e = 0; e < 8; ++e) { const int i = i0 + 8 * e; tile[i * 66 + j] = PH3[(size_t)s0 * 1024 + (size_t)(c0 + i) * L + (tok0 - s0) + j]; }
    __syncthreads();
#pragma unroll
    for (int e = 0; e < 8; ++e) { const int i = i0 + 8 * e; Y[(size_t)(tok0 + i) * 1024 + c0 + j] = tile[j * 66 + i]; }
  }
}

__device__ void ln_phase(const Params& p, int layer, const float* __restrict__ F, ushort_t* __restrict__ XB, bool dry = false) {
  const int lane = tidx() & 63, gw = bidx() * (NT / 64) + (tidx() >> 6), nw = gridDim.x * (NT / 64);
  const float alpha = 1.681792830507429f;
  const float4* g4 = (const float4*)(p.in[I_LNG] + layer * 1024);
  const float4* b4 = (const float4*)(p.in[I_LNB] + layer * 1024);
  const XSrc xs_ = xsrc(p);
  for (int row = gw; row < T; row += nw) {
    const float4* x4 = (const float4*)xrow(xs_, layer, row);
    const float4* f4 = (const float4*)(F + (size_t)row * 1024);
    float4 v[4];
    float s = 0.f;
#pragma unroll
    for (int e = 0; e < 4; ++e) {
      float4 a = x4[lane + 64 * e], f = f4[lane + 64 * e];
      v[e] = float4{alpha * a.x + f.x, alpha * a.y + f.y, alpha * a.z + f.z, alpha * a.w + f.w};
      s += v[e].x + v[e].y + v[e].z + v[e].w;
    }
    const float mean = wsum(s) * (1.f / 1024.f);
    float q = 0.f;
#pragma unroll
    for (int e = 0; e < 4; ++e) {
      v[e].x -= mean; v[e].y -= mean; v[e].z -= mean; v[e].w -= mean;
      q += v[e].x * v[e].x + v[e].y * v[e].y + v[e].z * v[e].z + v[e].w * v[e].w;
    }
    const float rs = rsqrtf(wsum(q) * (1.f / 1024.f) + 1e-5f);
    float4* o4 = (float4*)(p.out + (size_t)row * 1024);
#pragma unroll
    for (int e = 0; e < 4; ++e) {
      float4 g = g4[lane + 64 * e], b = b4[lane + 64 * e];
      const float4 o = float4{v[e].x * rs * g.x + b.x, v[e].y * rs * g.y + b.y, v[e].z * rs * g.z + b.z, v[e].w * rs * g.w + b.w};
      if (!dry) o4[lane + 64 * e] = o;
      if (XB) ((uint2*)(XB + (size_t)row * 1024))[lane + 64 * e] = uint2{pack2(o.x, o.y), pack2(o.z, o.w)};
    }
  }
}

struct cplx { float x, y; };
DEVI cplx cmul(cplx a, cplx b) { return cplx{a.x * b.x - a.y * b.y, a.x * b.y + a.y * b.x}; }
DEVI void s5_consts(const Params& p, int i, int d, int g, int n, cplx& lb, cplx& coef) {
  const int idx = ((i * 2 + d) * 32 + g) * 64 + n;
  const float lre = p.in[I_LRE][idx], lim = p.in[I_LIM][idx];
  const float dt = expf(p.in[I_LSTEP][(i * 2 + d) * 32 + g]);
  const float mag = expf(lre * dt);
  float sn, cs; sincosf(lim * dt, &sn, &cs);
  lb = cplx{mag * cs, mag * sn};
  const float nr = lb.x - 1.f, ni = lb.y, den = 1.f / (lre * lre + lim * lim);
  coef = cplx{(nr * lre + ni * lim) * den, (ni * lre - nr * lim) * den};
}
DEVI void s5_stage_u(const ushort_t* PS5, int tok0, int g, float* U, int lane) {
  const uint4* src = (const uint4*)(PS5 + (size_t)(tok0 + lane) * 1024 + g * 16);
  uint4 a = src[0], b = src[1];
  float4* d = (float4*)(U + lane * 16);
  d[0] = float4{__uint_as_float(a.x << 16), __uint_as_float(a.x & 0xffff0000u), __uint_as_float(a.y << 16), __uint_as_float(a.y & 0xffff0000u)};
  d[1] = float4{__uint_as_float(a.z << 16), __uint_as_float(a.z & 0xffff0000u), __uint_as_float(a.w << 16), __uint_as_float(a.w & 0xffff0000u)};
  d[2] = float4{__uint_as_float(b.x << 16), __uint_as_float(b.x & 0xffff0000u), __uint_as_float(b.y << 16), __uint_as_float(b.y & 0xffff0000u)};
  d[3] = float4{__uint_as_float(b.z << 16), __uint_as_float(b.z & 0xffff0000u), __uint_as_float(b.w << 16), __uint_as_float(b.w & 0xffff0000u)};
}
#define S5_BU(Urow, bur, bui)                                                         \
  {                                                                                   \
    const float4* u4 = (const float4*)(Urow);                                         \
    bur = 0.f; bui = 0.f;                                                             \
    _Pragma("unroll") for (int pp = 0; pp < 4; ++pp) {                                \
      float4 u = u4[pp];                                                              \
      bur += Br[4 * pp] * u.x + Br[4 * pp + 1] * u.y + Br[4 * pp + 2] * u.z + Br[4 * pp + 3] * u.w; \
      bui += Bi[4 * pp] * u.x + Bi[4 * pp + 1] * u.y + Bi[4 * pp + 2] * u.z + Bi[4 * pp + 3] * u.w; \
    }                                                                                 \
  }

__device__ void s5_passA(const Params& p, int i, unsigned char* lds) {
  const ushort_t* PS5 = (const ushort_t*)(p.ws + OFF_PS5);
  cplx* CAR = (cplx*)(p.ws + OFF_CAR);
  const int lane = tidx() & 63, wave = tidx() >> 6;
  float* U = (float*)(lds + wave * 8448);
  for (int item = bidx() * 8 + wave; item < 192 * 32; item += gridDim.x * 8) {
    const int q = item >> 5, g = item & 31;
    cplx lb0, c0, lb1, c1;
    s5_consts(p, i, 0, g, lane, lb0, c0);
    s5_consts(p, i, 1, g, lane, lb1, c1);
    float Br[16], Bi[16];
#pragma unroll
    for (int pp = 0; pp < 16; ++pp) { Br[pp] = p.in[I_BRE][((i * 32 + g) * 64 + lane) * 16 + pp]; Bi[pp] = p.in[I_BIM][((i * 32 + g) * 64 + lane) * 16 + pp]; }
    cplx xf{0.f, 0.f}, xb{0.f, 0.f}, pw{1.f, 0.f};
    for (int sb = 0; sb < 4; ++sb) {
      wave_sync();
      s5_stage_u(PS5, q * 256 + sb * 64, g, U, lane);
      wave_sync();
      for (int t = 0; t < 64; ++t) {
        float bur, bui;
        S5_BU(U + t * 16, bur, bui);
        xf = cmul(lb0, xf); xf.x += bur; xf.y += bui;
        xb.x += pw.x * bur - pw.y * bui; xb.y += pw.x * bui + pw.y * bur;
        pw = cmul(pw, lb1);
      }
    }
    CAR[((size_t)(q * 32 + g) * 2 + 0) * 64 + lane] = cmul(xf, c0);
    CAR[((size_t)(q * 32 + g) * 2 + 1) * 64 + lane] = cmul(xb, c1);
  }
}

__device__ void s5_passC(const Params& p, int i, unsigned char* lds) {
  const ushort_t* PS5 = (const ushort_t*)(p.ws + OFF_PS5);
  const cplx* CAR = (const cplx*)(p.ws + OFF_CAR);
  float* YS = (float*)(p.ws + OFF_YS);
  ushort_t* YG = (ushort_t*)(p.ws + OFF_Y);
  const int lane = tidx() & 63, wave = tidx() >> 6;
  float* U = (float*)(lds + wave * 8448);
  ushort_t* X = (ushort_t*)(lds + wave * 8448 + 4096);
  for (int item = bidx() * 8 + wave; item < 192 * 32; item += gridDim.x * 8) {
    const int q = item >> 5, g = item & 31;
    int cs, ce;
    if (q < 64) { cs = q & ~15; ce = cs + 16; } else { cs = 64 + ((q - 64) & ~63); ce = cs + 64; }
    float Br[16], Bi[16];
#pragma unroll
    for (int pp = 0; pp < 16; ++pp) { Br[pp] = p.in[I_BRE][((i * 32 + g) * 64 + lane) * 16 + pp]; Bi[pp] = p.in[I_BIM][((i * 32 + g) * 64 + lane) * 16 + pp]; }
    const int pcol = lane & 15;
    const float dd = p.in[I_S5D][i * 512 + g * 16 + pcol];
    for (int d = 0; d < 2; ++d) {
      cplx lb, coef;
      s5_consts(p, i, d, g, lane, lb, coef);
      cplx lp = lb;
#pragma unroll
      for (int e = 0; e < 8; ++e) lp = cmul(lp, lp);
      cplx xs{0.f, 0.f};
      if (d == 0) { for (int j = cs; j < q; ++j) { xs = cmul(lp, xs); cplx c = CAR[((size_t)(j * 32 + g) * 2 + 0) * 64 + lane]; xs.x += c.x; xs.y += c.y; } }
      else { for (int j = ce - 1; j > q; --j) { xs = cmul(lp, xs); cplx c = CAR[((size_t)(j * 32 + g) * 2 + 1) * 64 + lane]; xs.x += c.x; xs.y += c.y; } }
      bf16x8 cf[4];
#pragma unroll
      for (int kk = 0; kk < 4; ++kk) {
        const int n0 = (kk & 1) * 32 + (lane >> 4) * 8;
        const float* src = (kk < 2 ? p.in[I_CRE] : p.in[I_CIM]) + (((size_t)(i * 2 + d) * 32 + g) * 16 + pcol) * 64 + n0;
        const float sg = kk < 2 ? 1.f : -1.f;
#pragma unroll
        for (int j = 0; j < 8; ++j) cf[kk][j] = (short)f2bf(sg * src[j]);
      }
      for (int sbi = 0; sbi < 4; ++sbi) {
        const int sb = d ? 3 - sbi : sbi;
        wave_sync();
        s5_stage_u(PS5, q * 256 + sb * 64, g, U, lane);
        wave_sync();
        for (int tbi = 0; tbi < 4; ++tbi) {
          const int tb = d ? 3 - tbi : tbi;
          for (int tti = 0; tti < 16; ++tti) {
            const int tt = d ? 15 - tti : tti;
            float bur, bui;
            S5_BU(U + (tb * 16 + tt) * 16, bur, bui);
            xs = cmul(lb, xs);
            xs.x += coef.x * bur - coef.y * bui;
            xs.y += coef.x * bui + coef.y * bur;
            X[tt * 136 + lane] = f2bf(xs.x);
            X[tt * 136 + 64 + lane] = f2bf(xs.y);
          }
          wave_sync();
          f32x4 acc{0.f, 0.f, 0.f, 0.f};
#pragma unroll
          for (int kk = 0; kk < 4; ++kk) {
            bf16x8 a = *(const bf16x8*)(X + (lane & 15) * 136 + kk * 32 + (lane >> 4) * 8);
            acc = __builtin_amdgcn_mfma_f32_16x16x32_bf16(a, cf[kk], acc, 0, 0, 0);
          }
          wave_sync();
#pragma unroll
          for (int r = 0; r < 4; ++r) {
            const int tl = tb * 16 + (lane >> 4) * 4 + r;
            const size_t o = (size_t)(q * 256 + sb * 64 + tl) * 512 + g * 16 + pcol;
            if (d == 0) YS[o] = acc[r] + dd * U[tl * 16 + pcol];
            else {
              const float yv = YS[o] + acc[r];
              YG[(size_t)(q * 256 + sb * 64 + tl) * 1024 + 512 + g * 16 + pcol] = f2bf(gelu_tanh(yv));
            }
          }
        }
      }
    }
  }
}

struct RwConst { float mur, muk, muv, mul, w0, a0, kk, ka; };
struct RwRow { float r, k, v, l; };
DEVI RwRow rw_load_row(const ushort_t* PRW, int tok, int s0, int L, int h, int lane) {
  RwRow o{0.f, 0.f, 0.f, 0.f};
  if (tok >= s0 && tok < s0 + L) {
    const ushort_t* row = PRW + (size_t)tok * 2112;
    const int cc = h * 64 + lane;
    o.r = bf2f(row[cc]); o.k = bf2f(row[512 + cc]); o.v = bf2f(row[1024 + cc]); o.l = bf2f(row[2048 + lane]);
  }
  return o;
}
DEVI void rw_prologue(const RwRow& rm, const RwRow& rc, const RwRow& rn, int lane, const RwConst& c, const float* WU, const float* AU,
                      float* LT, float* Wd, float* KKd, float* BBd, float* KDd, float* RRd, float* VVd) {
  const float rr = rc.r + c.mur * (0.5f * (rm.r + rn.r) - rc.r);
  const float kx = rc.k + c.muk * (0.5f * (rm.k + rn.k) - rc.k);
  const float vv = rc.v + c.muv * (0.5f * (rm.v + rn.v) - rc.v);
  float ll = rc.l + c.mul * (0.5f * (rm.l + rn.l) - rc.l);
  ll = lane < 32 ? fast_tanh(ll) : ll;
  wave_sync();
  LT[lane] = ll;
  wave_sync();
  float accw = c.w0, acca = c.a0;
#pragma unroll 2
  for (int j = 0; j < 32; j += 4) {
    float4 lw = *(const float4*)(LT + j), la = *(const float4*)(LT + 32 + j);
    accw += lw.x * WU[(j + 0) * 64 + lane] + lw.y * WU[(j + 1) * 64 + lane] + lw.z * WU[(j + 2) * 64 + lane] + lw.w * WU[(j + 3) * 64 + lane];
    acca += la.x * AU[(j + 0) * 64 + lane] + la.y * AU[(j + 1) * 64 + lane] + la.z * AU[(j + 2) * 64 + lane] + la.w * AU[(j + 3) * 64 + lane];
  }
  const float dec = __builtin_amdgcn_exp2f(-0.8750387749145276f * fast_sigmoid(accw));
  const float a = fast_sigmoid(acca);
  const float kkr = kx * c.kk;
  const float ss = wsum_fast(kkr * kkr);
  const float kkn = kkr * __builtin_amdgcn_rsqf(fmaxf(ss, 1e-24f));
  Wd[lane] = dec; KKd[lane] = kkn; BBd[lane] = kkn * a; KDd[lane] = kx * (1.f + (a - 1.f) * c.ka); RRd[lane] = rr; VVd[lane] = vv;
}

typedef float f32x2 __attribute__((ext_vector_type(2)));
DEVI float dpp_f(float x, const int ctrl_sel) {
  int xi = __builtin_bit_cast(int, x), r;
  if (ctrl_sel == 0) r = __builtin_amdgcn_mov_dpp(xi, 0xB1, 0xf, 0xf, true);
  else if (ctrl_sel == 1) r = __builtin_amdgcn_mov_dpp(xi, 0x4E, 0xf, 0xf, true);
  else r = __builtin_amdgcn_mov_dpp(xi, 0x141, 0xf, 0xf, true);
  return __builtin_bit_cast(float, r);
}
DEVI float red8(float x) { x += dpp_f(x, 0); x += dpp_f(x, 1); x += dpp_f(x, 2); return x; }

#define RW_LOAD8(dst2, base)                                                        \
  { const float4 _a = *(const float4*)(base), _b = *(const float4*)((base) + 4);    \
    dst2[0] = f32x2{_a.x, _a.y}; dst2[1] = f32x2{_a.z, _a.w}; dst2[2] = f32x2{_b.x, _b.y}; dst2[3] = f32x2{_b.z, _b.w}; }

__device__ void rwkv_scan1(const Params& p, int i, unsigned char* lds) {
  const ushort_t* PRW = (const ushort_t*)(p.ws + OFF_PRW);
  float* CH = (float*)(p.ws + OFF_PS5);
  float* YR = (float*)(p.ws + OFF_YS);
  const int tid = tidx(), lane = tid & 63, wave = tid >> 6, pair = wave >> 1, role = wave & 1;
  const int vq = lane >> 3, kq = lane & 7;
  float* TAB = (float*)lds;
  float* WV = (float*)(lds + 24576 + pair * 12800);
  float* Wd = WV, *KKd = WV + 512, *BBd = WV + 1024, *KDd = WV + 1536, *RRd = WV + 2048, *VVd = WV + 2560, *LT = WV + 3072 + role * 64;
  {
    float4* z = (float4*)YR;
    for (size_t e = (size_t)bidx() * NT + tid; e < (size_t)T * 512 / 4; e += (size_t)gridDim.x * NT) z[e] = float4{0.f, 0.f, 0.f, 0.f};
  }
  for (int bi = bidx(); bi < 768; bi += gridDim.x) {
    const int h = bi / 96, rem = bi % 96;
    const int dir = pair >> 1, q = rem * 2 + (pair & 1);
    __syncthreads();
    for (int e = tid; e < 3 * 2048; e += NT) {
      const int which = e >> 11, j = (e >> 6) & 31, c = e & 63;
      TAB[e] = which < 2 ? p.in[I_WUP][((size_t)(i * 2 + which) * 32 + j) * 512 + h * 64 + c] : p.in[I_AUP][((size_t)i * 32 + j) * 512 + h * 64 + c];
    }
    __syncthreads();
    const float* WU = TAB + dir * 2048;
    const float* AU = TAB + 2 * 2048;
    RwConst c;
    const int cc = h * 64 + lane;
    c.mur = p.in[I_MURKV][(i * 3 + 0) * 512 + cc]; c.muk = p.in[I_MURKV][(i * 3 + 1) * 512 + cc]; c.muv = p.in[I_MURKV][(i * 3 + 2) * 512 + cc];
    c.mul = p.in[I_MULORA][i * 64 + lane];
    c.w0 = p.in[I_W0][(i * 2 + dir) * 512 + cc]; c.a0 = p.in[I_A0][(i * 2 + dir) * 512 + cc];
    c.kk = p.in[I_KK][i * 512 + cc]; c.ka = p.in[I_KA][i * 512 + cc];
    const size_t it = ((size_t)(q * 8 + h) * 2 + dir);
    int sq0, sqL; seq_of(q * 256, sq0, sqL);
    float* Op = CH + it * 8192 + (role ? 0 : 4096);
    f32x2 S2[8][4];
    int diag = (role && vq == kq) ? 1 : 0;
    asm volatile("" : "+v"(diag));
#pragma unroll
    for (int r = 0; r < 8; ++r)
#pragma unroll
      for (int jj = 0; jj < 4; ++jj) S2[r][jj] = f32x2{(diag && (2 * jj == r)) ? 1.f : 0.f, (diag && (2 * jj + 1 == r)) ? 1.f : 0.f};
    const float vsel = role ? 0.f : 1.f;
    for (int blk = 0; blk < 32; ++blk) {
      {
        RwRow R[6];
#pragma unroll
        for (int j = 0; j < 6; ++j) {
          const int st = blk * 8 + role * 4 + j - 1;
          R[j] = rw_load_row(PRW, dir ? (q * 256 + 255 - st) : (q * 256 + st), sq0, sqL, h, lane);
        }
#pragma unroll
        for (int e = 0; e < 4; ++e) {
          const int s = role * 4 + e;
          rw_prologue(R[e], R[e + 1], R[e + 2], lane, c, WU, AU, LT, Wd + s * 64, KKd + s * 64, BBd + s * 64, KDd + s * 64, RRd + s * 64, VVd + s * 64);
        }
      }
      __syncthreads();
#pragma unroll 1
      for (int s = 0; s < 8; ++s) {
        f32x2 kk2[4], w2[4], b2[4], kd2[4], vv2[4];
        RW_LOAD8(kk2, KKd + s * 64 + 8 * kq);
        RW_LOAD8(vv2, VVd + s * 64 + 8 * vq);
        RW_LOAD8(w2, Wd + s * 64 + 8 * kq);
        RW_LOAD8(b2, BBd + s * 64 + 8 * kq);
        RW_LOAD8(kd2, KDd + s * 64 + 8 * kq);
        float sa[8];
#pragma unroll
        for (int r = 0; r < 8; ++r) {
          f32x2 a = S2[r][0] * kk2[0];
          a = S2[r][1] * kk2[1] + a; a = S2[r][2] * kk2[2] + a; a = S2[r][3] * kk2[3] + a;
          sa[r] = -red8(a.x + a.y);
        }
#pragma unroll
        for (int r = 0; r < 8; ++r) {
          const float vr = ((r & 1) ? vv2[r >> 1].y : vv2[r >> 1].x) * vsel;
          const f32x2 sa2 = f32x2{sa[r], sa[r]}, v2 = f32x2{vr, vr};
#pragma unroll
          for (int jj = 0; jj < 4; ++jj) S2[r][jj] = S2[r][jj] * w2[jj] + sa2 * b2[jj] + v2 * kd2[jj];
        }
      }
      __syncthreads();
    }
#pragma unroll
    for (int r = 0; r < 8; ++r) {
      float* dst = Op + (8 * vq + r) * 64 + 8 * kq;
      *(float4*)dst = float4{S2[r][0].x, S2[r][0].y, S2[r][1].x, S2[r][1].y};
      *(float4*)(dst + 4) = float4{S2[r][2].x, S2[r][2].y, S2[r][3].x, S2[r][3].y};
    }
  }
}

__device__ void rwkv_scan3(const Params& p, int i, unsigned char* lds, bool dry = false) {
  const ushort_t* PRW = (const ushort_t*)(p.ws + OFF_PRW);
  float* CH = (float*)(p.ws + OFF_PS5);
  float* YR = (float*)(p.ws + OFF_YS);
  const int tid = tidx(), lane = tid & 63, wave = tid >> 6;
  const int vq = lane >> 3, kq = lane & 7;
  float* TAB = (float*)lds;
  float* WV = (float*)(lds + 24576 + wave * 12544);
  float* Wd = WV, *KKd = WV + 512, *BBd = WV + 1024, *KDd = WV + 1536, *RRd = WV + 2048, *VVd = WV + 2560, *LT = WV + 3072;
  for (int bi = bidx(); bi < 384; bi += gridDim.x) {
    const int h = bi / 48, cgp = bi % 48;
    const int dir = wave >> 2, q = cgp * 4 + (wave & 3);
    __syncthreads();
    for (int e = tid; e < 3 * 2048; e += NT) {
      const int which = e >> 11, j = (e >> 6) & 31, c = e & 63;
      TAB[e] = which < 2 ? p.in[I_WUP][((size_t)(i * 2 + which) * 32 + j) * 512 + h * 64 + c] : p.in[I_AUP][((size_t)i * 32 + j) * 512 + h * 64 + c];
    }
    __syncthreads();
    const float* WU = TAB + dir * 2048;
    const float* AU = TAB + 2 * 2048;
    RwConst c;
    const int cc = h * 64 + lane;
    c.mur = p.in[I_MURKV][(i * 3 + 0) * 512 + cc]; c.muk = p.in[I_MURKV][(i * 3 + 1) * 512 + cc]; c.muv = p.in[I_MURKV][(i * 3 + 2) * 512 + cc];
    c.mul = p.in[I_MULORA][i * 64 + lane];
    c.w0 = p.in[I_W0][(i * 2 + dir) * 512 + cc]; c.a0 = p.in[I_A0][(i * 2 + dir) * 512 + cc];
    c.kk = p.in[I_KK][i * 512 + cc]; c.ka = p.in[I_KA][i * 512 + cc];
    const size_t it = ((size_t)(q * 8 + h) * 2 + dir);
    int sq0, sqL; seq_of(q * 256, sq0, sqL);
    const float* Qp = CH + it * 8192 + 4096;
    f32x2 S2[8][4];
#pragma unroll
    for (int r = 0; r < 8; ++r) {
      const float* src = Qp + (8 * vq + r) * 64 + 8 * kq;
      const float4 a = *(const float4*)src, b = *(const float4*)(src + 4);
      S2[r][0] = f32x2{a.x, a.y}; S2[r][1] = f32x2{a.z, a.w}; S2[r][2] = f32x2{b.x, b.y}; S2[r][3] = f32x2{b.z, b.w};
    }
    for (int blk = 0; blk < 32; ++blk) {
      {
        RwRow R[10];
#pragma unroll
        for (int j = 0; j < 10; ++j) {
          const int st = blk * 8 + j - 1;
          R[j] = rw_load_row(PRW, dir ? (q * 256 + 255 - st) : (q * 256 + st), sq0, sqL, h, lane);
        }
#pragma unroll
        for (int s = 0; s < 8; ++s)
          rw_prologue(R[s], R[s + 1], R[s + 2], lane, c, WU, AU, LT, Wd + s * 64, KKd + s * 64, BBd + s * 64, KDd + s * 64, RRd + s * 64, VVd + s * 64);
      }
      wave_sync();
#pragma unroll 1
      for (int s = 0; s < 8; ++s) {
        f32x2 kk2[4], w2[4], b2[4], kd2[4], vv2[4], r2[4];
        RW_LOAD8(kk2, KKd + s * 64 + 8 * kq);
        RW_LOAD8(vv2, VVd + s * 64 + 8 * vq);
        RW_LOAD8(w2, Wd + s * 64 + 8 * kq);
        RW_LOAD8(b2, BBd + s * 64 + 8 * kq);
        RW_LOAD8(kd2, KDd + s * 64 + 8 * kq);
        RW_LOAD8(r2, RRd + s * 64 + 8 * kq);
        float sa[8];
#pragma unroll
        for (int r = 0; r < 8; ++r) {
          f32x2 a = S2[r][0] * kk2[0];
          a = S2[r][1] * kk2[1] + a; a = S2[r][2] * kk2[2] + a; a = S2[r][3] * kk2[3] + a;
          sa[r] = -red8(a.x + a.y);
        }
        float ysel = 0.f;
#pragma unroll
        for (int r = 0; r < 8; ++r) {
          const float vr = (r & 1) ? vv2[r >> 1].y : vv2[r >> 1].x;
          const f32x2 sa2 = f32x2{sa[r], sa[r]}, v2 = f32x2{vr, vr};
          f32x2 ya = f32x2{0.f, 0.f};
#pragma unroll
          for (int jj = 0; jj < 4; ++jj) {
            S2[r][jj] = S2[r][jj] * w2[jj] + sa2 * b2[jj] + v2 * kd2[jj];
            ya = S2[r][jj] * r2[jj] + ya;
          }
          const float yr = red8(ya.x + ya.y);
          ysel = (kq == r) ? yr : ysel;
        }
        const int st = blk * 8 + s;
        const int tok = dir ? (q * 256 + 255 - st) : (q * 256 + st);
        if (!dry) atomicAdd(YR + (size_t)tok * 512 + h * 64 + lane, ysel);
      }
      wave_sync();
    }
  }
}

__device__ void rwkv_carry(const Params& p, unsigned char* lds, bool dry = false) {
  float* CH = (float*)(p.ws + OFF_PS5);
  float* Ps = (float*)lds;
  float* Ss = Ps + 4096;
  const int tid = tidx(), v = tid >> 4, ks = (tid & 15) * 4;
  for (int bi = bidx(); bi < 192; bi += gridDim.x) {
    const int half = bi & 1, dir = (bi >> 1) & 1, h = (bi >> 2) & 7, s = bi >> 5;
    int cs, n;
    if (s < 4) { cs = s * 16; n = 16; } else { cs = 64 + (s - 4) * 64; n = 64; }
    float4 cur{0.f, 0.f, 0.f, 0.f};
    float4 pq0, pq1, qv;
    {
      const int q = dir ? (cs + n - 1) : cs;
      const float* Pp = CH + ((size_t)(q * 8 + h) * 2 + dir) * 8192;
      pq0 = ((const float4*)Pp)[tid]; pq1 = ((const float4*)Pp)[tid + 512];
      qv = *(const float4*)(Pp + 4096 + (half * 32 + v) * 64 + ks);
    }
    for (int ci = 0; ci < n; ++ci) {
      const int q = dir ? (cs + n - 1 - ci) : (cs + ci);
      float* Pp = CH + ((size_t)(q * 8 + h) * 2 + dir) * 8192;
      float* Qrow = Pp + 4096 + (half * 32 + v) * 64 + ks;
      __syncthreads();
      if (!dry) *(float4*)Qrow = cur;
      if (ci == n - 1) break;
      *(float4*)(Ss + v * 64 + ks) = cur;
      ((float4*)Ps)[tid] = pq0;
      ((float4*)Ps)[tid + 512] = pq1;
      float4 acc = qv;
      if (ci + 2 < n + 1 && ci + 1 < n) {
        const int qn = dir ? (cs + n - 2 - ci) : (cs + ci + 1);
        const float* Pn = CH + ((size_t)(qn * 8 + h) * 2 + dir) * 8192;
        pq0 = ((const float4*)Pn)[tid]; pq1 = ((const float4*)Pn)[tid + 512];
        qv = *(const float4*)(Pn + 4096 + (half * 32 + v) * 64 + ks);
      }
      __syncthreads();
#pragma unroll 8
      for (int j = 0; j < 64; ++j) {
        const float sv = Ss[v * 64 + j];
        const float4 pr = *(const float4*)(Ps + j * 64 + ks);
        acc.x += sv * pr.x; acc.y += sv * pr.y; acc.z += sv * pr.z; acc.w += sv * pr.w;
      }
      cur = acc;
    }
    __syncthreads();
  }
}

__device__ void rwkv_post(const Params& p, int i) {
  const ushort_t* PRW = (const ushort_t*)(p.ws + OFF_PRW);
  const float* YR = (const float*)(p.ws + OFF_YS);
  ushort_t* Y = (ushort_t*)(p.ws + OFF_Y);
  const int lane = tidx() & 63, gw = bidx() * 8 + (tidx() >> 6), nw = gridDim.x * 8;
  for (int item = gw; item < T * 8; item += nw) {
    const int tok = item >> 3, h = item & 7, cc = h * 64 + lane;
    int s0, L; seq_of(tok, s0, L);
    const ushort_t* row = PRW + (size_t)tok * 2112;
    const bool hm = tok > s0, hp = tok + 1 < s0 + L;
    float r0 = bf2f(row[cc]), k0 = bf2f(row[512 + cc]), v0 = bf2f(row[1024 + cc]);
    float rn = 0.f, kn = 0.f, vn = 0.f;
    if (hm) { const ushort_t* r2 = row - 2112; rn += bf2f(r2[cc]); kn += bf2f(r2[512 + cc]); vn += bf2f(r2[1024 + cc]); }
    if (hp) { const ushort_t* r2 = row + 2112; rn += bf2f(r2[cc]); kn += bf2f(r2[512 + cc]); vn += bf2f(r2[1024 + cc]); }
    const float rr = r0 + p.in[I_MURKV][(i * 3 + 0) * 512 + cc] * (0.5f * rn - r0);
    const float kx = k0 + p.in[I_MURKV][(i * 3 + 1) * 512 + cc] * (0.5f * kn - k0);
    const float vv = v0 + p.in[I_MURKV][(i * 3 + 2) * 512 + cc] * (0.5f * vn - v0);
    const float y = YR[(size_t)tok * 512 + cc];
    const float mean = wsum(y) * (1.f / 64.f);
    const float dlt = y - mean;
    const float var = wsum(dlt * dlt) * (1.f / 64.f);
    const float yn = dlt * rsqrtf(var + 64e-5f) * p.in[I_LNXW][i * 512 + cc] + p.in[I_LNXB][i * 512 + cc];
    const float bonus = wsum(rr * kx * p.in[I_RK][i * 512 + cc]) * vv;
    const float g = bf2f(row[1536 + cc]);
    Y[(size_t)tok * 1024 + 512 + cc] = f2bf((yn + bonus) * (g * sigmoidf_(g)));
  }
}

__device__ void hy_filter_mlp(const Params& p, int i) {
  float* H2 = (float*)(p.ws + OFF_H2);
  const int lane = tidx() & 63, gw = bidx() * 8 + (tidx() >> 6), nw = gridDim.x * 8;
  const float fr = p.in[I_FFREQ][i * 64 + lane], b1 = p.in[I_FB1][i * 64 + lane], b2 = p.in[I_FB2][i * 64 + lane];
  for (int row = gw; row < 20480; row += nw) {
    const int L = row < 4096 ? 4096 : 16384, t = row < 4096 ? row : row - 4096;
    const float w = 6.283185307179586f * (float)t / (float)L;
    float z = 0.f;
    if (lane == 0) z = (float)t / (float)(L - 1);
    else if (lane <= 32) {
      const int bi = (lane - 1) & 15;
      const float f = 1e-4f + (float)bi * ((15.f - 1e-4f) / 15.f);
      z = lane <= 16 ? cosf(f * w) : -sinf(f * w);
    }
    float a = b1;
#pragma unroll 3
    for (int k = 0; k < 33; ++k) a += __shfl(z, k) * p.in[I_FW1][((size_t)i * 33 + k) * 64 + lane];
    const float h1 = sinf(fr * a);
    float c = b2;
#pragma unroll 8
    for (int k = 0; k < 64; ++k) c += __shfl(h1, k) * p.in[I_FW2][((size_t)i * 64 + k) * 64 + lane];
    H2[(size_t)row * 64 + lane] = sinf(fr * c);
  }
}

template <int LOGN>
__device__ void fft_dif(float2* buf) {
  constexpr int N = 1 << LOGN;
  const int tid = tidx();
#pragma unroll
  for (int ps = 0; ps < LOGN / 2; ++ps) {
    const int lh = LOGN - 1 - 2 * ps;
    const int h = 1 << lh, hh = h >> 1;
    const float inv2h = 1.f / (float)(2 * h);
#pragma unroll 1
    for (int q = tid; q < N / 4; q += NT) {
      const int pos = q & (hh - 1), grp = q >> (lh - 1);
      const int e0 = (grp << (lh + 1)) + pos;
      float2 x0 = buf[e0], x1 = buf[e0 + hh], x2 = buf[e0 + h], x3 = buf[e0 + h + hh];
      const float f1 = (float)pos * inv2h;
      const float c1 = __builtin_amdgcn_cosf(f1), s1 = -__builtin_amdgcn_sinf(f1);
      const float c2 = c1 * c1 - s1 * s1, s2 = 2.f * c1 * s1;
      float2 a0{x0.x + x2.x, x0.y + x2.y};
      float2 d2{x0.x - x2.x, x0.y - x2.y};
      float2 a2{d2.x * c1 - d2.y * s1, d2.x * s1 + d2.y * c1};
      float2 a1{x1.x + x3.x, x1.y + x3.y};
      float2 d3{x1.x - x3.x, x1.y - x3.y};
      float2 t3{d3.x * c1 - d3.y * s1, d3.x * s1 + d3.y * c1};
      float2 a3{t3.y, -t3.x};
      float2 y0{a0.x + a1.x, a0.y + a1.y};
      float2 e1{a0.x - a1.x, a0.y - a1.y};
      float2 y1{e1.x * c2 - e1.y * s2, e1.x * s2 + e1.y * c2};
      float2 y2{a2.x + a3.x, a2.y + a3.y};
      float2 e3{a2.x - a3.x, a2.y - a3.y};
      float2 y3{e3.x * c2 - e3.y * s2, e3.x * s2 + e3.y * c2};
      buf[e0] = y0; buf[e0 + hh] = y1; buf[e0 + h] = y2; buf[e0 + h + hh] = y3;
    }
    __syncthreads();
  }
}
template <int LOGN>
__device__ void fft_dit_inv(float2* buf) {
  constexpr int N = 1 << LOGN;
  const int tid = tidx();
#pragma unroll
  for (int ps = 0; ps < LOGN / 2; ++ps) {
    const int lh = 2 * ps;
    const int h = 1 << lh;
    const float inv4h = 1.f / (float)(4 * h);
#pragma unroll 1
    for (int q = tid; q < N / 4; q += NT) {
      const int pos = q & (h - 1), grp = q >> lh;
      const int e0 = (grp << (lh + 2)) + pos;
      float2 x0 = buf[e0], x1 = buf[e0 + h], x2 = buf[e0 + 2 * h], x3 = buf[e0 + 3 * h];
      const float f2 = (float)pos * inv4h;
      const float c2 = __builtin_amdgcn_cosf(f2), s2 = __builtin_amdgcn_sinf(f2);
      const float c1 = c2 * c2 - s2 * s2, s1 = 2.f * c2 * s2;
      float2 b1{x1.x * c1 - x1.y * s1, x1.x * s1 + x1.y * c1};
      float2 b3{x3.x * c1 - x3.y * s1, x3.x * s1 + x3.y * c1};
      float2 a0{x0.x + b1.x, x0.y + b1.y}, a1{x0.x - b1.x, x0.y - b1.y};
      float2 a2{x2.x + b3.x, x2.y + b3.y}, a3{x2.x - b3.x, x2.y - b3.y};
      float2 cc2{a2.x * c2 - a2.y * s2, a2.x * s2 + a2.y * c2};
      float2 t3{a3.x * c2 - a3.y * s2, a3.x * s2 + a3.y * c2};
      float2 cc3{-t3.y, t3.x};
      buf[e0] = float2{a0.x + cc2.x, a0.y + cc2.y};
      buf[e0 + 2 * h] = float2{a0.x - cc2.x, a0.y - cc2.y};
      buf[e0 + h] = float2{a1.x + cc3.x, a1.y + cc3.y};
      buf[e0 + 3 * h] = float2{a1.x - cc3.x, a1.y - cc3.y};
    }
    __syncthreads();
  }
}
template <int LOGN>
__device__ void spectrum_extract(const float2* buf, float4* __restrict__ GP, float scale) {
  constexpr int Lc = 1 << LOGN;
  for (int j = tidx(); j < Lc / 2; j += NT) {
    if (j == 0) {
      const float2 c = buf[0], ch = buf[1];
      GP[0] = float4{(c.x + c.y) * scale, (c.x - c.y) * scale, ch.x * scale, -ch.y * scale};
    } else {
      const int pos = 2 * j;
      const int k = (int)(__brev((unsigned)pos) >> (32 - LOGN));
      const int p2 = pos ^ ((1 << (31 - __clz(pos))) - 1);
      float2 C1 = buf[pos], C2 = buf[p2];
      float2 E{0.5f * (C1.x + C2.x), 0.5f * (C1.y - C2.y)}, D{0.5f * (C1.x - C2.x), 0.5f * (C1.y + C2.y)};
      float2 O{D.y, -D.x};
      const float f = (float)k * (1.f / (float)(2 * Lc));
      const float wc = __builtin_amdgcn_cosf(f), wsn = -__builtin_amdgcn_sinf(f);
      float2 wO{wc * O.x - wsn * O.y, wc * O.y + wsn * O.x};
      GP[j] = float4{(E.x + wO.x) * scale, (E.y + wO.y) * scale, (E.x - wO.x) * scale, -(E.y - wO.y) * scale};
    }
  }
}
template <int LOGN>
__device__ void spectrum_mul(float2* buf, const float4* __restrict__ GP) {
  constexpr int Lc = 1 << LOGN;
  for (int j = tidx(); j < Lc / 2; j += NT) {
    const float4 gp = GP[j];
    if (j == 0) {
      const float2 c = buf[0], ch = buf[1];
      const float Y0 = (c.x + c.y) * gp.x, YL = (c.x - c.y) * gp.y;
      buf[0] = float2{0.5f * (Y0 + YL), 0.5f * (Y0 - YL)};
      buf[1] = float2{ch.x * gp.z + ch.y * gp.w, ch.y * gp.z - ch.x * gp.w};
    } else {
      const int pos = 2 * j;
      const int k = (int)(__brev((unsigned)pos) >> (32 - LOGN));
      const int p2 = pos ^ ((1 << (31 - __clz(pos))) - 1);
      float2 C1 = buf[pos], C2 = buf[p2];
      float2 E{0.5f * (C1.x + C2.x), 0.5f * (C1.y - C2.y)}, D{0.5f * (C1.x - C2.x), 0.5f * (C1.y + C2.y)};
      float2 O{D.y, -D.x};
      const float f = (float)k * (1.f / (float)(2 * Lc));
      const float wc = __builtin_amdgcn_cosf(f), wsn = -__builtin_amdgcn_sinf(f);
      float2 wO{wc * O.x - wsn * O.y, wc * O.y + wsn * O.x};
      float2 X1{E.x + wO.x, E.y + wO.y}, X2{E.x - wO.x, -(E.y - wO.y)};
      float2 Y1{X1.x * gp.x - X1.y * gp.y, X1.x * gp.y + X1.y * gp.x};
      float2 Y2{X2.x * gp.z - X2.y * gp.w, X2.x * gp.w + X2.y * gp.z};
      float2 Ye{0.5f * (Y1.x + Y2.x), 0.5f * (Y1.y - Y2.y)};
      float2 Dd{0.5f * (Y1.x - Y2.x), 0.5f * (Y1.y + Y2.y)};
      float2 Yo{wc * Dd.x + wsn * Dd.y, wc * Dd.y - wsn * Dd.x};
      buf[pos] = float2{Ye.x - Yo.y, Ye.y + Yo.x};
      buf[p2] = float2{Ye.x + Yo.y, -Ye.y + Yo.x};
    }
  }
}

template <int LOGN>
__device__ void hy_conv_item(const Params& p, int i, int c, unsigned char* lds, bool dry) {
  constexpr int Lc = 1 << LOGN;
  constexpr int L = Lc;
  constexpr int NB = (LOGN == 14) ? 2 : 4;
  const int tid = tidx();
  float2* buf = (float2*)lds;
  float* bufF = (float*)lds;
  float* W3s = (float*)(lds + 131072);
  float* red = W3s + 256;
  float4* GS = (float4*)(p.ws + OFF_GS + (size_t)bidx() * 2 * GS_PER);
  float4* GS1 = GS + GS_PER / 16;
  float* G1tmp = (float*)GS1;
  float* Z1 = (float*)(p.ws + OFF_Z1 + (size_t)bidx() * 65536);
  const float* H2 = (const float*)(p.ws + OFF_H2) + (LOGN == 14 ? (size_t)4096 * 64 : 0);
  const ushort_t* PH = (const ushort_t*)(p.ws + OFF_PH);
  const float delta = 4.605170185988091f * (1.f / 1.5f + (1.f / 0.3f - 1.f / 1.5f) * (float)c / 1023.f);
  __syncthreads();
  if (tid < 256) {
    const int col = tid >> 6, j = tid & 63, o = col >> 1, dirr = col & 1;
    W3s[tid] = p.in[I_FW3][((size_t)i * 64 + j) * 4096 + (dirr * 2 + o) * 1024 + c];
  }
  __syncthreads();
  float ss0 = 0.f, ss1 = 0.f;
  for (int t = tid; t < L; t += NT) {
    const float4* hr = (const float4*)(H2 + (size_t)t * 64);
    float d0 = 0.f, d1 = 0.f, d2 = 0.f, d3 = 0.f;
#pragma unroll 4
    for (int j4 = 0; j4 < 16; ++j4) {
      const float4 hv = hr[j4];
      const float4 w0 = *(const float4*)(W3s + 4 * j4), w1 = *(const float4*)(W3s + 64 + 4 * j4);
      const float4 w2 = *(const float4*)(W3s + 128 + 4 * j4), w3 = *(const float4*)(W3s + 192 + 4 * j4);
      d0 += hv.x * w0.x + hv.y * w0.y + hv.z * w0.z + hv.w * w0.w;
      d1 += hv.x * w1.x + hv.y * w1.y + hv.z * w1.z + hv.w * w1.w;
      d2 += hv.x * w2.x + hv.y * w2.y + hv.z * w2.z + hv.w * w2.w;
      d3 += hv.x * w3.x + hv.y * w3.y + hv.z * w3.z + hv.w * w3.w;
    }
    const float dec = expf(-((float)t * (1.f / (float)(L - 1))) * delta);
    d0 *= dec; d1 *= dec; d2 *= dec; d3 *= dec;
    ss0 += d0 * d0 + d1 * d1;
    ss1 += d2 * d2 + d3 * d3;
    bufF[t] = d0; G1tmp[t] = d2;
    if (t >= 1) { bufF[2 * L - t] = d1; G1tmp[2 * L - t] = d3; } else { bufF[L] = 0.f; G1tmp[L] = 0.f; }
  }
  ss0 = wsum(ss0); ss1 = wsum(ss1);
  if ((tid & 63) == 0) { red[tid >> 6] = ss0; red[8 + (tid >> 6)] = ss1; }
  __syncthreads();
  float tot0 = 0.f, tot1 = 0.f;
#pragma unroll
  for (int w = 0; w < 8; ++w) { tot0 += red[w]; tot1 += red[8 + w]; }
  fft_dif<LOGN>(buf);
  spectrum_extract<LOGN>(buf, GS, rsqrtf(tot0) * (1.f / (float)Lc));
  __syncthreads();
  for (int t = tid; t < 2 * L / 4; t += NT) ((float4*)bufF)[t] = ((const float4*)G1tmp)[t];
  __syncthreads();
  fft_dif<LOGN>(buf);
  spectrum_extract<LOGN>(buf, GS1, rsqrtf(tot1) * (1.f / (float)Lc));
  __threadfence_block();
  __syncthreads();
  const float* sw = p.in[I_HSW] + (size_t)i * 3 * 3072;
  const float* sbias = p.in[I_HSB] + (size_t)i * 3072;
  float cw[3][3], cb[3];
#pragma unroll
  for (int st = 0; st < 3; ++st) {
#pragma unroll
    for (int k = 0; k < 3; ++k) cw[st][k] = sw[k * 3072 + st * 1024 + c];
    cb[st] = sbias[st * 1024 + c];
  }
  const float fb0 = p.in[I_FBIAS][((size_t)i * 2 + 0) * 1024 + c], fb1 = p.in[I_FBIAS][((size_t)i * 2 + 1) * 1024 + c];
  for (int b = 0; b < NB; ++b) {
    const int s0 = (LOGN == 14) ? (TPROMPT + b * 16384) : (b * 4096);
    const ushort_t* pv = PH + (size_t)s0 * 1024 + (size_t)c * L;
    const ushort_t* px1 = pv + (size_t)T * 1024;
    const ushort_t* px2 = px1 + (size_t)T * 1024;
    ushort_t* pg = (ushort_t*)px2 + (size_t)T * 1024;
    auto conv3 = [&](const ushort_t* s, int st, int t) -> float {
      const float a = t > 0 ? bf2f(s[t - 1]) : 0.f, m = bf2f(s[t]), n = t + 1 < L ? bf2f(s[t + 1]) : 0.f;
      return cw[st][0] * a + cw[st][1] * m + cw[st][2] * n + cb[st];
    };
    __syncthreads();
    for (int t = tid; t < L; t += NT) { bufF[t] = conv3(pv, 0, t); bufF[L + t] = 0.f; }
    __syncthreads();
    fft_dif<LOGN>(buf);
    spectrum_mul<LOGN>(buf, GS);
    __syncthreads();
    fft_dit_inv<LOGN>(buf);
    for (int t = tid; t < L; t += NT) {
      const float z0 = conv3(pv, 0, t);
      const float z1 = conv3(px1, 1, t) * (bufF[t] + z0 * fb0);
      bufF[t] = z1; bufF[L + t] = 0.f; Z1[t] = z1;
    }
    __syncthreads();
    fft_dif<LOGN>(buf);
    spectrum_mul<LOGN>(buf, GS1);
    __syncthreads();
    fft_dit_inv<LOGN>(buf);
    for (int t = tid; t < L; t += NT) {
      const float z2 = conv3(px2, 2, t) * (bufF[t] + Z1[t] * fb1);
      const float g = bf2f(pg[t]);
      if (!dry) pg[t] = f2bf(z2 * g * sigmoidf_(g));
    }
  }
}

__device__ void hy_conv_phase(const Params& p, int i, unsigned char* lds, bool dry = false) {
  for (int it = bidx(); it < 2048; it += gridDim.x) {
    if (it < 1024) hy_conv_item<14>(p, i, it, lds, dry);
    else hy_conv_item<12>(p, i, it - 1024, lds, dry);
    __syncthreads();
  }
}

#ifndef PROBE_MASK
#define PROBE_MASK 0
#endif
#ifndef PH_MASK
#define PH_MASK 0x1ffff
#endif
#define PHM(n) ((PH_MASK >> (n)) & 1)
DEVI void run_phase(const Params& p, int ph, unsigned char* lds, bool dry = false) {
  const int layer = ph < NPH_EVEN ? 0 : ph < NPH_EVEN + NPH_ODD ? 1 : ph < 2 * NPH_EVEN + NPH_ODD ? 2 : 3;
  const int base = layer == 0 ? 0 : layer == 1 ? NPH_EVEN : layer == 2 ? NPH_EVEN + NPH_ODD : 2 * NPH_EVEN + NPH_ODD;
  const int sp = ph - base, i = layer >> 1;
  unsigned char* ws = p.ws;
  ushort_t* WB = (ushort_t*)(ws + OFF_WB);
  if ((layer & 1) == 0) {
    ushort_t* WinT = WB; ushort_t* WoutT = WB + 3328 * 1024; ushort_t* GluT = WoutT + 1024 * 1024;
    switch (sp) {
      case 0: if (PHM(0)) {
        transpose_bf16(p.in[I_EWIN] + (size_t)i * 1024 * 3136, WinT, 1024, 3136, lds);
        zero_fill(WinT + 3136 * 1024, 192 * 1024);
        transpose_bf16(p.in[I_EWOUT] + (size_t)i * 1024 * 1024, WoutT, 1024, 1024, lds);
        transpose_bf16(p.in[I_GLUW] + (size_t)i * 512 * 512, GluT, 512, 512, lds);
        if (layer == 0) xb_convert(p, (ushort_t*)(ws + OFF_Y));
        } break;
      case 1: if (PHM(1)) run_gemm(lds, (const ushort_t*)(ws + OFF_Y), 1024, WinT, 3328, 1024, pg8::EpiEvenIn{(ushort_t*)(ws + OFF_PS5), (ushort_t*)(ws + OFF_PRW)}); break;
      case 2: if (PHM(2)) s5_passA(p, i, lds); break;
      case 3: if (PHM(3)) s5_passC(p, i, lds); break;
      case 4: if (PHM(4)) run_gemm(lds, (const ushort_t*)(ws + OFF_Y) + 512, 1024, GluT, 512, 512, pg8::EpiGlu{(ushort_t*)(ws + OFF_Y), (const ushort_t*)(ws + OFF_PS5), p.in[I_GLUB] + i * 512}); break;
      case 5: if (PHM(5)) rwkv_scan1(p, i, lds); break;
      case 6: if (PHM(6)) rwkv_carry(p, lds, dry); break;
      case 7: if (PHM(7)) rwkv_scan3(p, i, lds, dry); break;
      case 8: if (PHM(8)) rwkv_post(p, i); break;
      case 9: if (PHM(9)) run_gemm(lds, (const ushort_t*)(ws + OFF_Y), 1024, WoutT, 1024, 1024, pg8::EpiF32{(float*)(ws + OFF_PRW)}); break;
      case 10: if (PHM(10)) ln_phase(p, layer, (const float*)(ws + OFF_PRW), (ushort_t*)(ws + OFF_XB_ODD), dry); break;
    }
  } else {
    ushort_t* HinT = WB; ushort_t* HoutT = WB + 4096 * 1024;
    switch (sp) {
      case 0: if (PHM(11)) {
        transpose_bf16(p.in[I_HWIN] + (size_t)i * 1024 * 4096, HinT, 1024, 4096, lds);
        transpose_bf16(p.in[I_HWOUT] + (size_t)i * 1024 * 1024, HoutT, 1024, 1024, lds);
        hy_filter_mlp(p, i);
        } break;
      case 1: if (PHM(12)) run_gemm(lds, (const ushort_t*)(ws + OFF_XB_ODD), 1024, HinT, 4096, 1024, pg8::EpiHyIn{(ushort_t*)(ws + OFF_PH)}); break;
      case 2: if (PHM(13)) hy_conv_phase(p, i, lds, dry); break;
      case 3: if (PHM(14)) hy_transpose((const ushort_t*)(ws + OFF_PH + 3 * SZ1), (ushort_t*)(ws + OFF_PH), lds); break;
      case 4: if (PHM(15)) run_gemm(lds, (const ushort_t*)(ws + OFF_PH), 1024, HoutT, 1024, 1024, pg8::EpiF32{(float*)(ws + OFF_PH + SZ1)}); break;
      case 5: if (PHM(16)) ln_phase(p, layer, (const float*)(ws + OFF_PH + SZ1), layer < 3 ? (ushort_t*)(ws + OFF_Y) : (ushort_t*)nullptr, dry); break;
    }
  }
}

#if ONE_LAUNCH
__global__ void __launch_bounds__(NT) fwd_kernel(Params p) {
  extern __shared__ __attribute__((aligned(16))) unsigned char lds[];
#if ONE_LAUNCH
  cg::grid_group grid = cg::this_grid();
#endif
  for (int ph = p.ph_lo; ph < p.ph_hi; ++ph) {
#if PROBE_MASK
    {
      const int lyr = ph < NPH_EVEN ? 0 : ph < NPH_EVEN + NPH_ODD ? 1 : ph < 2 * NPH_EVEN + NPH_ODD ? 2 : 3;
      const int bs = lyr == 0 ? 0 : lyr == 1 ? NPH_EVEN : lyr == 2 ? NPH_EVEN + NPH_ODD : 2 * NPH_EVEN + NPH_ODD;
      const int idx = (lyr & 1) ? NPH_EVEN + (ph - bs) : (ph - bs);
      if ((PROBE_MASK >> idx) & 1) { run_phase(p, ph, lds, true); grid.sync(); }
    }
#endif
    run_phase(p, ph, lds);
#if ONE_LAUNCH
    if (ph + 1 < p.ph_hi) grid.sync();
#endif
  }
}
#endif

#if !ONE_LAUNCH
template <int PH> __global__ void __launch_bounds__(NT) phase_kernel(Params p) {
  extern __shared__ __attribute__((aligned(16))) unsigned char lds[];
  run_phase(p, PH, lds);
}
typedef void (*kfn_t)(Params);
#define PK(n) phase_kernel<n>
static kfn_t k_tab[NPHASES] = {PK(0), PK(1), PK(2), PK(3), PK(4), PK(5), PK(6), PK(7), PK(8), PK(9), PK(10), PK(11), PK(12), PK(13), PK(14), PK(15),
                               PK(16), PK(17), PK(18), PK(19), PK(20), PK(21), PK(22), PK(23), PK(24), PK(25), PK(26), PK(27), PK(28), PK(29), PK(30), PK(31), PK(32), PK(33)};
#endif

extern "C" void kernel_launch(void* const* d_in, const int* in_sizes, int n_in, void* d_out, int out_size, void* d_ws, size_t ws_size,
                              hipStream_t stream) {
  static int grid_blocks = 0;
  if (!grid_blocks) {
    if (n_in != 38 || ws_size < WS_NEED || out_size != T * 1024) {
      fprintf(stderr, "kernel_launch: unexpected shapes n_in=%d ws=%zu out=%d\n", n_in, ws_size, out_size);
      grid_blocks = -1; return;
    }
    int dev = 0, cus = 0, per_cu = 0;
    (void)hipGetDevice(&dev);
    (void)hipDeviceGetAttribute(&cus, hipDeviceAttributeMultiprocessorCount, dev);
#if ONE_LAUNCH
    if (hipFuncSetAttribute((const void*)fwd_kernel, hipFuncAttributeMaxDynamicSharedMemorySize, LDS_BYTES) != hipSuccess) {
      fprintf(stderr, "kernel_launch: hipFuncSetAttribute failed\n"); grid_blocks = -1; return;
    }
    (void)hipOccupancyMaxActiveBlocksPerMultiprocessor(&per_cu, (const void*)fwd_kernel, NT, LDS_BYTES);
#else
    for (int ph = 0; ph < NPHASES; ++ph)
      if (hipFuncSetAttribute((const void*)k_tab[ph], hipFuncAttributeMaxDynamicSharedMemorySize, LDS_BYTES) != hipSuccess) {
        fprintf(stderr, "kernel_launch: hipFuncSetAttribute failed\n"); grid_blocks = -1; return;
      }
    per_cu = 1;
#endif
    if (per_cu < 1) { fprintf(stderr, "kernel_launch: occupancy query returned %d\n", per_cu); per_cu = 1; }
    grid_blocks = cus * per_cu;
    if (grid_blocks > 256) grid_blocks = 256;
    if (grid_blocks < 1) grid_blocks = 256;
  }
  if (grid_blocks < 0) return;
  Params p{};
  for (int k = 0; k < 38; ++k) p.in[k] = (const float*)d_in[k];
  p.out = (float*)d_out; p.ws = (unsigned char*)d_ws;
#if ONE_LAUNCH
  p.ph_lo = 0; p.ph_hi = NPHASES;
  void* args[] = {&p};
  hipError_t e = hipLaunchCooperativeKernel((const void*)fwd_kernel, dim3(grid_blocks), dim3(NT), args, LDS_BYTES, stream);
  if (e != hipSuccess) fprintf(stderr, "cooperative launch failed: %s (grid %d)\n", hipGetErrorString(e), grid_blocks);
#else
  for (int ph = 0; ph < NPHASES; ++ph) {
    p.ph_lo = ph; p.ph_hi = ph + 1;
    hipLaunchKernelGGL(k_tab[ph], dim3(grid_blocks), dim3(NT), LDS_BYTES, stream, p);
  }
#endif
}
```

```cpp
#include <hip/hip_runtime.h>
#include <hip/hip_cooperative_groups.h>
#include <cstdio>
#include <cstdint>
namespace cg = cooperative_groups;

#ifndef ONE_LAUNCH
#define ONE_LAUNCH 1
#endif

#define DEVI __device__ __forceinline__
constexpr int NT = 512;
constexpr int T = 49152;
constexpr int TPROMPT = 16384;
constexpr int LDS_BYTES = 133120;
constexpr int NPH_EVEN = 11, NPH_ODD = 6;
constexpr int NPHASES = 2 * (NPH_EVEN + NPH_ODD);

typedef __attribute__((ext_vector_type(8))) short bf16x8;
typedef __attribute__((ext_vector_type(4))) float f32x4;
typedef unsigned short ushort_t;

struct Params { const float* in[38]; float* out; unsigned char* ws; int ph_lo; int ph_hi; };

enum { I_XP = 0, I_XS, I_EWIN, I_EWOUT, I_LRE, I_LIM, I_LSTEP, I_BRE, I_BIM, I_CRE, I_CIM, I_S5D, I_GLUW, I_GLUB,
       I_MURKV, I_MULORA, I_W0, I_WUP, I_A0, I_AUP, I_KK, I_KA, I_RK, I_LNXW, I_LNXB,
       I_HWIN, I_HWOUT, I_HSW, I_HSB, I_FW1, I_FB1, I_FFREQ, I_FW2, I_FB2, I_FW3, I_FBIAS, I_LNG, I_LNB };

constexpr size_t SZ1 = (size_t)T * 1024 * 2;
constexpr size_t OFF_PS5 = 0;
constexpr size_t OFF_PRW = OFF_PS5 + SZ1;
constexpr size_t OFF_Y = OFF_PRW + (size_t)T * 2112 * 2;
constexpr size_t OFF_YS = OFF_Y + SZ1;
constexpr size_t OFF_WB = OFF_YS + SZ1;
constexpr size_t OFF_CAR = OFF_WB + 10485760;
constexpr size_t WS_NEED = OFF_CAR + 6291456;
constexpr size_t OFF_PH = 0;
constexpr size_t OFF_GS = 4 * SZ1;
constexpr size_t GS_PER = 131328;
constexpr size_t OFF_Z1 = OFF_GS + 256 * 2 * GS_PER;
constexpr size_t OFF_XB_ODD = 4 * SZ1;
constexpr size_t OFF_H2 = OFF_XB_ODD + SZ1;

DEVI int tidx() { int t = threadIdx.x; asm volatile("" : "+v"(t)); return t; }
DEVI int bidx() { int b = blockIdx.x; asm volatile("" : "+s"(b)); return b; }
DEVI ushort_t f2bf(float f) { unsigned u = __float_as_uint(f); u += 0x7fffu + ((u >> 16) & 1u); return (ushort_t)(u >> 16); }
DEVI float bf2f(ushort_t h) { return __uint_as_float(((unsigned)h) << 16); }
DEVI unsigned pack2(float a, float b) { return (unsigned)f2bf(a) | ((unsigned)f2bf(b) << 16); }
DEVI float wsum(float v) {
#pragma unroll
  for (int m = 32; m >= 1; m >>= 1) v += __shfl_xor(v, m);
  return v;
}
DEVI void wave_sync() { __builtin_amdgcn_fence(__ATOMIC_RELEASE, "wavefront"); __builtin_amdgcn_wave_barrier(); __builtin_amdgcn_fence(__ATOMIC_ACQUIRE, "wavefront"); }
DEVI void seq_of(int tok, int& s0, int& L) {
  if (tok < TPROMPT) { s0 = tok & ~4095; L = 4096; } else { s0 = TPROMPT + ((tok - TPROMPT) & ~16383); L = 16384; }
}
struct XSrc { const float* xp; const float* xs; const float* xo; };
DEVI XSrc xsrc(const Params& p) {
  XSrc x; x.xp = p.in[I_XP]; x.xs = p.in[I_XS]; x.xo = p.out;
  asm volatile("" : "+s"(x.xp), "+s"(x.xs), "+s"(x.xo));
  return x;
}
DEVI const float* xrow(const XSrc& x, int layer, int tok) {
  if (layer == 0) return tok < TPROMPT ? x.xp + (size_t)tok * 1024 : x.xs + (size_t)(tok - TPROMPT) * 1024;
  return x.xo + (size_t)tok * 1024;
}
DEVI float sigmoidf_(float x) { return 1.f / (1.f + expf(-x)); }
DEVI float fast_sigmoid(float x) { return __builtin_amdgcn_rcpf(1.f + __builtin_amdgcn_exp2f(-1.4426950408889634f * x)); }
DEVI float fast_tanh(float x) { return 1.f - 2.f * __builtin_amdgcn_rcpf(1.f + __builtin_amdgcn_exp2f(2.8853900817779268f * x)); }
DEVI float dpp_mov_f(float x, const int sel) {
  int xi = __builtin_bit_cast(int, x), r;
  if (sel == 0) r = __builtin_amdgcn_mov_dpp(xi, 0xB1, 0xf, 0xf, true);
  else if (sel == 1) r = __builtin_amdgcn_mov_dpp(xi, 0x4E, 0xf, 0xf, true);
  else if (sel == 2) r = __builtin_amdgcn_mov_dpp(xi, 0x141, 0xf, 0xf, true);
  else r = __builtin_amdgcn_mov_dpp(xi, 0x140, 0xf, 0xf, true);
  return __builtin_bit_cast(float, r);
}
DEVI float wsum_fast(float v) {
  v += dpp_mov_f(v, 0); v += dpp_mov_f(v, 1); v += dpp_mov_f(v, 2); v += dpp_mov_f(v, 3);
  const int vi = __builtin_bit_cast(int, v);
  return __builtin_bit_cast(float, __builtin_amdgcn_readlane(vi, 0)) + __builtin_bit_cast(float, __builtin_amdgcn_readlane(vi, 16)) +
         __builtin_bit_cast(float, __builtin_amdgcn_readlane(vi, 32)) + __builtin_bit_cast(float, __builtin_amdgcn_readlane(vi, 48));
}
DEVI float gelu_tanh(float x) { return 0.5f * x * (1.f + tanhf(0.7978845608f * (x + 0.044715f * x * x * x))); }

__device__ void transpose_bf16(const float* __restrict__ in, ushort_t* __restrict__ out, int K, int N, unsigned char* lds) {
  float* tile = (float*)lds;
  const int tid = tidx(), j = tid & 63, i0 = tid >> 6;
  const int tk = K / 64, tn = N / 64;
  for (int t = bidx(); t < tk * tn; t += gridDim.x) {
    const int k0 = (t / tn) * 64, n0 = (t % tn) * 64;
#pragma unroll
    for (int e = 0; e < 8; ++e) { int i = i0 + 8 * e; tile[i * 65 + j] = in[(size_t)(k0 + i) * N + n0 + j]; }
    __syncthreads();
#pragma unroll
    for (int e = 0; e < 8; ++e) { int i = i0 + 8 * e; out[(size_t)(n0 + i) * K + k0 + j] = f2bf(tile[j * 65 + i]); }
    __syncthreads();
  }
}

namespace pg8 {
#define PG8_LAS __attribute__((address_space(3)))
typedef unsigned u32x4 __attribute__((ext_vector_type(4)));
constexpr int BM = 256, BK = 64, HALF = 128, HTB = HALF * BK * 2, STAGE_BYTES = 8 * HTB, NXCD = 8, WGM = 8;
DEVI int lds_byte(int r, int c) { const int st = (r >> 4) * 2 + (c >> 5), rr = r & 15, cc = c & 31, ob = rr * 64 + cc * 2; return st * 1024 + (ob ^ (((ob >> 9) & 1) << 5)); }
DEVI void stage_rc(int b, int& R, int& C) { const int st = b / 1024, sb = b % 1024, swz = sb ^ (((sb >> 9) & 1) << 5); R = (st >> 1) * 16 + swz / 64; C = (st & 1) * 32 + (swz % 64) / 2; }
DEVI int perm32(int rho) { const int n = rho >> 4, i = rho & 15; return 8 * (i >> 2) + 4 * n + (i & 3); }
struct Unit { int pm, pn; };
struct Gemm { const ushort_t* A; const ushort_t* Bt; int M, N, K, lda; };
struct StaticOrder {
  int nM, nN, nwg, G, c;
  DEVI void init(int M, int N, int G_, int c_) { nM = M / BM; nN = N / BM; nwg = nM * nN; G = G_; c = c_; }
  DEVI bool next(int i, Unit& u) const {
    const long L = (long)i * G + c; if (L >= nwg) return false;
    int wgid = (int)L; { const int q = nwg / NXCD, r = nwg % NXCD, xcd = wgid % NXCD, off = wgid / NXCD; wgid = (xcd < r ? xcd * (q + 1) : r * (q + 1) + (xcd - r) * q) + off; }
    const int nig = WGM * nN, gid = wgid / nig, fm = gid * WGM, gsz = (nM - fm) < WGM ? (nM - fm) : WGM;
    u.pm = fm + ((wgid % nig) % gsz); u.pn = (wgid % nig) / gsz; return true;
  }
};
DEVI unsigned cvt_pk_bf16(float lo, float hi) { unsigned r; asm volatile("v_cvt_pk_bf16_f32 %0, %1, %2" : "=v"(r) : "v"(lo), "v"(hi)); return r; }

template <class Epi>
DEVI void gemm_phase(PG8_LAS unsigned char* lds, const Gemm g, const StaticOrder& S, const Epi& E) {
  const int tid = tidx(), wid = __builtin_amdgcn_readfirstlane(tid >> 6), lane = tid & 63, wr = wid >> 2, wc = wid & 3, fr = lane & 15, fq = lane >> 4;
  const int K = g.K, nt = K / BK, lda = g.lda;
  unsigned voffA[2], voffB[2];
#pragma unroll
  for (int i = 0; i < 2; ++i) { int R, C; stage_rc(tid * 16 + i * 8192, R, C); const int Rb = Epi::PERM ? ((R & ~31) + perm32(R & 31)) : R;
    voffA[i] = (unsigned)(R * lda + C) * 2u; voffB[i] = (unsigned)(Rb * K + C) * 2u; }
  const size_t kstep = (size_t)(BK * 2);
  const size_t hstepA = (size_t)HALF * lda * 2, hstepB = (size_t)HALF * K * 2;
  const size_t tstepA = 2 * hstepA, tstepB = 2 * hstepB;
  const unsigned ldsw = (unsigned)wid * 1024u;
  const int aoff = lds_byte(wr * 64 + fr, fq * 8), boff = lds_byte(wc * 32 + fr, fq * 8);
#define PG8_SA(b, h) (((b) * 2 + (h)) * HTB)
#define PG8_SB(b, h) ((4 + (b) * 2 + (h)) * HTB)
#define PG8_STAGE(bufoff, gbase, voff) do { _Pragma("unroll") for (int _i = 0; _i < 2; ++_i) \
    __builtin_amdgcn_global_load_lds((const unsigned*)((const char*)(gbase) + (voff)[_i]), (PG8_LAS unsigned*)(lds + (bufoff) + ldsw + _i * 8192), 16, 0, 0); } while (0)
#define PG8_LDA(dst, b, h) do { _Pragma("unroll") for (int m = 0; m < 4; ++m) _Pragma("unroll") for (int k = 0; k < 2; ++k) dst[m][k] = *(const PG8_LAS bf16x8*)(lds + PG8_SA(b, h) + aoff + m * 2048 + k * 1024); } while (0)
#define PG8_LDB(dst, b, h) do { _Pragma("unroll") for (int n = 0; n < 2; ++n) _Pragma("unroll") for (int k = 0; k < 2; ++k) dst[n][k] = *(const PG8_LAS bf16x8*)(lds + PG8_SB(b, h) + boff + n * 2048 + k * 1024); } while (0)
#define PG8_MMA(ai, bj, At, Bt) do { __builtin_amdgcn_s_setprio(1); _Pragma("unroll") for (int m = 0; m < 4; ++m) _Pragma("unroll") for (int n = 0; n < 2; ++n) _Pragma("unroll") for (int k = 0; k < 2; ++k) \
    acc[ai][bj][m][n] = Epi::TRANS ? __builtin_amdgcn_mfma_f32_16x16x32_bf16(Bt[n][k], At[m][k], acc[ai][bj][m][n], 0, 0, 0) \
                                   : __builtin_amdgcn_mfma_f32_16x16x32_bf16(At[m][k], Bt[n][k], acc[ai][bj][m][n], 0, 0, 0); __builtin_amdgcn_s_setprio(0); } while (0)
#define PG8_WAIT_V(n) asm volatile("s_waitcnt vmcnt(" #n ")" ::: "memory")
#define PG8_WAIT_L(n) asm volatile("s_waitcnt lgkmcnt(" #n ")" ::: "memory")
#define PG8_BAR __builtin_amdgcn_s_barrier()
#define PG8_SCHED __builtin_amdgcn_sched_barrier(0)
  Unit cur, nxt; int ui = 0;
  if (!S.next(0, cur)) return;
  f32x4 acc[2][2][4][2];
#pragma unroll
  for (int a = 0; a < 2; ++a)
#pragma unroll
    for (int b = 0; b < 2; ++b)
#pragma unroll
      for (int m = 0; m < 4; ++m)
#pragma unroll
        for (int n = 0; n < 2; ++n) acc[a][b][m][n] = (f32x4){0.f, 0.f, 0.f, 0.f};
  bf16x8 At[4][2], B0[2][2], B1[2][2];
  const char* cA = (const char*)g.A + (size_t)cur.pm * tstepA; const char* cB = (const char*)g.Bt + (size_t)cur.pn * tstepB;
  PG8_STAGE(PG8_SB(0, 0), cB, voffB); PG8_STAGE(PG8_SA(0, 0), cA, voffA); PG8_STAGE(PG8_SB(0, 1), cB + hstepB, voffB); PG8_STAGE(PG8_SA(0, 1), cA + hstepA, voffA);
  if (wr == 1) PG8_BAR;
  PG8_WAIT_V(4); PG8_BAR;
  PG8_STAGE(PG8_SB(1, 0), cB + kstep, voffB); PG8_STAGE(PG8_SA(1, 0), cA + kstep, voffA); PG8_STAGE(PG8_SB(1, 1), cB + hstepB + kstep, voffB);
  PG8_WAIT_V(6); PG8_BAR;
  for (;;) {
    const bool has_next = S.next(ui + 1, nxt);
    const char* nA = has_next ? (const char*)g.A + (size_t)nxt.pm * tstepA : cA; const char* nB = has_next ? (const char*)g.Bt + (size_t)nxt.pn * tstepB : cB;
    for (int t = 0; t < nt; t += 2) {
      const bool last = (t == nt - 2);
      const char* a1 = cA + (size_t)(t + 1) * kstep;
      const char* a2 = last ? nA : cA + (size_t)(t + 2) * kstep; const char* b2 = last ? nB : cB + (size_t)(t + 2) * kstep;
      const char* a3 = a2 + kstep; const char* b3 = b2 + kstep;
      PG8_LDB(B0, 0, 0); PG8_SCHED; PG8_LDA(At, 0, 0); PG8_STAGE(PG8_SA(1, 1), a1 + hstepA, voffA);
      PG8_WAIT_L(8); PG8_BAR; PG8_WAIT_L(0); PG8_MMA(0, 0, At, B0); PG8_BAR; PG8_SCHED;
      PG8_LDB(B1, 0, 1); PG8_STAGE(PG8_SB(0, 0), b2, voffB);
      PG8_BAR; PG8_WAIT_L(0); PG8_MMA(0, 1, At, B1); PG8_BAR;
      PG8_LDA(At, 0, 1); PG8_STAGE(PG8_SA(0, 0), a2, voffA);
      PG8_BAR; PG8_WAIT_L(0); PG8_MMA(1, 0, At, B0); PG8_BAR; PG8_SCHED;
      PG8_STAGE(PG8_SB(0, 1), b2 + hstepB, voffB);
      PG8_WAIT_V(6); PG8_BAR; PG8_MMA(1, 1, At, B1); PG8_BAR;
      PG8_LDB(B0, 1, 0); PG8_SCHED; PG8_LDA(At, 1, 0); PG8_STAGE(PG8_SA(0, 1), a2 + hstepA, voffA);
      PG8_WAIT_L(8); PG8_BAR; PG8_WAIT_L(0); PG8_MMA(0, 0, At, B0); PG8_BAR; PG8_SCHED;
      PG8_LDB(B1, 1, 1); PG8_STAGE(PG8_SB(1, 0), b3, voffB);
      PG8_BAR; PG8_WAIT_L(0); PG8_MMA(0, 1, At, B1); PG8_BAR;
      PG8_LDA(At, 1, 1); PG8_STAGE(PG8_SA(1, 0), a3, voffA);
      PG8_BAR; PG8_WAIT_L(0); PG8_MMA(1, 0, At, B0); PG8_BAR; PG8_SCHED;
      PG8_STAGE(PG8_SB(1, 1), b3 + hstepB, voffB);
      PG8_WAIT_V(6); PG8_BAR; PG8_MMA(1, 1, At, B1); PG8_BAR;
    }
    E(acc, cur, wr, wc, fr, fq);
    if (!has_next) break;
#pragma unroll
    for (int a = 0; a < 2; ++a)
#pragma unroll
      for (int b = 0; b < 2; ++b)
#pragma unroll
        for (int m = 0; m < 4; ++m)
#pragma unroll
          for (int n = 0; n < 2; ++n) acc[a][b][m][n] = (f32x4){0.f, 0.f, 0.f, 0.f};
    cur = nxt; cA = nA; cB = nB; ++ui;
  }
  PG8_WAIT_V(0);
  if (wr == 0) PG8_BAR;
  PG8_BAR;
#undef PG8_SA
#undef PG8_SB
#undef PG8_STAGE
#undef PG8_LDA
#undef PG8_LDB
#undef PG8_MMA
#undef PG8_WAIT_V
#undef PG8_WAIT_L
#undef PG8_BAR
#undef PG8_SCHED
}

struct EpiEvenIn {
  static constexpr bool PERM = true, TRANS = true;
  ushort_t* ps5; ushort_t* prw;
  DEVI void operator()(const f32x4 (&acc)[2][2][4][2], const Unit& u, int wr, int wc, int fr, int fq) const {
#pragma unroll
    for (int ai = 0; ai < 2; ++ai)
#pragma unroll
      for (int m = 0; m < 4; ++m) {
        const size_t row = (size_t)u.pm * BM + ai * HALF + wr * 64 + m * 16 + fr;
#pragma unroll
        for (int bj = 0; bj < 2; ++bj) {
          const int c0 = u.pn * BM + bj * HALF + wc * 32 + 8 * fq;
          const f32x4 v0 = acc[ai][bj][m][0], v1 = acc[ai][bj][m][1];
          u32x4 o = {cvt_pk_bf16(v0[0], v0[1]), cvt_pk_bf16(v0[2], v0[3]), cvt_pk_bf16(v1[0], v1[1]), cvt_pk_bf16(v1[2], v1[3])};
          if (c0 < 1024) *(u32x4*)(ps5 + row * 1024 + c0) = o;
          else if (c0 < 3136) *(u32x4*)(prw + row * 2112 + (c0 - 1024)) = o;
        }
      }
  }
};
struct EpiHyIn {
  static constexpr bool PERM = false, TRANS = false;
  ushort_t* ph;
  DEVI void operator()(const f32x4 (&acc)[2][2][4][2], const Unit& u, int wr, int wc, int fr, int fq) const {
    int s0, L; seq_of(u.pm * BM, s0, L);
#pragma unroll
    for (int ai = 0; ai < 2; ++ai)
#pragma unroll
      for (int m = 0; m < 4; ++m) {
        const int tok = u.pm * BM + ai * HALF + wr * 64 + m * 16 + 4 * fq;
#pragma unroll
        for (int bj = 0; bj < 2; ++bj)
#pragma unroll
          for (int n = 0; n < 2; ++n) {
            const int col = u.pn * BM + bj * HALF + wc * 32 + 16 * n + fr;
            const int st = col >> 10, c = col & 1023;
            const f32x4 v = acc[ai][bj][m][n];
            ushort_t* dst = ph + (size_t)st * T * 1024 + (size_t)s0 * 1024 + (size_t)c * L + (tok - s0);
            *(uint2*)dst = uint2{cvt_pk_bf16(v[0], v[1]), cvt_pk_bf16(v[2], v[3])};
          }
      }
  }
};
struct EpiGlu {
  static constexpr bool PERM = true, TRANS = true;
  ushort_t* y; const ushort_t* ps5; const float* bias;
  DEVI void operator()(const f32x4 (&acc)[2][2][4][2], const Unit& u, int wr, int wc, int fr, int fq) const {
#pragma unroll
    for (int ai = 0; ai < 2; ++ai)
#pragma unroll
      for (int m = 0; m < 4; ++m) {
        const size_t row = (size_t)u.pm * BM + ai * HALF + wr * 64 + m * 16 + fr;
#pragma unroll
        for (int bj = 0; bj < 2; ++bj) {
          const int c0 = u.pn * BM + bj * HALF + wc * 32 + 8 * fq;
          const u32x4 a8 = *(const u32x4*)(y + row * 1024 + 512 + c0);
          const u32x4 g8 = *(const u32x4*)(ps5 + row * 1024 + 512 + c0);
          const f32x4 b0 = *(const f32x4*)(bias + c0), b1 = *(const f32x4*)(bias + c0 + 4);
          float v[8];
#pragma unroll
          for (int e = 0; e < 4; ++e) { v[e] = acc[ai][bj][m][0][e] + b0[e]; v[4 + e] = acc[ai][bj][m][1][e] + b1[e]; }
          unsigned o[4];
#pragma unroll
          for (int e = 0; e < 4; ++e) {
            const float a_lo = __uint_as_float(a8[e] << 16), a_hi = __uint_as_float(a8[e] & 0xffff0000u);
            const float g_lo = __uint_as_float(g8[e] << 16), g_hi = __uint_as_float(g8[e] & 0xffff0000u);
            const float r_lo = a_lo * sigmoidf_(v[2 * e]) * (g_lo * sigmoidf_(g_lo));
            const float r_hi = a_hi * sigmoidf_(v[2 * e + 1]) * (g_hi * sigmoidf_(g_hi));
            o[e] = cvt_pk_bf16(r_lo, r_hi);
          }
          *(u32x4*)(y + row * 1024 + c0) = u32x4{o[0], o[1], o[2], o[3]};
        }
      }
  }
};
struct EpiF32 {
  static constexpr bool PERM = false, TRANS = true;
  float* C;
  DEVI void operator()(const f32x4 (&acc)[2][2][4][2], const Unit& u, int wr, int wc, int fr, int fq) const {
#pragma unroll
    for (int ai = 0; ai < 2; ++ai)
#pragma unroll
      for (int m = 0; m < 4; ++m) {
        float* rowp = C + ((size_t)u.pm * BM + ai * HALF + wr * 64 + m * 16 + fr) * 1024 + u.pn * BM + wc * 32 + 4 * fq;
#pragma unroll
        for (int bj = 0; bj < 2; ++bj)
#pragma unroll
          for (int n = 0; n < 2; ++n) *(f32x4*)(rowp + bj * HALF + n * 16) = acc[ai][bj][m][n];
      }
  }
};
}

template <class Epi>
DEVI void run_gemm(unsigned char* lds, const ushort_t* A, int lda, const ushort_t* Bt, int N, int K, const Epi& E) {
  pg8::Gemm g; g.A = A; g.Bt = Bt; g.M = T; g.N = N; g.K = K; g.lda = lda;
  pg8::StaticOrder S; S.init(T, N, (int)gridDim.x, bidx());
  __syncthreads();
  pg8::gemm_phase<Epi>((PG8_LAS unsigned char*)lds, g, S, E);
  __syncthreads();
}

__device__ void xb_convert(const Params& p, ushort_t* XB) {
  const size_t n4 = (size_t)T * 1024 / 4, np4 = (size_t)TPROMPT * 1024 / 4;
  const float4* xp = (const float4*)p.in[I_XP]; const float4* xs = (const float4*)p.in[I_XS];
  for (size_t e = (size_t)bidx() * NT + tidx(); e < n4; e += (size_t)gridDim.x * NT) {
    const float4 v = e < np4 ? xp[e] : xs[e - np4];
    ((uint2*)XB)[e] = uint2{pack2(v.x, v.y), pack2(v.z, v.w)};
  }
}
__device__ void zero_fill(ushort_t* dst, size_t n) {
  for (size_t e = (size_t)bidx() * NT + tidx(); e < n / 8; e += (size_t)gridDim.x * NT) ((uint4*)dst)[e] = uint4{0, 0, 0, 0};
}
__device__ void hy_transpose(const ushort_t* __restrict__ PH3, ushort_t* __restrict__ Y, unsigned char* lds) {
  ushort_t* tile = (ushort_t*)lds;
  const int tid = tidx(), j = tid & 63, i0 = tid >> 6;
  for (int t = bidx(); t < (T / 64) * 16; t += gridDim.x) {
    const int tok0 = (t >> 4) * 64, c0 = (t & 15) * 64;
    int s0, L; seq_of(tok0, s0, L);
    __syncthreads();
#pragma unroll
    for (int e = 0; e < 8; ++e) { const int i = i0 + 8 * e; tile[i * 66 + j] = PH3[(size_t)s0 * 1024 + (size_t)(c0 + i) * L + (tok0 - s0) + j]; }
    __syncthreads();
#pragma unroll
    for (int e = 0; e < 8; ++e) { const int i = i0 + 8 * e; Y[(size_t)(tok0 + i) * 1024 + c0 + j] = tile[j * 66 + i]; }
  }
}

__device__ void ln_phase(const Params& p, int layer, const float* __restrict__ F, ushort_t* __restrict__ XB, bool dry = false) {
  const int lane = tidx() & 63, gw = bidx() * (NT / 64) + (tidx() >> 6), nw = gridDim.x * (NT / 64);
  const float alpha = 1.681792830507429f;
  const float4* g4 = (const float4*)(p.in[I_LNG] + layer * 1024);
  const float4* b4 = (const float4*)(p.in[I_LNB] + layer * 1024);
  const XSrc xs_ = xsrc(p);
  for (int row = gw; row < T; row += nw) {
    const float4* x4 = (const float4*)xrow(xs_, layer, row);
    const float4* f4 = (const float4*)(F + (size_t)row * 1024);
    float4 v[4];
    float s = 0.f;
#pragma unroll
    for (int e = 0; e < 4; ++e) {
      float4 a = x4[lane + 64 * e], f = f4[lane + 64 * e];
      v[e] = float4{alpha * a.x + f.x, alpha * a.y + f.y, alpha * a.z + f.z, alpha * a.w + f.w};
      s += v[e].x + v[e].y + v[e].z + v[e].w;
    }
    const float mean = wsum(s) * (1.f / 1024.f);
    float q = 0.f;
#pragma unroll
    for (int e = 0; e < 4; ++e) {
      v[e].x -= mean; v[e].y -= mean; v[e].z -= mean; v[e].w -= mean;
      q += v[e].x * v[e].x + v[e].y * v[e].y + v[e].z * v[e].z + v[e].w * v[e].w;
    }
    const float rs = rsqrtf(wsum(q) * (1.f / 1024.f) + 1e-5f);
    float4* o4 = (float4*)(p.out + (size_t)row * 1024);
#pragma unroll
    for (int e = 0; e < 4; ++e) {
      float4 g = g4[lane + 64 * e], b = b4[lane + 64 * e];
      const float4 o = float4{v[e].x * rs * g.x + b.x, v[e].y * rs * g.y + b.y, v[e].z * rs * g.z + b.z, v[e].w * rs * g.w + b.w};
      if (!dry) o4[lane + 64 * e] = o;
      if (XB) ((uint2*)(XB + (size_t)row * 1024))[lane + 64 * e] = uint2{pack2(o.x, o.y), pack2(o.z, o.w)};
    }
  }
}

struct cplx { float x, y; };
DEVI cplx cmul(cplx a, cplx b) { return cplx{a.x * b.x - a.y * b.y, a.x * b.y + a.y * b.x}; }
DEVI void s5_consts(const Params& p, int i, int d, int g, int n, cplx& lb, cplx& coef) {
  const int idx = ((i * 2 + d) * 32 + g) * 64 + n;
  const float lre = p.in[I_LRE][idx], lim = p.in[I_LIM][idx];
  const float dt = expf(p.in[I_LSTEP][(i * 2 + d) * 32 + g]);
  const float mag = expf(lre * dt);
  float sn, cs; sincosf(lim * dt, &sn, &cs);
  lb = cplx{mag * cs, mag * sn};
  const float nr = lb.x - 1.f, ni = lb.y, den = 1.f / (lre * lre + lim * lim);
  coef = cplx{(nr * lre + ni * lim) * den, (ni * lre - nr * lim) * den};
}
DEVI void s5_stage_u(const ushort_t* PS5, int tok0, int g, float* U, int lane) {
  const uint4* src = (const uint4*)(PS5 + (size_t)(tok0 + lane) * 1024 + g * 16);
  uint4 a = src[0], b = src[1];
  float4* d = (float4*)(U + lane * 16);
  d[0] = float4{__uint_as_float(a.x << 16), __uint_as_float(a.x & 0xffff0000u), __uint_as_float(a.y << 16), __uint_as_float(a.y & 0xffff0000u)};
  d[1] = float4{__uint_as_float(a.z << 16), __uint_as_float(a.z & 0xffff0000u), __uint_as_float(a.w << 16), __uint_as_float(a.w & 0xffff0000u)};
  d[2] = float4{__uint_as_float(b.x << 16), __uint_as_float(b.x & 0xffff0000u), __uint_as_float(b.y << 16), __uint_as_float(b.y & 0xffff0000u)};
  d[3] = float4{__uint_as_float(b.z << 16), __uint_as_float(b.z & 0xffff0000u), __uint_as_float(b.w << 16), __uint_as_float(b.w & 0xffff0000u)};
}
#define S5_BU(Urow, bur, bui)                                                         \
  {                                                                                   \
    const float4* u4 = (const float4*)(Urow);                                         \
    bur = 0.f; bui = 0.f;                                                             \
    _Pragma("unroll") for (int pp = 0; pp < 4; ++pp) {                                \
      float4 u = u4[pp];                                                              \
      bur += Br[4 * pp] * u.x + Br[4 * pp + 1] * u.y + Br[4 * pp + 2] * u.z + Br[4 * pp + 3] * u.w; \
      bui += Bi[4 * pp] * u.x + Bi[4 * pp + 1] * u.y + Bi[4 * pp + 2] * u.z + Bi[4 * pp + 3] * u.w; \
    }                                                                                 \
  }

__device__ void s5_passA(const Params& p, int i, unsigned char* lds) {
  const ushort_t* PS5 = (const ushort_t*)(p.ws + OFF_PS5);
  cplx* CAR = (cplx*)(p.ws + OFF_CAR);
  const int lane = tidx() & 63, wave = tidx() >> 6;
  float* U = (float*)(lds + wave * 8448);
  for (int item = bidx() * 8 + wave; item < 192 * 32; item += gridDim.x * 8) {
    const int q = item >> 5, g = item & 31;
    cplx lb0, c0, lb1, c1;
    s5_consts(p, i, 0, g, lane, lb0, c0);
    s5_consts(p, i, 1, g, lane, lb1, c1);
    float Br[16], Bi[16];
#pragma unroll
    for (int pp = 0; pp < 16; ++pp) { Br[pp] = p.in[I_BRE][((i * 32 + g) * 64 + lane) * 16 + pp]; Bi[pp] = p.in[I_BIM][((i * 32 + g) * 64 + lane) * 16 + pp]; }
    cplx xf{0.f, 0.f}, xb{0.f, 0.f}, pw{1.f, 0.f};
    for (int sb = 0; sb < 4; ++sb) {
      wave_sync();
      s5_stage_u(PS5, q * 256 + sb * 64, g, U, lane);
      wave_sync();
      for (int t = 0; t < 64; ++t) {
        float bur, bui;
        S5_BU(U + t * 16, bur, bui);
        xf = cmul(lb0, xf); xf.x += bur; xf.y += bui;
        xb.x += pw.x * bur - pw.y * bui; xb.y += pw.x * bui + pw.y * bur;
        pw = cmul(pw, lb1);
      }
    }
    CAR[((size_t)(q * 32 + g) * 2 + 0) * 64 + lane] = cmul(xf, c0);
    CAR[((size_t)(q * 32 + g) * 2 + 1) * 64 + lane] = cmul(xb, c1);
  }
}

__device__ void s5_passC(const Params& p, int i, unsigned char* lds) {
  const ushort_t* PS5 = (const ushort_t*)(p.ws + OFF_PS5);
  const cplx* CAR = (const cplx*)(p.ws + OFF_CAR);
  float* YS = (float*)(p.ws + OFF_YS);
  ushort_t* YG = (ushort_t*)(p.ws + OFF_Y);
  const int lane = tidx() & 63, wave = tidx() >> 6;
  float* U = (float*)(lds + wave * 8448);
  ushort_t* X = (ushort_t*)(lds + wave * 8448 + 4096);
  for (int item = bidx() * 8 + wave; item < 192 * 32; item += gridDim.x * 8) {
    const int q = item >> 5, g = item & 31;
    int cs, ce;
    if (q < 64) { cs = q & ~15; ce = cs + 16; } else { cs = 64 + ((q - 64) & ~63); ce = cs + 64; }
    float Br[16], Bi[16];
#pragma unroll
    for (int pp = 0; pp < 16; ++pp) { Br[pp] = p.in[I_BRE][((i * 32 + g) * 64 + lane) * 16 + pp]; Bi[pp] = p.in[I_BIM][((i * 32 + g) * 64 + lane) * 16 + pp]; }
    const int pcol = lane & 15;
    const float dd = p.in[I_S5D][i * 512 + g * 16 + pcol];
    for (int d = 0; d < 2; ++d) {
      cplx lb, coef;
      s5_consts(p, i, d, g, lane, lb, coef);
      cplx lp = lb;
#pragma unroll
      for (int e = 0; e < 8; ++e) lp = cmul(lp, lp);
      cplx xs{0.f, 0.f};
      if (d == 0) {
#pragma unroll 8
        for (int j = cs; j < q; ++j) { xs = cmul(lp, xs); cplx c = CAR[((size_t)(j * 32 + g) * 2 + 0) * 64 + lane]; xs.x += c.x; xs.y += c.y; } }
      else {
#pragma unroll 8
        for (int j = ce - 1; j > q; --j) { xs = cmul(lp, xs); cplx c = CAR[((size_t)(j * 32 + g) * 2 + 1) * 64 + lane]; xs.x += c.x; xs.y += c.y; } }
      bf16x8 cf[4];
#pragma unroll
      for (int kk = 0; kk < 4; ++kk) {
        const int n0 = (kk & 1) * 32 + (lane >> 4) * 8;
        const float* src = (kk < 2 ? p.in[I_CRE] : p.in[I_CIM]) + (((size_t)(i * 2 + d) * 32 + g) * 16 + pcol) * 64 + n0;
        const float sg = kk < 2 ? 1.f : -1.f;
#pragma unroll
        for (int j = 0; j < 8; ++j) cf[kk][j] = (short)f2bf(sg * src[j]);
      }
      for (int sbi = 0; sbi < 4; ++sbi) {
        const int sb = d ? 3 - sbi : sbi;
        wave_sync();
        s5_stage_u(PS5, q * 256 + sb * 64, g, U, lane);
        wave_sync();
        for (int tbi = 0; tbi < 4; ++tbi) {
          const int tb = d ? 3 - tbi : tbi;
          for (int tti = 0; tti < 16; ++tti) {
            const int tt = d ? 15 - tti : tti;
            float bur, bui;
            S5_BU(U + (tb * 16 + tt) * 16, bur, bui);
            xs = cmul(lb, xs);
            xs.x += coef.x * bur - coef.y * bui;
            xs.y += coef.x * bui + coef.y * bur;
            X[tt * 136 + lane] = f2bf(xs.x);
            X[tt * 136 + 64 + lane] = f2bf(xs.y);
          }
          wave_sync();
          f32x4 acc{0.f, 0.f, 0.f, 0.f};
#pragma unroll
          for (int kk = 0; kk < 4; ++kk) {
            bf16x8 a = *(const bf16x8*)(X + (lane & 15) * 136 + kk * 32 + (lane >> 4) * 8);
            acc = __builtin_amdgcn_mfma_f32_16x16x32_bf16(a, cf[kk], acc, 0, 0, 0);
          }
          wave_sync();
#pragma unroll
          for (int r = 0; r < 4; ++r) {
            const int tl = tb * 16 + (lane >> 4) * 4 + r;
            const size_t o = (size_t)(q * 256 + sb * 64 + tl) * 512 + g * 16 + pcol;
            if (d == 0) YS[o] = acc[r] + dd * U[tl * 16 + pcol];
            else {
              const float yv = YS[o] + acc[r];
              YG[(size_t)(q * 256 + sb * 64 + tl) * 1024 + 512 + g * 16 + pcol] = f2bf(gelu_tanh(yv));
            }
          }
        }
      }
    }
  }
}

struct RwConst { float mur, muk, muv, mul, w0, a0, kk, ka; };
struct RwRow { float r, k, v, l; };
DEVI RwRow rw_load_row(const ushort_t* PRW, int tok, int s0, int L, int h, int lane) {
  RwRow o{0.f, 0.f, 0.f, 0.f};
  if (tok >= s0 && tok < s0 + L) {
    const ushort_t* row = PRW + (size_t)tok * 2112;
    const int cc = h * 64 + lane;
    o.r = bf2f(row[cc]); o.k = bf2f(row[512 + cc]); o.v = bf2f(row[1024 + cc]); o.l = bf2f(row[2048 + lane]);
  }
  return o;
}
DEVI void rw_prologue(const RwRow& rm, const RwRow& rc, const RwRow& rn, int lane, const RwConst& c, const float* WU, const float* AU,
                      float* LT, float* Wd, float* KKd, float* BBd, float* KDd, float* RRd, float* VVd) {
  const float rr = rc.r + c.mur * (0.5f * (rm.r + rn.r) - rc.r);
  const float kx = rc.k + c.muk * (0.5f * (rm.k + rn.k) - rc.k);
  const float vv = rc.v + c.muv * (0.5f * (rm.v + rn.v) - rc.v);
  float ll = rc.l + c.mul * (0.5f * (rm.l + rn.l) - rc.l);
  ll = lane < 32 ? fast_tanh(ll) : ll;
  wave_sync();
  LT[lane] = ll;
  wave_sync();
  float accw = c.w0, acca = c.a0;
#pragma unroll 2
  for (int j = 0; j < 32; j += 4) {
    float4 lw = *(const float4*)(LT + j), la = *(const float4*)(LT + 32 + j);
    accw += lw.x * WU[(j + 0) * 64 + lane] + lw.y * WU[(j + 1) * 64 + lane] + lw.z * WU[(j + 2) * 64 + lane] + lw.w * WU[(j + 3) * 64 + lane];
    acca += la.x * AU[(j + 0) * 64 + lane] + la.y * AU[(j + 1) * 64 + lane] + la.z * AU[(j + 2) * 64 + lane] + la.w * AU[(j + 3) * 64 + lane];
  }
  const float dec = __builtin_amdgcn_exp2f(-0.8750387749145276f * fast_sigmoid(accw));
  const float a = fast_sigmoid(acca);
  const float kkr = kx * c.kk;
  const float ss = wsum_fast(kkr * kkr);
  const float kkn = kkr * __builtin_amdgcn_rsqf(fmaxf(ss, 1e-24f));
  Wd[lane] = dec; KKd[lane] = kkn; BBd[lane] = kkn * a; KDd[lane] = kx * (1.f + (a - 1.f) * c.ka); RRd[lane] = rr; VVd[lane] = vv;
}

typedef float f32x2 __attribute__((ext_vector_type(2)));
DEVI float dpp_f(float x, const int ctrl_sel) {
  int xi = __builtin_bit_cast(int, x), r;
  if (ctrl_sel == 0) r = __builtin_amdgcn_mov_dpp(xi, 0xB1, 0xf, 0xf, true);
  else if (ctrl_sel == 1) r = __builtin_amdgcn_mov_dpp(xi, 0x4E, 0xf, 0xf, true);
  else r = __builtin_amdgcn_mov_dpp(xi, 0x141, 0xf, 0xf, true);
  return __builtin_bit_cast(float, r);
}
DEVI float red8(float x) { x += dpp_f(x, 0); x += dpp_f(x, 1); x += dpp_f(x, 2); return x; }

#define RW_LOAD8(dst2, base)                                                        \
  { const float4 _a = *(const float4*)(base), _b = *(const float4*)((base) + 4);    \
    dst2[0] = f32x2{_a.x, _a.y}; dst2[1] = f32x2{_a.z, _a.w}; dst2[2] = f32x2{_b.x, _b.y}; dst2[3] = f32x2{_b.z, _b.w}; }

__device__ void rwkv_scan1(const Params& p, int i, unsigned char* lds) {
  const ushort_t* PRW = (const ushort_t*)(p.ws + OFF_PRW);
  float* CH = (float*)(p.ws + OFF_PS5);
  float* YR = (float*)(p.ws + OFF_YS);
  const int tid = tidx(), lane = tid & 63, wave = tid >> 6, pair = wave >> 1, role = wave & 1;
  const int vq = lane >> 3, kq = lane & 7;
  float* TAB = (float*)lds;
  float* WV = (float*)(lds + 24576 + pair * 12800);
  float* Wd = WV, *KKd = WV + 512, *BBd = WV + 1024, *KDd = WV + 1536, *RRd = WV + 2048, *VVd = WV + 2560, *LT = WV + 3072 + role * 64;
  {
    float4* z = (float4*)YR;
    for (size_t e = (size_t)bidx() * NT + tid; e < (size_t)T * 512 / 4; e += (size_t)gridDim.x * NT) z[e] = float4{0.f, 0.f, 0.f, 0.f};
  }
  for (int bi = bidx(); bi < 768; bi += gridDim.x) {
    const int h = bi / 96, rem = bi % 96;
    const int dir = pair >> 1, q = rem * 2 + (pair & 1);
    __syncthreads();
    for (int e = tid; e < 3 * 2048; e += NT) {
      const int which = e >> 11, j = (e >> 6) & 31, c = e & 63;
      TAB[e] = which < 2 ? p.in[I_WUP][((size_t)(i * 2 + which) * 32 + j) * 512 + h * 64 + c] : p.in[I_AUP][((size_t)i * 32 + j) * 512 + h * 64 + c];
    }
    __syncthreads();
    const float* WU = TAB + dir * 2048;
    const float* AU = TAB + 2 * 2048;
    RwConst c;
    const int cc = h * 64 + lane;
    c.mur = p.in[I_MURKV][(i * 3 + 0) * 512 + cc]; c.muk = p.in[I_MURKV][(i * 3 + 1) * 512 + cc]; c.muv = p.in[I_MURKV][(i * 3 + 2) * 512 + cc];
    c.mul = p.in[I_MULORA][i * 64 + lane];
    c.w0 = p.in[I_W0][(i * 2 + dir) * 512 + cc]; c.a0 = p.in[I_A0][(i * 2 + dir) * 512 + cc];
    c.kk = p.in[I_KK][i * 512 + cc]; c.ka = p.in[I_KA][i * 512 + cc];
    const size_t it = ((size_t)(q * 8 + h) * 2 + dir);
    int sq0, sqL; seq_of(q * 256, sq0, sqL);
    float* Op = CH + it * 8192 + (role ? 0 : 4096);
    f32x2 S2[8][4];
    int diag = (role && vq == kq) ? 1 : 0;
    asm volatile("" : "+v"(diag));
#pragma unroll
    for (int r = 0; r < 8; ++r)
#pragma unroll
      for (int jj = 0; jj < 4; ++jj) S2[r][jj] = f32x2{(diag && (2 * jj == r)) ? 1.f : 0.f, (diag && (2 * jj + 1 == r)) ? 1.f : 0.f};
    const float vsel = role ? 0.f : 1.f;
    for (int blk = 0; blk < 32; ++blk) {
      {
        RwRow R[6];
#pragma unroll
        for (int j = 0; j < 6; ++j) {
          const int st = blk * 8 + role * 4 + j - 1;
          R[j] = rw_load_row(PRW, dir ? (q * 256 + 255 - st) : (q * 256 + st), sq0, sqL, h, lane);
        }
#pragma unroll
        for (int e = 0; e < 4; ++e) {
          const int s = role * 4 + e;
          rw_prologue(R[e], R[e + 1], R[e + 2], lane, c, WU, AU, LT, Wd + s * 64, KKd + s * 64, BBd + s * 64, KDd + s * 64, RRd + s * 64, VVd + s * 64);
        }
      }
      __syncthreads();
#pragma unroll 2
      for (int s = 0; s < 8; ++s) {
        f32x2 kk2[4], w2[4], b2[4], kd2[4], vv2[4];
        RW_LOAD8(kk2, KKd + s * 64 + 8 * kq);
        RW_LOAD8(vv2, VVd + s * 64 + 8 * vq);
        RW_LOAD8(w2, Wd + s * 64 + 8 * kq);
        RW_LOAD8(b2, BBd + s * 64 + 8 * kq);
        RW_LOAD8(kd2, KDd + s * 64 + 8 * kq);
        float sa[8];
#pragma unroll
        for (int r = 0; r < 8; ++r) {
          f32x2 a = S2[r][0] * kk2[0];
          a = S2[r][1] * kk2[1] + a; a = S2[r][2] * kk2[2] + a; a = S2[r][3] * kk2[3] + a;
          sa[r] = -red8(a.x + a.y);
        }
#pragma unroll
        for (int r = 0; r < 8; ++r) {
          const float vr = ((r & 1) ? vv2[r >> 1].y : vv2[r >> 1].x) * vsel;
          const f32x2 sa2 = f32x2{sa[r], sa[r]}, v2 = f32x2{vr, vr};
#pragma unroll
          for (int jj = 0; jj < 4; ++jj) S2[r][jj] = S2[r][jj] * w2[jj] + sa2 * b2[jj] + v2 * kd2[jj];
        }
      }
      __syncthreads();
    }
#pragma unroll
    for (int r = 0; r < 8; ++r) {
      float* dst = Op + (8 * vq + r) * 64 + 8 * kq;
      *(float4*)dst = float4{S2[r][0].x, S2[r][0].y, S2[r][1].x, S2[r][1].y};
      *(float4*)(dst + 4) = float4{S2[r][2].x, S2[r][2].y, S2[r][3].x, S2[r][3].y};
    }
  }
}

__device__ void rwkv_scan3(const Params& p, int i, unsigned char* lds, bool dry = false) {
  const ushort_t* PRW = (const ushort_t*)(p.ws + OFF_PRW);
  float* CH = (float*)(p.ws + OFF_PS5);
  float* YR = (float*)(p.ws + OFF_YS);
  const int tid = tidx(), lane = tid & 63, wave = tid >> 6;
  const int vq = lane >> 3, kq = lane & 7;
  float* TAB = (float*)lds;
  float* WV = (float*)(lds + 24576 + wave * 12544);
  float* Wd = WV, *KKd = WV + 512, *BBd = WV + 1024, *KDd = WV + 1536, *RRd = WV + 2048, *VVd = WV + 2560, *LT = WV + 3072;
  for (int bi = bidx(); bi < 384; bi += gridDim.x) {
    const int h = bi / 48, cgp = bi % 48;
    const int dir = wave >> 2, q = cgp * 4 + (wave & 3);
    __syncthreads();
    for (int e = tid; e < 3 * 2048; e += NT) {
      const int which = e >> 11, j = (e >> 6) & 31, c = e & 63;
      TAB[e] = which < 2 ? p.in[I_WUP][((size_t)(i * 2 + which) * 32 + j) * 512 + h * 64 + c] : p.in[I_AUP][((size_t)i * 32 + j) * 512 + h * 64 + c];
    }
    __syncthreads();
    const float* WU = TAB + dir * 2048;
    const float* AU = TAB + 2 * 2048;
    RwConst c;
    const int cc = h * 64 + lane;
    c.mur = p.in[I_MURKV][(i * 3 + 0) * 512 + cc]; c.muk = p.in[I_MURKV][(i * 3 + 1) * 512 + cc]; c.muv = p.in[I_MURKV][(i * 3 + 2) * 512 + cc];
    c.mul = p.in[I_MULORA][i * 64 + lane];
    c.w0 = p.in[I_W0][(i * 2 + dir) * 512 + cc]; c.a0 = p.in[I_A0][(i * 2 + dir) * 512 + cc];
    c.kk = p.in[I_KK][i * 512 + cc]; c.ka = p.in[I_KA][i * 512 + cc];
    const size_t it = ((size_t)(q * 8 + h) * 2 + dir);
    int sq0, sqL; seq_of(q * 256, sq0, sqL);
    const float* Qp = CH + it * 8192 + 4096;
    f32x2 S2[8][4];
#pragma unroll
    for (int r = 0; r < 8; ++r) {
      const float* src = Qp + (8 * vq + r) * 64 + 8 * kq;
      const float4 a = *(const float4*)src, b = *(const float4*)(src + 4);
      S2[r][0] = f32x2{a.x, a.y}; S2[r][1] = f32x2{a.z, a.w}; S2[r][2] = f32x2{b.x, b.y}; S2[r][3] = f32x2{b.z, b.w};
    }
    for (int blk = 0; blk < 32; ++blk) {
      {
        RwRow R[10];
#pragma unroll
        for (int j = 0; j < 10; ++j) {
          const int st = blk * 8 + j - 1;
          R[j] = rw_load_row(PRW, dir ? (q * 256 + 255 - st) : (q * 256 + st), sq0, sqL, h, lane);
        }
#pragma unroll
        for (int s = 0; s < 8; ++s)
          rw_prologue(R[s], R[s + 1], R[s + 2], lane, c, WU, AU, LT, Wd + s * 64, KKd + s * 64, BBd + s * 64, KDd + s * 64, RRd + s * 64, VVd + s * 64);
      }
      wave_sync();
#pragma unroll 2
      for (int s = 0; s < 8; ++s) {
        f32x2 kk2[4], w2[4], b2[4], kd2[4], vv2[4], r2[4];
        RW_LOAD8(kk2, KKd + s * 64 + 8 * kq);
        RW_LOAD8(vv2, VVd + s * 64 + 8 * vq);
        RW_LOAD8(w2, Wd + s * 64 + 8 * kq);
        RW_LOAD8(b2, BBd + s * 64 + 8 * kq);
        RW_LOAD8(kd2, KDd + s * 64 + 8 * kq);
        RW_LOAD8(r2, RRd + s * 64 + 8 * kq);
        float sa[8];
#pragma unroll
        for (int r = 0; r < 8; ++r) {
          f32x2 a = S2[r][0] * kk2[0];
          a = S2[r][1] * kk2[1] + a; a = S2[r][2] * kk2[2] + a; a = S2[r][3] * kk2[3] + a;
          sa[r] = -red8(a.x + a.y);
        }
        float ysel = 0.f;
#pragma unroll
        for (int r = 0; r < 8; ++r) {
          const float vr = (r & 1) ? vv2[r >> 1].y : vv2[r >> 1].x;
          const f32x2 sa2 = f32x2{sa[r], sa[r]}, v2 = f32x2{vr, vr};
          f32x2 ya = f32x2{0.f, 0.f};
#pragma unroll
          for (int jj = 0; jj < 4; ++jj) {
            S2[r][jj] = S2[r][jj] * w2[jj] + sa2 * b2[jj] + v2 * kd2[jj];
            ya = S2[r][jj] * r2[jj] + ya;
          }
          const float yr = red8(ya.x + ya.y);
          ysel = (kq == r) ? yr : ysel;
        }
        const int st = blk * 8 + s;
        const int tok = dir ? (q * 256 + 255 - st) : (q * 256 + st);
        if (!dry) atomicAdd(YR + (size_t)tok * 512 + h * 64 + lane, ysel);
      }
      wave_sync();
    }
  }
}

__device__ void rwkv_carry(const Params& p, unsigned char* lds, bool dry = false) {
  float* CH = (float*)(p.ws + OFF_PS5);
  float* Ps = (float*)lds;
  float* Ss = Ps + 4096;
  const int tid = tidx(), v = tid >> 4, ks = (tid & 15) * 4;
  for (int bi = bidx(); bi < 192; bi += gridDim.x) {
    const int half = bi & 1, dir = (bi >> 1) & 1, h = (bi >> 2) & 7, s = bi >> 5;
    int cs, n;
    if (s < 4) { cs = s * 16; n = 16; } else { cs = 64 + (s - 4) * 64; n = 64; }
    float4 cur{0.f, 0.f, 0.f, 0.f};
    float4 pq0, pq1, qv;
    {
      const int q = dir ? (cs + n - 1) : cs;
      const float* Pp = CH + ((size_t)(q * 8 + h) * 2 + dir) * 8192;
      pq0 = ((const float4*)Pp)[tid]; pq1 = ((const float4*)Pp)[tid + 512];
      qv = *(const float4*)(Pp + 4096 + (half * 32 + v) * 64 + ks);
    }
    for (int ci = 0; ci < n; ++ci) {
      const int q = dir ? (cs + n - 1 - ci) : (cs + ci);
      float* Pp = CH + ((size_t)(q * 8 + h) * 2 + dir) * 8192;
      float* Qrow = Pp + 4096 + (half * 32 + v) * 64 + ks;
      __syncthreads();
      if (!dry) *(float4*)Qrow = cur;
      if (ci == n - 1) break;
      *(float4*)(Ss + v * 64 + ks) = cur;
      ((float4*)Ps)[tid] = pq0;
      ((float4*)Ps)[tid + 512] = pq1;
      float4 acc = qv;
      if (ci + 2 < n + 1 && ci + 1 < n) {
        const int qn = dir ? (cs + n - 2 - ci) : (cs + ci + 1);
        const float* Pn = CH + ((size_t)(qn * 8 + h) * 2 + dir) * 8192;
        pq0 = ((const float4*)Pn)[tid]; pq1 = ((const float4*)Pn)[tid + 512];
        qv = *(const float4*)(Pn + 4096 + (half * 32 + v) * 64 + ks);
      }
      __syncthreads();
#pragma unroll 8
      for (int j = 0; j < 64; ++j) {
        const float sv = Ss[v * 64 + j];
        const float4 pr = *(const float4*)(Ps + j * 64 + ks);
        acc.x += sv * pr.x; acc.y += sv * pr.y; acc.z += sv * pr.z; acc.w += sv * pr.w;
      }
      cur = acc;
    }
    __syncthreads();
  }
}

__device__ void rwkv_post(const Params& p, int i) {
  const ushort_t* __restrict__ PRW = (const ushort_t*)(p.ws + OFF_PRW);
  const float* __restrict__ YR = (const float*)(p.ws + OFF_YS);
  ushort_t* __restrict__ Y = (ushort_t*)(p.ws + OFF_Y);
  const int lane = tidx() & 63, gw = bidx() * 8 + (tidx() >> 6), nw = gridDim.x * 8;
#pragma unroll 4
  for (int item = gw; item < T * 8; item += nw) {
    const int tok = item >> 3, h = item & 7, cc = h * 64 + lane;
    int s0, L; seq_of(tok, s0, L);
    const ushort_t* row = PRW + (size_t)tok * 2112;
    const bool hm = tok > s0, hp = tok + 1 < s0 + L;
    float r0 = bf2f(row[cc]), k0 = bf2f(row[512 + cc]), v0 = bf2f(row[1024 + cc]);
    float rn = 0.f, kn = 0.f, vn = 0.f;
    if (hm) { const ushort_t* r2 = row - 2112; rn += bf2f(r2[cc]); kn += bf2f(r2[512 + cc]); vn += bf2f(r2[1024 + cc]); }
    if (hp) { const ushort_t* r2 = row + 2112; rn += bf2f(r2[cc]); kn += bf2f(r2[512 + cc]); vn += bf2f(r2[1024 + cc]); }
    const float rr = r0 + p.in[I_MURKV][(i * 3 + 0) * 512 + cc] * (0.5f * rn - r0);
    const float kx = k0 + p.in[I_MURKV][(i * 3 + 1) * 512 + cc] * (0.5f * kn - k0);
    const float vv = v0 + p.in[I_MURKV][(i * 3 + 2) * 512 + cc] * (0.5f * vn - v0);
    const float y = YR[(size_t)tok * 512 + cc];
    const float mean = wsum_fast(y) * (1.f / 64.f);
    const float dlt = y - mean;
    const float var = wsum_fast(dlt * dlt) * (1.f / 64.f);
    const float yn = dlt * __builtin_amdgcn_rsqf(var + 64e-5f) * p.in[I_LNXW][i * 512 + cc] + p.in[I_LNXB][i * 512 + cc];
    const float bonus = wsum_fast(rr * kx * p.in[I_RK][i * 512 + cc]) * vv;
    const float g = bf2f(row[1536 + cc]);
    Y[(size_t)tok * 1024 + 512 + cc] = f2bf((yn + bonus) * (g * fast_sigmoid(g)));
  }
}

__device__ void hy_filter_mlp(const Params& p, int i) {
  float* H2 = (float*)(p.ws + OFF_H2);
  const int lane = tidx() & 63, gw = bidx() * 8 + (tidx() >> 6), nw = gridDim.x * 8;
  const float fr = p.in[I_FFREQ][i * 64 + lane], b1 = p.in[I_FB1][i * 64 + lane], b2 = p.in[I_FB2][i * 64 + lane];
  for (int row = gw; row < 20480; row += nw) {
    const int L = row < 4096 ? 4096 : 16384, t = row < 4096 ? row : row - 4096;
    const float w = 6.283185307179586f * (float)t / (float)L;
    float z = 0.f;
    if (lane == 0) z = (float)t / (float)(L - 1);
    else if (lane <= 32) {
      const int bi = (lane - 1) & 15;
      const float f = 1e-4f + (float)bi * ((15.f - 1e-4f) / 15.f);
      z = lane <= 16 ? cosf(f * w) : -sinf(f * w);
    }
    float a = b1;
#pragma unroll 3
    for (int k = 0; k < 33; ++k) a += __shfl(z, k) * p.in[I_FW1][((size_t)i * 33 + k) * 64 + lane];
    const float h1 = sinf(fr * a);
    float c = b2;
#pragma unroll 8
    for (int k = 0; k < 64; ++k) c += __shfl(h1, k) * p.in[I_FW2][((size_t)i * 64 + k) * 64 + lane];
    H2[(size_t)row * 64 + lane] = sinf(fr * c);
  }
}

DEVI constexpr int swz(int i) { return i ^ ((i & 32) ? 21 : 0) ^ ((i & 64) ? 26 : 0); }
DEVI int swzF(int t) { return (swz(t >> 1) << 1) | (t & 1); }
template <int LOGN>
__device__ void fft_dif(float2* buf) {
  constexpr int N = 1 << LOGN;
  const int tid = tidx();
#pragma unroll
  for (int ps = 0; ps < LOGN / 2; ++ps) {
    const int lh = LOGN - 1 - 2 * ps;
    const int h = 1 << lh, hh = h >> 1;
    const float inv2h = 1.f / (float)(2 * h);
#pragma unroll 2
    for (int q = tid; q < N / 4; q += NT) {
      const int pos = q & (hh - 1), grp = q >> (lh - 1);
      const int e0 = swz((grp << (lh + 1)) + pos);
      const int o1 = swz(hh), o2 = swz(h), o3 = swz(h + hh);
      float2 x0 = buf[e0], x1 = buf[e0 ^ o1], x2 = buf[e0 ^ o2], x3 = buf[e0 ^ o3];
      const float f1 = (float)pos * inv2h;
      const float c1 = __builtin_amdgcn_cosf(f1), s1 = -__builtin_amdgcn_sinf(f1);
      const float c2 = c1 * c1 - s1 * s1, s2 = 2.f * c1 * s1;
      float2 a0{x0.x + x2.x, x0.y + x2.y};
      float2 d2{x0.x - x2.x, x0.y - x2.y};
      float2 a2{d2.x * c1 - d2.y * s1, d2.x * s1 + d2.y * c1};
      float2 a1{x1.x + x3.x, x1.y + x3.y};
      float2 d3{x1.x - x3.x, x1.y - x3.y};
      float2 t3{d3.x * c1 - d3.y * s1, d3.x * s1 + d3.y * c1};
      float2 a3{t3.y, -t3.x};
      float2 y0{a0.x + a1.x, a0.y + a1.y};
      float2 e1{a0.x - a1.x, a0.y - a1.y};
      float2 y1{e1.x * c2 - e1.y * s2, e1.x * s2 + e1.y * c2};
      float2 y2{a2.x + a3.x, a2.y + a3.y};
      float2 e3{a2.x - a3.x, a2.y - a3.y};
      float2 y3{e3.x * c2 - e3.y * s2, e3.x * s2 + e3.y * c2};
      buf[e0] = y0; buf[e0 ^ o1] = y1; buf[e0 ^ o2] = y2; buf[e0 ^ o3] = y3;
    }
    __syncthreads();
  }
}
template <int LOGN>
__device__ void fft_dit_inv(float2* buf) {
  constexpr int N = 1 << LOGN;
  const int tid = tidx();
#pragma unroll
  for (int ps = 0; ps < LOGN / 2; ++ps) {
    const int lh = 2 * ps;
    const int h = 1 << lh;
    const float inv4h = 1.f / (float)(4 * h);
#pragma unroll 2
    for (int q = tid; q < N / 4; q += NT) {
      const int pos = q & (h - 1), grp = q >> lh;
      const int e0 = swz((grp << (lh + 2)) + pos);
      const int o1 = swz(h), o2 = swz(2 * h), o3 = swz(3 * h);
      float2 x0 = buf[e0], x1 = buf[e0 ^ o1], x2 = buf[e0 ^ o2], x3 = buf[e0 ^ o3];
      const float f2 = (float)pos * inv4h;
      const float c2 = __builtin_amdgcn_cosf(f2), s2 = __builtin_amdgcn_sinf(f2);
      const float c1 = c2 * c2 - s2 * s2, s1 = 2.f * c2 * s2;
      float2 b1{x1.x * c1 - x1.y * s1, x1.x * s1 + x1.y * c1};
      float2 b3{x3.x * c1 - x3.y * s1, x3.x * s1 + x3.y * c1};
      float2 a0{x0.x + b1.x, x0.y + b1.y}, a1{x0.x - b1.x, x0.y - b1.y};
      float2 a2{x2.x + b3.x, x2.y + b3.y}, a3{x2.x - b3.x, x2.y - b3.y};
      float2 cc2{a2.x * c2 - a2.y * s2, a2.x * s2 + a2.y * c2};
      float2 t3{a3.x * c2 - a3.y * s2, a3.x * s2 + a3.y * c2};
      float2 cc3{-t3.y, t3.x};
      buf[e0] = float2{a0.x + cc2.x, a0.y + cc2.y};
      buf[e0 ^ o2] = float2{a0.x - cc2.x, a0.y - cc2.y};
      buf[e0 ^ o1] = float2{a1.x + cc3.x, a1.y + cc3.y};
      buf[e0 ^ o3] = float2{a1.x - cc3.x, a1.y - cc3.y};
    }
    __syncthreads();
  }
}
template <int LOGN>
__device__ void spectrum_extract(const float2* buf, float4* __restrict__ GP, float scale) {
  constexpr int Lc = 1 << LOGN;
  for (int j = tidx(); j < Lc / 2; j += NT) {
    if (j == 0) {
      const float2 c = buf[0], ch = buf[1];
      GP[0] = float4{(c.x + c.y) * scale, (c.x - c.y) * scale, ch.x * scale, -ch.y * scale};
    } else {
      const int pos = 2 * j;
      const int k = (int)(__brev((unsigned)pos) >> (32 - LOGN));
      const int p2 = pos ^ ((1 << (31 - __clz(pos))) - 1);
      const int sp1 = swz(pos), sp2 = swz(p2);
      float2 C1 = buf[sp1], C2 = buf[sp2];
      float2 E{0.5f * (C1.x + C2.x), 0.5f * (C1.y - C2.y)}, D{0.5f * (C1.x - C2.x), 0.5f * (C1.y + C2.y)};
      float2 O{D.y, -D.x};
      const float f = (float)k * (1.f / (float)(2 * Lc));
      const float wc = __builtin_amdgcn_cosf(f), wsn = -__builtin_amdgcn_sinf(f);
      float2 wO{wc * O.x - wsn * O.y, wc * O.y + wsn * O.x};
      GP[j] = float4{(E.x + wO.x) * scale, (E.y + wO.y) * scale, (E.x - wO.x) * scale, -(E.y - wO.y) * scale};
    }
  }
}
template <int LOGN>
__device__ void spectrum_mul(float2* buf, const float4* __restrict__ GP) {
  constexpr int Lc = 1 << LOGN;
  for (int j = tidx(); j < Lc / 2; j += NT) {
    const float4 gp = GP[j];
    if (j == 0) {
      const float2 c = buf[0], ch = buf[1];
      const float Y0 = (c.x + c.y) * gp.x, YL = (c.x - c.y) * gp.y;
      buf[0] = float2{0.5f * (Y0 + YL), 0.5f * (Y0 - YL)};
      buf[1] = float2{ch.x * gp.z + ch.y * gp.w, ch.y * gp.z - ch.x * gp.w};
    } else {
      const int pos = 2 * j;
      const int k = (int)(__brev((unsigned)pos) >> (32 - LOGN));
      const int p2 = pos ^ ((1 << (31 - __clz(pos))) - 1);
      const int sp1 = swz(pos), sp2 = swz(p2);
      float2 C1 = buf[sp1], C2 = buf[sp2];
      float2 E{0.5f * (C1.x + C2.x), 0.5f * (C1.y - C2.y)}, D{0.5f * (C1.x - C2.x), 0.5f * (C1.y + C2.y)};
      float2 O{D.y, -D.x};
      const float f = (float)k * (1.f / (float)(2 * Lc));
      const float wc = __builtin_amdgcn_cosf(f), wsn = -__builtin_amdgcn_sinf(f);
      float2 wO{wc * O.x - wsn * O.y, wc * O.y + wsn * O.x};
      float2 X1{E.x + wO.x, E.y + wO.y}, X2{E.x - wO.x, -(E.y - wO.y)};
      float2 Y1{X1.x * gp.x - X1.y * gp.y, X1.x * gp.y + X1.y * gp.x};
      float2 Y2{X2.x * gp.z - X2.y * gp.w, X2.x * gp.w + X2.y * gp.z};
      float2 Ye{0.5f * (Y1.x + Y2.x), 0.5f * (Y1.y - Y2.y)};
      float2 Dd{0.5f * (Y1.x - Y2.x), 0.5f * (Y1.y + Y2.y)};
      float2 Yo{wc * Dd.x + wsn * Dd.y, wc * Dd.y - wsn * Dd.x};
      buf[sp1] = float2{Ye.x - Yo.y, Ye.y + Yo.x};
      buf[sp2] = float2{Ye.x + Yo.y, -Ye.y + Yo.x};
    }
  }
}

template <int LOGN>
__device__ void hy_conv_item(const Params& p, int i, int c, unsigned char* lds, bool dry) {
  constexpr int Lc = 1 << LOGN;
  constexpr int L = Lc;
  constexpr int NB = (LOGN == 14) ? 2 : 4;
  const int tid = tidx();
  float2* buf = (float2*)lds;
  float* bufF = (float*)lds;
  float* W3s = (float*)(lds + 131072);
  float* red = W3s + 256;
  float4* GS = (float4*)(p.ws + OFF_GS + (size_t)bidx() * 2 * GS_PER);
  float4* GS1 = GS + GS_PER / 16;
  float* G1tmp = (float*)GS1;
  float* Z1 = (float*)(p.ws + OFF_Z1 + (size_t)bidx() * 65536);
  const float* H2 = (const float*)(p.ws + OFF_H2) + (LOGN == 14 ? (size_t)4096 * 64 : 0);
  const ushort_t* PH = (const ushort_t*)(p.ws + OFF_PH);
  const float delta = 4.605170185988091f * (1.f / 1.5f + (1.f / 0.3f - 1.f / 1.5f) * (float)c / 1023.f);
  __syncthreads();
  if (tid < 256) {
    const int col = tid >> 6, j = tid & 63, o = col >> 1, dirr = col & 1;
    W3s[tid] = p.in[I_FW3][((size_t)i * 64 + j) * 4096 + (dirr * 2 + o) * 1024 + c];
  }
  __syncthreads();
  float ss0 = 0.f, ss1 = 0.f;
  for (int t = tid; t < L; t += NT) {
    const float4* hr = (const float4*)(H2 + (size_t)t * 64);
    float d0 = 0.f, d1 = 0.f, d2 = 0.f, d3 = 0.f;
#pragma unroll 4
    for (int j4 = 0; j4 < 16; ++j4) {
      const float4 hv = hr[j4];
      const float4 w0 = *(const float4*)(W3s + 4 * j4), w1 = *(const float4*)(W3s + 64 + 4 * j4);
      const float4 w2 = *(const float4*)(W3s + 128 + 4 * j4), w3 = *(const float4*)(W3s + 192 + 4 * j4);
      d0 += hv.x * w0.x + hv.y * w0.y + hv.z * w0.z + hv.w * w0.w;
      d1 += hv.x * w1.x + hv.y * w1.y + hv.z * w1.z + hv.w * w1.w;
      d2 += hv.x * w2.x + hv.y * w2.y + hv.z * w2.z + hv.w * w2.w;
      d3 += hv.x * w3.x + hv.y * w3.y + hv.z * w3.z + hv.w * w3.w;
    }
    const float dec = expf(-((float)t * (1.f / (float)(L - 1))) * delta);
    d0 *= dec; d1 *= dec; d2 *= dec; d3 *= dec;
    ss0 += d0 * d0 + d1 * d1;
    ss1 += d2 * d2 + d3 * d3;
    bufF[swzF(t)] = d0; G1tmp[t] = d2;
    if (t >= 1) { bufF[swzF(2 * L - t)] = d1; G1tmp[2 * L - t] = d3; } else { bufF[swzF(L)] = 0.f; G1tmp[L] = 0.f; }
  }
  ss0 = wsum(ss0); ss1 = wsum(ss1);
  if ((tid & 63) == 0) { red[tid >> 6] = ss0; red[8 + (tid >> 6)] = ss1; }
  __syncthreads();
  float tot0 = 0.f, tot1 = 0.f;
#pragma unroll
  for (int w = 0; w < 8; ++w) { tot0 += red[w]; tot1 += red[8 + w]; }
  fft_dif<LOGN>(buf);
  spectrum_extract<LOGN>(buf, GS, rsqrtf(tot0) * (1.f / (float)Lc));
  __syncthreads();
  for (int t = tid; t < L; t += NT) buf[swz(t)] = ((const float2*)G1tmp)[t];
  __syncthreads();
  fft_dif<LOGN>(buf);
  spectrum_extract<LOGN>(buf, GS1, rsqrtf(tot1) * (1.f / (float)Lc));
  __threadfence_block();
  __syncthreads();
  const float* sw = p.in[I_HSW] + (size_t)i * 3 * 3072;
  const float* sbias = p.in[I_HSB] + (size_t)i * 3072;
  float cw[3][3], cb[3];
#pragma unroll
  for (int st = 0; st < 3; ++st) {
#pragma unroll
    for (int k = 0; k < 3; ++k) cw[st][k] = sw[k * 3072 + st * 1024 + c];
    cb[st] = sbias[st * 1024 + c];
  }
  const float fb0 = p.in[I_FBIAS][((size_t)i * 2 + 0) * 1024 + c], fb1 = p.in[I_FBIAS][((size_t)i * 2 + 1) * 1024 + c];
  for (int b = 0; b < NB; ++b) {
    const int s0 = (LOGN == 14) ? (TPROMPT + b * 16384) : (b * 4096);
    const ushort_t* pv = PH + (size_t)s0 * 1024 + (size_t)c * L;
    const ushort_t* px1 = pv + (size_t)T * 1024;
    const ushort_t* px2 = px1 + (size_t)T * 1024;
    ushort_t* pg = (ushort_t*)px2 + (size_t)T * 1024;
    auto conv8 = [&](const ushort_t* sp, int st, int t0, float* y) {
      const uint4 v = *(const uint4*)(sp + t0);
      const float xm = t0 > 0 ? bf2f(sp[t0 - 1]) : 0.f, xn = t0 + 8 < L ? bf2f(sp[t0 + 8]) : 0.f;
      const float x[10] = {xm, __uint_as_float(v.x << 16), __uint_as_float(v.x & 0xffff0000u), __uint_as_float(v.y << 16), __uint_as_float(v.y & 0xffff0000u),
                           __uint_as_float(v.z << 16), __uint_as_float(v.z & 0xffff0000u), __uint_as_float(v.w << 16), __uint_as_float(v.w & 0xffff0000u), xn};
#pragma unroll
      for (int j = 0; j < 8; ++j) y[j] = cw[st][0] * x[j] + cw[st][1] * x[j + 1] + cw[st][2] * x[j + 2] + cb[st];
    };
    __syncthreads();
    for (int t0 = tid * 8; t0 < L; t0 += NT * 8) {
      float y[8]; conv8(pv, 0, t0, y);
#pragma unroll
      for (int j = 0; j < 4; ++j) { buf[swz((t0 >> 1) + j)] = float2{y[2 * j], y[2 * j + 1]}; buf[swz(L / 2 + (t0 >> 1) + j)] = float2{0.f, 0.f}; }
    }
    __syncthreads();
    fft_dif<LOGN>(buf);
    spectrum_mul<LOGN>(buf, GS);
    __syncthreads();
    fft_dit_inv<LOGN>(buf);
    for (int t0 = tid * 8; t0 < L; t0 += NT * 8) {
      float z0[8], xa[8]; conv8(pv, 0, t0, z0); conv8(px1, 1, t0, xa);
      float z1[8];
#pragma unroll
      for (int j = 0; j < 4; ++j) {
        const int e = swz((t0 >> 1) + j);
        const float2 zc = buf[e];
        z1[2 * j] = xa[2 * j] * (zc.x + z0[2 * j] * fb0); z1[2 * j + 1] = xa[2 * j + 1] * (zc.y + z0[2 * j + 1] * fb0);
        buf[e] = float2{z1[2 * j], z1[2 * j + 1]};
        buf[swz(L / 2 + (t0 >> 1) + j)] = float2{0.f, 0.f};
      }
      *(float4*)(Z1 + t0) = float4{z1[0], z1[1], z1[2], z1[3]};
      *(float4*)(Z1 + t0 + 4) = float4{z1[4], z1[5], z1[6], z1[7]};
    }
    __syncthreads();
    fft_dif<LOGN>(buf);
    spectrum_mul<LOGN>(buf, GS1);
    __syncthreads();
    fft_dit_inv<LOGN>(buf);
    for (int t0 = tid * 8; t0 < L; t0 += NT * 8) {
      float xb[8]; conv8(px2, 2, t0, xb);
      const float4 za = *(const float4*)(Z1 + t0), zb = *(const float4*)(Z1 + t0 + 4);
      const float z1[8] = {za.x, za.y, za.z, za.w, zb.x, zb.y, zb.z, zb.w};
      const uint4 gv = *(const uint4*)(pg + t0);
      const unsigned gw[4] = {gv.x, gv.y, gv.z, gv.w};
      unsigned o[4];
#pragma unroll
      for (int j = 0; j < 4; ++j) {
        const float2 zc = buf[swz((t0 >> 1) + j)];
        const float g0 = __uint_as_float(gw[j] << 16), g1 = __uint_as_float(gw[j] & 0xffff0000u);
        const float y0 = xb[2 * j] * (zc.x + z1[2 * j] * fb1) * (g0 * fast_sigmoid(g0));
        const float y1 = xb[2 * j + 1] * (zc.y + z1[2 * j + 1] * fb1) * (g1 * fast_sigmoid(g1));
        o[j] = pack2(y0, y1);
      }
      if (!dry) *(uint4*)(pg + t0) = uint4{o[0], o[1], o[2], o[3]};
    }
  }
}

__device__ void hy_conv_phase(const Params& p, int i, unsigned char* lds, bool dry = false) {
  for (int it = bidx(); it < 2048; it += gridDim.x) {
    if (it < 1024) hy_conv_item<14>(p, i, it, lds, dry);
    else hy_conv_item<12>(p, i, it - 1024, lds, dry);
    __syncthreads();
  }
}

#ifndef PROBE_MASK
#define PROBE_MASK 0
#endif
#ifndef PH_MASK
#define PH_MASK 0x1ffff
#endif
#define PHM(n) ((PH_MASK >> (n)) & 1)
DEVI void run_phase(const Params& p, int ph, unsigned char* lds, bool dry = false) {
  const int layer = ph < NPH_EVEN ? 0 : ph < NPH_EVEN + NPH_ODD ? 1 : ph < 2 * NPH_EVEN + NPH_ODD ? 2 : 3;
  const int base = layer == 0 ? 0 : layer == 1 ? NPH_EVEN : layer == 2 ? NPH_EVEN + NPH_ODD : 2 * NPH_EVEN + NPH_ODD;
  const int sp = ph - base, i = layer >> 1;
  unsigned char* ws = p.ws;
  ushort_t* WB = (ushort_t*)(ws + OFF_WB);
  if ((layer & 1) == 0) {
    ushort_t* WinT = WB; ushort_t* WoutT = WB + 3328 * 1024; ushort_t* GluT = WoutT + 1024 * 1024;
    switch (sp) {
      case 0: if (PHM(0)) {
        transpose_bf16(p.in[I_EWIN] + (size_t)i * 1024 * 3136, WinT, 1024, 3136, lds);
        zero_fill(WinT + 3136 * 1024, 192 * 1024);
        transpose_bf16(p.in[I_EWOUT] + (size_t)i * 1024 * 1024, WoutT, 1024, 1024, lds);
        transpose_bf16(p.in[I_GLUW] + (size_t)i * 512 * 512, GluT, 512, 512, lds);
        if (layer == 0) xb_convert(p, (ushort_t*)(ws + OFF_Y));
        } break;
      case 1: if (PHM(1)) run_gemm(lds, (const ushort_t*)(ws + OFF_Y), 1024, WinT, 3328, 1024, pg8::EpiEvenIn{(ushort_t*)(ws + OFF_PS5), (ushort_t*)(ws + OFF_PRW)}); break;
      case 2: if (PHM(2)) s5_passA(p, i, lds); break;
      case 3: if (PHM(3)) s5_passC(p, i, lds); break;
      case 4: if (PHM(4)) run_gemm(lds, (const ushort_t*)(ws + OFF_Y) + 512, 1024, GluT, 512, 512, pg8::EpiGlu{(ushort_t*)(ws + OFF_Y), (const ushort_t*)(ws + OFF_PS5), p.in[I_GLUB] + i * 512}); break;
      case 5: if (PHM(5)) rwkv_scan1(p, i, lds); break;
      case 6: if (PHM(6)) rwkv_carry(p, lds, dry); break;
      case 7: if (PHM(7)) rwkv_scan3(p, i, lds, dry); break;
      case 8: if (PHM(8)) rwkv_post(p, i); break;
      case 9: if (PHM(9)) run_gemm(lds, (const ushort_t*)(ws + OFF_Y), 1024, WoutT, 1024, 1024, pg8::EpiF32{(float*)(ws + OFF_PRW)}); break;
      case 10: if (PHM(10)) ln_phase(p, layer, (const float*)(ws + OFF_PRW), (ushort_t*)(ws + OFF_XB_ODD), dry); break;
    }
  } else {
    ushort_t* HinT = WB; ushort_t* HoutT = WB + 4096 * 1024;
    switch (sp) {
      case 0: if (PHM(11)) {
        transpose_bf16(p.in[I_HWIN] + (size_t)i * 1024 * 4096, HinT, 1024, 4096, lds);
        transpose_bf16(p.in[I_HWOUT] + (size_t)i * 1024 * 1024, HoutT, 1024, 1024, lds);
        hy_filter_mlp(p, i);
        } break;
      case 1: if (PHM(12)) run_gemm(lds, (const ushort_t*)(ws + OFF_XB_ODD), 1024, HinT, 4096, 1024, pg8::EpiHyIn{(ushort_t*)(ws + OFF_PH)}); break;
      case 2: if (PHM(13)) hy_conv_phase(p, i, lds, dry); break;
      case 3: if (PHM(14)) hy_transpose((const ushort_t*)(ws + OFF_PH + 3 * SZ1), (ushort_t*)(ws + OFF_PH), lds); break;
      case 4: if (PHM(15)) run_gemm(lds, (const ushort_t*)(ws + OFF_PH), 1024, HoutT, 1024, 1024, pg8::EpiF32{(float*)(ws + OFF_PH + SZ1)}); break;
      case 5: if (PHM(16)) ln_phase(p, layer, (const float*)(ws + OFF_PH + SZ1), layer < 3 ? (ushort_t*)(ws + OFF_Y) : (ushort_t*)nullptr, dry); break;
    }
  }
}

#if ONE_LAUNCH
__global__ void __launch_bounds__(NT) fwd_kernel(Params p) {
  extern __shared__ __attribute__((aligned(16))) unsigned char lds[];
#if ONE_LAUNCH
  cg::grid_group grid = cg::this_grid();
#endif
  for (int ph = p.ph_lo; ph < p.ph_hi; ++ph) {
#if PROBE_MASK
    {
      const int lyr = ph < NPH_EVEN ? 0 : ph < NPH_EVEN + NPH_ODD ? 1 : ph < 2 * NPH_EVEN + NPH_ODD ? 2 : 3;
      const int bs = lyr == 0 ? 0 : lyr == 1 ? NPH_EVEN : lyr == 2 ? NPH_EVEN + NPH_ODD : 2 * NPH_EVEN + NPH_ODD;
      const int idx = (lyr & 1) ? NPH_EVEN + (ph - bs) : (ph - bs);
      if ((PROBE_MASK >> idx) & 1) { run_phase(p, ph, lds, true); grid.sync(); }
    }
#endif
    run_phase(p, ph, lds);
#if ONE_LAUNCH
    if (ph + 1 < p.ph_hi) grid.sync();
#endif
  }
}
#endif

#if !ONE_LAUNCH
template <int PH> __global__ void __launch_bounds__(NT) phase_kernel(Params p) {
  extern __shared__ __attribute__((aligned(16))) unsigned char lds[];
  run_phase(p, PH, lds);
}
typedef void (*kfn_t)(Params);
#define PK(n) phase_kernel<n>
static kfn_t k_tab[NPHASES] = {PK(0), PK(1), PK(2), PK(3), PK(4), PK(5), PK(6), PK(7), PK(8), PK(9), PK(10), PK(11), PK(12), PK(13), PK(14), PK(15),
                               PK(16), PK(17), PK(18), PK(19), PK(20), PK(21), PK(22), PK(23), PK(24), PK(25), PK(26), PK(27), PK(28), PK(29), PK(30), PK(31), PK(32), PK(33)};
#endif

extern "C" void kernel_launch(void* const* d_in, const int* in_sizes, int n_in, void* d_out, int out_size, void* d_ws, size_t ws_size,
                              hipStream_t stream) {
  static int grid_blocks = 0;
  if (!grid_blocks) {
    if (n_in != 38 || ws_size < WS_NEED || out_size != T * 1024) {
      fprintf(stderr, "kernel_launch: unexpected shapes n_in=%d ws=%zu out=%d\n", n_in, ws_size, out_size);
      grid_blocks = -1; return;
    }
    int dev = 0, cus = 0, per_cu = 0;
    (void)hipGetDevice(&dev);
    (void)hipDeviceGetAttribute(&cus, hipDeviceAttributeMultiprocessorCount, dev);
#if ONE_LAUNCH
    if (hipFuncSetAttribute((const void*)fwd_kernel, hipFuncAttributeMaxDynamicSharedMemorySize, LDS_BYTES) != hipSuccess) {
      fprintf(stderr, "kernel_launch: hipFuncSetAttribute failed\n"); grid_blocks = -1; return;
    }
    (void)hipOccupancyMaxActiveBlocksPerMultiprocessor(&per_cu, (const void*)fwd_kernel, NT, LDS_BYTES);
#else
    for (int ph = 0; ph < NPHASES; ++ph)
      if (hipFuncSetAttribute((const void*)k_tab[ph], hipFuncAttributeMaxDynamicSharedMemorySize, LDS_BYTES) != hipSuccess) {
        fprintf(stderr, "kernel_launch: hipFuncSetAttribute failed\n"); grid_blocks = -1; return;
      }
    per_cu = 1;
#endif
    if (per_cu < 1) { fprintf(stderr, "kernel_launch: occupancy query returned %d\n", per_cu); per_cu = 1; }
    grid_blocks = cus * per_cu;
    if (grid_blocks > 256) grid_blocks = 256;
    if (grid_blocks < 1) grid_blocks = 256;
  }
  if (grid_blocks < 0) return;
  Params p{};
  for (int k = 0; k < 38; ++k) p.in[k] = (const float*)d_in[k];
  p.out = (float*)d_out; p.ws = (unsigned char*)d_ws;
#if ONE_LAUNCH
  p.ph_lo = 0; p.ph_hi = NPHASES;
  void* args[] = {&p};
  hipError_t e = hipLaunchCooperativeKernel((const void*)fwd_kernel, dim3(grid_blocks), dim3(NT), args, LDS_BYTES, stream);
  if (e != hipSuccess) fprintf(stderr, "cooperative launch failed: %s (grid %d)\n", hipGetErrorString(e), grid_blocks);
#else
  for (int ph = 0; ph < NPHASES; ++ph) {
    p.ph_lo = ph; p.ph_hi = ph + 1;
    hipLaunchKernelGGL(k_tab[ph], dim3(grid_blocks), dim3(NT), LDS_BYTES, stream, p);
  }
#endif
}
```

```cpp
#include <hip/hip_runtime.h>
#include <hip/hip_cooperative_groups.h>
#include <cstdio>
#include <cstdint>
namespace cg = cooperative_groups;

#ifndef ONE_LAUNCH
#define ONE_LAUNCH 1
#endif

#define DEVI __device__ __forceinline__
constexpr int NT = 512;
constexpr int T = 49152;
constexpr int TPROMPT = 16384;
constexpr int LDS_BYTES = 133120;
constexpr int NPH_EVEN = 11, NPH_ODD = 6;
constexpr int NPHASES = 2 * (NPH_EVEN + NPH_ODD);

typedef __attribute__((ext_vector_type(8))) short bf16x8;
typedef __attribute__((ext_vector_type(4))) float f32x4;
typedef unsigned short ushort_t;

struct Params { const float* in[38]; float* out; unsigned char* ws; int ph_lo; int ph_hi; };

enum { I_XP = 0, I_XS, I_EWIN, I_EWOUT, I_LRE, I_LIM, I_LSTEP, I_BRE, I_BIM, I_CRE, I_CIM, I_S5D, I_GLUW, I_GLUB,
       I_MURKV, I_MULORA, I_W0, I_WUP, I_A0, I_AUP, I_KK, I_KA, I_RK, I_LNXW, I_LNXB,
       I_HWIN, I_HWOUT, I_HSW, I_HSB, I_FW1, I_FB1, I_FFREQ, I_FW2, I_FB2, I_FW3, I_FBIAS, I_LNG, I_LNB };

constexpr size_t SZ1 = (size_t)T * 1024 * 2;
constexpr size_t OFF_PS5 = 0;
constexpr size_t OFF_PRW = OFF_PS5 + SZ1;
constexpr size_t OFF_Y = OFF_PRW + (size_t)T * 2112 * 2;
constexpr size_t OFF_YS = OFF_Y + SZ1;
constexpr size_t OFF_WB = OFF_YS + SZ1;
constexpr size_t OFF_CAR = OFF_WB + 10485760;
constexpr size_t OFF_BAR = OFF_CAR + 6291456;
constexpr size_t WS_NEED = OFF_BAR + 16384;
constexpr size_t OFF_PH = 0;
constexpr size_t OFF_GS = 4 * SZ1;
constexpr size_t GS_PER = 131328;
constexpr size_t OFF_Z1 = OFF_GS + 256 * 2 * GS_PER;
constexpr size_t OFF_XB_ODD = 4 * SZ1;
constexpr size_t OFF_H2 = OFF_XB_ODD + SZ1;

DEVI int tidx() { int t = threadIdx.x; asm volatile("" : "+v"(t)); return t; }
DEVI int bidx() { int b = blockIdx.x; asm volatile("" : "+s"(b)); return b; }
DEVI ushort_t f2bf(float f) { unsigned u = __float_as_uint(f); u += 0x7fffu + ((u >> 16) & 1u); return (ushort_t)(u >> 16); }
DEVI float bf2f(ushort_t h) { return __uint_as_float(((unsigned)h) << 16); }
DEVI unsigned pack2(float a, float b) { return (unsigned)f2bf(a) | ((unsigned)f2bf(b) << 16); }
DEVI float wsum(float v) {
#pragma unroll
  for (int m = 32; m >= 1; m >>= 1) v += __shfl_xor(v, m);
  return v;
}
DEVI void wave_sync() { __builtin_amdgcn_fence(__ATOMIC_RELEASE, "wavefront"); __builtin_amdgcn_wave_barrier(); __builtin_amdgcn_fence(__ATOMIC_ACQUIRE, "wavefront"); }
DEVI void seq_of(int tok, int& s0, int& L) {
  if (tok < TPROMPT) { s0 = tok & ~4095; L = 4096; } else { s0 = TPROMPT + ((tok - TPROMPT) & ~16383); L = 16384; }
}
struct XSrc { const float* xp; const float* xs; const float* xo; };
DEVI XSrc xsrc(const Params& p) {
  XSrc x; x.xp = p.in[I_XP]; x.xs = p.in[I_XS]; x.xo = p.out;
  asm volatile("" : "+s"(x.xp), "+s"(x.xs), "+s"(x.xo));
  return x;
}
DEVI const float* xrow(const XSrc& x, int layer, int tok) {
  if (layer == 0) return tok < TPROMPT ? x.xp + (size_t)tok * 1024 : x.xs + (size_t)(tok - TPROMPT) * 1024;
  return x.xo + (size_t)tok * 1024;
}
DEVI float sigmoidf_(float x) { return 1.f / (1.f + expf(-x)); }
DEVI float fast_sigmoid(float x) { return __builtin_amdgcn_rcpf(1.f + __builtin_amdgcn_exp2f(-1.4426950408889634f * x)); }
DEVI float fast_tanh(float x) { return 1.f - 2.f * __builtin_amdgcn_rcpf(1.f + __builtin_amdgcn_exp2f(2.8853900817779268f * x)); }
DEVI float dpp_mov_f(float x, const int sel) {
  int xi = __builtin_bit_cast(int, x), r;
  if (sel == 0) r = __builtin_amdgcn_mov_dpp(xi, 0xB1, 0xf, 0xf, true);
  else if (sel == 1) r = __builtin_amdgcn_mov_dpp(xi, 0x4E, 0xf, 0xf, true);
  else if (sel == 2) r = __builtin_amdgcn_mov_dpp(xi, 0x141, 0xf, 0xf, true);
  else r = __builtin_amdgcn_mov_dpp(xi, 0x140, 0xf, 0xf, true);
  return __builtin_bit_cast(float, r);
}
DEVI float wsum_fast(float v) {
  v += dpp_mov_f(v, 0); v += dpp_mov_f(v, 1); v += dpp_mov_f(v, 2); v += dpp_mov_f(v, 3);
  const int vi = __builtin_bit_cast(int, v);
  return __builtin_bit_cast(float, __builtin_amdgcn_readlane(vi, 0)) + __builtin_bit_cast(float, __builtin_amdgcn_readlane(vi, 16)) +
         __builtin_bit_cast(float, __builtin_amdgcn_readlane(vi, 32)) + __builtin_bit_cast(float, __builtin_amdgcn_readlane(vi, 48));
}
DEVI float gelu_tanh(float x) { return 0.5f * x * (1.f + tanhf(0.7978845608f * (x + 0.044715f * x * x * x))); }

__device__ void transpose_bf16(const float* __restrict__ in, ushort_t* __restrict__ out, int K, int N, unsigned char* lds) {
  float* tile = (float*)lds;
  const int tid = tidx(), j = tid & 63, i0 = tid >> 6;
  const int tk = K / 64, tn = N / 64;
  for (int t = bidx(); t < tk * tn; t += gridDim.x) {
    const int k0 = (t / tn) * 64, n0 = (t % tn) * 64;
#pragma unroll
    for (int e = 0; e < 8; ++e) { int i = i0 + 8 * e; tile[i * 65 + j] = in[(size_t)(k0 + i) * N + n0 + j]; }
    __syncthreads();
#pragma unroll
    for (int e = 0; e < 8; ++e) { int i = i0 + 8 * e; out[(size_t)(n0 + i) * K + k0 + j] = f2bf(tile[j * 65 + i]); }
    __syncthreads();
  }
}

namespace pg8 {
#define PG8_LAS __attribute__((address_space(3)))
typedef unsigned u32x4 __attribute__((ext_vector_type(4)));
constexpr int BM = 256, BK = 64, HALF = 128, HTB = HALF * BK * 2, STAGE_BYTES = 8 * HTB, NXCD = 8, WGM = 8;
DEVI int lds_byte(int r, int c) { const int st = (r >> 4) * 2 + (c >> 5), rr = r & 15, cc = c & 31, ob = rr * 64 + cc * 2; return st * 1024 + (ob ^ (((ob >> 9) & 1) << 5)); }
DEVI void stage_rc(int b, int& R, int& C) { const int st = b / 1024, sb = b % 1024, swz = sb ^ (((sb >> 9) & 1) << 5); R = (st >> 1) * 16 + swz / 64; C = (st & 1) * 32 + (swz % 64) / 2; }
DEVI int perm32(int rho) { const int n = rho >> 4, i = rho & 15; return 8 * (i >> 2) + 4 * n + (i & 3); }
struct Unit { int pm, pn; };
struct Gemm { const ushort_t* A; const ushort_t* Bt; int M, N, K, lda; };
struct StaticOrder {
  int nM, nN, nwg, G, c;
  DEVI void init(int M, int N, int G_, int c_) { nM = M / BM; nN = N / BM; nwg = nM * nN; G = G_; c = c_; }
  DEVI bool next(int i, Unit& u) const {
    const long L = (long)i * G + c; if (L >= nwg) return false;
    int wgid = (int)L; { const int q = nwg / NXCD, r = nwg % NXCD, xcd = wgid % NXCD, off = wgid / NXCD; wgid = (xcd < r ? xcd * (q + 1) : r * (q + 1) + (xcd - r) * q) + off; }
    const int nig = WGM * nN, gid = wgid / nig, fm = gid * WGM, gsz = (nM - fm) < WGM ? (nM - fm) : WGM;
    u.pm = fm + ((wgid % nig) % gsz); u.pn = (wgid % nig) / gsz; return true;
  }
};
DEVI unsigned cvt_pk_bf16(float lo, float hi) { unsigned r; asm volatile("v_cvt_pk_bf16_f32 %0, %1, %2" : "=v"(r) : "v"(lo), "v"(hi)); return r; }

template <class Epi>
DEVI void gemm_phase(PG8_LAS unsigned char* lds, const Gemm g, const StaticOrder& S, const Epi& E) {
  const int tid = tidx(), wid = __builtin_amdgcn_readfirstlane(tid >> 6), lane = tid & 63, wr = wid >> 2, wc = wid & 3, fr = lane & 15, fq = lane >> 4;
  const int K = g.K, nt = K / BK, lda = g.lda;
  unsigned voffA[2], voffB[2];
#pragma unroll
  for (int i = 0; i < 2; ++i) { int R, C; stage_rc(tid * 16 + i * 8192, R, C); const int Rb = Epi::PERM ? ((R & ~31) + perm32(R & 31)) : R;
    voffA[i] = (unsigned)(R * lda + C) * 2u; voffB[i] = (unsigned)(Rb * K + C) * 2u; }
  const size_t kstep = (size_t)(BK * 2);
  const size_t hstepA = (size_t)HALF * lda * 2, hstepB = (size_t)HALF * K * 2;
  const size_t tstepA = 2 * hstepA, tstepB = 2 * hstepB;
  const unsigned ldsw = (unsigned)wid * 1024u;
  const int aoff = lds_byte(wr * 64 + fr, fq * 8), boff = lds_byte(wc * 32 + fr, fq * 8);
#define PG8_SA(b, h) (((b) * 2 + (h)) * HTB)
#define PG8_SB(b, h) ((4 + (b) * 2 + (h)) * HTB)
#define PG8_STAGE(bufoff, gbase, voff) do { _Pragma("unroll") for (int _i = 0; _i < 2; ++_i) \
    __builtin_amdgcn_global_load_lds((const unsigned*)((const char*)(gbase) + (voff)[_i]), (PG8_LAS unsigned*)(lds + (bufoff) + ldsw + _i * 8192), 16, 0, 0); } while (0)
#define PG8_LDA(dst, b, h) do { _Pragma("unroll") for (int m = 0; m < 4; ++m) _Pragma("unroll") for (int k = 0; k < 2; ++k) dst[m][k] = *(const PG8_LAS bf16x8*)(lds + PG8_SA(b, h) + aoff + m * 2048 + k * 1024); } while (0)
#define PG8_LDB(dst, b, h) do { _Pragma("unroll") for (int n = 0; n < 2; ++n) _Pragma("unroll") for (int k = 0; k < 2; ++k) dst[n][k] = *(const PG8_LAS bf16x8*)(lds + PG8_SB(b, h) + boff + n * 2048 + k * 1024); } while (0)
#define PG8_MMA(ai, bj, At, Bt) do { __builtin_amdgcn_s_setprio(1); _Pragma("unroll") for (int m = 0; m < 4; ++m) _Pragma("unroll") for (int n = 0; n < 2; ++n) _Pragma("unroll") for (int k = 0; k < 2; ++k) \
    acc[ai][bj][m][n] = Epi::TRANS ? __builtin_amdgcn_mfma_f32_16x16x32_bf16(Bt[n][k], At[m][k], acc[ai][bj][m][n], 0, 0, 0) \
                                   : __builtin_amdgcn_mfma_f32_16x16x32_bf16(At[m][k], Bt[n][k], acc[ai][bj][m][n], 0, 0, 0); __builtin_amdgcn_s_setprio(0); } while (0)
#define PG8_WAIT_V(n) asm volatile("s_waitcnt vmcnt(" #n ")" ::: "memory")
#define PG8_WAIT_L(n) asm volatile("s_waitcnt lgkmcnt(" #n ")" ::: "memory")
#define PG8_BAR __builtin_amdgcn_s_barrier()
#define PG8_SCHED __builtin_amdgcn_sched_barrier(0)
  Unit cur, nxt; int ui = 0;
  if (!S.next(0, cur)) return;
  f32x4 acc[2][2][4][2];
#pragma unroll
  for (int a = 0; a < 2; ++a)
#pragma unroll
    for (int b = 0; b < 2; ++b)
#pragma unroll
      for (int m = 0; m < 4; ++m)
#pragma unroll
        for (int n = 0; n < 2; ++n) acc[a][b][m][n] = (f32x4){0.f, 0.f, 0.f, 0.f};
  bf16x8 At[4][2], B0[2][2], B1[2][2];
  const char* cA = (const char*)g.A + (size_t)cur.pm * tstepA; const char* cB = (const char*)g.Bt + (size_t)cur.pn * tstepB;
  PG8_STAGE(PG8_SB(0, 0), cB, voffB); PG8_STAGE(PG8_SA(0, 0), cA, voffA); PG8_STAGE(PG8_SB(0, 1), cB + hstepB, voffB); PG8_STAGE(PG8_SA(0, 1), cA + hstepA, voffA);
  if (wr == 1) PG8_BAR;
  PG8_WAIT_V(4); PG8_BAR;
  PG8_STAGE(PG8_SB(1, 0), cB + kstep, voffB); PG8_STAGE(PG8_SA(1, 0), cA + kstep, voffA); PG8_STAGE(PG8_SB(1, 1), cB + hstepB + kstep, voffB);
  PG8_WAIT_V(6); PG8_BAR;
  for (;;) {
    const bool has_next = S.next(ui + 1, nxt);
    const char* nA = has_next ? (const char*)g.A + (size_t)nxt.pm * tstepA : cA; const char* nB = has_next ? (const char*)g.Bt + (size_t)nxt.pn * tstepB : cB;
    for (int t = 0; t < nt; t += 2) {
      const bool last = (t == nt - 2);
      const char* a1 = cA + (size_t)(t + 1) * kstep;
      const char* a2 = last ? nA : cA + (size_t)(t + 2) * kstep; const char* b2 = last ? nB : cB + (size_t)(t + 2) * kstep;
      const char* a3 = a2 + kstep; const char* b3 = b2 + kstep;
      PG8_LDB(B0, 0, 0); PG8_SCHED; PG8_LDA(At, 0, 0); PG8_STAGE(PG8_SA(1, 1), a1 + hstepA, voffA);
      PG8_WAIT_L(8); PG8_BAR; PG8_WAIT_L(0); PG8_MMA(0, 0, At, B0); PG8_BAR; PG8_SCHED;
      PG8_LDB(B1, 0, 1); PG8_STAGE(PG8_SB(0, 0), b2, voffB);
      PG8_BAR; PG8_WAIT_L(0); PG8_MMA(0, 1, At, B1); PG8_BAR;
      PG8_LDA(At, 0, 1); PG8_STAGE(PG8_SA(0, 0), a2, voffA);
      PG8_BAR; PG8_WAIT_L(0); PG8_MMA(1, 0, At, B0); PG8_BAR; PG8_SCHED;
      PG8_STAGE(PG8_SB(0, 1), b2 + hstepB, voffB);
      PG8_WAIT_V(6); PG8_BAR; PG8_MMA(1, 1, At, B1); PG8_BAR;
      PG8_LDB(B0, 1, 0); PG8_SCHED; PG8_LDA(At, 1, 0); PG8_STAGE(PG8_SA(0, 1), a2 + hstepA, voffA);
      PG8_WAIT_L(8); PG8_BAR; PG8_WAIT_L(0); PG8_MMA(0, 0, At, B0); PG8_BAR; PG8_SCHED;
      PG8_LDB(B1, 1, 1); PG8_STAGE(PG8_SB(1, 0), b3, voffB);
      PG8_BAR; PG8_WAIT_L(0); PG8_MMA(0, 1, At, B1); PG8_BAR;
      PG8_LDA(At, 1, 1); PG8_STAGE(PG8_SA(1, 0), a3, voffA);
      PG8_BAR; PG8_WAIT_L(0); PG8_MMA(1, 0, At, B0); PG8_BAR; PG8_SCHED;
      PG8_STAGE(PG8_SB(1, 1), b3 + hstepB, voffB);
      PG8_WAIT_V(6); PG8_BAR; PG8_MMA(1, 1, At, B1); PG8_BAR;
    }
    E(acc, cur, wr, wc, fr, fq);
    if (!has_next) break;
#pragma unroll
    for (int a = 0; a < 2; ++a)
#pragma unroll
      for (int b = 0; b < 2; ++b)
#pragma unroll
        for (int m = 0; m < 4; ++m)
#pragma unroll
          for (int n = 0; n < 2; ++n) acc[a][b][m][n] = (f32x4){0.f, 0.f, 0.f, 0.f};
    cur = nxt; cA = nA; cB = nB; ++ui;
  }
  PG8_WAIT_V(0);
  if (wr == 0) PG8_BAR;
  PG8_BAR;
#undef PG8_SA
#undef PG8_SB
#undef PG8_STAGE
#undef PG8_LDA
#undef PG8_LDB
#undef PG8_MMA
#undef PG8_WAIT_V
#undef PG8_WAIT_L
#undef PG8_BAR
#undef PG8_SCHED
}

struct EpiEvenIn {
  static constexpr bool PERM = true, TRANS = true;
  ushort_t* ps5; ushort_t* prw;
  DEVI void operator()(const f32x4 (&acc)[2][2][4][2], const Unit& u, int wr, int wc, int fr, int fq) const {
#pragma unroll
    for (int ai = 0; ai < 2; ++ai)
#pragma unroll
      for (int m = 0; m < 4; ++m) {
        const size_t row = (size_t)u.pm * BM + ai * HALF + wr * 64 + m * 16 + fr;
#pragma unroll
        for (int bj = 0; bj < 2; ++bj) {
          const int c0 = u.pn * BM + bj * HALF + wc * 32 + 8 * fq;
          const f32x4 v0 = acc[ai][bj][m][0], v1 = acc[ai][bj][m][1];
          u32x4 o = {cvt_pk_bf16(v0[0], v0[1]), cvt_pk_bf16(v0[2], v0[3]), cvt_pk_bf16(v1[0], v1[1]), cvt_pk_bf16(v1[2], v1[3])};
          if (c0 < 1024) *(u32x4*)(ps5 + row * 1024 + c0) = o;
          else if (c0 < 3136) *(u32x4*)(prw + row * 2112 + (c0 - 1024)) = o;
        }
      }
  }
};
struct EpiHyIn {
  static constexpr bool PERM = false, TRANS = false;
  ushort_t* ph;
  DEVI void operator()(const f32x4 (&acc)[2][2][4][2], const Unit& u, int wr, int wc, int fr, int fq) const {
    int s0, L; seq_of(u.pm * BM, s0, L);
#pragma unroll
    for (int ai = 0; ai < 2; ++ai)
#pragma unroll
      for (int m = 0; m < 4; ++m) {
        const int tok = u.pm * BM + ai * HALF + wr * 64 + m * 16 + 4 * fq;
#pragma unroll
        for (int bj = 0; bj < 2; ++bj)
#pragma unroll
          for (int n = 0; n < 2; ++n) {
            const int col = u.pn * BM + bj * HALF + wc * 32 + 16 * n + fr;
            const int st = col >> 10, c = col & 1023;
            const f32x4 v = acc[ai][bj][m][n];
            ushort_t* dst = ph + (size_t)st * T * 1024 + (size_t)s0 * 1024 + (size_t)c * L + (tok - s0);
            *(uint2*)dst = uint2{cvt_pk_bf16(v[0], v[1]), cvt_pk_bf16(v[2], v[3])};
          }
      }
  }
};
struct EpiGlu {
  static constexpr bool PERM = true, TRANS = true;
  ushort_t* y; const ushort_t* ps5; const float* bias;
  DEVI void operator()(const f32x4 (&acc)[2][2][4][2], const Unit& u, int wr, int wc, int fr, int fq) const {
#pragma unroll
    for (int ai = 0; ai < 2; ++ai)
#pragma unroll
      for (int m = 0; m < 4; ++m) {
        const size_t row = (size_t)u.pm * BM + ai * HALF + wr * 64 + m * 16 + fr;
#pragma unroll
        for (int bj = 0; bj < 2; ++bj) {
          const int c0 = u.pn * BM + bj * HALF + wc * 32 + 8 * fq;
          const u32x4 a8 = *(const u32x4*)(y + row * 1024 + 512 + c0);
          const u32x4 g8 = *(const u32x4*)(ps5 + row * 1024 + 512 + c0);
          const f32x4 b0 = *(const f32x4*)(bias + c0), b1 = *(const f32x4*)(bias + c0 + 4);
          float v[8];
#pragma unroll
          for (int e = 0; e < 4; ++e) { v[e] = acc[ai][bj][m][0][e] + b0[e]; v[4 + e] = acc[ai][bj][m][1][e] + b1[e]; }
          unsigned o[4];
#pragma unroll
          for (int e = 0; e < 4; ++e) {
            const float a_lo = __uint_as_float(a8[e] << 16), a_hi = __uint_as_float(a8[e] & 0xffff0000u);
            const float g_lo = __uint_as_float(g8[e] << 16), g_hi = __uint_as_float(g8[e] & 0xffff0000u);
            const float r_lo = a_lo * sigmoidf_(v[2 * e]) * (g_lo * sigmoidf_(g_lo));
            const float r_hi = a_hi * sigmoidf_(v[2 * e + 1]) * (g_hi * sigmoidf_(g_hi));
            o[e] = cvt_pk_bf16(r_lo, r_hi);
          }
          *(u32x4*)(y + row * 1024 + c0) = u32x4{o[0], o[1], o[2], o[3]};
        }
      }
  }
};
struct EpiF32 {
  static constexpr bool PERM = false, TRANS = true;
  float* C;
  DEVI void operator()(const f32x4 (&acc)[2][2][4][2], const Unit& u, int wr, int wc, int fr, int fq) const {
#pragma unroll
    for (int ai = 0; ai < 2; ++ai)
#pragma unroll
      for (int m = 0; m < 4; ++m) {
        float* rowp = C + ((size_t)u.pm * BM + ai * HALF + wr * 64 + m * 16 + fr) * 1024 + u.pn * BM + wc * 32 + 4 * fq;
#pragma unroll
        for (int bj = 0; bj < 2; ++bj)
#pragma unroll
          for (int n = 0; n < 2; ++n) *(f32x4*)(rowp + bj * HALF + n * 16) = acc[ai][bj][m][n];
      }
  }
};
}

template <class Epi>
DEVI void run_gemm(unsigned char* lds, const ushort_t* A, int lda, const ushort_t* Bt, int N, int K, const Epi& E) {
  pg8::Gemm g; g.A = A; g.Bt = Bt; g.M = T; g.N = N; g.K = K; g.lda = lda;
  pg8::StaticOrder S; S.init(T, N, (int)gridDim.x, bidx());
  __syncthreads();
  pg8::gemm_phase<Epi>((PG8_LAS unsigned char*)lds, g, S, E);
  __syncthreads();
}

__device__ void xb_convert(const Params& p, ushort_t* XB) {
  const size_t n4 = (size_t)T * 1024 / 4, np4 = (size_t)TPROMPT * 1024 / 4;
  const float4* xp = (const float4*)p.in[I_XP]; const float4* xs = (const float4*)p.in[I_XS];
  for (size_t e = (size_t)bidx() * NT + tidx(); e < n4; e += (size_t)gridDim.x * NT) {
    const float4 v = e < np4 ? xp[e] : xs[e - np4];
    ((uint2*)XB)[e] = uint2{pack2(v.x, v.y), pack2(v.z, v.w)};
  }
}
__device__ void zero_fill(ushort_t* dst, size_t n) {
  for (size_t e = (size_t)bidx() * NT + tidx(); e < n / 8; e += (size_t)gridDim.x * NT) ((uint4*)dst)[e] = uint4{0, 0, 0, 0};
}
__device__ void hy_transpose(const ushort_t* __restrict__ PH3, ushort_t* __restrict__ Y, unsigned char* lds) {
  ushort_t* tile = (ushort_t*)lds;
  const int tid = tidx(), j = tid & 63, i0 = tid >> 6;
  for (int t = bidx(); t < (T / 64) * 16; t += gridDim.x) {
    const int tok0 = (t >> 4) * 64, c0 = (t & 15) * 64;
    int s0, L; seq_of(tok0, s0, L);
    __syncthreads();
#pragma unroll
    for (int e = 0; e < 8; ++e) { const int i = i0 + 8 * e; tile[i * 66 + j] = PH3[(size_t)s0 * 1024 + (size_t)(c0 + i) * L + (tok0 - s0) + j]; }
    __syncthreads();
#pragma unroll
    for (int e = 0; e < 8; ++e) { const int i = i0 + 8 * e; Y[(size_t)(tok0 + i) * 1024 + c0 + j] = tile[j * 66 + i]; }
  }
}

__device__ void ln_phase(const Params& p, int layer, const float* __restrict__ F, ushort_t* __restrict__ XB, bool dry = false) {
  const int lane = tidx() & 63, gw = bidx() * (NT / 64) + (tidx() >> 6), nw = gridDim.x * (NT / 64);
  const float alpha = 1.681792830507429f;
  const float4* g4 = (const float4*)(p.in[I_LNG] + layer * 1024);
  const float4* b4 = (const float4*)(p.in[I_LNB] + layer * 1024);
  const XSrc xs_ = xsrc(p);
  for (int row = gw; row < T; row += nw) {
    const float4* x4 = (const float4*)xrow(xs_, layer, row);
    const float4* f4 = (const float4*)(F + (size_t)row * 1024);
    float4 v[4];
    float s = 0.f;
#pragma unroll
    for (int e = 0; e < 4; ++e) {
      float4 a = x4[lane + 64 * e], f = f4[lane + 64 * e];
      v[e] = float4{alpha * a.x + f.x, alpha * a.y + f.y, alpha * a.z + f.z, alpha * a.w + f.w};
      s += v[e].x + v[e].y + v[e].z + v[e].w;
    }
    const float mean = wsum(s) * (1.f / 1024.f);
    float q = 0.f;
#pragma unroll
    for (int e = 0; e < 4; ++e) {
      v[e].x -= mean; v[e].y -= mean; v[e].z -= mean; v[e].w -= mean;
      q += v[e].x * v[e].x + v[e].y * v[e].y + v[e].z * v[e].z + v[e].w * v[e].w;
    }
    const float rs = rsqrtf(wsum(q) * (1.f / 1024.f) + 1e-5f);
    float4* o4 = (float4*)(p.out + (size_t)row * 1024);
#pragma unroll
    for (int e = 0; e < 4; ++e) {
      float4 g = g4[lane + 64 * e], b = b4[lane + 64 * e];
      const float4 o = float4{v[e].x * rs * g.x + b.x, v[e].y * rs * g.y + b.y, v[e].z * rs * g.z + b.z, v[e].w * rs * g.w + b.w};
      if (!dry) o4[lane + 64 * e] = o;
      if (XB) ((uint2*)(XB + (size_t)row * 1024))[lane + 64 * e] = uint2{pack2(o.x, o.y), pack2(o.z, o.w)};
    }
  }
}

struct cplx { float x, y; };
DEVI cplx cmul(cplx a, cplx b) { return cplx{a.x * b.x - a.y * b.y, a.x * b.y + a.y * b.x}; }
DEVI void s5_consts(const Params& p, int i, int d, int g, int n, cplx& lb, cplx& coef) {
  const int idx = ((i * 2 + d) * 32 + g) * 64 + n;
  const float lre = p.in[I_LRE][idx], lim = p.in[I_LIM][idx];
  const float dt = expf(p.in[I_LSTEP][(i * 2 + d) * 32 + g]);
  const float mag = expf(lre * dt);
  float sn, cs; sincosf(lim * dt, &sn, &cs);
  lb = cplx{mag * cs, mag * sn};
  const float nr = lb.x - 1.f, ni = lb.y, den = 1.f / (lre * lre + lim * lim);
  coef = cplx{(nr * lre + ni * lim) * den, (ni * lre - nr * lim) * den};
}
DEVI void s5_stage_u(const ushort_t* PS5, int tok0, int g, float* U, int lane) {
  const uint4* src = (const uint4*)(PS5 + (size_t)(tok0 + lane) * 1024 + g * 16);
  uint4 a = src[0], b = src[1];
  float4* d = (float4*)(U + lane * 16);
  d[0] = float4{__uint_as_float(a.x << 16), __uint_as_float(a.x & 0xffff0000u), __uint_as_float(a.y << 16), __uint_as_float(a.y & 0xffff0000u)};
  d[1] = float4{__uint_as_float(a.z << 16), __uint_as_float(a.z & 0xffff0000u), __uint_as_float(a.w << 16), __uint_as_float(a.w & 0xffff0000u)};
  d[2] = float4{__uint_as_float(b.x << 16), __uint_as_float(b.x & 0xffff0000u), __uint_as_float(b.y << 16), __uint_as_float(b.y & 0xffff0000u)};
  d[3] = float4{__uint_as_float(b.z << 16), __uint_as_float(b.z & 0xffff0000u), __uint_as_float(b.w << 16), __uint_as_float(b.w & 0xffff0000u)};
}
#define S5_BU(Urow, bur, bui)                                                         \
  {                                                                                   \
    const float4* u4 = (const float4*)(Urow);                                         \
    bur = 0.f; bui = 0.f;                                                             \
    _Pragma("unroll") for (int pp = 0; pp < 4; ++pp) {                                \
      float4 u = u4[pp];                                                              \
      bur += Br[4 * pp] * u.x + Br[4 * pp + 1] * u.y + Br[4 * pp + 2] * u.z + Br[4 * pp + 3] * u.w; \
      bui += Bi[4 * pp] * u.x + Bi[4 * pp + 1] * u.y + Bi[4 * pp + 2] * u.z + Bi[4 * pp + 3] * u.w; \
    }                                                                                 \
  }

__device__ void s5_passA(const Params& p, int i, unsigned char* lds) {
  const ushort_t* PS5 = (const ushort_t*)(p.ws + OFF_PS5);
  cplx* CAR = (cplx*)(p.ws + OFF_CAR);
  const int lane = tidx() & 63, wave = tidx() >> 6;
  float* U = (float*)(lds + wave * 8448);
  for (int item = bidx() * 8 + wave; item < 192 * 32; item += gridDim.x * 8) {
    const int q = item >> 5, g = item & 31;
    cplx lb0, c0, lb1, c1;
    s5_consts(p, i, 0, g, lane, lb0, c0);
    s5_consts(p, i, 1, g, lane, lb1, c1);
    float Br[16], Bi[16];
#pragma unroll
    for (int pp = 0; pp < 16; ++pp) { Br[pp] = p.in[I_BRE][((i * 32 + g) * 64 + lane) * 16 + pp]; Bi[pp] = p.in[I_BIM][((i * 32 + g) * 64 + lane) * 16 + pp]; }
    cplx xf{0.f, 0.f}, xb{0.f, 0.f}, pw{1.f, 0.f};
    for (int sb = 0; sb < 4; ++sb) {
      wave_sync();
      s5_stage_u(PS5, q * 256 + sb * 64, g, U, lane);
      wave_sync();
      for (int t = 0; t < 64; ++t) {
        float bur, bui;
        S5_BU(U + t * 16, bur, bui);
        xf = cmul(lb0, xf); xf.x += bur; xf.y += bui;
        xb.x += pw.x * bur - pw.y * bui; xb.y += pw.x * bui + pw.y * bur;
        pw = cmul(pw, lb1);
      }
    }
    CAR[((size_t)(q * 32 + g) * 2 + 0) * 64 + lane] = cmul(xf, c0);
    CAR[((size_t)(q * 32 + g) * 2 + 1) * 64 + lane] = cmul(xb, c1);
  }
}

__device__ void s5_passC(const Params& p, int i, unsigned char* lds) {
  const ushort_t* PS5 = (const ushort_t*)(p.ws + OFF_PS5);
  const cplx* CAR = (const cplx*)(p.ws + OFF_CAR);
  float* YS = (float*)(p.ws + OFF_YS);
  ushort_t* YG = (ushort_t*)(p.ws + OFF_Y);
  const int lane = tidx() & 63, wave = tidx() >> 6;
  float* U = (float*)(lds + wave * 8448);
  ushort_t* X = (ushort_t*)(lds + wave * 8448 + 4096);
  for (int item = bidx() * 8 + wave; item < 192 * 32; item += gridDim.x * 8) {
    const int q = item >> 5, g = item & 31;
    int cs, ce;
    if (q < 64) { cs = q & ~15; ce = cs + 16; } else { cs = 64 + ((q - 64) & ~63); ce = cs + 64; }
    float Br[16], Bi[16];
#pragma unroll
    for (int pp = 0; pp < 16; ++pp) { Br[pp] = p.in[I_BRE][((i * 32 + g) * 64 + lane) * 16 + pp]; Bi[pp] = p.in[I_BIM][((i * 32 + g) * 64 + lane) * 16 + pp]; }
    const int pcol = lane & 15;
    const float dd = p.in[I_S5D][i * 512 + g * 16 + pcol];
    for (int d = 0; d < 2; ++d) {
      cplx lb, coef;
      s5_consts(p, i, d, g, lane, lb, coef);
      cplx lp = lb;
#pragma unroll
      for (int e = 0; e < 8; ++e) lp = cmul(lp, lp);
      cplx xs{0.f, 0.f};
      if (d == 0) {
#pragma unroll 8
        for (int j = cs; j < q; ++j) { xs = cmul(lp, xs); cplx c = CAR[((size_t)(j * 32 + g) * 2 + 0) * 64 + lane]; xs.x += c.x; xs.y += c.y; } }
      else {
#pragma unroll 8
        for (int j = ce - 1; j > q; --j) { xs = cmul(lp, xs); cplx c = CAR[((size_t)(j * 32 + g) * 2 + 1) * 64 + lane]; xs.x += c.x; xs.y += c.y; } }
      bf16x8 cf[4];
#pragma unroll
      for (int kk = 0; kk < 4; ++kk) {
        const int n0 = (kk & 1) * 32 + (lane >> 4) * 8;
        const float* src = (kk < 2 ? p.in[I_CRE] : p.in[I_CIM]) + (((size_t)(i * 2 + d) * 32 + g) * 16 + pcol) * 64 + n0;
        const float sg = kk < 2 ? 1.f : -1.f;
#pragma unroll
        for (int j = 0; j < 8; ++j) cf[kk][j] = (short)f2bf(sg * src[j]);
      }
      for (int sbi = 0; sbi < 4; ++sbi) {
        const int sb = d ? 3 - sbi : sbi;
        wave_sync();
        s5_stage_u(PS5, q * 256 + sb * 64, g, U, lane);
        wave_sync();
        for (int tbi = 0; tbi < 4; ++tbi) {
          const int tb = d ? 3 - tbi : tbi;
          for (int tti = 0; tti < 16; ++tti) {
            const int tt = d ? 15 - tti : tti;
            float bur, bui;
            S5_BU(U + (tb * 16 + tt) * 16, bur, bui);
            xs = cmul(lb, xs);
            xs.x += coef.x * bur - coef.y * bui;
            xs.y += coef.x * bui + coef.y * bur;
            X[tt * 136 + lane] = f2bf(xs.x);
            X[tt * 136 + 64 + lane] = f2bf(xs.y);
          }
          wave_sync();
          f32x4 acc{0.f, 0.f, 0.f, 0.f};
#pragma unroll
          for (int kk = 0; kk < 4; ++kk) {
            bf16x8 a = *(const bf16x8*)(X + (lane & 15) * 136 + kk * 32 + (lane >> 4) * 8);
            acc = __builtin_amdgcn_mfma_f32_16x16x32_bf16(a, cf[kk], acc, 0, 0, 0);
          }
          wave_sync();
#pragma unroll
          for (int r = 0; r < 4; ++r) {
            const int tl = tb * 16 + (lane >> 4) * 4 + r;
            const size_t o = (size_t)(q * 256 + sb * 64 + tl) * 512 + g * 16 + pcol;
            if (d == 0) YS[o] = acc[r] + dd * U[tl * 16 + pcol];
            else {
              const float yv = YS[o] + acc[r];
              YG[(size_t)(q * 256 + sb * 64 + tl) * 1024 + 512 + g * 16 + pcol] = f2bf(gelu_tanh(yv));
            }
          }
        }
      }
    }
  }
}

struct RwConst { float mur, muk, muv, mul, w0, a0, kk, ka; };
struct RwRow { float r, k, v, l; };
DEVI RwRow rw_load_row(const ushort_t* PRW, int tok, int s0, int L, int h, int lane) {
  RwRow o{0.f, 0.f, 0.f, 0.f};
  if (tok >= s0 && tok < s0 + L) {
    const ushort_t* row = PRW + (size_t)tok * 2112;
    const int cc = h * 64 + lane;
    o.r = bf2f(row[cc]); o.k = bf2f(row[512 + cc]); o.v = bf2f(row[1024 + cc]); o.l = bf2f(row[2048 + lane]);
  }
  return o;
}
DEVI void rw_prologue(const RwRow& rm, const RwRow& rc, const RwRow& rn, int lane, const RwConst& c, const float* WU, const float* AU,
                      float* LT, float* Wd, float* KKd, float* BBd, float* KDd, float* RRd, float* VVd) {
  const float rr = rc.r + c.mur * (0.5f * (rm.r + rn.r) - rc.r);
  const float kx = rc.k + c.muk * (0.5f * (rm.k + rn.k) - rc.k);
  const float vv = rc.v + c.muv * (0.5f * (rm.v + rn.v) - rc.v);
  float ll = rc.l + c.mul * (0.5f * (rm.l + rn.l) - rc.l);
  ll = lane < 32 ? fast_tanh(ll) : ll;
  wave_sync();
  LT[lane] = ll;
  wave_sync();
  float accw = c.w0, acca = c.a0;
#pragma unroll 2
  for (int j = 0; j < 32; j += 4) {
    float4 lw = *(const float4*)(LT + j), la = *(const float4*)(LT + 32 + j);
    accw += lw.x * WU[(j + 0) * 64 + lane] + lw.y * WU[(j + 1) * 64 + lane] + lw.z * WU[(j + 2) * 64 + lane] + lw.w * WU[(j + 3) * 64 + lane];
    acca += la.x * AU[(j + 0) * 64 + lane] + la.y * AU[(j + 1) * 64 + lane] + la.z * AU[(j + 2) * 64 + lane] + la.w * AU[(j + 3) * 64 + lane];
  }
  const float dec = __builtin_amdgcn_exp2f(-0.8750387749145276f * fast_sigmoid(accw));
  const float a = fast_sigmoid(acca);
  const float kkr = kx * c.kk;
  const float ss = wsum_fast(kkr * kkr);
  const float kkn = kkr * __builtin_amdgcn_rsqf(fmaxf(ss, 1e-24f));
  Wd[lane] = dec; KKd[lane] = kkn; BBd[lane] = kkn * a; KDd[lane] = kx * (1.f + (a - 1.f) * c.ka); RRd[lane] = rr; VVd[lane] = vv;
}

typedef float f32x2 __attribute__((ext_vector_type(2)));
DEVI float dpp_f(float x, const int ctrl_sel) {
  int xi = __builtin_bit_cast(int, x), r;
  if (ctrl_sel == 0) r = __builtin_amdgcn_mov_dpp(xi, 0xB1, 0xf, 0xf, true);
  else if (ctrl_sel == 1) r = __builtin_amdgcn_mov_dpp(xi, 0x4E, 0xf, 0xf, true);
  else r = __builtin_amdgcn_mov_dpp(xi, 0x141, 0xf, 0xf, true);
  return __builtin_bit_cast(float, r);
}
DEVI float red8(float x) { x += dpp_f(x, 0); x += dpp_f(x, 1); x += dpp_f(x, 2); return x; }

#define RW_LOAD8(dst2, base)                                                        \
  { const float4 _a = *(const float4*)(base), _b = *(const float4*)((base) + 4);    \
    dst2[0] = f32x2{_a.x, _a.y}; dst2[1] = f32x2{_a.z, _a.w}; dst2[2] = f32x2{_b.x, _b.y}; dst2[3] = f32x2{_b.z, _b.w}; }

__device__ void rwkv_scan1(const Params& p, int i, unsigned char* lds) {
  const ushort_t* PRW = (const ushort_t*)(p.ws + OFF_PRW);
  float* CH = (float*)(p.ws + OFF_PS5);
  float* YR = (float*)(p.ws + OFF_YS);
  const int tid = tidx(), lane = tid & 63, wave = tid >> 6, pair = wave >> 1, role = wave & 1;
  const int vq = lane >> 3, kq = lane & 7;
  float* TAB = (float*)lds;
  float* WV = (float*)(lds + 24576 + pair * 12800);
  float* Wd = WV, *KKd = WV + 512, *BBd = WV + 1024, *KDd = WV + 1536, *RRd = WV + 2048, *VVd = WV + 2560, *LT = WV + 3072 + role * 64;
  {
    float4* z = (float4*)YR;
    for (size_t e = (size_t)bidx() * NT + tid; e < (size_t)T * 512 / 4; e += (size_t)gridDim.x * NT) z[e] = float4{0.f, 0.f, 0.f, 0.f};
  }
  for (int bi = bidx(); bi < 768; bi += gridDim.x) {
    const int h = bi / 96, rem = bi % 96;
    const int dir = pair >> 1, q = rem * 2 + (pair & 1);
    __syncthreads();
    for (int e = tid; e < 3 * 2048; e += NT) {
      const int which = e >> 11, j = (e >> 6) & 31, c = e & 63;
      TAB[e] = which < 2 ? p.in[I_WUP][((size_t)(i * 2 + which) * 32 + j) * 512 + h * 64 + c] : p.in[I_AUP][((size_t)i * 32 + j) * 512 + h * 64 + c];
    }
    __syncthreads();
    const float* WU = TAB + dir * 2048;
    const float* AU = TAB + 2 * 2048;
    RwConst c;
    const int cc = h * 64 + lane;
    c.mur = p.in[I_MURKV][(i * 3 + 0) * 512 + cc]; c.muk = p.in[I_MURKV][(i * 3 + 1) * 512 + cc]; c.muv = p.in[I_MURKV][(i * 3 + 2) * 512 + cc];
    c.mul = p.in[I_MULORA][i * 64 + lane];
    c.w0 = p.in[I_W0][(i * 2 + dir) * 512 + cc]; c.a0 = p.in[I_A0][(i * 2 + dir) * 512 + cc];
    c.kk = p.in[I_KK][i * 512 + cc]; c.ka = p.in[I_KA][i * 512 + cc];
    const size_t it = ((size_t)(q * 8 + h) * 2 + dir);
    int sq0, sqL; seq_of(q * 256, sq0, sqL);
    float* Op = CH + it * 8192 + (role ? 0 : 4096);
    f32x2 S2[8][4];
    int diag = (role && vq == kq) ? 1 : 0;
    asm volatile("" : "+v"(diag));
#pragma unroll
    for (int r = 0; r < 8; ++r)
#pragma unroll
      for (int jj = 0; jj < 4; ++jj) S2[r][jj] = f32x2{(diag && (2 * jj == r)) ? 1.f : 0.f, (diag && (2 * jj + 1 == r)) ? 1.f : 0.f};
    const float vsel = role ? 0.f : 1.f;
    for (int blk = 0; blk < 32; ++blk) {
      {
        RwRow R[6];
#pragma unroll
        for (int j = 0; j < 6; ++j) {
          const int st = blk * 8 + role * 4 + j - 1;
          R[j] = rw_load_row(PRW, dir ? (q * 256 + 255 - st) : (q * 256 + st), sq0, sqL, h, lane);
        }
#pragma unroll
        for (int e = 0; e < 4; ++e) {
          const int s = role * 4 + e;
          rw_prologue(R[e], R[e + 1], R[e + 2], lane, c, WU, AU, LT, Wd + s * 64, KKd + s * 64, BBd + s * 64, KDd + s * 64, RRd + s * 64, VVd + s * 64);
        }
      }
      __syncthreads();
#pragma unroll 2
      for (int s = 0; s < 8; ++s) {
        f32x2 kk2[4], w2[4], b2[4], kd2[4], vv2[4];
        RW_LOAD8(kk2, KKd + s * 64 + 8 * kq);
        RW_LOAD8(vv2, VVd + s * 64 + 8 * vq);
        RW_LOAD8(w2, Wd + s * 64 + 8 * kq);
        RW_LOAD8(b2, BBd + s * 64 + 8 * kq);
        RW_LOAD8(kd2, KDd + s * 64 + 8 * kq);
        float sa[8];
#pragma unroll
        for (int r = 0; r < 8; ++r) {
          f32x2 a = S2[r][0] * kk2[0];
          a = S2[r][1] * kk2[1] + a; a = S2[r][2] * kk2[2] + a; a = S2[r][3] * kk2[3] + a;
          sa[r] = -red8(a.x + a.y);
        }
#pragma unroll
        for (int r = 0; r < 8; ++r) {
          const float vr = ((r & 1) ? vv2[r >> 1].y : vv2[r >> 1].x) * vsel;
          const f32x2 sa2 = f32x2{sa[r], sa[r]}, v2 = f32x2{vr, vr};
#pragma unroll
          for (int jj = 0; jj < 4; ++jj) S2[r][jj] = S2[r][jj] * w2[jj] + sa2 * b2[jj] + v2 * kd2[jj];
        }
      }
      __syncthreads();
    }
#pragma unroll
    for (int r = 0; r < 8; ++r) {
      float* dst = Op + (8 * vq + r) * 64 + 8 * kq;
      *(float4*)dst = float4{S2[r][0].x, S2[r][0].y, S2[r][1].x, S2[r][1].y};
      *(float4*)(dst + 4) = float4{S2[r][2].x, S2[r][2].y, S2[r][3].x, S2[r][3].y};
    }
  }
}

__device__ void rwkv_scan3(const Params& p, int i, unsigned char* lds, bool dry = false) {
  const ushort_t* PRW = (const ushort_t*)(p.ws + OFF_PRW);
  float* CH = (float*)(p.ws + OFF_PS5);
  float* YR = (float*)(p.ws + OFF_YS);
  const int tid = tidx(), lane = tid & 63, wave = tid >> 6;
  const int vq = lane >> 3, kq = lane & 7;
  float* TAB = (float*)lds;
  float* WV = (float*)(lds + 24576 + wave * 12544);
  float* Wd = WV, *KKd = WV + 512, *BBd = WV + 1024, *KDd = WV + 1536, *RRd = WV + 2048, *VVd = WV + 2560, *LT = WV + 3072;
  for (int bi = bidx(); bi < 384; bi += gridDim.x) {
    const int h = bi / 48, cgp = bi % 48;
    const int dir = wave >> 2, q = cgp * 4 + (wave & 3);
    __syncthreads();
    for (int e = tid; e < 3 * 2048; e += NT) {
      const int which = e >> 11, j = (e >> 6) & 31, c = e & 63;
      TAB[e] = which < 2 ? p.in[I_WUP][((size_t)(i * 2 + which) * 32 + j) * 512 + h * 64 + c] : p.in[I_AUP][((size_t)i * 32 + j) * 512 + h * 64 + c];
    }
    __syncthreads();
    const float* WU = TAB + dir * 2048;
    const float* AU = TAB + 2 * 2048;
    RwConst c;
    const int cc = h * 64 + lane;
    c.mur = p.in[I_MURKV][(i * 3 + 0) * 512 + cc]; c.muk = p.in[I_MURKV][(i * 3 + 1) * 512 + cc]; c.muv = p.in[I_MURKV][(i * 3 + 2) * 512 + cc];
    c.mul = p.in[I_MULORA][i * 64 + lane];
    c.w0 = p.in[I_W0][(i * 2 + dir) * 512 + cc]; c.a0 = p.in[I_A0][(i * 2 + dir) * 512 + cc];
    c.kk = p.in[I_KK][i * 512 + cc]; c.ka = p.in[I_KA][i * 512 + cc];
    const size_t it = ((size_t)(q * 8 + h) * 2 + dir);
    int sq0, sqL; seq_of(q * 256, sq0, sqL);
    const float* Qp = CH + it * 8192 + 4096;
    f32x2 S2[8][4];
#pragma unroll
    for (int r = 0; r < 8; ++r) {
      const float* src = Qp + (8 * vq + r) * 64 + 8 * kq;
      const float4 a = *(const float4*)src, b = *(const float4*)(src + 4);
      S2[r][0] = f32x2{a.x, a.y}; S2[r][1] = f32x2{a.z, a.w}; S2[r][2] = f32x2{b.x, b.y}; S2[r][3] = f32x2{b.z, b.w};
    }
    for (int blk = 0; blk < 32; ++blk) {
      {
        RwRow R[10];
#pragma unroll
        for (int j = 0; j < 10; ++j) {
          const int st = blk * 8 + j - 1;
          R[j] = rw_load_row(PRW, dir ? (q * 256 + 255 - st) : (q * 256 + st), sq0, sqL, h, lane);
        }
#pragma unroll
        for (int s = 0; s < 8; ++s)
          rw_prologue(R[s], R[s + 1], R[s + 2], lane, c, WU, AU, LT, Wd + s * 64, KKd + s * 64, BBd + s * 64, KDd + s * 64, RRd + s * 64, VVd + s * 64);
      }
      wave_sync();
#pragma unroll 2
      for (int s = 0; s < 8; ++s) {
        f32x2 kk2[4], w2[4], b2[4], kd2[4], vv2[4], r2[4];
        RW_LOAD8(kk2, KKd + s * 64 + 8 * kq);
        RW_LOAD8(vv2, VVd + s * 64 + 8 * vq);
        RW_LOAD8(w2, Wd + s * 64 + 8 * kq);
        RW_LOAD8(b2, BBd + s * 64 + 8 * kq);
        RW_LOAD8(kd2, KDd + s * 64 + 8 * kq);
        RW_LOAD8(r2, RRd + s * 64 + 8 * kq);
        float sa[8];
#pragma unroll
        for (int r = 0; r < 8; ++r) {
          f32x2 a = S2[r][0] * kk2[0];
          a = S2[r][1] * kk2[1] + a; a = S2[r][2] * kk2[2] + a; a = S2[r][3] * kk2[3] + a;
          sa[r] = -red8(a.x + a.y);
        }
        float ysel = 0.f;
#pragma unroll
        for (int r = 0; r < 8; ++r) {
          const float vr = (r & 1) ? vv2[r >> 1].y : vv2[r >> 1].x;
          const f32x2 sa2 = f32x2{sa[r], sa[r]}, v2 = f32x2{vr, vr};
          f32x2 ya = f32x2{0.f, 0.f};
#pragma unroll
          for (int jj = 0; jj < 4; ++jj) {
            S2[r][jj] = S2[r][jj] * w2[jj] + sa2 * b2[jj] + v2 * kd2[jj];
            ya = S2[r][jj] * r2[jj] + ya;
          }
          const float yr = red8(ya.x + ya.y);
          ysel = (kq == r) ? yr : ysel;
        }
        const int st = blk * 8 + s;
        const int tok = dir ? (q * 256 + 255 - st) : (q * 256 + st);
        if (!dry) atomicAdd(YR + (size_t)tok * 512 + h * 64 + lane, ysel);
      }
      wave_sync();
    }
  }
}

__device__ void rwkv_carry(const Params& p, unsigned char* lds, bool dry = false) {
  float* CH = (float*)(p.ws + OFF_PS5);
  float* Ps = (float*)lds;
  float* Ss = Ps + 4096;
  const int tid = tidx(), v = tid >> 4, ks = (tid & 15) * 4;
  for (int bi = bidx(); bi < 192; bi += gridDim.x) {
    const int half = bi & 1, dir = (bi >> 1) & 1, h = (bi >> 2) & 7, s = bi >> 5;
    int cs, n;
    if (s < 4) { cs = s * 16; n = 16; } else { cs = 64 + (s - 4) * 64; n = 64; }
    float4 cur{0.f, 0.f, 0.f, 0.f};
    float4 pq0, pq1, qv;
    {
      const int q = dir ? (cs + n - 1) : cs;
      const float* Pp = CH + ((size_t)(q * 8 + h) * 2 + dir) * 8192;
      pq0 = ((const float4*)Pp)[tid]; pq1 = ((const float4*)Pp)[tid + 512];
      qv = *(const float4*)(Pp + 4096 + (half * 32 + v) * 64 + ks);
    }
    for (int ci = 0; ci < n; ++ci) {
      const int q = dir ? (cs + n - 1 - ci) : (cs + ci);
      float* Pp = CH + ((size_t)(q * 8 + h) * 2 + dir) * 8192;
      float* Qrow = Pp + 4096 + (half * 32 + v) * 64 + ks;
      __syncthreads();
      if (!dry) *(float4*)Qrow = cur;
      if (ci == n - 1) break;
      *(float4*)(Ss + v * 64 + ks) = cur;
      ((float4*)Ps)[tid] = pq0;
      ((float4*)Ps)[tid + 512] = pq1;
      float4 acc = qv;
      if (ci + 2 < n + 1 && ci + 1 < n) {
        const int qn = dir ? (cs + n - 2 - ci) : (cs + ci + 1);
        const float* Pn = CH + ((size_t)(qn * 8 + h) * 2 + dir) * 8192;
        pq0 = ((const float4*)Pn)[tid]; pq1 = ((const float4*)Pn)[tid + 512];
        qv = *(const float4*)(Pn + 4096 + (half * 32 + v) * 64 + ks);
      }
      __syncthreads();
#pragma unroll 8
      for (int j = 0; j < 64; ++j) {
        const float sv = Ss[v * 64 + j];
        const float4 pr = *(const float4*)(Ps + j * 64 + ks);
        acc.x += sv * pr.x; acc.y += sv * pr.y; acc.z += sv * pr.z; acc.w += sv * pr.w;
      }
      cur = acc;
    }
    __syncthreads();
  }
}

__device__ void rwkv_post(const Params& p, int i) {
  const ushort_t* __restrict__ PRW = (const ushort_t*)(p.ws + OFF_PRW);
  const float* __restrict__ YR = (const float*)(p.ws + OFF_YS);
  ushort_t* __restrict__ Y = (ushort_t*)(p.ws + OFF_Y);
  const int lane = tidx() & 63, gw = bidx() * 8 + (tidx() >> 6), nw = gridDim.x * 8;
#pragma unroll 4
  for (int item = gw; item < T * 8; item += nw) {
    const int tok = item >> 3, h = item & 7, cc = h * 64 + lane;
    int s0, L; seq_of(tok, s0, L);
    const ushort_t* row = PRW + (size_t)tok * 2112;
    const bool hm = tok > s0, hp = tok + 1 < s0 + L;
    float r0 = bf2f(row[cc]), k0 = bf2f(row[512 + cc]), v0 = bf2f(row[1024 + cc]);
    float rn = 0.f, kn = 0.f, vn = 0.f;
    if (hm) { const ushort_t* r2 = row - 2112; rn += bf2f(r2[cc]); kn += bf2f(r2[512 + cc]); vn += bf2f(r2[1024 + cc]); }
    if (hp) { const ushort_t* r2 = row + 2112; rn += bf2f(r2[cc]); kn += bf2f(r2[512 + cc]); vn += bf2f(r2[1024 + cc]); }
    const float rr = r0 + p.in[I_MURKV][(i * 3 + 0) * 512 + cc] * (0.5f * rn - r0);
    const float kx = k0 + p.in[I_MURKV][(i * 3 + 1) * 512 + cc] * (0.5f * kn - k0);
    const float vv = v0 + p.in[I_MURKV][(i * 3 + 2) * 512 + cc] * (0.5f * vn - v0);
    const float y = YR[(size_t)tok * 512 + cc];
    const float mean = wsum_fast(y) * (1.f / 64.f);
    const float dlt = y - mean;
    const float var = wsum_fast(dlt * dlt) * (1.f / 64.f);
    const float yn = dlt * __builtin_amdgcn_rsqf(var + 64e-5f) * p.in[I_LNXW][i * 512 + cc] + p.in[I_LNXB][i * 512 + cc];
    const float bonus = wsum_fast(rr * kx * p.in[I_RK][i * 512 + cc]) * vv;
    const float g = bf2f(row[1536 + cc]);
    Y[(size_t)tok * 1024 + 512 + cc] = f2bf((yn + bonus) * (g * fast_sigmoid(g)));
  }
}

__device__ void hy_filter_mlp(const Params& p, int i) {
  float* H2 = (float*)(p.ws + OFF_H2);
  const int lane = tidx() & 63, gw = bidx() * 8 + (tidx() >> 6), nw = gridDim.x * 8;
  const float fr = p.in[I_FFREQ][i * 64 + lane], b1 = p.in[I_FB1][i * 64 + lane], b2 = p.in[I_FB2][i * 64 + lane];
  for (int row = gw; row < 20480; row += nw) {
    const int L = row < 4096 ? 4096 : 16384, t = row < 4096 ? row : row - 4096;
    const float w = 6.283185307179586f * (float)t / (float)L;
    float z = 0.f;
    if (lane == 0) z = (float)t / (float)(L - 1);
    else if (lane <= 32) {
      const int bi = (lane - 1) & 15;
      const float f = 1e-4f + (float)bi * ((15.f - 1e-4f) / 15.f);
      z = lane <= 16 ? cosf(f * w) : -sinf(f * w);
    }
    float a = b1;
#pragma unroll 3
    for (int k = 0; k < 33; ++k) a += __shfl(z, k) * p.in[I_FW1][((size_t)i * 33 + k) * 64 + lane];
    const float h1 = sinf(fr * a);
    float c = b2;
#pragma unroll 8
    for (int k = 0; k < 64; ++k) c += __shfl(h1, k) * p.in[I_FW2][((size_t)i * 64 + k) * 64 + lane];
    H2[(size_t)row * 64 + lane] = sinf(fr * c);
  }
}

DEVI constexpr int swz(int i) { return i ^ ((i & 32) ? 21 : 0) ^ ((i & 64) ? 26 : 0); }
DEVI int swzF(int t) { return (swz(t >> 1) << 1) | (t & 1); }
template <int LOGN>
__device__ void fft_dif(float2* buf) {
  constexpr int N = 1 << LOGN;
  const int tid = tidx();
#pragma unroll
  for (int ps = 0; ps < LOGN / 2; ++ps) {
    const int lh = LOGN - 1 - 2 * ps;
    const int h = 1 << lh, hh = h >> 1;
    const float inv2h = 1.f / (float)(2 * h);
#pragma unroll 2
    for (int q = tid; q < N / 4; q += NT) {
      const int pos = q & (hh - 1), grp = q >> (lh - 1);
      const int e0 = swz((grp << (lh + 1)) + pos);
      const int o1 = swz(hh), o2 = swz(h), o3 = swz(h + hh);
      float2 x0 = buf[e0], x1 = buf[e0 ^ o1], x2 = buf[e0 ^ o2], x3 = buf[e0 ^ o3];
      const float f1 = (float)pos * inv2h;
      const float c1 = __builtin_amdgcn_cosf(f1), s1 = -__builtin_amdgcn_sinf(f1);
      const float c2 = c1 * c1 - s1 * s1, s2 = 2.f * c1 * s1;
      float2 a0{x0.x + x2.x, x0.y + x2.y};
      float2 d2{x0.x - x2.x, x0.y - x2.y};
      float2 a2{d2.x * c1 - d2.y * s1, d2.x * s1 + d2.y * c1};
      float2 a1{x1.x + x3.x, x1.y + x3.y};
      float2 d3{x1.x - x3.x, x1.y - x3.y};
      float2 t3{d3.x * c1 - d3.y * s1, d3.x * s1 + d3.y * c1};
      float2 a3{t3.y, -t3.x};
      float2 y0{a0.x + a1.x, a0.y + a1.y};
      float2 e1{a0.x - a1.x, a0.y - a1.y};
      float2 y1{e1.x * c2 - e1.y * s2, e1.x * s2 + e1.y * c2};
      float2 y2{a2.x + a3.x, a2.y + a3.y};
      float2 e3{a2.x - a3.x, a2.y - a3.y};
      float2 y3{e3.x * c2 - e3.y * s2, e3.x * s2 + e3.y * c2};
      buf[e0] = y0; buf[e0 ^ o1] = y1; buf[e0 ^ o2] = y2; buf[e0 ^ o3] = y3;
    }
    __syncthreads();
  }
}
template <int LOGN>
__device__ void fft_dit_inv(float2* buf) {
  constexpr int N = 1 << LOGN;
  const int tid = tidx();
#pragma unroll
  for (int ps = 0; ps < LOGN / 2; ++ps) {
    const int lh = 2 * ps;
    const int h = 1 << lh;
    const float inv4h = 1.f / (float)(4 * h);
#pragma unroll 2
    for (int q = tid; q < N / 4; q += NT) {
      const int pos = q & (h - 1), grp = q >> lh;
      const int e0 = swz((grp << (lh + 2)) + pos);
      const int o1 = swz(h), o2 = swz(2 * h), o3 = swz(3 * h);
      float2 x0 = buf[e0], x1 = buf[e0 ^ o1], x2 = buf[e0 ^ o2], x3 = buf[e0 ^ o3];
      const float f2 = (float)pos * inv4h;
      const float c2 = __builtin_amdgcn_cosf(f2), s2 = __builtin_amdgcn_sinf(f2);
      const float c1 = c2 * c2 - s2 * s2, s1 = 2.f * c2 * s2;
      float2 b1{x1.x * c1 - x1.y * s1, x1.x * s1 + x1.y * c1};
      float2 b3{x3.x * c1 - x3.y * s1, x3.x * s1 + x3.y * c1};
      float2 a0{x0.x + b1.x, x0.y + b1.y}, a1{x0.x - b1.x, x0.y - b1.y};
      float2 a2{x2.x + b3.x, x2.y + b3.y}, a3{x2.x - b3.x, x2.y - b3.y};
      float2 cc2{a2.x * c2 - a2.y * s2, a2.x * s2 + a2.y * c2};
      float2 t3{a3.x * c2 - a3.y * s2, a3.x * s2 + a3.y * c2};
      float2 cc3{-t3.y, t3.x};
      buf[e0] = float2{a0.x + cc2.x, a0.y + cc2.y};
      buf[e0 ^ o2] = float2{a0.x - cc2.x, a0.y - cc2.y};
      buf[e0 ^ o1] = float2{a1.x + cc3.x, a1.y + cc3.y};
      buf[e0 ^ o3] = float2{a1.x - cc3.x, a1.y - cc3.y};
    }
    __syncthreads();
  }
}
template <int LOGN>
__device__ void spectrum_extract(const float2* buf, float4* __restrict__ GP, float scale) {
  constexpr int Lc = 1 << LOGN;
  for (int j = tidx(); j < Lc / 2; j += NT) {
    if (j == 0) {
      const float2 c = buf[0], ch = buf[1];
      GP[0] = float4{(c.x + c.y) * scale, (c.x - c.y) * scale, ch.x * scale, -ch.y * scale};
    } else {
      const int pos = 2 * j;
      const int k = (int)(__brev((unsigned)pos) >> (32 - LOGN));
      const int p2 = pos ^ ((1 << (31 - __clz(pos))) - 1);
      const int sp1 = swz(pos), sp2 = swz(p2);
      float2 C1 = buf[sp1], C2 = buf[sp2];
      float2 E{0.5f * (C1.x + C2.x), 0.5f * (C1.y - C2.y)}, D{0.5f * (C1.x - C2.x), 0.5f * (C1.y + C2.y)};
      float2 O{D.y, -D.x};
      const float f = (float)k * (1.f / (float)(2 * Lc));
      const float wc = __builtin_amdgcn_cosf(f), wsn = -__builtin_amdgcn_sinf(f);
      float2 wO{wc * O.x - wsn * O.y, wc * O.y + wsn * O.x};
      GP[j] = float4{(E.x + wO.x) * scale, (E.y + wO.y) * scale, (E.x - wO.x) * scale, -(E.y - wO.y) * scale};
    }
  }
}
template <int LOGN>
__device__ void spectrum_mul(float2* buf, const float4* __restrict__ GP) {
  constexpr int Lc = 1 << LOGN;
  for (int j = tidx(); j < Lc / 2; j += NT) {
    const float4 gp = GP[j];
    if (j == 0) {
      const float2 c = buf[0], ch = buf[1];
      const float Y0 = (c.x + c.y) * gp.x, YL = (c.x - c.y) * gp.y;
      buf[0] = float2{0.5f * (Y0 + YL), 0.5f * (Y0 - YL)};
      buf[1] = float2{ch.x * gp.z + ch.y * gp.w, ch.y * gp.z - ch.x * gp.w};
    } else {
      const int pos = 2 * j;
      const int k = (int)(__brev((unsigned)pos) >> (32 - LOGN));
      const int p2 = pos ^ ((1 << (31 - __clz(pos))) - 1);
      const int sp1 = swz(pos), sp2 = swz(p2);
      float2 C1 = buf[sp1], C2 = buf[sp2];
      float2 E{0.5f * (C1.x + C2.x), 0.5f * (C1.y - C2.y)}, D{0.5f * (C1.x - C2.x), 0.5f * (C1.y + C2.y)};
      float2 O{D.y, -D.x};
      const float f = (float)k * (1.f / (float)(2 * Lc));
      const float wc = __builtin_amdgcn_cosf(f), wsn = -__builtin_amdgcn_sinf(f);
      float2 wO{wc * O.x - wsn * O.y, wc * O.y + wsn * O.x};
      float2 X1{E.x + wO.x, E.y + wO.y}, X2{E.x - wO.x, -(E.y - wO.y)};
      float2 Y1{X1.x * gp.x - X1.y * gp.y, X1.x * gp.y + X1.y * gp.x};
      float2 Y2{X2.x * gp.z - X2.y * gp.w, X2.x * gp.w + X2.y * gp.z};
      float2 Ye{0.5f * (Y1.x + Y2.x), 0.5f * (Y1.y - Y2.y)};
      float2 Dd{0.5f * (Y1.x - Y2.x), 0.5f * (Y1.y + Y2.y)};
      float2 Yo{wc * Dd.x + wsn * Dd.y, wc * Dd.y - wsn * Dd.x};
      buf[sp1] = float2{Ye.x - Yo.y, Ye.y + Yo.x};
      buf[sp2] = float2{Ye.x + Yo.y, -Ye.y + Yo.x};
    }
  }
}

template <int LOGN>
__device__ void hy_conv_item(const Params& p, int i, int c, unsigned char* lds, bool dry) {
  constexpr int Lc = 1 << LOGN;
  constexpr int L = Lc;
  constexpr int NB = (LOGN == 14) ? 2 : 4;
  const int tid = tidx();
  float2* buf = (float2*)lds;
  float* bufF = (float*)lds;
  float* W3s = (float*)(lds + 131072);
  float* red = W3s + 256;
  float4* GS = (float4*)(p.ws + OFF_GS + (size_t)bidx() * 2 * GS_PER);
  float4* GS1 = GS + GS_PER / 16;
  float* G1tmp = (float*)GS1;
  float* Z1 = (float*)(p.ws + OFF_Z1 + (size_t)bidx() * 65536);
  const float* H2 = (const float*)(p.ws + OFF_H2) + (LOGN == 14 ? (size_t)4096 * 64 : 0);
  const ushort_t* PH = (const ushort_t*)(p.ws + OFF_PH);
  const float delta = 4.605170185988091f * (1.f / 1.5f + (1.f / 0.3f - 1.f / 1.5f) * (float)c / 1023.f);
  __syncthreads();
  if (tid < 256) {
    const int col = tid >> 6, j = tid & 63, o = col >> 1, dirr = col & 1;
    W3s[tid] = p.in[I_FW3][((size_t)i * 64 + j) * 4096 + (dirr * 2 + o) * 1024 + c];
  }
  __syncthreads();
  float ss0 = 0.f, ss1 = 0.f;
  for (int t = tid; t < L; t += NT) {
    const float4* hr = (const float4*)(H2 + (size_t)t * 64);
    float d0 = 0.f, d1 = 0.f, d2 = 0.f, d3 = 0.f;
#pragma unroll 4
    for (int j4 = 0; j4 < 16; ++j4) {
      const float4 hv = hr[j4];
      const float4 w0 = *(const float4*)(W3s + 4 * j4), w1 = *(const float4*)(W3s + 64 + 4 * j4);
      const float4 w2 = *(const float4*)(W3s + 128 + 4 * j4), w3 = *(const float4*)(W3s + 192 + 4 * j4);
      d0 += hv.x * w0.x + hv.y * w0.y + hv.z * w0.z + hv.w * w0.w;
      d1 += hv.x * w1.x + hv.y * w1.y + hv.z * w1.z + hv.w * w1.w;
      d2 += hv.x * w2.x + hv.y * w2.y + hv.z * w2.z + hv.w * w2.w;
      d3 += hv.x * w3.x + hv.y * w3.y + hv.z * w3.z + hv.w * w3.w;
    }
    const float dec = expf(-((float)t * (1.f / (float)(L - 1))) * delta);
    d0 *= dec; d1 *= dec; d2 *= dec; d3 *= dec;
    ss0 += d0 * d0 + d1 * d1;
    ss1 += d2 * d2 + d3 * d3;
    bufF[swzF(t)] = d0; G1tmp[t] = d2;
    if (t >= 1) { bufF[swzF(2 * L - t)] = d1; G1tmp[2 * L - t] = d3; } else { bufF[swzF(L)] = 0.f; G1tmp[L] = 0.f; }
  }
  ss0 = wsum(ss0); ss1 = wsum(ss1);
  if ((tid & 63) == 0) { red[tid >> 6] = ss0; red[8 + (tid >> 6)] = ss1; }
  __syncthreads();
  float tot0 = 0.f, tot1 = 0.f;
#pragma unroll
  for (int w = 0; w < 8; ++w) { tot0 += red[w]; tot1 += red[8 + w]; }
  fft_dif<LOGN>(buf);
  spectrum_extract<LOGN>(buf, GS, rsqrtf(tot0) * (1.f / (float)Lc));
  __syncthreads();
  for (int t = tid; t < L; t += NT) buf[swz(t)] = ((const float2*)G1tmp)[t];
  __syncthreads();
  fft_dif<LOGN>(buf);
  spectrum_extract<LOGN>(buf, GS1, rsqrtf(tot1) * (1.f / (float)Lc));
  __threadfence_block();
  __syncthreads();
  const float* sw = p.in[I_HSW] + (size_t)i * 3 * 3072;
  const float* sbias = p.in[I_HSB] + (size_t)i * 3072;
  float cw[3][3], cb[3];
#pragma unroll
  for (int st = 0; st < 3; ++st) {
#pragma unroll
    for (int k = 0; k < 3; ++k) cw[st][k] = sw[k * 3072 + st * 1024 + c];
    cb[st] = sbias[st * 1024 + c];
  }
  const float fb0 = p.in[I_FBIAS][((size_t)i * 2 + 0) * 1024 + c], fb1 = p.in[I_FBIAS][((size_t)i * 2 + 1) * 1024 + c];
  for (int b = 0; b < NB; ++b) {
    const int s0 = (LOGN == 14) ? (TPROMPT + b * 16384) : (b * 4096);
    const ushort_t* pv = PH + (size_t)s0 * 1024 + (size_t)c * L;
    const ushort_t* px1 = pv + (size_t)T * 1024;
    const ushort_t* px2 = px1 + (size_t)T * 1024;
    ushort_t* pg = (ushort_t*)px2 + (size_t)T * 1024;
    auto conv8 = [&](const ushort_t* sp, int st, int t0, float* y) {
      const uint4 v = *(const uint4*)(sp + t0);
      const float xm = t0 > 0 ? bf2f(sp[t0 - 1]) : 0.f, xn = t0 + 8 < L ? bf2f(sp[t0 + 8]) : 0.f;
      const float x[10] = {xm, __uint_as_float(v.x << 16), __uint_as_float(v.x & 0xffff0000u), __uint_as_float(v.y << 16), __uint_as_float(v.y & 0xffff0000u),
                           __uint_as_float(v.z << 16), __uint_as_float(v.z & 0xffff0000u), __uint_as_float(v.w << 16), __uint_as_float(v.w & 0xffff0000u), xn};
#pragma unroll
      for (int j = 0; j < 8; ++j) y[j] = cw[st][0] * x[j] + cw[st][1] * x[j + 1] + cw[st][2] * x[j + 2] + cb[st];
    };
    __syncthreads();
    for (int t0 = tid * 8; t0 < L; t0 += NT * 8) {
      float y[8]; conv8(pv, 0, t0, y);
#pragma unroll
      for (int j = 0; j < 4; ++j) { buf[swz((t0 >> 1) + j)] = float2{y[2 * j], y[2 * j + 1]}; buf[swz(L / 2 + (t0 >> 1) + j)] = float2{0.f, 0.f}; }
    }
    __syncthreads();
    fft_dif<LOGN>(buf);
    spectrum_mul<LOGN>(buf, GS);
    __syncthreads();
    fft_dit_inv<LOGN>(buf);
    for (int t0 = tid * 8; t0 < L; t0 += NT * 8) {
      float z0[8], xa[8]; conv8(pv, 0, t0, z0); conv8(px1, 1, t0, xa);
      float z1[8];
#pragma unroll
      for (int j = 0; j < 4; ++j) {
        const int e = swz((t0 >> 1) + j);
        const float2 zc = buf[e];
        z1[2 * j] = xa[2 * j] * (zc.x + z0[2 * j] * fb0); z1[2 * j + 1] = xa[2 * j + 1] * (zc.y + z0[2 * j + 1] * fb0);
        buf[e] = float2{z1[2 * j], z1[2 * j + 1]};
        buf[swz(L / 2 + (t0 >> 1) + j)] = float2{0.f, 0.f};
      }
      *(float4*)(Z1 + t0) = float4{z1[0], z1[1], z1[2], z1[3]};
      *(float4*)(Z1 + t0 + 4) = float4{z1[4], z1[5], z1[6], z1[7]};
    }
    __syncthreads();
    fft_dif<LOGN>(buf);
    spectrum_mul<LOGN>(buf, GS1);
    __syncthreads();
    fft_dit_inv<LOGN>(buf);
    for (int t0 = tid * 8; t0 < L; t0 += NT * 8) {
      float xb[8]; conv8(px2, 2, t0, xb);
      const float4 za = *(const float4*)(Z1 + t0), zb = *(const float4*)(Z1 + t0 + 4);
      const float z1[8] = {za.x, za.y, za.z, za.w, zb.x, zb.y, zb.z, zb.w};
      const uint4 gv = *(const uint4*)(pg + t0);
      const unsigned gw[4] = {gv.x, gv.y, gv.z, gv.w};
      unsigned o[4];
#pragma unroll
      for (int j = 0; j < 4; ++j) {
        const float2 zc = buf[swz((t0 >> 1) + j)];
        const float g0 = __uint_as_float(gw[j] << 16), g1 = __uint_as_float(gw[j] & 0xffff0000u);
        const float y0 = xb[2 * j] * (zc.x + z1[2 * j] * fb1) * (g0 * fast_sigmoid(g0));
        const float y1 = xb[2 * j + 1] * (zc.y + z1[2 * j + 1] * fb1) * (g1 * fast_sigmoid(g1));
        o[j] = pack2(y0, y1);
      }
      if (!dry) *(uint4*)(pg + t0) = uint4{o[0], o[1], o[2], o[3]};
    }
  }
}

__device__ void hy_conv_phase(const Params& p, int i, unsigned char* lds, bool dry = false) {
  for (int it = bidx(); it < 2048; it += gridDim.x) {
    if (it < 1024) hy_conv_item<14>(p, i, it, lds, dry);
    else hy_conv_item<12>(p, i, it - 1024, lds, dry);
    __syncthreads();
  }
}

#ifndef PROBE_MASK
#define PROBE_MASK 0
#endif
#ifndef PH_MASK
#define PH_MASK 0x1ffff
#endif
#define PHM(n) ((PH_MASK >> (n)) & 1)
DEVI void run_phase(const Params& p, int ph, unsigned char* lds, bool dry = false) {
  const int layer = ph < NPH_EVEN ? 0 : ph < NPH_EVEN + NPH_ODD ? 1 : ph < 2 * NPH_EVEN + NPH_ODD ? 2 : 3;
  const int base = layer == 0 ? 0 : layer == 1 ? NPH_EVEN : layer == 2 ? NPH_EVEN + NPH_ODD : 2 * NPH_EVEN + NPH_ODD;
  const int sp = ph - base, i = layer >> 1;
  unsigned char* ws = p.ws;
  ushort_t* WB = (ushort_t*)(ws + OFF_WB);
  if ((layer & 1) == 0) {
    ushort_t* WinT = WB; ushort_t* WoutT = WB + 3328 * 1024; ushort_t* GluT = WoutT + 1024 * 1024;
    switch (sp) {
      case 0: if (PHM(0)) {
        transpose_bf16(p.in[I_EWIN] + (size_t)i * 1024 * 3136, WinT, 1024, 3136, lds);
        zero_fill(WinT + 3136 * 1024, 192 * 1024);
        transpose_bf16(p.in[I_EWOUT] + (size_t)i * 1024 * 1024, WoutT, 1024, 1024, lds);
        transpose_bf16(p.in[I_GLUW] + (size_t)i * 512 * 512, GluT, 512, 512, lds);
        if (layer == 0) xb_convert(p, (ushort_t*)(ws + OFF_Y));
        } break;
      case 1: if (PHM(1)) run_gemm(lds, (const ushort_t*)(ws + OFF_Y), 1024, WinT, 3328, 1024, pg8::EpiEvenIn{(ushort_t*)(ws + OFF_PS5), (ushort_t*)(ws + OFF_PRW)}); break;
      case 2: if (PHM(2)) s5_passA(p, i, lds); break;
      case 3: if (PHM(3)) s5_passC(p, i, lds); break;
      case 4: if (PHM(4)) run_gemm(lds, (const ushort_t*)(ws + OFF_Y) + 512, 1024, GluT, 512, 512, pg8::EpiGlu{(ushort_t*)(ws + OFF_Y), (const ushort_t*)(ws + OFF_PS5), p.in[I_GLUB] + i * 512}); break;
      case 5: if (PHM(5)) rwkv_scan1(p, i, lds); break;
      case 6: if (PHM(6)) rwkv_carry(p, lds, dry); break;
      case 7: if (PHM(7)) rwkv_scan3(p, i, lds, dry); break;
      case 8: if (PHM(8)) rwkv_post(p, i); break;
      case 9: if (PHM(9)) run_gemm(lds, (const ushort_t*)(ws + OFF_Y), 1024, WoutT, 1024, 1024, pg8::EpiF32{(float*)(ws + OFF_PRW)}); break;
      case 10: if (PHM(10)) ln_phase(p, layer, (const float*)(ws + OFF_PRW), (ushort_t*)(ws + OFF_XB_ODD), dry); break;
    }
  } else {
    ushort_t* HinT = WB; ushort_t* HoutT = WB + 4096 * 1024;
    switch (sp) {
      case 0: if (PHM(11)) {
        transpose_bf16(p.in[I_HWIN] + (size_t)i * 1024 * 4096, HinT, 1024, 4096, lds);
        transpose_bf16(p.in[I_HWOUT] + (size_t)i * 1024 * 1024, HoutT, 1024, 1024, lds);
        hy_filter_mlp(p, i);
        } break;
      case 1: if (PHM(12)) run_gemm(lds, (const ushort_t*)(ws + OFF_XB_ODD), 1024, HinT, 4096, 1024, pg8::EpiHyIn{(ushort_t*)(ws + OFF_PH)}); break;
      case 2: if (PHM(13)) hy_conv_phase(p, i, lds, dry); break;
      case 3: if (PHM(14)) hy_transpose((const ushort_t*)(ws + OFF_PH + 3 * SZ1), (ushort_t*)(ws + OFF_PH), lds); break;
      case 4: if (PHM(15)) run_gemm(lds, (const ushort_t*)(ws + OFF_PH), 1024, HoutT, 1024, 1024, pg8::EpiF32{(float*)(ws + OFF_PH + SZ1)}); break;
      case 5: if (PHM(16)) ln_phase(p, layer, (const float*)(ws + OFF_PH + SZ1), layer < 3 ? (ushort_t*)(ws + OFF_Y) : (ushort_t*)nullptr, dry); break;
    }
  }
}

#define LAS __attribute__((address_space(3)))
#define XB_TMO      128
#define XB_XCNT(j)  (256  + 64 * (j))
#define XB_XSUB(j)  (1280 + 64 * (j))
#define XB_XGEN(j)  (2304 + 64 * (j))
#define XB_TOP      3328
#define XB_TOPGEN   3392
#define XCD_BAR_WORDS 3456
#define XB_SPIN_CAP (1u << 18)
#define LAS __attribute__((address_space(3)))

__device__ __forceinline__ unsigned xb_ld(unsigned* p)              { return __hip_atomic_load(p, __ATOMIC_RELAXED, __HIP_MEMORY_SCOPE_AGENT); }
__device__ __forceinline__ unsigned xb_add(unsigned* p, unsigned v) { return __hip_atomic_fetch_add(p, v, __ATOMIC_RELAXED, __HIP_MEMORY_SCOPE_AGENT); }
__device__ __forceinline__ unsigned xb_xcc_id() { return (unsigned)__builtin_amdgcn_s_getreg((3 << 11) | 20) & 0xFu; }
#define XB_SPIN(cond, bar) do { unsigned _sp = 0; while (cond) { __builtin_amdgcn_s_sleep(1); \
    if ((++_sp & 255u) == 0u) { if (xb_ld(&(bar)[XB_TMO])) break; if (_sp > XB_SPIN_CAP) { atomicAdd(&(bar)[XB_TMO], 1u); break; } } } } while (0)

struct XcdBarrier {
    unsigned* bar; unsigned x;
    volatile LAS unsigned* st;
};

__device__ __forceinline__ XcdBarrier xcd_barrier_post(unsigned* bar, volatile LAS unsigned* st) {
    XcdBarrier b; b.bar = bar; b.x = xb_xcc_id(); b.st = st;
    if (threadIdx.x == 0) (void)xb_add(&bar[XB_XCNT(b.x)], 1u);
    return b;
}
__device__ __forceinline__ void xcd_barrier_complete(unsigned* bar, unsigned x, unsigned& nloc, unsigned& nx) {
    const unsigned G = gridDim.x * gridDim.y * gridDim.z;
    unsigned sum, cnt, mine, sp = 0u;
    for (;;) {
        sum = 0u; cnt = 0u; mine = 0u;
#pragma unroll
        for (unsigned j = 0; j < 16; ++j) { const unsigned c = xb_ld(&bar[XB_XCNT(j)]); sum += c; cnt += (c > 0u) ? 1u : 0u; mine = (j == x) ? c : mine; }
        if (sum == G) break;
        __builtin_amdgcn_s_sleep(1);
        if ((++sp & 255u) == 0u) { if (xb_ld(&bar[XB_TMO])) break; if (sp > XB_SPIN_CAP) { atomicAdd(&bar[XB_TMO], 1u); break; } }
    }
    nloc = mine > 0u ? mine : 1u; nx = cnt > 0u ? cnt : 1u;
}

__device__ __forceinline__ void xcd_barrier(const XcdBarrier& b) {
    asm volatile("s_waitcnt vmcnt(0)" ::: "memory");
    __syncthreads();
    if (threadIdx.x == 0) {
        unsigned* bar = b.bar;
        __builtin_amdgcn_s_waitcnt(0);
        unsigned nloc = b.st[0], nx = b.st[1];
        if (nloc == 0u) { xcd_barrier_complete(bar, b.x, nloc, nx); b.st[0] = nloc; b.st[1] = nx; }
        const unsigned old = xb_add(&bar[XB_XSUB(b.x)], 1u);
        const unsigned gen = old / nloc;
        if (old + 1u == (gen + 1u) * nloc) {
            __builtin_amdgcn_fence(__ATOMIC_RELEASE, "agent");
            asm volatile("s_waitcnt vmcnt(0)" ::: "memory");
            const unsigned og = xb_add(&bar[XB_TOP], 1u);
            const unsigned tg = og / nx;
            if (og + 1u == (tg + 1u) * nx) xb_add(&bar[XB_TOPGEN], 1u);
            else XB_SPIN(xb_ld(&bar[XB_TOPGEN]) == tg, bar);
            __builtin_amdgcn_fence(__ATOMIC_ACQUIRE, "agent");
            xb_add(&bar[XB_XGEN(b.x)], 1u);
            asm volatile("s_waitcnt vmcnt(0)" ::: "memory");
        } else {
            XB_SPIN(xb_ld(&bar[XB_XGEN(b.x)]) == gen, bar);
            __builtin_amdgcn_fence(__ATOMIC_ACQUIRE, "agent");
            asm volatile("s_waitcnt vmcnt(0)" ::: "memory");
        }
    }
    __syncthreads();
}


#if ONE_LAUNCH
__global__ void __launch_bounds__(NT) fwd_kernel(Params p) {
  extern __shared__ __attribute__((aligned(16))) unsigned char lds[];
#if ONE_LAUNCH
  cg::grid_group grid = cg::this_grid();
#endif
#if ONE_LAUNCH
  volatile LAS unsigned* xb_st = (volatile LAS unsigned*)(lds + LDS_BYTES - 16);
  if (threadIdx.x < 2) xb_st[threadIdx.x] = 0u;
  __syncthreads();
  const XcdBarrier xb = xcd_barrier_post((unsigned*)(p.ws + OFF_BAR), xb_st);
#endif
  for (int ph = p.ph_lo; ph < p.ph_hi; ++ph) {
#if PROBE_MASK
    {
      const int lyr = ph < NPH_EVEN ? 0 : ph < NPH_EVEN + NPH_ODD ? 1 : ph < 2 * NPH_EVEN + NPH_ODD ? 2 : 3;
      const int bs = lyr == 0 ? 0 : lyr == 1 ? NPH_EVEN : lyr == 2 ? NPH_EVEN + NPH_ODD : 2 * NPH_EVEN + NPH_ODD;
      const int idx = (lyr & 1) ? NPH_EVEN + (ph - bs) : (ph - bs);
      if ((PROBE_MASK >> idx) & 1) { run_phase(p, ph, lds, true); grid.sync(); }
    }
#endif
    run_phase(p, ph, lds);
#if ONE_LAUNCH
    if (ph + 1 < p.ph_hi) { if (ph == p.ph_lo) grid.sync(); else xcd_barrier(xb); }
#endif
  }
}
#endif

#if !ONE_LAUNCH
template <int PH> __global__ void __launch_bounds__(NT) phase_kernel(Params p) {
  extern __shared__ __attribute__((aligned(16))) unsigned char lds[];
  run_phase(p, PH, lds);
}
typedef void (*kfn_t)(Params);
#define PK(n) phase_kernel<n>
static kfn_t k_tab[NPHASES] = {PK(0), PK(1), PK(2), PK(3), PK(4), PK(5), PK(6), PK(7), PK(8), PK(9), PK(10), PK(11), PK(12), PK(13), PK(14), PK(15),
                               PK(16), PK(17), PK(18), PK(19), PK(20), PK(21), PK(22), PK(23), PK(24), PK(25), PK(26), PK(27), PK(28), PK(29), PK(30), PK(31), PK(32), PK(33)};
#endif

extern "C" void kernel_launch(void* const* d_in, const int* in_sizes, int n_in, void* d_out, int out_size, void* d_ws, size_t ws_size,
                              hipStream_t stream) {
  static int grid_blocks = 0;
  if (!grid_blocks) {
    if (n_in != 38 || ws_size < WS_NEED || out_size != T * 1024) {
      fprintf(stderr, "kernel_launch: unexpected shapes n_in=%d ws=%zu out=%d\n", n_in, ws_size, out_size);
      grid_blocks = -1; return;
    }
    int dev = 0, cus = 0, per_cu = 0;
    (void)hipGetDevice(&dev);
    (void)hipDeviceGetAttribute(&cus, hipDeviceAttributeMultiprocessorCount, dev);
#if ONE_LAUNCH
    if (hipFuncSetAttribute((const void*)fwd_kernel, hipFuncAttributeMaxDynamicSharedMemorySize, LDS_BYTES) != hipSuccess) {
      fprintf(stderr, "kernel_launch: hipFuncSetAttribute failed\n"); grid_blocks = -1; return;
    }
    (void)hipOccupancyMaxActiveBlocksPerMultiprocessor(&per_cu, (const void*)fwd_kernel, NT, LDS_BYTES);
#else
    for (int ph = 0; ph < NPHASES; ++ph)
      if (hipFuncSetAttribute((const void*)k_tab[ph], hipFuncAttributeMaxDynamicSharedMemorySize, LDS_BYTES) != hipSuccess) {
        fprintf(stderr, "kernel_launch: hipFuncSetAttribute failed\n"); grid_blocks = -1; return;
      }
    per_cu = 1;
#endif
    if (per_cu < 1) { fprintf(stderr, "kernel_launch: occupancy query returned %d\n", per_cu); per_cu = 1; }
    grid_blocks = cus * per_cu;
    if (grid_blocks > 256) grid_blocks = 256;
    if (grid_blocks < 1) grid_blocks = 256;
  }
  if (grid_blocks < 0) return;
  Params p{};
  for (int k = 0; k < 38; ++k) p.in[k] = (const float*)d_in[k];
  p.out = (float*)d_out; p.ws = (unsigned char*)d_ws;
#if ONE_LAUNCH
  if (hipMemsetAsync((unsigned char*)d_ws + OFF_BAR, 0, 16384, stream) != hipSuccess) { fprintf(stderr, "kernel_launch: memset of barrier words failed\n"); return; }
  p.ph_lo = 0; p.ph_hi = NPHASES;
  void* args[] = {&p};
  hipError_t e = hipLaunchCooperativeKernel((const void*)fwd_kernel, dim3(grid_blocks), dim3(NT), args, LDS_BYTES, stream);
  if (e != hipSuccess) fprintf(stderr, "cooperative launch failed: %s (grid %d)\n", hipGetErrorString(e), grid_blocks);
#else
  for (int ph = 0; ph < NPHASES; ++ph) {
    p.ph_lo = ph; p.ph_hi = ph + 1;
    hipLaunchKernelGGL(k_tab[ph], dim3(grid_blocks), dim3(NT), LDS_BYTES, stream, p);
  }
#endif
}
```

```cpp
#include <hip/hip_runtime.h>
#include <hip/hip_cooperative_groups.h>
#include <cstdio>
#include <cstdint>
namespace cg = cooperative_groups;

#ifndef ONE_LAUNCH
#define ONE_LAUNCH 1
#endif

#define DEVI __device__ __forceinline__
constexpr int NT = 512;
constexpr int T = 49152;
constexpr int TPROMPT = 16384;
constexpr int LDS_BYTES = 133120;
constexpr int NPH_EVEN = 11, NPH_ODD = 6;
constexpr int NPHASES = 2 * (NPH_EVEN + NPH_ODD);

typedef __attribute__((ext_vector_type(8))) short bf16x8;
typedef __attribute__((ext_vector_type(4))) float f32x4;
typedef unsigned short ushort_t;

struct Params { const float* in[38]; float* out; unsigned char* ws; int ph_lo; int ph_hi; };

enum { I_XP = 0, I_XS, I_EWIN, I_EWOUT, I_LRE, I_LIM, I_LSTEP, I_BRE, I_BIM, I_CRE, I_CIM, I_S5D, I_GLUW, I_GLUB,
       I_MURKV, I_MULORA, I_W0, I_WUP, I_A0, I_AUP, I_KK, I_KA, I_RK, I_LNXW, I_LNXB,
       I_HWIN, I_HWOUT, I_HSW, I_HSB, I_FW1, I_FB1, I_FFREQ, I_FW2, I_FB2, I_FW3, I_FBIAS, I_LNG, I_LNB };

constexpr size_t SZ1 = (size_t)T * 1024 * 2;
constexpr size_t OFF_PS5 = 0;
constexpr size_t OFF_PRW = OFF_PS5 + SZ1;
constexpr size_t OFF_Y = OFF_PRW + (size_t)T * 2112 * 2;
constexpr size_t OFF_YS = OFF_Y + SZ1;
constexpr size_t OFF_WB = OFF_YS + SZ1;
constexpr size_t OFF_CAR = OFF_WB + 10485760;
constexpr size_t OFF_BAR = OFF_CAR + 6291456;
constexpr size_t WS_NEED = OFF_BAR + 16384;
constexpr size_t OFF_PH = 0;
constexpr size_t OFF_GS = 4 * SZ1;
constexpr size_t GS_PER = 131328;
constexpr size_t OFF_Z1 = OFF_GS + 256 * 2 * GS_PER;
constexpr size_t OFF_XB_ODD = 4 * SZ1;
constexpr size_t OFF_H2 = OFF_XB_ODD + SZ1;

DEVI int tidx() { int t = threadIdx.x; asm volatile("" : "+v"(t)); return t; }
DEVI int bidx() { int b = blockIdx.x; asm volatile("" : "+s"(b)); return b; }
DEVI ushort_t f2bf(float f) { unsigned u = __float_as_uint(f); u += 0x7fffu + ((u >> 16) & 1u); return (ushort_t)(u >> 16); }
DEVI float bf2f(ushort_t h) { return __uint_as_float(((unsigned)h) << 16); }
DEVI unsigned pack2(float a, float b) { return (unsigned)f2bf(a) | ((unsigned)f2bf(b) << 16); }
DEVI float wsum(float v) {
#pragma unroll
  for (int m = 32; m >= 1; m >>= 1) v += __shfl_xor(v, m);
  return v;
}
DEVI void wave_sync() { __builtin_amdgcn_fence(__ATOMIC_RELEASE, "wavefront"); __builtin_amdgcn_wave_barrier(); __builtin_amdgcn_fence(__ATOMIC_ACQUIRE, "wavefront"); }
DEVI void seq_of(int tok, int& s0, int& L) {
  if (tok < TPROMPT) { s0 = tok & ~4095; L = 4096; } else { s0 = TPROMPT + ((tok - TPROMPT) & ~16383); L = 16384; }
}
struct XSrc { const float* xp; const float* xs; const float* xo; };
DEVI XSrc xsrc(const Params& p) {
  XSrc x; x.xp = p.in[I_XP]; x.xs = p.in[I_XS]; x.xo = p.out;
  asm volatile("" : "+s"(x.xp), "+s"(x.xs), "+s"(x.xo));
  return x;
}
DEVI const float* xrow(const XSrc& x, int layer, int tok) {
  if (layer == 0) return tok < TPROMPT ? x.xp + (size_t)tok * 1024 : x.xs + (size_t)(tok - TPROMPT) * 1024;
  return x.xo + (size_t)tok * 1024;
}
DEVI float sigmoidf_(float x) { return 1.f / (1.f + expf(-x)); }
DEVI float fast_sigmoid(float x) { return __builtin_amdgcn_rcpf(1.f + __builtin_amdgcn_exp2f(-1.4426950408889634f * x)); }
DEVI float fast_tanh(float x) { return 1.f - 2.f * __builtin_amdgcn_rcpf(1.f + __builtin_amdgcn_exp2f(2.8853900817779268f * x)); }
DEVI float dpp_mov_f(float x, const int sel) {
  int xi = __builtin_bit_cast(int, x), r;
  if (sel == 0) r = __builtin_amdgcn_mov_dpp(xi, 0xB1, 0xf, 0xf, true);
  else if (sel == 1) r = __builtin_amdgcn_mov_dpp(xi, 0x4E, 0xf, 0xf, true);
  else if (sel == 2) r = __builtin_amdgcn_mov_dpp(xi, 0x141, 0xf, 0xf, true);
  else r = __builtin_amdgcn_mov_dpp(xi, 0x140, 0xf, 0xf, true);
  return __builtin_bit_cast(float, r);
}
DEVI float wsum_fast(float v) {
  v += dpp_mov_f(v, 0); v += dpp_mov_f(v, 1); v += dpp_mov_f(v, 2); v += dpp_mov_f(v, 3);
  const int vi = __builtin_bit_cast(int, v);
  return __builtin_bit_cast(float, __builtin_amdgcn_readlane(vi, 0)) + __builtin_bit_cast(float, __builtin_amdgcn_readlane(vi, 16)) +
         __builtin_bit_cast(float, __builtin_amdgcn_readlane(vi, 32)) + __builtin_bit_cast(float, __builtin_amdgcn_readlane(vi, 48));
}
DEVI float gelu_tanh(float x) { return 0.5f * x * (1.f + tanhf(0.7978845608f * (x + 0.044715f * x * x * x))); }

__device__ void transpose_bf16(const float* __restrict__ in, ushort_t* __restrict__ out, int K, int N, unsigned char* lds) {
  float* tile = (float*)lds;
  const int tid = tidx(), j = tid & 63, i0 = tid >> 6;
  const int tk = K / 64, tn = N / 64;
  for (int t = bidx(); t < tk * tn; t += gridDim.x) {
    const int k0 = (t / tn) * 64, n0 = (t % tn) * 64;
#pragma unroll
    for (int e = 0; e < 8; ++e) { int i = i0 + 8 * e; tile[i * 65 + j] = in[(size_t)(k0 + i) * N + n0 + j]; }
    __syncthreads();
#pragma unroll
    for (int e = 0; e < 8; ++e) { int i = i0 + 8 * e; out[(size_t)(n0 + i) * K + k0 + j] = f2bf(tile[j * 65 + i]); }
    __syncthreads();
  }
}

namespace pg8 {
#define PG8_LAS __attribute__((address_space(3)))
typedef unsigned u32x4 __attribute__((ext_vector_type(4)));
constexpr int BM = 256, BK = 64, HALF = 128, HTB = HALF * BK * 2, STAGE_BYTES = 8 * HTB, NXCD = 8, WGM = 8;
DEVI int lds_byte(int r, int c) { const int st = (r >> 4) * 2 + (c >> 5), rr = r & 15, cc = c & 31, ob = rr * 64 + cc * 2; return st * 1024 + (ob ^ (((ob >> 9) & 1) << 5)); }
DEVI void stage_rc(int b, int& R, int& C) { const int st = b / 1024, sb = b % 1024, swz = sb ^ (((sb >> 9) & 1) << 5); R = (st >> 1) * 16 + swz / 64; C = (st & 1) * 32 + (swz % 64) / 2; }
DEVI int perm32(int rho) { const int n = rho >> 4, i = rho & 15; return 8 * (i >> 2) + 4 * n + (i & 3); }
struct Unit { int pm, pn; };
struct Gemm { const ushort_t* A; const ushort_t* Bt; int M, N, K, lda; };
struct StaticOrder {
  int nM, nN, nwg, G, c;
  DEVI void init(int M, int N, int G_, int c_) { nM = M / BM; nN = N / BM; nwg = nM * nN; G = G_; c = c_; }
  DEVI bool next(int i, Unit& u) const {
    const long L = (long)i * G + c; if (L >= nwg) return false;
    int wgid = (int)L; { const int q = nwg / NXCD, r = nwg % NXCD, xcd = wgid % NXCD, off = wgid / NXCD; wgid = (xcd < r ? xcd * (q + 1) : r * (q + 1) + (xcd - r) * q) + off; }
    const int nig = WGM * nN, gid = wgid / nig, fm = gid * WGM, gsz = (nM - fm) < WGM ? (nM - fm) : WGM;
    u.pm = fm + ((wgid % nig) % gsz); u.pn = (wgid % nig) / gsz; return true;
  }
};
DEVI unsigned cvt_pk_bf16(float lo, float hi) { unsigned r; asm volatile("v_cvt_pk_bf16_f32 %0, %1, %2" : "=v"(r) : "v"(lo), "v"(hi)); return r; }

template <class Epi>
DEVI void gemm_phase(PG8_LAS unsigned char* lds, const Gemm g, const StaticOrder& S, const Epi& E) {
  const int tid = tidx(), wid = __builtin_amdgcn_readfirstlane(tid >> 6), lane = tid & 63, wr = wid >> 2, wc = wid & 3, fr = lane & 15, fq = lane >> 4;
  const int K = g.K, nt = K / BK, lda = g.lda;
  unsigned voffA[2], voffB[2];
#pragma unroll
  for (int i = 0; i < 2; ++i) { int R, C; stage_rc(tid * 16 + i * 8192, R, C); const int Rb = Epi::PERM ? ((R & ~31) + perm32(R & 31)) : R;
    voffA[i] = (unsigned)(R * lda + C) * 2u; voffB[i] = (unsigned)(Rb * K + C) * 2u; }
  const size_t kstep = (size_t)(BK * 2);
  const size_t hstepA = (size_t)HALF * lda * 2, hstepB = (size_t)HALF * K * 2;
  const size_t tstepA = 2 * hstepA, tstepB = 2 * hstepB;
  const unsigned ldsw = (unsigned)wid * 1024u;
  const int aoff = lds_byte(wr * 64 + fr, fq * 8), boff = lds_byte(wc * 32 + fr, fq * 8);
#define PG8_SA(b, h) (((b) * 2 + (h)) * HTB)
#define PG8_SB(b, h) ((4 + (b) * 2 + (h)) * HTB)
#define PG8_STAGE(bufoff, gbase, voff) do { _Pragma("unroll") for (int _i = 0; _i < 2; ++_i) \
    __builtin_amdgcn_global_load_lds((const unsigned*)((const char*)(gbase) + (voff)[_i]), (PG8_LAS unsigned*)(lds + (bufoff) + ldsw + _i * 8192), 16, 0, 0); } while (0)
#define PG8_LDA(dst, b, h) do { _Pragma("unroll") for (int m = 0; m < 4; ++m) _Pragma("unroll") for (int k = 0; k < 2; ++k) dst[m][k] = *(const PG8_LAS bf16x8*)(lds + PG8_SA(b, h) + aoff + m * 2048 + k * 1024); } while (0)
#define PG8_LDB(dst, b, h) do { _Pragma("unroll") for (int n = 0; n < 2; ++n) _Pragma("unroll") for (int k = 0; k < 2; ++k) dst[n][k] = *(const PG8_LAS bf16x8*)(lds + PG8_SB(b, h) + boff + n * 2048 + k * 1024); } while (0)
#define PG8_MMA(ai, bj, At, Bt) do { __builtin_amdgcn_s_setprio(1); _Pragma("unroll") for (int m = 0; m < 4; ++m) _Pragma("unroll") for (int n = 0; n < 2; ++n) _Pragma("unroll") for (int k = 0; k < 2; ++k) \
    acc[ai][bj][m][n] = Epi::TRANS ? __builtin_amdgcn_mfma_f32_16x16x32_bf16(Bt[n][k], At[m][k], acc[ai][bj][m][n], 0, 0, 0) \
                                   : __builtin_amdgcn_mfma_f32_16x16x32_bf16(At[m][k], Bt[n][k], acc[ai][bj][m][n], 0, 0, 0); __builtin_amdgcn_s_setprio(0); } while (0)
#define PG8_WAIT_V(n) asm volatile("s_waitcnt vmcnt(" #n ")" ::: "memory")
#define PG8_WAIT_L(n) asm volatile("s_waitcnt lgkmcnt(" #n ")" ::: "memory")
#define PG8_BAR __builtin_amdgcn_s_barrier()
#define PG8_SCHED __builtin_amdgcn_sched_barrier(0)
  Unit cur, nxt; int ui = 0;
  if (!S.next(0, cur)) return;
  f32x4 acc[2][2][4][2];
#pragma unroll
  for (int a = 0; a < 2; ++a)
#pragma unroll
    for (int b = 0; b < 2; ++b)
#pragma unroll
      for (int m = 0; m < 4; ++m)
#pragma unroll
        for (int n = 0; n < 2; ++n) acc[a][b][m][n] = (f32x4){0.f, 0.f, 0.f, 0.f};
  bf16x8 At[4][2], B0[2][2], B1[2][2];
  const char* cA = (const char*)g.A + (size_t)cur.pm * tstepA; const char* cB = (const char*)g.Bt + (size_t)cur.pn * tstepB;
  PG8_STAGE(PG8_SB(0, 0), cB, voffB); PG8_STAGE(PG8_SA(0, 0), cA, voffA); PG8_STAGE(PG8_SB(0, 1), cB + hstepB, voffB); PG8_STAGE(PG8_SA(0, 1), cA + hstepA, voffA);
  if (wr == 1) PG8_BAR;
  PG8_WAIT_V(4); PG8_BAR;
  PG8_STAGE(PG8_SB(1, 0), cB + kstep, voffB); PG8_STAGE(PG8_SA(1, 0), cA + kstep, voffA); PG8_STAGE(PG8_SB(1, 1), cB + hstepB + kstep, voffB);
  PG8_WAIT_V(6); PG8_BAR;
  for (;;) {
    const bool has_next = S.next(ui + 1, nxt);
    const char* nA = has_next ? (const char*)g.A + (size_t)nxt.pm * tstepA : cA; const char* nB = has_next ? (const char*)g.Bt + (size_t)nxt.pn * tstepB : cB;
    for (int t = 0; t < nt; t += 2) {
      const bool last = (t == nt - 2);
      const char* a1 = cA + (size_t)(t + 1) * kstep;
      const char* a2 = last ? nA : cA + (size_t)(t + 2) * kstep; const char* b2 = last ? nB : cB + (size_t)(t + 2) * kstep;
      const char* a3 = a2 + kstep; const char* b3 = b2 + kstep;
      PG8_LDB(B0, 0, 0); PG8_SCHED; PG8_LDA(At, 0, 0); PG8_STAGE(PG8_SA(1, 1), a1 + hstepA, voffA);
      PG8_WAIT_L(8); PG8_BAR; PG8_WAIT_L(0); PG8_MMA(0, 0, At, B0); PG8_BAR; PG8_SCHED;
      PG8_LDB(B1, 0, 1); PG8_STAGE(PG8_SB(0, 0), b2, voffB);
      PG8_BAR; PG8_WAIT_L(0); PG8_MMA(0, 1, At, B1); PG8_BAR;
      PG8_LDA(At, 0, 1); PG8_STAGE(PG8_SA(0, 0), a2, voffA);
      PG8_BAR; PG8_WAIT_L(0); PG8_MMA(1, 0, At, B0); PG8_BAR; PG8_SCHED;
      PG8_STAGE(PG8_SB(0, 1), b2 + hstepB, voffB);
      PG8_WAIT_V(6); PG8_BAR; PG8_MMA(1, 1, At, B1); PG8_BAR;
      PG8_LDB(B0, 1, 0); PG8_SCHED; PG8_LDA(At, 1, 0); PG8_STAGE(PG8_SA(0, 1), a2 + hstepA, voffA);
      PG8_WAIT_L(8); PG8_BAR; PG8_WAIT_L(0); PG8_MMA(0, 0, At, B0); PG8_BAR; PG8_SCHED;
      PG8_LDB(B1, 1, 1); PG8_STAGE(PG8_SB(1, 0), b3, voffB);
      PG8_BAR; PG8_WAIT_L(0); PG8_MMA(0, 1, At, B1); PG8_BAR;
      PG8_LDA(At, 1, 1); PG8_STAGE(PG8_SA(1, 0), a3, voffA);
      PG8_BAR; PG8_WAIT_L(0); PG8_MMA(1, 0, At, B0); PG8_BAR; PG8_SCHED;
      PG8_STAGE(PG8_SB(1, 1), b3 + hstepB, voffB);
      PG8_WAIT_V(6); PG8_BAR; PG8_MMA(1, 1, At, B1); PG8_BAR;
    }
    E(acc, cur, wr, wc, fr, fq);
    if (!has_next) break;
#pragma unroll
    for (int a = 0; a < 2; ++a)
#pragma unroll
      for (int b = 0; b < 2; ++b)
#pragma unroll
        for (int m = 0; m < 4; ++m)
#pragma unroll
          for (int n = 0; n < 2; ++n) acc[a][b][m][n] = (f32x4){0.f, 0.f, 0.f, 0.f};
    cur = nxt; cA = nA; cB = nB; ++ui;
  }
  PG8_WAIT_V(0);
  if (wr == 0) PG8_BAR;
  PG8_BAR;
#undef PG8_SA
#undef PG8_SB
#undef PG8_STAGE
#undef PG8_LDA
#undef PG8_LDB
#undef PG8_MMA
#undef PG8_WAIT_V
#undef PG8_WAIT_L
#undef PG8_BAR
#undef PG8_SCHED
}

struct EpiEvenIn {
  static constexpr bool PERM = true, TRANS = true;
  ushort_t* ps5; ushort_t* prw;
  DEVI void operator()(const f32x4 (&acc)[2][2][4][2], const Unit& u, int wr, int wc, int fr, int fq) const {
#pragma unroll
    for (int ai = 0; ai < 2; ++ai)
#pragma unroll
      for (int m = 0; m < 4; ++m) {
        const size_t row = (size_t)u.pm * BM + ai * HALF + wr * 64 + m * 16 + fr;
#pragma unroll
        for (int bj = 0; bj < 2; ++bj) {
          const int c0 = u.pn * BM + bj * HALF + wc * 32 + 8 * fq;
          const f32x4 v0 = acc[ai][bj][m][0], v1 = acc[ai][bj][m][1];
          u32x4 o = {cvt_pk_bf16(v0[0], v0[1]), cvt_pk_bf16(v0[2], v0[3]), cvt_pk_bf16(v1[0], v1[1]), cvt_pk_bf16(v1[2], v1[3])};
          if (c0 < 1024) *(u32x4*)(ps5 + row * 1024 + c0) = o;
          else if (c0 < 3136) *(u32x4*)(prw + row * 2112 + (c0 - 1024)) = o;
        }
      }
  }
};
struct EpiHyIn {
  static constexpr bool PERM = false, TRANS = false;
  ushort_t* ph;
  DEVI void operator()(const f32x4 (&acc)[2][2][4][2], const Unit& u, int wr, int wc, int fr, int fq) const {
    int s0, L; seq_of(u.pm * BM, s0, L);
#pragma unroll
    for (int ai = 0; ai < 2; ++ai)
#pragma unroll
      for (int m = 0; m < 4; ++m) {
        const int tok = u.pm * BM + ai * HALF + wr * 64 + m * 16 + 4 * fq;
#pragma unroll
        for (int bj = 0; bj < 2; ++bj)
#pragma unroll
          for (int n = 0; n < 2; ++n) {
            const int col = u.pn * BM + bj * HALF + wc * 32 + 16 * n + fr;
            const int st = col >> 10, c = col & 1023;
            const f32x4 v = acc[ai][bj][m][n];
            ushort_t* dst = ph + (size_t)st * T * 1024 + (size_t)s0 * 1024 + (size_t)c * L + (tok - s0);
            *(uint2*)dst = uint2{cvt_pk_bf16(v[0], v[1]), cvt_pk_bf16(v[2], v[3])};
          }
      }
  }
};
struct EpiGlu {
  static constexpr bool PERM = true, TRANS = true;
  ushort_t* y; const ushort_t* ps5; const float* bias;
  DEVI void operator()(const f32x4 (&acc)[2][2][4][2], const Unit& u, int wr, int wc, int fr, int fq) const {
#pragma unroll
    for (int ai = 0; ai < 2; ++ai)
#pragma unroll
      for (int m = 0; m < 4; ++m) {
        const size_t row = (size_t)u.pm * BM + ai * HALF + wr * 64 + m * 16 + fr;
#pragma unroll
        for (int bj = 0; bj < 2; ++bj) {
          const int c0 = u.pn * BM + bj * HALF + wc * 32 + 8 * fq;
          const u32x4 a8 = *(const u32x4*)(y + row * 1024 + 512 + c0);
          const u32x4 g8 = *(const u32x4*)(ps5 + row * 1024 + 512 + c0);
          const f32x4 b0 = *(const f32x4*)(bias + c0), b1 = *(const f32x4*)(bias + c0 + 4);
          float v[8];
#pragma unroll
          for (int e = 0; e < 4; ++e) { v[e] = acc[ai][bj][m][0][e] + b0[e]; v[4 + e] = acc[ai][bj][m][1][e] + b1[e]; }
          unsigned o[4];
#pragma unroll
          for (int e = 0; e < 4; ++e) {
            const float a_lo = __uint_as_float(a8[e] << 16), a_hi = __uint_as_float(a8[e] & 0xffff0000u);
            const float g_lo = __uint_as_float(g8[e] << 16), g_hi = __uint_as_float(g8[e] & 0xffff0000u);
            const float r_lo = a_lo * sigmoidf_(v[2 * e]) * (g_lo * sigmoidf_(g_lo));
            const float r_hi = a_hi * sigmoidf_(v[2 * e + 1]) * (g_hi * sigmoidf_(g_hi));
            o[e] = cvt_pk_bf16(r_lo, r_hi);
          }
          *(u32x4*)(y + row * 1024 + c0) = u32x4{o[0], o[1], o[2], o[3]};
        }
      }
  }
};
struct EpiF32 {
  static constexpr bool PERM = false, TRANS = true;
  float* C;
  DEVI void operator()(const f32x4 (&acc)[2][2][4][2], const Unit& u, int wr, int wc, int fr, int fq) const {
#pragma unroll
    for (int ai = 0; ai < 2; ++ai)
#pragma unroll
      for (int m = 0; m < 4; ++m) {
        float* rowp = C + ((size_t)u.pm * BM + ai * HALF + wr * 64 + m * 16 + fr) * 1024 + u.pn * BM + wc * 32 + 4 * fq;
#pragma unroll
        for (int bj = 0; bj < 2; ++bj)
#pragma unroll
          for (int n = 0; n < 2; ++n) *(f32x4*)(rowp + bj * HALF + n * 16) = acc[ai][bj][m][n];
      }
  }
};
}

template <class Epi>
DEVI void run_gemm(unsigned char* lds, const ushort_t* A, int lda, const ushort_t* Bt, int N, int K, const Epi& E) {
  pg8::Gemm g; g.A = A; g.Bt = Bt; g.M = T; g.N = N; g.K = K; g.lda = lda;
  pg8::StaticOrder S; S.init(T, N, (int)gridDim.x, bidx());
  __syncthreads();
  pg8::gemm_phase<Epi>((PG8_LAS unsigned char*)lds, g, S, E);
  __syncthreads();
}

__device__ void xb_convert(const Params& p, ushort_t* XB) {
  const size_t n4 = (size_t)T * 1024 / 4, np4 = (size_t)TPROMPT * 1024 / 4;
  const float4* xp = (const float4*)p.in[I_XP]; const float4* xs = (const float4*)p.in[I_XS];
  for (size_t e = (size_t)bidx() * NT + tidx(); e < n4; e += (size_t)gridDim.x * NT) {
    const float4 v = e < np4 ? xp[e] : xs[e - np4];
    ((uint2*)XB)[e] = uint2{pack2(v.x, v.y), pack2(v.z, v.w)};
  }
}
__device__ void zero_fill(ushort_t* dst, size_t n) {
  for (size_t e = (size_t)bidx() * NT + tidx(); e < n / 8; e += (size_t)gridDim.x * NT) ((uint4*)dst)[e] = uint4{0, 0, 0, 0};
}
__device__ void hy_transpose(const ushort_t* __restrict__ PH3, ushort_t* __restrict__ Y, unsigned char* lds) {
  ushort_t* tile = (ushort_t*)lds;
  const int tid = tidx(), j = tid & 63, i0 = tid >> 6;
  for (int t = bidx(); t < (T / 64) * 16; t += gridDim.x) {
    const int tok0 = (t >> 4) * 64, c0 = (t & 15) * 64;
    int s0, L; seq_of(tok0, s0, L);
    __syncthreads();
#pragma unroll
    for (int e = 0; e < 8; ++e) { const int i = i0 + 8 * e; tile[i * 66 + j] = PH3[(size_t)s0 * 1024 + (size_t)(c0 + i) * L + (tok0 - s0) + j]; }
    __syncthreads();
#pragma unroll
    for (int e = 0; e < 8; ++e) { const int i = i0 + 8 * e; Y[(size_t)(tok0 + i) * 1024 + c0 + j] = tile[j * 66 + i]; }
  }
}

__device__ void ln_phase(const Params& p, int layer, const float* __restrict__ F, ushort_t* __restrict__ XB, bool dry = false) {
  const int lane = tidx() & 63, gw = bidx() * (NT / 64) + (tidx() >> 6), nw = gridDim.x * (NT / 64);
  const float alpha = 1.681792830507429f;
  const float4* g4 = (const float4*)(p.in[I_LNG] + layer * 1024);
  const float4* b4 = (const float4*)(p.in[I_LNB] + layer * 1024);
  const XSrc xs_ = xsrc(p);
  for (int row = gw; row < T; row += nw) {
    const float4* x4 = (const float4*)xrow(xs_, layer, row);
    const float4* f4 = (const float4*)(F + (size_t)row * 1024);
    float4 v[4];
    float s = 0.f;
#pragma unroll
    for (int e = 0; e < 4; ++e) {
      float4 a = x4[lane + 64 * e], f = f4[lane + 64 * e];
      v[e] = float4{alpha * a.x + f.x, alpha * a.y + f.y, alpha * a.z + f.z, alpha * a.w + f.w};
      s += v[e].x + v[e].y + v[e].z + v[e].w;
    }
    const float mean = wsum(s) * (1.f / 1024.f);
    float q = 0.f;
#pragma unroll
    for (int e = 0; e < 4; ++e) {
      v[e].x -= mean; v[e].y -= mean; v[e].z -= mean; v[e].w -= mean;
      q += v[e].x * v[e].x + v[e].y * v[e].y + v[e].z * v[e].z + v[e].w * v[e].w;
    }
    const float rs = rsqrtf(wsum(q) * (1.f / 1024.f) + 1e-5f);
    float4* o4 = (float4*)(p.out + (size_t)row * 1024);
#pragma unroll
    for (int e = 0; e < 4; ++e) {
      float4 g = g4[lane + 64 * e], b = b4[lane + 64 * e];
      const float4 o = float4{v[e].x * rs * g.x + b.x, v[e].y * rs * g.y + b.y, v[e].z * rs * g.z + b.z, v[e].w * rs * g.w + b.w};
      if (!dry) o4[lane + 64 * e] = o;
      if (XB) ((uint2*)(XB + (size_t)row * 1024))[lane + 64 * e] = uint2{pack2(o.x, o.y), pack2(o.z, o.w)};
    }
  }
}

struct cplx { float x, y; };
DEVI cplx cmul(cplx a, cplx b) { return cplx{a.x * b.x - a.y * b.y, a.x * b.y + a.y * b.x}; }
DEVI void s5_consts(const Params& p, int i, int d, int g, int n, cplx& lb, cplx& coef) {
  const int idx = ((i * 2 + d) * 32 + g) * 64 + n;
  const float lre = p.in[I_LRE][idx], lim = p.in[I_LIM][idx];
  const float dt = expf(p.in[I_LSTEP][(i * 2 + d) * 32 + g]);
  const float mag = expf(lre * dt);
  float sn, cs; sincosf(lim * dt, &sn, &cs);
  lb = cplx{mag * cs, mag * sn};
  const float nr = lb.x - 1.f, ni = lb.y, den = 1.f / (lre * lre + lim * lim);
  coef = cplx{(nr * lre + ni * lim) * den, (ni * lre - nr * lim) * den};
}
DEVI void s5_load_u(const ushort_t* PS5, int tok0, int g, int lane, uint4& a, uint4& b) {
  const uint4* src = (const uint4*)(PS5 + (size_t)(tok0 + lane) * 1024 + g * 16);
  a = src[0]; b = src[1];
}
DEVI void s5_store_u(float* U, int lane, const uint4& a, const uint4& b) {
  float4* d = (float4*)(U + lane * 16);
  d[0] = float4{__uint_as_float(a.x << 16), __uint_as_float(a.x & 0xffff0000u), __uint_as_float(a.y << 16), __uint_as_float(a.y & 0xffff0000u)};
  d[1] = float4{__uint_as_float(a.z << 16), __uint_as_float(a.z & 0xffff0000u), __uint_as_float(a.w << 16), __uint_as_float(a.w & 0xffff0000u)};
  d[2] = float4{__uint_as_float(b.x << 16), __uint_as_float(b.x & 0xffff0000u), __uint_as_float(b.y << 16), __uint_as_float(b.y & 0xffff0000u)};
  d[3] = float4{__uint_as_float(b.z << 16), __uint_as_float(b.z & 0xffff0000u), __uint_as_float(b.w << 16), __uint_as_float(b.w & 0xffff0000u)};
}
#define S5_BU(Urow, bur, bui)                                                         \
  {                                                                                   \
    const float4* u4 = (const float4*)(Urow);                                         \
    bur = 0.f; bui = 0.f;                                                             \
    _Pragma("unroll") for (int pp = 0; pp < 4; ++pp) {                                \
      float4 u = u4[pp];                                                              \
      bur += Br[4 * pp] * u.x + Br[4 * pp + 1] * u.y + Br[4 * pp + 2] * u.z + Br[4 * pp + 3] * u.w; \
      bui += Bi[4 * pp] * u.x + Bi[4 * pp + 1] * u.y + Bi[4 * pp + 2] * u.z + Bi[4 * pp + 3] * u.w; \
    }                                                                                 \
  }

__device__ void s5_passA(const Params& p, int i, unsigned char* lds) {
  const ushort_t* PS5 = (const ushort_t*)(p.ws + OFF_PS5);
  cplx* CAR = (cplx*)(p.ws + OFF_CAR);
  const int lane = tidx() & 63, wave = tidx() >> 6;
  float* U = (float*)(lds + wave * 8448);
  for (int item = bidx() * 8 + wave; item < 192 * 32; item += gridDim.x * 8) {
    const int q = item >> 5, g = item & 31;
    cplx lb0, c0, lb1, c1;
    s5_consts(p, i, 0, g, lane, lb0, c0);
    s5_consts(p, i, 1, g, lane, lb1, c1);
    float Br[16], Bi[16];
#pragma unroll
    for (int pp = 0; pp < 16; ++pp) { Br[pp] = p.in[I_BRE][((i * 32 + g) * 64 + lane) * 16 + pp]; Bi[pp] = p.in[I_BIM][((i * 32 + g) * 64 + lane) * 16 + pp]; }
    cplx xf{0.f, 0.f}, xb{0.f, 0.f}, pw{1.f, 0.f};
    uint4 ua, ub;
    s5_load_u(PS5, q * 256, g, lane, ua, ub);
    for (int sb = 0; sb < 4; ++sb) {
      wave_sync();
      s5_store_u(U, lane, ua, ub);
      wave_sync();
      if (sb < 3) s5_load_u(PS5, q * 256 + (sb + 1) * 64, g, lane, ua, ub);
      for (int t = 0; t < 64; ++t) {
        float bur, bui;
        S5_BU(U + t * 16, bur, bui);
        xf = cmul(lb0, xf); xf.x += bur; xf.y += bui;
        xb.x += pw.x * bur - pw.y * bui; xb.y += pw.x * bui + pw.y * bur;
        pw = cmul(pw, lb1);
      }
    }
    CAR[((size_t)(q * 32 + g) * 2 + 0) * 64 + lane] = cmul(xf, c0);
    CAR[((size_t)(q * 32 + g) * 2 + 1) * 64 + lane] = cmul(xb, c1);
  }
}

__device__ void s5_passC(const Params& p, int i, unsigned char* lds) {
  const ushort_t* PS5 = (const ushort_t*)(p.ws + OFF_PS5);
  const cplx* CAR = (const cplx*)(p.ws + OFF_CAR);
  float* YS = (float*)(p.ws + OFF_YS);
  ushort_t* YG = (ushort_t*)(p.ws + OFF_Y);
  const int lane = tidx() & 63, wave = tidx() >> 6;
  float* U = (float*)(lds + wave * 8448);
  ushort_t* X = (ushort_t*)(lds + wave * 8448 + 4096);
  for (int item = bidx() * 8 + wave; item < 192 * 32; item += gridDim.x * 8) {
    const int q = item >> 5, g = item & 31;
    int cs, ce;
    if (q < 64) { cs = q & ~15; ce = cs + 16; } else { cs = 64 + ((q - 64) & ~63); ce = cs + 64; }
    float Br[16], Bi[16];
#pragma unroll
    for (int pp = 0; pp < 16; ++pp) { Br[pp] = p.in[I_BRE][((i * 32 + g) * 64 + lane) * 16 + pp]; Bi[pp] = p.in[I_BIM][((i * 32 + g) * 64 + lane) * 16 + pp]; }
    const int pcol = lane & 15;
    const float dd = p.in[I_S5D][i * 512 + g * 16 + pcol];
    for (int d = 0; d < 2; ++d) {
      cplx lb, coef;
      s5_consts(p, i, d, g, lane, lb, coef);
      cplx lp = lb;
#pragma unroll
      for (int e = 0; e < 8; ++e) lp = cmul(lp, lp);
      cplx xs{0.f, 0.f};
      if (d == 0) {
#pragma unroll 8
        for (int j = cs; j < q; ++j) { xs = cmul(lp, xs); cplx c = CAR[((size_t)(j * 32 + g) * 2 + 0) * 64 + lane]; xs.x += c.x; xs.y += c.y; } }
      else {
#pragma unroll 8
        for (int j = ce - 1; j > q; --j) { xs = cmul(lp, xs); cplx c = CAR[((size_t)(j * 32 + g) * 2 + 1) * 64 + lane]; xs.x += c.x; xs.y += c.y; } }
      bf16x8 cf[4];
#pragma unroll
      for (int kk = 0; kk < 4; ++kk) {
        const int n0 = (kk & 1) * 32 + (lane >> 4) * 8;
        const float* src = (kk < 2 ? p.in[I_CRE] : p.in[I_CIM]) + (((size_t)(i * 2 + d) * 32 + g) * 16 + pcol) * 64 + n0;
        const float sg = kk < 2 ? 1.f : -1.f;
#pragma unroll
        for (int j = 0; j < 8; ++j) cf[kk][j] = (short)f2bf(sg * src[j]);
      }
      uint4 ua, ub;
      s5_load_u(PS5, q * 256 + (d ? 3 : 0) * 64, g, lane, ua, ub);
      for (int sbi = 0; sbi < 4; ++sbi) {
        const int sb = d ? 3 - sbi : sbi;
        wave_sync();
        s5_store_u(U, lane, ua, ub);
        wave_sync();
        if (sbi < 3) s5_load_u(PS5, q * 256 + (d ? 2 - sbi : sbi + 1) * 64, g, lane, ua, ub);
        for (int tbi = 0; tbi < 4; ++tbi) {
          const int tb = d ? 3 - tbi : tbi;
          float ysp[4] = {0.f, 0.f, 0.f, 0.f};
          if (d == 1) {
#pragma unroll
            for (int r = 0; r < 4; ++r) ysp[r] = YS[(size_t)(q * 256 + sb * 64 + tb * 16 + (lane >> 4) * 4 + r) * 512 + g * 16 + pcol];
          }
          for (int tti = 0; tti < 16; ++tti) {
            const int tt = d ? 15 - tti : tti;
            float bur, bui;
            S5_BU(U + (tb * 16 + tt) * 16, bur, bui);
            xs = cmul(lb, xs);
            xs.x += coef.x * bur - coef.y * bui;
            xs.y += coef.x * bui + coef.y * bur;
            X[tt * 136 + lane] = f2bf(xs.x);
            X[tt * 136 + 64 + lane] = f2bf(xs.y);
          }
          wave_sync();
          f32x4 acc{0.f, 0.f, 0.f, 0.f};
#pragma unroll
          for (int kk = 0; kk < 4; ++kk) {
            bf16x8 a = *(const bf16x8*)(X + (lane & 15) * 136 + kk * 32 + (lane >> 4) * 8);
            acc = __builtin_amdgcn_mfma_f32_16x16x32_bf16(a, cf[kk], acc, 0, 0, 0);
          }
          wave_sync();
#pragma unroll
          for (int r = 0; r < 4; ++r) {
            const int tl = tb * 16 + (lane >> 4) * 4 + r;
            const size_t o = (size_t)(q * 256 + sb * 64 + tl) * 512 + g * 16 + pcol;
            if (d == 0) YS[o] = acc[r] + dd * U[tl * 16 + pcol];
            else {
              const float yv = ysp[r] + acc[r];
              YG[(size_t)(q * 256 + sb * 64 + tl) * 1024 + 512 + g * 16 + pcol] = f2bf(gelu_tanh(yv));
            }
          }
        }
      }
    }
  }
}

struct RwConst { float mur, muk, muv, mul, w0, a0, kk, ka; };
struct RwRow { float r, k, v, l; };
DEVI RwRow rw_load_row(const ushort_t* PRW, int tok, int s0, int L, int h, int lane) {
  RwRow o{0.f, 0.f, 0.f, 0.f};
  if (tok >= s0 && tok < s0 + L) {
    const ushort_t* row = PRW + (size_t)tok * 2112;
    const int cc = h * 64 + lane;
    o.r = bf2f(row[cc]); o.k = bf2f(row[512 + cc]); o.v = bf2f(row[1024 + cc]); o.l = bf2f(row[2048 + lane]);
  }
  return o;
}
DEVI void rw_prologue(const RwRow& rm, const RwRow& rc, const RwRow& rn, int lane, const RwConst& c, const float* WU, const float* AU,
                      float* LT, float* Wd, float* KKd, float* BBd, float* KDd, float* RRd, float* VVd) {
  const float rr = rc.r + c.mur * (0.5f * (rm.r + rn.r) - rc.r);
  const float kx = rc.k + c.muk * (0.5f * (rm.k + rn.k) - rc.k);
  const float vv = rc.v + c.muv * (0.5f * (rm.v + rn.v) - rc.v);
  float ll = rc.l + c.mul * (0.5f * (rm.l + rn.l) - rc.l);
  ll = lane < 32 ? fast_tanh(ll) : ll;
  wave_sync();
  LT[lane] = ll;
  wave_sync();
  float accw = c.w0, acca = c.a0;
#pragma unroll 2
  for (int j = 0; j < 32; j += 4) {
    float4 lw = *(const float4*)(LT + j), la = *(const float4*)(LT + 32 + j);
    accw += lw.x * WU[(j + 0) * 64 + lane] + lw.y * WU[(j + 1) * 64 + lane] + lw.z * WU[(j + 2) * 64 + lane] + lw.w * WU[(j + 3) * 64 + lane];
    acca += la.x * AU[(j + 0) * 64 + lane] + la.y * AU[(j + 1) * 64 + lane] + la.z * AU[(j + 2) * 64 + lane] + la.w * AU[(j + 3) * 64 + lane];
  }
  const float dec = __builtin_amdgcn_exp2f(-0.8750387749145276f * fast_sigmoid(accw));
  const float a = fast_sigmoid(acca);
  const float kkr = kx * c.kk;
  const float ss = wsum_fast(kkr * kkr);
  const float kkn = kkr * __builtin_amdgcn_rsqf(fmaxf(ss, 1e-24f));
  Wd[lane] = dec; KKd[lane] = kkn; BBd[lane] = kkn * a; KDd[lane] = kx * (1.f + (a - 1.f) * c.ka); RRd[lane] = rr; VVd[lane] = vv;
}

typedef float f32x2 __attribute__((ext_vector_type(2)));
DEVI float dpp_f(float x, const int ctrl_sel) {
  int xi = __builtin_bit_cast(int, x), r;
  if (ctrl_sel == 0) r = __builtin_amdgcn_mov_dpp(xi, 0xB1, 0xf, 0xf, true);
  else if (ctrl_sel == 1) r = __builtin_amdgcn_mov_dpp(xi, 0x4E, 0xf, 0xf, true);
  else r = __builtin_amdgcn_mov_dpp(xi, 0x141, 0xf, 0xf, true);
  return __builtin_bit_cast(float, r);
}
DEVI float red8(float x) { x += dpp_f(x, 0); x += dpp_f(x, 1); x += dpp_f(x, 2); return x; }

#define RW_LOAD8(dst2, base)                                                        \
  { const float4 _a = *(const float4*)(base), _b = *(const float4*)((base) + 4);    \
    dst2[0] = f32x2{_a.x, _a.y}; dst2[1] = f32x2{_a.z, _a.w}; dst2[2] = f32x2{_b.x, _b.y}; dst2[3] = f32x2{_b.z, _b.w}; }

__device__ void rwkv_scan1(const Params& p, int i, unsigned char* lds) {
  const ushort_t* PRW = (const ushort_t*)(p.ws + OFF_PRW);
  float* CH = (float*)(p.ws + OFF_PS5);
  float* YR = (float*)(p.ws + OFF_YS);
  const int tid = tidx(), lane = tid & 63, wave = tid >> 6, pair = wave >> 1, role = wave & 1;
  const int vq = lane >> 3, kq = lane & 7;
  float* TAB = (float*)lds;
  float* WV = (float*)(lds + 24576 + pair * 12800);
  float* Wd = WV, *KKd = WV + 512, *BBd = WV + 1024, *KDd = WV + 1536, *RRd = WV + 2048, *VVd = WV + 2560, *LT = WV + 3072 + role * 64;
  {
    float4* z = (float4*)YR;
    for (size_t e = (size_t)bidx() * NT + tid; e < (size_t)T * 512 / 4; e += (size_t)gridDim.x * NT) z[e] = float4{0.f, 0.f, 0.f, 0.f};
  }
  for (int bi = bidx(); bi < 768; bi += gridDim.x) {
    const int h = bi / 96, rem = bi % 96;
    const int dir = pair >> 1, q = rem * 2 + (pair & 1);
    __syncthreads();
    for (int e = tid; e < 3 * 2048; e += NT) {
      const int which = e >> 11, j = (e >> 6) & 31, c = e & 63;
      TAB[e] = which < 2 ? p.in[I_WUP][((size_t)(i * 2 + which) * 32 + j) * 512 + h * 64 + c] : p.in[I_AUP][((size_t)i * 32 + j) * 512 + h * 64 + c];
    }
    __syncthreads();
    const float* WU = TAB + dir * 2048;
    const float* AU = TAB + 2 * 2048;
    RwConst c;
    const int cc = h * 64 + lane;
    c.mur = p.in[I_MURKV][(i * 3 + 0) * 512 + cc]; c.muk = p.in[I_MURKV][(i * 3 + 1) * 512 + cc]; c.muv = p.in[I_MURKV][(i * 3 + 2) * 512 + cc];
    c.mul = p.in[I_MULORA][i * 64 + lane];
    c.w0 = p.in[I_W0][(i * 2 + dir) * 512 + cc]; c.a0 = p.in[I_A0][(i * 2 + dir) * 512 + cc];
    c.kk = p.in[I_KK][i * 512 + cc]; c.ka = p.in[I_KA][i * 512 + cc];
    const size_t it = ((size_t)(q * 8 + h) * 2 + dir);
    int sq0, sqL; seq_of(q * 256, sq0, sqL);
    float* Op = CH + it * 8192 + (role ? 0 : 4096);
    f32x2 S2[8][4];
    int diag = (role && vq == kq) ? 1 : 0;
    asm volatile("" : "+v"(diag));
#pragma unroll
    for (int r = 0; r < 8; ++r)
#pragma unroll
      for (int jj = 0; jj < 4; ++jj) S2[r][jj] = f32x2{(diag && (2 * jj == r)) ? 1.f : 0.f, (diag && (2 * jj + 1 == r)) ? 1.f : 0.f};
    const float vsel = role ? 0.f : 1.f;
    for (int blk = 0; blk < 32; ++blk) {
      {
        RwRow R[6];
#pragma unroll
        for (int j = 0; j < 6; ++j) {
          const int st = blk * 8 + role * 4 + j - 1;
          R[j] = rw_load_row(PRW, dir ? (q * 256 + 255 - st) : (q * 256 + st), sq0, sqL, h, lane);
        }
#pragma unroll
        for (int e = 0; e < 4; ++e) {
          const int s = role * 4 + e;
          rw_prologue(R[e], R[e + 1], R[e + 2], lane, c, WU, AU, LT, Wd + s * 64, KKd + s * 64, BBd + s * 64, KDd + s * 64, RRd + s * 64, VVd + s * 64);
        }
      }
      __syncthreads();
#pragma unroll 2
      for (int s = 0; s < 8; ++s) {
        f32x2 kk2[4], w2[4], b2[4], kd2[4], vv2[4];
        RW_LOAD8(kk2, KKd + s * 64 + 8 * kq);
        RW_LOAD8(vv2, VVd + s * 64 + 8 * vq);
        RW_LOAD8(w2, Wd + s * 64 + 8 * kq);
        RW_LOAD8(b2, BBd + s * 64 + 8 * kq);
        RW_LOAD8(kd2, KDd + s * 64 + 8 * kq);
        float sa[8];
#pragma unroll
        for (int r = 0; r < 8; ++r) {
          f32x2 a = S2[r][0] * kk2[0];
          a = S2[r][1] * kk2[1] + a; a = S2[r][2] * kk2[2] + a; a = S2[r][3] * kk2[3] + a;
          sa[r] = -red8(a.x + a.y);
        }
#pragma unroll
        for (int r = 0; r < 8; ++r) {
          const float vr = ((r & 1) ? vv2[r >> 1].y : vv2[r >> 1].x) * vsel;
          const f32x2 sa2 = f32x2{sa[r], sa[r]}, v2 = f32x2{vr, vr};
#pragma unroll
          for (int jj = 0; jj < 4; ++jj) S2[r][jj] = S2[r][jj] * w2[jj] + sa2 * b2[jj] + v2 * kd2[jj];
        }
      }
      __syncthreads();
    }
#pragma unroll
    for (int r = 0; r < 8; ++r) {
      float* dst = Op + (8 * vq + r) * 64 + 8 * kq;
      *(float4*)dst = float4{S2[r][0].x, S2[r][0].y, S2[r][1].x, S2[r][1].y};
      *(float4*)(dst + 4) = float4{S2[r][2].x, S2[r][2].y, S2[r][3].x, S2[r][3].y};
    }
  }
}

__device__ void rwkv_scan3(const Params& p, int i, unsigned char* lds, bool dry = false) {
  const ushort_t* PRW = (const ushort_t*)(p.ws + OFF_PRW);
  float* CH = (float*)(p.ws + OFF_PS5);
  float* YR = (float*)(p.ws + OFF_YS);
  const int tid = tidx(), lane = tid & 63, wave = tid >> 6;
  const int vq = lane >> 3, kq = lane & 7;
  float* TAB = (float*)lds;
  float* WV = (float*)(lds + 24576 + wave * 12544);
  float* Wd = WV, *KKd = WV + 512, *BBd = WV + 1024, *KDd = WV + 1536, *RRd = WV + 2048, *VVd = WV + 2560, *LT = WV + 3072;
  for (int bi = bidx(); bi < 384; bi += gridDim.x) {
    const int h = bi / 48, cgp = bi % 48;
    const int dir = wave >> 2, q = cgp * 4 + (wave & 3);
    __syncthreads();
    for (int e = tid; e < 3 * 2048; e += NT) {
      const int which = e >> 11, j = (e >> 6) & 31, c = e & 63;
      TAB[e] = which < 2 ? p.in[I_WUP][((size_t)(i * 2 + which) * 32 + j) * 512 + h * 64 + c] : p.in[I_AUP][((size_t)i * 32 + j) * 512 + h * 64 + c];
    }
    __syncthreads();
    const float* WU = TAB + dir * 2048;
    const float* AU = TAB + 2 * 2048;
    RwConst c;
    const int cc = h * 64 + lane;
    c.mur = p.in[I_MURKV][(i * 3 + 0) * 512 + cc]; c.muk = p.in[I_MURKV][(i * 3 + 1) * 512 + cc]; c.muv = p.in[I_MURKV][(i * 3 + 2) * 512 + cc];
    c.mul = p.in[I_MULORA][i * 64 + lane];
    c.w0 = p.in[I_W0][(i * 2 + dir) * 512 + cc]; c.a0 = p.in[I_A0][(i * 2 + dir) * 512 + cc];
    c.kk = p.in[I_KK][i * 512 + cc]; c.ka = p.in[I_KA][i * 512 + cc];
    const size_t it = ((size_t)(q * 8 + h) * 2 + dir);
    int sq0, sqL; seq_of(q * 256, sq0, sqL);
    const float* Qp = CH + it * 8192 + 4096;
    f32x2 S2[8][4];
#pragma unroll
    for (int r = 0; r < 8; ++r) {
      const float* src = Qp + (8 * vq + r) * 64 + 8 * kq;
      const float4 a = *(const float4*)src, b = *(const float4*)(src + 4);
      S2[r][0] = f32x2{a.x, a.y}; S2[r][1] = f32x2{a.z, a.w}; S2[r][2] = f32x2{b.x, b.y}; S2[r][3] = f32x2{b.z, b.w};
    }
    for (int blk = 0; blk < 32; ++blk) {
      {
        RwRow R[10];
#pragma unroll
        for (int j = 0; j < 10; ++j) {
          const int st = blk * 8 + j - 1;
          R[j] = rw_load_row(PRW, dir ? (q * 256 + 255 - st) : (q * 256 + st), sq0, sqL, h, lane);
        }
#pragma unroll
        for (int s = 0; s < 8; ++s)
          rw_prologue(R[s], R[s + 1], R[s + 2], lane, c, WU, AU, LT, Wd + s * 64, KKd + s * 64, BBd + s * 64, KDd + s * 64, RRd + s * 64, VVd + s * 64);
      }
      wave_sync();
#pragma unroll 2
      for (int s = 0; s < 8; ++s) {
        f32x2 kk2[4], w2[4], b2[4], kd2[4], vv2[4], r2[4];
        RW_LOAD8(kk2, KKd + s * 64 + 8 * kq);
        RW_LOAD8(vv2, VVd + s * 64 + 8 * vq);
        RW_LOAD8(w2, Wd + s * 64 + 8 * kq);
        RW_LOAD8(b2, BBd + s * 64 + 8 * kq);
        RW_LOAD8(kd2, KDd + s * 64 + 8 * kq);
        RW_LOAD8(r2, RRd + s * 64 + 8 * kq);
        float sa[8];
#pragma unroll
        for (int r = 0; r < 8; ++r) {
          f32x2 a = S2[r][0] * kk2[0];
          a = S2[r][1] * kk2[1] + a; a = S2[r][2] * kk2[2] + a; a = S2[r][3] * kk2[3] + a;
          sa[r] = -red8(a.x + a.y);
        }
        float ysel = 0.f;
#pragma unroll
        for (int r = 0; r < 8; ++r) {
          const float vr = (r & 1) ? vv2[r >> 1].y : vv2[r >> 1].x;
          const f32x2 sa2 = f32x2{sa[r], sa[r]}, v2 = f32x2{vr, vr};
          f32x2 ya = f32x2{0.f, 0.f};
#pragma unroll
          for (int jj = 0; jj < 4; ++jj) {
            S2[r][jj] = S2[r][jj] * w2[jj] + sa2 * b2[jj] + v2 * kd2[jj];
            ya = S2[r][jj] * r2[jj] + ya;
          }
          const float yr = red8(ya.x + ya.y);
          ysel = (kq == r) ? yr : ysel;
        }
        const int st = blk * 8 + s;
        const int tok = dir ? (q * 256 + 255 - st) : (q * 256 + st);
        if (!dry) atomicAdd(YR + (size_t)tok * 512 + h * 64 + lane, ysel);
      }
      wave_sync();
    }
  }
}

__device__ void rwkv_carry(const Params& p, unsigned char* lds, bool dry = false) {
  float* CH = (float*)(p.ws + OFF_PS5);
  float* Ps = (float*)lds;
  float* Ss = Ps + 4096;
  const int tid = tidx(), v = tid >> 4, ks = (tid & 15) * 4;
  for (int bi = bidx(); bi < 192; bi += gridDim.x) {
    const int half = bi & 1, dir = (bi >> 1) & 1, h = (bi >> 2) & 7, s = bi >> 5;
    int cs, n;
    if (s < 4) { cs = s * 16; n = 16; } else { cs = 64 + (s - 4) * 64; n = 64; }
    float4 cur{0.f, 0.f, 0.f, 0.f};
    float4 pq0, pq1, qv;
    {
      const int q = dir ? (cs + n - 1) : cs;
      const float* Pp = CH + ((size_t)(q * 8 + h) * 2 + dir) * 8192;
      pq0 = ((const float4*)Pp)[tid]; pq1 = ((const float4*)Pp)[tid + 512];
      qv = *(const float4*)(Pp + 4096 + (half * 32 + v) * 64 + ks);
    }
    for (int ci = 0; ci < n; ++ci) {
      const int q = dir ? (cs + n - 1 - ci) : (cs + ci);
      float* Pp = CH + ((size_t)(q * 8 + h) * 2 + dir) * 8192;
      float* Qrow = Pp + 4096 + (half * 32 + v) * 64 + ks;
      __syncthreads();
      if (!dry) *(float4*)Qrow = cur;
      if (ci == n - 1) break;
      *(float4*)(Ss + v * 64 + ks) = cur;
      ((float4*)Ps)[tid] = pq0;
      ((float4*)Ps)[tid + 512] = pq1;
      float4 acc = qv;
      if (ci + 2 < n + 1 && ci + 1 < n) {
        const int qn = dir ? (cs + n - 2 - ci) : (cs + ci + 1);
        const float* Pn = CH + ((size_t)(qn * 8 + h) * 2 + dir) * 8192;
        pq0 = ((const float4*)Pn)[tid]; pq1 = ((const float4*)Pn)[tid + 512];
        qv = *(const float4*)(Pn + 4096 + (half * 32 + v) * 64 + ks);
      }
      __syncthreads();
#pragma unroll 8
      for (int j = 0; j < 64; ++j) {
        const float sv = Ss[v * 64 + j];
        const float4 pr = *(const float4*)(Ps + j * 64 + ks);
        acc.x += sv * pr.x; acc.y += sv * pr.y; acc.z += sv * pr.z; acc.w += sv * pr.w;
      }
      cur = acc;
    }
    __syncthreads();
  }
}

__device__ void rwkv_post(const Params& p, int i) {
  const ushort_t* __restrict__ PRW = (const ushort_t*)(p.ws + OFF_PRW);
  const float* __restrict__ YR = (const float*)(p.ws + OFF_YS);
  ushort_t* __restrict__ Y = (ushort_t*)(p.ws + OFF_Y);
  const int lane = tidx() & 63, gw = bidx() * 8 + (tidx() >> 6), nw = gridDim.x * 8;
  for (int item = gw; item < (T / 4) * 8; item += nw) {
    const int tok0 = (item >> 3) * 4, h = item & 7, cc = h * 64 + lane;
    int s0, L; seq_of(tok0, s0, L);
    float r[6], k[6], v[6], g[4], y[4];
#pragma unroll
    for (int j = 0; j < 6; ++j) {
      const int tok = tok0 - 1 + j;
      r[j] = 0.f; k[j] = 0.f; v[j] = 0.f;
      if (tok >= s0 && tok < s0 + L) {
        const ushort_t* row = PRW + (size_t)tok * 2112;
        r[j] = bf2f(row[cc]); k[j] = bf2f(row[512 + cc]); v[j] = bf2f(row[1024 + cc]);
      }
    }
#pragma unroll
    for (int e = 0; e < 4; ++e) { g[e] = bf2f(PRW[(size_t)(tok0 + e) * 2112 + 1536 + cc]); y[e] = YR[(size_t)(tok0 + e) * 512 + cc]; }
    const float mur = p.in[I_MURKV][(i * 3 + 0) * 512 + cc], muk = p.in[I_MURKV][(i * 3 + 1) * 512 + cc], muv = p.in[I_MURKV][(i * 3 + 2) * 512 + cc];
    const float lw = p.in[I_LNXW][i * 512 + cc], lb = p.in[I_LNXB][i * 512 + cc], rk = p.in[I_RK][i * 512 + cc];
#pragma unroll
    for (int e = 0; e < 4; ++e) {
      const float rr = r[e + 1] + mur * (0.5f * (r[e] + r[e + 2]) - r[e + 1]);
      const float kx = k[e + 1] + muk * (0.5f * (k[e] + k[e + 2]) - k[e + 1]);
      const float vv = v[e + 1] + muv * (0.5f * (v[e] + v[e + 2]) - v[e + 1]);
      const float mean = wsum_fast(y[e]) * (1.f / 64.f);
      const float dlt = y[e] - mean;
      const float var = wsum_fast(dlt * dlt) * (1.f / 64.f);
      const float yn = dlt * __builtin_amdgcn_rsqf(var + 64e-5f) * lw + lb;
      const float bonus = wsum_fast(rr * kx * rk) * vv;
      Y[(size_t)(tok0 + e) * 1024 + 512 + cc] = f2bf((yn + bonus) * (g[e] * fast_sigmoid(g[e])));
    }
  }
}

__device__ void hy_filter_mlp(const Params& p, int i) {
  float* H2 = (float*)(p.ws + OFF_H2);
  const int lane = tidx() & 63, gw = bidx() * 8 + (tidx() >> 6), nw = gridDim.x * 8;
  const float fr = p.in[I_FFREQ][i * 64 + lane], b1 = p.in[I_FB1][i * 64 + lane], b2 = p.in[I_FB2][i * 64 + lane];
  for (int row = gw; row < 20480; row += nw) {
    const int L = row < 4096 ? 4096 : 16384, t = row < 4096 ? row : row - 4096;
    const float w = 6.283185307179586f * (float)t / (float)L;
    float z = 0.f;
    if (lane == 0) z = (float)t / (float)(L - 1);
    else if (lane <= 32) {
      const int bi = (lane - 1) & 15;
      const float f = 1e-4f + (float)bi * ((15.f - 1e-4f) / 15.f);
      z = lane <= 16 ? cosf(f * w) : -sinf(f * w);
    }
    float a = b1;
#pragma unroll 3
    for (int k = 0; k < 33; ++k) a += __shfl(z, k) * p.in[I_FW1][((size_t)i * 33 + k) * 64 + lane];
    const float h1 = sinf(fr * a);
    float c = b2;
#pragma unroll 8
    for (int k = 0; k < 64; ++k) c += __shfl(h1, k) * p.in[I_FW2][((size_t)i * 64 + k) * 64 + lane];
    H2[(row < 4096 ? (size_t)0 : (size_t)4096 * 64) + (size_t)lane * L + t] = sinf(fr * c);
  }
}

DEVI constexpr int swz(int i) { return i ^ ((i & 32) ? 21 : 0) ^ ((i & 64) ? 26 : 0); }
DEVI int swzF(int t) { return (swz(t >> 1) << 1) | (t & 1); }
template <int LOGN>
__device__ void fft_dif(float2* buf) {
  constexpr int N = 1 << LOGN;
  const int tid = tidx();
#pragma unroll
  for (int ps = 0; ps < LOGN / 2; ++ps) {
    const int lh = LOGN - 1 - 2 * ps;
    const int h = 1 << lh, hh = h >> 1;
    const float inv2h = 1.f / (float)(2 * h);
#pragma unroll 2
    for (int q = tid; q < N / 4; q += NT) {
      const int pos = q & (hh - 1), grp = q >> (lh - 1);
      const int e0 = swz((grp << (lh + 1)) + pos);
      const int o1 = swz(hh), o2 = swz(h), o3 = swz(h + hh);
      float2 x0 = buf[e0], x1 = buf[e0 ^ o1], x2 = buf[e0 ^ o2], x3 = buf[e0 ^ o3];
      const float f1 = (float)pos * inv2h;
      const float c1 = __builtin_amdgcn_cosf(f1), s1 = -__builtin_amdgcn_sinf(f1);
      const float c2 = c1 * c1 - s1 * s1, s2 = 2.f * c1 * s1;
      float2 a0{x0.x + x2.x, x0.y + x2.y};
      float2 d2{x0.x - x2.x, x0.y - x2.y};
      float2 a2{d2.x * c1 - d2.y * s1, d2.x * s1 + d2.y * c1};
      float2 a1{x1.x + x3.x, x1.y + x3.y};
      float2 d3{x1.x - x3.x, x1.y - x3.y};
      float2 t3{d3.x * c1 - d3.y * s1, d3.x * s1 + d3.y * c1};
      float2 a3{t3.y, -t3.x};
      float2 y0{a0.x + a1.x, a0.y + a1.y};
      float2 e1{a0.x - a1.x, a0.y - a1.y};
      float2 y1{e1.x * c2 - e1.y * s2, e1.x * s2 + e1.y * c2};
      float2 y2{a2.x + a3.x, a2.y + a3.y};
      float2 e3{a2.x - a3.x, a2.y - a3.y};
      float2 y3{e3.x * c2 - e3.y * s2, e3.x * s2 + e3.y * c2};
      buf[e0] = y0; buf[e0 ^ o1] = y1; buf[e0 ^ o2] = y2; buf[e0 ^ o3] = y3;
    }
    __syncthreads();
  }
}
template <int LOGN>
__device__ void fft_dit_inv(float2* buf) {
  constexpr int N = 1 << LOGN;
  const int tid = tidx();
#pragma unroll
  for (int ps = 0; ps < LOGN / 2; ++ps) {
    const int lh = 2 * ps;
    const int h = 1 << lh;
    const float inv4h = 1.f / (float)(4 * h);
#pragma unroll 2
    for (int q = tid; q < N / 4; q += NT) {
      const int pos = q & (h - 1), grp = q >> lh;
      const int e0 = swz((grp << (lh + 2)) + pos);
      const int o1 = swz(h), o2 = swz(2 * h), o3 = swz(3 * h);
      float2 x0 = buf[e0], x1 = buf[e0 ^ o1], x2 = buf[e0 ^ o2], x3 = buf[e0 ^ o3];
      const float f2 = (float)pos * inv4h;
      const float c2 = __builtin_amdgcn_cosf(f2), s2 = __builtin_amdgcn_sinf(f2);
      const float c1 = c2 * c2 - s2 * s2, s1 = 2.f * c2 * s2;
      float2 b1{x1.x * c1 - x1.y * s1, x1.x * s1 + x1.y * c1};
      float2 b3{x3.x * c1 - x3.y * s1, x3.x * s1 + x3.y * c1};
      float2 a0{x0.x + b1.x, x0.y + b1.y}, a1{x0.x - b1.x, x0.y - b1.y};
      float2 a2{x2.x + b3.x, x2.y + b3.y}, a3{x2.x - b3.x, x2.y - b3.y};
      float2 cc2{a2.x * c2 - a2.y * s2, a2.x * s2 + a2.y * c2};
      float2 t3{a3.x * c2 - a3.y * s2, a3.x * s2 + a3.y * c2};
      float2 cc3{-t3.y, t3.x};
      buf[e0] = float2{a0.x + cc2.x, a0.y + cc2.y};
      buf[e0 ^ o2] = float2{a0.x - cc2.x, a0.y - cc2.y};
      buf[e0 ^ o1] = float2{a1.x + cc3.x, a1.y + cc3.y};
      buf[e0 ^ o3] = float2{a1.x - cc3.x, a1.y - cc3.y};
    }
    __syncthreads();
  }
}
template <int LOGN>
__device__ void spectrum_extract(const float2* buf, float4* __restrict__ GP, float scale) {
  constexpr int Lc = 1 << LOGN;
  for (int j = tidx(); j < Lc / 2; j += NT) {
    if (j == 0) {
      const float2 c = buf[0], ch = buf[1];
      GP[0] = float4{(c.x + c.y) * scale, (c.x - c.y) * scale, ch.x * scale, -ch.y * scale};
    } else {
      const int pos = 2 * j;
      const int k = (int)(__brev((unsigned)pos) >> (32 - LOGN));
      const int p2 = pos ^ ((1 << (31 - __clz(pos))) - 1);
      const int sp1 = swz(pos), sp2 = swz(p2);
      float2 C1 = buf[sp1], C2 = buf[sp2];
      float2 E{0.5f * (C1.x + C2.x), 0.5f * (C1.y - C2.y)}, D{0.5f * (C1.x - C2.x), 0.5f * (C1.y + C2.y)};
      float2 O{D.y, -D.x};
      const float f = (float)k * (1.f / (float)(2 * Lc));
      const float wc = __builtin_amdgcn_cosf(f), wsn = -__builtin_amdgcn_sinf(f);
      float2 wO{wc * O.x - wsn * O.y, wc * O.y + wsn * O.x};
      GP[j] = float4{(E.x + wO.x) * scale, (E.y + wO.y) * scale, (E.x - wO.x) * scale, -(E.y - wO.y) * scale};
    }
  }
}
template <int LOGN>
__device__ void spectrum_mul(float2* buf, const float4* __restrict__ GP) {
  constexpr int Lc = 1 << LOGN;
  for (int j = tidx(); j < Lc / 2; j += NT) {
    const float4 gp = GP[j];
    if (j == 0) {
      const float2 c = buf[0], ch = buf[1];
      const float Y0 = (c.x + c.y) * gp.x, YL = (c.x - c.y) * gp.y;
      buf[0] = float2{0.5f * (Y0 + YL), 0.5f * (Y0 - YL)};
      buf[1] = float2{ch.x * gp.z + ch.y * gp.w, ch.y * gp.z - ch.x * gp.w};
    } else {
      const int pos = 2 * j;
      const int k = (int)(__brev((unsigned)pos) >> (32 - LOGN));
      const int p2 = pos ^ ((1 << (31 - __clz(pos))) - 1);
      const int sp1 = swz(pos), sp2 = swz(p2);
      float2 C1 = buf[sp1], C2 = buf[sp2];
      float2 E{0.5f * (C1.x + C2.x), 0.5f * (C1.y - C2.y)}, D{0.5f * (C1.x - C2.x), 0.5f * (C1.y + C2.y)};
      float2 O{D.y, -D.x};
      const float f = (float)k * (1.f / (float)(2 * Lc));
      const float wc = __builtin_amdgcn_cosf(f), wsn = -__builtin_amdgcn_sinf(f);
      float2 wO{wc * O.x - wsn * O.y, wc * O.y + wsn * O.x};
      float2 X1{E.x + wO.x, E.y + wO.y}, X2{E.x - wO.x, -(E.y - wO.y)};
      float2 Y1{X1.x * gp.x - X1.y * gp.y, X1.x * gp.y + X1.y * gp.x};
      float2 Y2{X2.x * gp.z - X2.y * gp.w, X2.x * gp.w + X2.y * gp.z};
      float2 Ye{0.5f * (Y1.x + Y2.x), 0.5f * (Y1.y - Y2.y)};
      float2 Dd{0.5f * (Y1.x - Y2.x), 0.5f * (Y1.y + Y2.y)};
      float2 Yo{wc * Dd.x + wsn * Dd.y, wc * Dd.y - wsn * Dd.x};
      buf[sp1] = float2{Ye.x - Yo.y, Ye.y + Yo.x};
      buf[sp2] = float2{Ye.x + Yo.y, -Ye.y + Yo.x};
    }
  }
}

template <int LOGN>
__device__ void hy_conv_item(const Params& p, int i, int c, unsigned char* lds, bool dry) {
  constexpr int Lc = 1 << LOGN;
  constexpr int L = Lc;
  constexpr int NB = (LOGN == 14) ? 2 : 4;
  const int tid = tidx();
  float2* buf = (float2*)lds;
  float* bufF = (float*)lds;
  float* W3s = (float*)(lds + 131072);
  float* red = W3s + 256;
  float4* GS = (float4*)(p.ws + OFF_GS + (size_t)bidx() * 2 * GS_PER);
  float4* GS1 = GS + GS_PER / 16;
  float* G1tmp = (float*)GS1;
  float* Z1 = (float*)(p.ws + OFF_Z1 + (size_t)bidx() * 65536);
  const float* H2 = (const float*)(p.ws + OFF_H2) + (LOGN == 14 ? (size_t)4096 * 64 : 0);
  const ushort_t* PH = (const ushort_t*)(p.ws + OFF_PH);
  const float delta = 4.605170185988091f * (1.f / 1.5f + (1.f / 0.3f - 1.f / 1.5f) * (float)c / 1023.f);
  __syncthreads();
  if (tid < 256) {
    const int j = tid >> 2, col = tid & 3, o = col >> 1, dirr = col & 1;
    W3s[tid] = p.in[I_FW3][((size_t)i * 64 + j) * 4096 + (dirr * 2 + o) * 1024 + c];
  }
  __syncthreads();
  float ss0 = 0.f, ss1 = 0.f;
  for (int t0 = tid * 4; t0 < L; t0 += NT * 4) {
    float acc[4][4];
#pragma unroll
    for (int r = 0; r < 4; ++r)
#pragma unroll
      for (int cc = 0; cc < 4; ++cc) acc[r][cc] = 0.f;
#pragma unroll 1
    for (int jb = 0; jb < 64; jb += 16) {
      float4 hv[16];
#pragma unroll
      for (int jj = 0; jj < 16; ++jj) hv[jj] = *(const float4*)(H2 + (size_t)(jb + jj) * L + t0);
#pragma unroll
      for (int jj = 0; jj < 16; ++jj) {
        const float4 w = *(const float4*)(W3s + 4 * (jb + jj));
        acc[0][0] += hv[jj].x * w.x; acc[0][1] += hv[jj].x * w.y; acc[0][2] += hv[jj].x * w.z; acc[0][3] += hv[jj].x * w.w;
        acc[1][0] += hv[jj].y * w.x; acc[1][1] += hv[jj].y * w.y; acc[1][2] += hv[jj].y * w.z; acc[1][3] += hv[jj].y * w.w;
        acc[2][0] += hv[jj].z * w.x; acc[2][1] += hv[jj].z * w.y; acc[2][2] += hv[jj].z * w.z; acc[2][3] += hv[jj].z * w.w;
        acc[3][0] += hv[jj].w * w.x; acc[3][1] += hv[jj].w * w.y; acc[3][2] += hv[jj].w * w.z; acc[3][3] += hv[jj].w * w.w;
      }
    }
#pragma unroll
    for (int r = 0; r < 4; ++r) {
      const int t = t0 + r;
      const float dec = expf(-((float)t * (1.f / (float)(L - 1))) * delta);
      const float d0 = acc[r][0] * dec, d1 = acc[r][1] * dec, d2 = acc[r][2] * dec, d3 = acc[r][3] * dec;
      ss0 += d0 * d0 + d1 * d1;
      ss1 += d2 * d2 + d3 * d3;
      bufF[swzF(t)] = d0; G1tmp[t] = d2;
      if (t >= 1) { bufF[swzF(2 * L - t)] = d1; G1tmp[2 * L - t] = d3; } else { bufF[swzF(L)] = 0.f; G1tmp[L] = 0.f; }
    }
  }
  ss0 = wsum(ss0); ss1 = wsum(ss1);
  if ((tid & 63) == 0) { red[tid >> 6] = ss0; red[8 + (tid >> 6)] = ss1; }
  __syncthreads();
  float tot0 = 0.f, tot1 = 0.f;
#pragma unroll
  for (int w = 0; w < 8; ++w) { tot0 += red[w]; tot1 += red[8 + w]; }
  fft_dif<LOGN>(buf);
  spectrum_extract<LOGN>(buf, GS, rsqrtf(tot0) * (1.f / (float)Lc));
  __syncthreads();
  for (int t = tid; t < L; t += NT) buf[swz(t)] = ((const float2*)G1tmp)[t];
  __syncthreads();
  fft_dif<LOGN>(buf);
  spectrum_extract<LOGN>(buf, GS1, rsqrtf(tot1) * (1.f / (float)Lc));
  __threadfence_block();
  __syncthreads();
  const float* sw = p.in[I_HSW] + (size_t)i * 3 * 3072;
  const float* sbias = p.in[I_HSB] + (size_t)i * 3072;
  float cw[3][3], cb[3];
#pragma unroll
  for (int st = 0; st < 3; ++st) {
#pragma unroll
    for (int k = 0; k < 3; ++k) cw[st][k] = sw[k * 3072 + st * 1024 + c];
    cb[st] = sbias[st * 1024 + c];
  }
  const float fb0 = p.in[I_FBIAS][((size_t)i * 2 + 0) * 1024 + c], fb1 = p.in[I_FBIAS][((size_t)i * 2 + 1) * 1024 + c];
  for (int b = 0; b < NB; ++b) {
    const int s0 = (LOGN == 14) ? (TPROMPT + b * 16384) : (b * 4096);
    const ushort_t* pv = PH + (size_t)s0 * 1024 + (size_t)c * L;
    const ushort_t* px1 = pv + (size_t)T * 1024;
    const ushort_t* px2 = px1 + (size_t)T * 1024;
    ushort_t* pg = (ushort_t*)px2 + (size_t)T * 1024;
    auto conv8 = [&](const ushort_t* sp, int st, int t0, float* y) {
      const uint4 v = *(const uint4*)(sp + t0);
      const float xm = t0 > 0 ? bf2f(sp[t0 - 1]) : 0.f, xn = t0 + 8 < L ? bf2f(sp[t0 + 8]) : 0.f;
      const float x[10] = {xm, __uint_as_float(v.x << 16), __uint_as_float(v.x & 0xffff0000u), __uint_as_float(v.y << 16), __uint_as_float(v.y & 0xffff0000u),
                           __uint_as_float(v.z << 16), __uint_as_float(v.z & 0xffff0000u), __uint_as_float(v.w << 16), __uint_as_float(v.w & 0xffff0000u), xn};
#pragma unroll
      for (int j = 0; j < 8; ++j) y[j] = cw[st][0] * x[j] + cw[st][1] * x[j + 1] + cw[st][2] * x[j + 2] + cb[st];
    };
    __syncthreads();
    for (int t0 = tid * 8; t0 < L; t0 += NT * 8) {
      float y[8]; conv8(pv, 0, t0, y);
#pragma unroll
      for (int j = 0; j < 4; ++j) { buf[swz((t0 >> 1) + j)] = float2{y[2 * j], y[2 * j + 1]}; buf[swz(L / 2 + (t0 >> 1) + j)] = float2{0.f, 0.f}; }
    }
    __syncthreads();
    fft_dif<LOGN>(buf);
    spectrum_mul<LOGN>(buf, GS);
    __syncthreads();
    fft_dit_inv<LOGN>(buf);
    for (int t0 = tid * 8; t0 < L; t0 += NT * 8) {
      float z0[8], xa[8]; conv8(pv, 0, t0, z0); conv8(px1, 1, t0, xa);
      float z1[8];
#pragma unroll
      for (int j = 0; j < 4; ++j) {
        const int e = swz((t0 >> 1) + j);
        const float2 zc = buf[e];
        z1[2 * j] = xa[2 * j] * (zc.x + z0[2 * j] * fb0); z1[2 * j + 1] = xa[2 * j + 1] * (zc.y + z0[2 * j + 1] * fb0);
        buf[e] = float2{z1[2 * j], z1[2 * j + 1]};
        buf[swz(L / 2 + (t0 >> 1) + j)] = float2{0.f, 0.f};
      }
      *(float4*)(Z1 + t0) = float4{z1[0], z1[1], z1[2], z1[3]};
      *(float4*)(Z1 + t0 + 4) = float4{z1[4], z1[5], z1[6], z1[7]};
    }
    __syncthreads();
    fft_dif<LOGN>(buf);
    spectrum_mul<LOGN>(buf, GS1);
    __syncthreads();
    fft_dit_inv<LOGN>(buf);
    for (int t0 = tid * 8; t0 < L; t0 += NT * 8) {
      float xb[8]; conv8(px2, 2, t0, xb);
      const float4 za = *(const float4*)(Z1 + t0), zb = *(const float4*)(Z1 + t0 + 4);
      const float z1[8] = {za.x, za.y, za.z, za.w, zb.x, zb.y, zb.z, zb.w};
      const uint4 gv = *(const uint4*)(pg + t0);
      const unsigned gw[4] = {gv.x, gv.y, gv.z, gv.w};
      unsigned o[4];
#pragma unroll
      for (int j = 0; j < 4; ++j) {
        const float2 zc = buf[swz((t0 >> 1) + j)];
        const float g0 = __uint_as_float(gw[j] << 16), g1 = __uint_as_float(gw[j] & 0xffff0000u);
        const float y0 = xb[2 * j] * (zc.x + z1[2 * j] * fb1) * (g0 * fast_sigmoid(g0));
        const float y1 = xb[2 * j + 1] * (zc.y + z1[2 * j + 1] * fb1) * (g1 * fast_sigmoid(g1));
        o[j] = pack2(y0, y1);
      }
      if (!dry) *(uint4*)(pg + t0) = uint4{o[0], o[1], o[2], o[3]};
    }
  }
}

__device__ void hy_conv_phase(const Params& p, int i, unsigned char* lds, bool dry = false) {
  for (int it = bidx(); it < 2048; it += gridDim.x) {
    if (it < 1024) hy_conv_item<14>(p, i, it, lds, dry);
    else hy_conv_item<12>(p, i, it - 1024, lds, dry);
    __syncthreads();
  }
}

#ifndef PROBE_MASK
#define PROBE_MASK 0
#endif
#ifndef PH_MASK
#define PH_MASK 0x1ffff
#endif
#define PHM(n) ((PH_MASK >> (n)) & 1)
DEVI void run_phase(const Params& p, int ph, unsigned char* lds, bool dry = false) {
  const int layer = ph < NPH_EVEN ? 0 : ph < NPH_EVEN + NPH_ODD ? 1 : ph < 2 * NPH_EVEN + NPH_ODD ? 2 : 3;
  const int base = layer == 0 ? 0 : layer == 1 ? NPH_EVEN : layer == 2 ? NPH_EVEN + NPH_ODD : 2 * NPH_EVEN + NPH_ODD;
  const int sp = ph - base, i = layer >> 1;
  unsigned char* ws = p.ws;
  ushort_t* WB = (ushort_t*)(ws + OFF_WB);
  if ((layer & 1) == 0) {
    ushort_t* WinT = WB; ushort_t* WoutT = WB + 3328 * 1024; ushort_t* GluT = WoutT + 1024 * 1024;
    switch (sp) {
      case 0: if (PHM(0)) {
        transpose_bf16(p.in[I_EWIN] + (size_t)i * 1024 * 3136, WinT, 1024, 3136, lds);
        zero_fill(WinT + 3136 * 1024, 192 * 1024);
        transpose_bf16(p.in[I_EWOUT] + (size_t)i * 1024 * 1024, WoutT, 1024, 1024, lds);
        transpose_bf16(p.in[I_GLUW] + (size_t)i * 512 * 512, GluT, 512, 512, lds);
        if (layer == 0) xb_convert(p, (ushort_t*)(ws + OFF_Y));
        } break;
      case 1: if (PHM(1)) run_gemm(lds, (const ushort_t*)(ws + OFF_Y), 1024, WinT, 3328, 1024, pg8::EpiEvenIn{(ushort_t*)(ws + OFF_PS5), (ushort_t*)(ws + OFF_PRW)}); break;
      case 2: if (PHM(2)) s5_passA(p, i, lds); break;
      case 3: if (PHM(3)) s5_passC(p, i, lds); break;
      case 4: if (PHM(4)) run_gemm(lds, (const ushort_t*)(ws + OFF_Y) + 512, 1024, GluT, 512, 512, pg8::EpiGlu{(ushort_t*)(ws + OFF_Y), (const ushort_t*)(ws + OFF_PS5), p.in[I_GLUB] + i * 512}); break;
      case 5: if (PHM(5)) rwkv_scan1(p, i, lds); break;
      case 6: if (PHM(6)) rwkv_carry(p, lds, dry); break;
      case 7: if (PHM(7)) rwkv_scan3(p, i, lds, dry); break;
      case 8: if (PHM(8)) rwkv_post(p, i); break;
      case 9: if (PHM(9)) run_gemm(lds, (const ushort_t*)(ws + OFF_Y), 1024, WoutT, 1024, 1024, pg8::EpiF32{(float*)(ws + OFF_PRW)}); break;
      case 10: if (PHM(10)) ln_phase(p, layer, (const float*)(ws + OFF_PRW), (ushort_t*)(ws + OFF_XB_ODD), dry); break;
    }
  } else {
    ushort_t* HinT = WB; ushort_t* HoutT = WB + 4096 * 1024;
    switch (sp) {
      case 0: if (PHM(11)) {
        transpose_bf16(p.in[I_HWIN] + (size_t)i * 1024 * 4096, HinT, 1024, 4096, lds);
        transpose_bf16(p.in[I_HWOUT] + (size_t)i * 1024 * 1024, HoutT, 1024, 1024, lds);
        hy_filter_mlp(p, i);
        } break;
      case 1: if (PHM(12)) run_gemm(lds, (const ushort_t*)(ws + OFF_XB_ODD), 1024, HinT, 4096, 1024, pg8::EpiHyIn{(ushort_t*)(ws + OFF_PH)}); break;
      case 2: if (PHM(13)) hy_conv_phase(p, i, lds, dry); break;
      case 3: if (PHM(14)) hy_transpose((const ushort_t*)(ws + OFF_PH + 3 * SZ1), (ushort_t*)(ws + OFF_PH), lds); break;
      case 4: if (PHM(15)) run_gemm(lds, (const ushort_t*)(ws + OFF_PH), 1024, HoutT, 1024, 1024, pg8::EpiF32{(float*)(ws + OFF_PH + SZ1)}); break;
      case 5: if (PHM(16)) ln_phase(p, layer, (const float*)(ws + OFF_PH + SZ1), layer < 3 ? (ushort_t*)(ws + OFF_Y) : (ushort_t*)nullptr, dry); break;
    }
  }
}

#define LAS __attribute__((address_space(3)))
#define XB_TMO      128
#define XB_XCNT(j)  (256  + 64 * (j))
#define XB_XSUB(j)  (1280 + 64 * (j))
#define XB_XGEN(j)  (2304 + 64 * (j))
#define XB_TOP      3328
#define XB_TOPGEN   3392
#define XCD_BAR_WORDS 3456
#define XB_SPIN_CAP (1u << 18)
#define LAS __attribute__((address_space(3)))

__device__ __forceinline__ unsigned xb_ld(unsigned* p)              { return __hip_atomic_load(p, __ATOMIC_RELAXED, __HIP_MEMORY_SCOPE_AGENT); }
__device__ __forceinline__ unsigned xb_add(unsigned* p, unsigned v) { return __hip_atomic_fetch_add(p, v, __ATOMIC_RELAXED, __HIP_MEMORY_SCOPE_AGENT); }
__device__ __forceinline__ unsigned xb_xcc_id() { return (unsigned)__builtin_amdgcn_s_getreg((3 << 11) | 20) & 0xFu; }
#define XB_SPIN(cond, bar) do { unsigned _sp = 0; while (cond) { __builtin_amdgcn_s_sleep(1); \
    if ((++_sp & 255u) == 0u) { if (xb_ld(&(bar)[XB_TMO])) break; if (_sp > XB_SPIN_CAP) { atomicAdd(&(bar)[XB_TMO], 1u); break; } } } } while (0)

struct XcdBarrier {
    unsigned* bar; unsigned x;
    volatile LAS unsigned* st;
};

__device__ __forceinline__ XcdBarrier xcd_barrier_post(unsigned* bar, volatile LAS unsigned* st) {
    XcdBarrier b; b.bar = bar; b.x = xb_xcc_id(); b.st = st;
    if (threadIdx.x == 0) (void)xb_add(&bar[XB_XCNT(b.x)], 1u);
    return b;
}
__device__ __forceinline__ void xcd_barrier_complete(unsigned* bar, unsigned x, unsigned& nloc, unsigned& nx) {
    const unsigned G = gridDim.x * gridDim.y * gridDim.z;
    unsigned sum, cnt, mine, sp = 0u;
    for (;;) {
        sum = 0u; cnt = 0u; mine = 0u;
#pragma unroll
        for (unsigned j = 0; j < 16; ++j) { const unsigned c = xb_ld(&bar[XB_XCNT(j)]); sum += c; cnt += (c > 0u) ? 1u : 0u; mine = (j == x) ? c : mine; }
        if (sum == G) break;
        __builtin_amdgcn_s_sleep(1);
        if ((++sp & 255u) == 0u) { if (xb_ld(&bar[XB_TMO])) break; if (sp > XB_SPIN_CAP) { atomicAdd(&bar[XB_TMO], 1u); break; } }
    }
    nloc = mine > 0u ? mine : 1u; nx = cnt > 0u ? cnt : 1u;
}

__device__ __forceinline__ void xcd_barrier(const XcdBarrier& b) {
    asm volatile("s_waitcnt vmcnt(0)" ::: "memory");
    __syncthreads();
    if (threadIdx.x == 0) {
        unsigned* bar = b.bar;
        __builtin_amdgcn_s_waitcnt(0);
        unsigned nloc = b.st[0], nx = b.st[1];
        if (nloc == 0u) { xcd_barrier_complete(bar, b.x, nloc, nx); b.st[0] = nloc; b.st[1] = nx; }
        const unsigned old = xb_add(&bar[XB_XSUB(b.x)], 1u);
        const unsigned gen = old / nloc;
        if (old + 1u == (gen + 1u) * nloc) {
            __builtin_amdgcn_fence(__ATOMIC_RELEASE, "agent");
            asm volatile("s_waitcnt vmcnt(0)" ::: "memory");
            const unsigned og = xb_add(&bar[XB_TOP], 1u);
            const unsigned tg = og / nx;
            if (og + 1u == (tg + 1u) * nx) xb_add(&bar[XB_TOPGEN], 1u);
            else XB_SPIN(xb_ld(&bar[XB_TOPGEN]) == tg, bar);
            __builtin_amdgcn_fence(__ATOMIC_ACQUIRE, "agent");
            xb_add(&bar[XB_XGEN(b.x)], 1u);
            asm volatile("s_waitcnt vmcnt(0)" ::: "memory");
        } else {
            XB_SPIN(xb_ld(&bar[XB_XGEN(b.x)]) == gen, bar);
            __builtin_amdgcn_fence(__ATOMIC_ACQUIRE, "agent");
            asm volatile("s_waitcnt vmcnt(0)" ::: "memory");
        }
    }
    __syncthreads();
}


#if ONE_LAUNCH
__global__ void __launch_bounds__(NT) fwd_kernel(Params p) {
  extern __shared__ __attribute__((aligned(16))) unsigned char lds[];
#if ONE_LAUNCH
  cg::grid_group grid = cg::this_grid();
#endif
#if ONE_LAUNCH
  volatile LAS unsigned* xb_st = (volatile LAS unsigned*)(lds + LDS_BYTES - 16);
  if (threadIdx.x < 2) xb_st[threadIdx.x] = 0u;
  __syncthreads();
  const XcdBarrier xb = xcd_barrier_post((unsigned*)(p.ws + OFF_BAR), xb_st);
#endif
  for (int ph = p.ph_lo; ph < p.ph_hi; ++ph) {
#if PROBE_MASK
    {
      const int lyr = ph < NPH_EVEN ? 0 : ph < NPH_EVEN + NPH_ODD ? 1 : ph < 2 * NPH_EVEN + NPH_ODD ? 2 : 3;
      const int bs = lyr == 0 ? 0 : lyr == 1 ? NPH_EVEN : lyr == 2 ? NPH_EVEN + NPH_ODD : 2 * NPH_EVEN + NPH_ODD;
      const int idx = (lyr & 1) ? NPH_EVEN + (ph - bs) : (ph - bs);
      if ((PROBE_MASK >> idx) & 1) { run_phase(p, ph, lds, true); grid.sync(); }
    }
#endif
    run_phase(p, ph, lds);
#if ONE_LAUNCH
    if (ph + 1 < p.ph_hi) { if (ph == p.ph_lo) grid.sync(); else xcd_barrier(xb); }
#endif
  }
}
#endif

#if !ONE_LAUNCH
template <int PH> __global__ void __launch_bounds__(NT) phase_kernel(Params p) {
  extern __shared__ __attribute__((aligned(16))) unsigned char lds[];
  run_phase(p, PH, lds);
}
typedef void (*kfn_t)(Params);
#define PK(n) phase_kernel<n>
static kfn_t k_tab[NPHASES] = {PK(0), PK(1), PK(2), PK(3), PK(4), PK(5), PK(6), PK(7), PK(8), PK(9), PK(10), PK(11), PK(12), PK(13), PK(14), PK(15),
                               PK(16), PK(17), PK(18), PK(19), PK(20), PK(21), PK(22), PK(23), PK(24), PK(25), PK(26), PK(27), PK(28), PK(29), PK(30), PK(31), PK(32), PK(33)};
#endif

extern "C" void kernel_launch(void* const* d_in, const int* in_sizes, int n_in, void* d_out, int out_size, void* d_ws, size_t ws_size,
                              hipStream_t stream) {
  static int grid_blocks = 0;
  if (!grid_blocks) {
    if (n_in != 38 || ws_size < WS_NEED || out_size != T * 1024) {
      fprintf(stderr, "kernel_launch: unexpected shapes n_in=%d ws=%zu out=%d\n", n_in, ws_size, out_size);
      grid_blocks = -1; return;
    }
    int dev = 0, cus = 0, per_cu = 0;
    (void)hipGetDevice(&dev);
    (void)hipDeviceGetAttribute(&cus, hipDeviceAttributeMultiprocessorCount, dev);
#if ONE_LAUNCH
    if (hipFuncSetAttribute((const void*)fwd_kernel, hipFuncAttributeMaxDynamicSharedMemorySize, LDS_BYTES) != hipSuccess) {
      fprintf(stderr, "kernel_launch: hipFuncSetAttribute failed\n"); grid_blocks = -1; return;
    }
    (void)hipOccupancyMaxActiveBlocksPerMultiprocessor(&per_cu, (const void*)fwd_kernel, NT, LDS_BYTES);
#else
    for (int ph = 0; ph < NPHASES; ++ph)
      if (hipFuncSetAttribute((const void*)k_tab[ph], hipFuncAttributeMaxDynamicSharedMemorySize, LDS_BYTES) != hipSuccess) {
        fprintf(stderr, "kernel_launch: hipFuncSetAttribute failed\n"); grid_blocks = -1; return;
      }
    per_cu = 1;
#endif
    if (per_cu < 1) { fprintf(stderr, "kernel_launch: occupancy query returned %d\n", per_cu); per_cu = 1; }
    grid_blocks = cus * per_cu;
    if (grid_blocks > 256) grid_blocks = 256;
    if (grid_blocks < 1) grid_blocks = 256;
  }
  if (grid_blocks < 0) return;
  Params p{};
  for (int k = 0; k < 38; ++k) p.in[k] = (const float*)d_in[k];
  p.out = (float*)d_out; p.ws = (unsigned char*)d_ws;
#if ONE_LAUNCH
  if (hipMemsetAsync((unsigned char*)d_ws + OFF_BAR, 0, 16384, stream) != hipSuccess) { fprintf(stderr, "kernel_launch: memset of barrier words failed\n"); return; }
  p.ph_lo = 0; p.ph_hi = NPHASES;
  void* args[] = {&p};
  hipError_t e = hipLaunchCooperativeKernel((const void*)fwd_kernel, dim3(grid_blocks), dim3(NT), args, LDS_BYTES, stream);
  if (e != hipSuccess) fprintf(stderr, "cooperative launch failed: %s (grid %d)\n", hipGetErrorString(e), grid_blocks);
#else
  for (int ph = 0; ph < NPHASES; ++ph) {
    p.ph_lo = ph; p.ph_hi = ph + 1;
    hipLaunchKernelGGL(k_tab[ph], dim3(grid_blocks), dim3(NT), LDS_BYTES, stream, p);
  }
#endif
}
```

```cpp
#include <hip/hip_runtime.h>
#include <hip/hip_cooperative_groups.h>
#include <cstdio>
#include <cstdint>
namespace cg = cooperative_groups;

#ifndef ONE_LAUNCH
#define ONE_LAUNCH 1
#endif

#define DEVI __device__ __forceinline__
constexpr int NT = 512;
constexpr int T = 49152;
constexpr int TPROMPT = 16384;
constexpr int LDS_BYTES = 133120;
constexpr int NPH_EVEN = 11, NPH_ODD = 6;
constexpr int NPHASES = 2 * (NPH_EVEN + NPH_ODD);

typedef __attribute__((ext_vector_type(8))) short bf16x8;
typedef __attribute__((ext_vector_type(4))) float f32x4;
typedef unsigned short ushort_t;
typedef float f32x2 __attribute__((ext_vector_type(2)));

struct Params { const float* in[38]; float* out; unsigned char* ws; int ph_lo; int ph_hi; };

enum { I_XP = 0, I_XS, I_EWIN, I_EWOUT, I_LRE, I_LIM, I_LSTEP, I_BRE, I_BIM, I_CRE, I_CIM, I_S5D, I_GLUW, I_GLUB,
       I_MURKV, I_MULORA, I_W0, I_WUP, I_A0, I_AUP, I_KK, I_KA, I_RK, I_LNXW, I_LNXB,
       I_HWIN, I_HWOUT, I_HSW, I_HSB, I_FW1, I_FB1, I_FFREQ, I_FW2, I_FB2, I_FW3, I_FBIAS, I_LNG, I_LNB };

constexpr size_t SZ1 = (size_t)T * 1024 * 2;
constexpr size_t OFF_PS5 = 0;
constexpr size_t OFF_PRW = OFF_PS5 + SZ1;
constexpr size_t OFF_Y = OFF_PRW + (size_t)T * 2112 * 2;
constexpr size_t OFF_YS = OFF_Y + SZ1;
constexpr size_t OFF_WB = OFF_YS + SZ1;
constexpr size_t OFF_CAR = OFF_WB + 10485760;
constexpr size_t OFF_BAR = OFF_CAR + 6291456;
constexpr size_t WS_NEED = OFF_BAR + 16384;
constexpr size_t OFF_PH = 0;
constexpr size_t OFF_GS = 4 * SZ1;
constexpr size_t GS_PER = 131328;
constexpr size_t OFF_Z1 = OFF_GS + 256 * 2 * GS_PER;
constexpr size_t OFF_XB_ODD = 4 * SZ1;
constexpr size_t OFF_H2 = OFF_XB_ODD + SZ1;

DEVI int tidx() { int t = threadIdx.x; asm volatile("" : "+v"(t)); return t; }
DEVI int bidx() { int b = blockIdx.x; asm volatile("" : "+s"(b)); return b; }
DEVI ushort_t f2bf(float f) { unsigned u = __float_as_uint(f); u += 0x7fffu + ((u >> 16) & 1u); return (ushort_t)(u >> 16); }
DEVI float bf2f(ushort_t h) { return __uint_as_float(((unsigned)h) << 16); }
DEVI unsigned pack2(float a, float b) { return (unsigned)f2bf(a) | ((unsigned)f2bf(b) << 16); }
DEVI float wsum(float v) {
#pragma unroll
  for (int m = 32; m >= 1; m >>= 1) v += __shfl_xor(v, m);
  return v;
}
DEVI void wave_sync() { __builtin_amdgcn_fence(__ATOMIC_RELEASE, "wavefront"); __builtin_amdgcn_wave_barrier(); __builtin_amdgcn_fence(__ATOMIC_ACQUIRE, "wavefront"); }
DEVI void seq_of(int tok, int& s0, int& L) {
  if (tok < TPROMPT) { s0 = tok & ~4095; L = 4096; } else { s0 = TPROMPT + ((tok - TPROMPT) & ~16383); L = 16384; }
}
struct XSrc { const float* xp; const float* xs; const float* xo; };
DEVI XSrc xsrc(const Params& p) {
  XSrc x; x.xp = p.in[I_XP]; x.xs = p.in[I_XS]; x.xo = p.out;
  asm volatile("" : "+s"(x.xp), "+s"(x.xs), "+s"(x.xo));
  return x;
}
DEVI const float* xrow(const XSrc& x, int layer, int tok) {
  if (layer == 0) return tok < TPROMPT ? x.xp + (size_t)tok * 1024 : x.xs + (size_t)(tok - TPROMPT) * 1024;
  return x.xo + (size_t)tok * 1024;
}
DEVI float sigmoidf_(float x) { return 1.f / (1.f + expf(-x)); }
DEVI float fast_sigmoid(float x) { return __builtin_amdgcn_rcpf(1.f + __builtin_amdgcn_exp2f(-1.4426950408889634f * x)); }
DEVI float fast_tanh(float x) { return 1.f - 2.f * __builtin_amdgcn_rcpf(1.f + __builtin_amdgcn_exp2f(2.8853900817779268f * x)); }
DEVI float dpp_mov_f(float x, const int sel) {
  int xi = __builtin_bit_cast(int, x), r;
  if (sel == 0) r = __builtin_amdgcn_mov_dpp(xi, 0xB1, 0xf, 0xf, true);
  else if (sel == 1) r = __builtin_amdgcn_mov_dpp(xi, 0x4E, 0xf, 0xf, true);
  else if (sel == 2) r = __builtin_amdgcn_mov_dpp(xi, 0x141, 0xf, 0xf, true);
  else r = __builtin_amdgcn_mov_dpp(xi, 0x140, 0xf, 0xf, true);
  return __builtin_bit_cast(float, r);
}
DEVI float wsum_fast(float v) {
  v += dpp_mov_f(v, 0); v += dpp_mov_f(v, 1); v += dpp_mov_f(v, 2); v += dpp_mov_f(v, 3);
  const int vi = __builtin_bit_cast(int, v);
  return __builtin_bit_cast(float, __builtin_amdgcn_readlane(vi, 0)) + __builtin_bit_cast(float, __builtin_amdgcn_readlane(vi, 16)) +
         __builtin_bit_cast(float, __builtin_amdgcn_readlane(vi, 32)) + __builtin_bit_cast(float, __builtin_amdgcn_readlane(vi, 48));
}
DEVI float gelu_tanh(float x) { return 0.5f * x * (1.f + tanhf(0.7978845608f * (x + 0.044715f * x * x * x))); }

__device__ void transpose_bf16(const float* __restrict__ in, ushort_t* __restrict__ out, int K, int N, unsigned char* lds) {
  float* tile = (float*)lds;
  const int tid = tidx(), j = tid & 63, i0 = tid >> 6;
  const int tk = K / 64, tn = N / 64;
  for (int t = bidx(); t < tk * tn; t += gridDim.x) {
    const int k0 = (t / tn) * 64, n0 = (t % tn) * 64;
#pragma unroll
    for (int e = 0; e < 8; ++e) { int i = i0 + 8 * e; tile[i * 65 + j] = in[(size_t)(k0 + i) * N + n0 + j]; }
    __syncthreads();
#pragma unroll
    for (int e = 0; e < 8; ++e) { int i = i0 + 8 * e; out[(size_t)(n0 + i) * K + k0 + j] = f2bf(tile[j * 65 + i]); }
    __syncthreads();
  }
}

namespace pg8 {
#define PG8_LAS __attribute__((address_space(3)))
typedef unsigned u32x4 __attribute__((ext_vector_type(4)));
constexpr int BM = 256, BK = 64, HALF = 128, HTB = HALF * BK * 2, STAGE_BYTES = 8 * HTB, NXCD = 8, WGM = 8;
DEVI int lds_byte(int r, int c) { const int st = (r >> 4) * 2 + (c >> 5), rr = r & 15, cc = c & 31, ob = rr * 64 + cc * 2; return st * 1024 + (ob ^ (((ob >> 9) & 1) << 5)); }
DEVI void stage_rc(int b, int& R, int& C) { const int st = b / 1024, sb = b % 1024, swz = sb ^ (((sb >> 9) & 1) << 5); R = (st >> 1) * 16 + swz / 64; C = (st & 1) * 32 + (swz % 64) / 2; }
DEVI int perm32(int rho) { const int n = rho >> 4, i = rho & 15; return 8 * (i >> 2) + 4 * n + (i & 3); }
struct Unit { int pm, pn; };
struct Gemm { const ushort_t* A; const ushort_t* Bt; int M, N, K, lda; };
struct StaticOrder {
  int nM, nN, nwg, G, c;
  DEVI void init(int M, int N, int G_, int c_) { nM = M / BM; nN = N / BM; nwg = nM * nN; G = G_; c = c_; }
  DEVI bool next(int i, Unit& u) const {
    const long L = (long)i * G + c; if (L >= nwg) return false;
    int wgid = (int)L; { const int q = nwg / NXCD, r = nwg % NXCD, xcd = wgid % NXCD, off = wgid / NXCD; wgid = (xcd < r ? xcd * (q + 1) : r * (q + 1) + (xcd - r) * q) + off; }
    const int nig = WGM * nN, gid = wgid / nig, fm = gid * WGM, gsz = (nM - fm) < WGM ? (nM - fm) : WGM;
    u.pm = fm + ((wgid % nig) % gsz); u.pn = (wgid % nig) / gsz; return true;
  }
};
DEVI unsigned cvt_pk_bf16(float lo, float hi) { unsigned r; asm volatile("v_cvt_pk_bf16_f32 %0, %1, %2" : "=v"(r) : "v"(lo), "v"(hi)); return r; }

template <class Epi>
DEVI void gemm_phase(PG8_LAS unsigned char* lds, const Gemm g, const StaticOrder& S, const Epi& E) {
  const int tid = tidx(), wid = __builtin_amdgcn_readfirstlane(tid >> 6), lane = tid & 63, wr = wid >> 2, wc = wid & 3, fr = lane & 15, fq = lane >> 4;
  const int K = g.K, nt = K / BK, lda = g.lda;
  unsigned voffA[2], voffB[2];
#pragma unroll
  for (int i = 0; i < 2; ++i) { int R, C; stage_rc(tid * 16 + i * 8192, R, C); const int Rb = Epi::PERM ? ((R & ~31) + perm32(R & 31)) : R;
    voffA[i] = (unsigned)(R * lda + C) * 2u; voffB[i] = (unsigned)(Rb * K + C) * 2u; }
  const size_t kstep = (size_t)(BK * 2);
  const size_t hstepA = (size_t)HALF * lda * 2, hstepB = (size_t)HALF * K * 2;
  const size_t tstepA = 2 * hstepA, tstepB = 2 * hstepB;
  const unsigned ldsw = (unsigned)wid * 1024u;
  const int aoff = lds_byte(wr * 64 + fr, fq * 8), boff = lds_byte(wc * 32 + fr, fq * 8);
#define PG8_SA(b, h) (((b) * 2 + (h)) * HTB)
#define PG8_SB(b, h) ((4 + (b) * 2 + (h)) * HTB)
#define PG8_STAGE(bufoff, gbase, voff) do { _Pragma("unroll") for (int _i = 0; _i < 2; ++_i) \
    __builtin_amdgcn_global_load_lds((const unsigned*)((const char*)(gbase) + (voff)[_i]), (PG8_LAS unsigned*)(lds + (bufoff) + ldsw + _i * 8192), 16, 0, 0); } while (0)
#define PG8_LDA(dst, b, h) do { _Pragma("unroll") for (int m = 0; m < 4; ++m) _Pragma("unroll") for (int k = 0; k < 2; ++k) dst[m][k] = *(const PG8_LAS bf16x8*)(lds + PG8_SA(b, h) + aoff + m * 2048 + k * 1024); } while (0)
#define PG8_LDB(dst, b, h) do { _Pragma("unroll") for (int n = 0; n < 2; ++n) _Pragma("unroll") for (int k = 0; k < 2; ++k) dst[n][k] = *(const PG8_LAS bf16x8*)(lds + PG8_SB(b, h) + boff + n * 2048 + k * 1024); } while (0)
#define PG8_MMA(ai, bj, At, Bt) do { __builtin_amdgcn_s_setprio(1); _Pragma("unroll") for (int m = 0; m < 4; ++m) _Pragma("unroll") for (int n = 0; n < 2; ++n) _Pragma("unroll") for (int k = 0; k < 2; ++k) \
    acc[ai][bj][m][n] = Epi::TRANS ? __builtin_amdgcn_mfma_f32_16x16x32_bf16(Bt[n][k], At[m][k], acc[ai][bj][m][n], 0, 0, 0) \
                                   : __builtin_amdgcn_mfma_f32_16x16x32_bf16(At[m][k], Bt[n][k], acc[ai][bj][m][n], 0, 0, 0); __builtin_amdgcn_s_setprio(0); } while (0)
#define PG8_WAIT_V(n) asm volatile("s_waitcnt vmcnt(" #n ")" ::: "memory")
#define PG8_WAIT_L(n) asm volatile("s_waitcnt lgkmcnt(" #n ")" ::: "memory")
#define PG8_BAR __builtin_amdgcn_s_barrier()
#define PG8_SCHED __builtin_amdgcn_sched_barrier(0)
  Unit cur, nxt; int ui = 0;
  if (!S.next(0, cur)) return;
  f32x4 acc[2][2][4][2];
#pragma unroll
  for (int a = 0; a < 2; ++a)
#pragma unroll
    for (int b = 0; b < 2; ++b)
#pragma unroll
      for (int m = 0; m < 4; ++m)
#pragma unroll
        for (int n = 0; n < 2; ++n) acc[a][b][m][n] = (f32x4){0.f, 0.f, 0.f, 0.f};
  bf16x8 At[4][2], B0[2][2], B1[2][2];
  const char* cA = (const char*)g.A + (size_t)cur.pm * tstepA; const char* cB = (const char*)g.Bt + (size_t)cur.pn * tstepB;
  PG8_STAGE(PG8_SB(0, 0), cB, voffB); PG8_STAGE(PG8_SA(0, 0), cA, voffA); PG8_STAGE(PG8_SB(0, 1), cB + hstepB, voffB); PG8_STAGE(PG8_SA(0, 1), cA + hstepA, voffA);
  if (wr == 1) PG8_BAR;
  PG8_WAIT_V(4); PG8_BAR;
  PG8_STAGE(PG8_SB(1, 0), cB + kstep, voffB); PG8_STAGE(PG8_SA(1, 0), cA + kstep, voffA); PG8_STAGE(PG8_SB(1, 1), cB + hstepB + kstep, voffB);
  PG8_WAIT_V(6); PG8_BAR;
  for (;;) {
    const bool has_next = S.next(ui + 1, nxt);
    const char* nA = has_next ? (const char*)g.A + (size_t)nxt.pm * tstepA : cA; const char* nB = has_next ? (const char*)g.Bt + (size_t)nxt.pn * tstepB : cB;
    for (int t = 0; t < nt; t += 2) {
      const bool last = (t == nt - 2);
      const char* a1 = cA + (size_t)(t + 1) * kstep;
      const char* a2 = last ? nA : cA + (size_t)(t + 2) * kstep; const char* b2 = last ? nB : cB + (size_t)(t + 2) * kstep;
      const char* a3 = a2 + kstep; const char* b3 = b2 + kstep;
      PG8_LDB(B0, 0, 0); PG8_SCHED; PG8_LDA(At, 0, 0); PG8_STAGE(PG8_SA(1, 1), a1 + hstepA, voffA);
      PG8_WAIT_L(8); PG8_BAR; PG8_WAIT_L(0); PG8_MMA(0, 0, At, B0); PG8_BAR; PG8_SCHED;
      PG8_LDB(B1, 0, 1); PG8_STAGE(PG8_SB(0, 0), b2, voffB);
      PG8_BAR; PG8_WAIT_L(0); PG8_MMA(0, 1, At, B1); PG8_BAR;
      PG8_LDA(At, 0, 1); PG8_STAGE(PG8_SA(0, 0), a2, voffA);
      PG8_BAR; PG8_WAIT_L(0); PG8_MMA(1, 0, At, B0); PG8_BAR; PG8_SCHED;
      PG8_STAGE(PG8_SB(0, 1), b2 + hstepB, voffB);
      PG8_WAIT_V(6); PG8_BAR; PG8_MMA(1, 1, At, B1); PG8_BAR;
      PG8_LDB(B0, 1, 0); PG8_SCHED; PG8_LDA(At, 1, 0); PG8_STAGE(PG8_SA(0, 1), a2 + hstepA, voffA);
      PG8_WAIT_L(8); PG8_BAR; PG8_WAIT_L(0); PG8_MMA(0, 0, At, B0); PG8_BAR; PG8_SCHED;
      PG8_LDB(B1, 1, 1); PG8_STAGE(PG8_SB(1, 0), b3, voffB);
      PG8_BAR; PG8_WAIT_L(0); PG8_MMA(0, 1, At, B1); PG8_BAR;
      PG8_LDA(At, 1, 1); PG8_STAGE(PG8_SA(1, 0), a3, voffA);
      PG8_BAR; PG8_WAIT_L(0); PG8_MMA(1, 0, At, B0); PG8_BAR; PG8_SCHED;
      PG8_STAGE(PG8_SB(1, 1), b3 + hstepB, voffB);
      PG8_WAIT_V(6); PG8_BAR; PG8_MMA(1, 1, At, B1); PG8_BAR;
    }
    E(acc, cur, wr, wc, fr, fq);
    if (!has_next) break;
#pragma unroll
    for (int a = 0; a < 2; ++a)
#pragma unroll
      for (int b = 0; b < 2; ++b)
#pragma unroll
        for (int m = 0; m < 4; ++m)
#pragma unroll
          for (int n = 0; n < 2; ++n) acc[a][b][m][n] = (f32x4){0.f, 0.f, 0.f, 0.f};
    cur = nxt; cA = nA; cB = nB; ++ui;
  }
  PG8_WAIT_V(0);
  if (wr == 0) PG8_BAR;
  PG8_BAR;
#undef PG8_SA
#undef PG8_SB
#undef PG8_STAGE
#undef PG8_LDA
#undef PG8_LDB
#undef PG8_MMA
#undef PG8_WAIT_V
#undef PG8_WAIT_L
#undef PG8_BAR
#undef PG8_SCHED
}

struct EpiEvenIn {
  static constexpr bool PERM = true, TRANS = true;
  ushort_t* ps5; ushort_t* prw;
  DEVI void operator()(const f32x4 (&acc)[2][2][4][2], const Unit& u, int wr, int wc, int fr, int fq) const {
#pragma unroll
    for (int ai = 0; ai < 2; ++ai)
#pragma unroll
      for (int m = 0; m < 4; ++m) {
        const size_t row = (size_t)u.pm * BM + ai * HALF + wr * 64 + m * 16 + fr;
#pragma unroll
        for (int bj = 0; bj < 2; ++bj) {
          const int c0 = u.pn * BM + bj * HALF + wc * 32 + 8 * fq;
          const f32x4 v0 = acc[ai][bj][m][0], v1 = acc[ai][bj][m][1];
          u32x4 o = {cvt_pk_bf16(v0[0], v0[1]), cvt_pk_bf16(v0[2], v0[3]), cvt_pk_bf16(v1[0], v1[1]), cvt_pk_bf16(v1[2], v1[3])};
          if (c0 < 1024) *(u32x4*)(ps5 + row * 1024 + c0) = o;
          else if (c0 < 3136) *(u32x4*)(prw + row * 2112 + (c0 - 1024)) = o;
        }
      }
  }
};
struct EpiHyIn {
  static constexpr bool PERM = false, TRANS = false;
  ushort_t* ph;
  DEVI void operator()(const f32x4 (&acc)[2][2][4][2], const Unit& u, int wr, int wc, int fr, int fq) const {
    int s0, L; seq_of(u.pm * BM, s0, L);
#pragma unroll
    for (int ai = 0; ai < 2; ++ai)
#pragma unroll
      for (int m = 0; m < 4; ++m) {
        const int tok = u.pm * BM + ai * HALF + wr * 64 + m * 16 + 4 * fq;
#pragma unroll
        for (int bj = 0; bj < 2; ++bj)
#pragma unroll
          for (int n = 0; n < 2; ++n) {
            const int col = u.pn * BM + bj * HALF + wc * 32 + 16 * n + fr;
            const int st = col >> 10, c = col & 1023;
            const f32x4 v = acc[ai][bj][m][n];
            ushort_t* dst = ph + (size_t)st * T * 1024 + (size_t)s0 * 1024 + (size_t)c * L + (tok - s0);
            *(uint2*)dst = uint2{cvt_pk_bf16(v[0], v[1]), cvt_pk_bf16(v[2], v[3])};
          }
      }
  }
};
struct EpiGlu {
  static constexpr bool PERM = true, TRANS = true;
  ushort_t* y; const ushort_t* ps5; const float* bias;
  DEVI void operator()(const f32x4 (&acc)[2][2][4][2], const Unit& u, int wr, int wc, int fr, int fq) const {
#pragma unroll
    for (int ai = 0; ai < 2; ++ai)
#pragma unroll
      for (int m = 0; m < 4; ++m) {
        const size_t row = (size_t)u.pm * BM + ai * HALF + wr * 64 + m * 16 + fr;
#pragma unroll
        for (int bj = 0; bj < 2; ++bj) {
          const int c0 = u.pn * BM + bj * HALF + wc * 32 + 8 * fq;
          const u32x4 a8 = *(const u32x4*)(y + row * 1024 + 512 + c0);
          const u32x4 g8 = *(const u32x4*)(ps5 + row * 1024 + 512 + c0);
          const f32x4 b0 = *(const f32x4*)(bias + c0), b1 = *(const f32x4*)(bias + c0 + 4);
          float v[8];
#pragma unroll
          for (int e = 0; e < 4; ++e) { v[e] = acc[ai][bj][m][0][e] + b0[e]; v[4 + e] = acc[ai][bj][m][1][e] + b1[e]; }
          unsigned o[4];
#pragma unroll
          for (int e = 0; e < 4; ++e) {
            const float a_lo = __uint_as_float(a8[e] << 16), a_hi = __uint_as_float(a8[e] & 0xffff0000u);
            const float g_lo = __uint_as_float(g8[e] << 16), g_hi = __uint_as_float(g8[e] & 0xffff0000u);
            const float r_lo = a_lo * sigmoidf_(v[2 * e]) * (g_lo * sigmoidf_(g_lo));
            const float r_hi = a_hi * sigmoidf_(v[2 * e + 1]) * (g_hi * sigmoidf_(g_hi));
            o[e] = cvt_pk_bf16(r_lo, r_hi);
          }
          *(u32x4*)(y + row * 1024 + c0) = u32x4{o[0], o[1], o[2], o[3]};
        }
      }
  }
};
struct EpiF32 {
  static constexpr bool PERM = false, TRANS = true;
  float* C;
  DEVI void operator()(const f32x4 (&acc)[2][2][4][2], const Unit& u, int wr, int wc, int fr, int fq) const {
#pragma unroll
    for (int ai = 0; ai < 2; ++ai)
#pragma unroll
      for (int m = 0; m < 4; ++m) {
        float* rowp = C + ((size_t)u.pm * BM + ai * HALF + wr * 64 + m * 16 + fr) * 1024 + u.pn * BM + wc * 32 + 4 * fq;
#pragma unroll
        for (int bj = 0; bj < 2; ++bj)
#pragma unroll
          for (int n = 0; n < 2; ++n) *(f32x4*)(rowp + bj * HALF + n * 16) = acc[ai][bj][m][n];
      }
  }
};
}

template <class Epi>
DEVI void run_gemm(unsigned char* lds, const ushort_t* A, int lda, const ushort_t* Bt, int N, int K, const Epi& E) {
  pg8::Gemm g; g.A = A; g.Bt = Bt; g.M = T; g.N = N; g.K = K; g.lda = lda;
  pg8::StaticOrder S; S.init(T, N, (int)gridDim.x, bidx());
  __syncthreads();
  pg8::gemm_phase<Epi>((PG8_LAS unsigned char*)lds, g, S, E);
  __syncthreads();
}

__device__ void xb_convert(const Params& p, ushort_t* XB) {
  const size_t n4 = (size_t)T * 1024 / 4, np4 = (size_t)TPROMPT * 1024 / 4;
  const float4* xp = (const float4*)p.in[I_XP]; const float4* xs = (const float4*)p.in[I_XS];
  for (size_t e = (size_t)bidx() * NT + tidx(); e < n4; e += (size_t)gridDim.x * NT) {
    const float4 v = e < np4 ? xp[e] : xs[e - np4];
    ((uint2*)XB)[e] = uint2{pack2(v.x, v.y), pack2(v.z, v.w)};
  }
}
__device__ void zero_fill(ushort_t* dst, size_t n) {
  for (size_t e = (size_t)bidx() * NT + tidx(); e < n / 8; e += (size_t)gridDim.x * NT) ((uint4*)dst)[e] = uint4{0, 0, 0, 0};
}
__device__ void hy_transpose(const ushort_t* __restrict__ PH3, ushort_t* __restrict__ Y, unsigned char* lds) {
  ushort_t* tile = (ushort_t*)lds;
  const int tid = tidx(), r = tid >> 3, c8 = (tid & 7) * 8;
  for (int t = bidx(); t < (T / 64) * 16; t += gridDim.x) {
    const int tok0 = (t >> 4) * 64, c0 = (t & 15) * 64;
    int s0, L; seq_of(tok0, s0, L);
    const uint4 v = *(const uint4*)(PH3 + (size_t)s0 * 1024 + (size_t)(c0 + r) * L + (tok0 - s0) + c8);
    __syncthreads();
    *(uint4*)(tile + r * 72 + c8) = v;
    __syncthreads();
    unsigned o[4];
#pragma unroll
    for (int e = 0; e < 4; ++e) o[e] = (unsigned)tile[(c8 + 2 * e) * 72 + r] | ((unsigned)tile[(c8 + 2 * e + 1) * 72 + r] << 16);
    *(uint4*)(Y + (size_t)(tok0 + r) * 1024 + c0 + c8) = uint4{o[0], o[1], o[2], o[3]};
  }
}

__device__ void ln_phase(const Params& p, int layer, const float* __restrict__ F, ushort_t* __restrict__ XB, bool dry = false) {
  const int lane = tidx() & 63, gw = bidx() * (NT / 64) + (tidx() >> 6), nw = gridDim.x * (NT / 64);
  const float alpha = 1.681792830507429f;
  const float4* g4 = (const float4*)(p.in[I_LNG] + layer * 1024);
  const float4* b4 = (const float4*)(p.in[I_LNB] + layer * 1024);
  const XSrc xs_ = xsrc(p);
  for (int row0 = gw; row0 < T / 2; row0 += nw) {
    float4 v[2][4];
#pragma unroll
    for (int h = 0; h < 2; ++h) {
      const int row = row0 + h * (T / 2);
      const float4* x4 = (const float4*)xrow(xs_, layer, row);
      const float4* f4 = (const float4*)(F + (size_t)row * 1024);
#pragma unroll
      for (int e = 0; e < 4; ++e) {
        const float4 a = x4[lane + 64 * e], f = f4[lane + 64 * e];
        v[h][e] = float4{alpha * a.x + f.x, alpha * a.y + f.y, alpha * a.z + f.z, alpha * a.w + f.w};
      }
    }
#pragma unroll
    for (int h = 0; h < 2; ++h) {
      const int row = row0 + h * (T / 2);
      float s = 0.f;
#pragma unroll
      for (int e = 0; e < 4; ++e) s += v[h][e].x + v[h][e].y + v[h][e].z + v[h][e].w;
      const float mean = wsum_fast(s) * (1.f / 1024.f);
      float q = 0.f;
#pragma unroll
      for (int e = 0; e < 4; ++e) {
        v[h][e].x -= mean; v[h][e].y -= mean; v[h][e].z -= mean; v[h][e].w -= mean;
        q += v[h][e].x * v[h][e].x + v[h][e].y * v[h][e].y + v[h][e].z * v[h][e].z + v[h][e].w * v[h][e].w;
      }
      const float rs = rsqrtf(wsum_fast(q) * (1.f / 1024.f) + 1e-5f);
      float4* o4 = (float4*)(p.out + (size_t)row * 1024);
#pragma unroll
      for (int e = 0; e < 4; ++e) {
        const float4 g = g4[lane + 64 * e], b = b4[lane + 64 * e];
        const float4 o = float4{v[h][e].x * rs * g.x + b.x, v[h][e].y * rs * g.y + b.y, v[h][e].z * rs * g.z + b.z, v[h][e].w * rs * g.w + b.w};
        if (!dry) o4[lane + 64 * e] = o;
        if (XB) ((uint2*)(XB + (size_t)row * 1024))[lane + 64 * e] = uint2{pack2(o.x, o.y), pack2(o.z, o.w)};
      }
    }
  }
}

struct cplx { float x, y; };
DEVI cplx cmul(cplx a, cplx b) { return cplx{a.x * b.x - a.y * b.y, a.x * b.y + a.y * b.x}; }
DEVI void s5_consts(const Params& p, int i, int d, int g, int n, cplx& lb, cplx& coef) {
  const int idx = ((i * 2 + d) * 32 + g) * 64 + n;
  const float lre = p.in[I_LRE][idx], lim = p.in[I_LIM][idx];
  const float dt = expf(p.in[I_LSTEP][(i * 2 + d) * 32 + g]);
  const float mag = expf(lre * dt);
  float sn, cs; sincosf(lim * dt, &sn, &cs);
  lb = cplx{mag * cs, mag * sn};
  const float nr = lb.x - 1.f, ni = lb.y, den = 1.f / (lre * lre + lim * lim);
  coef = cplx{(nr * lre + ni * lim) * den, (ni * lre - nr * lim) * den};
}
DEVI void s5_load_u(const ushort_t* PS5, int tok0, int g, int lane, uint4& a, uint4& b) {
  const uint4* src = (const uint4*)(PS5 + (size_t)(tok0 + lane) * 1024 + g * 16);
  a = src[0]; b = src[1];
}
DEVI void s5_store_u(float* U, int lane, const uint4& a, const uint4& b) {
  float4* d = (float4*)(U + lane * 16);
  d[0] = float4{__uint_as_float(a.x << 16), __uint_as_float(a.x & 0xffff0000u), __uint_as_float(a.y << 16), __uint_as_float(a.y & 0xffff0000u)};
  d[1] = float4{__uint_as_float(a.z << 16), __uint_as_float(a.z & 0xffff0000u), __uint_as_float(a.w << 16), __uint_as_float(a.w & 0xffff0000u)};
  d[2] = float4{__uint_as_float(b.x << 16), __uint_as_float(b.x & 0xffff0000u), __uint_as_float(b.y << 16), __uint_as_float(b.y & 0xffff0000u)};
  d[3] = float4{__uint_as_float(b.z << 16), __uint_as_float(b.z & 0xffff0000u), __uint_as_float(b.w << 16), __uint_as_float(b.w & 0xffff0000u)};
}
#define S5_BU(Urow, bur, bui)                                                         \
  {                                                                                   \
    const float4* u4 = (const float4*)(Urow);                                         \
    bur = 0.f; bui = 0.f;                                                             \
    _Pragma("unroll") for (int pp = 0; pp < 4; ++pp) {                                \
      float4 u = u4[pp];                                                              \
      bur += Br[4 * pp] * u.x + Br[4 * pp + 1] * u.y + Br[4 * pp + 2] * u.z + Br[4 * pp + 3] * u.w; \
      bui += Bi[4 * pp] * u.x + Bi[4 * pp + 1] * u.y + Bi[4 * pp + 2] * u.z + Bi[4 * pp + 3] * u.w; \
    }                                                                                 \
  }

__device__ void s5_passA(const Params& p, int i, unsigned char* lds) {
  const ushort_t* PS5 = (const ushort_t*)(p.ws + OFF_PS5);
  cplx* CAR = (cplx*)(p.ws + OFF_CAR);
  const int lane = tidx() & 63, wave = tidx() >> 6;
  float* U = (float*)(lds + wave * 8448);
  for (int item = bidx() * 8 + wave; item < 192 * 32; item += gridDim.x * 8) {
    const int q = item >> 5, g = item & 31;
    cplx lb0, c0, lb1, c1;
    s5_consts(p, i, 0, g, lane, lb0, c0);
    s5_consts(p, i, 1, g, lane, lb1, c1);
    float Br[16], Bi[16];
#pragma unroll
    for (int pp = 0; pp < 16; ++pp) { Br[pp] = p.in[I_BRE][((i * 32 + g) * 64 + lane) * 16 + pp]; Bi[pp] = p.in[I_BIM][((i * 32 + g) * 64 + lane) * 16 + pp]; }
    cplx xf{0.f, 0.f}, xb{0.f, 0.f}, pw{1.f, 0.f};
    uint4 ua, ub;
    s5_load_u(PS5, q * 256, g, lane, ua, ub);
    for (int sb = 0; sb < 4; ++sb) {
      wave_sync();
      s5_store_u(U, lane, ua, ub);
      wave_sync();
      if (sb < 3) s5_load_u(PS5, q * 256 + (sb + 1) * 64, g, lane, ua, ub);
      for (int t = 0; t < 64; ++t) {
        float bur, bui;
        S5_BU(U + t * 16, bur, bui);
        xf = cmul(lb0, xf); xf.x += bur; xf.y += bui;
        xb.x += pw.x * bur - pw.y * bui; xb.y += pw.x * bui + pw.y * bur;
        pw = cmul(pw, lb1);
      }
    }
    CAR[((size_t)(q * 32 + g) * 2 + 0) * 64 + lane] = cmul(xf, c0);
    CAR[((size_t)(q * 32 + g) * 2 + 1) * 64 + lane] = cmul(xb, c1);
  }
}

__device__ void s5_passC(const Params& p, int i, unsigned char* lds) {
  const ushort_t* PS5 = (const ushort_t*)(p.ws + OFF_PS5);
  const cplx* CAR = (const cplx*)(p.ws + OFF_CAR);
  float* YS = (float*)(p.ws + OFF_YS);
  ushort_t* YG = (ushort_t*)(p.ws + OFF_Y);
  const int lane = tidx() & 63, wave = tidx() >> 6;
  float* U = (float*)(lds + wave * 8448);
  ushort_t* X = (ushort_t*)(lds + wave * 8448 + 4096);
  for (int item = bidx() * 8 + wave; item < 192 * 32; item += gridDim.x * 8) {
    const int q = item >> 5, g = item & 31;
    int cs, ce;
    if (q < 64) { cs = q & ~15; ce = cs + 16; } else { cs = 64 + ((q - 64) & ~63); ce = cs + 64; }
    float Br[16], Bi[16];
#pragma unroll
    for (int pp = 0; pp < 16; ++pp) { Br[pp] = p.in[I_BRE][((i * 32 + g) * 64 + lane) * 16 + pp]; Bi[pp] = p.in[I_BIM][((i * 32 + g) * 64 + lane) * 16 + pp]; }
    const int pcol = lane & 15;
    const float dd = p.in[I_S5D][i * 512 + g * 16 + pcol];
    for (int d = 0; d < 2; ++d) {
      cplx lb, coef;
      s5_consts(p, i, d, g, lane, lb, coef);
      cplx lp = lb;
#pragma unroll
      for (int e = 0; e < 8; ++e) lp = cmul(lp, lp);
      cplx xs{0.f, 0.f};
      if (d == 0) {
#pragma unroll 8
        for (int j = cs; j < q; ++j) { xs = cmul(lp, xs); cplx c = CAR[((size_t)(j * 32 + g) * 2 + 0) * 64 + lane]; xs.x += c.x; xs.y += c.y; } }
      else {
#pragma unroll 8
        for (int j = ce - 1; j > q; --j) { xs = cmul(lp, xs); cplx c = CAR[((size_t)(j * 32 + g) * 2 + 1) * 64 + lane]; xs.x += c.x; xs.y += c.y; } }
      bf16x8 cf[4];
#pragma unroll
      for (int kk = 0; kk < 4; ++kk) {
        const int n0 = (kk & 1) * 32 + (lane >> 4) * 8;
        const float* src = (kk < 2 ? p.in[I_CRE] : p.in[I_CIM]) + (((size_t)(i * 2 + d) * 32 + g) * 16 + pcol) * 64 + n0;
        const float sg = kk < 2 ? 1.f : -1.f;
#pragma unroll
        for (int j = 0; j < 8; ++j) cf[kk][j] = (short)f2bf(sg * src[j]);
      }
      uint4 ua, ub;
      s5_load_u(PS5, q * 256 + (d ? 3 : 0) * 64, g, lane, ua, ub);
      for (int sbi = 0; sbi < 4; ++sbi) {
        const int sb = d ? 3 - sbi : sbi;
        wave_sync();
        s5_store_u(U, lane, ua, ub);
        wave_sync();
        if (sbi < 3) s5_load_u(PS5, q * 256 + (d ? 2 - sbi : sbi + 1) * 64, g, lane, ua, ub);
        for (int tbi = 0; tbi < 4; ++tbi) {
          const int tb = d ? 3 - tbi : tbi;
          float ysp[4] = {0.f, 0.f, 0.f, 0.f};
          if (d == 1) {
#pragma unroll
            for (int r = 0; r < 4; ++r) ysp[r] = YS[(size_t)(q * 256 + sb * 64 + tb * 16 + (lane >> 4) * 4 + r) * 512 + g * 16 + pcol];
          }
          for (int tti = 0; tti < 16; ++tti) {
            const int tt = d ? 15 - tti : tti;
            float bur, bui;
            S5_BU(U + (tb * 16 + tt) * 16, bur, bui);
            xs = cmul(lb, xs);
            xs.x += coef.x * bur - coef.y * bui;
            xs.y += coef.x * bui + coef.y * bur;
            X[tt * 136 + lane] = f2bf(xs.x);
            X[tt * 136 + 64 + lane] = f2bf(xs.y);
          }
          wave_sync();
          f32x4 acc{0.f, 0.f, 0.f, 0.f};
#pragma unroll
          for (int kk = 0; kk < 4; ++kk) {
            bf16x8 a = *(const bf16x8*)(X + (lane & 15) * 136 + kk * 32 + (lane >> 4) * 8);
            acc = __builtin_amdgcn_mfma_f32_16x16x32_bf16(a, cf[kk], acc, 0, 0, 0);
          }
          wave_sync();
#pragma unroll
          for (int r = 0; r < 4; ++r) {
            const int tl = tb * 16 + (lane >> 4) * 4 + r;
            const size_t o = (size_t)(q * 256 + sb * 64 + tl) * 512 + g * 16 + pcol;
            if (d == 0) YS[o] = acc[r] + dd * U[tl * 16 + pcol];
            else {
              const float yv = ysp[r] + acc[r];
              YG[(size_t)(q * 256 + sb * 64 + tl) * 1024 + 512 + g * 16 + pcol] = f2bf(gelu_tanh(yv));
            }
          }
        }
      }
    }
  }
}

struct RwConst { float mur, muk, muv, mul, w0, a0, kk, ka; };
struct RwRow { float r, k, v, l; };
DEVI RwRow rw_load_row(const ushort_t* PRW, int tok, int s0, int L, int h, int lane) {
  RwRow o{0.f, 0.f, 0.f, 0.f};
  if (tok >= s0 && tok < s0 + L) {
    const ushort_t* row = PRW + (size_t)tok * 2112;
    const int cc = h * 64 + lane;
    o.r = bf2f(row[cc]); o.k = bf2f(row[512 + cc]); o.v = bf2f(row[1024 + cc]); o.l = bf2f(row[2048 + lane]);
  }
  return o;
}
DEVI void rw_prologue(const RwRow& rm, const RwRow& rc, const RwRow& rn, int lane, const RwConst& c, const float* WU, const float* AU,
                      float* LT, float* Wd, float* KKd, float* BBd, float* KDd, float* RRd, float* VVd) {
  const float rr = rc.r + c.mur * (0.5f * (rm.r + rn.r) - rc.r);
  const float kx = rc.k + c.muk * (0.5f * (rm.k + rn.k) - rc.k);
  const float vv = rc.v + c.muv * (0.5f * (rm.v + rn.v) - rc.v);
  float ll = rc.l + c.mul * (0.5f * (rm.l + rn.l) - rc.l);
  ll = lane < 32 ? fast_tanh(ll) : ll;
  wave_sync();
  LT[lane] = ll;
  wave_sync();
  float accw = c.w0, acca = c.a0;
#pragma unroll 2
  for (int j = 0; j < 32; j += 4) {
    float4 lw = *(const float4*)(LT + j), la = *(const float4*)(LT + 32 + j);
    accw += lw.x * WU[(j + 0) * 64 + lane] + lw.y * WU[(j + 1) * 64 + lane] + lw.z * WU[(j + 2) * 64 + lane] + lw.w * WU[(j + 3) * 64 + lane];
    acca += la.x * AU[(j + 0) * 64 + lane] + la.y * AU[(j + 1) * 64 + lane] + la.z * AU[(j + 2) * 64 + lane] + la.w * AU[(j + 3) * 64 + lane];
  }
  const float dec = __builtin_amdgcn_exp2f(-0.8750387749145276f * fast_sigmoid(accw));
  const float a = fast_sigmoid(acca);
  const float kkr = kx * c.kk;
  const float ss = wsum_fast(kkr * kkr);
  const float kkn = kkr * __builtin_amdgcn_rsqf(fmaxf(ss, 1e-24f));
  Wd[lane] = dec; KKd[lane] = kkn; BBd[lane] = kkn * a; KDd[lane] = kx * (1.f + (a - 1.f) * c.ka); RRd[lane] = rr; VVd[lane] = vv;
}

template <int NS>
DEVI void rw_prologue_blk(const RwRow* R, int lane, const RwConst& c, const bf16x8* BF, int dir, ushort_t* LTm,
                          float* Wd, float* KKd, float* BBd, float* KDd, float* RRd, float* VVd) {
#pragma unroll
  for (int e = 0; e < NS; ++e) {
    const RwRow& rm = R[e]; const RwRow& rc = R[e + 1]; const RwRow& rn = R[e + 2];
    const float rr = rc.r + c.mur * (0.5f * (rm.r + rn.r) - rc.r);
    const float kx = rc.k + c.muk * (0.5f * (rm.k + rn.k) - rc.k);
    const float vv = rc.v + c.muv * (0.5f * (rm.v + rn.v) - rc.v);
    float ll = rc.l + c.mul * (0.5f * (rm.l + rn.l) - rc.l);
    ll = lane < 32 ? fast_tanh(ll) : ll;
    RRd[e * 64 + lane] = rr; VVd[e * 64 + lane] = vv; KDd[e * 64 + lane] = kx;
    LTm[e * 72 + lane] = f2bf(ll);
  }
  wave_sync();
  {
    const int row = lane & (NS - 1), kq8 = (lane >> 4) * 8;
    const bf16x8 aw = *(const bf16x8*)(LTm + row * 72 + kq8);
    const bf16x8 aa = *(const bf16x8*)(LTm + row * 72 + 32 + kq8);
#pragma unroll
    for (int nt = 0; nt < 4; ++nt) {
      const f32x4 z = {0.f, 0.f, 0.f, 0.f};
      const f32x4 dw = __builtin_amdgcn_mfma_f32_16x16x32_bf16(aw, BF[(dir * 4 + nt) * 64 + lane], z, 0, 0, 0);
      const f32x4 da = __builtin_amdgcn_mfma_f32_16x16x32_bf16(aa, BF[(8 + nt) * 64 + lane], z, 0, 0, 0);
      if ((lane >> 4) < NS / 4) {
#pragma unroll
        for (int r = 0; r < 4; ++r) {
          const int o = ((lane >> 4) * 4 + r) * 64 + nt * 16 + (lane & 15);
          Wd[o] = dw[r]; BBd[o] = da[r];
        }
      }
    }
  }
  wave_sync();
#pragma unroll
  for (int e = 0; e < NS; ++e) {
    const float accw = c.w0 + Wd[e * 64 + lane], acca = c.a0 + BBd[e * 64 + lane], kx = KDd[e * 64 + lane];
    const float dec = __builtin_amdgcn_exp2f(-0.8750387749145276f * fast_sigmoid(accw));
    const float a = fast_sigmoid(acca);
    const float kkr = kx * c.kk;
    const float ss = wsum_fast(kkr * kkr);
    const float kkn = kkr * __builtin_amdgcn_rsqf(fmaxf(ss, 1e-24f));
    Wd[e * 64 + lane] = dec; KKd[e * 64 + lane] = kkn; BBd[e * 64 + lane] = kkn * a; KDd[e * 64 + lane] = kx * (1.f + (a - 1.f) * c.ka);
  }
}
DEVI void rw_fill_bf(const Params& p, int i, int h, bf16x8* BF, int tid) {
  for (int e = tid; e < 768; e += NT) {
    const int which = e >> 8, nt = (e >> 6) & 3, l = e & 63;
    const int n = nt * 16 + (l & 15), k0 = (l >> 4) * 8;
    const float* src = which < 2 ? p.in[I_WUP] + ((size_t)(i * 2 + which) * 32) * 512 : p.in[I_AUP] + ((size_t)i * 32) * 512;
    bf16x8 v;
#pragma unroll
    for (int jj = 0; jj < 8; ++jj) v[jj] = (short)f2bf(src[(size_t)(k0 + jj) * 512 + h * 64 + n]);
    BF[e] = v;
  }
}

DEVI float dpp_f(float x, const int ctrl_sel) {
  int xi = __builtin_bit_cast(int, x), r;
  if (ctrl_sel == 0) r = __builtin_amdgcn_mov_dpp(xi, 0xB1, 0xf, 0xf, true);
  else if (ctrl_sel == 1) r = __builtin_amdgcn_mov_dpp(xi, 0x4E, 0xf, 0xf, true);
  else r = __builtin_amdgcn_mov_dpp(xi, 0x141, 0xf, 0xf, true);
  return __builtin_bit_cast(float, r);
}
DEVI float red8(float x) { x += dpp_f(x, 0); x += dpp_f(x, 1); x += dpp_f(x, 2); return x; }

#define RW_LOAD8(dst2, base)                                                        \
  { const float4 _a = *(const float4*)(base), _b = *(const float4*)((base) + 4);    \
    dst2[0] = f32x2{_a.x, _a.y}; dst2[1] = f32x2{_a.z, _a.w}; dst2[2] = f32x2{_b.x, _b.y}; dst2[3] = f32x2{_b.z, _b.w}; }

__device__ void rwkv_scan1(const Params& p, int i, unsigned char* lds) {
  const ushort_t* PRW = (const ushort_t*)(p.ws + OFF_PRW);
  float* CH = (float*)(p.ws + OFF_PS5);
  float* YR = (float*)(p.ws + OFF_YS);
  const int tid = tidx(), lane = tid & 63, wave = tid >> 6, pair = wave >> 1, role = wave & 1;
  const int vq = lane >> 3, kq = lane & 7;
  bf16x8* BF = (bf16x8*)lds;
  float* WV = (float*)(lds + 12288 + pair * 14592);
  float* Wd = WV, *KKd = WV + 512, *BBd = WV + 1024, *KDd = WV + 1536, *RRd = WV + 2048, *VVd = WV + 2560;
  ushort_t* LTm = (ushort_t*)(WV + 3072) + role * 576;
  {
    float4* z = (float4*)YR;
    for (size_t e = (size_t)bidx() * NT + tid; e < (size_t)T * 512 / 4; e += (size_t)gridDim.x * NT) z[e] = float4{0.f, 0.f, 0.f, 0.f};
  }
  for (int bi = bidx(); bi < 768; bi += gridDim.x) {
    const int h = bi / 96, rem = bi % 96;
    const int dir = pair >> 1, q = rem * 2 + (pair & 1);
    __syncthreads();
    rw_fill_bf(p, i, h, BF, tid);
    __syncthreads();
    RwConst c;
    const int cc = h * 64 + lane;
    c.mur = p.in[I_MURKV][(i * 3 + 0) * 512 + cc]; c.muk = p.in[I_MURKV][(i * 3 + 1) * 512 + cc]; c.muv = p.in[I_MURKV][(i * 3 + 2) * 512 + cc];
    c.mul = p.in[I_MULORA][i * 64 + lane];
    c.w0 = p.in[I_W0][(i * 2 + dir) * 512 + cc]; c.a0 = p.in[I_A0][(i * 2 + dir) * 512 + cc];
    c.kk = p.in[I_KK][i * 512 + cc]; c.ka = p.in[I_KA][i * 512 + cc];
    const size_t it = ((size_t)(q * 8 + h) * 2 + dir);
    int sq0, sqL; seq_of(q * 256, sq0, sqL);
    float* Op = CH + it * 8192 + (role ? 0 : 4096);
    f32x2 S2[8][4];
    int diag = (role && vq == kq) ? 1 : 0;
    asm volatile("" : "+v"(diag));
#pragma unroll
    for (int r = 0; r < 8; ++r)
#pragma unroll
      for (int jj = 0; jj < 4; ++jj) S2[r][jj] = f32x2{(diag && (2 * jj == r)) ? 1.f : 0.f, (diag && (2 * jj + 1 == r)) ? 1.f : 0.f};
    const float vsel = role ? 0.f : 1.f;
    for (int blk = 0; blk < 32; ++blk) {
      {
        RwRow R[6];
#pragma unroll
        for (int j = 0; j < 6; ++j) {
          const int st = blk * 8 + role * 4 + j - 1;
          R[j] = rw_load_row(PRW, dir ? (q * 256 + 255 - st) : (q * 256 + st), sq0, sqL, h, lane);
        }
        {
          const int s = role * 4;
          rw_prologue_blk<4>(R, lane, c, BF, dir, LTm, Wd + s * 64, KKd + s * 64, BBd + s * 64, KDd + s * 64, RRd + s * 64, VVd + s * 64);
        }
      }
      __syncthreads();
#pragma unroll 2
      for (int s = 0; s < 8; ++s) {
        f32x2 kk2[4], w2[4], b2[4], kd2[4], vv2[4];
        RW_LOAD8(kk2, KKd + s * 64 + 8 * kq);
        RW_LOAD8(vv2, VVd + s * 64 + 8 * vq);
        RW_LOAD8(w2, Wd + s * 64 + 8 * kq);
        RW_LOAD8(b2, BBd + s * 64 + 8 * kq);
        RW_LOAD8(kd2, KDd + s * 64 + 8 * kq);
        float sa[8];
#pragma unroll
        for (int r = 0; r < 8; ++r) {
          f32x2 a = S2[r][0] * kk2[0];
          a = S2[r][1] * kk2[1] + a; a = S2[r][2] * kk2[2] + a; a = S2[r][3] * kk2[3] + a;
          sa[r] = -red8(a.x + a.y);
        }
#pragma unroll
        for (int r = 0; r < 8; ++r) {
          const float vr = ((r & 1) ? vv2[r >> 1].y : vv2[r >> 1].x) * vsel;
          const f32x2 sa2 = f32x2{sa[r], sa[r]}, v2 = f32x2{vr, vr};
#pragma unroll
          for (int jj = 0; jj < 4; ++jj) S2[r][jj] = S2[r][jj] * w2[jj] + sa2 * b2[jj] + v2 * kd2[jj];
        }
      }
      __syncthreads();
    }
#pragma unroll
    for (int r = 0; r < 8; ++r) {
      float* dst = Op + (8 * vq + r) * 64 + 8 * kq;
      *(float4*)dst = float4{S2[r][0].x, S2[r][0].y, S2[r][1].x, S2[r][1].y};
      *(float4*)(dst + 4) = float4{S2[r][2].x, S2[r][2].y, S2[r][3].x, S2[r][3].y};
    }
  }
}

__device__ void rwkv_scan3(const Params& p, int i, unsigned char* lds, bool dry = false) {
  const ushort_t* PRW = (const ushort_t*)(p.ws + OFF_PRW);
  float* CH = (float*)(p.ws + OFF_PS5);
  float* YR = (float*)(p.ws + OFF_YS);
  const int tid = tidx(), lane = tid & 63, wave = tid >> 6;
  const int vq = lane >> 3, kq = lane & 7;
  bf16x8* BF = (bf16x8*)lds;
  float* WV = (float*)(lds + 12288 + wave * 13440);
  float* Wd = WV, *KKd = WV + 512, *BBd = WV + 1024, *KDd = WV + 1536, *RRd = WV + 2048, *VVd = WV + 2560;
  ushort_t* LTm = (ushort_t*)(WV + 3072);
  for (int bi = bidx(); bi < 384; bi += gridDim.x) {
    const int h = bi / 48, cgp = bi % 48;
    const int dir = wave >> 2, q = cgp * 4 + (wave & 3);
    __syncthreads();
    rw_fill_bf(p, i, h, BF, tid);
    __syncthreads();
    RwConst c;
    const int cc = h * 64 + lane;
    c.mur = p.in[I_MURKV][(i * 3 + 0) * 512 + cc]; c.muk = p.in[I_MURKV][(i * 3 + 1) * 512 + cc]; c.muv = p.in[I_MURKV][(i * 3 + 2) * 512 + cc];
    c.mul = p.in[I_MULORA][i * 64 + lane];
    c.w0 = p.in[I_W0][(i * 2 + dir) * 512 + cc]; c.a0 = p.in[I_A0][(i * 2 + dir) * 512 + cc];
    c.kk = p.in[I_KK][i * 512 + cc]; c.ka = p.in[I_KA][i * 512 + cc];
    const size_t it = ((size_t)(q * 8 + h) * 2 + dir);
    int sq0, sqL; seq_of(q * 256, sq0, sqL);
    const float* Qp = CH + it * 8192 + 4096;
    f32x2 S2[8][4];
#pragma unroll
    for (int r = 0; r < 8; ++r) {
      const float* src = Qp + (8 * vq + r) * 64 + 8 * kq;
      const float4 a = *(const float4*)src, b = *(const float4*)(src + 4);
      S2[r][0] = f32x2{a.x, a.y}; S2[r][1] = f32x2{a.z, a.w}; S2[r][2] = f32x2{b.x, b.y}; S2[r][3] = f32x2{b.z, b.w};
    }
    for (int blk = 0; blk < 32; ++blk) {
      {
        RwRow R[10];
#pragma unroll
        for (int j = 0; j < 10; ++j) {
          const int st = blk * 8 + j - 1;
          R[j] = rw_load_row(PRW, dir ? (q * 256 + 255 - st) : (q * 256 + st), sq0, sqL, h, lane);
        }
        rw_prologue_blk<8>(R, lane, c, BF, dir, LTm, Wd, KKd, BBd, KDd, RRd, VVd);
      }
      wave_sync();
#pragma unroll 2
      for (int s = 0; s < 8; ++s) {
        f32x2 kk2[4], w2[4], b2[4], kd2[4], vv2[4], r2[4];
        RW_LOAD8(kk2, KKd + s * 64 + 8 * kq);
        RW_LOAD8(vv2, VVd + s * 64 + 8 * vq);
        RW_LOAD8(w2, Wd + s * 64 + 8 * kq);
        RW_LOAD8(b2, BBd + s * 64 + 8 * kq);
        RW_LOAD8(kd2, KDd + s * 64 + 8 * kq);
        RW_LOAD8(r2, RRd + s * 64 + 8 * kq);
        float sa[8];
#pragma unroll
        for (int r = 0; r < 8; ++r) {
          f32x2 a = S2[r][0] * kk2[0];
          a = S2[r][1] * kk2[1] + a; a = S2[r][2] * kk2[2] + a; a = S2[r][3] * kk2[3] + a;
          sa[r] = -red8(a.x + a.y);
        }
        float ysel = 0.f;
#pragma unroll
        for (int r = 0; r < 8; ++r) {
          const float vr = (r & 1) ? vv2[r >> 1].y : vv2[r >> 1].x;
          const f32x2 sa2 = f32x2{sa[r], sa[r]}, v2 = f32x2{vr, vr};
          f32x2 ya = f32x2{0.f, 0.f};
#pragma unroll
          for (int jj = 0; jj < 4; ++jj) {
            S2[r][jj] = S2[r][jj] * w2[jj] + sa2 * b2[jj] + v2 * kd2[jj];
            ya = S2[r][jj] * r2[jj] + ya;
          }
          const float yr = red8(ya.x + ya.y);
          ysel = (kq == r) ? yr : ysel;
        }
        const int st = blk * 8 + s;
        const int tok = dir ? (q * 256 + 255 - st) : (q * 256 + st);
        if (!dry) atomicAdd(YR + (size_t)tok * 512 + h * 64 + lane, ysel);
      }
      wave_sync();
    }
  }
}

__device__ void rwkv_carry(const Params& p, unsigned char* lds, bool dry = false) {
  float* CH = (float*)(p.ws + OFF_PS5);
  float* Ps = (float*)lds;
  float* Ss = Ps + 4096;
  const int tid = tidx(), v = tid >> 4, ks = (tid & 15) * 4;
  for (int bi = bidx(); bi < 192; bi += gridDim.x) {
    const int half = bi & 1, dir = (bi >> 1) & 1, h = (bi >> 2) & 7, s = bi >> 5;
    int cs, n;
    if (s < 4) { cs = s * 16; n = 16; } else { cs = 64 + (s - 4) * 64; n = 64; }
    float4 cur{0.f, 0.f, 0.f, 0.f};
    float4 pq0, pq1, qv;
    {
      const int q = dir ? (cs + n - 1) : cs;
      const float* Pp = CH + ((size_t)(q * 8 + h) * 2 + dir) * 8192;
      pq0 = ((const float4*)Pp)[tid]; pq1 = ((const float4*)Pp)[tid + 512];
      qv = *(const float4*)(Pp + 4096 + (half * 32 + v) * 64 + ks);
    }
    for (int ci = 0; ci < n; ++ci) {
      const int q = dir ? (cs + n - 1 - ci) : (cs + ci);
      float* Pp = CH + ((size_t)(q * 8 + h) * 2 + dir) * 8192;
      float* Qrow = Pp + 4096 + (half * 32 + v) * 64 + ks;
      __syncthreads();
      if (!dry) *(float4*)Qrow = cur;
      if (ci == n - 1) break;
      *(float4*)(Ss + v * 64 + ks) = cur;
      ((float4*)Ps)[tid] = pq0;
      ((float4*)Ps)[tid + 512] = pq1;
      float4 acc = qv;
      if (ci + 2 < n + 1 && ci + 1 < n) {
        const int qn = dir ? (cs + n - 2 - ci) : (cs + ci + 1);
        const float* Pn = CH + ((size_t)(qn * 8 + h) * 2 + dir) * 8192;
        pq0 = ((const float4*)Pn)[tid]; pq1 = ((const float4*)Pn)[tid + 512];
        qv = *(const float4*)(Pn + 4096 + (half * 32 + v) * 64 + ks);
      }
      __syncthreads();
#pragma unroll 8
      for (int j = 0; j < 64; ++j) {
        const float sv = Ss[v * 64 + j];
        const float4 pr = *(const float4*)(Ps + j * 64 + ks);
        acc.x += sv * pr.x; acc.y += sv * pr.y; acc.z += sv * pr.z; acc.w += sv * pr.w;
      }
      cur = acc;
    }
    __syncthreads();
  }
}

__device__ void rwkv_post(const Params& p, int i) {
  const ushort_t* __restrict__ PRW = (const ushort_t*)(p.ws + OFF_PRW);
  const float* __restrict__ YR = (const float*)(p.ws + OFF_YS);
  ushort_t* __restrict__ Y = (ushort_t*)(p.ws + OFF_Y);
  const int lane = tidx() & 63, gw = bidx() * 8 + (tidx() >> 6), nw = gridDim.x * 8;
  for (int item = gw; item < (T / 4) * 8; item += nw) {
    const int tok0 = (item >> 3) * 4, h = item & 7, cc = h * 64 + lane;
    int s0, L; seq_of(tok0, s0, L);
    float r[6], k[6], v[6], g[4], y[4];
#pragma unroll
    for (int j = 0; j < 6; ++j) {
      const int tok = tok0 - 1 + j;
      r[j] = 0.f; k[j] = 0.f; v[j] = 0.f;
      if (tok >= s0 && tok < s0 + L) {
        const ushort_t* row = PRW + (size_t)tok * 2112;
        r[j] = bf2f(row[cc]); k[j] = bf2f(row[512 + cc]); v[j] = bf2f(row[1024 + cc]);
      }
    }
#pragma unroll
    for (int e = 0; e < 4; ++e) { g[e] = bf2f(PRW[(size_t)(tok0 + e) * 2112 + 1536 + cc]); y[e] = YR[(size_t)(tok0 + e) * 512 + cc]; }
    const float mur = p.in[I_MURKV][(i * 3 + 0) * 512 + cc], muk = p.in[I_MURKV][(i * 3 + 1) * 512 + cc], muv = p.in[I_MURKV][(i * 3 + 2) * 512 + cc];
    const float lw = p.in[I_LNXW][i * 512 + cc], lb = p.in[I_LNXB][i * 512 + cc], rk = p.in[I_RK][i * 512 + cc];
#pragma unroll
    for (int e = 0; e < 4; ++e) {
      const float rr = r[e + 1] + mur * (0.5f * (r[e] + r[e + 2]) - r[e + 1]);
      const float kx = k[e + 1] + muk * (0.5f * (k[e] + k[e + 2]) - k[e + 1]);
      const float vv = v[e + 1] + muv * (0.5f * (v[e] + v[e + 2]) - v[e + 1]);
      const float mean = wsum_fast(y[e]) * (1.f / 64.f);
      const float dlt = y[e] - mean;
      const float var = wsum_fast(dlt * dlt) * (1.f / 64.f);
      const float yn = dlt * __builtin_amdgcn_rsqf(var + 64e-5f) * lw + lb;
      const float bonus = wsum_fast(rr * kx * rk) * vv;
      Y[(size_t)(tok0 + e) * 1024 + 512 + cc] = f2bf((yn + bonus) * (g[e] * fast_sigmoid(g[e])));
    }
  }
}

__device__ void hy_filter_mlp(const Params& p, int i) {
  float* H2 = (float*)(p.ws + OFF_H2);
  const int lane = tidx() & 63, gw = bidx() * 8 + (tidx() >> 6), nw = gridDim.x * 8;
  const float fr = p.in[I_FFREQ][i * 64 + lane], b1 = p.in[I_FB1][i * 64 + lane], b2 = p.in[I_FB2][i * 64 + lane];
  for (int row = gw; row < 20480; row += nw) {
    const int L = row < 4096 ? 4096 : 16384, t = row < 4096 ? row : row - 4096;
    const float w = 6.283185307179586f * (float)t / (float)L;
    float z = 0.f;
    if (lane == 0) z = (float)t / (float)(L - 1);
    else if (lane <= 32) {
      const int bi = (lane - 1) & 15;
      const float f = 1e-4f + (float)bi * ((15.f - 1e-4f) / 15.f);
      z = lane <= 16 ? cosf(f * w) : -sinf(f * w);
    }
    float a = b1;
#pragma unroll 3
    for (int k = 0; k < 33; ++k) a += __shfl(z, k) * p.in[I_FW1][((size_t)i * 33 + k) * 64 + lane];
    const float h1 = sinf(fr * a);
    float c = b2;
#pragma unroll 8
    for (int k = 0; k < 64; ++k) c += __shfl(h1, k) * p.in[I_FW2][((size_t)i * 64 + k) * 64 + lane];
    H2[(row < 4096 ? (size_t)0 : (size_t)4096 * 64) + (size_t)lane * L + t] = sinf(fr * c);
  }
}

DEVI constexpr int swz(int i) { return i ^ ((i & 32) ? 21 : 0) ^ ((i & 64) ? 26 : 0); }
DEVI int swzF(int t) { return (swz(t >> 1) << 1) | (t & 1); }
DEVI f32x2 cmul_pk(f32x2 a, float c, float sn) { return a * f32x2{c, c} + f32x2{-a.y, a.x} * f32x2{sn, sn}; }
template <int LOGN>
__device__ void fft_dif(float2* buf_) {
  constexpr int N = 1 << LOGN;
  f32x2* buf = (f32x2*)buf_;
  const int tid = tidx();
#pragma unroll
  for (int ps = 0; ps < LOGN / 2; ++ps) {
    const int lh = LOGN - 1 - 2 * ps;
    const int h = 1 << lh, hh = h >> 1;
    const float inv2h = 1.f / (float)(2 * h);
#pragma unroll 2
    for (int q = tid; q < N / 4; q += NT) {
      const int pos = q & (hh - 1), grp = q >> (lh - 1);
      const int e0 = swz((grp << (lh + 1)) + pos);
      const int o1 = swz(hh), o2 = swz(h), o3 = swz(h + hh);
      const f32x2 x0 = buf[e0], x1 = buf[e0 ^ o1], x2 = buf[e0 ^ o2], x3 = buf[e0 ^ o3];
      const float f1 = (float)pos * inv2h;
      const float c1 = __builtin_amdgcn_cosf(f1), s1 = -__builtin_amdgcn_sinf(f1);
      const float c2 = c1 * c1 - s1 * s1, s2 = 2.f * c1 * s1;
      const f32x2 a0 = x0 + x2, a1 = x1 + x3;
      const f32x2 a2 = cmul_pk(x0 - x2, c1, s1);
      const f32x2 t3 = cmul_pk(x1 - x3, c1, s1);
      const f32x2 a3 = f32x2{t3.y, -t3.x};
      buf[e0] = a0 + a1;
      buf[e0 ^ o1] = cmul_pk(a0 - a1, c2, s2);
      buf[e0 ^ o2] = a2 + a3;
      buf[e0 ^ o3] = cmul_pk(a2 - a3, c2, s2);
    }
    __syncthreads();
  }
}
template <int LOGN>
__device__ void fft_dit_inv(float2* buf_) {
  constexpr int N = 1 << LOGN;
  f32x2* buf = (f32x2*)buf_;
  const int tid = tidx();
#pragma unroll
  for (int ps = 0; ps < LOGN / 2; ++ps) {
    const int lh = 2 * ps;
    const int h = 1 << lh;
    const float inv4h = 1.f / (float)(4 * h);
#pragma unroll 2
    for (int q = tid; q < N / 4; q += NT) {
      const int pos = q & (h - 1), grp = q >> lh;
      const int e0 = swz((grp << (lh + 2)) + pos);
      const int o1 = swz(h), o2 = swz(2 * h), o3 = swz(3 * h);
      const f32x2 x0 = buf[e0], x1 = buf[e0 ^ o1], x2 = buf[e0 ^ o2], x3 = buf[e0 ^ o3];
      const float f2 = (float)pos * inv4h;
      const float c2 = __builtin_amdgcn_cosf(f2), s2 = __builtin_amdgcn_sinf(f2);
      const float c1 = c2 * c2 - s2 * s2, s1 = 2.f * c2 * s2;
      const f32x2 b1 = cmul_pk(x1, c1, s1), b3 = cmul_pk(x3, c1, s1);
      const f32x2 a0 = x0 + b1, a1 = x0 - b1, a2 = x2 + b3, a3 = x2 - b3;
      const f32x2 cc2 = cmul_pk(a2, c2, s2);
      const f32x2 t3 = cmul_pk(a3, c2, s2);
      const f32x2 cc3 = f32x2{-t3.y, t3.x};
      buf[e0] = a0 + cc2;
      buf[e0 ^ o2] = a0 - cc2;
      buf[e0 ^ o1] = a1 + cc3;
      buf[e0 ^ o3] = a1 - cc3;
    }
    __syncthreads();
  }
}
template <int LOGN>
__device__ void spectrum_extract(const float2* buf, float4* __restrict__ GP, float scale) {
  constexpr int Lc = 1 << LOGN;
  for (int j = tidx(); j < Lc / 2; j += NT) {
    if (j == 0) {
      const float2 c = buf[0], ch = buf[1];
      GP[0] = float4{(c.x + c.y) * scale, (c.x - c.y) * scale, ch.x * scale, -ch.y * scale};
    } else {
      const int pos = 2 * j;
      const int k = (int)(__brev((unsigned)pos) >> (32 - LOGN));
      const int p2 = pos ^ ((1 << (31 - __clz(pos))) - 1);
      const int sp1 = swz(pos), sp2 = swz(p2);
      float2 C1 = buf[sp1], C2 = buf[sp2];
      float2 E{0.5f * (C1.x + C2.x), 0.5f * (C1.y - C2.y)}, D{0.5f * (C1.x - C2.x), 0.5f * (C1.y + C2.y)};
      float2 O{D.y, -D.x};
      const float f = (float)k * (1.f / (float)(2 * Lc));
      const float wc = __builtin_amdgcn_cosf(f), wsn = -__builtin_amdgcn_sinf(f);
      float2 wO{wc * O.x - wsn * O.y, wc * O.y + wsn * O.x};
      GP[j] = float4{(E.x + wO.x) * scale, (E.y + wO.y) * scale, (E.x - wO.x) * scale, -(E.y - wO.y) * scale};
    }
  }
}
template <int LOGN>
__device__ void spectrum_mul(float2* buf, const float4* __restrict__ GP) {
  constexpr int Lc = 1 << LOGN;
  for (int j = tidx(); j < Lc / 2; j += NT) {
    const float4 gp = GP[j];
    if (j == 0) {
      const float2 c = buf[0], ch = buf[1];
      const float Y0 = (c.x + c.y) * gp.x, YL = (c.x - c.y) * gp.y;
      buf[0] = float2{0.5f * (Y0 + YL), 0.5f * (Y0 - YL)};
      buf[1] = float2{ch.x * gp.z + ch.y * gp.w, ch.y * gp.z - ch.x * gp.w};
    } else {
      const int pos = 2 * j;
      const int k = (int)(__brev((unsigned)pos) >> (32 - LOGN));
      const int p2 = pos ^ ((1 << (31 - __clz(pos))) - 1);
      const int sp1 = swz(pos), sp2 = swz(p2);
      float2 C1 = buf[sp1], C2 = buf[sp2];
      float2 E{0.5f * (C1.x + C2.x), 0.5f * (C1.y - C2.y)}, D{0.5f * (C1.x - C2.x), 0.5f * (C1.y + C2.y)};
      float2 O{D.y, -D.x};
      const float f = (float)k * (1.f / (float)(2 * Lc));
      const float wc = __builtin_amdgcn_cosf(f), wsn = -__builtin_amdgcn_sinf(f);
      float2 wO{wc * O.x - wsn * O.y, wc * O.y + wsn * O.x};
      float2 X1{E.x + wO.x, E.y + wO.y}, X2{E.x - wO.x, -(E.y - wO.y)};
      float2 Y1{X1.x * gp.x - X1.y * gp.y, X1.x * gp.y + X1.y * gp.x};
      float2 Y2{X2.x * gp.z - X2.y * gp.w, X2.x * gp.w + X2.y * gp.z};
      float2 Ye{0.5f * (Y1.x + Y2.x), 0.5f * (Y1.y - Y2.y)};
      float2 Dd{0.5f * (Y1.x - Y2.x), 0.5f * (Y1.y + Y2.y)};
      float2 Yo{wc * Dd.x + wsn * Dd.y, wc * Dd.y - wsn * Dd.x};
      buf[sp1] = float2{Ye.x - Yo.y, Ye.y + Yo.x};
      buf[sp2] = float2{Ye.x + Yo.y, -Ye.y + Yo.x};
    }
  }
}

template <int LOGN>
__device__ void hy_conv_item(const Params& p, int i, int c, unsigned char* lds, bool dry) {
  constexpr int Lc = 1 << LOGN;
  constexpr int L = Lc;
  constexpr int NB = (LOGN == 14) ? 2 : 4;
  const int tid = tidx();
  float2* buf = (float2*)lds;
  float* bufF = (float*)lds;
  float* W3s = (float*)(lds + 131072);
  float* red = W3s + 256;
  float4* GS = (float4*)(p.ws + OFF_GS + (size_t)bidx() * 2 * GS_PER);
  float4* GS1 = GS + GS_PER / 16;
  float* G1tmp = (float*)GS1;
  float* Z1 = (float*)(p.ws + OFF_Z1 + (size_t)bidx() * 65536);
  const float* H2 = (const float*)(p.ws + OFF_H2) + (LOGN == 14 ? (size_t)4096 * 64 : 0);
  const ushort_t* PH = (const ushort_t*)(p.ws + OFF_PH);
  const float delta = 4.605170185988091f * (1.f / 1.5f + (1.f / 0.3f - 1.f / 1.5f) * (float)c / 1023.f);
  __syncthreads();
  if (tid < 256) {
    const int j = tid >> 2, col = tid & 3, o = col >> 1, dirr = col & 1;
    W3s[tid] = p.in[I_FW3][((size_t)i * 64 + j) * 4096 + (dirr * 2 + o) * 1024 + c];
  }
  __syncthreads();
  float ss0 = 0.f, ss1 = 0.f;
  for (int t0 = tid * 4; t0 < L; t0 += NT * 4) {
    float acc[4][4];
#pragma unroll
    for (int r = 0; r < 4; ++r)
#pragma unroll
      for (int cc = 0; cc < 4; ++cc) acc[r][cc] = 0.f;
#pragma unroll 1
    for (int jb = 0; jb < 64; jb += 16) {
      float4 hv[16];
#pragma unroll
      for (int jj = 0; jj < 16; ++jj) hv[jj] = *(const float4*)(H2 + (size_t)(jb + jj) * L + t0);
#pragma unroll
      for (int jj = 0; jj < 16; ++jj) {
        const float4 w = *(const float4*)(W3s + 4 * (jb + jj));
        acc[0][0] += hv[jj].x * w.x; acc[0][1] += hv[jj].x * w.y; acc[0][2] += hv[jj].x * w.z; acc[0][3] += hv[jj].x * w.w;
        acc[1][0] += hv[jj].y * w.x; acc[1][1] += hv[jj].y * w.y; acc[1][2] += hv[jj].y * w.z; acc[1][3] += hv[jj].y * w.w;
        acc[2][0] += hv[jj].z * w.x; acc[2][1] += hv[jj].z * w.y; acc[2][2] += hv[jj].z * w.z; acc[2][3] += hv[jj].z * w.w;
        acc[3][0] += hv[jj].w * w.x; acc[3][1] += hv[jj].w * w.y; acc[3][2] += hv[jj].w * w.z; acc[3][3] += hv[jj].w * w.w;
      }
    }
#pragma unroll
    for (int r = 0; r < 4; ++r) {
      const int t = t0 + r;
      const float dec = expf(-((float)t * (1.f / (float)(L - 1))) * delta);
      const float d0 = acc[r][0] * dec, d1 = acc[r][1] * dec, d2 = acc[r][2] * dec, d3 = acc[r][3] * dec;
      ss0 += d0 * d0 + d1 * d1;
      ss1 += d2 * d2 + d3 * d3;
      bufF[swzF(t)] = d0; G1tmp[t] = d2;
      if (t >= 1) { bufF[swzF(2 * L - t)] = d1; G1tmp[2 * L - t] = d3; } else { bufF[swzF(L)] = 0.f; G1tmp[L] = 0.f; }
    }
  }
  ss0 = wsum(ss0); ss1 = wsum(ss1);
  if ((tid & 63) == 0) { red[tid >> 6] = ss0; red[8 + (tid >> 6)] = ss1; }
  __syncthreads();
  float tot0 = 0.f, tot1 = 0.f;
#pragma unroll
  for (int w = 0; w < 8; ++w) { tot0 += red[w]; tot1 += red[8 + w]; }
  fft_dif<LOGN>(buf);
  spectrum_extract<LOGN>(buf, GS, rsqrtf(tot0) * (1.f / (float)Lc));
  __syncthreads();
  for (int t = tid; t < L; t += NT) buf[swz(t)] = ((const float2*)G1tmp)[t];
  __syncthreads();
  fft_dif<LOGN>(buf);
  spectrum_extract<LOGN>(buf, GS1, rsqrtf(tot1) * (1.f / (float)Lc));
  __threadfence_block();
  __syncthreads();
  const float* sw = p.in[I_HSW] + (size_t)i * 3 * 3072;
  const float* sbias = p.in[I_HSB] + (size_t)i * 3072;
  float cw[3][3], cb[3];
#pragma unroll
  for (int st = 0; st < 3; ++st) {
#pragma unroll
    for (int k = 0; k < 3; ++k) cw[st][k] = sw[k * 3072 + st * 1024 + c];
    cb[st] = sbias[st * 1024 + c];
  }
  const float fb0 = p.in[I_FBIAS][((size_t)i * 2 + 0) * 1024 + c], fb1 = p.in[I_FBIAS][((size_t)i * 2 + 1) * 1024 + c];
  for (int b = 0; b < NB; ++b) {
    const int s0 = (LOGN == 14) ? (TPROMPT + b * 16384) : (b * 4096);
    const ushort_t* pv = PH + (size_t)s0 * 1024 + (size_t)c * L;
    const ushort_t* px1 = pv + (size_t)T * 1024;
    const ushort_t* px2 = px1 + (size_t)T * 1024;
    ushort_t* pg = (ushort_t*)px2 + (size_t)T * 1024;
    auto conv8 = [&](const ushort_t* sp, int st, int t0, float* y) {
      const uint4 v = *(const uint4*)(sp + t0);
      const float xm = t0 > 0 ? bf2f(sp[t0 - 1]) : 0.f, xn = t0 + 8 < L ? bf2f(sp[t0 + 8]) : 0.f;
      const float x[10] = {xm, __uint_as_float(v.x << 16), __uint_as_float(v.x & 0xffff0000u), __uint_as_float(v.y << 16), __uint_as_float(v.y & 0xffff0000u),
                           __uint_as_float(v.z << 16), __uint_as_float(v.z & 0xffff0000u), __uint_as_float(v.w << 16), __uint_as_float(v.w & 0xffff0000u), xn};
#pragma unroll
      for (int j = 0; j < 8; ++j) y[j] = cw[st][0] * x[j] + cw[st][1] * x[j + 1] + cw[st][2] * x[j + 2] + cb[st];
    };
    __syncthreads();
    for (int t0 = tid * 8; t0 < L; t0 += NT * 8) {
      float y[8]; conv8(pv, 0, t0, y);
#pragma unroll
      for (int j = 0; j < 4; ++j) { buf[swz((t0 >> 1) + j)] = float2{y[2 * j], y[2 * j + 1]}; buf[swz(L / 2 + (t0 >> 1) + j)] = float2{0.f, 0.f}; }
    }
    __syncthreads();
    fft_dif<LOGN>(buf);
    spectrum_mul<LOGN>(buf, GS);
    __syncthreads();
    fft_dit_inv<LOGN>(buf);
    for (int t0 = tid * 8; t0 < L; t0 += NT * 8) {
      float z0[8], xa[8]; conv8(pv, 0, t0, z0); conv8(px1, 1, t0, xa);
      float z1[8];
#pragma unroll
      for (int j = 0; j < 4; ++j) {
        const int e = swz((t0 >> 1) + j);
        const float2 zc = buf[e];
        z1[2 * j] = xa[2 * j] * (zc.x + z0[2 * j] * fb0); z1[2 * j + 1] = xa[2 * j + 1] * (zc.y + z0[2 * j + 1] * fb0);
        buf[e] = float2{z1[2 * j], z1[2 * j + 1]};
        buf[swz(L / 2 + (t0 >> 1) + j)] = float2{0.f, 0.f};
      }
      *(float4*)(Z1 + t0) = float4{z1[0], z1[1], z1[2], z1[3]};
      *(float4*)(Z1 + t0 + 4) = float4{z1[4], z1[5], z1[6], z1[7]};
    }
    __syncthreads();
    fft_dif<LOGN>(buf);
    spectrum_mul<LOGN>(buf, GS1);
    __syncthreads();
    fft_dit_inv<LOGN>(buf);
    for (int t0 = tid * 8; t0 < L; t0 += NT * 8) {
      float xb[8]; conv8(px2, 2, t0, xb);
      const float4 za = *(const float4*)(Z1 + t0), zb = *(const float4*)(Z1 + t0 + 4);
      const float z1[8] = {za.x, za.y, za.z, za.w, zb.x, zb.y, zb.z, zb.w};
      const uint4 gv = *(const uint4*)(pg + t0);
      const unsigned gw[4] = {gv.x, gv.y, gv.z, gv.w};
      unsigned o[4];
#pragma unroll
      for (int j = 0; j < 4; ++j) {
        const float2 zc = buf[swz((t0 >> 1) + j)];
        const float g0 = __uint_as_float(gw[j] << 16), g1 = __uint_as_float(gw[j] & 0xffff0000u);
        const float y0 = xb[2 * j] * (zc.x + z1[2 * j] * fb1) * (g0 * fast_sigmoid(g0));
        const float y1 = xb[2 * j + 1] * (zc.y + z1[2 * j + 1] * fb1) * (g1 * fast_sigmoid(g1));
        o[j] = pack2(y0, y1);
      }
      if (!dry) *(uint4*)(pg + t0) = uint4{o[0], o[1], o[2], o[3]};
    }
  }
}

__device__ void hy_conv_phase(const Params& p, int i, unsigned char* lds, bool dry = false) {
  for (int it = bidx(); it < 2048; it += gridDim.x) {
    if (it < 1024) hy_conv_item<14>(p, i, it, lds, dry);
    else hy_conv_item<12>(p, i, it - 1024, lds, dry);
    __syncthreads();
  }
}

#ifndef PROBE_MASK
#define PROBE_MASK 0
#endif
#ifndef PH_MASK
#define PH_MASK 0x1ffff
#endif
#define PHM(n) ((PH_MASK >> (n)) & 1)
DEVI void run_phase(const Params& p, int ph, unsigned char* lds, bool dry = false) {
  const int layer = ph < NPH_EVEN ? 0 : ph < NPH_EVEN + NPH_ODD ? 1 : ph < 2 * NPH_EVEN + NPH_ODD ? 2 : 3;
  const int base = layer == 0 ? 0 : layer == 1 ? NPH_EVEN : layer == 2 ? NPH_EVEN + NPH_ODD : 2 * NPH_EVEN + NPH_ODD;
  const int sp = ph - base, i = layer >> 1;
  unsigned char* ws = p.ws;
  ushort_t* WB = (ushort_t*)(ws + OFF_WB);
  if ((layer & 1) == 0) {
    ushort_t* WinT = WB; ushort_t* WoutT = WB + 3328 * 1024; ushort_t* GluT = WoutT + 1024 * 1024;
    switch (sp) {
      case 0: if (PHM(0)) {
        transpose_bf16(p.in[I_EWIN] + (size_t)i * 1024 * 3136, WinT, 1024, 3136, lds);
        zero_fill(WinT + 3136 * 1024, 192 * 1024);
        transpose_bf16(p.in[I_EWOUT] + (size_t)i * 1024 * 1024, WoutT, 1024, 1024, lds);
        transpose_bf16(p.in[I_GLUW] + (size_t)i * 512 * 512, GluT, 512, 512, lds);
        if (layer == 0) xb_convert(p, (ushort_t*)(ws + OFF_Y));
        } break;
      case 1: if (PHM(1)) run_gemm(lds, (const ushort_t*)(ws + OFF_Y), 1024, WinT, 3328, 1024, pg8::EpiEvenIn{(ushort_t*)(ws + OFF_PS5), (ushort_t*)(ws + OFF_PRW)}); break;
      case 2: if (PHM(2)) s5_passA(p, i, lds); break;
      case 3: if (PHM(3)) s5_passC(p, i, lds); break;
      case 4: if (PHM(4)) run_gemm(lds, (const ushort_t*)(ws + OFF_Y) + 512, 1024, GluT, 512, 512, pg8::EpiGlu{(ushort_t*)(ws + OFF_Y), (const ushort_t*)(ws + OFF_PS5), p.in[I_GLUB] + i * 512}); break;
      case 5: if (PHM(5)) rwkv_scan1(p, i, lds); break;
      case 6: if (PHM(6)) rwkv_carry(p, lds, dry); break;
      case 7: if (PHM(7)) rwkv_scan3(p, i, lds, dry); break;
      case 8: if (PHM(8)) rwkv_post(p, i); break;
      case 9: if (PHM(9)) run_gemm(lds, (const ushort_t*)(ws + OFF_Y), 1024, WoutT, 1024, 1024, pg8::EpiF32{(float*)(ws + OFF_PRW)}); break;
      case 10: if (PHM(10)) ln_phase(p, layer, (const float*)(ws + OFF_PRW), (ushort_t*)(ws + OFF_XB_ODD), dry); break;
    }
  } else {
    ushort_t* HinT = WB; ushort_t* HoutT = WB + 4096 * 1024;
    switch (sp) {
      case 0: if (PHM(11)) {
        transpose_bf16(p.in[I_HWIN] + (size_t)i * 1024 * 4096, HinT, 1024, 4096, lds);
        transpose_bf16(p.in[I_HWOUT] + (size_t)i * 1024 * 1024, HoutT, 1024, 1024, lds);
        hy_filter_mlp(p, i);
        } break;
      case 1: if (PHM(12)) run_gemm(lds, (const ushort_t*)(ws + OFF_XB_ODD), 1024, HinT, 4096, 1024, pg8::EpiHyIn{(ushort_t*)(ws + OFF_PH)}); break;
      case 2: if (PHM(13)) hy_conv_phase(p, i, lds, dry); break;
      case 3: if (PHM(14)) hy_transpose((const ushort_t*)(ws + OFF_PH + 3 * SZ1), (ushort_t*)(ws + OFF_PH), lds); break;
      case 4: if (PHM(15)) run_gemm(lds, (const ushort_t*)(ws + OFF_PH), 1024, HoutT, 1024, 1024, pg8::EpiF32{(float*)(ws + OFF_PH + SZ1)}); break;
      case 5: if (PHM(16)) ln_phase(p, layer, (const float*)(ws + OFF_PH + SZ1), layer < 3 ? (ushort_t*)(ws + OFF_Y) : (ushort_t*)nullptr, dry); break;
    }
  }
}

#define LAS __attribute__((address_space(3)))
#define XB_TMO      128
#define XB_XCNT(j)  (256  + 64 * (j))
#define XB_XSUB(j)  (1280 + 64 * (j))
#define XB_XGEN(j)  (2304 + 64 * (j))
#define XB_TOP      3328
#define XB_TOPGEN   3392
#define XCD_BAR_WORDS 3456
#define XB_SPIN_CAP (1u << 18)
#define LAS __attribute__((address_space(3)))

__device__ __forceinline__ unsigned xb_ld(unsigned* p)              { return __hip_atomic_load(p, __ATOMIC_RELAXED, __HIP_MEMORY_SCOPE_AGENT); }
__device__ __forceinline__ unsigned xb_add(unsigned* p, unsigned v) { return __hip_atomic_fetch_add(p, v, __ATOMIC_RELAXED, __HIP_MEMORY_SCOPE_AGENT); }
__device__ __forceinline__ unsigned xb_xcc_id() { return (unsigned)__builtin_amdgcn_s_getreg((3 << 11) | 20) & 0xFu; }
#define XB_SPIN(cond, bar) do { unsigned _sp = 0; while (cond) { __builtin_amdgcn_s_sleep(1); \
    if ((++_sp & 255u) == 0u) { if (xb_ld(&(bar)[XB_TMO])) break; if (_sp > XB_SPIN_CAP) { atomicAdd(&(bar)[XB_TMO], 1u); break; } } } } while (0)

struct XcdBarrier {
    unsigned* bar; unsigned x;
    volatile LAS unsigned* st;
};

__device__ __forceinline__ XcdBarrier xcd_barrier_post(unsigned* bar, volatile LAS unsigned* st) {
    XcdBarrier b; b.bar = bar; b.x = xb_xcc_id(); b.st = st;
    if (threadIdx.x == 0) (void)xb_add(&bar[XB_XCNT(b.x)], 1u);
    return b;
}
__device__ __forceinline__ void xcd_barrier_complete(unsigned* bar, unsigned x, unsigned& nloc, unsigned& nx) {
    const unsigned G = gridDim.x * gridDim.y * gridDim.z;
    unsigned sum, cnt, mine, sp = 0u;
    for (;;) {
        sum = 0u; cnt = 0u; mine = 0u;
#pragma unroll
        for (unsigned j = 0; j < 16; ++j) { const unsigned c = xb_ld(&bar[XB_XCNT(j)]); sum += c; cnt += (c > 0u) ? 1u : 0u; mine = (j == x) ? c : mine; }
        if (sum == G) break;
        __builtin_amdgcn_s_sleep(1);
        if ((++sp & 255u) == 0u) { if (xb_ld(&bar[XB_TMO])) break; if (sp > XB_SPIN_CAP) { atomicAdd(&bar[XB_TMO], 1u); break; } }
    }
    nloc = mine > 0u ? mine : 1u; nx = cnt > 0u ? cnt : 1u;
}

__device__ __forceinline__ void xcd_barrier(const XcdBarrier& b) {
    asm volatile("s_waitcnt vmcnt(0)" ::: "memory");
    __syncthreads();
    if (threadIdx.x == 0) {
        unsigned* bar = b.bar;
        __builtin_amdgcn_s_waitcnt(0);
        unsigned nloc = b.st[0], nx = b.st[1];
        if (nloc == 0u) { xcd_barrier_complete(bar, b.x, nloc, nx); b.st[0] = nloc; b.st[1] = nx; }
        const unsigned old = xb_add(&bar[XB_XSUB(b.x)], 1u);
        const unsigned gen = old / nloc;
        if (old + 1u == (gen + 1u) * nloc) {
            __builtin_amdgcn_fence(__ATOMIC_RELEASE, "agent");
            asm volatile("s_waitcnt vmcnt(0)" ::: "memory");
            const unsigned og = xb_add(&bar[XB_TOP], 1u);
            const unsigned tg = og / nx;
            if (og + 1u == (tg + 1u) * nx) xb_add(&bar[XB_TOPGEN], 1u);
            else XB_SPIN(xb_ld(&bar[XB_TOPGEN]) == tg, bar);
            __builtin_amdgcn_fence(__ATOMIC_ACQUIRE, "agent");
            xb_add(&bar[XB_XGEN(b.x)], 1u);
            asm volatile("s_waitcnt vmcnt(0)" ::: "memory");
        } else {
            XB_SPIN(xb_ld(&bar[XB_XGEN(b.x)]) == gen, bar);
            __builtin_amdgcn_fence(__ATOMIC_ACQUIRE, "agent");
            asm volatile("s_waitcnt vmcnt(0)" ::: "memory");
        }
    }
    __syncthreads();
}


#if ONE_LAUNCH
__global__ void __launch_bounds__(NT) fwd_kernel(Params p) {
  extern __shared__ __attribute__((aligned(16))) unsigned char lds[];
#if ONE_LAUNCH
  cg::grid_group grid = cg::this_grid();
#endif
#if ONE_LAUNCH
  volatile LAS unsigned* xb_st = (volatile LAS unsigned*)(lds + LDS_BYTES - 16);
  if (threadIdx.x < 2) xb_st[threadIdx.x] = 0u;
  __syncthreads();
  const XcdBarrier xb = xcd_barrier_post((unsigned*)(p.ws + OFF_BAR), xb_st);
#endif
  for (int ph = p.ph_lo; ph < p.ph_hi; ++ph) {
#if PROBE_MASK
    {
      const int lyr = ph < NPH_EVEN ? 0 : ph < NPH_EVEN + NPH_ODD ? 1 : ph < 2 * NPH_EVEN + NPH_ODD ? 2 : 3;
      const int bs = lyr == 0 ? 0 : lyr == 1 ? NPH_EVEN : lyr == 2 ? NPH_EVEN + NPH_ODD : 2 * NPH_EVEN + NPH_ODD;
      const int idx = (lyr & 1) ? NPH_EVEN + (ph - bs) : (ph - bs);
      if ((PROBE_MASK >> idx) & 1) { run_phase(p, ph, lds, true); grid.sync(); }
    }
#endif
    run_phase(p, ph, lds);
#if ONE_LAUNCH
    if (ph + 1 < p.ph_hi) { if (ph == p.ph_lo) grid.sync(); else xcd_barrier(xb); }
#endif
  }
}
#endif

#if !ONE_LAUNCH
template <int PH> __global__ void __launch_bounds__(NT) phase_kernel(Params p) {
  extern __shared__ __attribute__((aligned(16))) unsigned char lds[];
  run_phase(p, PH, lds);
}
typedef void (*kfn_t)(Params);
#define PK(n) phase_kernel<n>
static kfn_t k_tab[NPHASES] = {PK(0), PK(1), PK(2), PK(3), PK(4), PK(5), PK(6), PK(7), PK(8), PK(9), PK(10), PK(11), PK(12), PK(13), PK(14), PK(15),
                               PK(16), PK(17), PK(18), PK(19), PK(20), PK(21), PK(22), PK(23), PK(24), PK(25), PK(26), PK(27), PK(28), PK(29), PK(30), PK(31), PK(32), PK(33)};
#endif

extern "C" void kernel_launch(void* const* d_in, const int* in_sizes, int n_in, void* d_out, int out_size, void* d_ws, size_t ws_size,
                              hipStream_t stream) {
  static int grid_blocks = 0;
  if (!grid_blocks) {
    if (n_in != 38 || ws_size < WS_NEED || out_size != T * 1024) {
      fprintf(stderr, "kernel_launch: unexpected shapes n_in=%d ws=%zu out=%d\n", n_in, ws_size, out_size);
      grid_blocks = -1; return;
    }
    int dev = 0, cus = 0, per_cu = 0;
    (void)hipGetDevice(&dev);
    (void)hipDeviceGetAttribute(&cus, hipDeviceAttributeMultiprocessorCount, dev);
#if ONE_LAUNCH
    if (hipFuncSetAttribute((const void*)fwd_kernel, hipFuncAttributeMaxDynamicSharedMemorySize, LDS_BYTES) != hipSuccess) {
      fprintf(stderr, "kernel_launch: hipFuncSetAttribute failed\n"); grid_blocks = -1; return;
    }
    (void)hipOccupancyMaxActiveBlocksPerMultiprocessor(&per_cu, (const void*)fwd_kernel, NT, LDS_BYTES);
#else
    for (int ph = 0; ph < NPHASES; ++ph)
      if (hipFuncSetAttribute((const void*)k_tab[ph], hipFuncAttributeMaxDynamicSharedMemorySize, LDS_BYTES) != hipSuccess) {
        fprintf(stderr, "kernel_launch: hipFuncSetAttribute failed\n"); grid_blocks = -1; return;
      }
    per_cu = 1;
#endif
    if (per_cu < 1) { fprintf(stderr, "kernel_launch: occupancy query returned %d\n", per_cu); per_cu = 1; }
    grid_blocks = cus * per_cu;
    if (grid_blocks > 256) grid_blocks = 256;
    if (grid_blocks < 1) grid_blocks = 256;
  }
  if (grid_blocks < 0) return;
  Params p{};
  for (int k = 0; k < 38; ++k) p.in[k] = (const float*)d_in[k];
  p.out = (float*)d_out; p.ws = (unsigned char*)d_ws;
#if ONE_LAUNCH
  if (hipMemsetAsync((unsigned char*)d_ws + OFF_BAR, 0, 16384, stream) != hipSuccess) { fprintf(stderr, "kernel_launch: memset of barrier words failed\n"); return; }
  p.ph_lo = 0; p.ph_hi = NPHASES;
  void* args[] = {&p};
  hipError_t e = hipLaunchCooperativeKernel((const void*)fwd_kernel, dim3(grid_blocks), dim3(NT), args, LDS_BYTES, stream);
  if (e != hipSuccess) fprintf(stderr, "cooperative launch failed: %s (grid %d)\n", hipGetErrorString(e), grid_blocks);
#else
  for (int ph = 0; ph < NPHASES; ++ph) {
    p.ph_lo = ph; p.ph_hi = ph + 1;
    hipLaunchKernelGGL(k_tab[ph], dim3(grid_blocks), dim3(NT), LDS_BYTES, stream, p);
  }
#endif
}
```

```cpp
#include <hip/hip_runtime.h>
#include <hip/hip_cooperative_groups.h>
#include <cstdio>
#include <cstdint>
namespace cg = cooperative_groups;

#ifndef ONE_LAUNCH
#define ONE_LAUNCH 1
#endif

#define DEVI __device__ __forceinline__
constexpr int NT = 512;
constexpr int T = 49152;
constexpr int TPROMPT = 16384;
constexpr int LDS_BYTES = 133120;
constexpr int NPH_EVEN = 11, NPH_ODD = 6;
constexpr int NPHASES = 2 * (NPH_EVEN + NPH_ODD);

typedef __attribute__((ext_vector_type(8))) short bf16x8;
typedef __attribute__((ext_vector_type(4))) float f32x4;
typedef unsigned short ushort_t;
typedef float f32x2 __attribute__((ext_vector_type(2)));

struct Params { const float* in[38]; float* out; unsigned char* ws; int ph_lo; int ph_hi; };

enum { I_XP = 0, I_XS, I_EWIN, I_EWOUT, I_LRE, I_LIM, I_LSTEP, I_BRE, I_BIM, I_CRE, I_CIM, I_S5D, I_GLUW, I_GLUB,
       I_MURKV, I_MULORA, I_W0, I_WUP, I_A0, I_AUP, I_KK, I_KA, I_RK, I_LNXW, I_LNXB,
       I_HWIN, I_HWOUT, I_HSW, I_HSB, I_FW1, I_FB1, I_FFREQ, I_FW2, I_FB2, I_FW3, I_FBIAS, I_LNG, I_LNB };

constexpr size_t SZ1 = (size_t)T * 1024 * 2;
constexpr size_t OFF_PS5 = 0;
constexpr size_t OFF_PRW = OFF_PS5 + SZ1;
constexpr size_t OFF_Y = OFF_PRW + (size_t)T * 2112 * 2;
constexpr size_t OFF_YS = OFF_Y + SZ1;
constexpr size_t OFF_WB = OFF_YS + SZ1;
constexpr size_t OFF_CAR = OFF_WB + 10485760;
constexpr size_t OFF_BAR = OFF_CAR + 6291456;
constexpr size_t WS_NEED = OFF_BAR + 16384;
constexpr size_t OFF_PH = 0;
constexpr size_t OFF_GS = 4 * SZ1;
constexpr size_t GS_PER = 131328;
constexpr size_t OFF_Z1 = OFF_GS + 256 * 2 * GS_PER;
constexpr size_t OFF_XB_ODD = 4 * SZ1;
constexpr size_t OFF_H2 = OFF_XB_ODD + SZ1;

DEVI int tidx() { int t = threadIdx.x; asm volatile("" : "+v"(t)); return t; }
DEVI int bidx() { int b = blockIdx.x; asm volatile("" : "+r"(b)); return __builtin_amdgcn_readfirstlane(b); }
DEVI ushort_t f2bf(float f) { unsigned u = __float_as_uint(f); u += 0x7fffu + ((u >> 16) & 1u); return (ushort_t)(u >> 16); }
DEVI float bf2f(ushort_t h) { return __uint_as_float(((unsigned)h) << 16); }
DEVI unsigned pack2(float a, float b) { return (unsigned)f2bf(a) | ((unsigned)f2bf(b) << 16); }
DEVI float wsum(float v) {
#pragma unroll
  for (int m = 32; m >= 1; m >>= 1) v += __shfl_xor(v, m);
  return v;
}
DEVI void wave_sync() { __builtin_amdgcn_fence(__ATOMIC_RELEASE, "wavefront"); __builtin_amdgcn_wave_barrier(); __builtin_amdgcn_fence(__ATOMIC_ACQUIRE, "wavefront"); }
DEVI void seq_of(int tok, int& s0, int& L) {
  if (tok < TPROMPT) { s0 = tok & ~4095; L = 4096; } else { s0 = TPROMPT + ((tok - TPROMPT) & ~16383); L = 16384; }
}
struct XSrc { const float* xp; const float* xs; const float* xo; };
DEVI XSrc xsrc(const Params& p) {
  XSrc x; x.xp = p.in[I_XP]; x.xs = p.in[I_XS]; x.xo = p.out;
  asm volatile("" : "+r"(x.xp), "+r"(x.xs), "+r"(x.xo));
  return x;
}
DEVI const float* xrow(const XSrc& x, int layer, int tok) {
  if (layer == 0) return tok < TPROMPT ? x.xp + (size_t)tok * 1024 : x.xs + (size_t)(tok - TPROMPT) * 1024;
  return x.xo + (size_t)tok * 1024;
}
DEVI float sigmoidf_(float x) { return 1.f / (1.f + expf(-x)); }
DEVI float fast_sigmoid(float x) { return __builtin_amdgcn_rcpf(1.f + __builtin_amdgcn_exp2f(-1.4426950408889634f * x)); }
DEVI float fast_tanh(float x) { return 1.f - 2.f * __builtin_amdgcn_rcpf(1.f + __builtin_amdgcn_exp2f(2.8853900817779268f * x)); }
DEVI float dpp_mov_f(float x, const int sel) {
  int xi = __builtin_bit_cast(int, x), r;
  if (sel == 0) r = __builtin_amdgcn_mov_dpp(xi, 0xB1, 0xf, 0xf, true);
  else if (sel == 1) r = __builtin_amdgcn_mov_dpp(xi, 0x4E, 0xf, 0xf, true);
  else if (sel == 2) r = __builtin_amdgcn_mov_dpp(xi, 0x141, 0xf, 0xf, true);
  else r = __builtin_amdgcn_mov_dpp(xi, 0x140, 0xf, 0xf, true);
  return __builtin_bit_cast(float, r);
}
DEVI float wsum_fast(float v) {
  v += dpp_mov_f(v, 0); v += dpp_mov_f(v, 1); v += dpp_mov_f(v, 2); v += dpp_mov_f(v, 3);
  const int vi = __builtin_bit_cast(int, v);
  return __builtin_bit_cast(float, __builtin_amdgcn_readlane(vi, 0)) + __builtin_bit_cast(float, __builtin_amdgcn_readlane(vi, 16)) +
         __builtin_bit_cast(float, __builtin_amdgcn_readlane(vi, 32)) + __builtin_bit_cast(float, __builtin_amdgcn_readlane(vi, 48));
}
DEVI float gelu_tanh(float x) { return 0.5f * x * (1.f + tanhf(0.7978845608f * (x + 0.044715f * x * x * x))); }

__device__ void transpose_bf16(const float* __restrict__ in, ushort_t* __restrict__ out, int K, int N, unsigned char* lds) {
  float* tile = (float*)lds;
  const int tid = tidx(), j = tid & 63, i0 = tid >> 6;
  const int tk = K / 64, tn = N / 64;
  for (int t = bidx(); t < tk * tn; t += gridDim.x) {
    const int k0 = (t / tn) * 64, n0 = (t % tn) * 64;
#pragma unroll
    for (int e = 0; e < 8; ++e) { int i = i0 + 8 * e; tile[i * 65 + j] = in[(size_t)(k0 + i) * N + n0 + j]; }
    __syncthreads();
#pragma unroll
    for (int e = 0; e < 8; ++e) { int i = i0 + 8 * e; out[(size_t)(n0 + i) * K + k0 + j] = f2bf(tile[j * 65 + i]); }
    __syncthreads();
  }
}

namespace pg8 {
#define PG8_LAS __attribute__((address_space(3)))
typedef unsigned u32x4 __attribute__((ext_vector_type(4)));
constexpr int BM = 256, BK = 64, HALF = 128, HTB = HALF * BK * 2, STAGE_BYTES = 8 * HTB, NXCD = 8, WGM = 8;
DEVI int lds_byte(int r, int c) { const int st = (r >> 4) * 2 + (c >> 5), rr = r & 15, cc = c & 31, ob = rr * 64 + cc * 2; return st * 1024 + (ob ^ (((ob >> 9) & 1) << 5)); }
DEVI void stage_rc(int b, int& R, int& C) { const int st = b / 1024, sb = b % 1024, swz = sb ^ (((sb >> 9) & 1) << 5); R = (st >> 1) * 16 + swz / 64; C = (st & 1) * 32 + (swz % 64) / 2; }
DEVI int perm32(int rho) { const int n = rho >> 4, i = rho & 15; return 8 * (i >> 2) + 4 * n + (i & 3); }
struct Unit { int pm, pn; };
struct Gemm { const ushort_t* A; const ushort_t* Bt; int M, N, K, lda; };
struct StaticOrder {
  int nM, nN, nwg, G, c;
  DEVI void init(int M, int N, int G_, int c_) { nM = M / BM; nN = N / BM; nwg = nM * nN; G = G_; c = c_; }
  DEVI bool next(int i, Unit& u) const {
    const long L = (long)i * G + c; if (L >= nwg) return false;
    int wgid = (int)L; { const int q = nwg / NXCD, r = nwg % NXCD, xcd = wgid % NXCD, off = wgid / NXCD; wgid = (xcd < r ? xcd * (q + 1) : r * (q + 1) + (xcd - r) * q) + off; }
    const int nig = WGM * nN, gid = wgid / nig, fm = gid * WGM, gsz = (nM - fm) < WGM ? (nM - fm) : WGM;
    u.pm = fm + ((wgid % nig) % gsz); u.pn = (wgid % nig) / gsz; return true;
  }
};
DEVI unsigned cvt_pk_bf16(float lo, float hi) { unsigned r; asm volatile("v_cvt_pk_bf16_f32 %0, %1, %2" : "=v"(r) : "v"(lo), "v"(hi)); return r; }

template <class Epi>
DEVI void gemm_phase(PG8_LAS unsigned char* lds, const Gemm g, const StaticOrder& S, const Epi& E) {
  const int tid = tidx(), wid = __builtin_amdgcn_readfirstlane(tid >> 6), lane = tid & 63, wr = wid >> 2, wc = wid & 3, fr = lane & 15, fq = lane >> 4;
  const int K = g.K, nt = K / BK, lda = g.lda;
  unsigned voffA[2], voffB[2];
#pragma unroll
  for (int i = 0; i < 2; ++i) { int R, C; stage_rc(tid * 16 + i * 8192, R, C); const int Rb = Epi::PERM ? ((R & ~31) + perm32(R & 31)) : R;
    voffA[i] = (unsigned)(R * lda + C) * 2u; voffB[i] = (unsigned)(Rb * K + C) * 2u; }
  const size_t kstep = (size_t)(BK * 2);
  const size_t hstepA = (size_t)HALF * lda * 2, hstepB = (size_t)HALF * K * 2;
  const size_t tstepA = 2 * hstepA, tstepB = 2 * hstepB;
  const unsigned ldsw = (unsigned)wid * 1024u;
  const int aoff = lds_byte(wr * 64 + fr, fq * 8), boff = lds_byte(wc * 32 + fr, fq * 8);
#define PG8_SA(b, h) (((b) * 2 + (h)) * HTB)
#define PG8_SB(b, h) ((4 + (b) * 2 + (h)) * HTB)
#define PG8_STAGE(bufoff, gbase, voff) do { _Pragma("unroll") for (int _i = 0; _i < 2; ++_i) \
    __builtin_amdgcn_global_load_lds((const unsigned*)((const char*)(gbase) + (voff)[_i]), (PG8_LAS unsigned*)(lds + (bufoff) + ldsw + _i * 8192), 16, 0, 0); } while (0)
#define PG8_LDA(dst, b, h) do { _Pragma("unroll") for (int m = 0; m < 4; ++m) _Pragma("unroll") for (int k = 0; k < 2; ++k) dst[m][k] = *(const PG8_LAS bf16x8*)(lds + PG8_SA(b, h) + aoff + m * 2048 + k * 1024); } while (0)
#define PG8_LDB(dst, b, h) do { _Pragma("unroll") for (int n = 0; n < 2; ++n) _Pragma("unroll") for (int k = 0; k < 2; ++k) dst[n][k] = *(const PG8_LAS bf16x8*)(lds + PG8_SB(b, h) + boff + n * 2048 + k * 1024); } while (0)
#define PG8_MMA(ai, bj, At, Bt) do { __builtin_amdgcn_s_setprio(1); _Pragma("unroll") for (int m = 0; m < 4; ++m) _Pragma("unroll") for (int n = 0; n < 2; ++n) _Pragma("unroll") for (int k = 0; k < 2; ++k) \
    acc[ai][bj][m][n] = Epi::TRANS ? __builtin_amdgcn_mfma_f32_16x16x32_bf16(Bt[n][k], At[m][k], acc[ai][bj][m][n], 0, 0, 0) \
                                   : __builtin_amdgcn_mfma_f32_16x16x32_bf16(At[m][k], Bt[n][k], acc[ai][bj][m][n], 0, 0, 0); __builtin_amdgcn_s_setprio(0); } while (0)
#define PG8_WAIT_V(n) asm volatile("s_waitcnt vmcnt(" #n ")" ::: "memory")
#define PG8_WAIT_L(n) asm volatile("s_waitcnt lgkmcnt(" #n ")" ::: "memory")
#define PG8_BAR __builtin_amdgcn_s_barrier()
#define PG8_SCHED __builtin_amdgcn_sched_barrier(0)
  Unit cur, nxt; int ui = 0;
  if (!S.next(0, cur)) return;
  f32x4 acc[2][2][4][2];
#pragma unroll
  for (int a = 0; a < 2; ++a)
#pragma unroll
    for (int b = 0; b < 2; ++b)
#pragma unroll
      for (int m = 0; m < 4; ++m)
#pragma unroll
        for (int n = 0; n < 2; ++n) acc[a][b][m][n] = (f32x4){0.f, 0.f, 0.f, 0.f};
  bf16x8 At[4][2], B0[2][2], B1[2][2];
  const char* cA = (const char*)g.A + (size_t)cur.pm * tstepA; const char* cB = (const char*)g.Bt + (size_t)cur.pn * tstepB;
  PG8_STAGE(PG8_SB(0, 0), cB, voffB); PG8_STAGE(PG8_SA(0, 0), cA, voffA); PG8_STAGE(PG8_SB(0, 1), cB + hstepB, voffB); PG8_STAGE(PG8_SA(0, 1), cA + hstepA, voffA);
  if (wr == 1) PG8_BAR;
  PG8_WAIT_V(4); PG8_BAR;
  PG8_STAGE(PG8_SB(1, 0), cB + kstep, voffB); PG8_STAGE(PG8_SA(1, 0), cA + kstep, voffA); PG8_STAGE(PG8_SB(1, 1), cB + hstepB + kstep, voffB);
  PG8_WAIT_V(6); PG8_BAR;
  for (;;) {
    const bool has_next = S.next(ui + 1, nxt);
    const char* nA = has_next ? (const char*)g.A + (size_t)nxt.pm * tstepA : cA; const char* nB = has_next ? (const char*)g.Bt + (size_t)nxt.pn * tstepB : cB;
    for (int t = 0; t < nt; t += 2) {
      const bool last = (t == nt - 2);
      const char* a1 = cA + (size_t)(t + 1) * kstep;
      const char* a2 = last ? nA : cA + (size_t)(t + 2) * kstep; const char* b2 = last ? nB : cB + (size_t)(t + 2) * kstep;
      const char* a3 = a2 + kstep; const char* b3 = b2 + kstep;
      PG8_LDB(B0, 0, 0); PG8_SCHED; PG8_LDA(At, 0, 0); PG8_STAGE(PG8_SA(1, 1), a1 + hstepA, voffA);
      PG8_WAIT_L(8); PG8_BAR; PG8_WAIT_L(0); PG8_MMA(0, 0, At, B0); PG8_BAR; PG8_SCHED;
      PG8_LDB(B1, 0, 1); PG8_STAGE(PG8_SB(0, 0), b2, voffB);
      PG8_BAR; PG8_WAIT_L(0); PG8_MMA(0, 1, At, B1); PG8_BAR;
      PG8_LDA(At, 0, 1); PG8_STAGE(PG8_SA(0, 0), a2, voffA);
      PG8_BAR; PG8_WAIT_L(0); PG8_MMA(1, 0, At, B0); PG8_BAR; PG8_SCHED;
      PG8_STAGE(PG8_SB(0, 1), b2 + hstepB, voffB);
      PG8_WAIT_V(6); PG8_BAR; PG8_MMA(1, 1, At, B1); PG8_BAR;
      PG8_LDB(B0, 1, 0); PG8_SCHED; PG8_LDA(At, 1, 0); PG8_STAGE(PG8_SA(0, 1), a2 + hstepA, voffA);
      PG8_WAIT_L(8); PG8_BAR; PG8_WAIT_L(0); PG8_MMA(0, 0, At, B0); PG8_BAR; PG8_SCHED;
      PG8_LDB(B1, 1, 1); PG8_STAGE(PG8_SB(1, 0), b3, voffB);
      PG8_BAR; PG8_WAIT_L(0); PG8_MMA(0, 1, At, B1); PG8_BAR;
      PG8_LDA(At, 1, 1); PG8_STAGE(PG8_SA(1, 0), a3, voffA);
      PG8_BAR; PG8_WAIT_L(0); PG8_MMA(1, 0, At, B0); PG8_BAR; PG8_SCHED;
      PG8_STAGE(PG8_SB(1, 1), b3 + hstepB, voffB);
      PG8_WAIT_V(6); PG8_BAR; PG8_MMA(1, 1, At, B1); PG8_BAR;
    }
    E(acc, cur, wr, wc, fr, fq);
    if (!has_next) break;
#pragma unroll
    for (int a = 0; a < 2; ++a)
#pragma unroll
      for (int b = 0; b < 2; ++b)
#pragma unroll
        for (int m = 0; m < 4; ++m)
#pragma unroll
          for (int n = 0; n < 2; ++n) acc[a][b][m][n] = (f32x4){0.f, 0.f, 0.f, 0.f};
    cur = nxt; cA = nA; cB = nB; ++ui;
  }
  PG8_WAIT_V(0);
  if (wr == 0) PG8_BAR;
  PG8_BAR;
#undef PG8_SA
#undef PG8_SB
#undef PG8_STAGE
#undef PG8_LDA
#undef PG8_LDB
#undef PG8_MMA
#undef PG8_WAIT_V
#undef PG8_WAIT_L
#undef PG8_BAR
#undef PG8_SCHED
}

struct EpiEvenIn {
  static constexpr bool PERM = true, TRANS = true;
  ushort_t* ps5; ushort_t* prw;
  DEVI void operator()(const f32x4 (&acc)[2][2][4][2], const Unit& u, int wr, int wc, int fr, int fq) const {
#pragma unroll
    for (int ai = 0; ai < 2; ++ai)
#pragma unroll
      for (int m = 0; m < 4; ++m) {
        const size_t row = (size_t)u.pm * BM + ai * HALF + wr * 64 + m * 16 + fr;
#pragma unroll
        for (int bj = 0; bj < 2; ++bj) {
          const int c0 = u.pn * BM + bj * HALF + wc * 32 + 8 * fq;
          const f32x4 v0 = acc[ai][bj][m][0], v1 = acc[ai][bj][m][1];
          u32x4 o = {cvt_pk_bf16(v0[0], v0[1]), cvt_pk_bf16(v0[2], v0[3]), cvt_pk_bf16(v1[0], v1[1]), cvt_pk_bf16(v1[2], v1[3])};
          if (c0 < 1024) *(u32x4*)(ps5 + row * 1024 + c0) = o;
          else if (c0 < 3136) *(u32x4*)(prw + row * 2112 + (c0 - 1024)) = o;
        }
      }
  }
};
struct EpiHyIn {
  static constexpr bool PERM = false, TRANS = false;
  ushort_t* ph;
  DEVI void operator()(const f32x4 (&acc)[2][2][4][2], const Unit& u, int wr, int wc, int fr, int fq) const {
    int s0, L; seq_of(u.pm * BM, s0, L);
#pragma unroll
    for (int ai = 0; ai < 2; ++ai)
#pragma unroll
      for (int m = 0; m < 4; ++m) {
        const int tok = u.pm * BM + ai * HALF + wr * 64 + m * 16 + 4 * fq;
#pragma unroll
        for (int bj = 0; bj < 2; ++bj)
#pragma unroll
          for (int n = 0; n < 2; ++n) {
            const int col = u.pn * BM + bj * HALF + wc * 32 + 16 * n + fr;
            const int st = col >> 10, c = col & 1023;
            const f32x4 v = acc[ai][bj][m][n];
            ushort_t* dst = ph + (size_t)st * T * 1024 + (size_t)s0 * 1024 + (size_t)c * L + (tok - s0);
            *(uint2*)dst = uint2{cvt_pk_bf16(v[0], v[1]), cvt_pk_bf16(v[2], v[3])};
          }
      }
  }
};
struct EpiGlu {
  static constexpr bool PERM = true, TRANS = true;
  ushort_t* y; const ushort_t* ps5; const float* bias;
  DEVI void operator()(const f32x4 (&acc)[2][2][4][2], const Unit& u, int wr, int wc, int fr, int fq) const {
#pragma unroll
    for (int ai = 0; ai < 2; ++ai)
#pragma unroll
      for (int m = 0; m < 4; ++m) {
        const size_t row = (size_t)u.pm * BM + ai * HALF + wr * 64 + m * 16 + fr;
#pragma unroll
        for (int bj = 0; bj < 2; ++bj) {
          const int c0 = u.pn * BM + bj * HALF + wc * 32 + 8 * fq;
          const u32x4 a8 = *(const u32x4*)(y + row * 1024 + 512 + c0);
          const u32x4 g8 = *(const u32x4*)(ps5 + row * 1024 + 512 + c0);
          const f32x4 b0 = *(const f32x4*)(bias + c0), b1 = *(const f32x4*)(bias + c0 + 4);
          float v[8];
#pragma unroll
          for (int e = 0; e < 4; ++e) { v[e] = acc[ai][bj][m][0][e] + b0[e]; v[4 + e] = acc[ai][bj][m][1][e] + b1[e]; }
          unsigned o[4];
#pragma unroll
          for (int e = 0; e < 4; ++e) {
            const float a_lo = __uint_as_float(a8[e] << 16), a_hi = __uint_as_float(a8[e] & 0xffff0000u);
            const float g_lo = __uint_as_float(g8[e] << 16), g_hi = __uint_as_float(g8[e] & 0xffff0000u);
            const float r_lo = a_lo * sigmoidf_(v[2 * e]) * (g_lo * sigmoidf_(g_lo));
            const float r_hi = a_hi * sigmoidf_(v[2 * e + 1]) * (g_hi * sigmoidf_(g_hi));
            o[e] = cvt_pk_bf16(r_lo, r_hi);
          }
          *(u32x4*)(y + row * 1024 + c0) = u32x4{o[0], o[1], o[2], o[3]};
        }
      }
  }
};
struct EpiF32 {
  static constexpr bool PERM = false, TRANS = true;
  float* C;
  DEVI void operator()(const f32x4 (&acc)[2][2][4][2], const Unit& u, int wr, int wc, int fr, int fq) const {
#pragma unroll
    for (int ai = 0; ai < 2; ++ai)
#pragma unroll
      for (int m = 0; m < 4; ++m) {
        float* rowp = C + ((size_t)u.pm * BM + ai * HALF + wr * 64 + m * 16 + fr) * 1024 + u.pn * BM + wc * 32 + 4 * fq;
#pragma unroll
        for (int bj = 0; bj < 2; ++bj)
#pragma unroll
          for (int n = 0; n < 2; ++n) *(f32x4*)(rowp + bj * HALF + n * 16) = acc[ai][bj][m][n];
      }
  }
};
}

template <class Epi>
DEVI void run_gemm(unsigned char* lds, const ushort_t* A, int lda, const ushort_t* Bt, int N, int K, const Epi& E) {
  pg8::Gemm g; g.A = A; g.Bt = Bt; g.M = T; g.N = N; g.K = K; g.lda = lda;
  pg8::StaticOrder S; S.init(T, N, (int)gridDim.x, bidx());
  __syncthreads();
  pg8::gemm_phase<Epi>((PG8_LAS unsigned char*)lds, g, S, E);
  __syncthreads();
}

__device__ void xb_convert(const Params& p, ushort_t* XB) {
  const size_t n4 = (size_t)T * 1024 / 4, np4 = (size_t)TPROMPT * 1024 / 4;
  const float4* xp = (const float4*)p.in[I_XP]; const float4* xs = (const float4*)p.in[I_XS];
  for (size_t e = (size_t)bidx() * NT + tidx(); e < n4; e += (size_t)gridDim.x * NT) {
    const float4 v = e < np4 ? xp[e] : xs[e - np4];
    ((uint2*)XB)[e] = uint2{pack2(v.x, v.y), pack2(v.z, v.w)};
  }
}
__device__ void zero_fill(ushort_t* dst, size_t n) {
  for (size_t e = (size_t)bidx() * NT + tidx(); e < n / 8; e += (size_t)gridDim.x * NT) ((uint4*)dst)[e] = uint4{0, 0, 0, 0};
}
__device__ void hy_transpose(const ushort_t* __restrict__ PH3, ushort_t* __restrict__ Y, unsigned char* lds) {
  ushort_t* tile = (ushort_t*)lds;
  const int tid = tidx(), r = tid >> 3, c8 = (tid & 7) * 8;
  for (int t = bidx(); t < (T / 64) * 16; t += gridDim.x) {
    const int tok0 = (t >> 4) * 64, c0 = (t & 15) * 64;
    int s0, L; seq_of(tok0, s0, L);
    const uint4 v = *(const uint4*)(PH3 + (size_t)s0 * 1024 + (size_t)(c0 + r) * L + (tok0 - s0) + c8);
    __syncthreads();
    *(uint4*)(tile + r * 72 + c8) = v;
    __syncthreads();
    unsigned o[4];
#pragma unroll
    for (int e = 0; e < 4; ++e) o[e] = (unsigned)tile[(c8 + 2 * e) * 72 + r] | ((unsigned)tile[(c8 + 2 * e + 1) * 72 + r] << 16);
    *(uint4*)(Y + (size_t)(tok0 + r) * 1024 + c0 + c8) = uint4{o[0], o[1], o[2], o[3]};
  }
}

__device__ void ln_phase(const Params& p, int layer, const float* __restrict__ F, ushort_t* __restrict__ XB, bool dry = false) {
  const int lane = tidx() & 63, gw = bidx() * (NT / 64) + (tidx() >> 6), nw = gridDim.x * (NT / 64);
  const float alpha = 1.681792830507429f;
  const float4* g4 = (const float4*)(p.in[I_LNG] + layer * 1024);
  const float4* b4 = (const float4*)(p.in[I_LNB] + layer * 1024);
  const XSrc xs_ = xsrc(p);
  for (int row0 = gw; row0 < T / 2; row0 += nw) {
    float4 v[2][4];
#pragma unroll
    for (int h = 0; h < 2; ++h) {
      const int row = row0 + h * (T / 2);
      const float4* x4 = (const float4*)xrow(xs_, layer, row);
      const float4* f4 = (const float4*)(F + (size_t)row * 1024);
#pragma unroll
      for (int e = 0; e < 4; ++e) {
        const float4 a = x4[lane + 64 * e], f = f4[lane + 64 * e];
        v[h][e] = float4{alpha * a.x + f.x, alpha * a.y + f.y, alpha * a.z + f.z, alpha * a.w + f.w};
      }
    }
#pragma unroll
    for (int h = 0; h < 2; ++h) {
      const int row = row0 + h * (T / 2);
      float s = 0.f;
#pragma unroll
      for (int e = 0; e < 4; ++e) s += v[h][e].x + v[h][e].y + v[h][e].z + v[h][e].w;
      const float mean = wsum(s) * (1.f / 1024.f);
      float q = 0.f;
#pragma unroll
      for (int e = 0; e < 4; ++e) {
        v[h][e].x -= mean; v[h][e].y -= mean; v[h][e].z -= mean; v[h][e].w -= mean;
        q += v[h][e].x * v[h][e].x + v[h][e].y * v[h][e].y + v[h][e].z * v[h][e].z + v[h][e].w * v[h][e].w;
      }
      const float rs = rsqrtf(wsum(q) * (1.f / 1024.f) + 1e-5f);
      float4* o4 = (float4*)(p.out + (size_t)row * 1024);
#pragma unroll
      for (int e = 0; e < 4; ++e) {
        const float4 g = g4[lane + 64 * e], b = b4[lane + 64 * e];
        const float4 o = float4{v[h][e].x * rs * g.x + b.x, v[h][e].y * rs * g.y + b.y, v[h][e].z * rs * g.z + b.z, v[h][e].w * rs * g.w + b.w};
        if (!dry) o4[lane + 64 * e] = o;
        if (XB) ((uint2*)(XB + (size_t)row * 1024))[lane + 64 * e] = uint2{pack2(o.x, o.y), pack2(o.z, o.w)};
      }
    }
  }
}

struct cplx { float x, y; };
DEVI cplx cmul(cplx a, cplx b) { return cplx{a.x * b.x - a.y * b.y, a.x * b.y + a.y * b.x}; }
DEVI void s5_consts(const Params& p, int i, int d, int g, int n, cplx& lb, cplx& coef) {
  const int idx = ((i * 2 + d) * 32 + g) * 64 + n;
  const float lre = p.in[I_LRE][idx], lim = p.in[I_LIM][idx];
  const float dt = expf(p.in[I_LSTEP][(i * 2 + d) * 32 + g]);
  const float mag = expf(lre * dt);
  float sn, cs; sincosf(lim * dt, &sn, &cs);
  lb = cplx{mag * cs, mag * sn};
  const float nr = lb.x - 1.f, ni = lb.y, den = 1.f / (lre * lre + lim * lim);
  coef = cplx{(nr * lre + ni * lim) * den, (ni * lre - nr * lim) * den};
}
DEVI void s5_load_u(const ushort_t* PS5, int tok0, int g, int lane, uint4& a, uint4& b) {
  const uint4* src = (const uint4*)(PS5 + (size_t)(tok0 + lane) * 1024 + g * 16);
  a = src[0]; b = src[1];
}
DEVI void s5_store_u(float* U, int lane, const uint4& a, const uint4& b) {
  float4* d = (float4*)(U + lane * 16);
  d[0] = float4{__uint_as_float(a.x << 16), __uint_as_float(a.x & 0xffff0000u), __uint_as_float(a.y << 16), __uint_as_float(a.y & 0xffff0000u)};
  d[1] = float4{__uint_as_float(a.z << 16), __uint_as_float(a.z & 0xffff0000u), __uint_as_float(a.w << 16), __uint_as_float(a.w & 0xffff0000u)};
  d[2] = float4{__uint_as_float(b.x << 16), __uint_as_float(b.x & 0xffff0000u), __uint_as_float(b.y << 16), __uint_as_float(b.y & 0xffff0000u)};
  d[3] = float4{__uint_as_float(b.z << 16), __uint_as_float(b.z & 0xffff0000u), __uint_as_float(b.w << 16), __uint_as_float(b.w & 0xffff0000u)};
}
DEVI f32x2 cmul2(f32x2 a, f32x2 b) { return f32x2{a.x, a.x} * b + f32x2{a.y, a.y} * f32x2{-b.y, b.x}; }
#define S5_BU2(Urow, acc2)                                                            \
  {                                                                                   \
    const float4* u4 = (const float4*)(Urow);                                         \
    _Pragma("unroll") for (int pp = 0; pp < 4; ++pp) {                                \
      const float4 u = u4[pp];                                                        \
      acc2 = B2[4 * pp] * f32x2{u.x, u.x} + acc2; acc2 = B2[4 * pp + 1] * f32x2{u.y, u.y} + acc2; \
      acc2 = B2[4 * pp + 2] * f32x2{u.z, u.z} + acc2; acc2 = B2[4 * pp + 3] * f32x2{u.w, u.w} + acc2; \
    }                                                                                 \
  }

__device__ void s5_passA(const Params& p, int i, unsigned char* lds) {
  const ushort_t* PS5 = (const ushort_t*)(p.ws + OFF_PS5);
  cplx* CAR = (cplx*)(p.ws + OFF_CAR);
  const int lane = tidx() & 63, wave = tidx() >> 6;
  float* U = (float*)(lds + wave * 8448);
  for (int item = bidx() * 8 + wave; item < 192 * 32; item += gridDim.x * 8) {
    const int q = item >> 5, g = item & 31;
    cplx lb0, c0, lb1, c1;
    s5_consts(p, i, 0, g, lane, lb0, c0);
    s5_consts(p, i, 1, g, lane, lb1, c1);
    const f32x2 l0 = {lb0.x, lb0.y}, l1 = {lb1.x, lb1.y};
    f32x2 B2[16];
#pragma unroll
    for (int pp = 0; pp < 16; ++pp) B2[pp] = f32x2{p.in[I_BRE][((i * 32 + g) * 64 + lane) * 16 + pp], p.in[I_BIM][((i * 32 + g) * 64 + lane) * 16 + pp]};
    f32x2 xf = {0.f, 0.f}, xb = {0.f, 0.f}, pw = {1.f, 0.f};
    uint4 ua, ub;
    s5_load_u(PS5, q * 256, g, lane, ua, ub);
    for (int sb = 0; sb < 4; ++sb) {
      wave_sync();
      s5_store_u(U, lane, ua, ub);
      wave_sync();
      if (sb < 3) s5_load_u(PS5, q * 256 + (sb + 1) * 64, g, lane, ua, ub);
#pragma unroll 4
      for (int t = 0; t < 64; ++t) {
        f32x2 bu = {0.f, 0.f};
        S5_BU2(U + t * 16, bu);
        xf = cmul2(l0, xf) + bu;
        xb = cmul2(pw, bu) + xb;
        pw = cmul2(pw, l1);
      }
    }
    CAR[((size_t)(q * 32 + g) * 2 + 0) * 64 + lane] = cmul(cplx{xf.x, xf.y}, c0);
    CAR[((size_t)(q * 32 + g) * 2 + 1) * 64 + lane] = cmul(cplx{xb.x, xb.y}, c1);
  }
}

__device__ void s5_passC(const Params& p, int i, unsigned char* lds) {
  const ushort_t* PS5 = (const ushort_t*)(p.ws + OFF_PS5);
  const cplx* CAR = (const cplx*)(p.ws + OFF_CAR);
  float* YS = (float*)(p.ws + OFF_YS);
  ushort_t* YG = (ushort_t*)(p.ws + OFF_Y);
  const int lane = tidx() & 63, wave = tidx() >> 6;
  float* U = (float*)(lds + wave * 8448);
  ushort_t* X = (ushort_t*)(lds + wave * 8448 + 4096);
  for (int item = bidx() * 8 + wave; item < 192 * 32; item += gridDim.x * 8) {
    const int q = item >> 5, g = item & 31;
    int cs, ce;
    if (q < 64) { cs = q & ~15; ce = cs + 16; } else { cs = 64 + ((q - 64) & ~63); ce = cs + 64; }
    const int pcol = lane & 15;
    const float dd = p.in[I_S5D][i * 512 + g * 16 + pcol];
    for (int d = 0; d < 2; ++d) {
      cplx lb, coef;
      s5_consts(p, i, d, g, lane, lb, coef);
      const f32x2 l2 = {lb.x, lb.y};
      f32x2 B2[16];
#pragma unroll
      for (int pp = 0; pp < 16; ++pp) {
        const cplx bb = cmul(coef, cplx{p.in[I_BRE][((i * 32 + g) * 64 + lane) * 16 + pp], p.in[I_BIM][((i * 32 + g) * 64 + lane) * 16 + pp]});
        B2[pp] = f32x2{bb.x, bb.y};
      }
      cplx lp = lb;
#pragma unroll
      for (int e = 0; e < 8; ++e) lp = cmul(lp, lp);
      cplx xs{0.f, 0.f};
      if (d == 0) {
#pragma unroll 8
        for (int j = cs; j < q; ++j) { xs = cmul(lp, xs); cplx c = CAR[((size_t)(j * 32 + g) * 2 + 0) * 64 + lane]; xs.x += c.x; xs.y += c.y; } }
      else {
#pragma unroll 8
        for (int j = ce - 1; j > q; --j) { xs = cmul(lp, xs); cplx c = CAR[((size_t)(j * 32 + g) * 2 + 1) * 64 + lane]; xs.x += c.x; xs.y += c.y; } }
      f32x2 x2 = {xs.x, xs.y};
      bf16x8 cf[4];
#pragma unroll
      for (int kk = 0; kk < 4; ++kk) {
        const int n0 = (kk & 1) * 32 + (lane >> 4) * 8;
        const float* src = (kk < 2 ? p.in[I_CRE] : p.in[I_CIM]) + (((size_t)(i * 2 + d) * 32 + g) * 16 + pcol) * 64 + n0;
        const float sg = kk < 2 ? 1.f : -1.f;
#pragma unroll
        for (int j = 0; j < 8; ++j) cf[kk][j] = (short)f2bf(sg * src[j]);
      }
      uint4 ua, ub;
      s5_load_u(PS5, q * 256 + (d ? 3 : 0) * 64, g, lane, ua, ub);
      for (int sbi = 0; sbi < 4; ++sbi) {
        const int sb = d ? 3 - sbi : sbi;
        wave_sync();
        s5_store_u(U, lane, ua, ub);
        wave_sync();
        if (sbi < 3) s5_load_u(PS5, q * 256 + (d ? 2 - sbi : sbi + 1) * 64, g, lane, ua, ub);
        for (int tbi = 0; tbi < 4; ++tbi) {
          const int tb = d ? 3 - tbi : tbi;
          float ysp[4] = {0.f, 0.f, 0.f, 0.f};
          if (d == 1) {
#pragma unroll
            for (int r = 0; r < 4; ++r) ysp[r] = YS[(size_t)(q * 256 + sb * 64 + tb * 16 + (lane >> 4) * 4 + r) * 512 + g * 16 + pcol];
          }
#pragma unroll 4
          for (int tti = 0; tti < 16; ++tti) {
            const int tt = d ? 15 - tti : tti;
            f32x2 acc2 = cmul2(l2, x2);
            S5_BU2(U + (tb * 16 + tt) * 16, acc2);
            x2 = acc2;
            X[tt * 136 + lane] = f2bf(x2.x);
            X[tt * 136 + 64 + lane] = f2bf(x2.y);
          }
          wave_sync();
          f32x4 acc{0.f, 0.f, 0.f, 0.f};
#pragma unroll
          for (int kk = 0; kk < 4; ++kk) {
            bf16x8 a = *(const bf16x8*)(X + (lane & 15) * 136 + kk * 32 + (lane >> 4) * 8);
            acc = __builtin_amdgcn_mfma_f32_16x16x32_bf16(a, cf[kk], acc, 0, 0, 0);
          }
          wave_sync();
#pragma unroll
          for (int r = 0; r < 4; ++r) {
            const int tl = tb * 16 + (lane >> 4) * 4 + r;
            const size_t o = (size_t)(q * 256 + sb * 64 + tl) * 512 + g * 16 + pcol;
            if (d == 0) YS[o] = acc[r] + dd * U[tl * 16 + pcol];
            else {
              const float yv = ysp[r] + acc[r];
              YG[(size_t)(q * 256 + sb * 64 + tl) * 1024 + 512 + g * 16 + pcol] = f2bf(gelu_tanh(yv));
            }
          }
        }
      }
    }
  }
}

struct RwConst { float mur, muk, muv, mul, w0, a0, kk, ka; };
struct RwRow { float r, k, v, l; };
DEVI RwRow rw_load_row(const ushort_t* PRW, int tok, int s0, int L, int h, int lane) {
  RwRow o{0.f, 0.f, 0.f, 0.f};
  if (tok >= s0 && tok < s0 + L) {
    const ushort_t* row = PRW + (size_t)tok * 2112;
    const int cc = h * 64 + lane;
    o.r = bf2f(row[cc]); o.k = bf2f(row[512 + cc]); o.v = bf2f(row[1024 + cc]); o.l = bf2f(row[2048 + lane]);
  }
  return o;
}
DEVI void rw_prologue(const RwRow& rm, const RwRow& rc, const RwRow& rn, int lane, const RwConst& c, const float* WU, const float* AU,
                      float* LT, float* Wd, float* KKd, float* BBd, float* KDd, float* RRd, float* VVd) {
  const float rr = rc.r + c.mur * (0.5f * (rm.r + rn.r) - rc.r);
  const float kx = rc.k + c.muk * (0.5f * (rm.k + rn.k) - rc.k);
  const float vv = rc.v + c.muv * (0.5f * (rm.v + rn.v) - rc.v);
  float ll = rc.l + c.mul * (0.5f * (rm.l + rn.l) - rc.l);
  ll = lane < 32 ? fast_tanh(ll) : ll;
  wave_sync();
  LT[lane] = ll;
  wave_sync();
  float accw = c.w0, acca = c.a0;
#pragma unroll 2
  for (int j = 0; j < 32; j += 4) {
    float4 lw = *(const float4*)(LT + j), la = *(const float4*)(LT + 32 + j);
    accw += lw.x * WU[(j + 0) * 64 + lane] + lw.y * WU[(j + 1) * 64 + lane] + lw.z * WU[(j + 2) * 64 + lane] + lw.w * WU[(j + 3) * 64 + lane];
    acca += la.x * AU[(j + 0) * 64 + lane] + la.y * AU[(j + 1) * 64 + lane] + la.z * AU[(j + 2) * 64 + lane] + la.w * AU[(j + 3) * 64 + lane];
  }
  const float dec = __builtin_amdgcn_exp2f(-0.8750387749145276f * fast_sigmoid(accw));
  const float a = fast_sigmoid(acca);
  const float kkr = kx * c.kk;
  const float ss = wsum_fast(kkr * kkr);
  const float kkn = kkr * __builtin_amdgcn_rsqf(fmaxf(ss, 1e-24f));
  Wd[lane] = dec; KKd[lane] = kkn; BBd[lane] = kkn * a; KDd[lane] = kx * (1.f + (a - 1.f) * c.ka); RRd[lane] = rr; VVd[lane] = vv;
}

template <int NS>
DEVI void rw_prologue_blk(const RwRow* R, int lane, const RwConst& c, const bf16x8* BF, int dir, ushort_t* LTm,
                          float* Wd, float* KKd, float* BBd, float* KDd, float* RRd, float* VVd) {
#pragma unroll
  for (int e = 0; e < NS; ++e) {
    const RwRow& rm = R[e]; const RwRow& rc = R[e + 1]; const RwRow& rn = R[e + 2];
    const float rr = rc.r + c.mur * (0.5f * (rm.r + rn.r) - rc.r);
    const float kx = rc.k + c.muk * (0.5f * (rm.k + rn.k) - rc.k);
    const float vv = rc.v + c.muv * (0.5f * (rm.v + rn.v) - rc.v);
    float ll = rc.l + c.mul * (0.5f * (rm.l + rn.l) - rc.l);
    ll = lane < 32 ? fast_tanh(ll) : ll;
    RRd[e * 64 + lane] = rr; VVd[e * 64 + lane] = vv; KDd[e * 64 + lane] = kx;
    LTm[e * 72 + lane] = f2bf(ll);
  }
  wave_sync();
  {
    const int row = lane & (NS - 1), kq8 = (lane >> 4) * 8;
    const bf16x8 aw = *(const bf16x8*)(LTm + row * 72 + kq8);
    const bf16x8 aa = *(const bf16x8*)(LTm + row * 72 + 32 + kq8);
#pragma unroll
    for (int nt = 0; nt < 4; ++nt) {
      const f32x4 z = {0.f, 0.f, 0.f, 0.f};
      const f32x4 dw = __builtin_amdgcn_mfma_f32_16x16x32_bf16(aw, BF[(dir * 4 + nt) * 64 + lane], z, 0, 0, 0);
      const f32x4 da = __builtin_amdgcn_mfma_f32_16x16x32_bf16(aa, BF[(8 + nt) * 64 + lane], z, 0, 0, 0);
      if ((lane >> 4) < NS / 4) {
#pragma unroll
        for (int r = 0; r < 4; ++r) {
          const int o = ((lane >> 4) * 4 + r) * 64 + nt * 16 + (lane & 15);
          Wd[o] = dw[r]; BBd[o] = da[r];
        }
      }
    }
  }
  wave_sync();
#pragma unroll
  for (int e = 0; e < NS; ++e) {
    const float accw = c.w0 + Wd[e * 64 + lane], acca = c.a0 + BBd[e * 64 + lane], kx = KDd[e * 64 + lane];
    const float dec = __builtin_amdgcn_exp2f(-0.8750387749145276f * fast_sigmoid(accw));
    const float a = fast_sigmoid(acca);
    const float kkr = kx * c.kk;
    const float ss = wsum_fast(kkr * kkr);
    const float kkn = kkr * __builtin_amdgcn_rsqf(fmaxf(ss, 1e-24f));
    Wd[e * 64 + lane] = dec; KKd[e * 64 + lane] = kkn; BBd[e * 64 + lane] = kkn * a; KDd[e * 64 + lane] = kx * (1.f + (a - 1.f) * c.ka);
  }
}
DEVI void rw_fill_bf(const Params& p, int i, int h, bf16x8* BF, int tid) {
  for (int e = tid; e < 768; e += NT) {
    const int which = e >> 8, nt = (e >> 6) & 3, l = e & 63;
    const int n = nt * 16 + (l & 15), k0 = (l >> 4) * 8;
    const float* src = which < 2 ? p.in[I_WUP] + ((size_t)(i * 2 + which) * 32) * 512 : p.in[I_AUP] + ((size_t)i * 32) * 512;
    bf16x8 v;
#pragma unroll
    for (int jj = 0; jj < 8; ++jj) v[jj] = (short)f2bf(src[(size_t)(k0 + jj) * 512 + h * 64 + n]);
    BF[e] = v;
  }
}

DEVI float dpp_f(float x, const int ctrl_sel) {
  int xi = __builtin_bit_cast(int, x), r;
  if (ctrl_sel == 0) r = __builtin_amdgcn_mov_dpp(xi, 0xB1, 0xf, 0xf, true);
  else if (ctrl_sel == 1) r = __builtin_amdgcn_mov_dpp(xi, 0x4E, 0xf, 0xf, true);
  else r = __builtin_amdgcn_mov_dpp(xi, 0x141, 0xf, 0xf, true);
  return __builtin_bit_cast(float, r);
}
DEVI float red8(float x) { x += dpp_f(x, 0); x += dpp_f(x, 1); x += dpp_f(x, 2); return x; }

#define RW_LOAD8(dst2, base)                                                        \
  { const float4 _a = *(const float4*)(base), _b = *(const float4*)((base) + 4);    \
    dst2[0] = f32x2{_a.x, _a.y}; dst2[1] = f32x2{_a.z, _a.w}; dst2[2] = f32x2{_b.x, _b.y}; dst2[3] = f32x2{_b.z, _b.w}; }

__device__ void rwkv_scan1(const Params& p, int i, unsigned char* lds) {
  const ushort_t* PRW = (const ushort_t*)(p.ws + OFF_PRW);
  float* CH = (float*)(p.ws + OFF_PS5);
  float* YR = (float*)(p.ws + OFF_YS);
  const int tid = tidx(), lane = tid & 63, wave = tid >> 6, pair = wave >> 1, role = (wave ^ (wave >> 2)) & 1;
  const int vq = lane >> 3, kq = lane & 7;
  bf16x8* BF = (bf16x8*)lds;
  float* WV = (float*)(lds + 12288 + pair * 14592);
  float* Wd = WV, *KKd = WV + 512, *BBd = WV + 1024, *KDd = WV + 1536, *RRd = WV + 2048, *VVd = WV + 2560;
  ushort_t* LTm = (ushort_t*)(WV + 3072) + role * 576;
  {
    float4* z = (float4*)YR;
    for (size_t e = (size_t)bidx() * NT + tid; e < (size_t)T * 512 / 4; e += (size_t)gridDim.x * NT) z[e] = float4{0.f, 0.f, 0.f, 0.f};
  }
  for (int bi = bidx(); bi < 768; bi += gridDim.x) {
    const int h = bi / 96, rem = bi % 96;
    const int dir = pair >> 1, q = rem * 2 + (pair & 1);
    __syncthreads();
    rw_fill_bf(p, i, h, BF, tid);
    __syncthreads();
    RwConst c;
    const int cc = h * 64 + lane;
    c.mur = p.in[I_MURKV][(i * 3 + 0) * 512 + cc]; c.muk = p.in[I_MURKV][(i * 3 + 1) * 512 + cc]; c.muv = p.in[I_MURKV][(i * 3 + 2) * 512 + cc];
    c.mul = p.in[I_MULORA][i * 64 + lane];
    c.w0 = p.in[I_W0][(i * 2 + dir) * 512 + cc]; c.a0 = p.in[I_A0][(i * 2 + dir) * 512 + cc];
    c.kk = p.in[I_KK][i * 512 + cc]; c.ka = p.in[I_KA][i * 512 + cc];
    const size_t it = ((size_t)(q * 8 + h) * 2 + dir);
    int sq0, sqL; seq_of(q * 256, sq0, sqL);
    float* Op = CH + it * 8192 + (role ? 0 : 4096);
    f32x2 S2[8][4];
    int diag = (role && vq == kq) ? 1 : 0;
    asm volatile("" : "+v"(diag));
#pragma unroll
    for (int r = 0; r < 8; ++r)
#pragma unroll
      for (int jj = 0; jj < 4; ++jj) S2[r][jj] = f32x2{(diag && (2 * jj == r)) ? 1.f : 0.f, (diag && (2 * jj + 1 == r)) ? 1.f : 0.f};
    const float vsel = role ? 0.f : 1.f;
    for (int blk = 0; blk < 32; ++blk) {
      {
        RwRow R[6];
#pragma unroll
        for (int j = 0; j < 6; ++j) {
          const int st = blk * 8 + role * 4 + j - 1;
          R[j] = rw_load_row(PRW, dir ? (q * 256 + 255 - st) : (q * 256 + st), sq0, sqL, h, lane);
        }
        {
          const int s = role * 4;
          rw_prologue_blk<4>(R, lane, c, BF, dir, LTm, Wd + s * 64, KKd + s * 64, BBd + s * 64, KDd + s * 64, RRd + s * 64, VVd + s * 64);
        }
      }
      __syncthreads();
#pragma unroll 2
      for (int s = 0; s < 8; ++s) {
        f32x2 kk2[4], w2[4], b2[4], kd2[4], vv2[4];
        RW_LOAD8(kk2, KKd + s * 64 + 8 * kq);
        RW_LOAD8(vv2, VVd + s * 64 + 8 * vq);
        RW_LOAD8(w2, Wd + s * 64 + 8 * kq);
        RW_LOAD8(b2, BBd + s * 64 + 8 * kq);
        RW_LOAD8(kd2, KDd + s * 64 + 8 * kq);
        float sa[8];
#pragma unroll
        for (int r = 0; r < 8; ++r) {
          f32x2 a = S2[r][0] * kk2[0];
          a = S2[r][1] * kk2[1] + a; a = S2[r][2] * kk2[2] + a; a = S2[r][3] * kk2[3] + a;
          sa[r] = -red8(a.x + a.y);
        }
#pragma unroll
        for (int r = 0; r < 8; ++r) {
          const float vr = ((r & 1) ? vv2[r >> 1].y : vv2[r >> 1].x) * vsel;
          const f32x2 sa2 = f32x2{sa[r], sa[r]}, v2 = f32x2{vr, vr};
#pragma unroll
          for (int jj = 0; jj < 4; ++jj) S2[r][jj] = S2[r][jj] * w2[jj] + sa2 * b2[jj] + v2 * kd2[jj];
        }
      }
      __syncthreads();
    }
#pragma unroll
    for (int r = 0; r < 8; ++r) {
      float* dst = Op + (8 * vq + r) * 64 + 8 * kq;
      *(float4*)dst = float4{S2[r][0].x, S2[r][0].y, S2[r][1].x, S2[r][1].y};
      *(float4*)(dst + 4) = float4{S2[r][2].x, S2[r][2].y, S2[r][3].x, S2[r][3].y};
    }
  }
}

__device__ void rwkv_scan3(const Params& p, int i, unsigned char* lds, bool dry = false) {
  const ushort_t* PRW = (const ushort_t*)(p.ws + OFF_PRW);
  float* CH = (float*)(p.ws + OFF_PS5);
  float* YR = (float*)(p.ws + OFF_YS);
  const int tid = tidx(), lane = tid & 63, wave = tid >> 6;
  const int vq = lane >> 3, kq = lane & 7;
  bf16x8* BF = (bf16x8*)lds;
  float* WV = (float*)(lds + 12288 + wave * 13440);
  float* Wd = WV, *KKd = WV + 512, *BBd = WV + 1024, *KDd = WV + 1536, *RRd = WV + 2048, *VVd = WV + 2560;
  ushort_t* LTm = (ushort_t*)(WV + 3072);
  for (int bi = bidx(); bi < 384; bi += gridDim.x) {
    const int h = bi / 48, cgp = bi % 48;
    const int dir = wave >> 2, q = cgp * 4 + (wave & 3);
    __syncthreads();
    rw_fill_bf(p, i, h, BF, tid);
    __syncthreads();
    RwConst c;
    const int cc = h * 64 + lane;
    c.mur = p.in[I_MURKV][(i * 3 + 0) * 512 + cc]; c.muk = p.in[I_MURKV][(i * 3 + 1) * 512 + cc]; c.muv = p.in[I_MURKV][(i * 3 + 2) * 512 + cc];
    c.mul = p.in[I_MULORA][i * 64 + lane];
    c.w0 = p.in[I_W0][(i * 2 + dir) * 512 + cc]; c.a0 = p.in[I_A0][(i * 2 + dir) * 512 + cc];
    c.kk = p.in[I_KK][i * 512 + cc]; c.ka = p.in[I_KA][i * 512 + cc];
    const size_t it = ((size_t)(q * 8 + h) * 2 + dir);
    int sq0, sqL; seq_of(q * 256, sq0, sqL);
    const float* Qp = CH + it * 8192 + 4096;
    f32x2 S2[8][4];
#pragma unroll
    for (int r = 0; r < 8; ++r) {
      const float* src = Qp + (8 * vq + r) * 64 + 8 * kq;
      const float4 a = *(const float4*)src, b = *(const float4*)(src + 4);
      S2[r][0] = f32x2{a.x, a.y}; S2[r][1] = f32x2{a.z, a.w}; S2[r][2] = f32x2{b.x, b.y}; S2[r][3] = f32x2{b.z, b.w};
    }
    for (int blk = 0; blk < 32; ++blk) {
      {
        RwRow R[10];
#pragma unroll
        for (int j = 0; j < 10; ++j) {
          const int st = blk * 8 + j - 1;
          R[j] = rw_load_row(PRW, dir ? (q * 256 + 255 - st) : (q * 256 + st), sq0, sqL, h, lane);
        }
        rw_prologue_blk<8>(R, lane, c, BF, dir, LTm, Wd, KKd, BBd, KDd, RRd, VVd);
      }
      wave_sync();
#pragma unroll 2
      for (int s = 0; s < 8; ++s) {
        f32x2 kk2[4], w2[4], b2[4], kd2[4], vv2[4], r2[4];
        RW_LOAD8(kk2, KKd + s * 64 + 8 * kq);
        RW_LOAD8(vv2, VVd + s * 64 + 8 * vq);
        RW_LOAD8(w2, Wd + s * 64 + 8 * kq);
        RW_LOAD8(b2, BBd + s * 64 + 8 * kq);
        RW_LOAD8(kd2, KDd + s * 64 + 8 * kq);
        RW_LOAD8(r2, RRd + s * 64 + 8 * kq);
        float sa[8];
#pragma unroll
        for (int r = 0; r < 8; ++r) {
          f32x2 a = S2[r][0] * kk2[0];
          a = S2[r][1] * kk2[1] + a; a = S2[r][2] * kk2[2] + a; a = S2[r][3] * kk2[3] + a;
          sa[r] = -red8(a.x + a.y);
        }
        float ysel = 0.f;
#pragma unroll
        for (int r = 0; r < 8; ++r) {
          const float vr = (r & 1) ? vv2[r >> 1].y : vv2[r >> 1].x;
          const f32x2 sa2 = f32x2{sa[r], sa[r]}, v2 = f32x2{vr, vr};
          f32x2 ya = f32x2{0.f, 0.f};
#pragma unroll
          for (int jj = 0; jj < 4; ++jj) {
            S2[r][jj] = S2[r][jj] * w2[jj] + sa2 * b2[jj] + v2 * kd2[jj];
            ya = S2[r][jj] * r2[jj] + ya;
          }
          const float yr = red8(ya.x + ya.y);
          ysel = (kq == r) ? yr : ysel;
        }
        const int st = blk * 8 + s;
        const int tok = dir ? (q * 256 + 255 - st) : (q * 256 + st);
        if (!dry) atomicAdd(YR + (size_t)tok * 512 + h * 64 + lane, ysel);
      }
      wave_sync();
    }
  }
}

__device__ void rwkv_carry(const Params& p, unsigned char* lds, bool dry = false) {
  float* CH = (float*)(p.ws + OFF_PS5);
  float* Ps = (float*)lds;
  float* Ss = Ps + 4096;
  const int tid = tidx(), v = tid >> 4, ks = (tid & 15) * 4;
  for (int bi = bidx(); bi < 192; bi += gridDim.x) {
    const int half = bi & 1, dir = (bi >> 1) & 1, h = (bi >> 2) & 7, s = bi >> 5;
    int cs, n;
    if (s < 4) { cs = s * 16; n = 16; } else { cs = 64 + (s - 4) * 64; n = 64; }
    float4 cur{0.f, 0.f, 0.f, 0.f};
    float4 pq0, pq1, qv;
    {
      const int q = dir ? (cs + n - 1) : cs;
      const float* Pp = CH + ((size_t)(q * 8 + h) * 2 + dir) * 8192;
      pq0 = ((const float4*)Pp)[tid]; pq1 = ((const float4*)Pp)[tid + 512];
      qv = *(const float4*)(Pp + 4096 + (half * 32 + v) * 64 + ks);
    }
    for (int ci = 0; ci < n; ++ci) {
      const int q = dir ? (cs + n - 1 - ci) : (cs + ci);
      float* Pp = CH + ((size_t)(q * 8 + h) * 2 + dir) * 8192;
      float* Qrow = Pp + 4096 + (half * 32 + v) * 64 + ks;
      __syncthreads();
      if (!dry) *(float4*)Qrow = cur;
      if (ci == n - 1) break;
      *(float4*)(Ss + v * 64 + ks) = cur;
      ((float4*)Ps)[tid] = pq0;
      ((float4*)Ps)[tid + 512] = pq1;
      float4 acc = qv;
      if (ci + 2 < n + 1 && ci + 1 < n) {
        const int qn = dir ? (cs + n - 2 - ci) : (cs + ci + 1);
        const float* Pn = CH + ((size_t)(qn * 8 + h) * 2 + dir) * 8192;
        pq0 = ((const float4*)Pn)[tid]; pq1 = ((const float4*)Pn)[tid + 512];
        qv = *(const float4*)(Pn + 4096 + (half * 32 + v) * 64 + ks);
      }
      __syncthreads();
#pragma unroll 8
      for (int j = 0; j < 64; ++j) {
        const float sv = Ss[v * 64 + j];
        const float4 pr = *(const float4*)(Ps + j * 64 + ks);
        acc.x += sv * pr.x; acc.y += sv * pr.y; acc.z += sv * pr.z; acc.w += sv * pr.w;
      }
      cur = acc;
    }
    __syncthreads();
  }
}

__device__ void rwkv_post(const Params& p, int i) {
  const ushort_t* __restrict__ PRW = (const ushort_t*)(p.ws + OFF_PRW);
  const float* __restrict__ YR = (const float*)(p.ws + OFF_YS);
  ushort_t* __restrict__ Y = (ushort_t*)(p.ws + OFF_Y);
  const int lane = tidx() & 63, gw = bidx() * 8 + (tidx() >> 6), nw = gridDim.x * 8;
  for (int item = gw; item < (T / 4) * 8; item += nw) {
    const int tok0 = (item >> 3) * 4, h = item & 7, cc = h * 64 + lane;
    int s0, L; seq_of(tok0, s0, L);
    float r[6], k[6], v[6], g[4], y[4];
#pragma unroll
    for (int j = 0; j < 6; ++j) {
      const int tok = tok0 - 1 + j;
      r[j] = 0.f; k[j] = 0.f; v[j] = 0.f;
      if (tok >= s0 && tok < s0 + L) {
        const ushort_t* row = PRW + (size_t)tok * 2112;
        r[j] = bf2f(row[cc]); k[j] = bf2f(row[512 + cc]); v[j] = bf2f(row[1024 + cc]);
      }
    }
#pragma unroll
    for (int e = 0; e < 4; ++e) { g[e] = bf2f(PRW[(size_t)(tok0 + e) * 2112 + 1536 + cc]); y[e] = YR[(size_t)(tok0 + e) * 512 + cc]; }
    const float mur = p.in[I_MURKV][(i * 3 + 0) * 512 + cc], muk = p.in[I_MURKV][(i * 3 + 1) * 512 + cc], muv = p.in[I_MURKV][(i * 3 + 2) * 512 + cc];
    const float lw = p.in[I_LNXW][i * 512 + cc], lb = p.in[I_LNXB][i * 512 + cc], rk = p.in[I_RK][i * 512 + cc];
#pragma unroll
    for (int e = 0; e < 4; ++e) {
      const float rr = r[e + 1] + mur * (0.5f * (r[e] + r[e + 2]) - r[e + 1]);
      const float kx = k[e + 1] + muk * (0.5f * (k[e] + k[e + 2]) - k[e + 1]);
      const float vv = v[e + 1] + muv * (0.5f * (v[e] + v[e + 2]) - v[e + 1]);
      const float mean = wsum_fast(y[e]) * (1.f / 64.f);
      const float dlt = y[e] - mean;
      const float var = wsum_fast(dlt * dlt) * (1.f / 64.f);
      const float yn = dlt * __builtin_amdgcn_rsqf(var + 64e-5f) * lw + lb;
      const float bonus = wsum_fast(rr * kx * rk) * vv;
      Y[(size_t)(tok0 + e) * 1024 + 512 + cc] = f2bf((yn + bonus) * (g[e] * fast_sigmoid(g[e])));
    }
  }
}

__device__ void hy_filter_mlp(const Params& p, int i) {
  float* H2 = (float*)(p.ws + OFF_H2);
  const int lane = tidx() & 63, gw = bidx() * 8 + (tidx() >> 6), nw = gridDim.x * 8;
  const float fr = p.in[I_FFREQ][i * 64 + lane], b1 = p.in[I_FB1][i * 64 + lane], b2 = p.in[I_FB2][i * 64 + lane];
  for (int row = gw; row < 20480; row += nw) {
    const int L = row < 4096 ? 4096 : 16384, t = row < 4096 ? row : row - 4096;
    const float w = 6.283185307179586f * (float)t / (float)L;
    float z = 0.f;
    if (lane == 0) z = (float)t / (float)(L - 1);
    else if (lane <= 32) {
      const int bi = (lane - 1) & 15;
      const float f = 1e-4f + (float)bi * ((15.f - 1e-4f) / 15.f);
      z = lane <= 16 ? cosf(f * w) : -sinf(f * w);
    }
    float a = b1;
#pragma unroll 3
    for (int k = 0; k < 33; ++k) a += __shfl(z, k) * p.in[I_FW1][((size_t)i * 33 + k) * 64 + lane];
    const float h1 = sinf(fr * a);
    float c = b2;
#pragma unroll 8
    for (int k = 0; k < 64; ++k) c += __shfl(h1, k) * p.in[I_FW2][((size_t)i * 64 + k) * 64 + lane];
    H2[(row < 4096 ? (size_t)0 : (size_t)4096 * 64) + (size_t)lane * L + t] = sinf(fr * c);
  }
}

DEVI constexpr int swz(int i) { return i ^ ((i & 32) ? 21 : 0) ^ ((i & 64) ? 26 : 0); }
DEVI int swzF(int t) { return (swz(t >> 1) << 1) | (t & 1); }
DEVI f32x2 cmul_pk(f32x2 a, float c, float sn) { return a * f32x2{c, c} + f32x2{-a.y, a.x} * f32x2{sn, sn}; }
template <int LOGN, int NSEQ>
__device__ void fft_dif(float2* buf_) {
  constexpr int N = 1 << LOGN;
  f32x2* buf = (f32x2*)buf_;
  const int tid = tidx();
#pragma unroll
  for (int ps = 0; ps < LOGN / 2; ++ps) {
    const int lh = LOGN - 1 - 2 * ps;
    const int h = 1 << lh, hh = h >> 1;
    const float inv2h = 1.f / (float)(2 * h);
#pragma unroll 2
    for (int qg = tid; qg < NSEQ * N / 4; qg += NT) {
      const int q = qg & (N / 4 - 1), sb = (qg >> (LOGN - 2)) << LOGN;
      const int pos = q & (hh - 1), grp = q >> (lh - 1);
      const int e0 = sb + swz((grp << (lh + 1)) + pos);
      const int o1 = swz(hh), o2 = swz(h), o3 = swz(h + hh);
      const f32x2 x0 = buf[e0], x1 = buf[e0 ^ o1], x2 = buf[e0 ^ o2], x3 = buf[e0 ^ o3];
      const float f1 = (float)pos * inv2h;
      const float c1 = __builtin_amdgcn_cosf(f1), s1 = -__builtin_amdgcn_sinf(f1);
      const float c2 = c1 * c1 - s1 * s1, s2 = 2.f * c1 * s1;
      const f32x2 a0 = x0 + x2, a1 = x1 + x3;
      const f32x2 a2 = cmul_pk(x0 - x2, c1, s1);
      const f32x2 t3 = cmul_pk(x1 - x3, c1, s1);
      const f32x2 a3 = f32x2{t3.y, -t3.x};
      buf[e0] = a0 + a1;
      buf[e0 ^ o1] = cmul_pk(a0 - a1, c2, s2);
      buf[e0 ^ o2] = a2 + a3;
      buf[e0 ^ o3] = cmul_pk(a2 - a3, c2, s2);
    }
    __syncthreads();
  }
}
template <int LOGN, int NSEQ>
__device__ void fft_dit_inv(float2* buf_) {
  constexpr int N = 1 << LOGN;
  f32x2* buf = (f32x2*)buf_;
  const int tid = tidx();
#pragma unroll
  for (int ps = 0; ps < LOGN / 2; ++ps) {
    const int lh = 2 * ps;
    const int h = 1 << lh;
    const float inv4h = 1.f / (float)(4 * h);
#pragma unroll 2
    for (int qg = tid; qg < NSEQ * N / 4; qg += NT) {
      const int q = qg & (N / 4 - 1), sb = (qg >> (LOGN - 2)) << LOGN;
      const int pos = q & (h - 1), grp = q >> lh;
      const int e0 = sb + swz((grp << (lh + 2)) + pos);
      const int o1 = swz(h), o2 = swz(2 * h), o3 = swz(3 * h);
      const f32x2 x0 = buf[e0], x1 = buf[e0 ^ o1], x2 = buf[e0 ^ o2], x3 = buf[e0 ^ o3];
      const float f2 = (float)pos * inv4h;
      const float c2 = __builtin_amdgcn_cosf(f2), s2 = __builtin_amdgcn_sinf(f2);
      const float c1 = c2 * c2 - s2 * s2, s1 = 2.f * c2 * s2;
      const f32x2 b1 = cmul_pk(x1, c1, s1), b3 = cmul_pk(x3, c1, s1);
      const f32x2 a0 = x0 + b1, a1 = x0 - b1, a2 = x2 + b3, a3 = x2 - b3;
      const f32x2 cc2 = cmul_pk(a2, c2, s2);
      const f32x2 t3 = cmul_pk(a3, c2, s2);
      const f32x2 cc3 = f32x2{-t3.y, t3.x};
      buf[e0] = a0 + cc2;
      buf[e0 ^ o2] = a0 - cc2;
      buf[e0 ^ o1] = a1 + cc3;
      buf[e0 ^ o3] = a1 - cc3;
    }
    __syncthreads();
  }
}
template <int LOGN, int NSEQ>
__device__ void spectrum_extract(const float2* buf, float4* __restrict__ GPa, float4* __restrict__ GPb, float scale_a, float scale_b) {
  constexpr int Lc = 1 << LOGN;
  for (int jg = tidx(); jg < NSEQ * Lc / 2; jg += NT) {
    const int j = jg & (Lc / 2 - 1), sq = jg >> (LOGN - 1), sb = sq << LOGN;
    float4* GP = sq ? GPb : GPa;
    const float scale = sq ? scale_b : scale_a;
    if (j == 0) {
      const float2 c = buf[sb], ch = buf[sb + 1];
      GP[0] = float4{(c.x + c.y) * scale, (c.x - c.y) * scale, ch.x * scale, -ch.y * scale};
    } else {
      const int pos = 2 * j;
      const int k = (int)(__brev((unsigned)pos) >> (32 - LOGN));
      const int p2 = pos ^ ((1 << (31 - __clz(pos))) - 1);
      const int sp1 = sb + swz(pos), sp2 = sb + swz(p2);
      float2 C1 = buf[sp1], C2 = buf[sp2];
      float2 E{0.5f * (C1.x + C2.x), 0.5f * (C1.y - C2.y)}, D{0.5f * (C1.x - C2.x), 0.5f * (C1.y + C2.y)};
      float2 O{D.y, -D.x};
      const float f = (float)k * (1.f / (float)(2 * Lc));
      const float wc = __builtin_amdgcn_cosf(f), wsn = -__builtin_amdgcn_sinf(f);
      float2 wO{wc * O.x - wsn * O.y, wc * O.y + wsn * O.x};
      GP[j] = float4{(E.x + wO.x) * scale, (E.y + wO.y) * scale, (E.x - wO.x) * scale, -(E.y - wO.y) * scale};
    }
  }
}
template <int LOGN, int NSEQ>
__device__ void spectrum_mul(float2* buf, const float4* __restrict__ GP) {
  constexpr int Lc = 1 << LOGN;
  for (int jg = tidx(); jg < NSEQ * Lc / 2; jg += NT) {
    const int j = jg & (Lc / 2 - 1), sb = (jg >> (LOGN - 1)) << LOGN;
    const float4 gp = GP[j];
    if (j == 0) {
      const float2 c = buf[sb], ch = buf[sb + 1];
      const float Y0 = (c.x + c.y) * gp.x, YL = (c.x - c.y) * gp.y;
      buf[sb] = float2{0.5f * (Y0 + YL), 0.5f * (Y0 - YL)};
      buf[sb + 1] = float2{ch.x * gp.z + ch.y * gp.w, ch.y * gp.z - ch.x * gp.w};
    } else {
      const int pos = 2 * j;
      const int k = (int)(__brev((unsigned)pos) >> (32 - LOGN));
      const int p2 = pos ^ ((1 << (31 - __clz(pos))) - 1);
      const int sp1 = sb + swz(pos), sp2 = sb + swz(p2);
      float2 C1 = buf[sp1], C2 = buf[sp2];
      float2 E{0.5f * (C1.x + C2.x), 0.5f * (C1.y - C2.y)}, D{0.5f * (C1.x - C2.x), 0.5f * (C1.y + C2.y)};
      float2 O{D.y, -D.x};
      const float f = (float)k * (1.f / (float)(2 * Lc));
      const float wc = __builtin_amdgcn_cosf(f), wsn = -__builtin_amdgcn_sinf(f);
      float2 wO{wc * O.x - wsn * O.y, wc * O.y + wsn * O.x};
      float2 X1{E.x + wO.x, E.y + wO.y}, X2{E.x - wO.x, -(E.y - wO.y)};
      float2 Y1{X1.x * gp.x - X1.y * gp.y, X1.x * gp.y + X1.y * gp.x};
      float2 Y2{X2.x * gp.z - X2.y * gp.w, X2.x * gp.w + X2.y * gp.z};
      float2 Ye{0.5f * (Y1.x + Y2.x), 0.5f * (Y1.y - Y2.y)};
      float2 Dd{0.5f * (Y1.x - Y2.x), 0.5f * (Y1.y + Y2.y)};
      float2 Yo{wc * Dd.x + wsn * Dd.y, wc * Dd.y - wsn * Dd.x};
      buf[sp1] = float2{Ye.x - Yo.y, Ye.y + Yo.x};
      buf[sp2] = float2{Ye.x + Yo.y, -Ye.y + Yo.x};
    }
  }
}

template <int LOGN>
__device__ void hy_conv_item(const Params& p, int i, int c, unsigned char* lds, bool dry) {
  constexpr int Lc = 1 << LOGN;
  constexpr int L = Lc;
  constexpr int NB = (LOGN == 14) ? 2 : 4;
  constexpr int NSEQ = (LOGN == 14) ? 1 : 4;
  constexpr int LOG8 = LOGN - 3;
  const int tid = tidx();
  float2* buf = (float2*)lds;
  float* bufF = (float*)lds;
  float* W3s = (float*)(lds + 131072);
  float* red = W3s + 256;
  float4* GS = (float4*)(p.ws + OFF_GS + (size_t)bidx() * 2 * GS_PER);
  float4* GS1 = GS + GS_PER / 16;
  float* G1tmp = (float*)GS1;
  float* Z1 = (float*)(p.ws + OFF_Z1 + (size_t)bidx() * 65536);
  const float* H2 = (const float*)(p.ws + OFF_H2) + (LOGN == 14 ? (size_t)4096 * 64 : 0);
  const ushort_t* PH = (const ushort_t*)(p.ws + OFF_PH);
  const float delta = 4.605170185988091f * (1.f / 1.5f + (1.f / 0.3f - 1.f / 1.5f) * (float)c / 1023.f);
  __syncthreads();
  if (tid < 256) {
    const int j = tid >> 2, col = tid & 3, o = col >> 1, dirr = col & 1;
    W3s[tid] = p.in[I_FW3][((size_t)i * 64 + j) * 4096 + (dirr * 2 + o) * 1024 + c];
  }
  __syncthreads();
  float ss0 = 0.f, ss1 = 0.f;
  for (int t0 = tid * 4; t0 < L; t0 += NT * 4) {
    float acc[4][4];
#pragma unroll
    for (int r = 0; r < 4; ++r)
#pragma unroll
      for (int cc = 0; cc < 4; ++cc) acc[r][cc] = 0.f;
#pragma unroll 1
    for (int jb = 0; jb < 64; jb += 16) {
      float4 hv[16];
#pragma unroll
      for (int jj = 0; jj < 16; ++jj) hv[jj] = *(const float4*)(H2 + (size_t)(jb + jj) * L + t0);
#pragma unroll
      for (int jj = 0; jj < 16; ++jj) {
        const float4 w = *(const float4*)(W3s + 4 * (jb + jj));
        acc[0][0] += hv[jj].x * w.x; acc[0][1] += hv[jj].x * w.y; acc[0][2] += hv[jj].x * w.z; acc[0][3] += hv[jj].x * w.w;
        acc[1][0] += hv[jj].y * w.x; acc[1][1] += hv[jj].y * w.y; acc[1][2] += hv[jj].y * w.z; acc[1][3] += hv[jj].y * w.w;
        acc[2][0] += hv[jj].z * w.x; acc[2][1] += hv[jj].z * w.y; acc[2][2] += hv[jj].z * w.z; acc[2][3] += hv[jj].z * w.w;
        acc[3][0] += hv[jj].w * w.x; acc[3][1] += hv[jj].w * w.y; acc[3][2] += hv[jj].w * w.z; acc[3][3] += hv[jj].w * w.w;
      }
    }
#pragma unroll
    for (int r = 0; r < 4; ++r) {
      const int t = t0 + r;
      const float dec = expf(-((float)t * (1.f / (float)(L - 1))) * delta);
      const float d0 = acc[r][0] * dec, d1 = acc[r][1] * dec, d2 = acc[r][2] * dec, d3 = acc[r][3] * dec;
      ss0 += d0 * d0 + d1 * d1;
      ss1 += d2 * d2 + d3 * d3;
      if (NSEQ >= 2) {
        bufF[swzF(t)] = d0; bufF[2 * L + swzF(t)] = d2;
        if (t >= 1) { bufF[swzF(2 * L - t)] = d1; bufF[2 * L + swzF(2 * L - t)] = d3; } else { bufF[swzF(L)] = 0.f; bufF[2 * L + swzF(L)] = 0.f; }
      } else {
        bufF[swzF(t)] = d0; G1tmp[t] = d2;
        if (t >= 1) { bufF[swzF(2 * L - t)] = d1; G1tmp[2 * L - t] = d3; } else { bufF[swzF(L)] = 0.f; G1tmp[L] = 0.f; }
      }
    }
  }
  ss0 = wsum(ss0); ss1 = wsum(ss1);
  if ((tid & 63) == 0) { red[tid >> 6] = ss0; red[8 + (tid >> 6)] = ss1; }
  __syncthreads();
  float tot0 = 0.f, tot1 = 0.f;
#pragma unroll
  for (int w = 0; w < 8; ++w) { tot0 += red[w]; tot1 += red[8 + w]; }
  const float sc0 = rsqrtf(tot0) * (1.f / (float)Lc), sc1 = rsqrtf(tot1) * (1.f / (float)Lc);
  if (NSEQ >= 2) {
    fft_dif<LOGN, 2>(buf);
    spectrum_extract<LOGN, 2>(buf, GS, GS1, sc0, sc1);
  } else {
    fft_dif<LOGN, 1>(buf);
    spectrum_extract<LOGN, 1>(buf, GS, GS, sc0, sc0);
    __syncthreads();
    for (int t = tid; t < L; t += NT) buf[swz(t)] = ((const float2*)G1tmp)[t];
    __syncthreads();
    fft_dif<LOGN, 1>(buf);
    spectrum_extract<LOGN, 1>(buf, GS1, GS1, sc1, sc1);
  }
  __threadfence_block();
  __syncthreads();
  const float* sw = p.in[I_HSW] + (size_t)i * 3 * 3072;
  const float* sbias = p.in[I_HSB] + (size_t)i * 3072;
  float cw[3][3], cb[3];
#pragma unroll
  for (int st = 0; st < 3; ++st) {
#pragma unroll
    for (int k = 0; k < 3; ++k) cw[st][k] = sw[k * 3072 + st * 1024 + c];
    cb[st] = sbias[st * 1024 + c];
  }
  const float fb0 = p.in[I_FBIAS][((size_t)i * 2 + 0) * 1024 + c], fb1 = p.in[I_FBIAS][((size_t)i * 2 + 1) * 1024 + c];
  auto conv8 = [&](const ushort_t* sp, int st, int t0, float* y) {
    const uint4 v = *(const uint4*)(sp + t0);
    const float xm = t0 > 0 ? bf2f(sp[t0 - 1]) : 0.f, xn = t0 + 8 < L ? bf2f(sp[t0 + 8]) : 0.f;
    const float x[10] = {xm, __uint_as_float(v.x << 16), __uint_as_float(v.x & 0xffff0000u), __uint_as_float(v.y << 16), __uint_as_float(v.y & 0xffff0000u),
                         __uint_as_float(v.z << 16), __uint_as_float(v.z & 0xffff0000u), __uint_as_float(v.w << 16), __uint_as_float(v.w & 0xffff0000u), xn};
#pragma unroll
    for (int j = 0; j < 8; ++j) y[j] = cw[st][0] * x[j] + cw[st][1] * x[j + 1] + cw[st][2] * x[j + 2] + cb[st];
  };
  for (int b0 = 0; b0 < NB; b0 += NSEQ) {
    __syncthreads();
    for (int w = tid; w < NSEQ * (L / 8); w += NT) {
      const int sq = w >> LOG8, t0 = (w & (L / 8 - 1)) * 8;
      const int s0 = (LOGN == 14) ? (TPROMPT + (b0 + sq) * 16384) : ((b0 + sq) * 4096);
      const ushort_t* pv = PH + (size_t)s0 * 1024 + (size_t)c * L;
      float y[8]; conv8(pv, 0, t0, y);
#pragma unroll
      for (int j = 0; j < 4; ++j) { buf[sq * Lc + swz((t0 >> 1) + j)] = float2{y[2 * j], y[2 * j + 1]}; buf[sq * Lc + swz(L / 2 + (t0 >> 1) + j)] = float2{0.f, 0.f}; }
    }
    __syncthreads();
    fft_dif<LOGN, NSEQ>(buf);
    spectrum_mul<LOGN, NSEQ>(buf, GS);
    __syncthreads();
    fft_dit_inv<LOGN, NSEQ>(buf);
    for (int w = tid; w < NSEQ * (L / 8); w += NT) {
      const int sq = w >> LOG8, t0 = (w & (L / 8 - 1)) * 8;
      const int s0 = (LOGN == 14) ? (TPROMPT + (b0 + sq) * 16384) : ((b0 + sq) * 4096);
      const ushort_t* pv = PH + (size_t)s0 * 1024 + (size_t)c * L;
      const ushort_t* px1 = pv + (size_t)T * 1024;
      float z0[8], xa[8]; conv8(pv, 0, t0, z0); conv8(px1, 1, t0, xa);
      float z1[8];
#pragma unroll
      for (int j = 0; j < 4; ++j) {
        const int e = sq * Lc + swz((t0 >> 1) + j);
        const float2 zc = buf[e];
        z1[2 * j] = xa[2 * j] * (zc.x + z0[2 * j] * fb0); z1[2 * j + 1] = xa[2 * j + 1] * (zc.y + z0[2 * j + 1] * fb0);
        buf[e] = float2{z1[2 * j], z1[2 * j + 1]};
        buf[sq * Lc + swz(L / 2 + (t0 >> 1) + j)] = float2{0.f, 0.f};
      }
      *(float4*)(Z1 + sq * L + t0) = float4{z1[0], z1[1], z1[2], z1[3]};
      *(float4*)(Z1 + sq * L + t0 + 4) = float4{z1[4], z1[5], z1[6], z1[7]};
    }
    __syncthreads();
    fft_dif<LOGN, NSEQ>(buf);
    spectrum_mul<LOGN, NSEQ>(buf, GS1);
    __syncthreads();
    fft_dit_inv<LOGN, NSEQ>(buf);
    for (int w = tid; w < NSEQ * (L / 8); w += NT) {
      const int sq = w >> LOG8, t0 = (w & (L / 8 - 1)) * 8;
      const int s0 = (LOGN == 14) ? (TPROMPT + (b0 + sq) * 16384) : ((b0 + sq) * 4096);
      const ushort_t* px2 = PH + (size_t)s0 * 1024 + (size_t)c * L + (size_t)2 * T * 1024;
      ushort_t* pg = (ushort_t*)px2 + (size_t)T * 1024;
      float xb[8]; conv8(px2, 2, t0, xb);
      const float4 za = *(const float4*)(Z1 + sq * L + t0), zb = *(const float4*)(Z1 + sq * L + t0 + 4);
      const float z1[8] = {za.x, za.y, za.z, za.w, zb.x, zb.y, zb.z, zb.w};
      const uint4 gv = *(const uint4*)(pg + t0);
      const unsigned gw[4] = {gv.x, gv.y, gv.z, gv.w};
      unsigned o[4];
#pragma unroll
      for (int j = 0; j < 4; ++j) {
        const float2 zc = buf[sq * Lc + swz((t0 >> 1) + j)];
        const float g0 = __uint_as_float(gw[j] << 16), g1 = __uint_as_float(gw[j] & 0xffff0000u);
        const float y0 = xb[2 * j] * (zc.x + z1[2 * j] * fb1) * (g0 * fast_sigmoid(g0));
        const float y1 = xb[2 * j + 1] * (zc.y + z1[2 * j + 1] * fb1) * (g1 * fast_sigmoid(g1));
        o[j] = pack2(y0, y1);
      }
      if (!dry) *(uint4*)(pg + t0) = uint4{o[0], o[1], o[2], o[3]};
    }
  }
}

__device__ void hy_conv_phase(const Params& p, int i, unsigned char* lds, bool dry = false) {
  for (int it = bidx(); it < 2048; it += gridDim.x) {
    if (it < 1024) hy_conv_item<14>(p, i, it, lds, dry);
    else hy_conv_item<12>(p, i, it - 1024, lds, dry);
    __syncthreads();
  }
}

__device__ void prep_even(const Params& p, int i, unsigned char* lds) {
  ushort_t* WB = (ushort_t*)(p.ws + OFF_WB);
  ushort_t* WinT = WB; ushort_t* WoutT = WB + 3328 * 1024; ushort_t* GluT = WoutT + 1024 * 1024;
  transpose_bf16(p.in[I_EWIN] + (size_t)i * 1024 * 3136, WinT, 1024, 3136, lds);
  zero_fill(WinT + 3136 * 1024, 192 * 1024);
  transpose_bf16(p.in[I_EWOUT] + (size_t)i * 1024 * 1024, WoutT, 1024, 1024, lds);
  transpose_bf16(p.in[I_GLUW] + (size_t)i * 512 * 512, GluT, 512, 512, lds);
}
__device__ void prep_odd(const Params& p, int i, unsigned char* lds) {
  ushort_t* WB = (ushort_t*)(p.ws + OFF_WB);
  transpose_bf16(p.in[I_HWIN] + (size_t)i * 1024 * 4096, WB, 1024, 4096, lds);
  transpose_bf16(p.in[I_HWOUT] + (size_t)i * 1024 * 1024, WB + 4096 * 1024, 1024, 1024, lds);
  hy_filter_mlp(p, i);
}
#ifndef PROBE_MASK
#define PROBE_MASK 0
#endif
#ifndef PH_MASK
#define PH_MASK 0x1ffff
#endif
#define PHM(n) ((PH_MASK >> (n)) & 1)
DEVI void run_phase(const Params& p, int ph, unsigned char* lds, bool dry = false) {
  const int layer = ph < NPH_EVEN ? 0 : ph < NPH_EVEN + NPH_ODD ? 1 : ph < 2 * NPH_EVEN + NPH_ODD ? 2 : 3;
  const int base = layer == 0 ? 0 : layer == 1 ? NPH_EVEN : layer == 2 ? NPH_EVEN + NPH_ODD : 2 * NPH_EVEN + NPH_ODD;
  const int sp = ph - base, i = layer >> 1;
  unsigned char* ws = p.ws;
  ushort_t* WB = (ushort_t*)(ws + OFF_WB);
  if ((layer & 1) == 0) {
    ushort_t* WinT = WB; ushort_t* WoutT = WB + 3328 * 1024; ushort_t* GluT = WoutT + 1024 * 1024;
    switch (sp) {
      case 0: if (PHM(0)) {
        prep_even(p, 0, lds);
        xb_convert(p, (ushort_t*)(ws + OFF_Y));
        } break;
      case 1: if (PHM(1)) run_gemm(lds, (const ushort_t*)(ws + OFF_Y), 1024, WinT, 3328, 1024, pg8::EpiEvenIn{(ushort_t*)(ws + OFF_PS5), (ushort_t*)(ws + OFF_PRW)}); break;
      case 2: if (PHM(2)) s5_passA(p, i, lds); break;
      case 3: if (PHM(3)) s5_passC(p, i, lds); break;
      case 4: if (PHM(4)) run_gemm(lds, (const ushort_t*)(ws + OFF_Y) + 512, 1024, GluT, 512, 512, pg8::EpiGlu{(ushort_t*)(ws + OFF_Y), (const ushort_t*)(ws + OFF_PS5), p.in[I_GLUB] + i * 512}); break;
      case 5: if (PHM(5)) rwkv_scan1(p, i, lds); break;
      case 6: if (PHM(6)) rwkv_carry(p, lds, dry); break;
      case 7: if (PHM(7)) rwkv_scan3(p, i, lds, dry); break;
      case 8: if (PHM(8)) rwkv_post(p, i); break;
      case 9: if (PHM(9)) run_gemm(lds, (const ushort_t*)(ws + OFF_Y), 1024, WoutT, 1024, 1024, pg8::EpiF32{(float*)(ws + OFF_PRW)}); break;
      case 10: if (PHM(10)) { if (!dry) prep_odd(p, i, lds); ln_phase(p, layer, (const float*)(ws + OFF_PRW), (ushort_t*)(ws + OFF_XB_ODD), dry); } break;
    }
  } else {
    ushort_t* HinT = WB; ushort_t* HoutT = WB + 4096 * 1024;
    switch (sp) {
      case 0: break;
      case 1: if (PHM(12)) run_gemm(lds, (const ushort_t*)(ws + OFF_XB_ODD), 1024, HinT, 4096, 1024, pg8::EpiHyIn{(ushort_t*)(ws + OFF_PH)}); break;
      case 2: if (PHM(13)) hy_conv_phase(p, i, lds, dry); break;
      case 3: if (PHM(14)) hy_transpose((const ushort_t*)(ws + OFF_PH + 3 * SZ1), (ushort_t*)(ws + OFF_PH), lds); break;
      case 4: if (PHM(15)) run_gemm(lds, (const ushort_t*)(ws + OFF_PH), 1024, HoutT, 1024, 1024, pg8::EpiF32{(float*)(ws + OFF_PH + SZ1)}); break;
      case 5: if (PHM(16)) { if (!dry && layer < 3) prep_even(p, i + 1, lds); ln_phase(p, layer, (const float*)(ws + OFF_PH + SZ1), layer < 3 ? (ushort_t*)(ws + OFF_Y) : (ushort_t*)nullptr, dry); } break;
    }
  }
}

#define LAS __attribute__((address_space(3)))
#define XB_TMO      128
#define XB_XCNT(j)  (256  + 64 * (j))
#define XB_XSUB(j)  (1280 + 64 * (j))
#define XB_XGEN(j)  (2304 + 64 * (j))
#define XB_TOP      3328
#define XB_TOPGEN   3392
#define XCD_BAR_WORDS 3456
#define XB_SPIN_CAP (1u << 18)
#define LAS __attribute__((address_space(3)))

__device__ __forceinline__ unsigned xb_ld(unsigned* p)              { return __hip_atomic_load(p, __ATOMIC_RELAXED, __HIP_MEMORY_SCOPE_AGENT); }
__device__ __forceinline__ unsigned xb_add(unsigned* p, unsigned v) { return __hip_atomic_fetch_add(p, v, __ATOMIC_RELAXED, __HIP_MEMORY_SCOPE_AGENT); }
__device__ __forceinline__ unsigned xb_xcc_id() { return (unsigned)__builtin_amdgcn_s_getreg((3 << 11) | 20) & 0xFu; }
#define XB_SPIN(cond, bar) do { unsigned _sp = 0; while (cond) { __builtin_amdgcn_s_sleep(1); \
    if ((++_sp & 255u) == 0u) { if (xb_ld(&(bar)[XB_TMO])) break; if (_sp > XB_SPIN_CAP) { atomicAdd(&(bar)[XB_TMO], 1u); break; } } } } while (0)

struct XcdBarrier {
    unsigned* bar; unsigned x;
    volatile LAS unsigned* st;
};

__device__ __forceinline__ XcdBarrier xcd_barrier_post(unsigned* bar, volatile LAS unsigned* st) {
    XcdBarrier b; b.bar = bar; b.x = xb_xcc_id(); b.st = st;
    if (threadIdx.x == 0) (void)xb_add(&bar[XB_XCNT(b.x)], 1u);
    return b;
}
__device__ __forceinline__ void xcd_barrier_complete(unsigned* bar, unsigned x, unsigned& nloc, unsigned& nx) {
    const unsigned G = gridDim.x * gridDim.y * gridDim.z;
    unsigned sum, cnt, mine, sp = 0u;
    for (;;) {
        sum = 0u; cnt = 0u; mine = 0u;
#pragma unroll
        for (unsigned j = 0; j < 16; ++j) { const unsigned c = xb_ld(&bar[XB_XCNT(j)]); sum += c; cnt += (c > 0u) ? 1u : 0u; mine = (j == x) ? c : mine; }
        if (sum == G) break;
        __builtin_amdgcn_s_sleep(1);
        if ((++sp & 255u) == 0u) { if (xb_ld(&bar[XB_TMO])) break; if (sp > XB_SPIN_CAP) { atomicAdd(&bar[XB_TMO], 1u); break; } }
    }
    nloc = mine > 0u ? mine : 1u; nx = cnt > 0u ? cnt : 1u;
}

__device__ __forceinline__ void xcd_barrier(const XcdBarrier& b) {
    asm volatile("s_waitcnt vmcnt(0)" ::: "memory");
    __syncthreads();
    if (threadIdx.x == 0) {
        unsigned* bar = b.bar;
        __builtin_amdgcn_s_waitcnt(0);
        unsigned nloc = b.st[0], nx = b.st[1];
        if (nloc == 0u) { xcd_barrier_complete(bar, b.x, nloc, nx); b.st[0] = nloc; b.st[1] = nx; }
        const unsigned old = xb_add(&bar[XB_XSUB(b.x)], 1u);
        const unsigned gen = old / nloc;
        if (old + 1u == (gen + 1u) * nloc) {
            __builtin_amdgcn_fence(__ATOMIC_RELEASE, "agent");
            asm volatile("s_waitcnt vmcnt(0)" ::: "memory");
            const unsigned og = xb_add(&bar[XB_TOP], 1u);
            const unsigned tg = og / nx;
            if (og + 1u == (tg + 1u) * nx) xb_add(&bar[XB_TOPGEN], 1u);
            else XB_SPIN(xb_ld(&bar[XB_TOPGEN]) == tg, bar);
            __builtin_amdgcn_fence(__ATOMIC_ACQUIRE, "agent");
            xb_add(&bar[XB_XGEN(b.x)], 1u);
            asm volatile("s_waitcnt vmcnt(0)" ::: "memory");
        } else {
            XB_SPIN(xb_ld(&bar[XB_XGEN(b.x)]) == gen, bar);
            __builtin_amdgcn_fence(__ATOMIC_ACQUIRE, "agent");
            asm volatile("s_waitcnt vmcnt(0)" ::: "memory");
        }
    }
    __syncthreads();
}


#if ONE_LAUNCH
__global__ void __launch_bounds__(NT) fwd_kernel(Params p) {
  extern __shared__ __attribute__((aligned(16))) unsigned char lds[];
#if ONE_LAUNCH
  cg::grid_group grid = cg::this_grid();
#endif
#if ONE_LAUNCH
  volatile LAS unsigned* xb_st = (volatile LAS unsigned*)(lds + LDS_BYTES - 16);
  if (threadIdx.x < 2) xb_st[threadIdx.x] = 0u;
  __syncthreads();
  const XcdBarrier xb = xcd_barrier_post((unsigned*)(p.ws + OFF_BAR), xb_st);
#endif
  for (int ph = p.ph_lo; ph < p.ph_hi; ++ph) {
    if (ph == NPH_EVEN || ph == NPH_EVEN + NPH_ODD || ph == 2 * NPH_EVEN + NPH_ODD) continue;
    int reps = 1;
#if PROBE_MASK
    {
      const int lyr = ph < NPH_EVEN ? 0 : ph < NPH_EVEN + NPH_ODD ? 1 : ph < 2 * NPH_EVEN + NPH_ODD ? 2 : 3;
      const int bs = lyr == 0 ? 0 : lyr == 1 ? NPH_EVEN : lyr == 2 ? NPH_EVEN + NPH_ODD : 2 * NPH_EVEN + NPH_ODD;
      const int idx = (lyr & 1) ? NPH_EVEN + (ph - bs) : (ph - bs);
      if ((PROBE_MASK >> idx) & 1) reps = 2;
    }
#endif
    for (int rep = 0; rep < reps; ++rep) {
      run_phase(p, ph, lds, rep + 1 < reps);
#if ONE_LAUNCH
      if (ph + 1 < p.ph_hi || rep + 1 < reps) { if (ph == p.ph_lo && rep == 0) grid.sync(); else xcd_barrier(xb); }
#endif
    }
  }
}
#endif

#if !ONE_LAUNCH
template <int PH> __global__ void __launch_bounds__(NT) phase_kernel(Params p) {
  extern __shared__ __attribute__((aligned(16))) unsigned char lds[];
  run_phase(p, PH, lds);
}
typedef void (*kfn_t)(Params);
#define PK(n) phase_kernel<n>
static kfn_t k_tab[NPHASES] = {PK(0), PK(1), PK(2), PK(3), PK(4), PK(5), PK(6), PK(7), PK(8), PK(9), PK(10), PK(11), PK(12), PK(13), PK(14), PK(15),
                               PK(16), PK(17), PK(18), PK(19), PK(20), PK(21), PK(22), PK(23), PK(24), PK(25), PK(26), PK(27), PK(28), PK(29), PK(30), PK(31), PK(32), PK(33)};
#endif

extern "C" void kernel_launch(void* const* d_in, const int* in_sizes, int n_in, void* d_out, int out_size, void* d_ws, size_t ws_size,
                              hipStream_t stream) {
  static int grid_blocks = 0;
  if (!grid_blocks) {
    if (n_in != 38 || ws_size < WS_NEED || out_size != T * 1024) {
      fprintf(stderr, "kernel_launch: unexpected shapes n_in=%d ws=%zu out=%d\n", n_in, ws_size, out_size);
      grid_blocks = -1; return;
    }
    int dev = 0, cus = 0, per_cu = 0;
    (void)hipGetDevice(&dev);
    (void)hipDeviceGetAttribute(&cus, hipDeviceAttributeMultiprocessorCount, dev);
#if ONE_LAUNCH
    if (hipFuncSetAttribute((const void*)fwd_kernel, hipFuncAttributeMaxDynamicSharedMemorySize, LDS_BYTES) != hipSuccess) {
      fprintf(stderr, "kernel_launch: hipFuncSetAttribute failed\n"); grid_blocks = -1; return;
    }
    (void)hipOccupancyMaxActiveBlocksPerMultiprocessor(&per_cu, (const void*)fwd_kernel, NT, LDS_BYTES);
#else
    for (int ph = 0; ph < NPHASES; ++ph)
      if (hipFuncSetAttribute((const void*)k_tab[ph], hipFuncAttributeMaxDynamicSharedMemorySize, LDS_BYTES) != hipSuccess) {
        fprintf(stderr, "kernel_launch: hipFuncSetAttribute failed\n"); grid_blocks = -1; return;
      }
    per_cu = 1;
#endif
    if (per_cu < 1) { fprintf(stderr, "kernel_launch: occupancy query returned %d\n", per_cu); per_cu = 1; }
    grid_blocks = cus * per_cu;
    if (grid_blocks > 256) grid_blocks = 256;
    if (grid_blocks < 1) grid_blocks = 256;
  }
  if (grid_blocks < 0) return;
  Params p{};
  for (int k = 0; k < 38; ++k) p.in[k] = (const float*)d_in[k];
  p.out = (float*)d_out; p.ws = (unsigned char*)d_ws;
#if ONE_LAUNCH
  if (hipMemsetAsync((unsigned char*)d_ws + OFF_BAR, 0, 16384, stream) != hipSuccess) { fprintf(stderr, "kernel_launch: memset of barrier words failed\n"); return; }
  p.ph_lo = 0; p.ph_hi = NPHASES;
  void* args[] = {&p};
  hipError_t e = hipLaunchCooperativeKernel((const void*)fwd_kernel, dim3(grid_blocks), dim3(NT), args, LDS_BYTES, stream);
  if (e != hipSuccess) fprintf(stderr, "cooperative launch failed: %s (grid %d)\n", hipGetErrorString(e), grid_blocks);
#else
  for (int ph = 0; ph < NPHASES; ++ph) {
    p.ph_lo = ph; p.ph_hi = ph + 1;
    hipLaunchKernelGGL(k_tab[ph], dim3(grid_blocks), dim3(NT), LDS_BYTES, stream, p);
  }
#endif
}
```

```cpp
#include <hip/hip_runtime.h>
#include <hip/hip_cooperative_groups.h>
#include <cstdio>
#include <cstdint>
namespace cg = cooperative_groups;

#ifndef ONE_LAUNCH
#define ONE_LAUNCH 1
#endif

#define DEVI __device__ __forceinline__
constexpr int NT = 512;
constexpr int T = 49152;
constexpr int TPROMPT = 16384;
constexpr int LDS_BYTES = 133120;
constexpr int NPH_EVEN = 11, NPH_ODD = 6;
constexpr int NPHASES = 2 * (NPH_EVEN + NPH_ODD);

typedef __attribute__((ext_vector_type(8))) short bf16x8;
typedef __attribute__((ext_vector_type(4))) float f32x4;
typedef unsigned short ushort_t;
typedef float f32x2 __attribute__((ext_vector_type(2)));

struct Params { const float* in[38]; float* out; unsigned char* ws; int ph_lo; int ph_hi; };

enum { I_XP = 0, I_XS, I_EWIN, I_EWOUT, I_LRE, I_LIM, I_LSTEP, I_BRE, I_BIM, I_CRE, I_CIM, I_S5D, I_GLUW, I_GLUB,
       I_MURKV, I_MULORA, I_W0, I_WUP, I_A0, I_AUP, I_KK, I_KA, I_RK, I_LNXW, I_LNXB,
       I_HWIN, I_HWOUT, I_HSW, I_HSB, I_FW1, I_FB1, I_FFREQ, I_FW2, I_FB2, I_FW3, I_FBIAS, I_LNG, I_LNB };

constexpr size_t SZ1 = (size_t)T * 1024 * 2;
constexpr size_t OFF_PS5 = 0;
constexpr size_t OFF_PRW = OFF_PS5 + SZ1;
constexpr size_t OFF_Y = OFF_PRW + (size_t)T * 2112 * 2;
constexpr size_t OFF_YS = OFF_Y + SZ1;
constexpr size_t OFF_WB = OFF_YS + SZ1;
constexpr size_t OFF_CAR = OFF_WB + 10485760;
constexpr size_t OFF_BAR = OFF_CAR + 6291456;
constexpr size_t WS_NEED = OFF_BAR + 16384;
constexpr size_t OFF_PH = 0;
constexpr size_t OFF_GS = 4 * SZ1;
constexpr size_t GS_PER = 131328;
constexpr size_t OFF_Z1 = OFF_GS + 256 * 2 * GS_PER;
constexpr size_t OFF_XB_ODD = 4 * SZ1;
constexpr size_t OFF_H2 = OFF_XB_ODD + SZ1;

DEVI int tidx() { int t = threadIdx.x; asm volatile("" : "+v"(t)); return t; }
DEVI int bidx() { int b = blockIdx.x; asm volatile("" : "+r"(b)); return __builtin_amdgcn_readfirstlane(b); }
DEVI ushort_t f2bf(float f) { unsigned u = __float_as_uint(f); u += 0x7fffu + ((u >> 16) & 1u); return (ushort_t)(u >> 16); }
DEVI float bf2f(ushort_t h) { return __uint_as_float(((unsigned)h) << 16); }
DEVI unsigned pack2(float a, float b) { return (unsigned)f2bf(a) | ((unsigned)f2bf(b) << 16); }
DEVI float wsum(float v) {
#pragma unroll
  for (int m = 32; m >= 1; m >>= 1) v += __shfl_xor(v, m);
  return v;
}
DEVI void wave_sync() { __builtin_amdgcn_fence(__ATOMIC_RELEASE, "wavefront"); __builtin_amdgcn_wave_barrier(); __builtin_amdgcn_fence(__ATOMIC_ACQUIRE, "wavefront"); }
DEVI void seq_of(int tok, int& s0, int& L) {
  if (tok < TPROMPT) { s0 = tok & ~4095; L = 4096; } else { s0 = TPROMPT + ((tok - TPROMPT) & ~16383); L = 16384; }
}
struct XSrc { const float* xp; const float* xs; const float* xo; };
DEVI XSrc xsrc(const Params& p) {
  XSrc x; x.xp = p.in[I_XP]; x.xs = p.in[I_XS]; x.xo = p.out;
  asm volatile("" : "+r"(x.xp), "+r"(x.xs), "+r"(x.xo));
  return x;
}
DEVI const float* xrow(const XSrc& x, int layer, int tok) {
  if (layer == 0) return tok < TPROMPT ? x.xp + (size_t)tok * 1024 : x.xs + (size_t)(tok - TPROMPT) * 1024;
  return x.xo + (size_t)tok * 1024;
}
DEVI float sigmoidf_(float x) { return 1.f / (1.f + expf(-x)); }
DEVI float fast_sigmoid(float x) { return __builtin_amdgcn_rcpf(1.f + __builtin_amdgcn_exp2f(-1.4426950408889634f * x)); }
DEVI float fast_tanh(float x) { return 1.f - 2.f * __builtin_amdgcn_rcpf(1.f + __builtin_amdgcn_exp2f(2.8853900817779268f * x)); }
DEVI float dpp_mov_f(float x, const int sel) {
  int xi = __builtin_bit_cast(int, x), r;
  if (sel == 0) r = __builtin_amdgcn_mov_dpp(xi, 0xB1, 0xf, 0xf, true);
  else if (sel == 1) r = __builtin_amdgcn_mov_dpp(xi, 0x4E, 0xf, 0xf, true);
  else if (sel == 2) r = __builtin_amdgcn_mov_dpp(xi, 0x141, 0xf, 0xf, true);
  else r = __builtin_amdgcn_mov_dpp(xi, 0x140, 0xf, 0xf, true);
  return __builtin_bit_cast(float, r);
}
DEVI float wsum_fast(float v) {
  v += dpp_mov_f(v, 0); v += dpp_mov_f(v, 1); v += dpp_mov_f(v, 2); v += dpp_mov_f(v, 3);
  const int vi = __builtin_bit_cast(int, v);
  return __builtin_bit_cast(float, __builtin_amdgcn_readlane(vi, 0)) + __builtin_bit_cast(float, __builtin_amdgcn_readlane(vi, 16)) +
         __builtin_bit_cast(float, __builtin_amdgcn_readlane(vi, 32)) + __builtin_bit_cast(float, __builtin_amdgcn_readlane(vi, 48));
}
DEVI float gelu_tanh(float x) { return 0.5f * x * (1.f + tanhf(0.7978845608f * (x + 0.044715f * x * x * x))); }

__device__ void transpose_bf16(const float* __restrict__ in, ushort_t* __restrict__ out, int K, int N, unsigned char* lds) {
  float* tile = (float*)lds;
  const int tid = tidx(), j = tid & 63, i0 = tid >> 6;
  const int tk = K / 64, tn = N / 64;
  for (int t = bidx(); t < tk * tn; t += gridDim.x) {
    const int k0 = (t / tn) * 64, n0 = (t % tn) * 64;
#pragma unroll
    for (int e = 0; e < 8; ++e) { int i = i0 + 8 * e; tile[i * 65 + j] = in[(size_t)(k0 + i) * N + n0 + j]; }
    __syncthreads();
#pragma unroll
    for (int e = 0; e < 8; ++e) { int i = i0 + 8 * e; out[(size_t)(n0 + i) * K + k0 + j] = f2bf(tile[j * 65 + i]); }
    __syncthreads();
  }
}

namespace pg8 {
#define PG8_LAS __attribute__((address_space(3)))
typedef unsigned u32x4 __attribute__((ext_vector_type(4)));
constexpr int BM = 256, BK = 64, HALF = 128, HTB = HALF * BK * 2, STAGE_BYTES = 8 * HTB, NXCD = 8, WGM = 8;
DEVI int lds_byte(int r, int c) { const int st = (r >> 4) * 2 + (c >> 5), rr = r & 15, cc = c & 31, ob = rr * 64 + cc * 2; return st * 1024 + (ob ^ (((ob >> 9) & 1) << 5)); }
DEVI void stage_rc(int b, int& R, int& C) { const int st = b / 1024, sb = b % 1024, swz = sb ^ (((sb >> 9) & 1) << 5); R = (st >> 1) * 16 + swz / 64; C = (st & 1) * 32 + (swz % 64) / 2; }
DEVI int perm32(int rho) { const int n = rho >> 4, i = rho & 15; return 8 * (i >> 2) + 4 * n + (i & 3); }
struct Unit { int pm, pn; };
struct Gemm { const ushort_t* A; const ushort_t* Bt; int M, N, K, lda; };
struct StaticOrder {
  int nM, nN, nwg, G, c;
  DEVI void init(int M, int N, int G_, int c_) { nM = M / BM; nN = N / BM; nwg = nM * nN; G = G_; c = c_; }
  DEVI bool next(int i, Unit& u) const {
    const long L = (long)i * G + c; if (L >= nwg) return false;
    int wgid = (int)L; { const int q = nwg / NXCD, r = nwg % NXCD, xcd = wgid % NXCD, off = wgid / NXCD; wgid = (xcd < r ? xcd * (q + 1) : r * (q + 1) + (xcd - r) * q) + off; }
    const int nig = WGM * nN, gid = wgid / nig, fm = gid * WGM, gsz = (nM - fm) < WGM ? (nM - fm) : WGM;
    u.pm = fm + ((wgid % nig) % gsz); u.pn = (wgid % nig) / gsz; return true;
  }
};
DEVI unsigned cvt_pk_bf16(float lo, float hi) { unsigned r; asm volatile("v_cvt_pk_bf16_f32 %0, %1, %2" : "=v"(r) : "v"(lo), "v"(hi)); return r; }

template <class Epi>
DEVI void gemm_phase(PG8_LAS unsigned char* lds, const Gemm g, const StaticOrder& S, const Epi& E) {
  const int tid = tidx(), wid = __builtin_amdgcn_readfirstlane(tid >> 6), lane = tid & 63, wr = wid >> 2, wc = wid & 3, fr = lane & 15, fq = lane >> 4;
  const int K = g.K, nt = K / BK, lda = g.lda;
  unsigned voffA[2], voffB[2];
#pragma unroll
  for (int i = 0; i < 2; ++i) { int R, C; stage_rc(tid * 16 + i * 8192, R, C); const int Rb = Epi::PERM ? ((R & ~31) + perm32(R & 31)) : R;
    voffA[i] = (unsigned)(R * lda + C) * 2u; voffB[i] = (unsigned)(Rb * K + C) * 2u; }
  const size_t kstep = (size_t)(BK * 2);
  const size_t hstepA = (size_t)HALF * lda * 2, hstepB = (size_t)HALF * K * 2;
  const size_t tstepA = 2 * hstepA, tstepB = 2 * hstepB;
  const unsigned ldsw = (unsigned)wid * 1024u;
  const int aoff = lds_byte(wr * 64 + fr, fq * 8), boff = lds_byte(wc * 32 + fr, fq * 8);
#define PG8_SA(b, h) (((b) * 2 + (h)) * HTB)
#define PG8_SB(b, h) ((4 + (b) * 2 + (h)) * HTB)
#define PG8_STAGE(bufoff, gbase, voff) do { _Pragma("unroll") for (int _i = 0; _i < 2; ++_i) \
    __builtin_amdgcn_global_load_lds((const unsigned*)((const char*)(gbase) + (voff)[_i]), (PG8_LAS unsigned*)(lds + (bufoff) + ldsw + _i * 8192), 16, 0, 0); } while (0)
#define PG8_LDA(dst, b, h) do { _Pragma("unroll") for (int m = 0; m < 4; ++m) _Pragma("unroll") for (int k = 0; k < 2; ++k) dst[m][k] = *(const PG8_LAS bf16x8*)(lds + PG8_SA(b, h) + aoff + m * 2048 + k * 1024); } while (0)
#define PG8_LDB(dst, b, h) do { _Pragma("unroll") for (int n = 0; n < 2; ++n) _Pragma("unroll") for (int k = 0; k < 2; ++k) dst[n][k] = *(const PG8_LAS bf16x8*)(lds + PG8_SB(b, h) + boff + n * 2048 + k * 1024); } while (0)
#define PG8_MMA(ai, bj, At, Bt) do { __builtin_amdgcn_s_setprio(1); _Pragma("unroll") for (int m = 0; m < 4; ++m) _Pragma("unroll") for (int n = 0; n < 2; ++n) _Pragma("unroll") for (int k = 0; k < 2; ++k) \
    acc[ai][bj][m][n] = Epi::TRANS ? __builtin_amdgcn_mfma_f32_16x16x32_bf16(Bt[n][k], At[m][k], acc[ai][bj][m][n], 0, 0, 0) \
                                   : __builtin_amdgcn_mfma_f32_16x16x32_bf16(At[m][k], Bt[n][k], acc[ai][bj][m][n], 0, 0, 0); __builtin_amdgcn_s_setprio(0); } while (0)
#define PG8_WAIT_V(n) asm volatile("s_waitcnt vmcnt(" #n ")" ::: "memory")
#define PG8_WAIT_L(n) asm volatile("s_waitcnt lgkmcnt(" #n ")" ::: "memory")
#define PG8_BAR __builtin_amdgcn_s_barrier()
#define PG8_SCHED __builtin_amdgcn_sched_barrier(0)
  Unit cur, nxt; int ui = 0;
  if (!S.next(0, cur)) return;
  f32x4 acc[2][2][4][2];
#pragma unroll
  for (int a = 0; a < 2; ++a)
#pragma unroll
    for (int b = 0; b < 2; ++b)
#pragma unroll
      for (int m = 0; m < 4; ++m)
#pragma unroll
        for (int n = 0; n < 2; ++n) acc[a][b][m][n] = (f32x4){0.f, 0.f, 0.f, 0.f};
  bf16x8 At[4][2], B0[2][2], B1[2][2];
  const char* cA = (const char*)g.A + (size_t)cur.pm * tstepA; const char* cB = (const char*)g.Bt + (size_t)cur.pn * tstepB;
  PG8_STAGE(PG8_SB(0, 0), cB, voffB); PG8_STAGE(PG8_SA(0, 0), cA, voffA); PG8_STAGE(PG8_SB(0, 1), cB + hstepB, voffB); PG8_STAGE(PG8_SA(0, 1), cA + hstepA, voffA);
  if (wr == 1) PG8_BAR;
  PG8_WAIT_V(4); PG8_BAR;
  PG8_STAGE(PG8_SB(1, 0), cB + kstep, voffB); PG8_STAGE(PG8_SA(1, 0), cA + kstep, voffA); PG8_STAGE(PG8_SB(1, 1), cB + hstepB + kstep, voffB);
  PG8_WAIT_V(6); PG8_BAR;
  for (;;) {
    const bool has_next = S.next(ui + 1, nxt);
    const char* nA = has_next ? (const char*)g.A + (size_t)nxt.pm * tstepA : cA; const char* nB = has_next ? (const char*)g.Bt + (size_t)nxt.pn * tstepB : cB;
    for (int t = 0; t < nt; t += 2) {
      const bool last = (t == nt - 2);
      const char* a1 = cA + (size_t)(t + 1) * kstep;
      const char* a2 = last ? nA : cA + (size_t)(t + 2) * kstep; const char* b2 = last ? nB : cB + (size_t)(t + 2) * kstep;
      const char* a3 = a2 + kstep; const char* b3 = b2 + kstep;
      PG8_LDB(B0, 0, 0); PG8_SCHED; PG8_LDA(At, 0, 0); PG8_STAGE(PG8_SA(1, 1), a1 + hstepA, voffA);
      PG8_WAIT_L(8); PG8_BAR; PG8_WAIT_L(0); PG8_MMA(0, 0, At, B0); PG8_BAR; PG8_SCHED;
      PG8_LDB(B1, 0, 1); PG8_STAGE(PG8_SB(0, 0), b2, voffB);
      PG8_BAR; PG8_WAIT_L(0); PG8_MMA(0, 1, At, B1); PG8_BAR;
      PG8_LDA(At, 0, 1); PG8_STAGE(PG8_SA(0, 0), a2, voffA);
      PG8_BAR; PG8_WAIT_L(0); PG8_MMA(1, 0, At, B0); PG8_BAR; PG8_SCHED;
      PG8_STAGE(PG8_SB(0, 1), b2 + hstepB, voffB);
      PG8_WAIT_V(6); PG8_BAR; PG8_MMA(1, 1, At, B1); PG8_BAR;
      PG8_LDB(B0, 1, 0); PG8_SCHED; PG8_LDA(At, 1, 0); PG8_STAGE(PG8_SA(0, 1), a2 + hstepA, voffA);
      PG8_WAIT_L(8); PG8_BAR; PG8_WAIT_L(0); PG8_MMA(0, 0, At, B0); PG8_BAR; PG8_SCHED;
      PG8_LDB(B1, 1, 1); PG8_STAGE(PG8_SB(1, 0), b3, voffB);
      PG8_BAR; PG8_WAIT_L(0); PG8_MMA(0, 1, At, B1); PG8_BAR;
      PG8_LDA(At, 1, 1); PG8_STAGE(PG8_SA(1, 0), a3, voffA);
      PG8_BAR; PG8_WAIT_L(0); PG8_MMA(1, 0, At, B0); PG8_BAR; PG8_SCHED;
      PG8_STAGE(PG8_SB(1, 1), b3 + hstepB, voffB);
      PG8_WAIT_V(6); PG8_BAR; PG8_MMA(1, 1, At, B1); PG8_BAR;
    }
    E(acc, cur, wr, wc, fr, fq);
    if (!has_next) break;
#pragma unroll
    for (int a = 0; a < 2; ++a)
#pragma unroll
      for (int b = 0; b < 2; ++b)
#pragma unroll
        for (int m = 0; m < 4; ++m)
#pragma unroll
          for (int n = 0; n < 2; ++n) acc[a][b][m][n] = (f32x4){0.f, 0.f, 0.f, 0.f};
    cur = nxt; cA = nA; cB = nB; ++ui;
  }
  PG8_WAIT_V(0);
  if (wr == 0) PG8_BAR;
  PG8_BAR;
#undef PG8_SA
#undef PG8_SB
#undef PG8_STAGE
#undef PG8_LDA
#undef PG8_LDB
#undef PG8_MMA
#undef PG8_WAIT_V
#undef PG8_WAIT_L
#undef PG8_BAR
#undef PG8_SCHED
}

struct EpiEvenIn {
  static constexpr bool PERM = true, TRANS = true;
  ushort_t* ps5; ushort_t* prw;
  DEVI void operator()(const f32x4 (&acc)[2][2][4][2], const Unit& u, int wr, int wc, int fr, int fq) const {
#pragma unroll
    for (int ai = 0; ai < 2; ++ai)
#pragma unroll
      for (int m = 0; m < 4; ++m) {
        const size_t row = (size_t)u.pm * BM + ai * HALF + wr * 64 + m * 16 + fr;
#pragma unroll
        for (int bj = 0; bj < 2; ++bj) {
          const int c0 = u.pn * BM + bj * HALF + wc * 32 + 8 * fq;
          const f32x4 v0 = acc[ai][bj][m][0], v1 = acc[ai][bj][m][1];
          u32x4 o = {cvt_pk_bf16(v0[0], v0[1]), cvt_pk_bf16(v0[2], v0[3]), cvt_pk_bf16(v1[0], v1[1]), cvt_pk_bf16(v1[2], v1[3])};
          if (c0 < 1024) *(u32x4*)(ps5 + row * 1024 + c0) = o;
          else if (c0 < 3136) *(u32x4*)(prw + row * 2112 + (c0 - 1024)) = o;
        }
      }
  }
};
struct EpiHyIn {
  static constexpr bool PERM = false, TRANS = false;
  ushort_t* ph;
  DEVI void operator()(const f32x4 (&acc)[2][2][4][2], const Unit& u, int wr, int wc, int fr, int fq) const {
    int s0, L; seq_of(u.pm * BM, s0, L);
#pragma unroll
    for (int ai = 0; ai < 2; ++ai)
#pragma unroll
      for (int m = 0; m < 4; ++m) {
        const int tok = u.pm * BM + ai * HALF + wr * 64 + m * 16 + 4 * fq;
#pragma unroll
        for (int bj = 0; bj < 2; ++bj)
#pragma unroll
          for (int n = 0; n < 2; ++n) {
            const int col = u.pn * BM + bj * HALF + wc * 32 + 16 * n + fr;
            const int st = col >> 10, c = col & 1023;
            const f32x4 v = acc[ai][bj][m][n];
            ushort_t* dst = ph + (size_t)st * T * 1024 + (size_t)s0 * 1024 + (size_t)c * L + (tok - s0);
            *(uint2*)dst = uint2{cvt_pk_bf16(v[0], v[1]), cvt_pk_bf16(v[2], v[3])};
          }
      }
  }
};
struct EpiGlu {
  static constexpr bool PERM = true, TRANS = true;
  ushort_t* y; const ushort_t* ps5; const float* bias;
  DEVI void operator()(const f32x4 (&acc)[2][2][4][2], const Unit& u, int wr, int wc, int fr, int fq) const {
#pragma unroll
    for (int ai = 0; ai < 2; ++ai)
#pragma unroll
      for (int m = 0; m < 4; ++m) {
        const size_t row = (size_t)u.pm * BM + ai * HALF + wr * 64 + m * 16 + fr;
#pragma unroll
        for (int bj = 0; bj < 2; ++bj) {
          const int c0 = u.pn * BM + bj * HALF + wc * 32 + 8 * fq;
          const u32x4 a8 = *(const u32x4*)(y + row * 1024 + 512 + c0);
          const u32x4 g8 = *(const u32x4*)(ps5 + row * 1024 + 512 + c0);
          const f32x4 b0 = *(const f32x4*)(bias + c0), b1 = *(const f32x4*)(bias + c0 + 4);
          float v[8];
#pragma unroll
          for (int e = 0; e < 4; ++e) { v[e] = acc[ai][bj][m][0][e] + b0[e]; v[4 + e] = acc[ai][bj][m][1][e] + b1[e]; }
          unsigned o[4];
#pragma unroll
          for (int e = 0; e < 4; ++e) {
            const float a_lo = __uint_as_float(a8[e] << 16), a_hi = __uint_as_float(a8[e] & 0xffff0000u);
            const float g_lo = __uint_as_float(g8[e] << 16), g_hi = __uint_as_float(g8[e] & 0xffff0000u);
            const float r_lo = a_lo * sigmoidf_(v[2 * e]) * (g_lo * sigmoidf_(g_lo));
            const float r_hi = a_hi * sigmoidf_(v[2 * e + 1]) * (g_hi * sigmoidf_(g_hi));
            o[e] = cvt_pk_bf16(r_lo, r_hi);
          }
          *(u32x4*)(y + row * 1024 + c0) = u32x4{o[0], o[1], o[2], o[3]};
        }
      }
  }
};
struct EpiF16 {
  static constexpr bool PERM = true, TRANS = true;
  ushort_t* C;
  DEVI void operator()(const f32x4 (&acc)[2][2][4][2], const Unit& u, int wr, int wc, int fr, int fq) const {
#pragma unroll
    for (int ai = 0; ai < 2; ++ai)
#pragma unroll
      for (int m = 0; m < 4; ++m) {
        ushort_t* rowp = C + ((size_t)u.pm * BM + ai * HALF + wr * 64 + m * 16 + fr) * 1024 + u.pn * BM + wc * 32 + 8 * fq;
#pragma unroll
        for (int bj = 0; bj < 2; ++bj) {
          const f32x4 v0 = acc[ai][bj][m][0], v1 = acc[ai][bj][m][1];
          *(u32x4*)(rowp + bj * HALF) = u32x4{cvt_pk_bf16(v0[0], v0[1]), cvt_pk_bf16(v0[2], v0[3]), cvt_pk_bf16(v1[0], v1[1]), cvt_pk_bf16(v1[2], v1[3])};
        }
      }
  }
};
}

template <class Epi>
DEVI void run_gemm(unsigned char* lds, const ushort_t* A, int lda, const ushort_t* Bt, int N, int K, const Epi& E) {
  pg8::Gemm g; g.A = A; g.Bt = Bt; g.M = T; g.N = N; g.K = K; g.lda = lda;
  pg8::StaticOrder S; S.init(T, N, (int)gridDim.x, bidx());
  __syncthreads();
  pg8::gemm_phase<Epi>((PG8_LAS unsigned char*)lds, g, S, E);
  __syncthreads();
}

__device__ void xb_convert(const Params& p, ushort_t* XB) {
  const size_t n4 = (size_t)T * 1024 / 4, np4 = (size_t)TPROMPT * 1024 / 4;
  const float4* xp = (const float4*)p.in[I_XP]; const float4* xs = (const float4*)p.in[I_XS];
  for (size_t e = (size_t)bidx() * NT + tidx(); e < n4; e += (size_t)gridDim.x * NT) {
    const float4 v = e < np4 ? xp[e] : xs[e - np4];
    ((uint2*)XB)[e] = uint2{pack2(v.x, v.y), pack2(v.z, v.w)};
  }
}
__device__ void zero_fill(ushort_t* dst, size_t n) {
  for (size_t e = (size_t)bidx() * NT + tidx(); e < n / 8; e += (size_t)gridDim.x * NT) ((uint4*)dst)[e] = uint4{0, 0, 0, 0};
}
__device__ void hy_transpose(const ushort_t* __restrict__ PH3, ushort_t* __restrict__ Y, unsigned char* lds) {
  ushort_t* tile = (ushort_t*)lds;
  const int tid = tidx(), r = tid >> 3, c8 = (tid & 7) * 8;
  for (int t = bidx(); t < (T / 64) * 16; t += gridDim.x) {
    const int tok0 = (t >> 4) * 64, c0 = (t & 15) * 64;
    int s0, L; seq_of(tok0, s0, L);
    const uint4 v = *(const uint4*)(PH3 + (size_t)s0 * 1024 + (size_t)(c0 + r) * L + (tok0 - s0) + c8);
    __syncthreads();
    *(uint4*)(tile + r * 72 + c8) = v;
    __syncthreads();
    unsigned o[4];
#pragma unroll
    for (int e = 0; e < 4; ++e) o[e] = (unsigned)tile[(c8 + 2 * e) * 72 + r] | ((unsigned)tile[(c8 + 2 * e + 1) * 72 + r] << 16);
    *(uint4*)(Y + (size_t)(tok0 + r) * 1024 + c0 + c8) = uint4{o[0], o[1], o[2], o[3]};
  }
}

__device__ void ln_phase(const Params& p, int layer, const ushort_t* __restrict__ F, ushort_t* __restrict__ XB, bool dry = false) {
  const int lane = tidx() & 63, gw = bidx() * (NT / 64) + (tidx() >> 6), nw = gridDim.x * (NT / 64);
  const float alpha = 1.681792830507429f;
  const float4* g4 = (const float4*)(p.in[I_LNG] + layer * 1024);
  const float4* b4 = (const float4*)(p.in[I_LNB] + layer * 1024);
  const XSrc xs_ = xsrc(p);
  for (int row0 = gw; row0 < T / 2; row0 += nw) {
    float4 v[2][4];
#pragma unroll
    for (int h = 0; h < 2; ++h) {
      const int row = row0 + h * (T / 2);
      const float4* x4 = (const float4*)xrow(xs_, layer, row);
      const uint2* f2 = (const uint2*)(F + (size_t)row * 1024);
#pragma unroll
      for (int e = 0; e < 4; ++e) {
        const float4 a = x4[lane + 64 * e];
        const uint2 fw = f2[lane + 64 * e];
        const float4 f = float4{__uint_as_float(fw.x << 16), __uint_as_float(fw.x & 0xffff0000u), __uint_as_float(fw.y << 16), __uint_as_float(fw.y & 0xffff0000u)};
        v[h][e] = float4{alpha * a.x + f.x, alpha * a.y + f.y, alpha * a.z + f.z, alpha * a.w + f.w};
      }
    }
#pragma unroll
    for (int h = 0; h < 2; ++h) {
      const int row = row0 + h * (T / 2);
      float s = 0.f;
#pragma unroll
      for (int e = 0; e < 4; ++e) s += v[h][e].x + v[h][e].y + v[h][e].z + v[h][e].w;
      const float mean = wsum(s) * (1.f / 1024.f);
      float q = 0.f;
#pragma unroll
      for (int e = 0; e < 4; ++e) {
        v[h][e].x -= mean; v[h][e].y -= mean; v[h][e].z -= mean; v[h][e].w -= mean;
        q += v[h][e].x * v[h][e].x + v[h][e].y * v[h][e].y + v[h][e].z * v[h][e].z + v[h][e].w * v[h][e].w;
      }
      const float rs = rsqrtf(wsum(q) * (1.f / 1024.f) + 1e-5f);
      float4* o4 = (float4*)(p.out + (size_t)row * 1024);
#pragma unroll
      for (int e = 0; e < 4; ++e) {
        const float4 g = g4[lane + 64 * e], b = b4[lane + 64 * e];
        const float4 o = float4{v[h][e].x * rs * g.x + b.x, v[h][e].y * rs * g.y + b.y, v[h][e].z * rs * g.z + b.z, v[h][e].w * rs * g.w + b.w};
        if (!dry) o4[lane + 64 * e] = o;
        if (XB) ((uint2*)(XB + (size_t)row * 1024))[lane + 64 * e] = uint2{pack2(o.x, o.y), pack2(o.z, o.w)};
      }
    }
  }
}

struct cplx { float x, y; };
DEVI cplx cmul(cplx a, cplx b) { return cplx{a.x * b.x - a.y * b.y, a.x * b.y + a.y * b.x}; }
DEVI void s5_consts(const Params& p, int i, int d, int g, int n, cplx& lb, cplx& coef) {
  const int idx = ((i * 2 + d) * 32 + g) * 64 + n;
  const float lre = p.in[I_LRE][idx], lim = p.in[I_LIM][idx];
  const float dt = expf(p.in[I_LSTEP][(i * 2 + d) * 32 + g]);
  const float mag = expf(lre * dt);
  float sn, cs; sincosf(lim * dt, &sn, &cs);
  lb = cplx{mag * cs, mag * sn};
  const float nr = lb.x - 1.f, ni = lb.y, den = 1.f / (lre * lre + lim * lim);
  coef = cplx{(nr * lre + ni * lim) * den, (ni * lre - nr * lim) * den};
}
DEVI void s5_load_u(const ushort_t* PS5, int tok0, int g, int lane, uint4& a, uint4& b) {
  const uint4* src = (const uint4*)(PS5 + (size_t)(tok0 + lane) * 1024 + g * 16);
  a = src[0]; b = src[1];
}
DEVI void s5_store_u(float* U, int lane, const uint4& a, const uint4& b) {
  float4* d = (float4*)(U + lane * 16);
  d[0] = float4{__uint_as_float(a.x << 16), __uint_as_float(a.x & 0xffff0000u), __uint_as_float(a.y << 16), __uint_as_float(a.y & 0xffff0000u)};
  d[1] = float4{__uint_as_float(a.z << 16), __uint_as_float(a.z & 0xffff0000u), __uint_as_float(a.w << 16), __uint_as_float(a.w & 0xffff0000u)};
  d[2] = float4{__uint_as_float(b.x << 16), __uint_as_float(b.x & 0xffff0000u), __uint_as_float(b.y << 16), __uint_as_float(b.y & 0xffff0000u)};
  d[3] = float4{__uint_as_float(b.z << 16), __uint_as_float(b.z & 0xffff0000u), __uint_as_float(b.w << 16), __uint_as_float(b.w & 0xffff0000u)};
}
DEVI f32x2 cmul2(f32x2 a, f32x2 b) { return f32x2{a.x, a.x} * b + f32x2{a.y, a.y} * f32x2{-b.y, b.x}; }
#define S5_BU2(Urow, acc2)                                                            \
  {                                                                                   \
    const float4* u4 = (const float4*)(Urow);                                         \
    _Pragma("unroll") for (int pp = 0; pp < 4; ++pp) {                                \
      const float4 u = u4[pp];                                                        \
      acc2 = B2[4 * pp] * f32x2{u.x, u.x} + acc2; acc2 = B2[4 * pp + 1] * f32x2{u.y, u.y} + acc2; \
      acc2 = B2[4 * pp + 2] * f32x2{u.z, u.z} + acc2; acc2 = B2[4 * pp + 3] * f32x2{u.w, u.w} + acc2; \
    }                                                                                 \
  }

__device__ void s5_passA(const Params& p, int i, unsigned char* lds) {
  const ushort_t* PS5 = (const ushort_t*)(p.ws + OFF_PS5);
  cplx* CAR = (cplx*)(p.ws + OFF_CAR);
  const int lane = tidx() & 63, wave = tidx() >> 6;
  float* U = (float*)(lds + wave * 8448);
  for (int item = bidx() * 8 + wave; item < 192 * 32; item += gridDim.x * 8) {
    const int q = item >> 5, g = item & 31;
    cplx lb0, c0, lb1, c1;
    s5_consts(p, i, 0, g, lane, lb0, c0);
    s5_consts(p, i, 1, g, lane, lb1, c1);
    const f32x2 l0 = {lb0.x, lb0.y}, l1 = {lb1.x, lb1.y};
    f32x2 B2[16];
#pragma unroll
    for (int pp = 0; pp < 16; ++pp) B2[pp] = f32x2{p.in[I_BRE][((i * 32 + g) * 64 + lane) * 16 + pp], p.in[I_BIM][((i * 32 + g) * 64 + lane) * 16 + pp]};
    f32x2 xf = {0.f, 0.f}, xb = {0.f, 0.f}, pw = {1.f, 0.f};
    uint4 ua, ub;
    s5_load_u(PS5, q * 256, g, lane, ua, ub);
    for (int sb = 0; sb < 4; ++sb) {
      wave_sync();
      s5_store_u(U, lane, ua, ub);
      wave_sync();
      if (sb < 3) s5_load_u(PS5, q * 256 + (sb + 1) * 64, g, lane, ua, ub);
#pragma unroll 4
      for (int t = 0; t < 64; ++t) {
        f32x2 bu = {0.f, 0.f};
        S5_BU2(U + t * 16, bu);
        xf = cmul2(l0, xf) + bu;
        xb = cmul2(pw, bu) + xb;
        pw = cmul2(pw, l1);
      }
    }
    CAR[((size_t)(q * 32 + g) * 2 + 0) * 64 + lane] = cmul(cplx{xf.x, xf.y}, c0);
    CAR[((size_t)(q * 32 + g) * 2 + 1) * 64 + lane] = cmul(cplx{xb.x, xb.y}, c1);
  }
}

__device__ void s5_passC(const Params& p, int i, unsigned char* lds) {
  const ushort_t* PS5 = (const ushort_t*)(p.ws + OFF_PS5);
  const cplx* CAR = (const cplx*)(p.ws + OFF_CAR);
  float* YS = (float*)(p.ws + OFF_YS);
  ushort_t* YG = (ushort_t*)(p.ws + OFF_Y);
  const int lane = tidx() & 63, wave = tidx() >> 6;
  float* U = (float*)(lds + wave * 8448);
  ushort_t* X = (ushort_t*)(lds + wave * 8448 + 4096);
  for (int item = bidx() * 8 + wave; item < 192 * 32; item += gridDim.x * 8) {
    const int q = item >> 5, g = item & 31;
    int cs, ce;
    if (q < 64) { cs = q & ~15; ce = cs + 16; } else { cs = 64 + ((q - 64) & ~63); ce = cs + 64; }
    const int pcol = lane & 15;
    const float dd = p.in[I_S5D][i * 512 + g * 16 + pcol];
    for (int d = 0; d < 2; ++d) {
      cplx lb, coef;
      s5_consts(p, i, d, g, lane, lb, coef);
      const f32x2 l2 = {lb.x, lb.y};
      f32x2 B2[16];
#pragma unroll
      for (int pp = 0; pp < 16; ++pp) {
        const cplx bb = cmul(coef, cplx{p.in[I_BRE][((i * 32 + g) * 64 + lane) * 16 + pp], p.in[I_BIM][((i * 32 + g) * 64 + lane) * 16 + pp]});
        B2[pp] = f32x2{bb.x, bb.y};
      }
      cplx lp = lb;
#pragma unroll
      for (int e = 0; e < 8; ++e) lp = cmul(lp, lp);
      cplx xs{0.f, 0.f};
      if (d == 0) {
#pragma unroll 8
        for (int j = cs; j < q; ++j) { xs = cmul(lp, xs); cplx c = CAR[((size_t)(j * 32 + g) * 2 + 0) * 64 + lane]; xs.x += c.x; xs.y += c.y; } }
      else {
#pragma unroll 8
        for (int j = ce - 1; j > q; --j) { xs = cmul(lp, xs); cplx c = CAR[((size_t)(j * 32 + g) * 2 + 1) * 64 + lane]; xs.x += c.x; xs.y += c.y; } }
      f32x2 x2 = {xs.x, xs.y};
      bf16x8 cf[4];
#pragma unroll
      for (int kk = 0; kk < 4; ++kk) {
        const int n0 = (kk & 1) * 32 + (lane >> 4) * 8;
        const float* src = (kk < 2 ? p.in[I_CRE] : p.in[I_CIM]) + (((size_t)(i * 2 + d) * 32 + g) * 16 + pcol) * 64 + n0;
        const float sg = kk < 2 ? 1.f : -1.f;
#pragma unroll
        for (int j = 0; j < 8; ++j) cf[kk][j] = (short)f2bf(sg * src[j]);
      }
      uint4 ua, ub;
      s5_load_u(PS5, q * 256 + (d ? 3 : 0) * 64, g, lane, ua, ub);
      for (int sbi = 0; sbi < 4; ++sbi) {
        const int sb = d ? 3 - sbi : sbi;
        wave_sync();
        s5_store_u(U, lane, ua, ub);
        wave_sync();
        if (sbi < 3) s5_load_u(PS5, q * 256 + (d ? 2 - sbi : sbi + 1) * 64, g, lane, ua, ub);
        for (int tbi = 0; tbi < 4; ++tbi) {
          const int tb = d ? 3 - tbi : tbi;
          float ysp[4] = {0.f, 0.f, 0.f, 0.f};
          if (d == 1) {
#pragma unroll
            for (int r = 0; r < 4; ++r) ysp[r] = YS[(size_t)(q * 256 + sb * 64 + tb * 16 + (lane >> 4) * 4 + r) * 512 + g * 16 + pcol];
          }
#pragma unroll 4
          for (int tti = 0; tti < 16; ++tti) {
            const int tt = d ? 15 - tti : tti;
            f32x2 acc2 = cmul2(l2, x2);
            S5_BU2(U + (tb * 16 + tt) * 16, acc2);
            x2 = acc2;
            X[tt * 136 + lane] = f2bf(x2.x);
            X[tt * 136 + 64 + lane] = f2bf(x2.y);
          }
          wave_sync();
          f32x4 acc{0.f, 0.f, 0.f, 0.f};
#pragma unroll
          for (int kk = 0; kk < 4; ++kk) {
            bf16x8 a = *(const bf16x8*)(X + (lane & 15) * 136 + kk * 32 + (lane >> 4) * 8);
            acc = __builtin_amdgcn_mfma_f32_16x16x32_bf16(a, cf[kk], acc, 0, 0, 0);
          }
          wave_sync();
#pragma unroll
          for (int r = 0; r < 4; ++r) {
            const int tl = tb * 16 + (lane >> 4) * 4 + r;
            const size_t o = (size_t)(q * 256 + sb * 64 + tl) * 512 + g * 16 + pcol;
            if (d == 0) YS[o] = acc[r] + dd * U[tl * 16 + pcol];
            else {
              const float yv = ysp[r] + acc[r];
              YG[(size_t)(q * 256 + sb * 64 + tl) * 1024 + 512 + g * 16 + pcol] = f2bf(gelu_tanh(yv));
            }
          }
        }
      }
    }
  }
}

struct RwConst { float mur, muk, muv, mul, w0, a0, kk, ka; };
struct RwRow { float r, k, v, l; };
DEVI RwRow rw_load_row(const ushort_t* PRW, int tok, int s0, int L, int h, int lane) {
  RwRow o{0.f, 0.f, 0.f, 0.f};
  if (tok >= s0 && tok < s0 + L) {
    const ushort_t* row = PRW + (size_t)tok * 2112;
    const int cc = h * 64 + lane;
    o.r = bf2f(row[cc]); o.k = bf2f(row[512 + cc]); o.v = bf2f(row[1024 + cc]); o.l = bf2f(row[2048 + lane]);
  }
  return o;
}
DEVI void rw_prologue(const RwRow& rm, const RwRow& rc, const RwRow& rn, int lane, const RwConst& c, const float* WU, const float* AU,
                      float* LT, float* Wd, float* KKd, float* BBd, float* KDd, float* RRd, float* VVd) {
  const float rr = rc.r + c.mur * (0.5f * (rm.r + rn.r) - rc.r);
  const float kx = rc.k + c.muk * (0.5f * (rm.k + rn.k) - rc.k);
  const float vv = rc.v + c.muv * (0.5f * (rm.v + rn.v) - rc.v);
  float ll = rc.l + c.mul * (0.5f * (rm.l + rn.l) - rc.l);
  ll = lane < 32 ? fast_tanh(ll) : ll;
  wave_sync();
  LT[lane] = ll;
  wave_sync();
  float accw = c.w0, acca = c.a0;
#pragma unroll 2
  for (int j = 0; j < 32; j += 4) {
    float4 lw = *(const float4*)(LT + j), la = *(const float4*)(LT + 32 + j);
    accw += lw.x * WU[(j + 0) * 64 + lane] + lw.y * WU[(j + 1) * 64 + lane] + lw.z * WU[(j + 2) * 64 + lane] + lw.w * WU[(j + 3) * 64 + lane];
    acca += la.x * AU[(j + 0) * 64 + lane] + la.y * AU[(j + 1) * 64 + lane] + la.z * AU[(j + 2) * 64 + lane] + la.w * AU[(j + 3) * 64 + lane];
  }
  const float dec = __builtin_amdgcn_exp2f(-0.8750387749145276f * fast_sigmoid(accw));
  const float a = fast_sigmoid(acca);
  const float kkr = kx * c.kk;
  const float ss = wsum_fast(kkr * kkr);
  const float kkn = kkr * __builtin_amdgcn_rsqf(fmaxf(ss, 1e-24f));
  Wd[lane] = dec; KKd[lane] = kkn; BBd[lane] = kkn * a; KDd[lane] = kx * (1.f + (a - 1.f) * c.ka); RRd[lane] = rr; VVd[lane] = vv;
}

template <int NS>
DEVI void rw_prologue_blk(const RwRow* R, int lane, const RwConst& c, const bf16x8* BF, int dir, ushort_t* LTm,
                          float* Wd, float* KKd, float* BBd, float* KDd, float* RRd, float* VVd) {
#pragma unroll
  for (int e = 0; e < NS; ++e) {
    const RwRow& rm = R[e]; const RwRow& rc = R[e + 1]; const RwRow& rn = R[e + 2];
    const float rr = rc.r + c.mur * (0.5f * (rm.r + rn.r) - rc.r);
    const float kx = rc.k + c.muk * (0.5f * (rm.k + rn.k) - rc.k);
    const float vv = rc.v + c.muv * (0.5f * (rm.v + rn.v) - rc.v);
    float ll = rc.l + c.mul * (0.5f * (rm.l + rn.l) - rc.l);
    ll = lane < 32 ? fast_tanh(ll) : ll;
    RRd[e * 64 + lane] = rr; VVd[e * 64 + lane] = vv; KDd[e * 64 + lane] = kx;
    LTm[e * 72 + lane] = f2bf(ll);
  }
  wave_sync();
  {
    const int row = lane & (NS - 1), kq8 = (lane >> 4) * 8;
    const bf16x8 aw = *(const bf16x8*)(LTm + row * 72 + kq8);
    const bf16x8 aa = *(const bf16x8*)(LTm + row * 72 + 32 + kq8);
#pragma unroll
    for (int nt = 0; nt < 4; ++nt) {
      const f32x4 z = {0.f, 0.f, 0.f, 0.f};
      const f32x4 dw = __builtin_amdgcn_mfma_f32_16x16x32_bf16(aw, BF[(dir * 4 + nt) * 64 + lane], z, 0, 0, 0);
      const f32x4 da = __builtin_amdgcn_mfma_f32_16x16x32_bf16(aa, BF[(8 + nt) * 64 + lane], z, 0, 0, 0);
      if ((lane >> 4) < NS / 4) {
#pragma unroll
        for (int r = 0; r < 4; ++r) {
          const int o = ((lane >> 4) * 4 + r) * 64 + nt * 16 + (lane & 15);
          Wd[o] = dw[r]; BBd[o] = da[r];
        }
      }
    }
  }
  wave_sync();
#pragma unroll
  for (int e = 0; e < NS; ++e) {
    const float accw = c.w0 + Wd[e * 64 + lane], acca = c.a0 + BBd[e * 64 + lane], kx = KDd[e * 64 + lane];
    const float dec = __builtin_amdgcn_exp2f(-0.8750387749145276f * fast_sigmoid(accw));
    const float a = fast_sigmoid(acca);
    const float kkr = kx * c.kk;
    const float ss = wsum_fast(kkr * kkr);
    const float kkn = kkr * __builtin_amdgcn_rsqf(fmaxf(ss, 1e-24f));
    Wd[e * 64 + lane] = dec; KKd[e * 64 + lane] = kkn; BBd[e * 64 + lane] = kkn * a; KDd[e * 64 + lane] = kx * (1.f + (a - 1.f) * c.ka);
  }
}
DEVI void rw_fill_bf(const Params& p, int i, int h, bf16x8* BF, int tid, int nthr = NT) {
  for (int e = tid; e < 768; e += nthr) {
    const int which = e >> 8, nt = (e >> 6) & 3, l = e & 63;
    const int n = nt * 16 + (l & 15), k0 = (l >> 4) * 8;
    const float* src = which < 2 ? p.in[I_WUP] + ((size_t)(i * 2 + which) * 32) * 512 : p.in[I_AUP] + ((size_t)i * 32) * 512;
    bf16x8 v;
#pragma unroll
    for (int jj = 0; jj < 8; ++jj) v[jj] = (short)f2bf(src[(size_t)(k0 + jj) * 512 + h * 64 + n]);
    BF[e] = v;
  }
}

DEVI float dpp_f(float x, const int ctrl_sel) {
  int xi = __builtin_bit_cast(int, x), r;
  if (ctrl_sel == 0) r = __builtin_amdgcn_mov_dpp(xi, 0xB1, 0xf, 0xf, true);
  else if (ctrl_sel == 1) r = __builtin_amdgcn_mov_dpp(xi, 0x4E, 0xf, 0xf, true);
  else r = __builtin_amdgcn_mov_dpp(xi, 0x141, 0xf, 0xf, true);
  return __builtin_bit_cast(float, r);
}
DEVI float red8(float x) { x += dpp_f(x, 0); x += dpp_f(x, 1); x += dpp_f(x, 2); return x; }

#define RW_LOAD8(dst2, base)                                                        \
  { const float4 _a = *(const float4*)(base), _b = *(const float4*)((base) + 4);    \
    dst2[0] = f32x2{_a.x, _a.y}; dst2[1] = f32x2{_a.z, _a.w}; dst2[2] = f32x2{_b.x, _b.y}; dst2[3] = f32x2{_b.z, _b.w}; }

__device__ void rwkv_scan1(const Params& p, int i, unsigned char* lds) {
  const ushort_t* PRW = (const ushort_t*)(p.ws + OFF_PRW);
  float* CH = (float*)(p.ws + OFF_PS5);
  float* YR = (float*)(p.ws + OFF_YS);
  const int tid = tidx(), lane = tid & 63, wave = tid >> 6, pair = wave >> 1, role = (wave ^ (wave >> 2)) & 1;
  const int vq = lane >> 3, kq = lane & 7;
  bf16x8* BF = (bf16x8*)lds;
  float* WV = (float*)(lds + 12288 + pair * 14592);
  float* Wd = WV, *KKd = WV + 512, *BBd = WV + 1024, *KDd = WV + 1536, *RRd = WV + 2048, *VVd = WV + 2560;
  ushort_t* LTm = (ushort_t*)(WV + 3072) + role * 576;
  {
    float4* z = (float4*)YR;
    for (size_t e = (size_t)bidx() * NT + tid; e < (size_t)T * 512 / 4; e += (size_t)gridDim.x * NT) z[e] = float4{0.f, 0.f, 0.f, 0.f};
  }
  for (int bi = bidx(); bi < 768; bi += gridDim.x) {
    const int h = bi / 96, rem = bi % 96;
    const int dir = pair >> 1, q = rem * 2 + (pair & 1);
    __syncthreads();
    rw_fill_bf(p, i, h, BF, tid);
    __syncthreads();
    RwConst c;
    const int cc = h * 64 + lane;
    c.mur = p.in[I_MURKV][(i * 3 + 0) * 512 + cc]; c.muk = p.in[I_MURKV][(i * 3 + 1) * 512 + cc]; c.muv = p.in[I_MURKV][(i * 3 + 2) * 512 + cc];
    c.mul = p.in[I_MULORA][i * 64 + lane];
    c.w0 = p.in[I_W0][(i * 2 + dir) * 512 + cc]; c.a0 = p.in[I_A0][(i * 2 + dir) * 512 + cc];
    c.kk = p.in[I_KK][i * 512 + cc]; c.ka = p.in[I_KA][i * 512 + cc];
    const size_t it = ((size_t)(q * 8 + h) * 2 + dir);
    int sq0, sqL; seq_of(q * 256, sq0, sqL);
    float* Op = CH + it * 8192 + (role ? 0 : 4096);
    f32x2 S2[8][4];
    int diag = (role && vq == kq) ? 1 : 0;
    asm volatile("" : "+v"(diag));
#pragma unroll
    for (int r = 0; r < 8; ++r)
#pragma unroll
      for (int jj = 0; jj < 4; ++jj) S2[r][jj] = f32x2{(diag && (2 * jj == r)) ? 1.f : 0.f, (diag && (2 * jj + 1 == r)) ? 1.f : 0.f};
    const float vsel = role ? 0.f : 1.f;
    for (int blk = 0; blk < 32; ++blk) {
      {
        RwRow R[6];
#pragma unroll
        for (int j = 0; j < 6; ++j) {
          const int st = blk * 8 + role * 4 + j - 1;
          R[j] = rw_load_row(PRW, dir ? (q * 256 + 255 - st) : (q * 256 + st), sq0, sqL, h, lane);
        }
        {
          const int s = role * 4;
          rw_prologue_blk<4>(R, lane, c, BF, dir, LTm, Wd + s * 64, KKd + s * 64, BBd + s * 64, KDd + s * 64, RRd + s * 64, VVd + s * 64);
        }
      }
      __syncthreads();
#pragma unroll 2
      for (int s = 0; s < 8; ++s) {
        f32x2 kk2[4], w2[4], b2[4], kd2[4], vv2[4];
        RW_LOAD8(kk2, KKd + s * 64 + 8 * kq);
        RW_LOAD8(vv2, VVd + s * 64 + 8 * vq);
        RW_LOAD8(w2, Wd + s * 64 + 8 * kq);
        RW_LOAD8(b2, BBd + s * 64 + 8 * kq);
        RW_LOAD8(kd2, KDd + s * 64 + 8 * kq);
        float sa[8];
#pragma unroll
        for (int r = 0; r < 8; ++r) {
          f32x2 a = S2[r][0] * kk2[0];
          a = S2[r][1] * kk2[1] + a; a = S2[r][2] * kk2[2] + a; a = S2[r][3] * kk2[3] + a;
          sa[r] = -red8(a.x + a.y);
        }
#pragma unroll
        for (int r = 0; r < 8; ++r) {
          const float vr = ((r & 1) ? vv2[r >> 1].y : vv2[r >> 1].x) * vsel;
          const f32x2 sa2 = f32x2{sa[r], sa[r]}, v2 = f32x2{vr, vr};
#pragma unroll
          for (int jj = 0; jj < 4; ++jj) S2[r][jj] = S2[r][jj] * w2[jj] + sa2 * b2[jj] + v2 * kd2[jj];
        }
      }
      __syncthreads();
    }
#pragma unroll
    for (int r = 0; r < 8; ++r) {
      float* dst = Op + (8 * vq + r) * 64 + 8 * kq;
      *(float4*)dst = float4{S2[r][0].x, S2[r][0].y, S2[r][1].x, S2[r][1].y};
      *(float4*)(dst + 4) = float4{S2[r][2].x, S2[r][2].y, S2[r][3].x, S2[r][3].y};
    }
  }
}

__device__ void rwkv_scan3(const Params& p, int i, unsigned char* lds, bool dry = false) {
  const ushort_t* PRW = (const ushort_t*)(p.ws + OFF_PRW);
  float* CH = (float*)(p.ws + OFF_PS5);
  float* YR = (float*)(p.ws + OFF_YS);
  const int tid = tidx(), lane = tid & 63, wave = tid >> 6;
  const int vq = lane >> 3, kq = lane & 7;
  const int half = wave >> 2;
  bf16x8* BF = (bf16x8*)lds + half * 768;
  float* WV = (float*)(lds + 24576 + wave * 13440);
  float* Wd = WV, *KKd = WV + 512, *BBd = WV + 1024, *KDd = WV + 1536, *RRd = WV + 2048, *VVd = WV + 2560;
  ushort_t* LTm = (ushort_t*)(WV + 3072);
  for (int tb2 = bidx() * 2; tb2 < 512; tb2 += gridDim.x * 2)
  for (int rnd = 0; rnd < 2; ++rnd) {
    const int tb = tb2 >> 1;
    const int hi = tb * 3 + (rnd == 0 ? half : 2);
    const bool active = (rnd == 0) || (half == 0);
    const int h = hi / 96, rem = hi % 96, cgp = rem >> 1, dir = rem & 1;
    const int q = cgp * 4 + (wave & 3);
    __syncthreads();
    if (active) rw_fill_bf(p, i, h, BF, tid & 255, 256);
    __syncthreads();
    if (!active) continue;
    RwConst c;
    const int cc = h * 64 + lane;
    c.mur = p.in[I_MURKV][(i * 3 + 0) * 512 + cc]; c.muk = p.in[I_MURKV][(i * 3 + 1) * 512 + cc]; c.muv = p.in[I_MURKV][(i * 3 + 2) * 512 + cc];
    c.mul = p.in[I_MULORA][i * 64 + lane];
    c.w0 = p.in[I_W0][(i * 2 + dir) * 512 + cc]; c.a0 = p.in[I_A0][(i * 2 + dir) * 512 + cc];
    c.kk = p.in[I_KK][i * 512 + cc]; c.ka = p.in[I_KA][i * 512 + cc];
    const size_t it = ((size_t)(q * 8 + h) * 2 + dir);
    int sq0, sqL; seq_of(q * 256, sq0, sqL);
    const float* Qp = CH + it * 8192 + 4096;
    f32x2 S2[8][4];
#pragma unroll
    for (int r = 0; r < 8; ++r) {
      const float* src = Qp + (8 * vq + r) * 64 + 8 * kq;
      const float4 a = *(const float4*)src, b = *(const float4*)(src + 4);
      S2[r][0] = f32x2{a.x, a.y}; S2[r][1] = f32x2{a.z, a.w}; S2[r][2] = f32x2{b.x, b.y}; S2[r][3] = f32x2{b.z, b.w};
    }
    for (int blk = 0; blk < 32; ++blk) {
      {
        RwRow R[10];
#pragma unroll
        for (int j = 0; j < 10; ++j) {
          const int st = blk * 8 + j - 1;
          R[j] = rw_load_row(PRW, dir ? (q * 256 + 255 - st) : (q * 256 + st), sq0, sqL, h, lane);
        }
        rw_prologue_blk<8>(R, lane, c, BF, dir, LTm, Wd, KKd, BBd, KDd, RRd, VVd);
      }
      wave_sync();
#pragma unroll 2
      for (int s = 0; s < 8; ++s) {
        f32x2 kk2[4], w2[4], b2[4], kd2[4], vv2[4], r2[4];
        RW_LOAD8(kk2, KKd + s * 64 + 8 * kq);
        RW_LOAD8(vv2, VVd + s * 64 + 8 * vq);
        RW_LOAD8(w2, Wd + s * 64 + 8 * kq);
        RW_LOAD8(b2, BBd + s * 64 + 8 * kq);
        RW_LOAD8(kd2, KDd + s * 64 + 8 * kq);
        RW_LOAD8(r2, RRd + s * 64 + 8 * kq);
        float sa[8];
#pragma unroll
        for (int r = 0; r < 8; ++r) {
          f32x2 a = S2[r][0] * kk2[0];
          a = S2[r][1] * kk2[1] + a; a = S2[r][2] * kk2[2] + a; a = S2[r][3] * kk2[3] + a;
          sa[r] = -red8(a.x + a.y);
        }
        float ysel = 0.f;
#pragma unroll
        for (int r = 0; r < 8; ++r) {
          const float vr = (r & 1) ? vv2[r >> 1].y : vv2[r >> 1].x;
          const f32x2 sa2 = f32x2{sa[r], sa[r]}, v2 = f32x2{vr, vr};
          f32x2 ya = f32x2{0.f, 0.f};
#pragma unroll
          for (int jj = 0; jj < 4; ++jj) {
            S2[r][jj] = S2[r][jj] * w2[jj] + sa2 * b2[jj] + v2 * kd2[jj];
            ya = S2[r][jj] * r2[jj] + ya;
          }
          const float yr = red8(ya.x + ya.y);
          ysel = (kq == r) ? yr : ysel;
        }
        const int st = blk * 8 + s;
        const int tok = dir ? (q * 256 + 255 - st) : (q * 256 + st);
        if (!dry) atomicAdd(YR + (size_t)tok * 512 + h * 64 + lane, ysel);
      }
      wave_sync();
    }
  }
}

__device__ void rwkv_carry(const Params& p, unsigned char* lds, bool dry = false) {
  float* CH = (float*)(p.ws + OFF_PS5);
  float* Ps = (float*)lds;
  float* Ss = Ps + 4096;
  const int tid = tidx(), v = tid >> 4, ks = (tid & 15) * 4;
  for (int bi = bidx(); bi < 192; bi += gridDim.x) {
    const int half = bi & 1, dir = (bi >> 1) & 1, h = (bi >> 2) & 7, s = bi >> 5;
    int cs, n;
    if (s < 4) { cs = s * 16; n = 16; } else { cs = 64 + (s - 4) * 64; n = 64; }
    float4 cur{0.f, 0.f, 0.f, 0.f};
    float4 pq0, pq1, qv;
    {
      const int q = dir ? (cs + n - 1) : cs;
      const float* Pp = CH + ((size_t)(q * 8 + h) * 2 + dir) * 8192;
      pq0 = ((const float4*)Pp)[tid]; pq1 = ((const float4*)Pp)[tid + 512];
      qv = *(const float4*)(Pp + 4096 + (half * 32 + v) * 64 + ks);
    }
    for (int ci = 0; ci < n; ++ci) {
      const int q = dir ? (cs + n - 1 - ci) : (cs + ci);
      float* Pp = CH + ((size_t)(q * 8 + h) * 2 + dir) * 8192;
      float* Qrow = Pp + 4096 + (half * 32 + v) * 64 + ks;
      __syncthreads();
      if (!dry) *(float4*)Qrow = cur;
      if (ci == n - 1) break;
      *(float4*)(Ss + v * 64 + ks) = cur;
      ((float4*)Ps)[tid] = pq0;
      ((float4*)Ps)[tid + 512] = pq1;
      float4 acc = qv;
      if (ci + 2 < n + 1 && ci + 1 < n) {
        const int qn = dir ? (cs + n - 2 - ci) : (cs + ci + 1);
        const float* Pn = CH + ((size_t)(qn * 8 + h) * 2 + dir) * 8192;
        pq0 = ((const float4*)Pn)[tid]; pq1 = ((const float4*)Pn)[tid + 512];
        qv = *(const float4*)(Pn + 4096 + (half * 32 + v) * 64 + ks);
      }
      __syncthreads();
#pragma unroll 8
      for (int j = 0; j < 64; ++j) {
        const float sv = Ss[v * 64 + j];
        const float4 pr = *(const float4*)(Ps + j * 64 + ks);
        acc.x += sv * pr.x; acc.y += sv * pr.y; acc.z += sv * pr.z; acc.w += sv * pr.w;
      }
      cur = acc;
    }
    __syncthreads();
  }
}

__device__ void rwkv_post(const Params& p, int i) {
  const ushort_t* __restrict__ PRW = (const ushort_t*)(p.ws + OFF_PRW);
  const float* __restrict__ YR = (const float*)(p.ws + OFF_YS);
  ushort_t* __restrict__ Y = (ushort_t*)(p.ws + OFF_Y);
  const int lane = tidx() & 63, gw = bidx() * 8 + (tidx() >> 6), nw = gridDim.x * 8;
  for (int item = gw; item < (T / 4) * 8; item += nw) {
    const int tok0 = (item >> 3) * 4, h = item & 7, cc = h * 64 + lane;
    int s0, L; seq_of(tok0, s0, L);
    float r[6], k[6], v[6], g[4], y[4];
#pragma unroll
    for (int j = 0; j < 6; ++j) {
      const int tok = tok0 - 1 + j;
      r[j] = 0.f; k[j] = 0.f; v[j] = 0.f;
      if (tok >= s0 && tok < s0 + L) {
        const ushort_t* row = PRW + (size_t)tok * 2112;
        r[j] = bf2f(row[cc]); k[j] = bf2f(row[512 + cc]); v[j] = bf2f(row[1024 + cc]);
      }
    }
#pragma unroll
    for (int e = 0; e < 4; ++e) { g[e] = bf2f(PRW[(size_t)(tok0 + e) * 2112 + 1536 + cc]); y[e] = YR[(size_t)(tok0 + e) * 512 + cc]; }
    const float mur = p.in[I_MURKV][(i * 3 + 0) * 512 + cc], muk = p.in[I_MURKV][(i * 3 + 1) * 512 + cc], muv = p.in[I_MURKV][(i * 3 + 2) * 512 + cc];
    const float lw = p.in[I_LNXW][i * 512 + cc], lb = p.in[I_LNXB][i * 512 + cc], rk = p.in[I_RK][i * 512 + cc];
#pragma unroll
    for (int e = 0; e < 4; ++e) {
      const float rr = r[e + 1] + mur * (0.5f * (r[e] + r[e + 2]) - r[e + 1]);
      const float kx = k[e + 1] + muk * (0.5f * (k[e] + k[e + 2]) - k[e + 1]);
      const float vv = v[e + 1] + muv * (0.5f * (v[e] + v[e + 2]) - v[e + 1]);
      const float mean = wsum_fast(y[e]) * (1.f / 64.f);
      const float dlt = y[e] - mean;
      const float var = wsum_fast(dlt * dlt) * (1.f / 64.f);
      const float yn = dlt * __builtin_amdgcn_rsqf(var + 64e-5f) * lw + lb;
      const float bonus = wsum_fast(rr * kx * rk) * vv;
      Y[(size_t)(tok0 + e) * 1024 + 512 + cc] = f2bf((yn + bonus) * (g[e] * fast_sigmoid(g[e])));
    }
  }
}

__device__ void hy_filter_mlp(const Params& p, int i) {
  float* H2 = (float*)(p.ws + OFF_H2);
  const int lane = tidx() & 63, gw = bidx() * 8 + (tidx() >> 6), nw = gridDim.x * 8;
  const float fr = p.in[I_FFREQ][i * 64 + lane], b1 = p.in[I_FB1][i * 64 + lane], b2 = p.in[I_FB2][i * 64 + lane];
  for (int row = gw; row < 20480; row += nw) {
    const int L = row < 4096 ? 4096 : 16384, t = row < 4096 ? row : row - 4096;
    const float w = 6.283185307179586f * (float)t / (float)L;
    float z = 0.f;
    if (lane == 0) z = (float)t / (float)(L - 1);
    else if (lane <= 32) {
      const int bi = (lane - 1) & 15;
      const float f = 1e-4f + (float)bi * ((15.f - 1e-4f) / 15.f);
      z = lane <= 16 ? cosf(f * w) : -sinf(f * w);
    }
    float a = b1;
#pragma unroll 3
    for (int k = 0; k < 33; ++k) a += __shfl(z, k) * p.in[I_FW1][((size_t)i * 33 + k) * 64 + lane];
    const float h1 = sinf(fr * a);
    float c = b2;
#pragma unroll 8
    for (int k = 0; k < 64; ++k) c += __shfl(h1, k) * p.in[I_FW2][((size_t)i * 64 + k) * 64 + lane];
    H2[(row < 4096 ? (size_t)0 : (size_t)4096 * 64) + (size_t)lane * L + t] = sinf(fr * c);
  }
}

DEVI constexpr int swz(int i) { return i ^ ((i & 32) ? 21 : 0) ^ ((i & 64) ? 26 : 0); }
DEVI int swzF(int t) { return (swz(t >> 1) << 1) | (t & 1); }
DEVI f32x2 cmul_pk(f32x2 a, float c, float sn) { return a * f32x2{c, c} + f32x2{-a.y, a.x} * f32x2{sn, sn}; }
template <int LOGN, int NSEQ>
__device__ void fft_dif(float2* buf_) {
  constexpr int N = 1 << LOGN;
  f32x2* buf = (f32x2*)buf_;
  const int tid = tidx();
#pragma unroll
  for (int ps = 0; ps < LOGN / 2; ++ps) {
    const int lh = LOGN - 1 - 2 * ps;
    const int h = 1 << lh, hh = h >> 1;
    const float inv2h = 1.f / (float)(2 * h);
#pragma unroll 2
    for (int qg = tid; qg < NSEQ * N / 4; qg += NT) {
      const int q = qg & (N / 4 - 1), sb = (qg >> (LOGN - 2)) << LOGN;
      const int pos = q & (hh - 1), grp = q >> (lh - 1);
      const int e0 = sb + swz((grp << (lh + 1)) + pos);
      const int o1 = swz(hh), o2 = swz(h), o3 = swz(h + hh);
      const f32x2 x0 = buf[e0], x1 = buf[e0 ^ o1], x2 = buf[e0 ^ o2], x3 = buf[e0 ^ o3];
      const float f1 = (float)pos * inv2h;
      const float c1 = __builtin_amdgcn_cosf(f1), s1 = -__builtin_amdgcn_sinf(f1);
      const float c2 = c1 * c1 - s1 * s1, s2 = 2.f * c1 * s1;
      const f32x2 a0 = x0 + x2, a1 = x1 + x3;
      const f32x2 a2 = cmul_pk(x0 - x2, c1, s1);
      const f32x2 t3 = cmul_pk(x1 - x3, c1, s1);
      const f32x2 a3 = f32x2{t3.y, -t3.x};
      buf[e0] = a0 + a1;
      buf[e0 ^ o1] = cmul_pk(a0 - a1, c2, s2);
      buf[e0 ^ o2] = a2 + a3;
      buf[e0 ^ o3] = cmul_pk(a2 - a3, c2, s2);
    }
    __syncthreads();
  }
}
template <int LOGN, int NSEQ>
__device__ void fft_dit_inv(float2* buf_) {
  constexpr int N = 1 << LOGN;
  f32x2* buf = (f32x2*)buf_;
  const int tid = tidx();
#pragma unroll
  for (int ps = 0; ps < LOGN / 2; ++ps) {
    const int lh = 2 * ps;
    const int h = 1 << lh;
    const float inv4h = 1.f / (float)(4 * h);
#pragma unroll 2
    for (int qg = tid; qg < NSEQ * N / 4; qg += NT) {
      const int q = qg & (N / 4 - 1), sb = (qg >> (LOGN - 2)) << LOGN;
      const int pos = q & (h - 1), grp = q >> lh;
      const int e0 = sb + swz((grp << (lh + 2)) + pos);
      const int o1 = swz(h), o2 = swz(2 * h), o3 = swz(3 * h);
      const f32x2 x0 = buf[e0], x1 = buf[e0 ^ o1], x2 = buf[e0 ^ o2], x3 = buf[e0 ^ o3];
      const float f2 = (float)pos * inv4h;
      const float c2 = __builtin_amdgcn_cosf(f2), s2 = __builtin_amdgcn_sinf(f2);
      const float c1 = c2 * c2 - s2 * s2, s1 = 2.f * c2 * s2;
      const f32x2 b1 = cmul_pk(x1, c1, s1), b3 = cmul_pk(x3, c1, s1);
      const f32x2 a0 = x0 + b1, a1 = x0 - b1, a2 = x2 + b3, a3 = x2 - b3;
      const f32x2 cc2 = cmul_pk(a2, c2, s2);
      const f32x2 t3 = cmul_pk(a3, c2, s2);
      const f32x2 cc3 = f32x2{-t3.y, t3.x};
      buf[e0] = a0 + cc2;
      buf[e0 ^ o2] = a0 - cc2;
      buf[e0 ^ o1] = a1 + cc3;
      buf[e0 ^ o3] = a1 - cc3;
    }
    __syncthreads();
  }
}
template <int LOGN, int NSEQ>
__device__ void spectrum_extract(const float2* buf, float4* __restrict__ GPa, float4* __restrict__ GPb, float scale_a, float scale_b) {
  constexpr int Lc = 1 << LOGN;
  for (int jg = tidx(); jg < NSEQ * Lc / 2; jg += NT) {
    const int j = jg & (Lc / 2 - 1), sq = jg >> (LOGN - 1), sb = sq << LOGN;
    float4* GP = sq ? GPb : GPa;
    const float scale = sq ? scale_b : scale_a;
    if (j == 0) {
      const float2 c = buf[sb], ch = buf[sb + 1];
      GP[0] = float4{(c.x + c.y) * scale, (c.x - c.y) * scale, ch.x * scale, -ch.y * scale};
    } else {
      const int pos = 2 * j;
      const int k = (int)(__brev((unsigned)pos) >> (32 - LOGN));
      const int p2 = pos ^ ((1 << (31 - __clz(pos))) - 1);
      const int sp1 = sb + swz(pos), sp2 = sb + swz(p2);
      float2 C1 = buf[sp1], C2 = buf[sp2];
      float2 E{0.5f * (C1.x + C2.x), 0.5f * (C1.y - C2.y)}, D{0.5f * (C1.x - C2.x), 0.5f * (C1.y + C2.y)};
      float2 O{D.y, -D.x};
      const float f = (float)k * (1.f / (float)(2 * Lc));
      const float wc = __builtin_amdgcn_cosf(f), wsn = -__builtin_amdgcn_sinf(f);
      float2 wO{wc * O.x - wsn * O.y, wc * O.y + wsn * O.x};
      GP[j] = float4{(E.x + wO.x) * scale, (E.y + wO.y) * scale, (E.x - wO.x) * scale, -(E.y - wO.y) * scale};
    }
  }
}
template <int LOGN, int NSEQ>
__device__ void spectrum_mul(float2* buf, const float4* __restrict__ GP) {
  constexpr int Lc = 1 << LOGN;
  for (int jg = tidx(); jg < NSEQ * Lc / 2; jg += NT) {
    const int j = jg & (Lc / 2 - 1), sb = (jg >> (LOGN - 1)) << LOGN;
    const float4 gp = GP[j];
    if (j == 0) {
      const float2 c = buf[sb], ch = buf[sb + 1];
      const float Y0 = (c.x + c.y) * gp.x, YL = (c.x - c.y) * gp.y;
      buf[sb] = float2{0.5f * (Y0 + YL), 0.5f * (Y0 - YL)};
      buf[sb + 1] = float2{ch.x * gp.z + ch.y * gp.w, ch.y * gp.z - ch.x * gp.w};
    } else {
      const int pos = 2 * j;
      const int k = (int)(__brev((unsigned)pos) >> (32 - LOGN));
      const int p2 = pos ^ ((1 << (31 - __clz(pos))) - 1);
      const int sp1 = sb + swz(pos), sp2 = sb + swz(p2);
      float2 C1 = buf[sp1], C2 = buf[sp2];
      float2 E{0.5f * (C1.x + C2.x), 0.5f * (C1.y - C2.y)}, D{0.5f * (C1.x - C2.x), 0.5f * (C1.y + C2.y)};
      float2 O{D.y, -D.x};
      const float f = (float)k * (1.f / (float)(2 * Lc));
      const float wc = __builtin_amdgcn_cosf(f), wsn = -__builtin_amdgcn_sinf(f);
      float2 wO{wc * O.x - wsn * O.y, wc * O.y + wsn * O.x};
      float2 X1{E.x + wO.x, E.y + wO.y}, X2{E.x - wO.x, -(E.y - wO.y)};
      float2 Y1{X1.x * gp.x - X1.y * gp.y, X1.x * gp.y + X1.y * gp.x};
      float2 Y2{X2.x * gp.z - X2.y * gp.w, X2.x * gp.w + X2.y * gp.z};
      float2 Ye{0.5f * (Y1.x + Y2.x), 0.5f * (Y1.y - Y2.y)};
      float2 Dd{0.5f * (Y1.x - Y2.x), 0.5f * (Y1.y + Y2.y)};
      float2 Yo{wc * Dd.x + wsn * Dd.y, wc * Dd.y - wsn * Dd.x};
      buf[sp1] = float2{Ye.x - Yo.y, Ye.y + Yo.x};
      buf[sp2] = float2{Ye.x + Yo.y, -Ye.y + Yo.x};
    }
  }
}

template <int LOGN>
__device__ void hy_conv_item(const Params& p, int i, int c, unsigned char* lds, bool dry) {
  constexpr int Lc = 1 << LOGN;
  constexpr int L = Lc;
  constexpr int NB = (LOGN == 14) ? 2 : 4;
  constexpr int NSEQ = (LOGN == 14) ? 1 : 4;
  constexpr int LOG8 = LOGN - 3;
  const int tid = tidx();
  float2* buf = (float2*)lds;
  float* bufF = (float*)lds;
  float* W3s = (float*)(lds + 131072);
  float* red = W3s + 256;
  float4* GS = (float4*)(p.ws + OFF_GS + (size_t)bidx() * 2 * GS_PER);
  float4* GS1 = GS + GS_PER / 16;
  float* G1tmp = (float*)GS1;
  float* Z1 = (float*)(p.ws + OFF_Z1 + (size_t)bidx() * 65536);
  const float* H2 = (const float*)(p.ws + OFF_H2) + (LOGN == 14 ? (size_t)4096 * 64 : 0);
  const ushort_t* PH = (const ushort_t*)(p.ws + OFF_PH);
  const float delta = 4.605170185988091f * (1.f / 1.5f + (1.f / 0.3f - 1.f / 1.5f) * (float)c / 1023.f);
  __syncthreads();
  if (tid < 256) {
    const int j = tid >> 2, col = tid & 3, o = col >> 1, dirr = col & 1;
    W3s[tid] = p.in[I_FW3][((size_t)i * 64 + j) * 4096 + (dirr * 2 + o) * 1024 + c];
  }
  __syncthreads();
  float ss0 = 0.f, ss1 = 0.f;
  for (int t0 = tid * 4; t0 < L; t0 += NT * 4) {
    float acc[4][4];
#pragma unroll
    for (int r = 0; r < 4; ++r)
#pragma unroll
      for (int cc = 0; cc < 4; ++cc) acc[r][cc] = 0.f;
#pragma unroll 1
    for (int jb = 0; jb < 64; jb += 16) {
      float4 hv[16];
#pragma unroll
      for (int jj = 0; jj < 16; ++jj) hv[jj] = *(const float4*)(H2 + (size_t)(jb + jj) * L + t0);
#pragma unroll
      for (int jj = 0; jj < 16; ++jj) {
        const float4 w = *(const float4*)(W3s + 4 * (jb + jj));
        acc[0][0] += hv[jj].x * w.x; acc[0][1] += hv[jj].x * w.y; acc[0][2] += hv[jj].x * w.z; acc[0][3] += hv[jj].x * w.w;
        acc[1][0] += hv[jj].y * w.x; acc[1][1] += hv[jj].y * w.y; acc[1][2] += hv[jj].y * w.z; acc[1][3] += hv[jj].y * w.w;
        acc[2][0] += hv[jj].z * w.x; acc[2][1] += hv[jj].z * w.y; acc[2][2] += hv[jj].z * w.z; acc[2][3] += hv[jj].z * w.w;
        acc[3][0] += hv[jj].w * w.x; acc[3][1] += hv[jj].w * w.y; acc[3][2] += hv[jj].w * w.z; acc[3][3] += hv[jj].w * w.w;
      }
    }
#pragma unroll
    for (int r = 0; r < 4; ++r) {
      const int t = t0 + r;
      const float dec = expf(-((float)t * (1.f / (float)(L - 1))) * delta);
      const float d0 = acc[r][0] * dec, d1 = acc[r][1] * dec, d2 = acc[r][2] * dec, d3 = acc[r][3] * dec;
      ss0 += d0 * d0 + d1 * d1;
      ss1 += d2 * d2 + d3 * d3;
      if (NSEQ >= 2) {
        bufF[swzF(t)] = d0; bufF[2 * L + swzF(t)] = d2;
        if (t >= 1) { bufF[swzF(2 * L - t)] = d1; bufF[2 * L + swzF(2 * L - t)] = d3; } else { bufF[swzF(L)] = 0.f; bufF[2 * L + swzF(L)] = 0.f; }
      } else {
        bufF[swzF(t)] = d0; G1tmp[t] = d2;
        if (t >= 1) { bufF[swzF(2 * L - t)] = d1; G1tmp[2 * L - t] = d3; } else { bufF[swzF(L)] = 0.f; G1tmp[L] = 0.f; }
      }
    }
  }
  ss0 = wsum(ss0); ss1 = wsum(ss1);
  if ((tid & 63) == 0) { red[tid >> 6] = ss0; red[8 + (tid >> 6)] = ss1; }
  __syncthreads();
  float tot0 = 0.f, tot1 = 0.f;
#pragma unroll
  for (int w = 0; w < 8; ++w) { tot0 += red[w]; tot1 += red[8 + w]; }
  const float sc0 = rsqrtf(tot0) * (1.f / (float)Lc), sc1 = rsqrtf(tot1) * (1.f / (float)Lc);
  if (NSEQ >= 2) {
    fft_dif<LOGN, 2>(buf);
    spectrum_extract<LOGN, 2>(buf, GS, GS1, sc0, sc1);
  } else {
    fft_dif<LOGN, 1>(buf);
    spectrum_extract<LOGN, 1>(buf, GS, GS, sc0, sc0);
    __syncthreads();
    for (int t = tid; t < L; t += NT) buf[swz(t)] = ((const float2*)G1tmp)[t];
    __syncthreads();
    fft_dif<LOGN, 1>(buf);
    spectrum_extract<LOGN, 1>(buf, GS1, GS1, sc1, sc1);
  }
  __threadfence_block();
  __syncthreads();
  const float* sw = p.in[I_HSW] + (size_t)i * 3 * 3072;
  const float* sbias = p.in[I_HSB] + (size_t)i * 3072;
  float cw[3][3], cb[3];
#pragma unroll
  for (int st = 0; st < 3; ++st) {
#pragma unroll
    for (int k = 0; k < 3; ++k) cw[st][k] = sw[k * 3072 + st * 1024 + c];
    cb[st] = sbias[st * 1024 + c];
  }
  const float fb0 = p.in[I_FBIAS][((size_t)i * 2 + 0) * 1024 + c], fb1 = p.in[I_FBIAS][((size_t)i * 2 + 1) * 1024 + c];
  auto conv8 = [&](const ushort_t* sp, int st, int t0, float* y) {
    const uint4 v = *(const uint4*)(sp + t0);
    const float xm = t0 > 0 ? bf2f(sp[t0 - 1]) : 0.f, xn = t0 + 8 < L ? bf2f(sp[t0 + 8]) : 0.f;
    const float x[10] = {xm, __uint_as_float(v.x << 16), __uint_as_float(v.x & 0xffff0000u), __uint_as_float(v.y << 16), __uint_as_float(v.y & 0xffff0000u),
                         __uint_as_float(v.z << 16), __uint_as_float(v.z & 0xffff0000u), __uint_as_float(v.w << 16), __uint_as_float(v.w & 0xffff0000u), xn};
#pragma unroll
    for (int j = 0; j < 8; ++j) y[j] = cw[st][0] * x[j] + cw[st][1] * x[j + 1] + cw[st][2] * x[j + 2] + cb[st];
  };
  for (int b0 = 0; b0 < NB; b0 += NSEQ) {
    __syncthreads();
    for (int w = tid; w < NSEQ * (L / 8); w += NT) {
      const int sq = w >> LOG8, t0 = (w & (L / 8 - 1)) * 8;
      const int s0 = (LOGN == 14) ? (TPROMPT + (b0 + sq) * 16384) : ((b0 + sq) * 4096);
      const ushort_t* pv = PH + (size_t)s0 * 1024 + (size_t)c * L;
      float y[8]; conv8(pv, 0, t0, y);
#pragma unroll
      for (int j = 0; j < 4; ++j) { buf[sq * Lc + swz((t0 >> 1) + j)] = float2{y[2 * j], y[2 * j + 1]}; buf[sq * Lc + swz(L / 2 + (t0 >> 1) + j)] = float2{0.f, 0.f}; }
    }
    __syncthreads();
    fft_dif<LOGN, NSEQ>(buf);
    spectrum_mul<LOGN, NSEQ>(buf, GS);
    __syncthreads();
    fft_dit_inv<LOGN, NSEQ>(buf);
    for (int w = tid; w < NSEQ * (L / 8); w += NT) {
      const int sq = w >> LOG8, t0 = (w & (L / 8 - 1)) * 8;
      const int s0 = (LOGN == 14) ? (TPROMPT + (b0 + sq) * 16384) : ((b0 + sq) * 4096);
      const ushort_t* pv = PH + (size_t)s0 * 1024 + (size_t)c * L;
      const ushort_t* px1 = pv + (size_t)T * 1024;
      float z0[8], xa[8]; conv8(pv, 0, t0, z0); conv8(px1, 1, t0, xa);
      float z1[8];
#pragma unroll
      for (int j = 0; j < 4; ++j) {
        const int e = sq * Lc + swz((t0 >> 1) + j);
        const float2 zc = buf[e];
        z1[2 * j] = xa[2 * j] * (zc.x + z0[2 * j] * fb0); z1[2 * j + 1] = xa[2 * j + 1] * (zc.y + z0[2 * j + 1] * fb0);
        buf[e] = float2{z1[2 * j], z1[2 * j + 1]};
        buf[sq * Lc + swz(L / 2 + (t0 >> 1) + j)] = float2{0.f, 0.f};
      }
      *(float4*)(Z1 + sq * L + t0) = float4{z1[0], z1[1], z1[2], z1[3]};
      *(float4*)(Z1 + sq * L + t0 + 4) = float4{z1[4], z1[5], z1[6], z1[7]};
    }
    __syncthreads();
    fft_dif<LOGN, NSEQ>(buf);
    spectrum_mul<LOGN, NSEQ>(buf, GS1);
    __syncthreads();
    fft_dit_inv<LOGN, NSEQ>(buf);
    for (int w = tid; w < NSEQ * (L / 8); w += NT) {
      const int sq = w >> LOG8, t0 = (w & (L / 8 - 1)) * 8;
      const int s0 = (LOGN == 14) ? (TPROMPT + (b0 + sq) * 16384) : ((b0 + sq) * 4096);
      const ushort_t* px2 = PH + (size_t)s0 * 1024 + (size_t)c * L + (size_t)2 * T * 1024;
      ushort_t* pg = (ushort_t*)px2 + (size_t)T * 1024;
      float xb[8]; conv8(px2, 2, t0, xb);
      const float4 za = *(const float4*)(Z1 + sq * L + t0), zb = *(const float4*)(Z1 + sq * L + t0 + 4);
      const float z1[8] = {za.x, za.y, za.z, za.w, zb.x, zb.y, zb.z, zb.w};
      const uint4 gv = *(const uint4*)(pg + t0);
      const unsigned gw[4] = {gv.x, gv.y, gv.z, gv.w};
      unsigned o[4];
#pragma unroll
      for (int j = 0; j < 4; ++j) {
        const float2 zc = buf[sq * Lc + swz((t0 >> 1) + j)];
        const float g0 = __uint_as_float(gw[j] << 16), g1 = __uint_as_float(gw[j] & 0xffff0000u);
        const float y0 = xb[2 * j] * (zc.x + z1[2 * j] * fb1) * (g0 * fast_sigmoid(g0));
        const float y1 = xb[2 * j + 1] * (zc.y + z1[2 * j + 1] * fb1) * (g1 * fast_sigmoid(g1));
        o[j] = pack2(y0, y1);
      }
      if (!dry) *(uint4*)(pg + t0) = uint4{o[0], o[1], o[2], o[3]};
    }
  }
}

__device__ void hy_conv_phase(const Params& p, int i, unsigned char* lds, bool dry = false) {
  for (int it = bidx(); it < 2048; it += gridDim.x) {
    if (it < 1024) hy_conv_item<14>(p, i, it, lds, dry);
    else hy_conv_item<12>(p, i, it - 1024, lds, dry);
    __syncthreads();
  }
}

__device__ void prep_even(const Params& p, int i, unsigned char* lds) {
  ushort_t* WB = (ushort_t*)(p.ws + OFF_WB);
  ushort_t* WinT = WB; ushort_t* WoutT = WB + 3328 * 1024; ushort_t* GluT = WoutT + 1024 * 1024;
  transpose_bf16(p.in[I_EWIN] + (size_t)i * 1024 * 3136, WinT, 1024, 3136, lds);
  zero_fill(WinT + 3136 * 1024, 192 * 1024);
  transpose_bf16(p.in[I_EWOUT] + (size_t)i * 1024 * 1024, WoutT, 1024, 1024, lds);
  transpose_bf16(p.in[I_GLUW] + (size_t)i * 512 * 512, GluT, 512, 512, lds);
}
__device__ void prep_odd(const Params& p, int i, unsigned char* lds) {
  ushort_t* WB = (ushort_t*)(p.ws + OFF_WB);
  transpose_bf16(p.in[I_HWIN] + (size_t)i * 1024 * 4096, WB, 1024, 4096, lds);
  transpose_bf16(p.in[I_HWOUT] + (size_t)i * 1024 * 1024, WB + 4096 * 1024, 1024, 1024, lds);
  hy_filter_mlp(p, i);
}
#ifndef PROBE_MASK
#define PROBE_MASK 0
#endif
#ifndef PH_MASK
#define PH_MASK 0x1ffff
#endif
#define PHM(n) ((PH_MASK >> (n)) & 1)
DEVI void run_phase(const Params& p, int ph, unsigned char* lds, bool dry = false) {
  const int layer = ph < NPH_EVEN ? 0 : ph < NPH_EVEN + NPH_ODD ? 1 : ph < 2 * NPH_EVEN + NPH_ODD ? 2 : 3;
  const int base = layer == 0 ? 0 : layer == 1 ? NPH_EVEN : layer == 2 ? NPH_EVEN + NPH_ODD : 2 * NPH_EVEN + NPH_ODD;
  const int sp = ph - base, i = layer >> 1;
  unsigned char* ws = p.ws;
  ushort_t* WB = (ushort_t*)(ws + OFF_WB);
  if ((layer & 1) == 0) {
    ushort_t* WinT = WB; ushort_t* WoutT = WB + 3328 * 1024; ushort_t* GluT = WoutT + 1024 * 1024;
    switch (sp) {
      case 0: if (PHM(0)) {
        prep_even(p, 0, lds);
        xb_convert(p, (ushort_t*)(ws + OFF_Y));
        } break;
      case 1: if (PHM(1)) run_gemm(lds, (const ushort_t*)(ws + OFF_Y), 1024, WinT, 3328, 1024, pg8::EpiEvenIn{(ushort_t*)(ws + OFF_PS5), (ushort_t*)(ws + OFF_PRW)}); break;
      case 2: if (PHM(2)) s5_passA(p, i, lds); break;
      case 3: if (PHM(3)) s5_passC(p, i, lds); break;
      case 4: if (PHM(4)) run_gemm(lds, (const ushort_t*)(ws + OFF_Y) + 512, 1024, GluT, 512, 512, pg8::EpiGlu{(ushort_t*)(ws + OFF_Y), (const ushort_t*)(ws + OFF_PS5), p.in[I_GLUB] + i * 512}); break;
      case 5: if (PHM(5)) rwkv_scan1(p, i, lds); break;
      case 6: if (PHM(6)) rwkv_carry(p, lds, dry); break;
      case 7: if (PHM(7)) rwkv_scan3(p, i, lds, dry); break;
      case 8: if (PHM(8)) rwkv_post(p, i); break;
      case 9: if (PHM(9)) run_gemm(lds, (const ushort_t*)(ws + OFF_Y), 1024, WoutT, 1024, 1024, pg8::EpiF16{(ushort_t*)(ws + OFF_PRW)}); break;
      case 10: if (PHM(10)) { if (!dry) prep_odd(p, i, lds); ln_phase(p, layer, (const ushort_t*)(ws + OFF_PRW), (ushort_t*)(ws + OFF_XB_ODD), dry); } break;
    }
  } else {
    ushort_t* HinT = WB; ushort_t* HoutT = WB + 4096 * 1024;
    switch (sp) {
      case 0: break;
      case 1: if (PHM(12)) run_gemm(lds, (const ushort_t*)(ws + OFF_XB_ODD), 1024, HinT, 4096, 1024, pg8::EpiHyIn{(ushort_t*)(ws + OFF_PH)}); break;
      case 2: if (PHM(13)) hy_conv_phase(p, i, lds, dry); break;
      case 3: if (PHM(14)) hy_transpose((const ushort_t*)(ws + OFF_PH + 3 * SZ1), (ushort_t*)(ws + OFF_PH), lds); break;
      case 4: if (PHM(15)) run_gemm(lds, (const ushort_t*)(ws + OFF_PH), 1024, HoutT, 1024, 1024, pg8::EpiF16{(ushort_t*)(ws + OFF_PH + SZ1)}); break;
      case 5: if (PHM(16)) { if (!dry && layer < 3) prep_even(p, i + 1, lds); ln_phase(p, layer, (const ushort_t*)(ws + OFF_PH + SZ1), layer < 3 ? (ushort_t*)(ws + OFF_Y) : (ushort_t*)nullptr, dry); } break;
    }
  }
}

#define LAS __attribute__((address_space(3)))
#define XB_TMO      128
#define XB_XCNT(j)  (256  + 64 * (j))
#define XB_XSUB(j)  (1280 + 64 * (j))
#define XB_XGEN(j)  (2304 + 64 * (j))
#define XB_TOP      3328
#define XB_TOPGEN   3392
#define XCD_BAR_WORDS 3456
#define XB_SPIN_CAP (1u << 18)
#define LAS __attribute__((address_space(3)))

__device__ __forceinline__ unsigned xb_ld(unsigned* p)              { return __hip_atomic_load(p, __ATOMIC_RELAXED, __HIP_MEMORY_SCOPE_AGENT); }
__device__ __forceinline__ unsigned xb_add(unsigned* p, unsigned v) { return __hip_atomic_fetch_add(p, v, __ATOMIC_RELAXED, __HIP_MEMORY_SCOPE_AGENT); }
__device__ __forceinline__ unsigned xb_xcc_id() { return (unsigned)__builtin_amdgcn_s_getreg((3 << 11) | 20) & 0xFu; }
#define XB_SPIN(cond, bar) do { unsigned _sp = 0; while (cond) { __builtin_amdgcn_s_sleep(1); \
    if ((++_sp & 255u) == 0u) { if (xb_ld(&(bar)[XB_TMO])) break; if (_sp > XB_SPIN_CAP) { atomicAdd(&(bar)[XB_TMO], 1u); break; } } } } while (0)

struct XcdBarrier {
    unsigned* bar; unsigned x;
    volatile LAS unsigned* st;
};

__device__ __forceinline__ XcdBarrier xcd_barrier_post(unsigned* bar, volatile LAS unsigned* st) {
    XcdBarrier b; b.bar = bar; b.x = xb_xcc_id(); b.st = st;
    if (threadIdx.x == 0) (void)xb_add(&bar[XB_XCNT(b.x)], 1u);
    return b;
}
__device__ __forceinline__ void xcd_barrier_complete(unsigned* bar, unsigned x, unsigned& nloc, unsigned& nx) {
    const unsigned G = gridDim.x * gridDim.y * gridDim.z;
    unsigned sum, cnt, mine, sp = 0u;
    for (;;) {
        sum = 0u; cnt = 0u; mine = 0u;
#pragma unroll
        for (unsigned j = 0; j < 16; ++j) { const unsigned c = xb_ld(&bar[XB_XCNT(j)]); sum += c; cnt += (c > 0u) ? 1u : 0u; mine = (j == x) ? c : mine; }
        if (sum == G) break;
        __builtin_amdgcn_s_sleep(1);
        if ((++sp & 255u) == 0u) { if (xb_ld(&bar[XB_TMO])) break; if (sp > XB_SPIN_CAP) { atomicAdd(&bar[XB_TMO], 1u); break; } }
    }
    nloc = mine > 0u ? mine : 1u; nx = cnt > 0u ? cnt : 1u;
}

__device__ __forceinline__ void xcd_barrier(const XcdBarrier& b) {
    asm volatile("s_waitcnt vmcnt(0)" ::: "memory");
    __syncthreads();
    if (threadIdx.x == 0) {
        unsigned* bar = b.bar;
        __builtin_amdgcn_s_waitcnt(0);
        unsigned nloc = b.st[0], nx = b.st[1];
        if (nloc == 0u) { xcd_barrier_complete(bar, b.x, nloc, nx); b.st[0] = nloc; b.st[1] = nx; }
        const unsigned old = xb_add(&bar[XB_XSUB(b.x)], 1u);
        const unsigned gen = old / nloc;
        if (old + 1u == (gen + 1u) * nloc) {
            __builtin_amdgcn_fence(__ATOMIC_RELEASE, "agent");
            asm volatile("s_waitcnt vmcnt(0)" ::: "memory");
            const unsigned og = xb_add(&bar[XB_TOP], 1u);
            const unsigned tg = og / nx;
            if (og + 1u == (tg + 1u) * nx) xb_add(&bar[XB_TOPGEN], 1u);
            else XB_SPIN(xb_ld(&bar[XB_TOPGEN]) == tg, bar);
            __builtin_amdgcn_fence(__ATOMIC_ACQUIRE, "agent");
            xb_add(&bar[XB_XGEN(b.x)], 1u);
            asm volatile("s_waitcnt vmcnt(0)" ::: "memory");
        } else {
            XB_SPIN(xb_ld(&bar[XB_XGEN(b.x)]) == gen, bar);
            __builtin_amdgcn_fence(__ATOMIC_ACQUIRE, "agent");
            asm volatile("s_waitcnt vmcnt(0)" ::: "memory");
        }
    }
    __syncthreads();
}


#if ONE_LAUNCH
__global__ void __launch_bounds__(NT) fwd_kernel(Params p) {
  extern __shared__ __attribute__((aligned(16))) unsigned char lds[];
#if ONE_LAUNCH
  cg::grid_group grid = cg::this_grid();
#endif
#if ONE_LAUNCH
  volatile LAS unsigned* xb_st = (volatile LAS unsigned*)(lds + LDS_BYTES - 16);
  if (threadIdx.x < 2) xb_st[threadIdx.x] = 0u;
  __syncthreads();
  const XcdBarrier xb = xcd_barrier_post((unsigned*)(p.ws + OFF_BAR), xb_st);
#endif
  for (int ph = p.ph_lo; ph < p.ph_hi; ++ph) {
    if (ph == NPH_EVEN || ph == NPH_EVEN + NPH_ODD || ph == 2 * NPH_EVEN + NPH_ODD) continue;
    int reps = 1;
#if PROBE_MASK
    {
      const int lyr = ph < NPH_EVEN ? 0 : ph < NPH_EVEN + NPH_ODD ? 1 : ph < 2 * NPH_EVEN + NPH_ODD ? 2 : 3;
      const int bs = lyr == 0 ? 0 : lyr == 1 ? NPH_EVEN : lyr == 2 ? NPH_EVEN + NPH_ODD : 2 * NPH_EVEN + NPH_ODD;
      const int idx = (lyr & 1) ? NPH_EVEN + (ph - bs) : (ph - bs);
      if ((PROBE_MASK >> idx) & 1) reps = 2;
    }
#endif
    for (int rep = 0; rep < reps; ++rep) {
      run_phase(p, ph, lds, rep + 1 < reps);
#if ONE_LAUNCH
      if (ph + 1 < p.ph_hi || rep + 1 < reps) { if (ph == p.ph_lo && rep == 0) grid.sync(); else xcd_barrier(xb); }
#endif
    }
  }
}
#endif

#if !ONE_LAUNCH
template <int PH> __global__ void __launch_bounds__(NT) phase_kernel(Params p) {
  extern __shared__ __attribute__((aligned(16))) unsigned char lds[];
  run_phase(p, PH, lds);
}
typedef void (*kfn_t)(Params);
#define PK(n) phase_kernel<n>
static kfn_t k_tab[NPHASES] = {PK(0), PK(1), PK(2), PK(3), PK(4), PK(5), PK(6), PK(7), PK(8), PK(9), PK(10), PK(11), PK(12), PK(13), PK(14), PK(15),
                               PK(16), PK(17), PK(18), PK(19), PK(20), PK(21), PK(22), PK(23), PK(24), PK(25), PK(26), PK(27), PK(28), PK(29), PK(30), PK(31), PK(32), PK(33)};
#endif

extern "C" void kernel_launch(void* const* d_in, const int* in_sizes, int n_in, void* d_out, int out_size, void* d_ws, size_t ws_size,
                              hipStream_t stream) {
  static int grid_blocks = 0;
  if (!grid_blocks) {
    if (n_in != 38 || ws_size < WS_NEED || out_size != T * 1024) {
      fprintf(stderr, "kernel_launch: unexpected shapes n_in=%d ws=%zu out=%d\n", n_in, ws_size, out_size);
      grid_blocks = -1; return;
    }
    int dev = 0, cus = 0, per_cu = 0;
    (void)hipGetDevice(&dev);
    (void)hipDeviceGetAttribute(&cus, hipDeviceAttributeMultiprocessorCount, dev);
#if ONE_LAUNCH
    if (hipFuncSetAttribute((const void*)fwd_kernel, hipFuncAttributeMaxDynamicSharedMemorySize, LDS_BYTES) != hipSuccess) {
      fprintf(stderr, "kernel_launch: hipFuncSetAttribute failed\n"); grid_blocks = -1; return;
    }
    (void)hipOccupancyMaxActiveBlocksPerMultiprocessor(&per_cu, (const void*)fwd_kernel, NT, LDS_BYTES);
#else
    for (int ph = 0; ph < NPHASES; ++ph)
      if (hipFuncSetAttribute((const void*)k_tab[ph], hipFuncAttributeMaxDynamicSharedMemorySize, LDS_BYTES) != hipSuccess) {
        fprintf(stderr, "kernel_launch: hipFuncSetAttribute failed\n"); grid_blocks = -1; return;
      }
    per_cu = 1;
#endif
    if (per_cu < 1) { fprintf(stderr, "kernel_launch: occupancy query returned %d\n", per_cu); per_cu = 1; }
    grid_blocks = cus * per_cu;
    if (grid_blocks > 256) grid_blocks = 256;
    if (grid_blocks < 1) grid_blocks = 256;
  }
  if (grid_blocks < 0) return;
  Params p{};
  for (int k = 0; k < 38; ++k) p.in[k] = (const float*)d_in[k];
  p.out = (float*)d_out; p.ws = (unsigned char*)d_ws;
#if ONE_LAUNCH
  if (hipMemsetAsync((unsigned char*)d_ws + OFF_BAR, 0, 16384, stream) != hipSuccess) { fprintf(stderr, "kernel_launch: memset of barrier words failed\n"); return; }
  p.ph_lo = 0; p.ph_hi = NPHASES;
  void* args[] = {&p};
  hipError_t e = hipLaunchCooperativeKernel((const void*)fwd_kernel, dim3(grid_blocks), dim3(NT), args, LDS_BYTES, stream);
  if (e != hipSuccess) fprintf(stderr, "cooperative launch failed: %s (grid %d)\n", hipGetErrorString(e), grid_blocks);
#else
  for (int ph = 0; ph < NPHASES; ++ph) {
    p.ph_lo = ph; p.ph_hi = ph + 1;
    hipLaunchKernelGGL(k_tab[ph], dim3(grid_blocks), dim3(NT), LDS_BYTES, stream, p);
  }
#endif
}
```

```cpp
#include <hip/hip_runtime.h>
#include <hip/hip_cooperative_groups.h>
#include <cstdio>
#include <cstdint>
namespace cg = cooperative_groups;

#ifndef ONE_LAUNCH
#define ONE_LAUNCH 1
#endif

#define DEVI __device__ __forceinline__
constexpr int NT = 512;
constexpr int T = 49152;
constexpr int TPROMPT = 16384;
constexpr int LDS_BYTES = 133120;
constexpr int NPH_EVEN = 11, NPH_ODD = 6;
constexpr int NPHASES = 2 * (NPH_EVEN + NPH_ODD);

typedef __attribute__((ext_vector_type(8))) short bf16x8;
typedef __attribute__((ext_vector_type(4))) float f32x4;
typedef unsigned short ushort_t;
typedef float f32x2 __attribute__((ext_vector_type(2)));

struct Params { const float* in[38]; float* out; unsigned char* ws; int ph_lo; int ph_hi; };

enum { I_XP = 0, I_XS, I_EWIN, I_EWOUT, I_LRE, I_LIM, I_LSTEP, I_BRE, I_BIM, I_CRE, I_CIM, I_S5D, I_GLUW, I_GLUB,
       I_MURKV, I_MULORA, I_W0, I_WUP, I_A0, I_AUP, I_KK, I_KA, I_RK, I_LNXW, I_LNXB,
       I_HWIN, I_HWOUT, I_HSW, I_HSB, I_FW1, I_FB1, I_FFREQ, I_FW2, I_FB2, I_FW3, I_FBIAS, I_LNG, I_LNB };

constexpr size_t SZ1 = (size_t)T * 1024 * 2;
constexpr size_t OFF_PS5 = 0;
constexpr size_t OFF_PRW = OFF_PS5 + SZ1;
constexpr size_t OFF_Y = OFF_PRW + (size_t)T * 2112 * 2;
constexpr size_t OFF_YS = OFF_Y + SZ1;
constexpr size_t OFF_WB = OFF_YS + SZ1;
constexpr size_t OFF_CAR = OFF_WB + 10485760;
constexpr size_t OFF_BAR = OFF_CAR + 6291456;
constexpr size_t WS_NEED = OFF_BAR + 16384;
constexpr size_t OFF_PH = 0;
constexpr size_t OFF_GS = 4 * SZ1;
constexpr size_t GS_PER = 131328;
constexpr size_t OFF_Z1 = OFF_GS + 256 * 2 * GS_PER;
constexpr size_t OFF_XB_ODD = 4 * SZ1;
constexpr size_t OFF_H2 = OFF_XB_ODD + SZ1;

DEVI int tidx() { int t = threadIdx.x; asm volatile("" : "+v"(t)); return t; }
DEVI int bidx() { int b = blockIdx.x; asm volatile("" : "+r"(b)); return __builtin_amdgcn_readfirstlane(b); }
DEVI ushort_t f2bf(float f) { unsigned u = __float_as_uint(f); u += 0x7fffu + ((u >> 16) & 1u); return (ushort_t)(u >> 16); }
DEVI float bf2f(ushort_t h) { return __uint_as_float(((unsigned)h) << 16); }
DEVI unsigned pack2(float a, float b) { return (unsigned)f2bf(a) | ((unsigned)f2bf(b) << 16); }
DEVI float wsum(float v) {
#pragma unroll
  for (int m = 32; m >= 1; m >>= 1) v += __shfl_xor(v, m);
  return v;
}
DEVI void wave_sync() { __builtin_amdgcn_fence(__ATOMIC_RELEASE, "wavefront"); __builtin_amdgcn_wave_barrier(); __builtin_amdgcn_fence(__ATOMIC_ACQUIRE, "wavefront"); }
DEVI void wave_sync_lds() { asm volatile("" ::: "memory"); __builtin_amdgcn_wave_barrier(); asm volatile("" ::: "memory"); }
DEVI void block_sync_lds() { asm volatile("s_waitcnt lgkmcnt(0)" ::: "memory"); __builtin_amdgcn_s_barrier(); asm volatile("" ::: "memory"); }
DEVI void seq_of(int tok, int& s0, int& L) {
  if (tok < TPROMPT) { s0 = tok & ~4095; L = 4096; } else { s0 = TPROMPT + ((tok - TPROMPT) & ~16383); L = 16384; }
}
struct XSrc { const float* xp; const float* xs; const float* xo; };
DEVI XSrc xsrc(const Params& p) {
  XSrc x; x.xp = p.in[I_XP]; x.xs = p.in[I_XS]; x.xo = p.out;
  asm volatile("" : "+r"(x.xp), "+r"(x.xs), "+r"(x.xo));
  return x;
}
DEVI const float* xrow(const XSrc& x, int layer, int tok) {
  if (layer == 0) return tok < TPROMPT ? x.xp + (size_t)tok * 1024 : x.xs + (size_t)(tok - TPROMPT) * 1024;
  return x.xo + (size_t)tok * 1024;
}
DEVI float sigmoidf_(float x) { return 1.f / (1.f + expf(-x)); }
DEVI float fast_sigmoid(float x) { return __builtin_amdgcn_rcpf(1.f + __builtin_amdgcn_exp2f(-1.4426950408889634f * x)); }
DEVI float fast_tanh(float x) { return 1.f - 2.f * __builtin_amdgcn_rcpf(1.f + __builtin_amdgcn_exp2f(2.8853900817779268f * x)); }
DEVI float dpp_mov_f(float x, const int sel) {
  int xi = __builtin_bit_cast(int, x), r;
  if (sel == 0) r = __builtin_amdgcn_mov_dpp(xi, 0xB1, 0xf, 0xf, true);
  else if (sel == 1) r = __builtin_amdgcn_mov_dpp(xi, 0x4E, 0xf, 0xf, true);
  else if (sel == 2) r = __builtin_amdgcn_mov_dpp(xi, 0x141, 0xf, 0xf, true);
  else r = __builtin_amdgcn_mov_dpp(xi, 0x140, 0xf, 0xf, true);
  return __builtin_bit_cast(float, r);
}
DEVI float wsum_fast(float v) {
  v += dpp_mov_f(v, 0); v += dpp_mov_f(v, 1); v += dpp_mov_f(v, 2); v += dpp_mov_f(v, 3);
  const int vi = __builtin_bit_cast(int, v);
  return __builtin_bit_cast(float, __builtin_amdgcn_readlane(vi, 0)) + __builtin_bit_cast(float, __builtin_amdgcn_readlane(vi, 16)) +
         __builtin_bit_cast(float, __builtin_amdgcn_readlane(vi, 32)) + __builtin_bit_cast(float, __builtin_amdgcn_readlane(vi, 48));
}
DEVI float gelu_tanh(float x) { return 0.5f * x * (1.f + tanhf(0.7978845608f * (x + 0.044715f * x * x * x))); }

__device__ void transpose_bf16(const float* __restrict__ in, ushort_t* __restrict__ out, int K, int N, unsigned char* lds) {
  float* tile = (float*)lds;
  const int tid = tidx(), j = tid & 63, i0 = tid >> 6;
  const int tk = K / 64, tn = N / 64;
  for (int t = bidx(); t < tk * tn; t += gridDim.x) {
    const int k0 = (t / tn) * 64, n0 = (t % tn) * 64;
#pragma unroll
    for (int e = 0; e < 8; ++e) { int i = i0 + 8 * e; tile[i * 65 + j] = in[(size_t)(k0 + i) * N + n0 + j]; }
    __syncthreads();
#pragma unroll
    for (int e = 0; e < 8; ++e) { int i = i0 + 8 * e; out[(size_t)(n0 + i) * K + k0 + j] = f2bf(tile[j * 65 + i]); }
    __syncthreads();
  }
}

namespace pg8 {
#define PG8_LAS __attribute__((address_space(3)))
typedef unsigned u32x4 __attribute__((ext_vector_type(4)));
constexpr int BM = 256, BK = 64, HALF = 128, HTB = HALF * BK * 2, STAGE_BYTES = 8 * HTB, NXCD = 8, WGM = 8;
DEVI int lds_byte(int r, int c) { const int st = (r >> 4) * 2 + (c >> 5), rr = r & 15, cc = c & 31, ob = rr * 64 + cc * 2; return st * 1024 + (ob ^ (((ob >> 9) & 1) << 5)); }
DEVI void stage_rc(int b, int& R, int& C) { const int st = b / 1024, sb = b % 1024, swz = sb ^ (((sb >> 9) & 1) << 5); R = (st >> 1) * 16 + swz / 64; C = (st & 1) * 32 + (swz % 64) / 2; }
DEVI int perm32(int rho) { const int n = rho >> 4, i = rho & 15; return 8 * (i >> 2) + 4 * n + (i & 3); }
struct Unit { int pm, pn; };
struct Gemm { const ushort_t* A; const ushort_t* Bt; int M, N, K, lda; };
struct StaticOrder {
  int nM, nN, nwg, G, c;
  DEVI void init(int M, int N, int G_, int c_) { nM = M / BM; nN = N / BM; nwg = nM * nN; G = G_; c = c_; }
  DEVI bool next(int i, Unit& u) const {
    const long L = (long)i * G + c; if (L >= nwg) return false;
    int wgid = (int)L; { const int q = nwg / NXCD, r = nwg % NXCD, xcd = wgid % NXCD, off = wgid / NXCD; wgid = (xcd < r ? xcd * (q + 1) : r * (q + 1) + (xcd - r) * q) + off; }
    const int nig = WGM * nN, gid = wgid / nig, fm = gid * WGM, gsz = (nM - fm) < WGM ? (nM - fm) : WGM;
    u.pm = fm + ((wgid % nig) % gsz); u.pn = (wgid % nig) / gsz; return true;
  }
};
DEVI unsigned cvt_pk_bf16(float lo, float hi) { unsigned r; asm volatile("v_cvt_pk_bf16_f32 %0, %1, %2" : "=v"(r) : "v"(lo), "v"(hi)); return r; }

template <class Epi>
DEVI void gemm_phase(PG8_LAS unsigned char* lds, const Gemm g, const StaticOrder& S, const Epi& E) {
  const int tid = tidx(), wid = __builtin_amdgcn_readfirstlane(tid >> 6), lane = tid & 63, wr = wid >> 2, wc = wid & 3, fr = lane & 15, fq = lane >> 4;
  const int K = g.K, nt = K / BK, lda = g.lda;
  unsigned voffA[2], voffB[2];
#pragma unroll
  for (int i = 0; i < 2; ++i) { int R, C; stage_rc(tid * 16 + i * 8192, R, C); const int Rb = Epi::PERM ? ((R & ~31) + perm32(R & 31)) : R;
    voffA[i] = (unsigned)(R * lda + C) * 2u; voffB[i] = (unsigned)(Rb * K + C) * 2u; }
  const size_t kstep = (size_t)(BK * 2);
  const size_t hstepA = (size_t)HALF * lda * 2, hstepB = (size_t)HALF * K * 2;
  const size_t tstepA = 2 * hstepA, tstepB = 2 * hstepB;
  const unsigned ldsw = (unsigned)wid * 1024u;
  const int aoff = lds_byte(wr * 64 + fr, fq * 8), boff = lds_byte(wc * 32 + fr, fq * 8);
#define PG8_SA(b, h) (((b) * 2 + (h)) * HTB)
#define PG8_SB(b, h) ((4 + (b) * 2 + (h)) * HTB)
#define PG8_STAGE(bufoff, gbase, voff) do { _Pragma("unroll") for (int _i = 0; _i < 2; ++_i) \
    __builtin_amdgcn_global_load_lds((const unsigned*)((const char*)(gbase) + (voff)[_i]), (PG8_LAS unsigned*)(lds + (bufoff) + ldsw + _i * 8192), 16, 0, 0); } while (0)
#define PG8_LDA(dst, b, h) do { _Pragma("unroll") for (int m = 0; m < 4; ++m) _Pragma("unroll") for (int k = 0; k < 2; ++k) dst[m][k] = *(const PG8_LAS bf16x8*)(lds + PG8_SA(b, h) + aoff + m * 2048 + k * 1024); } while (0)
#define PG8_LDB(dst, b, h) do { _Pragma("unroll") for (int n = 0; n < 2; ++n) _Pragma("unroll") for (int k = 0; k < 2; ++k) dst[n][k] = *(const PG8_LAS bf16x8*)(lds + PG8_SB(b, h) + boff + n * 2048 + k * 1024); } while (0)
#define PG8_MMA(ai, bj, At, Bt) do { __builtin_amdgcn_s_setprio(1); _Pragma("unroll") for (int m = 0; m < 4; ++m) _Pragma("unroll") for (int n = 0; n < 2; ++n) _Pragma("unroll") for (int k = 0; k < 2; ++k) \
    acc[ai][bj][m][n] = Epi::TRANS ? __builtin_amdgcn_mfma_f32_16x16x32_bf16(Bt[n][k], At[m][k], acc[ai][bj][m][n], 0, 0, 0) \
                                   : __builtin_amdgcn_mfma_f32_16x16x32_bf16(At[m][k], Bt[n][k], acc[ai][bj][m][n], 0, 0, 0); __builtin_amdgcn_s_setprio(0); } while (0)
#define PG8_WAIT_V(n) asm volatile("s_waitcnt vmcnt(" #n ")" ::: "memory")
#define PG8_WAIT_L(n) asm volatile("s_waitcnt lgkmcnt(" #n ")" ::: "memory")
#define PG8_BAR __builtin_amdgcn_s_barrier()
#define PG8_SCHED __builtin_amdgcn_sched_barrier(0)
  Unit cur, nxt; int ui = 0;
  if (!S.next(0, cur)) return;
  f32x4 acc[2][2][4][2];
#pragma unroll
  for (int a = 0; a < 2; ++a)
#pragma unroll
    for (int b = 0; b < 2; ++b)
#pragma unroll
      for (int m = 0; m < 4; ++m)
#pragma unroll
        for (int n = 0; n < 2; ++n) acc[a][b][m][n] = (f32x4){0.f, 0.f, 0.f, 0.f};
  bf16x8 At[4][2], B0[2][2], B1[2][2];
  const char* cA = (const char*)g.A + (size_t)cur.pm * tstepA; const char* cB = (const char*)g.Bt + (size_t)cur.pn * tstepB;
  PG8_STAGE(PG8_SB(0, 0), cB, voffB); PG8_STAGE(PG8_SA(0, 0), cA, voffA); PG8_STAGE(PG8_SB(0, 1), cB + hstepB, voffB); PG8_STAGE(PG8_SA(0, 1), cA + hstepA, voffA);
  if (wr == 1) PG8_BAR;
  PG8_WAIT_V(4); PG8_BAR;
  PG8_STAGE(PG8_SB(1, 0), cB + kstep, voffB); PG8_STAGE(PG8_SA(1, 0), cA + kstep, voffA); PG8_STAGE(PG8_SB(1, 1), cB + hstepB + kstep, voffB);
  PG8_WAIT_V(6); PG8_BAR;
  for (;;) {
    const bool has_next = S.next(ui + 1, nxt);
    const char* nA = has_next ? (const char*)g.A + (size_t)nxt.pm * tstepA : cA; const char* nB = has_next ? (const char*)g.Bt + (size_t)nxt.pn * tstepB : cB;
    for (int t = 0; t < nt; t += 2) {
      const bool last = (t == nt - 2);
      const char* a1 = cA + (size_t)(t + 1) * kstep;
      const char* a2 = last ? nA : cA + (size_t)(t + 2) * kstep; const char* b2 = last ? nB : cB + (size_t)(t + 2) * kstep;
      const char* a3 = a2 + kstep; const char* b3 = b2 + kstep;
      PG8_LDB(B0, 0, 0); PG8_SCHED; PG8_LDA(At, 0, 0); PG8_STAGE(PG8_SA(1, 1), a1 + hstepA, voffA);
      PG8_WAIT_L(8); PG8_BAR; PG8_WAIT_L(0); PG8_MMA(0, 0, At, B0); PG8_BAR; PG8_SCHED;
      PG8_LDB(B1, 0, 1); PG8_STAGE(PG8_SB(0, 0), b2, voffB);
      PG8_BAR; PG8_WAIT_L(0); PG8_MMA(0, 1, At, B1); PG8_BAR;
      PG8_LDA(At, 0, 1); PG8_STAGE(PG8_SA(0, 0), a2, voffA);
      PG8_BAR; PG8_WAIT_L(0); PG8_MMA(1, 0, At, B0); PG8_BAR; PG8_SCHED;
      PG8_STAGE(PG8_SB(0, 1), b2 + hstepB, voffB);
      PG8_WAIT_V(6); PG8_BAR; PG8_MMA(1, 1, At, B1); PG8_BAR;
      PG8_LDB(B0, 1, 0); PG8_SCHED; PG8_LDA(At, 1, 0); PG8_STAGE(PG8_SA(0, 1), a2 + hstepA, voffA);
      PG8_WAIT_L(8); PG8_BAR; PG8_WAIT_L(0); PG8_MMA(0, 0, At, B0); PG8_BAR; PG8_SCHED;
      PG8_LDB(B1, 1, 1); PG8_STAGE(PG8_SB(1, 0), b3, voffB);
      PG8_BAR; PG8_WAIT_L(0); PG8_MMA(0, 1, At, B1); PG8_BAR;
      PG8_LDA(At, 1, 1); PG8_STAGE(PG8_SA(1, 0), a3, voffA);
      PG8_BAR; PG8_WAIT_L(0); PG8_MMA(1, 0, At, B0); PG8_BAR; PG8_SCHED;
      PG8_STAGE(PG8_SB(1, 1), b3 + hstepB, voffB);
      PG8_WAIT_V(6); PG8_BAR; PG8_MMA(1, 1, At, B1); PG8_BAR;
    }
    E(acc, cur, wr, wc, fr, fq);
    if (!has_next) break;
#pragma unroll
    for (int a = 0; a < 2; ++a)
#pragma unroll
      for (int b = 0; b < 2; ++b)
#pragma unroll
        for (int m = 0; m < 4; ++m)
#pragma unroll
          for (int n = 0; n < 2; ++n) acc[a][b][m][n] = (f32x4){0.f, 0.f, 0.f, 0.f};
    cur = nxt; cA = nA; cB = nB; ++ui;
  }
  PG8_WAIT_V(0);
  if (wr == 0) PG8_BAR;
  PG8_BAR;
#undef PG8_SA
#undef PG8_SB
#undef PG8_STAGE
#undef PG8_LDA
#undef PG8_LDB
#undef PG8_MMA
#undef PG8_WAIT_V
#undef PG8_WAIT_L
#undef PG8_BAR
#undef PG8_SCHED
}

struct EpiEvenIn {
  static constexpr bool PERM = true, TRANS = true;
  ushort_t* ps5; ushort_t* prw;
  DEVI void operator()(const f32x4 (&acc)[2][2][4][2], const Unit& u, int wr, int wc, int fr, int fq) const {
#pragma unroll
    for (int ai = 0; ai < 2; ++ai)
#pragma unroll
      for (int m = 0; m < 4; ++m) {
        const size_t row = (size_t)u.pm * BM + ai * HALF + wr * 64 + m * 16 + fr;
#pragma unroll
        for (int bj = 0; bj < 2; ++bj) {
          const int c0 = u.pn * BM + bj * HALF + wc * 32 + 8 * fq;
          const f32x4 v0 = acc[ai][bj][m][0], v1 = acc[ai][bj][m][1];
          u32x4 o = {cvt_pk_bf16(v0[0], v0[1]), cvt_pk_bf16(v0[2], v0[3]), cvt_pk_bf16(v1[0], v1[1]), cvt_pk_bf16(v1[2], v1[3])};
          if (c0 < 1024) *(u32x4*)(ps5 + row * 1024 + c0) = o;
          else if (c0 < 3136) *(u32x4*)(prw + row * 2112 + (c0 - 1024)) = o;
        }
      }
  }
};
struct EpiHyIn {
  static constexpr bool PERM = false, TRANS = false;
  ushort_t* ph;
  DEVI void operator()(const f32x4 (&acc)[2][2][4][2], const Unit& u, int wr, int wc, int fr, int fq) const {
    int s0, L; seq_of(u.pm * BM, s0, L);
#pragma unroll
    for (int ai = 0; ai < 2; ++ai)
#pragma unroll
      for (int m = 0; m < 4; ++m) {
        const int tok = u.pm * BM + ai * HALF + wr * 64 + m * 16 + 4 * fq;
#pragma unroll
        for (int bj = 0; bj < 2; ++bj)
#pragma unroll
          for (int n = 0; n < 2; ++n) {
            const int col = u.pn * BM + bj * HALF + wc * 32 + 16 * n + fr;
            const int st = col >> 10, c = col & 1023;
            const f32x4 v = acc[ai][bj][m][n];
            ushort_t* dst = ph + (size_t)st * T * 1024 + (size_t)s0 * 1024 + (size_t)c * L + (tok - s0);
            *(uint2*)dst = uint2{cvt_pk_bf16(v[0], v[1]), cvt_pk_bf16(v[2], v[3])};
          }
      }
  }
};
struct EpiGlu {
  static constexpr bool PERM = true, TRANS = true;
  ushort_t* y; const ushort_t* ps5; const float* bias;
  DEVI void operator()(const f32x4 (&acc)[2][2][4][2], const Unit& u, int wr, int wc, int fr, int fq) const {
#pragma unroll
    for (int ai = 0; ai < 2; ++ai)
#pragma unroll
      for (int m = 0; m < 4; ++m) {
        const size_t row = (size_t)u.pm * BM + ai * HALF + wr * 64 + m * 16 + fr;
#pragma unroll
        for (int bj = 0; bj < 2; ++bj) {
          const int c0 = u.pn * BM + bj * HALF + wc * 32 + 8 * fq;
          const u32x4 a8 = *(const u32x4*)(y + row * 1024 + 512 + c0);
          const u32x4 g8 = *(const u32x4*)(ps5 + row * 1024 + 512 + c0);
          const f32x4 b0 = *(const f32x4*)(bias + c0), b1 = *(const f32x4*)(bias + c0 + 4);
          float v[8];
#pragma unroll
          for (int e = 0; e < 4; ++e) { v[e] = acc[ai][bj][m][0][e] + b0[e]; v[4 + e] = acc[ai][bj][m][1][e] + b1[e]; }
          unsigned o[4];
#pragma unroll
          for (int e = 0; e < 4; ++e) {
            const float a_lo = __uint_as_float(a8[e] << 16), a_hi = __uint_as_float(a8[e] & 0xffff0000u);
            const float g_lo = __uint_as_float(g8[e] << 16), g_hi = __uint_as_float(g8[e] & 0xffff0000u);
            const float r_lo = a_lo * sigmoidf_(v[2 * e]) * (g_lo * sigmoidf_(g_lo));
            const float r_hi = a_hi * sigmoidf_(v[2 * e + 1]) * (g_hi * sigmoidf_(g_hi));
            o[e] = cvt_pk_bf16(r_lo, r_hi);
          }
          *(u32x4*)(y + row * 1024 + c0) = u32x4{o[0], o[1], o[2], o[3]};
        }
      }
  }
};
struct EpiF16 {
  static constexpr bool PERM = true, TRANS = true;
  ushort_t* C;
  DEVI void operator()(const f32x4 (&acc)[2][2][4][2], const Unit& u, int wr, int wc, int fr, int fq) const {
#pragma unroll
    for (int ai = 0; ai < 2; ++ai)
#pragma unroll
      for (int m = 0; m < 4; ++m) {
        ushort_t* rowp = C + ((size_t)u.pm * BM + ai * HALF + wr * 64 + m * 16 + fr) * 1024 + u.pn * BM + wc * 32 + 8 * fq;
#pragma unroll
        for (int bj = 0; bj < 2; ++bj) {
          const f32x4 v0 = acc[ai][bj][m][0], v1 = acc[ai][bj][m][1];
          *(u32x4*)(rowp + bj * HALF) = u32x4{cvt_pk_bf16(v0[0], v0[1]), cvt_pk_bf16(v0[2], v0[3]), cvt_pk_bf16(v1[0], v1[1]), cvt_pk_bf16(v1[2], v1[3])};
        }
      }
  }
};
}

template <class Epi>
DEVI void run_gemm(unsigned char* lds, const ushort_t* A, int lda, const ushort_t* Bt, int N, int K, const Epi& E) {
  pg8::Gemm g; g.A = A; g.Bt = Bt; g.M = T; g.N = N; g.K = K; g.lda = lda;
  pg8::StaticOrder S; S.init(T, N, (int)gridDim.x, bidx());
  __syncthreads();
  pg8::gemm_phase<Epi>((PG8_LAS unsigned char*)lds, g, S, E);
  __syncthreads();
}

__device__ void xb_convert(const Params& p, ushort_t* XB) {
  const size_t n4 = (size_t)T * 1024 / 4, np4 = (size_t)TPROMPT * 1024 / 4;
  const float4* xp = (const float4*)p.in[I_XP]; const float4* xs = (const float4*)p.in[I_XS];
  for (size_t e = (size_t)bidx() * NT + tidx(); e < n4; e += (size_t)gridDim.x * NT) {
    const float4 v = e < np4 ? xp[e] : xs[e - np4];
    ((uint2*)XB)[e] = uint2{pack2(v.x, v.y), pack2(v.z, v.w)};
  }
}
__device__ void zero_fill(ushort_t* dst, size_t n) {
  for (size_t e = (size_t)bidx() * NT + tidx(); e < n / 8; e += (size_t)gridDim.x * NT) ((uint4*)dst)[e] = uint4{0, 0, 0, 0};
}
DEVI uint4 hy_tr_load(const ushort_t* __restrict__ PH3, int t, int r, int c8) {
  const int tok0 = (t >> 4) * 64, c0 = (t & 15) * 64;
  int s0, L; seq_of(tok0, s0, L);
  return *(const uint4*)(PH3 + (size_t)s0 * 1024 + (size_t)(c0 + r) * L + (tok0 - s0) + c8);
}
__device__ void hy_transpose(const ushort_t* __restrict__ PH3, ushort_t* __restrict__ Y, unsigned char* lds) {
  ushort_t* tile = (ushort_t*)lds;
  const int tid = tidx(), r = tid >> 3, c8 = (tid & 7) * 8;
  const int nt = (T / 64) * 16, t_first = bidx();
  uint4 v = uint4{0, 0, 0, 0};
  if (t_first < nt) v = hy_tr_load(PH3, t_first, r, c8);
  for (int t = t_first; t < nt; t += gridDim.x) {
    const int tok0 = (t >> 4) * 64, c0 = (t & 15) * 64;
    block_sync_lds();
    *(uint4*)(tile + r * 72 + c8) = v;
    if (t + (int)gridDim.x < nt) v = hy_tr_load(PH3, t + gridDim.x, r, c8);
    block_sync_lds();
    unsigned o[4];
#pragma unroll
    for (int e = 0; e < 4; ++e) o[e] = (unsigned)tile[(c8 + 2 * e) * 72 + r] | ((unsigned)tile[(c8 + 2 * e + 1) * 72 + r] << 16);
    *(uint4*)(Y + (size_t)(tok0 + r) * 1024 + c0 + c8) = uint4{o[0], o[1], o[2], o[3]};
  }
}

struct LnIn { float4 x[2][4]; uint2 f[2][4]; };
DEVI void ln_load(const XSrc& xs_, int layer, const ushort_t* __restrict__ F, int row0, int lane, LnIn& o) {
#pragma unroll
  for (int h = 0; h < 2; ++h) {
    const int row = row0 + h * (T / 2);
    const float4* x4 = (const float4*)xrow(xs_, layer, row);
    const uint2* f2 = (const uint2*)(F + (size_t)row * 1024);
#pragma unroll
    for (int e = 0; e < 4; ++e) { o.x[h][e] = x4[lane + 64 * e]; o.f[h][e] = f2[lane + 64 * e]; }
  }
}
__device__ void ln_phase(const Params& p, int layer, const ushort_t* __restrict__ F, ushort_t* __restrict__ XB, bool dry = false) {
  const int lane = tidx() & 63, gw = bidx() * (NT / 64) + (tidx() >> 6), nw = gridDim.x * (NT / 64);
  const float alpha = 1.681792830507429f;
  const float4* g4 = (const float4*)(p.in[I_LNG] + layer * 1024);
  const float4* b4 = (const float4*)(p.in[I_LNB] + layer * 1024);
  const XSrc xs_ = xsrc(p);
  LnIn cur, nxt;
  if (gw < T / 2) ln_load(xs_, layer, F, gw, lane, cur);
  for (int row0 = gw; row0 < T / 2; row0 += nw) {
    if (row0 + nw < T / 2) ln_load(xs_, layer, F, row0 + nw, lane, nxt);
#pragma unroll
    for (int h = 0; h < 2; ++h) {
      const int row = row0 + h * (T / 2);
      float4 v[4];
      float s = 0.f;
#pragma unroll
      for (int e = 0; e < 4; ++e) {
        const float4 a = cur.x[h][e];
        const uint2 fw = cur.f[h][e];
        v[e] = float4{alpha * a.x + __uint_as_float(fw.x << 16), alpha * a.y + __uint_as_float(fw.x & 0xffff0000u),
                      alpha * a.z + __uint_as_float(fw.y << 16), alpha * a.w + __uint_as_float(fw.y & 0xffff0000u)};
        s += v[e].x + v[e].y + v[e].z + v[e].w;
      }
      const float mean = wsum(s) * (1.f / 1024.f);
      float q = 0.f;
#pragma unroll
      for (int e = 0; e < 4; ++e) {
        v[e].x -= mean; v[e].y -= mean; v[e].z -= mean; v[e].w -= mean;
        q += v[e].x * v[e].x + v[e].y * v[e].y + v[e].z * v[e].z + v[e].w * v[e].w;
      }
      const float rs = rsqrtf(wsum(q) * (1.f / 1024.f) + 1e-5f);
      float4* o4 = (float4*)(p.out + (size_t)row * 1024);
#pragma unroll
      for (int e = 0; e < 4; ++e) {
        const float4 g = g4[lane + 64 * e], b = b4[lane + 64 * e];
        const float4 o = float4{v[e].x * rs * g.x + b.x, v[e].y * rs * g.y + b.y, v[e].z * rs * g.z + b.z, v[e].w * rs * g.w + b.w};
        if (!dry) o4[lane + 64 * e] = o;
        if (XB) ((uint2*)(XB + (size_t)row * 1024))[lane + 64 * e] = uint2{pack2(o.x, o.y), pack2(o.z, o.w)};
      }
    }
    cur = nxt;
  }
}

struct cplx { float x, y; };
DEVI cplx cmul(cplx a, cplx b) { return cplx{a.x * b.x - a.y * b.y, a.x * b.y + a.y * b.x}; }
DEVI void s5_consts(const Params& p, int i, int d, int g, int n, cplx& lb, cplx& coef) {
  const int idx = ((i * 2 + d) * 32 + g) * 64 + n;
  const float lre = p.in[I_LRE][idx], lim = p.in[I_LIM][idx];
  const float dt = expf(p.in[I_LSTEP][(i * 2 + d) * 32 + g]);
  const float mag = expf(lre * dt);
  float sn, cs; sincosf(lim * dt, &sn, &cs);
  lb = cplx{mag * cs, mag * sn};
  const float nr = lb.x - 1.f, ni = lb.y, den = 1.f / (lre * lre + lim * lim);
  coef = cplx{(nr * lre + ni * lim) * den, (ni * lre - nr * lim) * den};
}
DEVI void s5_load_u(const ushort_t* PS5, int tok0, int g, int lane, uint4& a, uint4& b) {
  const uint4* src = (const uint4*)(PS5 + (size_t)(tok0 + lane) * 1024 + g * 16);
  a = src[0]; b = src[1];
}
DEVI void s5_store_u(float* U, int lane, const uint4& a, const uint4& b) {
  float4* d = (float4*)(U + lane * 16);
  d[0] = float4{__uint_as_float(a.x << 16), __uint_as_float(a.x & 0xffff0000u), __uint_as_float(a.y << 16), __uint_as_float(a.y & 0xffff0000u)};
  d[1] = float4{__uint_as_float(a.z << 16), __uint_as_float(a.z & 0xffff0000u), __uint_as_float(a.w << 16), __uint_as_float(a.w & 0xffff0000u)};
  d[2] = float4{__uint_as_float(b.x << 16), __uint_as_float(b.x & 0xffff0000u), __uint_as_float(b.y << 16), __uint_as_float(b.y & 0xffff0000u)};
  d[3] = float4{__uint_as_float(b.z << 16), __uint_as_float(b.z & 0xffff0000u), __uint_as_float(b.w << 16), __uint_as_float(b.w & 0xffff0000u)};
}
DEVI f32x2 cmul2(f32x2 a, f32x2 b) { return f32x2{a.x, a.x} * b + f32x2{a.y, a.y} * f32x2{-b.y, b.x}; }
#define S5_BU2(Urow, acc2)                                                            \
  {                                                                                   \
    const float4* u4 = (const float4*)(Urow);                                         \
    _Pragma("unroll") for (int pp = 0; pp < 4; ++pp) {                                \
      const float4 u = u4[pp];                                                        \
      acc2 = B2[4 * pp] * f32x2{u.x, u.x} + acc2; acc2 = B2[4 * pp + 1] * f32x2{u.y, u.y} + acc2; \
      acc2 = B2[4 * pp + 2] * f32x2{u.z, u.z} + acc2; acc2 = B2[4 * pp + 3] * f32x2{u.w, u.w} + acc2; \
    }                                                                                 \
  }

__device__ void s5_passA(const Params& p, int i, unsigned char* lds) {
  const ushort_t* PS5 = (const ushort_t*)(p.ws + OFF_PS5);
  cplx* CAR = (cplx*)(p.ws + OFF_CAR);
  const int lane = tidx() & 63, wave = tidx() >> 6;
  float* U = (float*)(lds + wave * 8448);
  for (int item = bidx() * 8 + wave; item < 192 * 32; item += gridDim.x * 8) {
    const int q = item >> 5, g = item & 31;
    cplx lb0, c0, lb1, c1;
    s5_consts(p, i, 0, g, lane, lb0, c0);
    s5_consts(p, i, 1, g, lane, lb1, c1);
    const f32x2 l0 = {lb0.x, lb0.y}, l1 = {lb1.x, lb1.y};
    f32x2 B2[16];
#pragma unroll
    for (int pp = 0; pp < 16; ++pp) B2[pp] = f32x2{p.in[I_BRE][((i * 32 + g) * 64 + lane) * 16 + pp], p.in[I_BIM][((i * 32 + g) * 64 + lane) * 16 + pp]};
    f32x2 xf = {0.f, 0.f}, xb = {0.f, 0.f}, pw = {1.f, 0.f};
    uint4 ua, ub;
    s5_load_u(PS5, q * 256, g, lane, ua, ub);
    for (int sb = 0; sb < 4; ++sb) {
      wave_sync();
      s5_store_u(U, lane, ua, ub);
      wave_sync();
      if (sb < 3) s5_load_u(PS5, q * 256 + (sb + 1) * 64, g, lane, ua, ub);
#pragma unroll 4
      for (int t = 0; t < 64; ++t) {
        f32x2 bu = {0.f, 0.f};
        S5_BU2(U + t * 16, bu);
        xf = cmul2(l0, xf) + bu;
        xb = cmul2(pw, bu) + xb;
        pw = cmul2(pw, l1);
      }
    }
    CAR[((size_t)(q * 32 + g) * 2 + 0) * 64 + lane] = cmul(cplx{xf.x, xf.y}, c0);
    CAR[((size_t)(q * 32 + g) * 2 + 1) * 64 + lane] = cmul(cplx{xb.x, xb.y}, c1);
  }
}

__device__ void s5_passC(const Params& p, int i, unsigned char* lds) {
  const ushort_t* PS5 = (const ushort_t*)(p.ws + OFF_PS5);
  const cplx* CAR = (const cplx*)(p.ws + OFF_CAR);
  float* YS = (float*)(p.ws + OFF_YS);
  ushort_t* YG = (ushort_t*)(p.ws + OFF_Y);
  const int lane = tidx() & 63, wave = tidx() >> 6;
  float* U = (float*)(lds + wave * 8448);
  ushort_t* X = (ushort_t*)(lds + wave * 8448 + 4096);
  for (int item = bidx() * 8 + wave; item < 192 * 32; item += gridDim.x * 8) {
    const int q = item >> 5, g = item & 31;
    int cs, ce;
    if (q < 64) { cs = q & ~15; ce = cs + 16; } else { cs = 64 + ((q - 64) & ~63); ce = cs + 64; }
    const int pcol = lane & 15;
    const float dd = p.in[I_S5D][i * 512 + g * 16 + pcol];
    for (int d = 0; d < 2; ++d) {
      cplx lb, coef;
      s5_consts(p, i, d, g, lane, lb, coef);
      const f32x2 l2 = {lb.x, lb.y};
      f32x2 B2[16];
#pragma unroll
      for (int pp = 0; pp < 16; ++pp) {
        const cplx bb = cmul(coef, cplx{p.in[I_BRE][((i * 32 + g) * 64 + lane) * 16 + pp], p.in[I_BIM][((i * 32 + g) * 64 + lane) * 16 + pp]});
        B2[pp] = f32x2{bb.x, bb.y};
      }
      cplx lp = lb;
#pragma unroll
      for (int e = 0; e < 8; ++e) lp = cmul(lp, lp);
      cplx xs{0.f, 0.f};
      if (d == 0) {
#pragma unroll 8
        for (int j = cs; j < q; ++j) { xs = cmul(lp, xs); cplx c = CAR[((size_t)(j * 32 + g) * 2 + 0) * 64 + lane]; xs.x += c.x; xs.y += c.y; } }
      else {
#pragma unroll 8
        for (int j = ce - 1; j > q; --j) { xs = cmul(lp, xs); cplx c = CAR[((size_t)(j * 32 + g) * 2 + 1) * 64 + lane]; xs.x += c.x; xs.y += c.y; } }
      f32x2 x2 = {xs.x, xs.y};
      bf16x8 cf[4];
#pragma unroll
      for (int kk = 0; kk < 4; ++kk) {
        const int n0 = (kk & 1) * 32 + (lane >> 4) * 8;
        const float* src = (kk < 2 ? p.in[I_CRE] : p.in[I_CIM]) + (((size_t)(i * 2 + d) * 32 + g) * 16 + pcol) * 64 + n0;
        const float sg = kk < 2 ? 1.f : -1.f;
#pragma unroll
        for (int j = 0; j < 8; ++j) cf[kk][j] = (short)f2bf(sg * src[j]);
      }
      uint4 ua, ub;
      s5_load_u(PS5, q * 256 + (d ? 3 : 0) * 64, g, lane, ua, ub);
      for (int sbi = 0; sbi < 4; ++sbi) {
        const int sb = d ? 3 - sbi : sbi;
        wave_sync();
        s5_store_u(U, lane, ua, ub);
        wave_sync();
        if (sbi < 3) s5_load_u(PS5, q * 256 + (d ? 2 - sbi : sbi + 1) * 64, g, lane, ua, ub);
        for (int tbi = 0; tbi < 4; ++tbi) {
          const int tb = d ? 3 - tbi : tbi;
          float ysp[4] = {0.f, 0.f, 0.f, 0.f};
          if (d == 1) {
#pragma unroll
            for (int r = 0; r < 4; ++r) ysp[r] = YS[(size_t)(q * 256 + sb * 64 + tb * 16 + (lane >> 4) * 4 + r) * 512 + g * 16 + pcol];
          }
#pragma unroll 4
          for (int tti = 0; tti < 16; ++tti) {
            const int tt = d ? 15 - tti : tti;
            f32x2 acc2 = cmul2(l2, x2);
            S5_BU2(U + (tb * 16 + tt) * 16, acc2);
            x2 = acc2;
            X[tt * 136 + lane] = f2bf(x2.x);
            X[tt * 136 + 64 + lane] = f2bf(x2.y);
          }
          wave_sync();
          f32x4 acc{0.f, 0.f, 0.f, 0.f};
#pragma unroll
          for (int kk = 0; kk < 4; ++kk) {
            bf16x8 a = *(const bf16x8*)(X + (lane & 15) * 136 + kk * 32 + (lane >> 4) * 8);
            acc = __builtin_amdgcn_mfma_f32_16x16x32_bf16(a, cf[kk], acc, 0, 0, 0);
          }
          wave_sync();
#pragma unroll
          for (int r = 0; r < 4; ++r) {
            const int tl = tb * 16 + (lane >> 4) * 4 + r;
            const size_t o = (size_t)(q * 256 + sb * 64 + tl) * 512 + g * 16 + pcol;
            if (d == 0) YS[o] = acc[r] + dd * U[tl * 16 + pcol];
            else {
              const float yv = ysp[r] + acc[r];
              YG[(size_t)(q * 256 + sb * 64 + tl) * 1024 + 512 + g * 16 + pcol] = f2bf(yv * fast_sigmoid(1.5957691216f * (yv + 0.044715f * yv * yv * yv)));
            }
          }
        }
      }
    }
  }
}

struct RwConst { float mur, muk, muv, mul, w0, a0, kk, ka; };
struct RwRow { float r, k, v, l; };
DEVI RwRow rw_load_row(const ushort_t* PRW, int tok, int s0, int L, int h, int lane) {
  RwRow o{0.f, 0.f, 0.f, 0.f};
  if (tok >= s0 && tok < s0 + L) {
    const ushort_t* row = PRW + (size_t)tok * 2112;
    const int cc = h * 64 + lane;
    o.r = bf2f(row[cc]); o.k = bf2f(row[512 + cc]); o.v = bf2f(row[1024 + cc]); o.l = bf2f(row[2048 + lane]);
  }
  return o;
}
DEVI void rw_prologue(const RwRow& rm, const RwRow& rc, const RwRow& rn, int lane, const RwConst& c, const float* WU, const float* AU,
                      float* LT, float* Wd, float* KKd, float* BBd, float* KDd, float* RRd, float* VVd) {
  const float rr = rc.r + c.mur * (0.5f * (rm.r + rn.r) - rc.r);
  const float kx = rc.k + c.muk * (0.5f * (rm.k + rn.k) - rc.k);
  const float vv = rc.v + c.muv * (0.5f * (rm.v + rn.v) - rc.v);
  float ll = rc.l + c.mul * (0.5f * (rm.l + rn.l) - rc.l);
  ll = lane < 32 ? fast_tanh(ll) : ll;
  wave_sync();
  LT[lane] = ll;
  wave_sync();
  float accw = c.w0, acca = c.a0;
#pragma unroll 2
  for (int j = 0; j < 32; j += 4) {
    float4 lw = *(const float4*)(LT + j), la = *(const float4*)(LT + 32 + j);
    accw += lw.x * WU[(j + 0) * 64 + lane] + lw.y * WU[(j + 1) * 64 + lane] + lw.z * WU[(j + 2) * 64 + lane] + lw.w * WU[(j + 3) * 64 + lane];
    acca += la.x * AU[(j + 0) * 64 + lane] + la.y * AU[(j + 1) * 64 + lane] + la.z * AU[(j + 2) * 64 + lane] + la.w * AU[(j + 3) * 64 + lane];
  }
  const float dec = __builtin_amdgcn_exp2f(-0.8750387749145276f * fast_sigmoid(accw));
  const float a = fast_sigmoid(acca);
  const float kkr = kx * c.kk;
  const float ss = wsum_fast(kkr * kkr);
  const float kkn = kkr * __builtin_amdgcn_rsqf(fmaxf(ss, 1e-24f));
  Wd[lane] = dec; KKd[lane] = kkn; BBd[lane] = kkn * a; KDd[lane] = kx * (1.f + (a - 1.f) * c.ka); RRd[lane] = rr; VVd[lane] = vv;
}

template <int NS>
DEVI void rw_prologue_blk(const RwRow* R, int lane, const RwConst& c, const bf16x8* BF, int dir, ushort_t* LTm,
                          float* Wd, float* KKd, float* BBd, float* KDd, float* RRd, float* VVd) {
#pragma unroll
  for (int e = 0; e < NS; ++e) {
    const RwRow& rm = R[e]; const RwRow& rc = R[e + 1]; const RwRow& rn = R[e + 2];
    const float rr = rc.r + c.mur * (0.5f * (rm.r + rn.r) - rc.r);
    const float kx = rc.k + c.muk * (0.5f * (rm.k + rn.k) - rc.k);
    const float vv = rc.v + c.muv * (0.5f * (rm.v + rn.v) - rc.v);
    float ll = rc.l + c.mul * (0.5f * (rm.l + rn.l) - rc.l);
    ll = lane < 32 ? fast_tanh(ll) : ll;
    RRd[e * 64 + lane] = rr; VVd[e * 64 + lane] = vv; KDd[e * 64 + lane] = kx;
    LTm[e * 72 + lane] = f2bf(ll);
  }
  wave_sync_lds();
  {
    const int row = lane & (NS - 1), kq8 = (lane >> 4) * 8;
    const bf16x8 aw = *(const bf16x8*)(LTm + row * 72 + kq8);
    const bf16x8 aa = *(const bf16x8*)(LTm + row * 72 + 32 + kq8);
#pragma unroll
    for (int nt = 0; nt < 4; ++nt) {
      const f32x4 z = {0.f, 0.f, 0.f, 0.f};
      const f32x4 dw = __builtin_amdgcn_mfma_f32_16x16x32_bf16(aw, BF[(dir * 4 + nt) * 64 + lane], z, 0, 0, 0);
      const f32x4 da = __builtin_amdgcn_mfma_f32_16x16x32_bf16(aa, BF[(8 + nt) * 64 + lane], z, 0, 0, 0);
      if ((lane >> 4) < NS / 4) {
#pragma unroll
        for (int r = 0; r < 4; ++r) {
          const int o = ((lane >> 4) * 4 + r) * 64 + nt * 16 + (lane & 15);
          Wd[o] = dw[r]; BBd[o] = da[r];
        }
      }
    }
  }
  wave_sync_lds();
#pragma unroll
  for (int e = 0; e < NS; ++e) {
    const float accw = c.w0 + Wd[e * 64 + lane], acca = c.a0 + BBd[e * 64 + lane], kx = KDd[e * 64 + lane];
    const float dec = __builtin_amdgcn_exp2f(-0.8750387749145276f * fast_sigmoid(accw));
    const float a = fast_sigmoid(acca);
    const float kkr = kx * c.kk;
    const float ss = wsum_fast(kkr * kkr);
    const float kkn = kkr * __builtin_amdgcn_rsqf(fmaxf(ss, 1e-24f));
    Wd[e * 64 + lane] = dec; KKd[e * 64 + lane] = kkn; BBd[e * 64 + lane] = kkn * a; KDd[e * 64 + lane] = kx * (1.f + (a - 1.f) * c.ka);
  }
}
DEVI void rw_fill_bf(const Params& p, int i, int h, bf16x8* BF, int tid, int nthr = NT) {
  for (int e = tid; e < 768; e += nthr) {
    const int which = e >> 8, nt = (e >> 6) & 3, l = e & 63;
    const int n = nt * 16 + (l & 15), k0 = (l >> 4) * 8;
    const float* src = which < 2 ? p.in[I_WUP] + ((size_t)(i * 2 + which) * 32) * 512 : p.in[I_AUP] + ((size_t)i * 32) * 512;
    bf16x8 v;
#pragma unroll
    for (int jj = 0; jj < 8; ++jj) v[jj] = (short)f2bf(src[(size_t)(k0 + jj) * 512 + h * 64 + n]);
    BF[e] = v;
  }
}

DEVI float dpp_f(float x, const int ctrl_sel) {
  int xi = __builtin_bit_cast(int, x), r;
  if (ctrl_sel == 0) r = __builtin_amdgcn_mov_dpp(xi, 0xB1, 0xf, 0xf, true);
  else if (ctrl_sel == 1) r = __builtin_amdgcn_mov_dpp(xi, 0x4E, 0xf, 0xf, true);
  else r = __builtin_amdgcn_mov_dpp(xi, 0x141, 0xf, 0xf, true);
  return __builtin_bit_cast(float, r);
}
DEVI float red8(float x) { x += dpp_f(x, 0); x += dpp_f(x, 1); x += dpp_f(x, 2); return x; }

#define RW_LOAD8(dst2, base)                                                        \
  { const float4 _a = *(const float4*)(base), _b = *(const float4*)((base) + 4);    \
    dst2[0] = f32x2{_a.x, _a.y}; dst2[1] = f32x2{_a.z, _a.w}; dst2[2] = f32x2{_b.x, _b.y}; dst2[3] = f32x2{_b.z, _b.w}; }

__device__ void rwkv_scan1(const Params& p, int i, unsigned char* lds) {
  const ushort_t* PRW = (const ushort_t*)(p.ws + OFF_PRW);
  float* CH = (float*)(p.ws + OFF_PS5);
  float* YR = (float*)(p.ws + OFF_YS);
  const int tid = tidx(), lane = tid & 63, wave = tid >> 6, pair = wave >> 1, role = (wave ^ (wave >> 2)) & 1;
  const int vq = lane >> 3, kq = lane & 7;
  bf16x8* BF = (bf16x8*)lds;
  float* WV = (float*)(lds + 12288 + pair * 14592);
  float* Wd = WV, *KKd = WV + 512, *BBd = WV + 1024, *KDd = WV + 1536, *RRd = WV + 2048, *VVd = WV + 2560;
  ushort_t* LTm = (ushort_t*)(WV + 3072) + role * 576;
  {
    float4* z = (float4*)YR;
    for (size_t e = (size_t)bidx() * NT + tid; e < (size_t)T * 512 / 4; e += (size_t)gridDim.x * NT) z[e] = float4{0.f, 0.f, 0.f, 0.f};
  }
  for (int bi = bidx(); bi < 768; bi += gridDim.x) {
    const int h = bi / 96, rem = bi % 96;
    const int dir = pair >> 1, q = rem * 2 + (pair & 1);
    __syncthreads();
    rw_fill_bf(p, i, h, BF, tid);
    __syncthreads();
    RwConst c;
    const int cc = h * 64 + lane;
    c.mur = p.in[I_MURKV][(i * 3 + 0) * 512 + cc]; c.muk = p.in[I_MURKV][(i * 3 + 1) * 512 + cc]; c.muv = p.in[I_MURKV][(i * 3 + 2) * 512 + cc];
    c.mul = p.in[I_MULORA][i * 64 + lane];
    c.w0 = p.in[I_W0][(i * 2 + dir) * 512 + cc]; c.a0 = p.in[I_A0][(i * 2 + dir) * 512 + cc];
    c.kk = p.in[I_KK][i * 512 + cc]; c.ka = p.in[I_KA][i * 512 + cc];
    const size_t it = ((size_t)(q * 8 + h) * 2 + dir);
    int sq0, sqL; seq_of(q * 256, sq0, sqL);
    float* Op = CH + it * 8192 + (role ? 0 : 4096);
    f32x2 S2[8][4];
    int diag = (role && vq == kq) ? 1 : 0;
    asm volatile("" : "+v"(diag));
#pragma unroll
    for (int r = 0; r < 8; ++r)
#pragma unroll
      for (int jj = 0; jj < 4; ++jj) S2[r][jj] = f32x2{(diag && (2 * jj == r)) ? 1.f : 0.f, (diag && (2 * jj + 1 == r)) ? 1.f : 0.f};
    const float vsel = role ? 0.f : 1.f;
    RwRow R[6];
#pragma unroll
    for (int j = 0; j < 6; ++j) {
      const int st = role * 4 + j - 1;
      R[j] = rw_load_row(PRW, dir ? (q * 256 + 255 - st) : (q * 256 + st), sq0, sqL, h, lane);
    }
    for (int blk = 0; blk < 32; ++blk) {
      {
        const int s = role * 4;
        rw_prologue_blk<4>(R, lane, c, BF, dir, LTm, Wd + s * 64, KKd + s * 64, BBd + s * 64, KDd + s * 64, RRd + s * 64, VVd + s * 64);
      }
      if (blk + 1 < 32) {
#pragma unroll
        for (int j = 0; j < 6; ++j) {
          const int st = (blk + 1) * 8 + role * 4 + j - 1;
          R[j] = rw_load_row(PRW, dir ? (q * 256 + 255 - st) : (q * 256 + st), sq0, sqL, h, lane);
        }
      }
      block_sync_lds();
#pragma unroll 2
      for (int s = 0; s < 8; ++s) {
        f32x2 kk2[4], w2[4], b2[4], kd2[4], vv2[4];
        RW_LOAD8(kk2, KKd + s * 64 + 8 * kq);
        RW_LOAD8(vv2, VVd + s * 64 + 8 * vq);
        RW_LOAD8(w2, Wd + s * 64 + 8 * kq);
        RW_LOAD8(b2, BBd + s * 64 + 8 * kq);
        RW_LOAD8(kd2, KDd + s * 64 + 8 * kq);
        float sa[8];
#pragma unroll
        for (int r = 0; r < 8; ++r) {
          f32x2 a = S2[r][0] * kk2[0];
          a = S2[r][1] * kk2[1] + a; a = S2[r][2] * kk2[2] + a; a = S2[r][3] * kk2[3] + a;
          sa[r] = -red8(a.x + a.y);
        }
#pragma unroll
        for (int r = 0; r < 8; ++r) {
          const float vr = ((r & 1) ? vv2[r >> 1].y : vv2[r >> 1].x) * vsel;
          const f32x2 sa2 = f32x2{sa[r], sa[r]}, v2 = f32x2{vr, vr};
#pragma unroll
          for (int jj = 0; jj < 4; ++jj) S2[r][jj] = S2[r][jj] * w2[jj] + sa2 * b2[jj] + v2 * kd2[jj];
        }
      }
      block_sync_lds();
    }
#pragma unroll
    for (int r = 0; r < 8; ++r) {
      float* dst = Op + (8 * vq + r) * 64 + 8 * kq;
      *(float4*)dst = float4{S2[r][0].x, S2[r][0].y, S2[r][1].x, S2[r][1].y};
      *(float4*)(dst + 4) = float4{S2[r][2].x, S2[r][2].y, S2[r][3].x, S2[r][3].y};
    }
  }
}

__device__ void rwkv_scan3(const Params& p, int i, unsigned char* lds, bool dry = false) {
  const ushort_t* PRW = (const ushort_t*)(p.ws + OFF_PRW);
  float* CH = (float*)(p.ws + OFF_PS5);
  float* YR = (float*)(p.ws + OFF_YS);
  const int tid = tidx(), lane = tid & 63, wave = tid >> 6;
  const int vq = lane >> 3, kq = lane & 7;
  const int half = wave >> 2;
  bf16x8* BF = (bf16x8*)lds + half * 768;
  float* WV = (float*)(lds + 24576 + wave * 13440);
  float* Wd = WV, *KKd = WV + 512, *BBd = WV + 1024, *KDd = WV + 1536, *RRd = WV + 2048, *VVd = WV + 2560;
  ushort_t* LTm = (ushort_t*)(WV + 3072);
  for (int tb2 = bidx() * 2; tb2 < 512; tb2 += gridDim.x * 2)
  for (int rnd = 0; rnd < 2; ++rnd) {
    const int tb = tb2 >> 1;
    const int hi = tb * 3 + (rnd == 0 ? half : 2);
    const bool active = (rnd == 0) || (half == 0);
    const int h = hi / 96, rem = hi % 96, cgp = rem >> 1, dir = rem & 1;
    const int q = cgp * 4 + (wave & 3);
    __syncthreads();
    if (active) rw_fill_bf(p, i, h, BF, tid & 255, 256);
    __syncthreads();
    if (!active) continue;
    RwConst c;
    const int cc = h * 64 + lane;
    c.mur = p.in[I_MURKV][(i * 3 + 0) * 512 + cc]; c.muk = p.in[I_MURKV][(i * 3 + 1) * 512 + cc]; c.muv = p.in[I_MURKV][(i * 3 + 2) * 512 + cc];
    c.mul = p.in[I_MULORA][i * 64 + lane];
    c.w0 = p.in[I_W0][(i * 2 + dir) * 512 + cc]; c.a0 = p.in[I_A0][(i * 2 + dir) * 512 + cc];
    c.kk = p.in[I_KK][i * 512 + cc]; c.ka = p.in[I_KA][i * 512 + cc];
    const size_t it = ((size_t)(q * 8 + h) * 2 + dir);
    int sq0, sqL; seq_of(q * 256, sq0, sqL);
    const float* Qp = CH + it * 8192 + 4096;
    f32x2 S2[8][4];
#pragma unroll
    for (int r = 0; r < 8; ++r) {
      const float* src = Qp + (8 * vq + r) * 64 + 8 * kq;
      const float4 a = *(const float4*)src, b = *(const float4*)(src + 4);
      S2[r][0] = f32x2{a.x, a.y}; S2[r][1] = f32x2{a.z, a.w}; S2[r][2] = f32x2{b.x, b.y}; S2[r][3] = f32x2{b.z, b.w};
    }
    RwRow R[10];
#pragma unroll
    for (int j = 0; j < 10; ++j) {
      const int st = j - 1;
      R[j] = rw_load_row(PRW, dir ? (q * 256 + 255 - st) : (q * 256 + st), sq0, sqL, h, lane);
    }
    for (int blk = 0; blk < 32; ++blk) {
      rw_prologue_blk<8>(R, lane, c, BF, dir, LTm, Wd, KKd, BBd, KDd, RRd, VVd);
      if (blk + 1 < 32) {
#pragma unroll
        for (int j = 0; j < 10; ++j) {
          const int st = (blk + 1) * 8 + j - 1;
          R[j] = rw_load_row(PRW, dir ? (q * 256 + 255 - st) : (q * 256 + st), sq0, sqL, h, lane);
        }
      }
      wave_sync_lds();
#pragma unroll 2
      for (int s = 0; s < 8; ++s) {
        f32x2 kk2[4], w2[4], b2[4], kd2[4], vv2[4], r2[4];
        RW_LOAD8(kk2, KKd + s * 64 + 8 * kq);
        RW_LOAD8(vv2, VVd + s * 64 + 8 * vq);
        RW_LOAD8(w2, Wd + s * 64 + 8 * kq);
        RW_LOAD8(b2, BBd + s * 64 + 8 * kq);
        RW_LOAD8(kd2, KDd + s * 64 + 8 * kq);
        RW_LOAD8(r2, RRd + s * 64 + 8 * kq);
        float sa[8];
#pragma unroll
        for (int r = 0; r < 8; ++r) {
          f32x2 a = S2[r][0] * kk2[0];
          a = S2[r][1] * kk2[1] + a; a = S2[r][2] * kk2[2] + a; a = S2[r][3] * kk2[3] + a;
          sa[r] = -red8(a.x + a.y);
        }
        float ysel = 0.f;
#pragma unroll
        for (int r = 0; r < 8; ++r) {
          const float vr = (r & 1) ? vv2[r >> 1].y : vv2[r >> 1].x;
          const f32x2 sa2 = f32x2{sa[r], sa[r]}, v2 = f32x2{vr, vr};
          f32x2 ya = f32x2{0.f, 0.f};
#pragma unroll
          for (int jj = 0; jj < 4; ++jj) {
            S2[r][jj] = S2[r][jj] * w2[jj] + sa2 * b2[jj] + v2 * kd2[jj];
            ya = S2[r][jj] * r2[jj] + ya;
          }
          const float yr = red8(ya.x + ya.y);
          ysel = (kq == r) ? yr : ysel;
        }
        const int st = blk * 8 + s;
        const int tok = dir ? (q * 256 + 255 - st) : (q * 256 + st);
        if (!dry) atomicAdd(YR + (size_t)tok * 512 + h * 64 + lane, ysel);
      }
      wave_sync_lds();
    }
  }
}

__device__ void rwkv_carry(const Params& p, unsigned char* lds, bool dry = false) {
  float* CH = (float*)(p.ws + OFF_PS5);
  float* Ps = (float*)lds;
  float* Ss = Ps + 4096;
  const int tid = tidx(), v = tid >> 4, ks = (tid & 15) * 4;
  for (int bi = bidx(); bi < 192; bi += gridDim.x) {
    const int half = bi & 1, dir = (bi >> 1) & 1, h = (bi >> 2) & 7, s = bi >> 5;
    int cs, n;
    if (s < 4) { cs = s * 16; n = 16; } else { cs = 64 + (s - 4) * 64; n = 64; }
    float4 cur{0.f, 0.f, 0.f, 0.f};
    float4 pq0, pq1, qv;
    {
      const int q = dir ? (cs + n - 1) : cs;
      const float* Pp = CH + ((size_t)(q * 8 + h) * 2 + dir) * 8192;
      pq0 = ((const float4*)Pp)[tid]; pq1 = ((const float4*)Pp)[tid + 512];
      qv = *(const float4*)(Pp + 4096 + (half * 32 + v) * 64 + ks);
    }
    for (int ci = 0; ci < n; ++ci) {
      const int q = dir ? (cs + n - 1 - ci) : (cs + ci);
      float* Pp = CH + ((size_t)(q * 8 + h) * 2 + dir) * 8192;
      float* Qrow = Pp + 4096 + (half * 32 + v) * 64 + ks;
      __syncthreads();
      if (!dry) *(float4*)Qrow = cur;
      if (ci == n - 1) break;
      *(float4*)(Ss + v * 64 + ks) = cur;
      ((float4*)Ps)[tid] = pq0;
      ((float4*)Ps)[tid + 512] = pq1;
      float4 acc = qv;
      if (ci + 2 < n + 1 && ci + 1 < n) {
        const int qn = dir ? (cs + n - 2 - ci) : (cs + ci + 1);
        const float* Pn = CH + ((size_t)(qn * 8 + h) * 2 + dir) * 8192;
        pq0 = ((const float4*)Pn)[tid]; pq1 = ((const float4*)Pn)[tid + 512];
        qv = *(const float4*)(Pn + 4096 + (half * 32 + v) * 64 + ks);
      }
      __syncthreads();
#pragma unroll 8
      for (int j = 0; j < 64; ++j) {
        const float sv = Ss[v * 64 + j];
        const float4 pr = *(const float4*)(Ps + j * 64 + ks);
        acc.x += sv * pr.x; acc.y += sv * pr.y; acc.z += sv * pr.z; acc.w += sv * pr.w;
      }
      cur = acc;
    }
    __syncthreads();
  }
}

struct PostIn { float r[6], k[6], v[6], g[4], y[4]; };
DEVI void post_load(const ushort_t* __restrict__ PRW, const float* __restrict__ YR, int item, int lane, PostIn& o) {
  const int tok0 = (item >> 3) * 4, h = item & 7, cc = h * 64 + lane;
  int s0, L; seq_of(tok0, s0, L);
#pragma unroll
  for (int j = 0; j < 6; ++j) {
    const int tok = tok0 - 1 + j;
    o.r[j] = 0.f; o.k[j] = 0.f; o.v[j] = 0.f;
    if (tok >= s0 && tok < s0 + L) {
      const ushort_t* row = PRW + (size_t)tok * 2112;
      o.r[j] = bf2f(row[cc]); o.k[j] = bf2f(row[512 + cc]); o.v[j] = bf2f(row[1024 + cc]);
    }
  }
#pragma unroll
  for (int e = 0; e < 4; ++e) { o.g[e] = bf2f(PRW[(size_t)(tok0 + e) * 2112 + 1536 + cc]); o.y[e] = YR[(size_t)(tok0 + e) * 512 + cc]; }
}
__device__ void rwkv_post(const Params& p, int i) {
  const ushort_t* __restrict__ PRW = (const ushort_t*)(p.ws + OFF_PRW);
  const float* __restrict__ YR = (const float*)(p.ws + OFF_YS);
  ushort_t* __restrict__ Y = (ushort_t*)(p.ws + OFF_Y);
  const int lane = tidx() & 63, gw = bidx() * 8 + (tidx() >> 6), nw = gridDim.x * 8;
  PostIn cur, nxt;
  if (gw < (T / 4) * 8) post_load(PRW, YR, gw, lane, cur);
  for (int item = gw; item < (T / 4) * 8; item += nw) {
    const int tok0 = (item >> 3) * 4, h = item & 7, cc = h * 64 + lane;
    if (item + nw < (T / 4) * 8) post_load(PRW, YR, item + nw, lane, nxt);
    const float mur = p.in[I_MURKV][(i * 3 + 0) * 512 + cc], muk = p.in[I_MURKV][(i * 3 + 1) * 512 + cc], muv = p.in[I_MURKV][(i * 3 + 2) * 512 + cc];
    const float lw = p.in[I_LNXW][i * 512 + cc], lb = p.in[I_LNXB][i * 512 + cc], rk = p.in[I_RK][i * 512 + cc];
#pragma unroll
    for (int e = 0; e < 4; ++e) {
      const float rr = cur.r[e + 1] + mur * (0.5f * (cur.r[e] + cur.r[e + 2]) - cur.r[e + 1]);
      const float kx = cur.k[e + 1] + muk * (0.5f * (cur.k[e] + cur.k[e + 2]) - cur.k[e + 1]);
      const float vv = cur.v[e + 1] + muv * (0.5f * (cur.v[e] + cur.v[e + 2]) - cur.v[e + 1]);
      const float mean = wsum_fast(cur.y[e]) * (1.f / 64.f);
      const float dlt = cur.y[e] - mean;
      const float var = wsum_fast(dlt * dlt) * (1.f / 64.f);
      const float yn = dlt * __builtin_amdgcn_rsqf(var + 64e-5f) * lw + lb;
      const float bonus = wsum_fast(rr * kx * rk) * vv;
      Y[(size_t)(tok0 + e) * 1024 + 512 + cc] = f2bf((yn + bonus) * (cur.g[e] * fast_sigmoid(cur.g[e])));
    }
    cur = nxt;
  }
}

__device__ void hy_filter_mlp(const Params& p, int i) {
  float* H2 = (float*)(p.ws + OFF_H2);
  const int lane = tidx() & 63, gw = bidx() * 8 + (tidx() >> 6), nw = gridDim.x * 8;
  const float fr = p.in[I_FFREQ][i * 64 + lane], b1 = p.in[I_FB1][i * 64 + lane], b2 = p.in[I_FB2][i * 64 + lane];
  for (int row = gw; row < 20480; row += nw) {
    const int L = row < 4096 ? 4096 : 16384, t = row < 4096 ? row : row - 4096;
    const float w = 6.283185307179586f * (float)t / (float)L;
    float z = 0.f;
    if (lane == 0) z = (float)t / (float)(L - 1);
    else if (lane <= 32) {
      const int bi = (lane - 1) & 15;
      const float f = 1e-4f + (float)bi * ((15.f - 1e-4f) / 15.f);
      z = lane <= 16 ? cosf(f * w) : -sinf(f * w);
    }
    float a = b1;
#pragma unroll 3
    for (int k = 0; k < 33; ++k) a += __shfl(z, k) * p.in[I_FW1][((size_t)i * 33 + k) * 64 + lane];
    const float h1 = sinf(fr * a);
    float c = b2;
#pragma unroll 8
    for (int k = 0; k < 64; ++k) c += __shfl(h1, k) * p.in[I_FW2][((size_t)i * 64 + k) * 64 + lane];
    H2[(row < 4096 ? (size_t)0 : (size_t)4096 * 64) + (size_t)lane * L + t] = sinf(fr * c);
  }
}

DEVI constexpr int swz(int i) { return i ^ ((i & 32) ? 21 : 0) ^ ((i & 64) ? 26 : 0); }
DEVI int swzF(int t) { return (swz(t >> 1) << 1) | (t & 1); }
DEVI f32x2 cmul_pk(f32x2 a, float c, float sn) { return a * f32x2{c, c} + f32x2{-a.y, a.x} * f32x2{sn, sn}; }
template <int LOGN, int NSEQ>
__device__ void fft_dif(float2* buf_) {
  constexpr int N = 1 << LOGN;
  f32x2* buf = (f32x2*)buf_;
  const int tid = tidx();
#pragma unroll
  for (int ps = 0; ps < LOGN / 2; ++ps) {
    const int lh = LOGN - 1 - 2 * ps;
    const int h = 1 << lh, hh = h >> 1;
    const float inv2h = 1.f / (float)(2 * h);
#pragma unroll 4
    for (int qg = tid; qg < NSEQ * N / 4; qg += NT) {
      const int q = qg & (N / 4 - 1), sb = (qg >> (LOGN - 2)) << LOGN;
      const int pos = q & (hh - 1), grp = q >> (lh - 1);
      const int e0 = sb + swz((grp << (lh + 1)) + pos);
      const int o1 = swz(hh), o2 = swz(h), o3 = swz(h + hh);
      const f32x2 x0 = buf[e0], x1 = buf[e0 ^ o1], x2 = buf[e0 ^ o2], x3 = buf[e0 ^ o3];
      const float f1 = (float)pos * inv2h;
      const float c1 = __builtin_amdgcn_cosf(f1), s1 = -__builtin_amdgcn_sinf(f1);
      const float c2 = c1 * c1 - s1 * s1, s2 = 2.f * c1 * s1;
      const f32x2 a0 = x0 + x2, a1 = x1 + x3;
      const f32x2 a2 = cmul_pk(x0 - x2, c1, s1);
      const f32x2 t3 = cmul_pk(x1 - x3, c1, s1);
      const f32x2 a3 = f32x2{t3.y, -t3.x};
      buf[e0] = a0 + a1;
      buf[e0 ^ o1] = cmul_pk(a0 - a1, c2, s2);
      buf[e0 ^ o2] = a2 + a3;
      buf[e0 ^ o3] = cmul_pk(a2 - a3, c2, s2);
    }
    __syncthreads();
  }
}
template <int LOGN, int NSEQ>
__device__ void fft_dit_inv(float2* buf_) {
  constexpr int N = 1 << LOGN;
  f32x2* buf = (f32x2*)buf_;
  const int tid = tidx();
#pragma unroll
  for (int ps = 0; ps < LOGN / 2; ++ps) {
    const int lh = 2 * ps;
    const int h = 1 << lh;
    const float inv4h = 1.f / (float)(4 * h);
#pragma unroll 4
    for (int qg = tid; qg < NSEQ * N / 4; qg += NT) {
      const int q = qg & (N / 4 - 1), sb = (qg >> (LOGN - 2)) << LOGN;
      const int pos = q & (h - 1), grp = q >> lh;
      const int e0 = sb + swz((grp << (lh + 2)) + pos);
      const int o1 = swz(h), o2 = swz(2 * h), o3 = swz(3 * h);
      const f32x2 x0 = buf[e0], x1 = buf[e0 ^ o1], x2 = buf[e0 ^ o2], x3 = buf[e0 ^ o3];
      const float f2 = (float)pos * inv4h;
      const float c2 = __builtin_amdgcn_cosf(f2), s2 = __builtin_amdgcn_sinf(f2);
      const float c1 = c2 * c2 - s2 * s2, s1 = 2.f * c2 * s2;
      const f32x2 b1 = cmul_pk(x1, c1, s1), b3 = cmul_pk(x3, c1, s1);
      const f32x2 a0 = x0 + b1, a1 = x0 - b1, a2 = x2 + b3, a3 = x2 - b3;
      const f32x2 cc2 = cmul_pk(a2, c2, s2);
      const f32x2 t3 = cmul_pk(a3, c2, s2);
      const f32x2 cc3 = f32x2{-t3.y, t3.x};
      buf[e0] = a0 + cc2;
      buf[e0 ^ o2] = a0 - cc2;
      buf[e0 ^ o1] = a1 + cc3;
      buf[e0 ^ o3] = a1 - cc3;
    }
    __syncthreads();
  }
}
template <int LOGN, int NSEQ>
__device__ void spectrum_extract(const float2* buf, float4* __restrict__ GPa, float4* __restrict__ GPb, float scale_a, float scale_b) {
  constexpr int Lc = 1 << LOGN;
#pragma unroll 2
  for (int jg = tidx(); jg < NSEQ * Lc / 2; jg += NT) {
    const int j = jg & (Lc / 2 - 1), sq = jg >> (LOGN - 1), sb = sq << LOGN;
    float4* GP = sq ? GPb : GPa;
    const float scale = sq ? scale_b : scale_a;
    if (j == 0) {
      const float2 c = buf[sb], ch = buf[sb + 1];
      GP[0] = float4{(c.x + c.y) * scale, (c.x - c.y) * scale, ch.x * scale, -ch.y * scale};
    } else {
      const int pos = 2 * j;
      const int k = (int)(__brev((unsigned)pos) >> (32 - LOGN));
      const int p2 = pos ^ ((1 << (31 - __clz(pos))) - 1);
      const int sp1 = sb + swz(pos), sp2 = sb + swz(p2);
      float2 C1 = buf[sp1], C2 = buf[sp2];
      float2 E{0.5f * (C1.x + C2.x), 0.5f * (C1.y - C2.y)}, D{0.5f * (C1.x - C2.x), 0.5f * (C1.y + C2.y)};
      float2 O{D.y, -D.x};
      const float f = (float)k * (1.f / (float)(2 * Lc));
      const float wc = __builtin_amdgcn_cosf(f), wsn = -__builtin_amdgcn_sinf(f);
      float2 wO{wc * O.x - wsn * O.y, wc * O.y + wsn * O.x};
      GP[j] = float4{(E.x + wO.x) * scale, (E.y + wO.y) * scale, (E.x - wO.x) * scale, -(E.y - wO.y) * scale};
    }
  }
}
template <int LOGN, int NSEQ>
__device__ void spectrum_mul(float2* buf, const float4* __restrict__ GP) {
  constexpr int Lc = 1 << LOGN;
#pragma unroll 2
  for (int jg = tidx(); jg < NSEQ * Lc / 2; jg += NT) {
    const int j = jg & (Lc / 2 - 1), sb = (jg >> (LOGN - 1)) << LOGN;
    const float4 gp = GP[j];
    if (j == 0) {
      const float2 c = buf[sb], ch = buf[sb + 1];
      const float Y0 = (c.x + c.y) * gp.x, YL = (c.x - c.y) * gp.y;
      buf[sb] = float2{0.5f * (Y0 + YL), 0.5f * (Y0 - YL)};
      buf[sb + 1] = float2{ch.x * gp.z + ch.y * gp.w, ch.y * gp.z - ch.x * gp.w};
    } else {
      const int pos = 2 * j;
      const int k = (int)(__brev((unsigned)pos) >> (32 - LOGN));
      const int p2 = pos ^ ((1 << (31 - __clz(pos))) - 1);
      const int sp1 = sb + swz(pos), sp2 = sb + swz(p2);
      float2 C1 = buf[sp1], C2 = buf[sp2];
      float2 E{0.5f * (C1.x + C2.x), 0.5f * (C1.y - C2.y)}, D{0.5f * (C1.x - C2.x), 0.5f * (C1.y + C2.y)};
      float2 O{D.y, -D.x};
      const float f = (float)k * (1.f / (float)(2 * Lc));
      const float wc = __builtin_amdgcn_cosf(f), wsn = -__builtin_amdgcn_sinf(f);
      float2 wO{wc * O.x - wsn * O.y, wc * O.y + wsn * O.x};
      float2 X1{E.x + wO.x, E.y + wO.y}, X2{E.x - wO.x, -(E.y - wO.y)};
      float2 Y1{X1.x * gp.x - X1.y * gp.y, X1.x * gp.y + X1.y * gp.x};
      float2 Y2{X2.x * gp.z - X2.y * gp.w, X2.x * gp.w + X2.y * gp.z};
      float2 Ye{0.5f * (Y1.x + Y2.x), 0.5f * (Y1.y - Y2.y)};
      float2 Dd{0.5f * (Y1.x - Y2.x), 0.5f * (Y1.y + Y2.y)};
      float2 Yo{wc * Dd.x + wsn * Dd.y, wc * Dd.y - wsn * Dd.x};
      buf[sp1] = float2{Ye.x - Yo.y, Ye.y + Yo.x};
      buf[sp2] = float2{Ye.x + Yo.y, -Ye.y + Yo.x};
    }
  }
}

template <int LOGN>
__device__ void hy_conv_item(const Params& p, int i, int c, unsigned char* lds, bool dry) {
  constexpr int Lc = 1 << LOGN;
  constexpr int L = Lc;
  constexpr int NB = (LOGN == 14) ? 2 : 4;
  constexpr int NSEQ = (LOGN == 14) ? 1 : 4;
  constexpr int LOG8 = LOGN - 3;
  const int tid = tidx();
  float2* buf = (float2*)lds;
  float* bufF = (float*)lds;
  float* W3s = (float*)(lds + 131072);
  float* red = W3s + 256;
  float4* GS = (float4*)(p.ws + OFF_GS + (size_t)bidx() * 2 * GS_PER);
  float4* GS1 = GS + GS_PER / 16;
  float* G1tmp = (float*)GS1;
  float* Z1 = (float*)(p.ws + OFF_Z1 + (size_t)bidx() * 65536);
  const float* H2 = (const float*)(p.ws + OFF_H2) + (LOGN == 14 ? (size_t)4096 * 64 : 0);
  const ushort_t* PH = (const ushort_t*)(p.ws + OFF_PH);
  const float delta = 4.605170185988091f * (1.f / 1.5f + (1.f / 0.3f - 1.f / 1.5f) * (float)c / 1023.f);
  __syncthreads();
  if (tid < 256) {
    const int j = tid >> 2, col = tid & 3, o = col >> 1, dirr = col & 1;
    W3s[tid] = p.in[I_FW3][((size_t)i * 64 + j) * 4096 + (dirr * 2 + o) * 1024 + c];
  }
  __syncthreads();
  float ss0 = 0.f, ss1 = 0.f;
  for (int t0 = tid * 4; t0 < L; t0 += NT * 4) {
    float acc[4][4];
#pragma unroll
    for (int r = 0; r < 4; ++r)
#pragma unroll
      for (int cc = 0; cc < 4; ++cc) acc[r][cc] = 0.f;
#pragma unroll 1
    for (int jb = 0; jb < 64; jb += 16) {
      float4 hv[16];
#pragma unroll
      for (int jj = 0; jj < 16; ++jj) hv[jj] = *(const float4*)(H2 + (size_t)(jb + jj) * L + t0);
#pragma unroll
      for (int jj = 0; jj < 16; ++jj) {
        const float4 w = *(const float4*)(W3s + 4 * (jb + jj));
        acc[0][0] += hv[jj].x * w.x; acc[0][1] += hv[jj].x * w.y; acc[0][2] += hv[jj].x * w.z; acc[0][3] += hv[jj].x * w.w;
        acc[1][0] += hv[jj].y * w.x; acc[1][1] += hv[jj].y * w.y; acc[1][2] += hv[jj].y * w.z; acc[1][3] += hv[jj].y * w.w;
        acc[2][0] += hv[jj].z * w.x; acc[2][1] += hv[jj].z * w.y; acc[2][2] += hv[jj].z * w.z; acc[2][3] += hv[jj].z * w.w;
        acc[3][0] += hv[jj].w * w.x; acc[3][1] += hv[jj].w * w.y; acc[3][2] += hv[jj].w * w.z; acc[3][3] += hv[jj].w * w.w;
      }
    }
#pragma unroll
    for (int r = 0; r < 4; ++r) {
      const int t = t0 + r;
      const float dec = expf(-((float)t * (1.f / (float)(L - 1))) * delta);
      const float d0 = acc[r][0] * dec, d1 = acc[r][1] * dec, d2 = acc[r][2] * dec, d3 = acc[r][3] * dec;
      ss0 += d0 * d0 + d1 * d1;
      ss1 += d2 * d2 + d3 * d3;
      if (NSEQ >= 2) {
        bufF[swzF(t)] = d0; bufF[2 * L + swzF(t)] = d2;
        if (t >= 1) { bufF[swzF(2 * L - t)] = d1; bufF[2 * L + swzF(2 * L - t)] = d3; } else { bufF[swzF(L)] = 0.f; bufF[2 * L + swzF(L)] = 0.f; }
      } else {
        bufF[swzF(t)] = d0; G1tmp[t] = d2;
        if (t >= 1) { bufF[swzF(2 * L - t)] = d1; G1tmp[2 * L - t] = d3; } else { bufF[swzF(L)] = 0.f; G1tmp[L] = 0.f; }
      }
    }
  }
  ss0 = wsum(ss0); ss1 = wsum(ss1);
  if ((tid & 63) == 0) { red[tid >> 6] = ss0; red[8 + (tid >> 6)] = ss1; }
  __syncthreads();
  float tot0 = 0.f, tot1 = 0.f;
#pragma unroll
  for (int w = 0; w < 8; ++w) { tot0 += red[w]; tot1 += red[8 + w]; }
  const float sc0 = rsqrtf(tot0) * (1.f / (float)Lc), sc1 = rsqrtf(tot1) * (1.f / (float)Lc);
  if (NSEQ >= 2) {
    fft_dif<LOGN, 2>(buf);
    spectrum_extract<LOGN, 2>(buf, GS, GS1, sc0, sc1);
  } else {
    fft_dif<LOGN, 1>(buf);
    spectrum_extract<LOGN, 1>(buf, GS, GS, sc0, sc0);
    __syncthreads();
    for (int t = tid; t < L; t += NT) buf[swz(t)] = ((const float2*)G1tmp)[t];
    __syncthreads();
    fft_dif<LOGN, 1>(buf);
    spectrum_extract<LOGN, 1>(buf, GS1, GS1, sc1, sc1);
  }
  __threadfence_block();
  __syncthreads();
  const float* sw = p.in[I_HSW] + (size_t)i * 3 * 3072;
  const float* sbias = p.in[I_HSB] + (size_t)i * 3072;
  float cw[3][3], cb[3];
#pragma unroll
  for (int st = 0; st < 3; ++st) {
#pragma unroll
    for (int k = 0; k < 3; ++k) cw[st][k] = sw[k * 3072 + st * 1024 + c];
    cb[st] = sbias[st * 1024 + c];
  }
  const float fb0 = p.in[I_FBIAS][((size_t)i * 2 + 0) * 1024 + c], fb1 = p.in[I_FBIAS][((size_t)i * 2 + 1) * 1024 + c];
  auto conv8 = [&](const ushort_t* sp, int st, int t0, float* y) {
    const uint4 v = *(const uint4*)(sp + t0);
    const float xm = t0 > 0 ? bf2f(sp[t0 - 1]) : 0.f, xn = t0 + 8 < L ? bf2f(sp[t0 + 8]) : 0.f;
    const float x[10] = {xm, __uint_as_float(v.x << 16), __uint_as_float(v.x & 0xffff0000u), __uint_as_float(v.y << 16), __uint_as_float(v.y & 0xffff0000u),
                         __uint_as_float(v.z << 16), __uint_as_float(v.z & 0xffff0000u), __uint_as_float(v.w << 16), __uint_as_float(v.w & 0xffff0000u), xn};
#pragma unroll
    for (int j = 0; j < 8; ++j) y[j] = cw[st][0] * x[j] + cw[st][1] * x[j + 1] + cw[st][2] * x[j + 2] + cb[st];
  };
  for (int b0 = 0; b0 < NB; b0 += NSEQ) {
    __syncthreads();
    for (int w = tid; w < NSEQ * (L / 8); w += NT) {
      const int sq = w >> LOG8, t0 = (w & (L / 8 - 1)) * 8;
      const int s0 = (LOGN == 14) ? (TPROMPT + (b0 + sq) * 16384) : ((b0 + sq) * 4096);
      const ushort_t* pv = PH + (size_t)s0 * 1024 + (size_t)c * L;
      float y[8]; conv8(pv, 0, t0, y);
#pragma unroll
      for (int j = 0; j < 4; ++j) { buf[sq * Lc + swz((t0 >> 1) + j)] = float2{y[2 * j], y[2 * j + 1]}; buf[sq * Lc + swz(L / 2 + (t0 >> 1) + j)] = float2{0.f, 0.f}; }
    }
    __syncthreads();
    fft_dif<LOGN, NSEQ>(buf);
    spectrum_mul<LOGN, NSEQ>(buf, GS);
    __syncthreads();
    fft_dit_inv<LOGN, NSEQ>(buf);
    for (int w = tid; w < NSEQ * (L / 8); w += NT) {
      const int sq = w >> LOG8, t0 = (w & (L / 8 - 1)) * 8;
      const int s0 = (LOGN == 14) ? (TPROMPT + (b0 + sq) * 16384) : ((b0 + sq) * 4096);
      const ushort_t* pv = PH + (size_t)s0 * 1024 + (size_t)c * L;
      const ushort_t* px1 = pv + (size_t)T * 1024;
      float z0[8], xa[8]; conv8(pv, 0, t0, z0); conv8(px1, 1, t0, xa);
      float z1[8];
#pragma unroll
      for (int j = 0; j < 4; ++j) {
        const int e = sq * Lc + swz((t0 >> 1) + j);
        const float2 zc = buf[e];
        z1[2 * j] = xa[2 * j] * (zc.x + z0[2 * j] * fb0); z1[2 * j + 1] = xa[2 * j + 1] * (zc.y + z0[2 * j + 1] * fb0);
        buf[e] = float2{z1[2 * j], z1[2 * j + 1]};
        buf[sq * Lc + swz(L / 2 + (t0 >> 1) + j)] = float2{0.f, 0.f};
      }
      *(float4*)(Z1 + sq * L + t0) = float4{z1[0], z1[1], z1[2], z1[3]};
      *(float4*)(Z1 + sq * L + t0 + 4) = float4{z1[4], z1[5], z1[6], z1[7]};
    }
    __syncthreads();
    fft_dif<LOGN, NSEQ>(buf);
    spectrum_mul<LOGN, NSEQ>(buf, GS1);
    __syncthreads();
    fft_dit_inv<LOGN, NSEQ>(buf);
    for (int w = tid; w < NSEQ * (L / 8); w += NT) {
      const int sq = w >> LOG8, t0 = (w & (L / 8 - 1)) * 8;
      const int s0 = (LOGN == 14) ? (TPROMPT + (b0 + sq) * 16384) : ((b0 + sq) * 4096);
      const ushort_t* px2 = PH + (size_t)s0 * 1024 + (size_t)c * L + (size_t)2 * T * 1024;
      ushort_t* pg = (ushort_t*)px2 + (size_t)T * 1024;
      float xb[8]; conv8(px2, 2, t0, xb);
      const float4 za = *(const float4*)(Z1 + sq * L + t0), zb = *(const float4*)(Z1 + sq * L + t0 + 4);
      const float z1[8] = {za.x, za.y, za.z, za.w, zb.x, zb.y, zb.z, zb.w};
      const uint4 gv = *(const uint4*)(pg + t0);
      const unsigned gw[4] = {gv.x, gv.y, gv.z, gv.w};
      unsigned o[4];
#pragma unroll
      for (int j = 0; j < 4; ++j) {
        const float2 zc = buf[sq * Lc + swz((t0 >> 1) + j)];
        const float g0 = __uint_as_float(gw[j] << 16), g1 = __uint_as_float(gw[j] & 0xffff0000u);
        const float y0 = xb[2 * j] * (zc.x + z1[2 * j] * fb1) * (g0 * fast_sigmoid(g0));
        const float y1 = xb[2 * j + 1] * (zc.y + z1[2 * j + 1] * fb1) * (g1 * fast_sigmoid(g1));
        o[j] = pack2(y0, y1);
      }
      if (!dry) *(uint4*)(pg + t0) = uint4{o[0], o[1], o[2], o[3]};
    }
  }
}

__device__ void hy_conv_phase(const Params& p, int i, unsigned char* lds, bool dry = false) {
  for (int it = bidx(); it < 2048; it += gridDim.x) {
    if (it < 1024) hy_conv_item<14>(p, i, it, lds, dry);
    else hy_conv_item<12>(p, i, it - 1024, lds, dry);
    __syncthreads();
  }
}

__device__ void prep_even(const Params& p, int i, unsigned char* lds) {
  ushort_t* WB = (ushort_t*)(p.ws + OFF_WB);
  ushort_t* WinT = WB; ushort_t* WoutT = WB + 3328 * 1024; ushort_t* GluT = WoutT + 1024 * 1024;
  transpose_bf16(p.in[I_EWIN] + (size_t)i * 1024 * 3136, WinT, 1024, 3136, lds);
  zero_fill(WinT + 3136 * 1024, 192 * 1024);
  transpose_bf16(p.in[I_EWOUT] + (size_t)i * 1024 * 1024, WoutT, 1024, 1024, lds);
  transpose_bf16(p.in[I_GLUW] + (size_t)i * 512 * 512, GluT, 512, 512, lds);
}
__device__ void prep_odd(const Params& p, int i, unsigned char* lds) {
  ushort_t* WB = (ushort_t*)(p.ws + OFF_WB);
  transpose_bf16(p.in[I_HWIN] + (size_t)i * 1024 * 4096, WB, 1024, 4096, lds);
  transpose_bf16(p.in[I_HWOUT] + (size_t)i * 1024 * 1024, WB + 4096 * 1024, 1024, 1024, lds);
  hy_filter_mlp(p, i);
}
#ifndef PROBE_MASK
#define PROBE_MASK 0
#endif
#ifndef PH_MASK
#define PH_MASK 0x1ffff
#endif
#define PHM(n) ((PH_MASK >> (n)) & 1)
DEVI void run_phase(const Params& p, int ph, unsigned char* lds, bool dry = false) {
  const int layer = ph < NPH_EVEN ? 0 : ph < NPH_EVEN + NPH_ODD ? 1 : ph < 2 * NPH_EVEN + NPH_ODD ? 2 : 3;
  const int base = layer == 0 ? 0 : layer == 1 ? NPH_EVEN : layer == 2 ? NPH_EVEN + NPH_ODD : 2 * NPH_EVEN + NPH_ODD;
  const int sp = ph - base, i = layer >> 1;
  unsigned char* ws = p.ws;
  ushort_t* WB = (ushort_t*)(ws + OFF_WB);
  if ((layer & 1) == 0) {
    ushort_t* WinT = WB; ushort_t* WoutT = WB + 3328 * 1024; ushort_t* GluT = WoutT + 1024 * 1024;
    switch (sp) {
      case 0: if (PHM(0)) {
        prep_even(p, 0, lds);
        xb_convert(p, (ushort_t*)(ws + OFF_Y));
        } break;
      case 1: if (PHM(1)) run_gemm(lds, (const ushort_t*)(ws + OFF_Y), 1024, WinT, 3328, 1024, pg8::EpiEvenIn{(ushort_t*)(ws + OFF_PS5), (ushort_t*)(ws + OFF_PRW)}); break;
      case 2: if (PHM(2)) s5_passA(p, i, lds); break;
      case 3: if (PHM(3)) s5_passC(p, i, lds); break;
      case 4: if (PHM(4)) run_gemm(lds, (const ushort_t*)(ws + OFF_Y) + 512, 1024, GluT, 512, 512, pg8::EpiGlu{(ushort_t*)(ws + OFF_Y), (const ushort_t*)(ws + OFF_PS5), p.in[I_GLUB] + i * 512}); break;
      case 5: if (PHM(5)) rwkv_scan1(p, i, lds); break;
      case 6: if (PHM(6)) rwkv_carry(p, lds, dry); break;
      case 7: if (PHM(7)) rwkv_scan3(p, i, lds, dry); break;
      case 8: if (PHM(8)) rwkv_post(p, i); break;
      case 9: if (PHM(9)) run_gemm(lds, (const ushort_t*)(ws + OFF_Y), 1024, WoutT, 1024, 1024, pg8::EpiF16{(ushort_t*)(ws + OFF_PRW)}); break;
      case 10: if (PHM(10)) { if (!dry) prep_odd(p, i, lds); ln_phase(p, layer, (const ushort_t*)(ws + OFF_PRW), (ushort_t*)(ws + OFF_XB_ODD), dry); } break;
    }
  } else {
    ushort_t* HinT = WB; ushort_t* HoutT = WB + 4096 * 1024;
    switch (sp) {
      case 0: break;
      case 1: if (PHM(12)) run_gemm(lds, (const ushort_t*)(ws + OFF_XB_ODD), 1024, HinT, 4096, 1024, pg8::EpiHyIn{(ushort_t*)(ws + OFF_PH)}); break;
      case 2: if (PHM(13)) hy_conv_phase(p, i, lds, dry); break;
      case 3: if (PHM(14)) hy_transpose((const ushort_t*)(ws + OFF_PH + 3 * SZ1), (ushort_t*)(ws + OFF_PH), lds); break;
      case 4: if (PHM(15)) run_gemm(lds, (const ushort_t*)(ws + OFF_PH), 1024, HoutT, 1024, 1024, pg8::EpiF16{(ushort_t*)(ws + OFF_PH + SZ1)}); break;
      case 5: if (PHM(16)) { if (!dry && layer < 3) prep_even(p, i + 1, lds); ln_phase(p, layer, (const ushort_t*)(ws + OFF_PH + SZ1), layer < 3 ? (ushort_t*)(ws + OFF_Y) : (ushort_t*)nullptr, dry); } break;
    }
  }
}

#define LAS __attribute__((address_space(3)))
#define XB_TMO      128
#define XB_XCNT(j)  (256  + 64 * (j))
#define XB_XSUB(j)  (1280 + 64 * (j))
#define XB_XGEN(j)  (2304 + 64 * (j))
#define XB_TOP      3328
#define XB_TOPGEN   3392
#define XCD_BAR_WORDS 3456
#define XB_SPIN_CAP (1u << 18)
#define LAS __attribute__((address_space(3)))

__device__ __forceinline__ unsigned xb_ld(unsigned* p)              { return __hip_atomic_load(p, __ATOMIC_RELAXED, __HIP_MEMORY_SCOPE_AGENT); }
__device__ __forceinline__ unsigned xb_add(unsigned* p, unsigned v) { return __hip_atomic_fetch_add(p, v, __ATOMIC_RELAXED, __HIP_MEMORY_SCOPE_AGENT); }
__device__ __forceinline__ unsigned xb_xcc_id() { return (unsigned)__builtin_amdgcn_s_getreg((3 << 11) | 20) & 0xFu; }
#define XB_SPIN(cond, bar) do { unsigned _sp = 0; while (cond) { __builtin_amdgcn_s_sleep(1); \
    if ((++_sp & 255u) == 0u) { if (xb_ld(&(bar)[XB_TMO])) break; if (_sp > XB_SPIN_CAP) { atomicAdd(&(bar)[XB_TMO], 1u); break; } } } } while (0)

struct XcdBarrier {
    unsigned* bar; unsigned x;
    volatile LAS unsigned* st;
};

__device__ __forceinline__ XcdBarrier xcd_barrier_post(unsigned* bar, volatile LAS unsigned* st) {
    XcdBarrier b; b.bar = bar; b.x = xb_xcc_id(); b.st = st;
    if (threadIdx.x == 0) (void)xb_add(&bar[XB_XCNT(b.x)], 1u);
    return b;
}
__device__ __forceinline__ void xcd_barrier_complete(unsigned* bar, unsigned x, unsigned& nloc, unsigned& nx) {
    const unsigned G = gridDim.x * gridDim.y * gridDim.z;
    unsigned sum, cnt, mine, sp = 0u;
    for (;;) {
        sum = 0u; cnt = 0u; mine = 0u;
#pragma unroll
        for (unsigned j = 0; j < 16; ++j) { const unsigned c = xb_ld(&bar[XB_XCNT(j)]); sum += c; cnt += (c > 0u) ? 1u : 0u; mine = (j == x) ? c : mine; }
        if (sum == G) break;
        __builtin_amdgcn_s_sleep(1);
        if ((++sp & 255u) == 0u) { if (xb_ld(&bar[XB_TMO])) break; if (sp > XB_SPIN_CAP) { atomicAdd(&bar[XB_TMO], 1u); break; } }
    }
    nloc = mine > 0u ? mine : 1u; nx = cnt > 0u ? cnt : 1u;
}

__device__ __forceinline__ void xcd_barrier(const XcdBarrier& b) {
    asm volatile("s_waitcnt vmcnt(0)" ::: "memory");
    __syncthreads();
    if (threadIdx.x == 0) {
        unsigned* bar = b.bar;
        __builtin_amdgcn_s_waitcnt(0);
        unsigned nloc = b.st[0], nx = b.st[1];
        if (nloc == 0u) { xcd_barrier_complete(bar, b.x, nloc, nx); b.st[0] = nloc; b.st[1] = nx; }
        const unsigned old = xb_add(&bar[XB_XSUB(b.x)], 1u);
        const unsigned gen = old / nloc;
        if (old + 1u == (gen + 1u) * nloc) {
            __builtin_amdgcn_fence(__ATOMIC_RELEASE, "agent");
            asm volatile("s_waitcnt vmcnt(0)" ::: "memory");
            const unsigned og = xb_add(&bar[XB_TOP], 1u);
            const unsigned tg = og / nx;
            if (og + 1u == (tg + 1u) * nx) xb_add(&bar[XB_TOPGEN], 1u);
            else XB_SPIN(xb_ld(&bar[XB_TOPGEN]) == tg, bar);
            __builtin_amdgcn_fence(__ATOMIC_ACQUIRE, "agent");
            xb_add(&bar[XB_XGEN(b.x)], 1u);
            asm volatile("s_waitcnt vmcnt(0)" ::: "memory");
        } else {
            XB_SPIN(xb_ld(&bar[XB_XGEN(b.x)]) == gen, bar);
            __builtin_amdgcn_fence(__ATOMIC_ACQUIRE, "agent");
            asm volatile("s_waitcnt vmcnt(0)" ::: "memory");
        }
    }
    __syncthreads();
}


#if ONE_LAUNCH
__global__ void __launch_bounds__(NT) fwd_kernel(Params p) {
  extern __shared__ __attribute__((aligned(16))) unsigned char lds[];
#if ONE_LAUNCH
  cg::grid_group grid = cg::this_grid();
#endif
#if ONE_LAUNCH
  volatile LAS unsigned* xb_st = (volatile LAS unsigned*)(lds + LDS_BYTES - 16);
  if (threadIdx.x < 2) xb_st[threadIdx.x] = 0u;
  __syncthreads();
  const XcdBarrier xb = xcd_barrier_post((unsigned*)(p.ws + OFF_BAR), xb_st);
#endif
  for (int ph = p.ph_lo; ph < p.ph_hi; ++ph) {
    if (ph == NPH_EVEN || ph == NPH_EVEN + NPH_ODD || ph == 2 * NPH_EVEN + NPH_ODD) continue;
    int reps = 1;
#if PROBE_MASK
    {
      const int lyr = ph < NPH_EVEN ? 0 : ph < NPH_EVEN + NPH_ODD ? 1 : ph < 2 * NPH_EVEN + NPH_ODD ? 2 : 3;
      const int bs = lyr == 0 ? 0 : lyr == 1 ? NPH_EVEN : lyr == 2 ? NPH_EVEN + NPH_ODD : 2 * NPH_EVEN + NPH_ODD;
      const int idx = (lyr & 1) ? NPH_EVEN + (ph - bs) : (ph - bs);
      if ((PROBE_MASK >> idx) & 1) reps = 2;
    }
#endif
    for (int rep = 0; rep < reps; ++rep) {
      run_phase(p, ph, lds, rep + 1 < reps);
#if ONE_LAUNCH
      if (ph + 1 < p.ph_hi || rep + 1 < reps) { if (ph == p.ph_lo && rep == 0) grid.sync(); else xcd_barrier(xb); }
#endif
    }
  }
}
#endif

#if !ONE_LAUNCH
template <int PH> __global__ void __launch_bounds__(NT) phase_kernel(Params p) {
  extern __shared__ __attribute__((aligned(16))) unsigned char lds[];
  run_phase(p, PH, lds);
}
typedef void (*kfn_t)(Params);
#define PK(n) phase_kernel<n>
static kfn_t k_tab[NPHASES] = {PK(0), PK(1), PK(2), PK(3), PK(4), PK(5), PK(6), PK(7), PK(8), PK(9), PK(10), PK(11), PK(12), PK(13), PK(14), PK(15),
                               PK(16), PK(17), PK(18), PK(19), PK(20), PK(21), PK(22), PK(23), PK(24), PK(25), PK(26), PK(27), PK(28), PK(29), PK(30), PK(31), PK(32), PK(33)};
#endif

extern "C" void kernel_launch(void* const* d_in, const int* in_sizes, int n_in, void* d_out, int out_size, void* d_ws, size_t ws_size,
                              hipStream_t stream) {
  static int grid_blocks = 0;
  if (!grid_blocks) {
    if (n_in != 38 || ws_size < WS_NEED || out_size != T * 1024) {
      fprintf(stderr, "kernel_launch: unexpected shapes n_in=%d ws=%zu out=%d\n", n_in, ws_size, out_size);
      grid_blocks = -1; return;
    }
    int dev = 0, cus = 0, per_cu = 0;
    (void)hipGetDevice(&dev);
    (void)hipDeviceGetAttribute(&cus, hipDeviceAttributeMultiprocessorCount, dev);
#if ONE_LAUNCH
    if (hipFuncSetAttribute((const void*)fwd_kernel, hipFuncAttributeMaxDynamicSharedMemorySize, LDS_BYTES) != hipSuccess) {
      fprintf(stderr, "kernel_launch: hipFuncSetAttribute failed\n"); grid_blocks = -1; return;
    }
    (void)hipOccupancyMaxActiveBlocksPerMultiprocessor(&per_cu, (const void*)fwd_kernel, NT, LDS_BYTES);
#else
    for (int ph = 0; ph < NPHASES; ++ph)
      if (hipFuncSetAttribute((const void*)k_tab[ph], hipFuncAttributeMaxDynamicSharedMemorySize, LDS_BYTES) != hipSuccess) {
        fprintf(stderr, "kernel_launch: hipFuncSetAttribute failed\n"); grid_blocks = -1; return;
      }
    per_cu = 1;
#endif
    if (per_cu < 1) { fprintf(stderr, "kernel_launch: occupancy query returned %d\n", per_cu); per_cu = 1; }
    grid_blocks = cus * per_cu;
    if (grid_blocks > 256) grid_blocks = 256;
    if (grid_blocks < 1) grid_blocks = 256;
  }
  if (grid_blocks < 0) return;
  Params p{};
  for (int k = 0; k < 38; ++k) p.in[k] = (const float*)d_in[k];
  p.out = (float*)d_out; p.ws = (unsigned char*)d_ws;
#if ONE_LAUNCH
  if (hipMemsetAsync((unsigned char*)d_ws + OFF_BAR, 0, 16384, stream) != hipSuccess) { fprintf(stderr, "kernel_launch: memset of barrier words failed\n"); return; }
  p.ph_lo = 0; p.ph_hi = NPHASES;
  void* args[] = {&p};
  hipError_t e = hipLaunchCooperativeKernel((const void*)fwd_kernel, dim3(grid_blocks), dim3(NT), args, LDS_BYTES, stream);
  if (e != hipSuccess) fprintf(stderr, "cooperative launch failed: %s (grid %d)\n", hipGetErrorString(e), grid_blocks);
#else
  for (int ph = 0; ph < NPHASES; ++ph) {
    p.ph_lo = ph; p.ph_hi = ph + 1;
    hipLaunchKernelGGL(k_tab[ph], dim3(grid_blocks), dim3(NT), LDS_BYTES, stream, p);
  }
#endif
}
```

```cpp
#include <hip/hip_runtime.h>
#include <hip/hip_cooperative_groups.h>
#include <cstdio>
#include <cstdint>
namespace cg = cooperative_groups;

#ifndef ONE_LAUNCH
#define ONE_LAUNCH 1
#endif

#define DEVI __device__ __forceinline__
constexpr int NT = 512;
constexpr int T = 49152;
constexpr int TPROMPT = 16384;
constexpr int LDS_BYTES = 133120;
constexpr int NPH_EVEN = 11, NPH_ODD = 6;
constexpr int NPHASES = 2 * (NPH_EVEN + NPH_ODD);

typedef __attribute__((ext_vector_type(8))) short bf16x8;
typedef __attribute__((ext_vector_type(4))) float f32x4;
typedef unsigned short ushort_t;
typedef float f32x2 __attribute__((ext_vector_type(2)));

struct Params { const float* in[38]; float* out; unsigned char* ws; int ph_lo; int ph_hi; };

enum { I_XP = 0, I_XS, I_EWIN, I_EWOUT, I_LRE, I_LIM, I_LSTEP, I_BRE, I_BIM, I_CRE, I_CIM, I_S5D, I_GLUW, I_GLUB,
       I_MURKV, I_MULORA, I_W0, I_WUP, I_A0, I_AUP, I_KK, I_KA, I_RK, I_LNXW, I_LNXB,
       I_HWIN, I_HWOUT, I_HSW, I_HSB, I_FW1, I_FB1, I_FFREQ, I_FW2, I_FB2, I_FW3, I_FBIAS, I_LNG, I_LNB };

constexpr size_t SZ1 = (size_t)T * 1024 * 2;
constexpr size_t OFF_PS5 = 0;
constexpr size_t OFF_PRW = OFF_PS5 + SZ1;
constexpr size_t OFF_Y = OFF_PRW + (size_t)T * 2112 * 2;
constexpr size_t OFF_YS = OFF_Y + SZ1;
constexpr size_t OFF_WB = OFF_YS + SZ1;
constexpr size_t OFF_CAR = OFF_WB + 10485760;
constexpr size_t OFF_BAR = OFF_CAR + 6291456;
constexpr size_t WS_NEED = OFF_BAR + 16384;
constexpr size_t OFF_PH = 0;
constexpr size_t OFF_GS = 4 * SZ1;
constexpr size_t GS_PER = 131328;
constexpr size_t OFF_Z1 = OFF_GS + 256 * 2 * GS_PER;
constexpr size_t OFF_XB_ODD = 4 * SZ1;
constexpr size_t OFF_H2 = OFF_XB_ODD + SZ1;

DEVI int tidx() { int t = threadIdx.x; asm volatile("" : "+v"(t)); return t; }
DEVI int bidx() { int b = blockIdx.x; asm volatile("" : "+r"(b)); return __builtin_amdgcn_readfirstlane(b); }
DEVI ushort_t f2bf(float f) { unsigned u = __float_as_uint(f); u += 0x7fffu + ((u >> 16) & 1u); return (ushort_t)(u >> 16); }
DEVI float bf2f(ushort_t h) { return __uint_as_float(((unsigned)h) << 16); }
DEVI unsigned pack2(float a, float b) { return (unsigned)f2bf(a) | ((unsigned)f2bf(b) << 16); }
DEVI float wsum(float v) {
#pragma unroll
  for (int m = 32; m >= 1; m >>= 1) v += __shfl_xor(v, m);
  return v;
}
DEVI void wave_sync() { __builtin_amdgcn_fence(__ATOMIC_RELEASE, "wavefront"); __builtin_amdgcn_wave_barrier(); __builtin_amdgcn_fence(__ATOMIC_ACQUIRE, "wavefront"); }
DEVI void wave_sync_lds() { asm volatile("" ::: "memory"); __builtin_amdgcn_wave_barrier(); asm volatile("" ::: "memory"); }
DEVI void block_sync_lds() { asm volatile("s_waitcnt lgkmcnt(0)" ::: "memory"); __builtin_amdgcn_s_barrier(); asm volatile("" ::: "memory"); }
DEVI void seq_of(int tok, int& s0, int& L) {
  if (tok < TPROMPT) { s0 = tok & ~4095; L = 4096; } else { s0 = TPROMPT + ((tok - TPROMPT) & ~16383); L = 16384; }
}
struct XSrc { const float* xp; const float* xs; const float* xo; };
DEVI XSrc xsrc(const Params& p) {
  XSrc x; x.xp = p.in[I_XP]; x.xs = p.in[I_XS]; x.xo = p.out;
  asm volatile("" : "+r"(x.xp), "+r"(x.xs), "+r"(x.xo));
  return x;
}
DEVI const float* xrow(const XSrc& x, int layer, int tok) {
  if (layer == 0) return tok < TPROMPT ? x.xp + (size_t)tok * 1024 : x.xs + (size_t)(tok - TPROMPT) * 1024;
  return x.xo + (size_t)tok * 1024;
}
DEVI float sigmoidf_(float x) { return 1.f / (1.f + expf(-x)); }
DEVI float fast_sigmoid(float x) { return __builtin_amdgcn_rcpf(1.f + __builtin_amdgcn_exp2f(-1.4426950408889634f * x)); }
DEVI float fast_tanh(float x) { return 1.f - 2.f * __builtin_amdgcn_rcpf(1.f + __builtin_amdgcn_exp2f(2.8853900817779268f * x)); }
DEVI float dpp_mov_f(float x, const int sel) {
  int xi = __builtin_bit_cast(int, x), r;
  if (sel == 0) r = __builtin_amdgcn_mov_dpp(xi, 0xB1, 0xf, 0xf, true);
  else if (sel == 1) r = __builtin_amdgcn_mov_dpp(xi, 0x4E, 0xf, 0xf, true);
  else if (sel == 2) r = __builtin_amdgcn_mov_dpp(xi, 0x141, 0xf, 0xf, true);
  else r = __builtin_amdgcn_mov_dpp(xi, 0x140, 0xf, 0xf, true);
  return __builtin_bit_cast(float, r);
}
DEVI float wsum_fast(float v) {
  v += dpp_mov_f(v, 0); v += dpp_mov_f(v, 1); v += dpp_mov_f(v, 2); v += dpp_mov_f(v, 3);
  const int vi = __builtin_bit_cast(int, v);
  return __builtin_bit_cast(float, __builtin_amdgcn_readlane(vi, 0)) + __builtin_bit_cast(float, __builtin_amdgcn_readlane(vi, 16)) +
         __builtin_bit_cast(float, __builtin_amdgcn_readlane(vi, 32)) + __builtin_bit_cast(float, __builtin_amdgcn_readlane(vi, 48));
}
DEVI float gelu_tanh(float x) { return 0.5f * x * (1.f + tanhf(0.7978845608f * (x + 0.044715f * x * x * x))); }

__device__ void transpose_bf16(const float* __restrict__ in, ushort_t* __restrict__ out, int K, int N, unsigned char* lds) {
  float* tile = (float*)lds;
  const int tid = tidx(), j = tid & 63, i0 = tid >> 6;
  const int tk = K / 64, tn = N / 64;
  for (int t = bidx(); t < tk * tn; t += gridDim.x) {
    const int k0 = (t / tn) * 64, n0 = (t % tn) * 64;
#pragma unroll
    for (int e = 0; e < 8; ++e) { int i = i0 + 8 * e; tile[i * 65 + j] = in[(size_t)(k0 + i) * N + n0 + j]; }
    __syncthreads();
#pragma unroll
    for (int e = 0; e < 8; ++e) { int i = i0 + 8 * e; out[(size_t)(n0 + i) * K + k0 + j] = f2bf(tile[j * 65 + i]); }
    __syncthreads();
  }
}

namespace pg8 {
#define PG8_LAS __attribute__((address_space(3)))
typedef unsigned u32x4 __attribute__((ext_vector_type(4)));
constexpr int BM = 256, BK = 64, HALF = 128, HTB = HALF * BK * 2, STAGE_BYTES = 8 * HTB, NXCD = 8, WGM = 8;
DEVI int lds_byte(int r, int c) { const int st = (r >> 4) * 2 + (c >> 5), rr = r & 15, cc = c & 31, ob = rr * 64 + cc * 2; return st * 1024 + (ob ^ (((ob >> 9) & 1) << 5)); }
DEVI void stage_rc(int b, int& R, int& C) { const int st = b / 1024, sb = b % 1024, swz = sb ^ (((sb >> 9) & 1) << 5); R = (st >> 1) * 16 + swz / 64; C = (st & 1) * 32 + (swz % 64) / 2; }
DEVI int perm32(int rho) { const int n = rho >> 4, i = rho & 15; return 8 * (i >> 2) + 4 * n + (i & 3); }
struct Unit { int pm, pn; };
struct Gemm { const ushort_t* A; const ushort_t* Bt; int M, N, K, lda; };
struct StaticOrder {
  int nM, nN, nwg, G, c;
  DEVI void init(int M, int N, int G_, int c_) { nM = M / BM; nN = N / BM; nwg = nM * nN; G = G_; c = c_; }
  DEVI bool next(int i, Unit& u) const {
    const long L = (long)i * G + c; if (L >= nwg) return false;
    int wgid = (int)L; { const int q = nwg / NXCD, r = nwg % NXCD, xcd = wgid % NXCD, off = wgid / NXCD; wgid = (xcd < r ? xcd * (q + 1) : r * (q + 1) + (xcd - r) * q) + off; }
    const int nig = WGM * nN, gid = wgid / nig, fm = gid * WGM, gsz = (nM - fm) < WGM ? (nM - fm) : WGM;
    u.pm = fm + ((wgid % nig) % gsz); u.pn = (wgid % nig) / gsz; return true;
  }
};
DEVI unsigned cvt_pk_bf16(float lo, float hi) { unsigned r; asm volatile("v_cvt_pk_bf16_f32 %0, %1, %2" : "=v"(r) : "v"(lo), "v"(hi)); return r; }

template <class Epi>
DEVI void gemm_phase(PG8_LAS unsigned char* lds, const Gemm g, const StaticOrder& S, const Epi& E) {
  const int tid = tidx(), wid = __builtin_amdgcn_readfirstlane(tid >> 6), lane = tid & 63, wr = wid >> 2, wc = wid & 3, fr = lane & 15, fq = lane >> 4;
  const int K = g.K, nt = K / BK, lda = g.lda;
  unsigned voffA[2], voffB[2];
#pragma unroll
  for (int i = 0; i < 2; ++i) { int R, C; stage_rc(tid * 16 + i * 8192, R, C); const int Rb = Epi::PERM ? ((R & ~31) + perm32(R & 31)) : R;
    voffA[i] = (unsigned)(R * lda + C) * 2u; voffB[i] = (unsigned)(Rb * K + C) * 2u; }
  const size_t kstep = (size_t)(BK * 2);
  const size_t hstepA = (size_t)HALF * lda * 2, hstepB = (size_t)HALF * K * 2;
  const size_t tstepA = 2 * hstepA, tstepB = 2 * hstepB;
  const unsigned ldsw = (unsigned)wid * 1024u;
  const int aoff = lds_byte(wr * 64 + fr, fq * 8), boff = lds_byte(wc * 32 + fr, fq * 8);
#define PG8_SA(b, h) (((b) * 2 + (h)) * HTB)
#define PG8_SB(b, h) ((4 + (b) * 2 + (h)) * HTB)
#define PG8_STAGE(bufoff, gbase, voff) do { _Pragma("unroll") for (int _i = 0; _i < 2; ++_i) \
    __builtin_amdgcn_global_load_lds((const unsigned*)((const char*)(gbase) + (voff)[_i]), (PG8_LAS unsigned*)(lds + (bufoff) + ldsw + _i * 8192), 16, 0, 0); } while (0)
#define PG8_LDA(dst, b, h) do { _Pragma("unroll") for (int m = 0; m < 4; ++m) _Pragma("unroll") for (int k = 0; k < 2; ++k) dst[m][k] = *(const PG8_LAS bf16x8*)(lds + PG8_SA(b, h) + aoff + m * 2048 + k * 1024); } while (0)
#define PG8_LDB(dst, b, h) do { _Pragma("unroll") for (int n = 0; n < 2; ++n) _Pragma("unroll") for (int k = 0; k < 2; ++k) dst[n][k] = *(const PG8_LAS bf16x8*)(lds + PG8_SB(b, h) + boff + n * 2048 + k * 1024); } while (0)
#define PG8_MMA(ai, bj, At, Bt) do { __builtin_amdgcn_s_setprio(1); _Pragma("unroll") for (int m = 0; m < 4; ++m) _Pragma("unroll") for (int n = 0; n < 2; ++n) _Pragma("unroll") for (int k = 0; k < 2; ++k) \
    acc[ai][bj][m][n] = Epi::TRANS ? __builtin_amdgcn_mfma_f32_16x16x32_bf16(Bt[n][k], At[m][k], acc[ai][bj][m][n], 0, 0, 0) \
                                   : __builtin_amdgcn_mfma_f32_16x16x32_bf16(At[m][k], Bt[n][k], acc[ai][bj][m][n], 0, 0, 0); __builtin_amdgcn_s_setprio(0); } while (0)
#define PG8_WAIT_V(n) asm volatile("s_waitcnt vmcnt(" #n ")" ::: "memory")
#define PG8_WAIT_L(n) asm volatile("s_waitcnt lgkmcnt(" #n ")" ::: "memory")
#define PG8_BAR __builtin_amdgcn_s_barrier()
#define PG8_SCHED __builtin_amdgcn_sched_barrier(0)
  Unit cur, nxt; int ui = 0;
  if (!S.next(0, cur)) return;
  f32x4 acc[2][2][4][2];
#pragma unroll
  for (int a = 0; a < 2; ++a)
#pragma unroll
    for (int b = 0; b < 2; ++b)
#pragma unroll
      for (int m = 0; m < 4; ++m)
#pragma unroll
        for (int n = 0; n < 2; ++n) acc[a][b][m][n] = (f32x4){0.f, 0.f, 0.f, 0.f};
  bf16x8 At[4][2], B0[2][2], B1[2][2];
  const char* cA = (const char*)g.A + (size_t)cur.pm * tstepA; const char* cB = (const char*)g.Bt + (size_t)cur.pn * tstepB;
  PG8_STAGE(PG8_SB(0, 0), cB, voffB); PG8_STAGE(PG8_SA(0, 0), cA, voffA); PG8_STAGE(PG8_SB(0, 1), cB + hstepB, voffB); PG8_STAGE(PG8_SA(0, 1), cA + hstepA, voffA);
  if (wr == 1) PG8_BAR;
  PG8_WAIT_V(4); PG8_BAR;
  PG8_STAGE(PG8_SB(1, 0), cB + kstep, voffB); PG8_STAGE(PG8_SA(1, 0), cA + kstep, voffA); PG8_STAGE(PG8_SB(1, 1), cB + hstepB + kstep, voffB);
  PG8_WAIT_V(6); PG8_BAR;
  for (;;) {
    const bool has_next = S.next(ui + 1, nxt);
    const char* nA = has_next ? (const char*)g.A + (size_t)nxt.pm * tstepA : cA; const char* nB = has_next ? (const char*)g.Bt + (size_t)nxt.pn * tstepB : cB;
    for (int t = 0; t < nt; t += 2) {
      const bool last = (t == nt - 2);
      const char* a1 = cA + (size_t)(t + 1) * kstep;
      const char* a2 = last ? nA : cA + (size_t)(t + 2) * kstep; const char* b2 = last ? nB : cB + (size_t)(t + 2) * kstep;
      const char* a3 = a2 + kstep; const char* b3 = b2 + kstep;
      PG8_LDB(B0, 0, 0); PG8_SCHED; PG8_LDA(At, 0, 0); PG8_STAGE(PG8_SA(1, 1), a1 + hstepA, voffA);
      PG8_WAIT_L(8); PG8_BAR; PG8_WAIT_L(0); PG8_MMA(0, 0, At, B0); PG8_BAR; PG8_SCHED;
      PG8_LDB(B1, 0, 1); PG8_STAGE(PG8_SB(0, 0), b2, voffB);
      PG8_BAR; PG8_WAIT_L(0); PG8_MMA(0, 1, At, B1); PG8_BAR;
      PG8_LDA(At, 0, 1); PG8_STAGE(PG8_SA(0, 0), a2, voffA);
      PG8_BAR; PG8_WAIT_L(0); PG8_MMA(1, 0, At, B0); PG8_BAR; PG8_SCHED;
      PG8_STAGE(PG8_SB(0, 1), b2 + hstepB, voffB);
      PG8_WAIT_V(6); PG8_BAR; PG8_MMA(1, 1, At, B1); PG8_BAR;
      PG8_LDB(B0, 1, 0); PG8_SCHED; PG8_LDA(At, 1, 0); PG8_STAGE(PG8_SA(0, 1), a2 + hstepA, voffA);
      PG8_WAIT_L(8); PG8_BAR; PG8_WAIT_L(0); PG8_MMA(0, 0, At, B0); PG8_BAR; PG8_SCHED;
      PG8_LDB(B1, 1, 1); PG8_STAGE(PG8_SB(1, 0), b3, voffB);
      PG8_BAR; PG8_WAIT_L(0); PG8_MMA(0, 1, At, B1); PG8_BAR;
      PG8_LDA(At, 1, 1); PG8_STAGE(PG8_SA(1, 0), a3, voffA);
      PG8_BAR; PG8_WAIT_L(0); PG8_MMA(1, 0, At, B0); PG8_BAR; PG8_SCHED;
      PG8_STAGE(PG8_SB(1, 1), b3 + hstepB, voffB);
      PG8_WAIT_V(6); PG8_BAR; PG8_MMA(1, 1, At, B1); PG8_BAR;
    }
    E(acc, cur, wr, wc, fr, fq);
    if (!has_next) break;
#pragma unroll
    for (int a = 0; a < 2; ++a)
#pragma unroll
      for (int b = 0; b < 2; ++b)
#pragma unroll
        for (int m = 0; m < 4; ++m)
#pragma unroll
          for (int n = 0; n < 2; ++n) acc[a][b][m][n] = (f32x4){0.f, 0.f, 0.f, 0.f};
    cur = nxt; cA = nA; cB = nB; ++ui;
  }
  PG8_WAIT_V(0);
  if (wr == 0) PG8_BAR;
  PG8_BAR;
#undef PG8_SA
#undef PG8_SB
#undef PG8_STAGE
#undef PG8_LDA
#undef PG8_LDB
#undef PG8_MMA
#undef PG8_WAIT_V
#undef PG8_WAIT_L
#undef PG8_BAR
#undef PG8_SCHED
}

struct EpiEvenIn {
  static constexpr bool PERM = true, TRANS = true;
  ushort_t* ps5; ushort_t* prw;
  DEVI void operator()(const f32x4 (&acc)[2][2][4][2], const Unit& u, int wr, int wc, int fr, int fq) const {
#pragma unroll
    for (int ai = 0; ai < 2; ++ai)
#pragma unroll
      for (int m = 0; m < 4; ++m) {
        const size_t row = (size_t)u.pm * BM + ai * HALF + wr * 64 + m * 16 + fr;
#pragma unroll
        for (int bj = 0; bj < 2; ++bj) {
          const int c0 = u.pn * BM + bj * HALF + wc * 32 + 8 * fq;
          const f32x4 v0 = acc[ai][bj][m][0], v1 = acc[ai][bj][m][1];
          u32x4 o = {cvt_pk_bf16(v0[0], v0[1]), cvt_pk_bf16(v0[2], v0[3]), cvt_pk_bf16(v1[0], v1[1]), cvt_pk_bf16(v1[2], v1[3])};
          if (c0 < 1024) *(u32x4*)(ps5 + row * 1024 + c0) = o;
          else if (c0 < 3136) *(u32x4*)(prw + row * 2112 + (c0 - 1024)) = o;
        }
      }
  }
};
struct EpiHyIn {
  static constexpr bool PERM = false, TRANS = false;
  ushort_t* ph;
  DEVI void operator()(const f32x4 (&acc)[2][2][4][2], const Unit& u, int wr, int wc, int fr, int fq) const {
    int s0, L; seq_of(u.pm * BM, s0, L);
#pragma unroll
    for (int ai = 0; ai < 2; ++ai)
#pragma unroll
      for (int m = 0; m < 4; ++m) {
        const int tok = u.pm * BM + ai * HALF + wr * 64 + m * 16 + 4 * fq;
#pragma unroll
        for (int bj = 0; bj < 2; ++bj)
#pragma unroll
          for (int n = 0; n < 2; ++n) {
            const int col = u.pn * BM + bj * HALF + wc * 32 + 16 * n + fr;
            const int st = col >> 10, c = col & 1023;
            const f32x4 v = acc[ai][bj][m][n];
            ushort_t* dst = ph + (size_t)st * T * 1024 + (size_t)s0 * 1024 + (size_t)c * L + (tok - s0);
            *(uint2*)dst = uint2{cvt_pk_bf16(v[0], v[1]), cvt_pk_bf16(v[2], v[3])};
          }
      }
  }
};
struct EpiGlu {
  static constexpr bool PERM = true, TRANS = true;
  ushort_t* y; const ushort_t* ps5; const float* bias;
  DEVI void operator()(const f32x4 (&acc)[2][2][4][2], const Unit& u, int wr, int wc, int fr, int fq) const {
#pragma unroll
    for (int ai = 0; ai < 2; ++ai)
#pragma unroll
      for (int m = 0; m < 4; ++m) {
        const size_t row = (size_t)u.pm * BM + ai * HALF + wr * 64 + m * 16 + fr;
#pragma unroll
        for (int bj = 0; bj < 2; ++bj) {
          const int c0 = u.pn * BM + bj * HALF + wc * 32 + 8 * fq;
          const u32x4 a8 = *(const u32x4*)(y + row * 1024 + 512 + c0);
          const u32x4 g8 = *(const u32x4*)(ps5 + row * 1024 + 512 + c0);
          const f32x4 b0 = *(const f32x4*)(bias + c0), b1 = *(const f32x4*)(bias + c0 + 4);
          float v[8];
#pragma unroll
          for (int e = 0; e < 4; ++e) { v[e] = acc[ai][bj][m][0][e] + b0[e]; v[4 + e] = acc[ai][bj][m][1][e] + b1[e]; }
          unsigned o[4];
#pragma unroll
          for (int e = 0; e < 4; ++e) {
            const float a_lo = __uint_as_float(a8[e] << 16), a_hi = __uint_as_float(a8[e] & 0xffff0000u);
            const float g_lo = __uint_as_float(g8[e] << 16), g_hi = __uint_as_float(g8[e] & 0xffff0000u);
            const float r_lo = a_lo * sigmoidf_(v[2 * e]) * (g_lo * sigmoidf_(g_lo));
            const float r_hi = a_hi * sigmoidf_(v[2 * e + 1]) * (g_hi * sigmoidf_(g_hi));
            o[e] = cvt_pk_bf16(r_lo, r_hi);
          }
          *(u32x4*)(y + row * 1024 + c0) = u32x4{o[0], o[1], o[2], o[3]};
        }
      }
  }
};
struct EpiF16 {
  static constexpr bool PERM = true, TRANS = true;
  ushort_t* C;
  DEVI void operator()(const f32x4 (&acc)[2][2][4][2], const Unit& u, int wr, int wc, int fr, int fq) const {
#pragma unroll
    for (int ai = 0; ai < 2; ++ai)
#pragma unroll
      for (int m = 0; m < 4; ++m) {
        ushort_t* rowp = C + ((size_t)u.pm * BM + ai * HALF + wr * 64 + m * 16 + fr) * 1024 + u.pn * BM + wc * 32 + 8 * fq;
#pragma unroll
        for (int bj = 0; bj < 2; ++bj) {
          const f32x4 v0 = acc[ai][bj][m][0], v1 = acc[ai][bj][m][1];
          *(u32x4*)(rowp + bj * HALF) = u32x4{cvt_pk_bf16(v0[0], v0[1]), cvt_pk_bf16(v0[2], v0[3]), cvt_pk_bf16(v1[0], v1[1]), cvt_pk_bf16(v1[2], v1[3])};
        }
      }
  }
};
}

template <class Epi>
DEVI void run_gemm(unsigned char* lds, const ushort_t* A, int lda, const ushort_t* Bt, int N, int K, const Epi& E) {
  pg8::Gemm g; g.A = A; g.Bt = Bt; g.M = T; g.N = N; g.K = K; g.lda = lda;
  pg8::StaticOrder S; S.init(T, N, (int)gridDim.x, bidx());
  __syncthreads();
  pg8::gemm_phase<Epi>((PG8_LAS unsigned char*)lds, g, S, E);
  __syncthreads();
}

__device__ void xb_convert(const Params& p, ushort_t* XB) {
  const size_t n4 = (size_t)T * 1024 / 4, np4 = (size_t)TPROMPT * 1024 / 4;
  const float4* xp = (const float4*)p.in[I_XP]; const float4* xs = (const float4*)p.in[I_XS];
  for (size_t e = (size_t)bidx() * NT + tidx(); e < n4; e += (size_t)gridDim.x * NT) {
    const float4 v = e < np4 ? xp[e] : xs[e - np4];
    ((uint2*)XB)[e] = uint2{pack2(v.x, v.y), pack2(v.z, v.w)};
  }
}
__device__ void zero_fill(ushort_t* dst, size_t n) {
  for (size_t e = (size_t)bidx() * NT + tidx(); e < n / 8; e += (size_t)gridDim.x * NT) ((uint4*)dst)[e] = uint4{0, 0, 0, 0};
}
DEVI uint4 hy_tr_load(const ushort_t* __restrict__ PH3, int t, int r, int c8) {
  const int tok0 = (t >> 4) * 64, c0 = (t & 15) * 64;
  int s0, L; seq_of(tok0, s0, L);
  return *(const uint4*)(PH3 + (size_t)s0 * 1024 + (size_t)(c0 + r) * L + (tok0 - s0) + c8);
}
__device__ void hy_transpose(const ushort_t* __restrict__ PH3, ushort_t* __restrict__ Y, unsigned char* lds) {
  ushort_t* tile = (ushort_t*)lds;
  const int tid = tidx(), r = tid >> 3, c8 = (tid & 7) * 8;
  const int nt = (T / 64) * 16, t_first = bidx();
  uint4 v = uint4{0, 0, 0, 0};
  if (t_first < nt) v = hy_tr_load(PH3, t_first, r, c8);
  for (int t = t_first; t < nt; t += gridDim.x) {
    const int tok0 = (t >> 4) * 64, c0 = (t & 15) * 64;
    block_sync_lds();
    *(uint4*)(tile + r * 72 + c8) = v;
    if (t + (int)gridDim.x < nt) v = hy_tr_load(PH3, t + gridDim.x, r, c8);
    block_sync_lds();
    unsigned o[4];
#pragma unroll
    for (int e = 0; e < 4; ++e) o[e] = (unsigned)tile[(c8 + 2 * e) * 72 + r] | ((unsigned)tile[(c8 + 2 * e + 1) * 72 + r] << 16);
    *(uint4*)(Y + (size_t)(tok0 + r) * 1024 + c0 + c8) = uint4{o[0], o[1], o[2], o[3]};
  }
}

struct LnIn { float4 x[2][4]; uint2 f[2][4]; };
DEVI void ln_load(const XSrc& xs_, int layer, const ushort_t* __restrict__ F, int row0, int lane, LnIn& o) {
#pragma unroll
  for (int h = 0; h < 2; ++h) {
    const int row = row0 + h * (T / 2);
    const float4* x4 = (const float4*)xrow(xs_, layer, row);
    const uint2* f2 = (const uint2*)(F + (size_t)row * 1024);
#pragma unroll
    for (int e = 0; e < 4; ++e) { o.x[h][e] = x4[lane + 64 * e]; o.f[h][e] = f2[lane + 64 * e]; }
  }
}
__device__ void ln_phase(const Params& p, int layer, const ushort_t* __restrict__ F, ushort_t* __restrict__ XB, bool dry = false) {
  const int lane = tidx() & 63, gw = bidx() * (NT / 64) + (tidx() >> 6), nw = gridDim.x * (NT / 64);
  const float alpha = 1.681792830507429f;
  const float4* g4 = (const float4*)(p.in[I_LNG] + layer * 1024);
  const float4* b4 = (const float4*)(p.in[I_LNB] + layer * 1024);
  const XSrc xs_ = xsrc(p);
  LnIn cur, nxt;
  if (gw < T / 2) ln_load(xs_, layer, F, gw, lane, cur);
  for (int row0 = gw; row0 < T / 2; row0 += nw) {
    if (row0 + nw < T / 2) ln_load(xs_, layer, F, row0 + nw, lane, nxt);
#pragma unroll
    for (int h = 0; h < 2; ++h) {
      const int row = row0 + h * (T / 2);
      float4 v[4];
      float s = 0.f;
#pragma unroll
      for (int e = 0; e < 4; ++e) {
        const float4 a = cur.x[h][e];
        const uint2 fw = cur.f[h][e];
        v[e] = float4{alpha * a.x + __uint_as_float(fw.x << 16), alpha * a.y + __uint_as_float(fw.x & 0xffff0000u),
                      alpha * a.z + __uint_as_float(fw.y << 16), alpha * a.w + __uint_as_float(fw.y & 0xffff0000u)};
        s += v[e].x + v[e].y + v[e].z + v[e].w;
      }
      const float mean = wsum(s) * (1.f / 1024.f);
      float q = 0.f;
#pragma unroll
      for (int e = 0; e < 4; ++e) {
        v[e].x -= mean; v[e].y -= mean; v[e].z -= mean; v[e].w -= mean;
        q += v[e].x * v[e].x + v[e].y * v[e].y + v[e].z * v[e].z + v[e].w * v[e].w;
      }
      const float rs = rsqrtf(wsum(q) * (1.f / 1024.f) + 1e-5f);
      float4* o4 = (float4*)(p.out + (size_t)row * 1024);
#pragma unroll
      for (int e = 0; e < 4; ++e) {
        const float4 g = g4[lane + 64 * e], b = b4[lane + 64 * e];
        const float4 o = float4{v[e].x * rs * g.x + b.x, v[e].y * rs * g.y + b.y, v[e].z * rs * g.z + b.z, v[e].w * rs * g.w + b.w};
        if (!dry) o4[lane + 64 * e] = o;
        if (XB) ((uint2*)(XB + (size_t)row * 1024))[lane + 64 * e] = uint2{pack2(o.x, o.y), pack2(o.z, o.w)};
      }
    }
    cur = nxt;
  }
}

struct cplx { float x, y; };
DEVI cplx cmul(cplx a, cplx b) { return cplx{a.x * b.x - a.y * b.y, a.x * b.y + a.y * b.x}; }
DEVI void s5_consts(const Params& p, int i, int d, int g, int n, cplx& lb, cplx& coef) {
  const int idx = ((i * 2 + d) * 32 + g) * 64 + n;
  const float lre = p.in[I_LRE][idx], lim = p.in[I_LIM][idx];
  const float dt = expf(p.in[I_LSTEP][(i * 2 + d) * 32 + g]);
  const float mag = expf(lre * dt);
  float sn, cs; sincosf(lim * dt, &sn, &cs);
  lb = cplx{mag * cs, mag * sn};
  const float nr = lb.x - 1.f, ni = lb.y, den = 1.f / (lre * lre + lim * lim);
  coef = cplx{(nr * lre + ni * lim) * den, (ni * lre - nr * lim) * den};
}
DEVI void s5_load_u(const ushort_t* PS5, int tok0, int g, int lane, uint4& a, uint4& b) {
  const uint4* src = (const uint4*)(PS5 + (size_t)(tok0 + lane) * 1024 + g * 16);
  a = src[0]; b = src[1];
}
DEVI void s5_store_u(float* U, int lane, const uint4& a, const uint4& b) {
  float4* d = (float4*)(U + lane * 16);
  d[0] = float4{__uint_as_float(a.x << 16), __uint_as_float(a.x & 0xffff0000u), __uint_as_float(a.y << 16), __uint_as_float(a.y & 0xffff0000u)};
  d[1] = float4{__uint_as_float(a.z << 16), __uint_as_float(a.z & 0xffff0000u), __uint_as_float(a.w << 16), __uint_as_float(a.w & 0xffff0000u)};
  d[2] = float4{__uint_as_float(b.x << 16), __uint_as_float(b.x & 0xffff0000u), __uint_as_float(b.y << 16), __uint_as_float(b.y & 0xffff0000u)};
  d[3] = float4{__uint_as_float(b.z << 16), __uint_as_float(b.z & 0xffff0000u), __uint_as_float(b.w << 16), __uint_as_float(b.w & 0xffff0000u)};
}
DEVI f32x2 cmul2(f32x2 a, f32x2 b) { return f32x2{a.x, a.x} * b + f32x2{a.y, a.y} * f32x2{-b.y, b.x}; }
#define S5_BU2(Urow, acc2)                                                            \
  {                                                                                   \
    const float4* u4 = (const float4*)(Urow);                                         \
    _Pragma("unroll") for (int pp = 0; pp < 4; ++pp) {                                \
      const float4 u = u4[pp];                                                        \
      acc2 = B2[4 * pp] * f32x2{u.x, u.x} + acc2; acc2 = B2[4 * pp + 1] * f32x2{u.y, u.y} + acc2; \
      acc2 = B2[4 * pp + 2] * f32x2{u.z, u.z} + acc2; acc2 = B2[4 * pp + 3] * f32x2{u.w, u.w} + acc2; \
    }                                                                                 \
  }

__device__ void s5_passA(const Params& p, int i, unsigned char* lds) {
  const ushort_t* PS5 = (const ushort_t*)(p.ws + OFF_PS5);
  cplx* CAR = (cplx*)(p.ws + OFF_CAR);
  const int lane = tidx() & 63, wave = tidx() >> 6;
  float* U = (float*)(lds + wave * 8448);
  for (int item = bidx() * 8 + wave; item < 192 * 32; item += gridDim.x * 8) {
    const int q = item >> 5, g = item & 31;
    cplx lb0, c0, lb1, c1;
    s5_consts(p, i, 0, g, lane, lb0, c0);
    s5_consts(p, i, 1, g, lane, lb1, c1);
    const f32x2 l0 = {lb0.x, lb0.y}, l1 = {lb1.x, lb1.y};
    f32x2 B2[16];
#pragma unroll
    for (int pp = 0; pp < 16; ++pp) B2[pp] = f32x2{p.in[I_BRE][((i * 32 + g) * 64 + lane) * 16 + pp], p.in[I_BIM][((i * 32 + g) * 64 + lane) * 16 + pp]};
    f32x2 xf = {0.f, 0.f}, xb = {0.f, 0.f}, pw = {1.f, 0.f};
    uint4 ua, ub;
    s5_load_u(PS5, q * 256, g, lane, ua, ub);
    for (int sb = 0; sb < 4; ++sb) {
      wave_sync();
      s5_store_u(U, lane, ua, ub);
      wave_sync();
      if (sb < 3) s5_load_u(PS5, q * 256 + (sb + 1) * 64, g, lane, ua, ub);
#pragma unroll 4
      for (int t = 0; t < 64; ++t) {
        f32x2 bu = {0.f, 0.f};
        S5_BU2(U + t * 16, bu);
        xf = cmul2(l0, xf) + bu;
        xb = cmul2(pw, bu) + xb;
        pw = cmul2(pw, l1);
      }
    }
    CAR[((size_t)(q * 32 + g) * 2 + 0) * 64 + lane] = cmul(cplx{xf.x, xf.y}, c0);
    CAR[((size_t)(q * 32 + g) * 2 + 1) * 64 + lane] = cmul(cplx{xb.x, xb.y}, c1);
  }
}

__device__ void s5_passC(const Params& p, int i, unsigned char* lds) {
  const ushort_t* PS5 = (const ushort_t*)(p.ws + OFF_PS5);
  const cplx* CAR = (const cplx*)(p.ws + OFF_CAR);
  float* YS = (float*)(p.ws + OFF_YS);
  ushort_t* YG = (ushort_t*)(p.ws + OFF_Y);
  const int lane = tidx() & 63, wave = tidx() >> 6;
  float* U = (float*)(lds + wave * 8448);
  ushort_t* X = (ushort_t*)(lds + wave * 8448 + 4096);
  for (int item = bidx() * 8 + wave; item < 192 * 32; item += gridDim.x * 8) {
    const int q = item >> 5, g = item & 31;
    int cs, ce;
    if (q < 64) { cs = q & ~15; ce = cs + 16; } else { cs = 64 + ((q - 64) & ~63); ce = cs + 64; }
    const int pcol = lane & 15;
    const float dd = p.in[I_S5D][i * 512 + g * 16 + pcol];
    for (int d = 0; d < 2; ++d) {
      cplx lb, coef;
      s5_consts(p, i, d, g, lane, lb, coef);
      const f32x2 l2 = {lb.x, lb.y};
      f32x2 B2[16];
#pragma unroll
      for (int pp = 0; pp < 16; ++pp) {
        const cplx bb = cmul(coef, cplx{p.in[I_BRE][((i * 32 + g) * 64 + lane) * 16 + pp], p.in[I_BIM][((i * 32 + g) * 64 + lane) * 16 + pp]});
        B2[pp] = f32x2{bb.x, bb.y};
      }
      cplx lp = lb;
#pragma unroll
      for (int e = 0; e < 8; ++e) lp = cmul(lp, lp);
      cplx xs{0.f, 0.f};
      if (d == 0) {
#pragma unroll 8
        for (int j = cs; j < q; ++j) { xs = cmul(lp, xs); cplx c = CAR[((size_t)(j * 32 + g) * 2 + 0) * 64 + lane]; xs.x += c.x; xs.y += c.y; } }
      else {
#pragma unroll 8
        for (int j = ce - 1; j > q; --j) { xs = cmul(lp, xs); cplx c = CAR[((size_t)(j * 32 + g) * 2 + 1) * 64 + lane]; xs.x += c.x; xs.y += c.y; } }
      f32x2 x2 = {xs.x, xs.y};
      bf16x8 cf[4];
#pragma unroll
      for (int kk = 0; kk < 4; ++kk) {
        const int n0 = (kk & 1) * 32 + (lane >> 4) * 8;
        const float* src = (kk < 2 ? p.in[I_CRE] : p.in[I_CIM]) + (((size_t)(i * 2 + d) * 32 + g) * 16 + pcol) * 64 + n0;
        const float sg = kk < 2 ? 1.f : -1.f;
#pragma unroll
        for (int j = 0; j < 8; ++j) cf[kk][j] = (short)f2bf(sg * src[j]);
      }
      uint4 ua, ub;
      s5_load_u(PS5, q * 256 + (d ? 3 : 0) * 64, g, lane, ua, ub);
      for (int sbi = 0; sbi < 4; ++sbi) {
        const int sb = d ? 3 - sbi : sbi;
        wave_sync();
        s5_store_u(U, lane, ua, ub);
        wave_sync();
        if (sbi < 3) s5_load_u(PS5, q * 256 + (d ? 2 - sbi : sbi + 1) * 64, g, lane, ua, ub);
        for (int tbi = 0; tbi < 4; ++tbi) {
          const int tb = d ? 3 - tbi : tbi;
          float ysp[4] = {0.f, 0.f, 0.f, 0.f};
          if (d == 1) {
#pragma unroll
            for (int r = 0; r < 4; ++r) ysp[r] = YS[(size_t)(q * 256 + sb * 64 + tb * 16 + (lane >> 4) * 4 + r) * 512 + g * 16 + pcol];
          }
#pragma unroll 4
          for (int tti = 0; tti < 16; ++tti) {
            const int tt = d ? 15 - tti : tti;
            f32x2 acc2 = cmul2(l2, x2);
            S5_BU2(U + (tb * 16 + tt) * 16, acc2);
            x2 = acc2;
            X[tt * 136 + lane] = f2bf(x2.x);
            X[tt * 136 + 64 + lane] = f2bf(x2.y);
          }
          wave_sync();
          f32x4 acc{0.f, 0.f, 0.f, 0.f};
#pragma unroll
          for (int kk = 0; kk < 4; ++kk) {
            bf16x8 a = *(const bf16x8*)(X + (lane & 15) * 136 + kk * 32 + (lane >> 4) * 8);
            acc = __builtin_amdgcn_mfma_f32_16x16x32_bf16(a, cf[kk], acc, 0, 0, 0);
          }
          wave_sync();
#pragma unroll
          for (int r = 0; r < 4; ++r) {
            const int tl = tb * 16 + (lane >> 4) * 4 + r;
            const size_t o = (size_t)(q * 256 + sb * 64 + tl) * 512 + g * 16 + pcol;
            if (d == 0) YS[o] = acc[r] + dd * U[tl * 16 + pcol];
            else {
              const float yv = ysp[r] + acc[r];
              YG[(size_t)(q * 256 + sb * 64 + tl) * 1024 + 512 + g * 16 + pcol] = f2bf(yv * fast_sigmoid(1.5957691216f * (yv + 0.044715f * yv * yv * yv)));
            }
          }
        }
      }
    }
  }
}

struct RwConst { float mur, muk, muv, mul, w0, a0, kk, ka; };
struct RwRow { float r, k, v, l; };
DEVI RwRow rw_load_row(const ushort_t* PRW, int tok, int s0, int L, int h, int lane) {
  RwRow o{0.f, 0.f, 0.f, 0.f};
  if (tok >= s0 && tok < s0 + L) {
    const ushort_t* row = PRW + (size_t)tok * 2112;
    const int cc = h * 64 + lane;
    o.r = bf2f(row[cc]); o.k = bf2f(row[512 + cc]); o.v = bf2f(row[1024 + cc]); o.l = bf2f(row[2048 + lane]);
  }
  return o;
}
DEVI void rw_prologue(const RwRow& rm, const RwRow& rc, const RwRow& rn, int lane, const RwConst& c, const float* WU, const float* AU,
                      float* LT, float* Wd, float* KKd, float* BBd, float* KDd, float* RRd, float* VVd) {
  const float rr = rc.r + c.mur * (0.5f * (rm.r + rn.r) - rc.r);
  const float kx = rc.k + c.muk * (0.5f * (rm.k + rn.k) - rc.k);
  const float vv = rc.v + c.muv * (0.5f * (rm.v + rn.v) - rc.v);
  float ll = rc.l + c.mul * (0.5f * (rm.l + rn.l) - rc.l);
  ll = lane < 32 ? fast_tanh(ll) : ll;
  wave_sync();
  LT[lane] = ll;
  wave_sync();
  float accw = c.w0, acca = c.a0;
#pragma unroll 2
  for (int j = 0; j < 32; j += 4) {
    float4 lw = *(const float4*)(LT + j), la = *(const float4*)(LT + 32 + j);
    accw += lw.x * WU[(j + 0) * 64 + lane] + lw.y * WU[(j + 1) * 64 + lane] + lw.z * WU[(j + 2) * 64 + lane] + lw.w * WU[(j + 3) * 64 + lane];
    acca += la.x * AU[(j + 0) * 64 + lane] + la.y * AU[(j + 1) * 64 + lane] + la.z * AU[(j + 2) * 64 + lane] + la.w * AU[(j + 3) * 64 + lane];
  }
  const float dec = __builtin_amdgcn_exp2f(-0.8750387749145276f * fast_sigmoid(accw));
  const float a = fast_sigmoid(acca);
  const float kkr = kx * c.kk;
  const float ss = wsum_fast(kkr * kkr);
  const float kkn = kkr * __builtin_amdgcn_rsqf(fmaxf(ss, 1e-24f));
  Wd[lane] = dec; KKd[lane] = kkn; BBd[lane] = kkn * a; KDd[lane] = kx * (1.f + (a - 1.f) * c.ka); RRd[lane] = rr; VVd[lane] = vv;
}

template <int NS>
DEVI void rw_prologue_blk(const RwRow* R, int lane, const RwConst& c, const bf16x8* BF, int dir, ushort_t* LTm,
                          float* Wd, float* KKd, float* BBd, float* KDd, float* RRd, float* VVd) {
#pragma unroll
  for (int e = 0; e < NS; ++e) {
    const RwRow& rm = R[e]; const RwRow& rc = R[e + 1]; const RwRow& rn = R[e + 2];
    const float rr = rc.r + c.mur * (0.5f * (rm.r + rn.r) - rc.r);
    const float kx = rc.k + c.muk * (0.5f * (rm.k + rn.k) - rc.k);
    const float vv = rc.v + c.muv * (0.5f * (rm.v + rn.v) - rc.v);
    float ll = rc.l + c.mul * (0.5f * (rm.l + rn.l) - rc.l);
    ll = lane < 32 ? fast_tanh(ll) : ll;
    RRd[e * 64 + lane] = rr; VVd[e * 64 + lane] = vv; KDd[e * 64 + lane] = kx;
    LTm[e * 72 + lane] = f2bf(ll);
  }
  wave_sync_lds();
  {
    const int row = lane & (NS - 1), kq8 = (lane >> 4) * 8;
    const bf16x8 aw = *(const bf16x8*)(LTm + row * 72 + kq8);
    const bf16x8 aa = *(const bf16x8*)(LTm + row * 72 + 32 + kq8);
#pragma unroll
    for (int nt = 0; nt < 4; ++nt) {
      const f32x4 z = {0.f, 0.f, 0.f, 0.f};
      const f32x4 dw = __builtin_amdgcn_mfma_f32_16x16x32_bf16(aw, BF[(dir * 4 + nt) * 64 + lane], z, 0, 0, 0);
      const f32x4 da = __builtin_amdgcn_mfma_f32_16x16x32_bf16(aa, BF[(8 + nt) * 64 + lane], z, 0, 0, 0);
      if ((lane >> 4) < NS / 4) {
#pragma unroll
        for (int r = 0; r < 4; ++r) {
          const int o = ((lane >> 4) * 4 + r) * 64 + nt * 16 + (lane & 15);
          Wd[o] = dw[r]; BBd[o] = da[r];
        }
      }
    }
  }
  wave_sync_lds();
#pragma unroll
  for (int e = 0; e < NS; ++e) {
    const float accw = c.w0 + Wd[e * 64 + lane], acca = c.a0 + BBd[e * 64 + lane], kx = KDd[e * 64 + lane];
    const float dec = __builtin_amdgcn_exp2f(-0.8750387749145276f * fast_sigmoid(accw));
    const float a = fast_sigmoid(acca);
    const float kkr = kx * c.kk;
    const float ss = wsum_fast(kkr * kkr);
    const float kkn = kkr * __builtin_amdgcn_rsqf(fmaxf(ss, 1e-24f));
    Wd[e * 64 + lane] = dec; KKd[e * 64 + lane] = kkn; BBd[e * 64 + lane] = kkn * a; KDd[e * 64 + lane] = kx * (1.f + (a - 1.f) * c.ka);
  }
}
DEVI void rw_fill_bf(const Params& p, int i, int h, bf16x8* BF, int tid, int nthr = NT) {
  for (int e = tid; e < 768; e += nthr) {
    const int which = e >> 8, nt = (e >> 6) & 3, l = e & 63;
    const int n = nt * 16 + (l & 15), k0 = (l >> 4) * 8;
    const float* src = which < 2 ? p.in[I_WUP] + ((size_t)(i * 2 + which) * 32) * 512 : p.in[I_AUP] + ((size_t)i * 32) * 512;
    bf16x8 v;
#pragma unroll
    for (int jj = 0; jj < 8; ++jj) v[jj] = (short)f2bf(src[(size_t)(k0 + jj) * 512 + h * 64 + n]);
    BF[e] = v;
  }
}

DEVI float dpp_f(float x, const int ctrl_sel) {
  int xi = __builtin_bit_cast(int, x), r;
  if (ctrl_sel == 0) r = __builtin_amdgcn_mov_dpp(xi, 0xB1, 0xf, 0xf, true);
  else if (ctrl_sel == 1) r = __builtin_amdgcn_mov_dpp(xi, 0x4E, 0xf, 0xf, true);
  else r = __builtin_amdgcn_mov_dpp(xi, 0x141, 0xf, 0xf, true);
  return __builtin_bit_cast(float, r);
}
DEVI float red8(float x) { x += dpp_f(x, 0); x += dpp_f(x, 1); x += dpp_f(x, 2); return x; }

#define RW_LOAD8(dst2, base)                                                        \
  { const float4 _a = *(const float4*)(base), _b = *(const float4*)((base) + 4);    \
    dst2[0] = f32x2{_a.x, _a.y}; dst2[1] = f32x2{_a.z, _a.w}; dst2[2] = f32x2{_b.x, _b.y}; dst2[3] = f32x2{_b.z, _b.w}; }

__device__ void rwkv_scan1(const Params& p, int i, unsigned char* lds) {
  const ushort_t* PRW = (const ushort_t*)(p.ws + OFF_PRW);
  float* CH = (float*)(p.ws + OFF_PS5);
  float* YR = (float*)(p.ws + OFF_YS);
  const int tid = tidx(), lane = tid & 63, wave = tid >> 6, pair = wave >> 1, role = (wave ^ (wave >> 2)) & 1;
  const int vq = lane >> 3, kq = lane & 7;
  bf16x8* BF = (bf16x8*)lds;
  float* WV = (float*)(lds + 12288 + pair * 26880);
  float* Wd = WV, *KKd = WV + 1024, *BBd = WV + 2048, *KDd = WV + 3072, *RRd = WV + 4096, *VVd = WV + 5120;
  ushort_t* LTm = (ushort_t*)(WV + 6144) + role * 576;
  {
    float4* z = (float4*)YR;
    for (size_t e = (size_t)bidx() * NT + tid; e < (size_t)T * 512 / 4; e += (size_t)gridDim.x * NT) z[e] = float4{0.f, 0.f, 0.f, 0.f};
  }
  for (int bi = bidx(); bi < 768; bi += gridDim.x) {
    const int h = bi / 96, rem = bi % 96;
    const int dir = pair >> 1, q = rem * 2 + (pair & 1);
    __syncthreads();
    rw_fill_bf(p, i, h, BF, tid);
    __syncthreads();
    RwConst c;
    const int cc = h * 64 + lane;
    c.mur = p.in[I_MURKV][(i * 3 + 0) * 512 + cc]; c.muk = p.in[I_MURKV][(i * 3 + 1) * 512 + cc]; c.muv = p.in[I_MURKV][(i * 3 + 2) * 512 + cc];
    c.mul = p.in[I_MULORA][i * 64 + lane];
    c.w0 = p.in[I_W0][(i * 2 + dir) * 512 + cc]; c.a0 = p.in[I_A0][(i * 2 + dir) * 512 + cc];
    c.kk = p.in[I_KK][i * 512 + cc]; c.ka = p.in[I_KA][i * 512 + cc];
    const size_t it = ((size_t)(q * 8 + h) * 2 + dir);
    int sq0, sqL; seq_of(q * 256, sq0, sqL);
    float* Op = CH + it * 8192 + (role ? 0 : 4096);
    f32x2 S2[8][4];
    int diag = (role && vq == kq) ? 1 : 0;
    asm volatile("" : "+v"(diag));
#pragma unroll
    for (int r = 0; r < 8; ++r)
#pragma unroll
      for (int jj = 0; jj < 4; ++jj) S2[r][jj] = f32x2{(diag && (2 * jj == r)) ? 1.f : 0.f, (diag && (2 * jj + 1 == r)) ? 1.f : 0.f};
    const float vsel = role ? 0.f : 1.f;
    RwRow R[10];
#pragma unroll
    for (int j = 0; j < 10; ++j) {
      const int st = role * 8 + j - 1;
      R[j] = rw_load_row(PRW, dir ? (q * 256 + 255 - st) : (q * 256 + st), sq0, sqL, h, lane);
    }
    for (int blk = 0; blk < 16; ++blk) {
      {
        const int s = role * 8;
        rw_prologue_blk<8>(R, lane, c, BF, dir, LTm, Wd + s * 64, KKd + s * 64, BBd + s * 64, KDd + s * 64, RRd + s * 64, VVd + s * 64);
      }
      if (blk + 1 < 16) {
#pragma unroll
        for (int j = 0; j < 10; ++j) {
          const int st = (blk + 1) * 16 + role * 8 + j - 1;
          R[j] = rw_load_row(PRW, dir ? (q * 256 + 255 - st) : (q * 256 + st), sq0, sqL, h, lane);
        }
      }
      block_sync_lds();
#pragma unroll 2
      for (int s = 0; s < 16; ++s) {
        f32x2 kk2[4], w2[4], b2[4], kd2[4], vv2[4];
        RW_LOAD8(kk2, KKd + s * 64 + 8 * kq);
        RW_LOAD8(vv2, VVd + s * 64 + 8 * vq);
        RW_LOAD8(w2, Wd + s * 64 + 8 * kq);
        RW_LOAD8(b2, BBd + s * 64 + 8 * kq);
        RW_LOAD8(kd2, KDd + s * 64 + 8 * kq);
        float sa[8];
#pragma unroll
        for (int r = 0; r < 8; ++r) {
          f32x2 a = S2[r][0] * kk2[0];
          a = S2[r][1] * kk2[1] + a; a = S2[r][2] * kk2[2] + a; a = S2[r][3] * kk2[3] + a;
          sa[r] = -red8(a.x + a.y);
        }
#pragma unroll
        for (int r = 0; r < 8; ++r) {
          const float vr = ((r & 1) ? vv2[r >> 1].y : vv2[r >> 1].x) * vsel;
          const f32x2 sa2 = f32x2{sa[r], sa[r]}, v2 = f32x2{vr, vr};
#pragma unroll
          for (int jj = 0; jj < 4; ++jj) S2[r][jj] = S2[r][jj] * w2[jj] + sa2 * b2[jj] + v2 * kd2[jj];
        }
      }
      block_sync_lds();
    }
#pragma unroll
    for (int r = 0; r < 8; ++r) {
      float* dst = Op + (8 * vq + r) * 64 + 8 * kq;
      *(float4*)dst = float4{S2[r][0].x, S2[r][0].y, S2[r][1].x, S2[r][1].y};
      *(float4*)(dst + 4) = float4{S2[r][2].x, S2[r][2].y, S2[r][3].x, S2[r][3].y};
    }
  }
}

__device__ void rwkv_scan3(const Params& p, int i, unsigned char* lds, bool dry = false) {
  const ushort_t* PRW = (const ushort_t*)(p.ws + OFF_PRW);
  float* CH = (float*)(p.ws + OFF_PS5);
  float* YR = (float*)(p.ws + OFF_YS);
  const int tid = tidx(), lane = tid & 63, wave = tid >> 6;
  const int vq = lane >> 3, kq = lane & 7;
  const int half = wave >> 2;
  bf16x8* BF = (bf16x8*)lds + half * 768;
  float* WV = (float*)(lds + 24576 + wave * 13440);
  float* Wd = WV, *KKd = WV + 512, *BBd = WV + 1024, *KDd = WV + 1536, *RRd = WV + 2048, *VVd = WV + 2560;
  ushort_t* LTm = (ushort_t*)(WV + 3072);
  for (int tb2 = bidx() * 2; tb2 < 512; tb2 += gridDim.x * 2)
  for (int rnd = 0; rnd < 2; ++rnd) {
    const int tb = tb2 >> 1;
    const int hi = tb * 3 + (rnd == 0 ? half : 2);
    const bool active = (rnd == 0) || (half == 0);
    const int h = hi / 96, rem = hi % 96, cgp = rem >> 1, dir = rem & 1;
    const int q = cgp * 4 + (wave & 3);
    __syncthreads();
    if (active) rw_fill_bf(p, i, h, BF, tid & 255, 256);
    __syncthreads();
    if (!active) continue;
    RwConst c;
    const int cc = h * 64 + lane;
    c.mur = p.in[I_MURKV][(i * 3 + 0) * 512 + cc]; c.muk = p.in[I_MURKV][(i * 3 + 1) * 512 + cc]; c.muv = p.in[I_MURKV][(i * 3 + 2) * 512 + cc];
    c.mul = p.in[I_MULORA][i * 64 + lane];
    c.w0 = p.in[I_W0][(i * 2 + dir) * 512 + cc]; c.a0 = p.in[I_A0][(i * 2 + dir) * 512 + cc];
    c.kk = p.in[I_KK][i * 512 + cc]; c.ka = p.in[I_KA][i * 512 + cc];
    const size_t it = ((size_t)(q * 8 + h) * 2 + dir);
    int sq0, sqL; seq_of(q * 256, sq0, sqL);
    const float* Qp = CH + it * 8192 + 4096;
    f32x2 S2[8][4];
#pragma unroll
    for (int r = 0; r < 8; ++r) {
      const float* src = Qp + (8 * vq + r) * 64 + 8 * kq;
      const float4 a = *(const float4*)src, b = *(const float4*)(src + 4);
      S2[r][0] = f32x2{a.x, a.y}; S2[r][1] = f32x2{a.z, a.w}; S2[r][2] = f32x2{b.x, b.y}; S2[r][3] = f32x2{b.z, b.w};
    }
    RwRow R[10];
#pragma unroll
    for (int j = 0; j < 10; ++j) {
      const int st = j - 1;
      R[j] = rw_load_row(PRW, dir ? (q * 256 + 255 - st) : (q * 256 + st), sq0, sqL, h, lane);
    }
    for (int blk = 0; blk < 32; ++blk) {
      rw_prologue_blk<8>(R, lane, c, BF, dir, LTm, Wd, KKd, BBd, KDd, RRd, VVd);
      if (blk + 1 < 32) {
#pragma unroll
        for (int j = 0; j < 10; ++j) {
          const int st = (blk + 1) * 8 + j - 1;
          R[j] = rw_load_row(PRW, dir ? (q * 256 + 255 - st) : (q * 256 + st), sq0, sqL, h, lane);
        }
      }
      wave_sync_lds();
#pragma unroll 2
      for (int s = 0; s < 8; ++s) {
        f32x2 kk2[4], w2[4], b2[4], kd2[4], vv2[4], r2[4];
        RW_LOAD8(kk2, KKd + s * 64 + 8 * kq);
        RW_LOAD8(vv2, VVd + s * 64 + 8 * vq);
        RW_LOAD8(w2, Wd + s * 64 + 8 * kq);
        RW_LOAD8(b2, BBd + s * 64 + 8 * kq);
        RW_LOAD8(kd2, KDd + s * 64 + 8 * kq);
        RW_LOAD8(r2, RRd + s * 64 + 8 * kq);
        float sa[8];
#pragma unroll
        for (int r = 0; r < 8; ++r) {
          f32x2 a = S2[r][0] * kk2[0];
          a = S2[r][1] * kk2[1] + a; a = S2[r][2] * kk2[2] + a; a = S2[r][3] * kk2[3] + a;
          sa[r] = -red8(a.x + a.y);
        }
        float ysel = 0.f;
#pragma unroll
        for (int r = 0; r < 8; ++r) {
          const float vr = (r & 1) ? vv2[r >> 1].y : vv2[r >> 1].x;
          const f32x2 sa2 = f32x2{sa[r], sa[r]}, v2 = f32x2{vr, vr};
          f32x2 ya = f32x2{0.f, 0.f};
#pragma unroll
          for (int jj = 0; jj < 4; ++jj) {
            S2[r][jj] = S2[r][jj] * w2[jj] + sa2 * b2[jj] + v2 * kd2[jj];
            ya = S2[r][jj] * r2[jj] + ya;
          }
          const float yr = red8(ya.x + ya.y);
          ysel = (kq == r) ? yr : ysel;
        }
        const int st = blk * 8 + s;
        const int tok = dir ? (q * 256 + 255 - st) : (q * 256 + st);
        if (!dry) atomicAdd(YR + (size_t)tok * 512 + h * 64 + lane, ysel);
      }
      wave_sync_lds();
    }
  }
}

__device__ void rwkv_carry(const Params& p, unsigned char* lds, bool dry = false) {
  float* CH = (float*)(p.ws + OFF_PS5);
  float* Ps = (float*)lds;
  float* Ss = Ps + 4096;
  const int tid = tidx(), v = tid >> 4, ks = (tid & 15) * 4;
  for (int bi = bidx(); bi < 192; bi += gridDim.x) {
    const int half = bi & 1, dir = (bi >> 1) & 1, h = (bi >> 2) & 7, s = bi >> 5;
    int cs, n;
    if (s < 4) { cs = s * 16; n = 16; } else { cs = 64 + (s - 4) * 64; n = 64; }
    float4 cur{0.f, 0.f, 0.f, 0.f};
    float4 pq0, pq1, qv;
    {
      const int q = dir ? (cs + n - 1) : cs;
      const float* Pp = CH + ((size_t)(q * 8 + h) * 2 + dir) * 8192;
      pq0 = ((const float4*)Pp)[tid]; pq1 = ((const float4*)Pp)[tid + 512];
      qv = *(const float4*)(Pp + 4096 + (half * 32 + v) * 64 + ks);
    }
    for (int ci = 0; ci < n; ++ci) {
      const int q = dir ? (cs + n - 1 - ci) : (cs + ci);
      float* Pp = CH + ((size_t)(q * 8 + h) * 2 + dir) * 8192;
      float* Qrow = Pp + 4096 + (half * 32 + v) * 64 + ks;
      __syncthreads();
      if (!dry) *(float4*)Qrow = cur;
      if (ci == n - 1) break;
      *(float4*)(Ss + v * 64 + ks) = cur;
      ((float4*)Ps)[tid] = pq0;
      ((float4*)Ps)[tid + 512] = pq1;
      float4 acc = qv;
      if (ci + 2 < n + 1 && ci + 1 < n) {
        const int qn = dir ? (cs + n - 2 - ci) : (cs + ci + 1);
        const float* Pn = CH + ((size_t)(qn * 8 + h) * 2 + dir) * 8192;
        pq0 = ((const float4*)Pn)[tid]; pq1 = ((const float4*)Pn)[tid + 512];
        qv = *(const float4*)(Pn + 4096 + (half * 32 + v) * 64 + ks);
      }
      __syncthreads();
#pragma unroll 8
      for (int j = 0; j < 64; ++j) {
        const float sv = Ss[v * 64 + j];
        const float4 pr = *(const float4*)(Ps + j * 64 + ks);
        acc.x += sv * pr.x; acc.y += sv * pr.y; acc.z += sv * pr.z; acc.w += sv * pr.w;
      }
      cur = acc;
    }
    __syncthreads();
  }
}

struct PostIn { float r[6], k[6], v[6], g[4], y[4]; };
DEVI void post_load(const ushort_t* __restrict__ PRW, const float* __restrict__ YR, int item, int lane, PostIn& o) {
  const int tok0 = (item >> 3) * 4, h = item & 7, cc = h * 64 + lane;
  int s0, L; seq_of(tok0, s0, L);
#pragma unroll
  for (int j = 0; j < 6; ++j) {
    const int tok = tok0 - 1 + j;
    o.r[j] = 0.f; o.k[j] = 0.f; o.v[j] = 0.f;
    if (tok >= s0 && tok < s0 + L) {
      const ushort_t* row = PRW + (size_t)tok * 2112;
      o.r[j] = bf2f(row[cc]); o.k[j] = bf2f(row[512 + cc]); o.v[j] = bf2f(row[1024 + cc]);
    }
  }
#pragma unroll
  for (int e = 0; e < 4; ++e) { o.g[e] = bf2f(PRW[(size_t)(tok0 + e) * 2112 + 1536 + cc]); o.y[e] = YR[(size_t)(tok0 + e) * 512 + cc]; }
}
__device__ void rwkv_post(const Params& p, int i) {
  const ushort_t* __restrict__ PRW = (const ushort_t*)(p.ws + OFF_PRW);
  const float* __restrict__ YR = (const float*)(p.ws + OFF_YS);
  ushort_t* __restrict__ Y = (ushort_t*)(p.ws + OFF_Y);
  const int lane = tidx() & 63, gw = bidx() * 8 + (tidx() >> 6), nw = gridDim.x * 8;
  PostIn cur, nxt;
  if (gw < (T / 4) * 8) post_load(PRW, YR, gw, lane, cur);
  for (int item = gw; item < (T / 4) * 8; item += nw) {
    const int tok0 = (item >> 3) * 4, h = item & 7, cc = h * 64 + lane;
    if (item + nw < (T / 4) * 8) post_load(PRW, YR, item + nw, lane, nxt);
    const float mur = p.in[I_MURKV][(i * 3 + 0) * 512 + cc], muk = p.in[I_MURKV][(i * 3 + 1) * 512 + cc], muv = p.in[I_MURKV][(i * 3 + 2) * 512 + cc];
    const float lw = p.in[I_LNXW][i * 512 + cc], lb = p.in[I_LNXB][i * 512 + cc], rk = p.in[I_RK][i * 512 + cc];
#pragma unroll
    for (int e = 0; e < 4; ++e) {
      const float rr = cur.r[e + 1] + mur * (0.5f * (cur.r[e] + cur.r[e + 2]) - cur.r[e + 1]);
      const float kx = cur.k[e + 1] + muk * (0.5f * (cur.k[e] + cur.k[e + 2]) - cur.k[e + 1]);
      const float vv = cur.v[e + 1] + muv * (0.5f * (cur.v[e] + cur.v[e + 2]) - cur.v[e + 1]);
      const float mean = wsum_fast(cur.y[e]) * (1.f / 64.f);
      const float dlt = cur.y[e] - mean;
      const float var = wsum_fast(dlt * dlt) * (1.f / 64.f);
      const float yn = dlt * __builtin_amdgcn_rsqf(var + 64e-5f) * lw + lb;
      const float bonus = wsum_fast(rr * kx * rk) * vv;
      Y[(size_t)(tok0 + e) * 1024 + 512 + cc] = f2bf((yn + bonus) * (cur.g[e] * fast_sigmoid(cur.g[e])));
    }
    cur = nxt;
  }
}

__device__ void hy_filter_mlp(const Params& p, int i) {
  float* H2 = (float*)(p.ws + OFF_H2);
  const int lane = tidx() & 63, gw = bidx() * 8 + (tidx() >> 6), nw = gridDim.x * 8;
  const float fr = p.in[I_FFREQ][i * 64 + lane], b1 = p.in[I_FB1][i * 64 + lane], b2 = p.in[I_FB2][i * 64 + lane];
  for (int row = gw; row < 20480; row += nw) {
    const int L = row < 4096 ? 4096 : 16384, t = row < 4096 ? row : row - 4096;
    const float w = 6.283185307179586f * (float)t / (float)L;
    float z = 0.f;
    if (lane == 0) z = (float)t / (float)(L - 1);
    else if (lane <= 32) {
      const int bi = (lane - 1) & 15;
      const float f = 1e-4f + (float)bi * ((15.f - 1e-4f) / 15.f);
      z = lane <= 16 ? cosf(f * w) : -sinf(f * w);
    }
    float a = b1;
#pragma unroll 3
    for (int k = 0; k < 33; ++k) a += __shfl(z, k) * p.in[I_FW1][((size_t)i * 33 + k) * 64 + lane];
    const float h1 = sinf(fr * a);
    float c = b2;
#pragma unroll 8
    for (int k = 0; k < 64; ++k) c += __shfl(h1, k) * p.in[I_FW2][((size_t)i * 64 + k) * 64 + lane];
    H2[(row < 4096 ? (size_t)0 : (size_t)4096 * 64) + (size_t)lane * L + t] = sinf(fr * c);
  }
}

DEVI constexpr int swz(int i) { return i ^ ((i & 32) ? 21 : 0) ^ ((i & 64) ? 26 : 0); }
DEVI int swzF(int t) { return (swz(t >> 1) << 1) | (t & 1); }
DEVI f32x2 cmul_pk(f32x2 a, float c, float sn) { return a * f32x2{c, c} + f32x2{-a.y, a.x} * f32x2{sn, sn}; }
template <int LOGN, int NSEQ>
__device__ void fft_dif(float2* buf_) {
  constexpr int N = 1 << LOGN;
  f32x2* buf = (f32x2*)buf_;
  const int tid = tidx();
#pragma unroll
  for (int ps = 0; ps < LOGN / 2; ++ps) {
    const int lh = LOGN - 1 - 2 * ps;
    const int h = 1 << lh, hh = h >> 1;
    const float inv2h = 1.f / (float)(2 * h);
#pragma unroll 4
    for (int qg = tid; qg < NSEQ * N / 4; qg += NT) {
      const int q = qg & (N / 4 - 1), sb = (qg >> (LOGN - 2)) << LOGN;
      const int pos = q & (hh - 1), grp = q >> (lh - 1);
      const int e0 = sb + swz((grp << (lh + 1)) + pos);
      const int o1 = swz(hh), o2 = swz(h), o3 = swz(h + hh);
      const f32x2 x0 = buf[e0], x1 = buf[e0 ^ o1], x2 = buf[e0 ^ o2], x3 = buf[e0 ^ o3];
      const float f1 = (float)pos * inv2h;
      const float c1 = __builtin_amdgcn_cosf(f1), s1 = -__builtin_amdgcn_sinf(f1);
      const float c2 = c1 * c1 - s1 * s1, s2 = 2.f * c1 * s1;
      const f32x2 a0 = x0 + x2, a1 = x1 + x3;
      const f32x2 a2 = cmul_pk(x0 - x2, c1, s1);
      const f32x2 t3 = cmul_pk(x1 - x3, c1, s1);
      const f32x2 a3 = f32x2{t3.y, -t3.x};
      buf[e0] = a0 + a1;
      buf[e0 ^ o1] = cmul_pk(a0 - a1, c2, s2);
      buf[e0 ^ o2] = a2 + a3;
      buf[e0 ^ o3] = cmul_pk(a2 - a3, c2, s2);
    }
    __syncthreads();
  }
}
template <int LOGN, int NSEQ>
__device__ void fft_dit_inv(float2* buf_) {
  constexpr int N = 1 << LOGN;
  f32x2* buf = (f32x2*)buf_;
  const int tid = tidx();
#pragma unroll
  for (int ps = 0; ps < LOGN / 2; ++ps) {
    const int lh = 2 * ps;
    const int h = 1 << lh;
    const float inv4h = 1.f / (float)(4 * h);
#pragma unroll 4
    for (int qg = tid; qg < NSEQ * N / 4; qg += NT) {
      const int q = qg & (N / 4 - 1), sb = (qg >> (LOGN - 2)) << LOGN;
      const int pos = q & (h - 1), grp = q >> lh;
      const int e0 = sb + swz((grp << (lh + 2)) + pos);
      const int o1 = swz(h), o2 = swz(2 * h), o3 = swz(3 * h);
      const f32x2 x0 = buf[e0], x1 = buf[e0 ^ o1], x2 = buf[e0 ^ o2], x3 = buf[e0 ^ o3];
      const float f2 = (float)pos * inv4h;
      const float c2 = __builtin_amdgcn_cosf(f2), s2 = __builtin_amdgcn_sinf(f2);
      const float c1 = c2 * c2 - s2 * s2, s1 = 2.f * c2 * s2;
      const f32x2 b1 = cmul_pk(x1, c1, s1), b3 = cmul_pk(x3, c1, s1);
      const f32x2 a0 = x0 + b1, a1 = x0 - b1, a2 = x2 + b3, a3 = x2 - b3;
      const f32x2 cc2 = cmul_pk(a2, c2, s2);
      const f32x2 t3 = cmul_pk(a3, c2, s2);
      const f32x2 cc3 = f32x2{-t3.y, t3.x};
      buf[e0] = a0 + cc2;
      buf[e0 ^ o2] = a0 - cc2;
      buf[e0 ^ o1] = a1 + cc3;
      buf[e0 ^ o3] = a1 - cc3;
    }
    __syncthreads();
  }
}
template <int LOGN, int NSEQ>
__device__ void spectrum_extract(const float2* buf, float4* __restrict__ GPa, float4* __restrict__ GPb, float scale_a, float scale_b) {
  constexpr int Lc = 1 << LOGN;
#pragma unroll 2
  for (int jg = tidx(); jg < NSEQ * Lc / 2; jg += NT) {
    const int j = jg & (Lc / 2 - 1), sq = jg >> (LOGN - 1), sb = sq << LOGN;
    float4* GP = sq ? GPb : GPa;
    const float scale = sq ? scale_b : scale_a;
    if (j == 0) {
      const float2 c = buf[sb], ch = buf[sb + 1];
      GP[0] = float4{(c.x + c.y) * scale, (c.x - c.y) * scale, ch.x * scale, -ch.y * scale};
    } else {
      const int pos = 2 * j;
      const int k = (int)(__brev((unsigned)pos) >> (32 - LOGN));
      const int p2 = pos ^ ((1 << (31 - __clz(pos))) - 1);
      const int sp1 = sb + swz(pos), sp2 = sb + swz(p2);
      float2 C1 = buf[sp1], C2 = buf[sp2];
      float2 E{0.5f * (C1.x + C2.x), 0.5f * (C1.y - C2.y)}, D{0.5f * (C1.x - C2.x), 0.5f * (C1.y + C2.y)};
      float2 O{D.y, -D.x};
      const float f = (float)k * (1.f / (float)(2 * Lc));
      const float wc = __builtin_amdgcn_cosf(f), wsn = -__builtin_amdgcn_sinf(f);
      float2 wO{wc * O.x - wsn * O.y, wc * O.y + wsn * O.x};
      GP[j] = float4{(E.x + wO.x) * scale, (E.y + wO.y) * scale, (E.x - wO.x) * scale, -(E.y - wO.y) * scale};
    }
  }
}
template <int LOGN, int NSEQ>
__device__ void spectrum_mul(float2* buf, const float4* __restrict__ GP) {
  constexpr int Lc = 1 << LOGN;
#pragma unroll 2
  for (int jg = tidx(); jg < NSEQ * Lc / 2; jg += NT) {
    const int j = jg & (Lc / 2 - 1), sb = (jg >> (LOGN - 1)) << LOGN;
    const float4 gp = GP[j];
    if (j == 0) {
      const float2 c = buf[sb], ch = buf[sb + 1];
      const float Y0 = (c.x + c.y) * gp.x, YL = (c.x - c.y) * gp.y;
      buf[sb] = float2{0.5f * (Y0 + YL), 0.5f * (Y0 - YL)};
      buf[sb + 1] = float2{ch.x * gp.z + ch.y * gp.w, ch.y * gp.z - ch.x * gp.w};
    } else {
      const int pos = 2 * j;
      const int k = (int)(__brev((unsigned)pos) >> (32 - LOGN));
      const int p2 = pos ^ ((1 << (31 - __clz(pos))) - 1);
      const int sp1 = sb + swz(pos), sp2 = sb + swz(p2);
      float2 C1 = buf[sp1], C2 = buf[sp2];
      float2 E{0.5f * (C1.x + C2.x), 0.5f * (C1.y - C2.y)}, D{0.5f * (C1.x - C2.x), 0.5f * (C1.y + C2.y)};
      float2 O{D.y, -D.x};
      const float f = (float)k * (1.f / (float)(2 * Lc));
      const float wc = __builtin_amdgcn_cosf(f), wsn = -__builtin_amdgcn_sinf(f);
      float2 wO{wc * O.x - wsn * O.y, wc * O.y + wsn * O.x};
      float2 X1{E.x + wO.x, E.y + wO.y}, X2{E.x - wO.x, -(E.y - wO.y)};
      float2 Y1{X1.x * gp.x - X1.y * gp.y, X1.x * gp.y + X1.y * gp.x};
      float2 Y2{X2.x * gp.z - X2.y * gp.w, X2.x * gp.w + X2.y * gp.z};
      float2 Ye{0.5f * (Y1.x + Y2.x), 0.5f * (Y1.y - Y2.y)};
      float2 Dd{0.5f * (Y1.x - Y2.x), 0.5f * (Y1.y + Y2.y)};
      float2 Yo{wc * Dd.x + wsn * Dd.y, wc * Dd.y - wsn * Dd.x};
      buf[sp1] = float2{Ye.x - Yo.y, Ye.y + Yo.x};
      buf[sp2] = float2{Ye.x + Yo.y, -Ye.y + Yo.x};
    }
  }
}

template <int LOGN>
__device__ void hy_conv_item(const Params& p, int i, int c, unsigned char* lds, bool dry) {
  constexpr int Lc = 1 << LOGN;
  constexpr int L = Lc;
  constexpr int NB = (LOGN == 14) ? 2 : 4;
  constexpr int NSEQ = (LOGN == 14) ? 1 : 4;
  constexpr int LOG8 = LOGN - 3;
  const int tid = tidx();
  float2* buf = (float2*)lds;
  float* bufF = (float*)lds;
  float* W3s = (float*)(lds + 131072);
  float* red = W3s + 256;
  float4* GS = (float4*)(p.ws + OFF_GS + (size_t)bidx() * 2 * GS_PER);
  float4* GS1 = GS + GS_PER / 16;
  float* G1tmp = (float*)GS1;
  float* Z1 = (float*)(p.ws + OFF_Z1 + (size_t)bidx() * 65536);
  const float* H2 = (const float*)(p.ws + OFF_H2) + (LOGN == 14 ? (size_t)4096 * 64 : 0);
  const ushort_t* PH = (const ushort_t*)(p.ws + OFF_PH);
  const float delta = 4.605170185988091f * (1.f / 1.5f + (1.f / 0.3f - 1.f / 1.5f) * (float)c / 1023.f);
  __syncthreads();
  if (tid < 256) {
    const int j = tid >> 2, col = tid & 3, o = col >> 1, dirr = col & 1;
    W3s[tid] = p.in[I_FW3][((size_t)i * 64 + j) * 4096 + (dirr * 2 + o) * 1024 + c];
  }
  __syncthreads();
  float ss0 = 0.f, ss1 = 0.f;
  for (int t0 = tid * 4; t0 < L; t0 += NT * 4) {
    float acc[4][4];
#pragma unroll
    for (int r = 0; r < 4; ++r)
#pragma unroll
      for (int cc = 0; cc < 4; ++cc) acc[r][cc] = 0.f;
#pragma unroll 1
    for (int jb = 0; jb < 64; jb += 16) {
      float4 hv[16];
#pragma unroll
      for (int jj = 0; jj < 16; ++jj) hv[jj] = *(const float4*)(H2 + (size_t)(jb + jj) * L + t0);
#pragma unroll
      for (int jj = 0; jj < 16; ++jj) {
        const float4 w = *(const float4*)(W3s + 4 * (jb + jj));
        acc[0][0] += hv[jj].x * w.x; acc[0][1] += hv[jj].x * w.y; acc[0][2] += hv[jj].x * w.z; acc[0][3] += hv[jj].x * w.w;
        acc[1][0] += hv[jj].y * w.x; acc[1][1] += hv[jj].y * w.y; acc[1][2] += hv[jj].y * w.z; acc[1][3] += hv[jj].y * w.w;
        acc[2][0] += hv[jj].z * w.x; acc[2][1] += hv[jj].z * w.y; acc[2][2] += hv[jj].z * w.z; acc[2][3] += hv[jj].z * w.w;
        acc[3][0] += hv[jj].w * w.x; acc[3][1] += hv[jj].w * w.y; acc[3][2] += hv[jj].w * w.z; acc[3][3] += hv[jj].w * w.w;
      }
    }
#pragma unroll
    for (int r = 0; r < 4; ++r) {
      const int t = t0 + r;
      const float dec = expf(-((float)t * (1.f / (float)(L - 1))) * delta);
      const float d0 = acc[r][0] * dec, d1 = acc[r][1] * dec, d2 = acc[r][2] * dec, d3 = acc[r][3] * dec;
      ss0 += d0 * d0 + d1 * d1;
      ss1 += d2 * d2 + d3 * d3;
      if (NSEQ >= 2) {
        bufF[swzF(t)] = d0; bufF[2 * L + swzF(t)] = d2;
        if (t >= 1) { bufF[swzF(2 * L - t)] = d1; bufF[2 * L + swzF(2 * L - t)] = d3; } else { bufF[swzF(L)] = 0.f; bufF[2 * L + swzF(L)] = 0.f; }
      } else {
        bufF[swzF(t)] = d0; G1tmp[t] = d2;
        if (t >= 1) { bufF[swzF(2 * L - t)] = d1; G1tmp[2 * L - t] = d3; } else { bufF[swzF(L)] = 0.f; G1tmp[L] = 0.f; }
      }
    }
  }
  ss0 = wsum(ss0); ss1 = wsum(ss1);
  if ((tid & 63) == 0) { red[tid >> 6] = ss0; red[8 + (tid >> 6)] = ss1; }
  __syncthreads();
  float tot0 = 0.f, tot1 = 0.f;
#pragma unroll
  for (int w = 0; w < 8; ++w) { tot0 += red[w]; tot1 += red[8 + w]; }
  const float sc0 = rsqrtf(tot0) * (1.f / (float)Lc), sc1 = rsqrtf(tot1) * (1.f / (float)Lc);
  if (NSEQ >= 2) {
    fft_dif<LOGN, 2>(buf);
    spectrum_extract<LOGN, 2>(buf, GS, GS1, sc0, sc1);
  } else {
    fft_dif<LOGN, 1>(buf);
    spectrum_extract<LOGN, 1>(buf, GS, GS, sc0, sc0);
    __syncthreads();
    for (int t = tid; t < L; t += NT) buf[swz(t)] = ((const float2*)G1tmp)[t];
    __syncthreads();
    fft_dif<LOGN, 1>(buf);
    spectrum_extract<LOGN, 1>(buf, GS1, GS1, sc1, sc1);
  }
  __threadfence_block();
  __syncthreads();
  const float* sw = p.in[I_HSW] + (size_t)i * 3 * 3072;
  const float* sbias = p.in[I_HSB] + (size_t)i * 3072;
  float cw[3][3], cb[3];
#pragma unroll
  for (int st = 0; st < 3; ++st) {
#pragma unroll
    for (int k = 0; k < 3; ++k) cw[st][k] = sw[k * 3072 + st * 1024 + c];
    cb[st] = sbias[st * 1024 + c];
  }
  const float fb0 = p.in[I_FBIAS][((size_t)i * 2 + 0) * 1024 + c], fb1 = p.in[I_FBIAS][((size_t)i * 2 + 1) * 1024 + c];
  auto conv8 = [&](const ushort_t* sp, int st, int t0, float* y) {
    const uint4 v = *(const uint4*)(sp + t0);
    const float xm = t0 > 0 ? bf2f(sp[t0 - 1]) : 0.f, xn = t0 + 8 < L ? bf2f(sp[t0 + 8]) : 0.f;
    const float x[10] = {xm, __uint_as_float(v.x << 16), __uint_as_float(v.x & 0xffff0000u), __uint_as_float(v.y << 16), __uint_as_float(v.y & 0xffff0000u),
                         __uint_as_float(v.z << 16), __uint_as_float(v.z & 0xffff0000u), __uint_as_float(v.w << 16), __uint_as_float(v.w & 0xffff0000u), xn};
#pragma unroll
    for (int j = 0; j < 8; ++j) y[j] = cw[st][0] * x[j] + cw[st][1] * x[j + 1] + cw[st][2] * x[j + 2] + cb[st];
  };
  for (int b0 = 0; b0 < NB; b0 += NSEQ) {
    __syncthreads();
    for (int w = tid; w < NSEQ * (L / 8); w += NT) {
      const int sq = w >> LOG8, t0 = (w & (L / 8 - 1)) * 8;
      const int s0 = (LOGN == 14) ? (TPROMPT + (b0 + sq) * 16384) : ((b0 + sq) * 4096);
      const ushort_t* pv = PH + (size_t)s0 * 1024 + (size_t)c * L;
      float y[8]; conv8(pv, 0, t0, y);
#pragma unroll
      for (int j = 0; j < 4; ++j) { buf[sq * Lc + swz((t0 >> 1) + j)] = float2{y[2 * j], y[2 * j + 1]}; buf[sq * Lc + swz(L / 2 + (t0 >> 1) + j)] = float2{0.f, 0.f}; }
    }
    __syncthreads();
    fft_dif<LOGN, NSEQ>(buf);
    spectrum_mul<LOGN, NSEQ>(buf, GS);
    __syncthreads();
    fft_dit_inv<LOGN, NSEQ>(buf);
    for (int w = tid; w < NSEQ * (L / 8); w += NT) {
      const int sq = w >> LOG8, t0 = (w & (L / 8 - 1)) * 8;
      const int s0 = (LOGN == 14) ? (TPROMPT + (b0 + sq) * 16384) : ((b0 + sq) * 4096);
      const ushort_t* pv = PH + (size_t)s0 * 1024 + (size_t)c * L;
      const ushort_t* px1 = pv + (size_t)T * 1024;
      float z0[8], xa[8]; conv8(pv, 0, t0, z0); conv8(px1, 1, t0, xa);
      float z1[8];
#pragma unroll
      for (int j = 0; j < 4; ++j) {
        const int e = sq * Lc + swz((t0 >> 1) + j);
        const float2 zc = buf[e];
        z1[2 * j] = xa[2 * j] * (zc.x + z0[2 * j] * fb0); z1[2 * j + 1] = xa[2 * j + 1] * (zc.y + z0[2 * j + 1] * fb0);
        buf[e] = float2{z1[2 * j], z1[2 * j + 1]};
        buf[sq * Lc + swz(L / 2 + (t0 >> 1) + j)] = float2{0.f, 0.f};
      }
      *(float4*)(Z1 + sq * L + t0) = float4{z1[0], z1[1], z1[2], z1[3]};
      *(float4*)(Z1 + sq * L + t0 + 4) = float4{z1[4], z1[5], z1[6], z1[7]};
    }
    __syncthreads();
    fft_dif<LOGN, NSEQ>(buf);
    spectrum_mul<LOGN, NSEQ>(buf, GS1);
    __syncthreads();
    fft_dit_inv<LOGN, NSEQ>(buf);
    for (int w = tid; w < NSEQ * (L / 8); w += NT) {
      const int sq = w >> LOG8, t0 = (w & (L / 8 - 1)) * 8;
      const int s0 = (LOGN == 14) ? (TPROMPT + (b0 + sq) * 16384) : ((b0 + sq) * 4096);
      const ushort_t* px2 = PH + (size_t)s0 * 1024 + (size_t)c * L + (size_t)2 * T * 1024;
      ushort_t* pg = (ushort_t*)px2 + (size_t)T * 1024;
      float xb[8]; conv8(px2, 2, t0, xb);
      const float4 za = *(const float4*)(Z1 + sq * L + t0), zb = *(const float4*)(Z1 + sq * L + t0 + 4);
      const float z1[8] = {za.x, za.y, za.z, za.w, zb.x, zb.y, zb.z, zb.w};
      const uint4 gv = *(const uint4*)(pg + t0);
      const unsigned gw[4] = {gv.x, gv.y, gv.z, gv.w};
      unsigned o[4];
#pragma unroll
      for (int j = 0; j < 4; ++j) {
        const float2 zc = buf[sq * Lc + swz((t0 >> 1) + j)];
        const float g0 = __uint_as_float(gw[j] << 16), g1 = __uint_as_float(gw[j] & 0xffff0000u);
        const float y0 = xb[2 * j] * (zc.x + z1[2 * j] * fb1) * (g0 * fast_sigmoid(g0));
        const float y1 = xb[2 * j + 1] * (zc.y + z1[2 * j + 1] * fb1) * (g1 * fast_sigmoid(g1));
        o[j] = pack2(y0, y1);
      }
      if (!dry) *(uint4*)(pg + t0) = uint4{o[0], o[1], o[2], o[3]};
    }
  }
}

__device__ void hy_conv_phase(const Params& p, int i, unsigned char* lds, bool dry = false) {
  for (int it = bidx(); it < 2048; it += gridDim.x) {
    if (it < 1024) hy_conv_item<14>(p, i, it, lds, dry);
    else hy_conv_item<12>(p, i, it - 1024, lds, dry);
    __syncthreads();
  }
}

__device__ void prep_even(const Params& p, int i, unsigned char* lds) {
  ushort_t* WB = (ushort_t*)(p.ws + OFF_WB);
  ushort_t* WinT = WB; ushort_t* WoutT = WB + 3328 * 1024; ushort_t* GluT = WoutT + 1024 * 1024;
  transpose_bf16(p.in[I_EWIN] + (size_t)i * 1024 * 3136, WinT, 1024, 3136, lds);
  zero_fill(WinT + 3136 * 1024, 192 * 1024);
  transpose_bf16(p.in[I_EWOUT] + (size_t)i * 1024 * 1024, WoutT, 1024, 1024, lds);
  transpose_bf16(p.in[I_GLUW] + (size_t)i * 512 * 512, GluT, 512, 512, lds);
}
__device__ void prep_odd(const Params& p, int i, unsigned char* lds) {
  ushort_t* WB = (ushort_t*)(p.ws + OFF_WB);
  transpose_bf16(p.in[I_HWIN] + (size_t)i * 1024 * 4096, WB, 1024, 4096, lds);
  transpose_bf16(p.in[I_HWOUT] + (size_t)i * 1024 * 1024, WB + 4096 * 1024, 1024, 1024, lds);
  hy_filter_mlp(p, i);
}
#ifndef PROBE_MASK
#define PROBE_MASK 0
#endif
#ifndef PH_MASK
#define PH_MASK 0x1ffff
#endif
#define PHM(n) ((PH_MASK >> (n)) & 1)
DEVI void run_phase(const Params& p, int ph, unsigned char* lds, bool dry = false) {
  const int layer = ph < NPH_EVEN ? 0 : ph < NPH_EVEN + NPH_ODD ? 1 : ph < 2 * NPH_EVEN + NPH_ODD ? 2 : 3;
  const int base = layer == 0 ? 0 : layer == 1 ? NPH_EVEN : layer == 2 ? NPH_EVEN + NPH_ODD : 2 * NPH_EVEN + NPH_ODD;
  const int sp = ph - base, i = layer >> 1;
  unsigned char* ws = p.ws;
  ushort_t* WB = (ushort_t*)(ws + OFF_WB);
  if ((layer & 1) == 0) {
    ushort_t* WinT = WB; ushort_t* WoutT = WB + 3328 * 1024; ushort_t* GluT = WoutT + 1024 * 1024;
    switch (sp) {
      case 0: if (PHM(0)) {
        prep_even(p, 0, lds);
        xb_convert(p, (ushort_t*)(ws + OFF_Y));
        } break;
      case 1: if (PHM(1)) run_gemm(lds, (const ushort_t*)(ws + OFF_Y), 1024, WinT, 3328, 1024, pg8::EpiEvenIn{(ushort_t*)(ws + OFF_PS5), (ushort_t*)(ws + OFF_PRW)}); break;
      case 2: if (PHM(2)) s5_passA(p, i, lds); break;
      case 3: if (PHM(3)) s5_passC(p, i, lds); break;
      case 4: if (PHM(4)) run_gemm(lds, (const ushort_t*)(ws + OFF_Y) + 512, 1024, GluT, 512, 512, pg8::EpiGlu{(ushort_t*)(ws + OFF_Y), (const ushort_t*)(ws + OFF_PS5), p.in[I_GLUB] + i * 512}); break;
      case 5: if (PHM(5)) rwkv_scan1(p, i, lds); break;
      case 6: if (PHM(6)) rwkv_carry(p, lds, dry); break;
      case 7: if (PHM(7)) rwkv_scan3(p, i, lds, dry); break;
      case 8: if (PHM(8)) rwkv_post(p, i); break;
      case 9: if (PHM(9)) run_gemm(lds, (const ushort_t*)(ws + OFF_Y), 1024, WoutT, 1024, 1024, pg8::EpiF16{(ushort_t*)(ws + OFF_PRW)}); break;
      case 10: if (PHM(10)) { if (!dry) prep_odd(p, i, lds); ln_phase(p, layer, (const ushort_t*)(ws + OFF_PRW), (ushort_t*)(ws + OFF_XB_ODD), dry); } break;
    }
  } else {
    ushort_t* HinT = WB; ushort_t* HoutT = WB + 4096 * 1024;
    switch (sp) {
      case 0: break;
      case 1: if (PHM(12)) run_gemm(lds, (const ushort_t*)(ws + OFF_XB_ODD), 1024, HinT, 4096, 1024, pg8::EpiHyIn{(ushort_t*)(ws + OFF_PH)}); break;
      case 2: if (PHM(13)) hy_conv_phase(p, i, lds, dry); break;
      case 3: if (PHM(14)) hy_transpose((const ushort_t*)(ws + OFF_PH + 3 * SZ1), (ushort_t*)(ws + OFF_PH), lds); break;
      case 4: if (PHM(15)) run_gemm(lds, (const ushort_t*)(ws + OFF_PH), 1024, HoutT, 1024, 1024, pg8::EpiF16{(ushort_t*)(ws + OFF_PH + SZ1)}); break;
      case 5: if (PHM(16)) { if (!dry && layer < 3) prep_even(p, i + 1, lds); ln_phase(p, layer, (const ushort_t*)(ws + OFF_PH + SZ1), layer < 3 ? (ushort_t*)(ws + OFF_Y) : (ushort_t*)nullptr, dry); } break;
    }
  }
}

#define LAS __attribute__((address_space(3)))
#define XB_TMO      128
#define XB_XCNT(j)  (256  + 64 * (j))
#define XB_XSUB(j)  (1280 + 64 * (j))
#define XB_XGEN(j)  (2304 + 64 * (j))
#define XB_TOP      3328
#define XB_TOPGEN   3392
#define XCD_BAR_WORDS 3456
#define XB_SPIN_CAP (1u << 18)
#define LAS __attribute__((address_space(3)))

__device__ __forceinline__ unsigned xb_ld(unsigned* p)              { return __hip_atomic_load(p, __ATOMIC_RELAXED, __HIP_MEMORY_SCOPE_AGENT); }
__device__ __forceinline__ unsigned xb_add(unsigned* p, unsigned v) { return __hip_atomic_fetch_add(p, v, __ATOMIC_RELAXED, __HIP_MEMORY_SCOPE_AGENT); }
__device__ __forceinline__ unsigned xb_xcc_id() { return (unsigned)__builtin_amdgcn_s_getreg((3 << 11) | 20) & 0xFu; }
#define XB_SPIN(cond, bar) do { unsigned _sp = 0; while (cond) { __builtin_amdgcn_s_sleep(1); \
    if ((++_sp & 255u) == 0u) { if (xb_ld(&(bar)[XB_TMO])) break; if (_sp > XB_SPIN_CAP) { atomicAdd(&(bar)[XB_TMO], 1u); break; } } } } while (0)

struct XcdBarrier {
    unsigned* bar; unsigned x;
    volatile LAS unsigned* st;
};

__device__ __forceinline__ XcdBarrier xcd_barrier_post(unsigned* bar, volatile LAS unsigned* st) {
    XcdBarrier b; b.bar = bar; b.x = xb_xcc_id(); b.st = st;
    if (threadIdx.x == 0) (void)xb_add(&bar[XB_XCNT(b.x)], 1u);
    return b;
}
__device__ __forceinline__ void xcd_barrier_complete(unsigned* bar, unsigned x, unsigned& nloc, unsigned& nx) {
    const unsigned G = gridDim.x * gridDim.y * gridDim.z;
    unsigned sum, cnt, mine, sp = 0u;
    for (;;) {
        sum = 0u; cnt = 0u; mine = 0u;
#pragma unroll
        for (unsigned j = 0; j < 16; ++j) { const unsigned c = xb_ld(&bar[XB_XCNT(j)]); sum += c; cnt += (c > 0u) ? 1u : 0u; mine = (j == x) ? c : mine; }
        if (sum == G) break;
        __builtin_amdgcn_s_sleep(1);
        if ((++sp & 255u) == 0u) { if (xb_ld(&bar[XB_TMO])) break; if (sp > XB_SPIN_CAP) { atomicAdd(&bar[XB_TMO], 1u); break; } }
    }
    nloc = mine > 0u ? mine : 1u; nx = cnt > 0u ? cnt : 1u;
}

__device__ __forceinline__ void xcd_barrier(const XcdBarrier& b) {
    asm volatile("s_waitcnt vmcnt(0)" ::: "memory");
    __syncthreads();
    if (threadIdx.x == 0) {
        unsigned* bar = b.bar;
        __builtin_amdgcn_s_waitcnt(0);
        unsigned nloc = b.st[0], nx = b.st[1];
        if (nloc == 0u) { xcd_barrier_complete(bar, b.x, nloc, nx); b.st[0] = nloc; b.st[1] = nx; }
        const unsigned old = xb_add(&bar[XB_XSUB(b.x)], 1u);
        const unsigned gen = old / nloc;
        if (old + 1u == (gen + 1u) * nloc) {
            __builtin_amdgcn_fence(__ATOMIC_RELEASE, "agent");
            asm volatile("s_waitcnt vmcnt(0)" ::: "memory");
            const unsigned og = xb_add(&bar[XB_TOP], 1u);
            const unsigned tg = og / nx;
            if (og + 1u == (tg + 1u) * nx) xb_add(&bar[XB_TOPGEN], 1u);
            else XB_SPIN(xb_ld(&bar[XB_TOPGEN]) == tg, bar);
            __builtin_amdgcn_fence(__ATOMIC_ACQUIRE, "agent");
            xb_add(&bar[XB_XGEN(b.x)], 1u);
            asm volatile("s_waitcnt vmcnt(0)" ::: "memory");
        } else {
            XB_SPIN(xb_ld(&bar[XB_XGEN(b.x)]) == gen, bar);
            __builtin_amdgcn_fence(__ATOMIC_ACQUIRE, "agent");
            asm volatile("s_waitcnt vmcnt(0)" ::: "memory");
        }
    }
    __syncthreads();
}


#if ONE_LAUNCH
__global__ void __launch_bounds__(NT) fwd_kernel(Params p) {
  extern __shared__ __attribute__((aligned(16))) unsigned char lds[];
#if ONE_LAUNCH
  cg::grid_group grid = cg::this_grid();
#endif
#if ONE_LAUNCH
  volatile LAS unsigned* xb_st = (volatile LAS unsigned*)(lds + LDS_BYTES - 16);
  if (threadIdx.x < 2) xb_st[threadIdx.x] = 0u;
  __syncthreads();
  const XcdBarrier xb = xcd_barrier_post((unsigned*)(p.ws + OFF_BAR), xb_st);
#endif
  for (int ph = p.ph_lo; ph < p.ph_hi; ++ph) {
    if (ph == NPH_EVEN || ph == NPH_EVEN + NPH_ODD || ph == 2 * NPH_EVEN + NPH_ODD) continue;
    int reps = 1;
#if PROBE_MASK
    {
      const int lyr = ph < NPH_EVEN ? 0 : ph < NPH_EVEN + NPH_ODD ? 1 : ph < 2 * NPH_EVEN + NPH_ODD ? 2 : 3;
      const int bs = lyr == 0 ? 0 : lyr == 1 ? NPH_EVEN : lyr == 2 ? NPH_EVEN + NPH_ODD : 2 * NPH_EVEN + NPH_ODD;
      const int idx = (lyr & 1) ? NPH_EVEN + (ph - bs) : (ph - bs);
      if ((PROBE_MASK >> idx) & 1) reps = 2;
    }
#endif
    for (int rep = 0; rep < reps; ++rep) {
      run_phase(p, ph, lds, rep + 1 < reps);
#if ONE_LAUNCH
      if (ph + 1 < p.ph_hi || rep + 1 < reps) { if (ph == p.ph_lo && rep == 0) grid.sync(); else xcd_barrier(xb); }
#endif
    }
  }
}
#endif

#if !ONE_LAUNCH
template <int PH> __global__ void __launch_bounds__(NT) phase_kernel(Params p) {
  extern __shared__ __attribute__((aligned(16))) unsigned char lds[];
  run_phase(p, PH, lds);
}
typedef void (*kfn_t)(Params);
#define PK(n) phase_kernel<n>
static kfn_t k_tab[NPHASES] = {PK(0), PK(1), PK(2), PK(3), PK(4), PK(5), PK(6), PK(7), PK(8), PK(9), PK(10), PK(11), PK(12), PK(13), PK(14), PK(15),
                               PK(16), PK(17), PK(18), PK(19), PK(20), PK(21), PK(22), PK(23), PK(24), PK(25), PK(26), PK(27), PK(28), PK(29), PK(30), PK(31), PK(32), PK(33)};
#endif

extern "C" void kernel_launch(void* const* d_in, const int* in_sizes, int n_in, void* d_out, int out_size, void* d_ws, size_t ws_size,
                              hipStream_t stream) {
  static int grid_blocks = 0;
  if (!grid_blocks) {
    if (n_in != 38 || ws_size < WS_NEED || out_size != T * 1024) {
      fprintf(stderr, "kernel_launch: unexpected shapes n_in=%d ws=%zu out=%d\n", n_in, ws_size, out_size);
      grid_blocks = -1; return;
    }
    int dev = 0, cus = 0, per_cu = 0;
    (void)hipGetDevice(&dev);
    (void)hipDeviceGetAttribute(&cus, hipDeviceAttributeMultiprocessorCount, dev);
#if ONE_LAUNCH
    if (hipFuncSetAttribute((const void*)fwd_kernel, hipFuncAttributeMaxDynamicSharedMemorySize, LDS_BYTES) != hipSuccess) {
      fprintf(stderr, "kernel_launch: hipFuncSetAttribute failed\n"); grid_blocks = -1; return;
    }
    (void)hipOccupancyMaxActiveBlocksPerMultiprocessor(&per_cu, (const void*)fwd_kernel, NT, LDS_BYTES);
#else
    for (int ph = 0; ph < NPHASES; ++ph)
      if (hipFuncSetAttribute((const void*)k_tab[ph], hipFuncAttributeMaxDynamicSharedMemorySize, LDS_BYTES) != hipSuccess) {
        fprintf(stderr, "kernel_launch: hipFuncSetAttribute failed\n"); grid_blocks = -1; return;
      }
    per_cu = 1;
#endif
    if (per_cu < 1) { fprintf(stderr, "kernel_launch: occupancy query returned %d\n", per_cu); per_cu = 1; }
    grid_blocks = cus * per_cu;
    if (grid_blocks > 256) grid_blocks = 256;
    if (grid_blocks < 1) grid_blocks = 256;
  }
  if (grid_blocks < 0) return;
  Params p{};
  for (int k = 0; k < 38; ++k) p.in[k] = (const float*)d_in[k];
  p.out = (float*)d_out; p.ws = (unsigned char*)d_ws;
#if ONE_LAUNCH
  if (hipMemsetAsync((unsigned char*)d_ws + OFF_BAR, 0, 16384, stream) != hipSuccess) { fprintf(stderr, "kernel_launch: memset of barrier words failed\n"); return; }
  p.ph_lo = 0; p.ph_hi = NPHASES;
  void* args[] = {&p};
  hipError_t e = hipLaunchCooperativeKernel((const void*)fwd_kernel, dim3(grid_blocks), dim3(NT), args, LDS_BYTES, stream);
  if (e != hipSuccess) fprintf(stderr, "cooperative launch failed: %s (grid %d)\n", hipGetErrorString(e), grid_blocks);
#else
  for (int ph = 0; ph < NPHASES; ++ph) {
    p.ph_lo = ph; p.ph_hi = ph + 1;
    hipLaunchKernelGGL(k_tab[ph], dim3(grid_blocks), dim3(NT), LDS_BYTES, stream, p);
  }
#endif
}
```

```cpp
#include <hip/hip_runtime.h>
#include <hip/hip_cooperative_groups.h>
#include <cstdio>
#include <cstdint>
namespace cg = cooperative_groups;

#ifndef ONE_LAUNCH
#define ONE_LAUNCH 1
#endif

#define DEVI __device__ __forceinline__
constexpr int NT = 512;
constexpr int T = 49152;
constexpr int TPROMPT = 16384;
constexpr int LDS_BYTES = 133120;
constexpr int NPH_EVEN = 11, NPH_ODD = 6;
constexpr int NPHASES = 2 * (NPH_EVEN + NPH_ODD);

typedef __attribute__((ext_vector_type(8))) short bf16x8;
typedef __attribute__((ext_vector_type(4))) float f32x4;
typedef unsigned short ushort_t;
typedef float f32x2 __attribute__((ext_vector_type(2)));

struct Params { const float* in[38]; float* out; unsigned char* ws; int ph_lo; int ph_hi; };

enum { I_XP = 0, I_XS, I_EWIN, I_EWOUT, I_LRE, I_LIM, I_LSTEP, I_BRE, I_BIM, I_CRE, I_CIM, I_S5D, I_GLUW, I_GLUB,
       I_MURKV, I_MULORA, I_W0, I_WUP, I_A0, I_AUP, I_KK, I_KA, I_RK, I_LNXW, I_LNXB,
       I_HWIN, I_HWOUT, I_HSW, I_HSB, I_FW1, I_FB1, I_FFREQ, I_FW2, I_FB2, I_FW3, I_FBIAS, I_LNG, I_LNB };

constexpr size_t SZ1 = (size_t)T * 1024 * 2;
constexpr size_t OFF_PS5 = 0;
constexpr size_t OFF_PRW = OFF_PS5 + SZ1;
constexpr size_t OFF_Y = OFF_PRW + (size_t)T * 2112 * 2;
constexpr size_t OFF_YS = OFF_Y + SZ1;
constexpr size_t OFF_WB = OFF_YS + SZ1;
constexpr size_t OFF_CAR = OFF_WB + 10485760;
constexpr size_t OFF_BAR = OFF_CAR + 6291456;
constexpr size_t WS_NEED = OFF_BAR + 16384;
constexpr size_t OFF_PH = 0;
constexpr size_t OFF_GS = 4 * SZ1;
constexpr size_t GS_PER = 131328;
constexpr size_t OFF_Z1 = OFF_GS + 256 * 2 * GS_PER;
constexpr size_t OFF_XB_ODD = 4 * SZ1;
constexpr size_t OFF_H2 = OFF_XB_ODD + SZ1;

DEVI int tidx() { int t = threadIdx.x; asm volatile("" : "+v"(t)); return t; }
DEVI int bidx() { int b = blockIdx.x; asm volatile("" : "+r"(b)); return __builtin_amdgcn_readfirstlane(b); }
DEVI ushort_t f2bf(float f) { unsigned u = __float_as_uint(f); u += 0x7fffu + ((u >> 16) & 1u); return (ushort_t)(u >> 16); }
DEVI float bf2f(ushort_t h) { return __uint_as_float(((unsigned)h) << 16); }
DEVI unsigned pack2(float a, float b) { return (unsigned)f2bf(a) | ((unsigned)f2bf(b) << 16); }
DEVI float wsum(float v) {
#pragma unroll
  for (int m = 32; m >= 1; m >>= 1) v += __shfl_xor(v, m);
  return v;
}
DEVI void wave_sync() { __builtin_amdgcn_fence(__ATOMIC_RELEASE, "wavefront"); __builtin_amdgcn_wave_barrier(); __builtin_amdgcn_fence(__ATOMIC_ACQUIRE, "wavefront"); }
DEVI void wave_sync_lds() { asm volatile("" ::: "memory"); __builtin_amdgcn_wave_barrier(); asm volatile("" ::: "memory"); }
DEVI void block_sync_lds() { asm volatile("s_waitcnt lgkmcnt(0)" ::: "memory"); __builtin_amdgcn_s_barrier(); asm volatile("" ::: "memory"); }
DEVI void seq_of(int tok, int& s0, int& L) {
  if (tok < TPROMPT) { s0 = tok & ~4095; L = 4096; } else { s0 = TPROMPT + ((tok - TPROMPT) & ~16383); L = 16384; }
}
struct XSrc { const float* xp; const float* xs; const float* xo; };
DEVI XSrc xsrc(const Params& p) {
  XSrc x; x.xp = p.in[I_XP]; x.xs = p.in[I_XS]; x.xo = p.out;
  asm volatile("" : "+r"(x.xp), "+r"(x.xs), "+r"(x.xo));
  return x;
}
DEVI const float* xrow(const XSrc& x, int layer, int tok) {
  if (layer == 0) return tok < TPROMPT ? x.xp + (size_t)tok * 1024 : x.xs + (size_t)(tok - TPROMPT) * 1024;
  return x.xo + (size_t)tok * 1024;
}
DEVI float sigmoidf_(float x) { return 1.f / (1.f + expf(-x)); }
DEVI float fast_sigmoid(float x) { return __builtin_amdgcn_rcpf(1.f + __builtin_amdgcn_exp2f(-1.4426950408889634f * x)); }
DEVI float fast_tanh(float x) { return 1.f - 2.f * __builtin_amdgcn_rcpf(1.f + __builtin_amdgcn_exp2f(2.8853900817779268f * x)); }
DEVI float dpp_mov_f(float x, const int sel) {
  int xi = __builtin_bit_cast(int, x), r;
  if (sel == 0) r = __builtin_amdgcn_mov_dpp(xi, 0xB1, 0xf, 0xf, true);
  else if (sel == 1) r = __builtin_amdgcn_mov_dpp(xi, 0x4E, 0xf, 0xf, true);
  else if (sel == 2) r = __builtin_amdgcn_mov_dpp(xi, 0x141, 0xf, 0xf, true);
  else r = __builtin_amdgcn_mov_dpp(xi, 0x140, 0xf, 0xf, true);
  return __builtin_bit_cast(float, r);
}
DEVI float wsum_fast(float v) {
  v += dpp_mov_f(v, 0); v += dpp_mov_f(v, 1); v += dpp_mov_f(v, 2); v += dpp_mov_f(v, 3);
  const int vi = __builtin_bit_cast(int, v);
  return __builtin_bit_cast(float, __builtin_amdgcn_readlane(vi, 0)) + __builtin_bit_cast(float, __builtin_amdgcn_readlane(vi, 16)) +
         __builtin_bit_cast(float, __builtin_amdgcn_readlane(vi, 32)) + __builtin_bit_cast(float, __builtin_amdgcn_readlane(vi, 48));
}
DEVI float gelu_tanh(float x) { return 0.5f * x * (1.f + tanhf(0.7978845608f * (x + 0.044715f * x * x * x))); }

__device__ void transpose_bf16(const float* __restrict__ in, ushort_t* __restrict__ out, int K, int N, unsigned char* lds) {
  float* tile = (float*)lds;
  const int tid = tidx(), j = tid & 63, i0 = tid >> 6;
  const int tk = K / 64, tn = N / 64;
  for (int t = bidx(); t < tk * tn; t += gridDim.x) {
    const int k0 = (t / tn) * 64, n0 = (t % tn) * 64;
#pragma unroll
    for (int e = 0; e < 8; ++e) { int i = i0 + 8 * e; tile[i * 65 + j] = in[(size_t)(k0 + i) * N + n0 + j]; }
    __syncthreads();
#pragma unroll
    for (int e = 0; e < 8; ++e) { int i = i0 + 8 * e; out[(size_t)(n0 + i) * K + k0 + j] = f2bf(tile[j * 65 + i]); }
    __syncthreads();
  }
}

namespace pg8 {
#define PG8_LAS __attribute__((address_space(3)))
typedef unsigned u32x4 __attribute__((ext_vector_type(4)));
constexpr int BM = 256, BK = 64, HALF = 128, HTB = HALF * BK * 2, STAGE_BYTES = 8 * HTB, NXCD = 8, WGM = 8;
DEVI int lds_byte(int r, int c) { const int st = (r >> 4) * 2 + (c >> 5), rr = r & 15, cc = c & 31, ob = rr * 64 + cc * 2; return st * 1024 + (ob ^ (((ob >> 9) & 1) << 5)); }
DEVI void stage_rc(int b, int& R, int& C) { const int st = b / 1024, sb = b % 1024, swz = sb ^ (((sb >> 9) & 1) << 5); R = (st >> 1) * 16 + swz / 64; C = (st & 1) * 32 + (swz % 64) / 2; }
DEVI int perm32(int rho) { const int n = rho >> 4, i = rho & 15; return 8 * (i >> 2) + 4 * n + (i & 3); }
struct Unit { int pm, pn; };
struct Gemm { const ushort_t* A; const ushort_t* Bt; int M, N, K, lda; };
struct StaticOrder {
  int nM, nN, nwg, G, c;
  DEVI void init(int M, int N, int G_, int c_) { nM = M / BM; nN = N / BM; nwg = nM * nN; G = G_; c = c_; }
  DEVI bool next(int i, Unit& u) const {
    const long L = (long)i * G + c; if (L >= nwg) return false;
    int wgid = (int)L; { const int q = nwg / NXCD, r = nwg % NXCD, xcd = wgid % NXCD, off = wgid / NXCD; wgid = (xcd < r ? xcd * (q + 1) : r * (q + 1) + (xcd - r) * q) + off; }
    const int nig = WGM * nN, gid = wgid / nig, fm = gid * WGM, gsz = (nM - fm) < WGM ? (nM - fm) : WGM;
    u.pm = fm + ((wgid % nig) % gsz); u.pn = (wgid % nig) / gsz; return true;
  }
};
DEVI unsigned cvt_pk_bf16(float lo, float hi) { unsigned r; asm volatile("v_cvt_pk_bf16_f32 %0, %1, %2" : "=v"(r) : "v"(lo), "v"(hi)); return r; }

template <class Epi>
DEVI void gemm_phase(PG8_LAS unsigned char* lds, const Gemm g, const StaticOrder& S, const Epi& E) {
  const int tid = tidx(), wid = __builtin_amdgcn_readfirstlane(tid >> 6), lane = tid & 63, wr = wid >> 2, wc = wid & 3, fr = lane & 15, fq = lane >> 4;
  const int K = g.K, nt = K / BK, lda = g.lda;
  unsigned voffA[2], voffB[2];
#pragma unroll
  for (int i = 0; i < 2; ++i) { int R, C; stage_rc(tid * 16 + i * 8192, R, C); const int Rb = Epi::PERM ? ((R & ~31) + perm32(R & 31)) : R;
    voffA[i] = (unsigned)(R * lda + C) * 2u; voffB[i] = (unsigned)(Rb * K + C) * 2u; }
  const size_t kstep = (size_t)(BK * 2);
  const size_t hstepA = (size_t)HALF * lda * 2, hstepB = (size_t)HALF * K * 2;
  const size_t tstepA = 2 * hstepA, tstepB = 2 * hstepB;
  const unsigned ldsw = (unsigned)wid * 1024u;
  const int aoff = lds_byte(wr * 64 + fr, fq * 8), boff = lds_byte(wc * 32 + fr, fq * 8);
#define PG8_SA(b, h) (((b) * 2 + (h)) * HTB)
#define PG8_SB(b, h) ((4 + (b) * 2 + (h)) * HTB)
#define PG8_STAGE(bufoff, gbase, voff) do { _Pragma("unroll") for (int _i = 0; _i < 2; ++_i) \
    __builtin_amdgcn_global_load_lds((const unsigned*)((const char*)(gbase) + (voff)[_i]), (PG8_LAS unsigned*)(lds + (bufoff) + ldsw + _i * 8192), 16, 0, 0); } while (0)
#define PG8_LDA(dst, b, h) do { _Pragma("unroll") for (int m = 0; m < 4; ++m) _Pragma("unroll") for (int k = 0; k < 2; ++k) dst[m][k] = *(const PG8_LAS bf16x8*)(lds + PG8_SA(b, h) + aoff + m * 2048 + k * 1024); } while (0)
#define PG8_LDB(dst, b, h) do { _Pragma("unroll") for (int n = 0; n < 2; ++n) _Pragma("unroll") for (int k = 0; k < 2; ++k) dst[n][k] = *(const PG8_LAS bf16x8*)(lds + PG8_SB(b, h) + boff + n * 2048 + k * 1024); } while (0)
#define PG8_MMA(ai, bj, At, Bt) do { __builtin_amdgcn_s_setprio(1); _Pragma("unroll") for (int m = 0; m < 4; ++m) _Pragma("unroll") for (int n = 0; n < 2; ++n) _Pragma("unroll") for (int k = 0; k < 2; ++k) \
    acc[ai][bj][m][n] = Epi::TRANS ? __builtin_amdgcn_mfma_f32_16x16x32_bf16(Bt[n][k], At[m][k], acc[ai][bj][m][n], 0, 0, 0) \
                                   : __builtin_amdgcn_mfma_f32_16x16x32_bf16(At[m][k], Bt[n][k], acc[ai][bj][m][n], 0, 0, 0); __builtin_amdgcn_s_setprio(0); } while (0)
#define PG8_WAIT_V(n) asm volatile("s_waitcnt vmcnt(" #n ")" ::: "memory")
#define PG8_WAIT_L(n) asm volatile("s_waitcnt lgkmcnt(" #n ")" ::: "memory")
#define PG8_BAR __builtin_amdgcn_s_barrier()
#define PG8_SCHED __builtin_amdgcn_sched_barrier(0)
  Unit cur, nxt; int ui = 0;
  if (!S.next(0, cur)) return;
  f32x4 acc[2][2][4][2];
#pragma unroll
  for (int a = 0; a < 2; ++a)
#pragma unroll
    for (int b = 0; b < 2; ++b)
#pragma unroll
      for (int m = 0; m < 4; ++m)
#pragma unroll
        for (int n = 0; n < 2; ++n) acc[a][b][m][n] = (f32x4){0.f, 0.f, 0.f, 0.f};
  bf16x8 At[4][2], B0[2][2], B1[2][2];
  const char* cA = (const char*)g.A + (size_t)cur.pm * tstepA; const char* cB = (const char*)g.Bt + (size_t)cur.pn * tstepB;
  PG8_STAGE(PG8_SB(0, 0), cB, voffB); PG8_STAGE(PG8_SA(0, 0), cA, voffA); PG8_STAGE(PG8_SB(0, 1), cB + hstepB, voffB); PG8_STAGE(PG8_SA(0, 1), cA + hstepA, voffA);
  if (wr == 1) PG8_BAR;
  PG8_WAIT_V(4); PG8_BAR;
  PG8_STAGE(PG8_SB(1, 0), cB + kstep, voffB); PG8_STAGE(PG8_SA(1, 0), cA + kstep, voffA); PG8_STAGE(PG8_SB(1, 1), cB + hstepB + kstep, voffB);
  PG8_WAIT_V(6); PG8_BAR;
  for (;;) {
    const bool has_next = S.next(ui + 1, nxt);
    const char* nA = has_next ? (const char*)g.A + (size_t)nxt.pm * tstepA : cA; const char* nB = has_next ? (const char*)g.Bt + (size_t)nxt.pn * tstepB : cB;
    for (int t = 0; t < nt; t += 2) {
      const bool last = (t == nt - 2);
      const char* a1 = cA + (size_t)(t + 1) * kstep;
      const char* a2 = last ? nA : cA + (size_t)(t + 2) * kstep; const char* b2 = last ? nB : cB + (size_t)(t + 2) * kstep;
      const char* a3 = a2 + kstep; const char* b3 = b2 + kstep;
      PG8_LDB(B0, 0, 0); PG8_SCHED; PG8_LDA(At, 0, 0); PG8_STAGE(PG8_SA(1, 1), a1 + hstepA, voffA);
      PG8_WAIT_L(8); PG8_BAR; PG8_WAIT_L(0); PG8_MMA(0, 0, At, B0); PG8_BAR; PG8_SCHED;
      PG8_LDB(B1, 0, 1); PG8_STAGE(PG8_SB(0, 0), b2, voffB);
      PG8_BAR; PG8_WAIT_L(0); PG8_MMA(0, 1, At, B1); PG8_BAR;
      PG8_LDA(At, 0, 1); PG8_STAGE(PG8_SA(0, 0), a2, voffA);
      PG8_BAR; PG8_WAIT_L(0); PG8_MMA(1, 0, At, B0); PG8_BAR; PG8_SCHED;
      PG8_STAGE(PG8_SB(0, 1), b2 + hstepB, voffB);
      PG8_WAIT_V(6); PG8_BAR; PG8_MMA(1, 1, At, B1); PG8_BAR;
      PG8_LDB(B0, 1, 0); PG8_SCHED; PG8_LDA(At, 1, 0); PG8_STAGE(PG8_SA(0, 1), a2 + hstepA, voffA);
      PG8_WAIT_L(8); PG8_BAR; PG8_WAIT_L(0); PG8_MMA(0, 0, At, B0); PG8_BAR; PG8_SCHED;
      PG8_LDB(B1, 1, 1); PG8_STAGE(PG8_SB(1, 0), b3, voffB);
      PG8_BAR; PG8_WAIT_L(0); PG8_MMA(0, 1, At, B1); PG8_BAR;
      PG8_LDA(At, 1, 1); PG8_STAGE(PG8_SA(1, 0), a3, voffA);
      PG8_BAR; PG8_WAIT_L(0); PG8_MMA(1, 0, At, B0); PG8_BAR; PG8_SCHED;
      PG8_STAGE(PG8_SB(1, 1), b3 + hstepB, voffB);
      PG8_WAIT_V(6); PG8_BAR; PG8_MMA(1, 1, At, B1); PG8_BAR;
    }
    E(acc, cur, wr, wc, fr, fq);
    if (!has_next) break;
#pragma unroll
    for (int a = 0; a < 2; ++a)
#pragma unroll
      for (int b = 0; b < 2; ++b)
#pragma unroll
        for (int m = 0; m < 4; ++m)
#pragma unroll
          for (int n = 0; n < 2; ++n) acc[a][b][m][n] = (f32x4){0.f, 0.f, 0.f, 0.f};
    cur = nxt; cA = nA; cB = nB; ++ui;
  }
  PG8_WAIT_V(0);
  if (wr == 0) PG8_BAR;
  PG8_BAR;
#undef PG8_SA
#undef PG8_SB
#undef PG8_STAGE
#undef PG8_LDA
#undef PG8_LDB
#undef PG8_MMA
#undef PG8_WAIT_V
#undef PG8_WAIT_L
#undef PG8_BAR
#undef PG8_SCHED
}

struct EpiEvenIn {
  static constexpr bool PERM = true, TRANS = true;
  ushort_t* ps5; ushort_t* prw;
  DEVI void operator()(const f32x4 (&acc)[2][2][4][2], const Unit& u, int wr, int wc, int fr, int fq) const {
#pragma unroll
    for (int ai = 0; ai < 2; ++ai)
#pragma unroll
      for (int m = 0; m < 4; ++m) {
        const size_t row = (size_t)u.pm * BM + ai * HALF + wr * 64 + m * 16 + fr;
#pragma unroll
        for (int bj = 0; bj < 2; ++bj) {
          const int c0 = u.pn * BM + bj * HALF + wc * 32 + 8 * fq;
          const f32x4 v0 = acc[ai][bj][m][0], v1 = acc[ai][bj][m][1];
          u32x4 o = {cvt_pk_bf16(v0[0], v0[1]), cvt_pk_bf16(v0[2], v0[3]), cvt_pk_bf16(v1[0], v1[1]), cvt_pk_bf16(v1[2], v1[3])};
          if (c0 < 1024) *(u32x4*)(ps5 + row * 1024 + c0) = o;
          else if (c0 < 3136) *(u32x4*)(prw + row * 2112 + (c0 - 1024)) = o;
        }
      }
  }
};
struct EpiHyIn {
  static constexpr bool PERM = false, TRANS = false;
  ushort_t* ph;
  DEVI void operator()(const f32x4 (&acc)[2][2][4][2], const Unit& u, int wr, int wc, int fr, int fq) const {
    int s0, L; seq_of(u.pm * BM, s0, L);
#pragma unroll
    for (int ai = 0; ai < 2; ++ai)
#pragma unroll
      for (int m = 0; m < 4; ++m) {
        const int tok = u.pm * BM + ai * HALF + wr * 64 + m * 16 + 4 * fq;
#pragma unroll
        for (int bj = 0; bj < 2; ++bj)
#pragma unroll
          for (int n = 0; n < 2; ++n) {
            const int col = u.pn * BM + bj * HALF + wc * 32 + 16 * n + fr;
            const int st = col >> 10, c = col & 1023;
            const f32x4 v = acc[ai][bj][m][n];
            ushort_t* dst = ph + (size_t)st * T * 1024 + (size_t)s0 * 1024 + (size_t)c * L + (tok - s0);
            *(uint2*)dst = uint2{cvt_pk_bf16(v[0], v[1]), cvt_pk_bf16(v[2], v[3])};
          }
      }
  }
};
struct EpiGlu {
  static constexpr bool PERM = true, TRANS = true;
  ushort_t* y; const ushort_t* ps5; const float* bias;
  DEVI void operator()(const f32x4 (&acc)[2][2][4][2], const Unit& u, int wr, int wc, int fr, int fq) const {
#pragma unroll
    for (int ai = 0; ai < 2; ++ai)
#pragma unroll
      for (int m = 0; m < 4; ++m) {
        const size_t row = (size_t)u.pm * BM + ai * HALF + wr * 64 + m * 16 + fr;
#pragma unroll
        for (int bj = 0; bj < 2; ++bj) {
          const int c0 = u.pn * BM + bj * HALF + wc * 32 + 8 * fq;
          const u32x4 a8 = *(const u32x4*)(y + row * 1024 + 512 + c0);
          const u32x4 g8 = *(const u32x4*)(ps5 + row * 1024 + 512 + c0);
          const f32x4 b0 = *(const f32x4*)(bias + c0), b1 = *(const f32x4*)(bias + c0 + 4);
          float v[8];
#pragma unroll
          for (int e = 0; e < 4; ++e) { v[e] = acc[ai][bj][m][0][e] + b0[e]; v[4 + e] = acc[ai][bj][m][1][e] + b1[e]; }
          unsigned o[4];
#pragma unroll
          for (int e = 0; e < 4; ++e) {
            const float a_lo = __uint_as_float(a8[e] << 16), a_hi = __uint_as_float(a8[e] & 0xffff0000u);
            const float g_lo = __uint_as_float(g8[e] << 16), g_hi = __uint_as_float(g8[e] & 0xffff0000u);
            const float r_lo = a_lo * sigmoidf_(v[2 * e]) * (g_lo * sigmoidf_(g_lo));
            const float r_hi = a_hi * sigmoidf_(v[2 * e + 1]) * (g_hi * sigmoidf_(g_hi));
            o[e] = cvt_pk_bf16(r_lo, r_hi);
          }
          *(u32x4*)(y + row * 1024 + c0) = u32x4{o[0], o[1], o[2], o[3]};
        }
      }
  }
};
struct EpiF16 {
  static constexpr bool PERM = true, TRANS = true;
  ushort_t* C;
  DEVI void operator()(const f32x4 (&acc)[2][2][4][2], const Unit& u, int wr, int wc, int fr, int fq) const {
#pragma unroll
    for (int ai = 0; ai < 2; ++ai)
#pragma unroll
      for (int m = 0; m < 4; ++m) {
        ushort_t* rowp = C + ((size_t)u.pm * BM + ai * HALF + wr * 64 + m * 16 + fr) * 1024 + u.pn * BM + wc * 32 + 8 * fq;
#pragma unroll
        for (int bj = 0; bj < 2; ++bj) {
          const f32x4 v0 = acc[ai][bj][m][0], v1 = acc[ai][bj][m][1];
          *(u32x4*)(rowp + bj * HALF) = u32x4{cvt_pk_bf16(v0[0], v0[1]), cvt_pk_bf16(v0[2], v0[3]), cvt_pk_bf16(v1[0], v1[1]), cvt_pk_bf16(v1[2], v1[3])};
        }
      }
  }
};
}

template <class Epi>
DEVI void run_gemm(unsigned char* lds, const ushort_t* A, int lda, const ushort_t* Bt, int N, int K, const Epi& E) {
  pg8::Gemm g; g.A = A; g.Bt = Bt; g.M = T; g.N = N; g.K = K; g.lda = lda;
  pg8::StaticOrder S; S.init(T, N, (int)gridDim.x, bidx());
  __syncthreads();
  pg8::gemm_phase<Epi>((PG8_LAS unsigned char*)lds, g, S, E);
  __syncthreads();
}

__device__ void xb_convert(const Params& p, ushort_t* XB) {
  const size_t n4 = (size_t)T * 1024 / 4, np4 = (size_t)TPROMPT * 1024 / 4;
  const float4* xp = (const float4*)p.in[I_XP]; const float4* xs = (const float4*)p.in[I_XS];
  for (size_t e = (size_t)bidx() * NT + tidx(); e < n4; e += (size_t)gridDim.x * NT) {
    const float4 v = e < np4 ? xp[e] : xs[e - np4];
    ((uint2*)XB)[e] = uint2{pack2(v.x, v.y), pack2(v.z, v.w)};
  }
}
__device__ void zero_fill(ushort_t* dst, size_t n) {
  for (size_t e = (size_t)bidx() * NT + tidx(); e < n / 8; e += (size_t)gridDim.x * NT) ((uint4*)dst)[e] = uint4{0, 0, 0, 0};
}
DEVI uint4 hy_tr_load(const ushort_t* __restrict__ PH3, int t, int r, int c8) {
  const int tok0 = (t >> 4) * 64, c0 = (t & 15) * 64;
  int s0, L; seq_of(tok0, s0, L);
  return *(const uint4*)(PH3 + (size_t)s0 * 1024 + (size_t)(c0 + r) * L + (tok0 - s0) + c8);
}
__device__ void hy_transpose(const ushort_t* __restrict__ PH3, ushort_t* __restrict__ Y, unsigned char* lds) {
  ushort_t* tile = (ushort_t*)lds;
  const int tid = tidx(), r = tid >> 3, c8 = (tid & 7) * 8;
  const int nt = (T / 64) * 16, t_first = bidx();
  uint4 v = uint4{0, 0, 0, 0};
  if (t_first < nt) v = hy_tr_load(PH3, t_first, r, c8);
  for (int t = t_first; t < nt; t += gridDim.x) {
    const int tok0 = (t >> 4) * 64, c0 = (t & 15) * 64;
    block_sync_lds();
    *(uint4*)(tile + r * 72 + c8) = v;
    if (t + (int)gridDim.x < nt) v = hy_tr_load(PH3, t + gridDim.x, r, c8);
    block_sync_lds();
    unsigned o[4];
#pragma unroll
    for (int e = 0; e < 4; ++e) o[e] = (unsigned)tile[(c8 + 2 * e) * 72 + r] | ((unsigned)tile[(c8 + 2 * e + 1) * 72 + r] << 16);
    *(uint4*)(Y + (size_t)(tok0 + r) * 1024 + c0 + c8) = uint4{o[0], o[1], o[2], o[3]};
  }
}

struct LnIn { float4 x[2][4]; uint2 f[2][4]; };
DEVI void ln_load(const XSrc& xs_, int layer, const ushort_t* __restrict__ F, int row0, int lane, LnIn& o) {
#pragma unroll
  for (int h = 0; h < 2; ++h) {
    const int row = row0 + h * (T / 2);
    const float4* x4 = (const float4*)xrow(xs_, layer, row);
    const uint2* f2 = (const uint2*)(F + (size_t)row * 1024);
#pragma unroll
    for (int e = 0; e < 4; ++e) { o.x[h][e] = x4[lane + 64 * e]; o.f[h][e] = f2[lane + 64 * e]; }
  }
}
__device__ void ln_phase(const Params& p, int layer, const ushort_t* __restrict__ F, ushort_t* __restrict__ XB, bool dry = false) {
  const int lane = tidx() & 63, gw = bidx() * (NT / 64) + (tidx() >> 6), nw = gridDim.x * (NT / 64);
  const float alpha = 1.681792830507429f;
  const float4* g4 = (const float4*)(p.in[I_LNG] + layer * 1024);
  const float4* b4 = (const float4*)(p.in[I_LNB] + layer * 1024);
  const XSrc xs_ = xsrc(p);
  LnIn cur, nxt;
  if (gw < T / 2) ln_load(xs_, layer, F, gw, lane, cur);
  for (int row0 = gw; row0 < T / 2; row0 += nw) {
    if (row0 + nw < T / 2) ln_load(xs_, layer, F, row0 + nw, lane, nxt);
#pragma unroll
    for (int h = 0; h < 2; ++h) {
      const int row = row0 + h * (T / 2);
      float4 v[4];
      float s = 0.f;
#pragma unroll
      for (int e = 0; e < 4; ++e) {
        const float4 a = cur.x[h][e];
        const uint2 fw = cur.f[h][e];
        v[e] = float4{alpha * a.x + __uint_as_float(fw.x << 16), alpha * a.y + __uint_as_float(fw.x & 0xffff0000u),
                      alpha * a.z + __uint_as_float(fw.y << 16), alpha * a.w + __uint_as_float(fw.y & 0xffff0000u)};
        s += v[e].x + v[e].y + v[e].z + v[e].w;
      }
      const float mean = wsum(s) * (1.f / 1024.f);
      float q = 0.f;
#pragma unroll
      for (int e = 0; e < 4; ++e) {
        v[e].x -= mean; v[e].y -= mean; v[e].z -= mean; v[e].w -= mean;
        q += v[e].x * v[e].x + v[e].y * v[e].y + v[e].z * v[e].z + v[e].w * v[e].w;
      }
      const float rs = rsqrtf(wsum(q) * (1.f / 1024.f) + 1e-5f);
      float4* o4 = (float4*)(p.out + (size_t)row * 1024);
#pragma unroll
      for (int e = 0; e < 4; ++e) {
        const float4 g = g4[lane + 64 * e], b = b4[lane + 64 * e];
        const float4 o = float4{v[e].x * rs * g.x + b.x, v[e].y * rs * g.y + b.y, v[e].z * rs * g.z + b.z, v[e].w * rs * g.w + b.w};
        if (!dry) o4[lane + 64 * e] = o;
        if (XB) ((uint2*)(XB + (size_t)row * 1024))[lane + 64 * e] = uint2{pack2(o.x, o.y), pack2(o.z, o.w)};
      }
    }
    cur = nxt;
  }
}

struct cplx { float x, y; };
DEVI cplx cmul(cplx a, cplx b) { return cplx{a.x * b.x - a.y * b.y, a.x * b.y + a.y * b.x}; }
DEVI void s5_consts(const Params& p, int i, int d, int g, int n, cplx& lb, cplx& coef) {
  const int idx = ((i * 2 + d) * 32 + g) * 64 + n;
  const float lre = p.in[I_LRE][idx], lim = p.in[I_LIM][idx];
  const float dt = expf(p.in[I_LSTEP][(i * 2 + d) * 32 + g]);
  const float mag = expf(lre * dt);
  float sn, cs; sincosf(lim * dt, &sn, &cs);
  lb = cplx{mag * cs, mag * sn};
  const float nr = lb.x - 1.f, ni = lb.y, den = 1.f / (lre * lre + lim * lim);
  coef = cplx{(nr * lre + ni * lim) * den, (ni * lre - nr * lim) * den};
}
DEVI void s5_load_u(const ushort_t* PS5, int tok0, int g, int lane, uint4& a, uint4& b) {
  const uint4* src = (const uint4*)(PS5 + (size_t)(tok0 + lane) * 1024 + g * 16);
  a = src[0]; b = src[1];
}
DEVI void s5_store_u(float* U, int lane, const uint4& a, const uint4& b) {
  float4* d = (float4*)(U + lane * 16);
  d[0] = float4{__uint_as_float(a.x << 16), __uint_as_float(a.x & 0xffff0000u), __uint_as_float(a.y << 16), __uint_as_float(a.y & 0xffff0000u)};
  d[1] = float4{__uint_as_float(a.z << 16), __uint_as_float(a.z & 0xffff0000u), __uint_as_float(a.w << 16), __uint_as_float(a.w & 0xffff0000u)};
  d[2] = float4{__uint_as_float(b.x << 16), __uint_as_float(b.x & 0xffff0000u), __uint_as_float(b.y << 16), __uint_as_float(b.y & 0xffff0000u)};
  d[3] = float4{__uint_as_float(b.z << 16), __uint_as_float(b.z & 0xffff0000u), __uint_as_float(b.w << 16), __uint_as_float(b.w & 0xffff0000u)};
}
DEVI f32x2 cmul2(f32x2 a, f32x2 b) { return f32x2{a.x, a.x} * b + f32x2{a.y, a.y} * f32x2{-b.y, b.x}; }
#define S5_BU2(Urow, acc2)                                                            \
  {                                                                                   \
    const float4* u4 = (const float4*)(Urow);                                         \
    _Pragma("unroll") for (int pp = 0; pp < 4; ++pp) {                                \
      const float4 u = u4[pp];                                                        \
      acc2 = B2[4 * pp] * f32x2{u.x, u.x} + acc2; acc2 = B2[4 * pp + 1] * f32x2{u.y, u.y} + acc2; \
      acc2 = B2[4 * pp + 2] * f32x2{u.z, u.z} + acc2; acc2 = B2[4 * pp + 3] * f32x2{u.w, u.w} + acc2; \
    }                                                                                 \
  }

__device__ void s5_passA(const Params& p, int i, unsigned char* lds) {
  const ushort_t* PS5 = (const ushort_t*)(p.ws + OFF_PS5);
  cplx* CAR = (cplx*)(p.ws + OFF_CAR);
  const int lane = tidx() & 63, wave = tidx() >> 6;
  float* U = (float*)(lds + wave * 8448);
  for (int item = bidx() * 8 + wave; item < 192 * 32; item += gridDim.x * 8) {
    const int q = item >> 5, g = item & 31;
    cplx lb0, c0, lb1, c1;
    s5_consts(p, i, 0, g, lane, lb0, c0);
    s5_consts(p, i, 1, g, lane, lb1, c1);
    const f32x2 l0 = {lb0.x, lb0.y}, l1 = {lb1.x, lb1.y};
    f32x2 B2[16];
#pragma unroll
    for (int pp = 0; pp < 16; ++pp) B2[pp] = f32x2{p.in[I_BRE][((i * 32 + g) * 64 + lane) * 16 + pp], p.in[I_BIM][((i * 32 + g) * 64 + lane) * 16 + pp]};
    f32x2 xf = {0.f, 0.f}, xb = {0.f, 0.f}, pw = {1.f, 0.f};
    uint4 ua, ub;
    s5_load_u(PS5, q * 256, g, lane, ua, ub);
    for (int sb = 0; sb < 4; ++sb) {
      wave_sync();
      s5_store_u(U, lane, ua, ub);
      wave_sync();
      if (sb < 3) s5_load_u(PS5, q * 256 + (sb + 1) * 64, g, lane, ua, ub);
#pragma unroll 4
      for (int t = 0; t < 64; ++t) {
        f32x2 bu = {0.f, 0.f};
        S5_BU2(U + t * 16, bu);
        xf = cmul2(l0, xf) + bu;
        xb = cmul2(pw, bu) + xb;
        pw = cmul2(pw, l1);
      }
    }
    CAR[((size_t)(q * 32 + g) * 2 + 0) * 64 + lane] = cmul(cplx{xf.x, xf.y}, c0);
    CAR[((size_t)(q * 32 + g) * 2 + 1) * 64 + lane] = cmul(cplx{xb.x, xb.y}, c1);
  }
}

__device__ void s5_passC(const Params& p, int i, unsigned char* lds) {
  const ushort_t* PS5 = (const ushort_t*)(p.ws + OFF_PS5);
  const cplx* CAR = (const cplx*)(p.ws + OFF_CAR);
  float* YS = (float*)(p.ws + OFF_YS);
  ushort_t* YG = (ushort_t*)(p.ws + OFF_Y);
  const int lane = tidx() & 63, wave = tidx() >> 6;
  float* U = (float*)(lds + wave * 8448);
  ushort_t* X = (ushort_t*)(lds + wave * 8448 + 4096);
  for (int item = bidx() * 8 + wave; item < 192 * 32; item += gridDim.x * 8) {
    const int q = item >> 5, g = item & 31;
    int cs, ce;
    if (q < 64) { cs = q & ~15; ce = cs + 16; } else { cs = 64 + ((q - 64) & ~63); ce = cs + 64; }
    const int pcol = lane & 15;
    const float dd = p.in[I_S5D][i * 512 + g * 16 + pcol];
    for (int d = 0; d < 2; ++d) {
      cplx lb, coef;
      s5_consts(p, i, d, g, lane, lb, coef);
      const f32x2 l2 = {lb.x, lb.y};
      f32x2 B2[16];
#pragma unroll
      for (int pp = 0; pp < 16; ++pp) {
        const cplx bb = cmul(coef, cplx{p.in[I_BRE][((i * 32 + g) * 64 + lane) * 16 + pp], p.in[I_BIM][((i * 32 + g) * 64 + lane) * 16 + pp]});
        B2[pp] = f32x2{bb.x, bb.y};
      }
      cplx lp = lb;
#pragma unroll
      for (int e = 0; e < 8; ++e) lp = cmul(lp, lp);
      cplx xs{0.f, 0.f};
      if (d == 0) {
#pragma unroll 8
        for (int j = cs; j < q; ++j) { xs = cmul(lp, xs); cplx c = CAR[((size_t)(j * 32 + g) * 2 + 0) * 64 + lane]; xs.x += c.x; xs.y += c.y; } }
      else {
#pragma unroll 8
        for (int j = ce - 1; j > q; --j) { xs = cmul(lp, xs); cplx c = CAR[((size_t)(j * 32 + g) * 2 + 1) * 64 + lane]; xs.x += c.x; xs.y += c.y; } }
      f32x2 x2 = {xs.x, xs.y};
      bf16x8 cf[4];
#pragma unroll
      for (int kk = 0; kk < 4; ++kk) {
        const int n0 = (kk & 1) * 32 + (lane >> 4) * 8;
        const float* src = (kk < 2 ? p.in[I_CRE] : p.in[I_CIM]) + (((size_t)(i * 2 + d) * 32 + g) * 16 + pcol) * 64 + n0;
        const float sg = kk < 2 ? 1.f : -1.f;
#pragma unroll
        for (int j = 0; j < 8; ++j) cf[kk][j] = (short)f2bf(sg * src[j]);
      }
      uint4 ua, ub;
      s5_load_u(PS5, q * 256 + (d ? 3 : 0) * 64, g, lane, ua, ub);
      for (int sbi = 0; sbi < 4; ++sbi) {
        const int sb = d ? 3 - sbi : sbi;
        wave_sync();
        s5_store_u(U, lane, ua, ub);
        wave_sync();
        if (sbi < 3) s5_load_u(PS5, q * 256 + (d ? 2 - sbi : sbi + 1) * 64, g, lane, ua, ub);
        for (int tbi = 0; tbi < 4; ++tbi) {
          const int tb = d ? 3 - tbi : tbi;
          float ysp[4] = {0.f, 0.f, 0.f, 0.f};
          if (d == 1) {
#pragma unroll
            for (int r = 0; r < 4; ++r) ysp[r] = YS[(size_t)(q * 256 + sb * 64 + tb * 16 + (lane >> 4) * 4 + r) * 512 + g * 16 + pcol];
          }
#pragma unroll 4
          for (int tti = 0; tti < 16; ++tti) {
            const int tt = d ? 15 - tti : tti;
            f32x2 acc2 = cmul2(l2, x2);
            S5_BU2(U + (tb * 16 + tt) * 16, acc2);
            x2 = acc2;
            X[tt * 136 + lane] = f2bf(x2.x);
            X[tt * 136 + 64 + lane] = f2bf(x2.y);
          }
          wave_sync();
          f32x4 acc{0.f, 0.f, 0.f, 0.f};
#pragma unroll
          for (int kk = 0; kk < 4; ++kk) {
            bf16x8 a = *(const bf16x8*)(X + (lane & 15) * 136 + kk * 32 + (lane >> 4) * 8);
            acc = __builtin_amdgcn_mfma_f32_16x16x32_bf16(a, cf[kk], acc, 0, 0, 0);
          }
          wave_sync();
#pragma unroll
          for (int r = 0; r < 4; ++r) {
            const int tl = tb * 16 + (lane >> 4) * 4 + r;
            const size_t o = (size_t)(q * 256 + sb * 64 + tl) * 512 + g * 16 + pcol;
            if (d == 0) YS[o] = acc[r] + dd * U[tl * 16 + pcol];
            else {
              const float yv = ysp[r] + acc[r];
              YG[(size_t)(q * 256 + sb * 64 + tl) * 1024 + 512 + g * 16 + pcol] = f2bf(yv * fast_sigmoid(1.5957691216f * (yv + 0.044715f * yv * yv * yv)));
            }
          }
        }
      }
    }
  }
}

struct RwConst { float mur, muk, muv, mul, w0, a0, kk, ka; };
struct RwRow { float r, k, v, l; };
DEVI RwRow rw_load_row(const ushort_t* PRW, int tok, int s0, int L, int h, int lane) {
  RwRow o{0.f, 0.f, 0.f, 0.f};
  if (tok >= s0 && tok < s0 + L) {
    const ushort_t* row = PRW + (size_t)tok * 2112;
    const int cc = h * 64 + lane;
    o.r = bf2f(row[cc]); o.k = bf2f(row[512 + cc]); o.v = bf2f(row[1024 + cc]); o.l = bf2f(row[2048 + lane]);
  }
  return o;
}
DEVI void rw_prologue(const RwRow& rm, const RwRow& rc, const RwRow& rn, int lane, const RwConst& c, const float* WU, const float* AU,
                      float* LT, float* Wd, float* KKd, float* BBd, float* KDd, float* RRd, float* VVd) {
  const float rr = rc.r + c.mur * (0.5f * (rm.r + rn.r) - rc.r);
  const float kx = rc.k + c.muk * (0.5f * (rm.k + rn.k) - rc.k);
  const float vv = rc.v + c.muv * (0.5f * (rm.v + rn.v) - rc.v);
  float ll = rc.l + c.mul * (0.5f * (rm.l + rn.l) - rc.l);
  ll = lane < 32 ? fast_tanh(ll) : ll;
  wave_sync();
  LT[lane] = ll;
  wave_sync();
  float accw = c.w0, acca = c.a0;
#pragma unroll 2
  for (int j = 0; j < 32; j += 4) {
    float4 lw = *(const float4*)(LT + j), la = *(const float4*)(LT + 32 + j);
    accw += lw.x * WU[(j + 0) * 64 + lane] + lw.y * WU[(j + 1) * 64 + lane] + lw.z * WU[(j + 2) * 64 + lane] + lw.w * WU[(j + 3) * 64 + lane];
    acca += la.x * AU[(j + 0) * 64 + lane] + la.y * AU[(j + 1) * 64 + lane] + la.z * AU[(j + 2) * 64 + lane] + la.w * AU[(j + 3) * 64 + lane];
  }
  const float dec = __builtin_amdgcn_exp2f(-0.8750387749145276f * fast_sigmoid(accw));
  const float a = fast_sigmoid(acca);
  const float kkr = kx * c.kk;
  const float ss = wsum_fast(kkr * kkr);
  const float kkn = kkr * __builtin_amdgcn_rsqf(fmaxf(ss, 1e-24f));
  Wd[lane] = dec; KKd[lane] = kkn; BBd[lane] = kkn * a; KDd[lane] = kx * (1.f + (a - 1.f) * c.ka); RRd[lane] = rr; VVd[lane] = vv;
}

template <int NS>
DEVI void rw_prologue_blk(const RwRow* R, int lane, const RwConst& c, const bf16x8* BF, int dir, ushort_t* LTm,
                          float* Wd, float* KKd, float* BBd, float* KDd, float* RRd, float* VVd) {
#pragma unroll
  for (int e = 0; e < NS; ++e) {
    const RwRow& rm = R[e]; const RwRow& rc = R[e + 1]; const RwRow& rn = R[e + 2];
    const float rr = rc.r + c.mur * (0.5f * (rm.r + rn.r) - rc.r);
    const float kx = rc.k + c.muk * (0.5f * (rm.k + rn.k) - rc.k);
    const float vv = rc.v + c.muv * (0.5f * (rm.v + rn.v) - rc.v);
    float ll = rc.l + c.mul * (0.5f * (rm.l + rn.l) - rc.l);
    ll = lane < 32 ? fast_tanh(ll) : ll;
    RRd[e * 64 + lane] = rr; VVd[e * 64 + lane] = vv; KDd[e * 64 + lane] = kx;
    LTm[e * 72 + lane] = f2bf(ll);
  }
  wave_sync_lds();
  {
    const int row = lane & (NS - 1), kq8 = (lane >> 4) * 8;
    const bf16x8 aw = *(const bf16x8*)(LTm + row * 72 + kq8);
    const bf16x8 aa = *(const bf16x8*)(LTm + row * 72 + 32 + kq8);
#pragma unroll
    for (int nt = 0; nt < 4; ++nt) {
      const f32x4 z = {0.f, 0.f, 0.f, 0.f};
      const f32x4 dw = __builtin_amdgcn_mfma_f32_16x16x32_bf16(aw, BF[(dir * 4 + nt) * 64 + lane], z, 0, 0, 0);
      const f32x4 da = __builtin_amdgcn_mfma_f32_16x16x32_bf16(aa, BF[(8 + nt) * 64 + lane], z, 0, 0, 0);
      if ((lane >> 4) < NS / 4) {
#pragma unroll
        for (int r = 0; r < 4; ++r) {
          const int o = ((lane >> 4) * 4 + r) * 64 + nt * 16 + (lane & 15);
          Wd[o] = dw[r]; BBd[o] = da[r];
        }
      }
    }
  }
  wave_sync_lds();
#pragma unroll
  for (int e = 0; e < NS; ++e) {
    const float accw = c.w0 + Wd[e * 64 + lane], acca = c.a0 + BBd[e * 64 + lane], kx = KDd[e * 64 + lane];
    const float dec = __builtin_amdgcn_exp2f(-0.8750387749145276f * fast_sigmoid(accw));
    const float a = fast_sigmoid(acca);
    const float kkr = kx * c.kk;
    const float ss = wsum_fast(kkr * kkr);
    const float kkn = kkr * __builtin_amdgcn_rsqf(fmaxf(ss, 1e-24f));
    Wd[e * 64 + lane] = dec; KKd[e * 64 + lane] = kkn; BBd[e * 64 + lane] = kkn * a; KDd[e * 64 + lane] = kx * (1.f + (a - 1.f) * c.ka);
  }
}
DEVI void rw_fill_bf(const Params& p, int i, int h, bf16x8* BF, int tid, int nthr = NT) {
  for (int e = tid; e < 768; e += nthr) {
    const int which = e >> 8, nt = (e >> 6) & 3, l = e & 63;
    const int n = nt * 16 + (l & 15), k0 = (l >> 4) * 8;
    const float* src = which < 2 ? p.in[I_WUP] + ((size_t)(i * 2 + which) * 32) * 512 : p.in[I_AUP] + ((size_t)i * 32) * 512;
    bf16x8 v;
#pragma unroll
    for (int jj = 0; jj < 8; ++jj) v[jj] = (short)f2bf(src[(size_t)(k0 + jj) * 512 + h * 64 + n]);
    BF[e] = v;
  }
}

DEVI float dpp_f(float x, const int ctrl_sel) {
  int xi = __builtin_bit_cast(int, x), r;
  if (ctrl_sel == 0) r = __builtin_amdgcn_mov_dpp(xi, 0xB1, 0xf, 0xf, true);
  else if (ctrl_sel == 1) r = __builtin_amdgcn_mov_dpp(xi, 0x4E, 0xf, 0xf, true);
  else r = __builtin_amdgcn_mov_dpp(xi, 0x141, 0xf, 0xf, true);
  return __builtin_bit_cast(float, r);
}
DEVI float red8(float x) { x += dpp_f(x, 0); x += dpp_f(x, 1); x += dpp_f(x, 2); return x; }

#define RW_LOAD8(dst2, base)                                                        \
  { const float4 _a = *(const float4*)(base), _b = *(const float4*)((base) + 4);    \
    dst2[0] = f32x2{_a.x, _a.y}; dst2[1] = f32x2{_a.z, _a.w}; dst2[2] = f32x2{_b.x, _b.y}; dst2[3] = f32x2{_b.z, _b.w}; }

__device__ void rwkv_scan1(const Params& p, int i, unsigned char* lds) {
  const ushort_t* PRW = (const ushort_t*)(p.ws + OFF_PRW);
  float* CH = (float*)(p.ws + OFF_PS5);
  float* YR = (float*)(p.ws + OFF_YS);
  const int tid = tidx(), lane = tid & 63, wave = tid >> 6, pair = wave >> 1, role = (wave ^ (wave >> 2)) & 1;
  const int vq = lane >> 3, kq = lane & 7;
  bf16x8* BF = (bf16x8*)lds;
  float* WV = (float*)(lds + 12288 + pair * 26880);
  float* Wd = WV, *KKd = WV + 1024, *BBd = WV + 2048, *KDd = WV + 3072, *RRd = WV + 4096, *VVd = WV + 5120;
  ushort_t* LTm = (ushort_t*)(WV + 6144) + role * 576;
  {
    float4* z = (float4*)YR;
    for (size_t e = (size_t)bidx() * NT + tid; e < (size_t)T * 512 / 4; e += (size_t)gridDim.x * NT) z[e] = float4{0.f, 0.f, 0.f, 0.f};
  }
  for (int bi = bidx(); bi < 768; bi += gridDim.x) {
    const int h = bi / 96, rem = bi % 96;
    const int dir = pair >> 1, q = rem * 2 + (pair & 1);
    __syncthreads();
    rw_fill_bf(p, i, h, BF, tid);
    __syncthreads();
    RwConst c;
    const int cc = h * 64 + lane;
    c.mur = p.in[I_MURKV][(i * 3 + 0) * 512 + cc]; c.muk = p.in[I_MURKV][(i * 3 + 1) * 512 + cc]; c.muv = p.in[I_MURKV][(i * 3 + 2) * 512 + cc];
    c.mul = p.in[I_MULORA][i * 64 + lane];
    c.w0 = p.in[I_W0][(i * 2 + dir) * 512 + cc]; c.a0 = p.in[I_A0][(i * 2 + dir) * 512 + cc];
    c.kk = p.in[I_KK][i * 512 + cc]; c.ka = p.in[I_KA][i * 512 + cc];
    const size_t it = ((size_t)(q * 8 + h) * 2 + dir);
    int sq0, sqL; seq_of(q * 256, sq0, sqL);
    float* Op = CH + it * 8192 + (role ? 0 : 4096);
    f32x2 S2[8][4];
    int diag = (role && vq == kq) ? 1 : 0;
    asm volatile("" : "+v"(diag));
#pragma unroll
    for (int r = 0; r < 8; ++r)
#pragma unroll
      for (int jj = 0; jj < 4; ++jj) S2[r][jj] = f32x2{(diag && (2 * jj == r)) ? 1.f : 0.f, (diag && (2 * jj + 1 == r)) ? 1.f : 0.f};
    const float vsel = role ? 0.f : 1.f;
    RwRow R[10];
#pragma unroll
    for (int j = 0; j < 10; ++j) {
      const int st = role * 8 + j - 1;
      R[j] = rw_load_row(PRW, dir ? (q * 256 + 255 - st) : (q * 256 + st), sq0, sqL, h, lane);
    }
    for (int blk = 0; blk < 16; ++blk) {
      {
        const int s = role * 8;
        rw_prologue_blk<8>(R, lane, c, BF, dir, LTm, Wd + s * 64, KKd + s * 64, BBd + s * 64, KDd + s * 64, RRd + s * 64, VVd + s * 64);
      }
      if (blk + 1 < 16) {
#pragma unroll
        for (int j = 0; j < 10; ++j) {
          const int st = (blk + 1) * 16 + role * 8 + j - 1;
          R[j] = rw_load_row(PRW, dir ? (q * 256 + 255 - st) : (q * 256 + st), sq0, sqL, h, lane);
        }
      }
      block_sync_lds();
#pragma unroll 2
      for (int s = 0; s < 16; ++s) {
        f32x2 kk2[4], w2[4], b2[4], kd2[4], vv2[4];
        RW_LOAD8(kk2, KKd + s * 64 + 8 * kq);
        RW_LOAD8(vv2, VVd + s * 64 + 8 * vq);
        RW_LOAD8(w2, Wd + s * 64 + 8 * kq);
        RW_LOAD8(b2, BBd + s * 64 + 8 * kq);
        RW_LOAD8(kd2, KDd + s * 64 + 8 * kq);
        float sa[8];
#pragma unroll
        for (int r = 0; r < 8; ++r) {
          f32x2 a = S2[r][0] * kk2[0];
          a = S2[r][1] * kk2[1] + a; a = S2[r][2] * kk2[2] + a; a = S2[r][3] * kk2[3] + a;
          sa[r] = -red8(a.x + a.y);
        }
#pragma unroll
        for (int r = 0; r < 8; ++r) {
          const float vr = ((r & 1) ? vv2[r >> 1].y : vv2[r >> 1].x) * vsel;
          const f32x2 sa2 = f32x2{sa[r], sa[r]}, v2 = f32x2{vr, vr};
#pragma unroll
          for (int jj = 0; jj < 4; ++jj) S2[r][jj] = S2[r][jj] * w2[jj] + sa2 * b2[jj] + v2 * kd2[jj];
        }
      }
      block_sync_lds();
    }
#pragma unroll
    for (int r = 0; r < 8; ++r) {
      float* dst = Op + (8 * vq + r) * 64 + 8 * kq;
      *(float4*)dst = float4{S2[r][0].x, S2[r][0].y, S2[r][1].x, S2[r][1].y};
      *(float4*)(dst + 4) = float4{S2[r][2].x, S2[r][2].y, S2[r][3].x, S2[r][3].y};
    }
  }
}

__device__ void rwkv_scan3(const Params& p, int i, unsigned char* lds, bool dry = false) {
  const ushort_t* PRW = (const ushort_t*)(p.ws + OFF_PRW);
  float* CH = (float*)(p.ws + OFF_PS5);
  float* YR = (float*)(p.ws + OFF_YS);
  const int tid = tidx(), lane = tid & 63, wave = tid >> 6;
  const int vq = lane >> 3, kq = lane & 7;
  const int half = wave >> 2;
  bf16x8* BF = (bf16x8*)lds + half * 768;
  float* WV = (float*)(lds + 24576 + wave * 13440);
  float* Wd = WV, *KKd = WV + 512, *BBd = WV + 1024, *KDd = WV + 1536, *RRd = WV + 2048, *VVd = WV + 2560;
  ushort_t* LTm = (ushort_t*)(WV + 3072);
  for (int tb2 = bidx() * 2; tb2 < 512; tb2 += gridDim.x * 2)
  for (int rnd = 0; rnd < 2; ++rnd) {
    const int tb = tb2 >> 1;
    const int hi = tb * 3 + (rnd == 0 ? half : 2);
    const bool active = (rnd == 0) || (half == 0);
    const int h = hi / 96, rem = hi % 96, cgp = rem >> 1, dir = rem & 1;
    const int q = cgp * 4 + (wave & 3);
    __syncthreads();
    if (active) rw_fill_bf(p, i, h, BF, tid & 255, 256);
    __syncthreads();
    if (!active) continue;
    RwConst c;
    const int cc = h * 64 + lane;
    c.mur = p.in[I_MURKV][(i * 3 + 0) * 512 + cc]; c.muk = p.in[I_MURKV][(i * 3 + 1) * 512 + cc]; c.muv = p.in[I_MURKV][(i * 3 + 2) * 512 + cc];
    c.mul = p.in[I_MULORA][i * 64 + lane];
    c.w0 = p.in[I_W0][(i * 2 + dir) * 512 + cc]; c.a0 = p.in[I_A0][(i * 2 + dir) * 512 + cc];
    c.kk = p.in[I_KK][i * 512 + cc]; c.ka = p.in[I_KA][i * 512 + cc];
    const size_t it = ((size_t)(q * 8 + h) * 2 + dir);
    int sq0, sqL; seq_of(q * 256, sq0, sqL);
    const float* Qp = CH + it * 8192 + 4096;
    f32x2 S2[8][4];
#pragma unroll
    for (int r = 0; r < 8; ++r) {
      const float* src = Qp + (8 * vq + r) * 64 + 8 * kq;
      const float4 a = *(const float4*)src, b = *(const float4*)(src + 4);
      S2[r][0] = f32x2{a.x, a.y}; S2[r][1] = f32x2{a.z, a.w}; S2[r][2] = f32x2{b.x, b.y}; S2[r][3] = f32x2{b.z, b.w};
    }
    RwRow R[10];
#pragma unroll
    for (int j = 0; j < 10; ++j) {
      const int st = j - 1;
      R[j] = rw_load_row(PRW, dir ? (q * 256 + 255 - st) : (q * 256 + st), sq0, sqL, h, lane);
    }
    for (int blk = 0; blk < 32; ++blk) {
      rw_prologue_blk<8>(R, lane, c, BF, dir, LTm, Wd, KKd, BBd, KDd, RRd, VVd);
      if (blk + 1 < 32) {
#pragma unroll
        for (int j = 0; j < 10; ++j) {
          const int st = (blk + 1) * 8 + j - 1;
          R[j] = rw_load_row(PRW, dir ? (q * 256 + 255 - st) : (q * 256 + st), sq0, sqL, h, lane);
        }
      }
      wave_sync_lds();
#pragma unroll 2
      for (int s = 0; s < 8; ++s) {
        f32x2 kk2[4], w2[4], b2[4], kd2[4], vv2[4], r2[4];
        RW_LOAD8(kk2, KKd + s * 64 + 8 * kq);
        RW_LOAD8(vv2, VVd + s * 64 + 8 * vq);
        RW_LOAD8(w2, Wd + s * 64 + 8 * kq);
        RW_LOAD8(b2, BBd + s * 64 + 8 * kq);
        RW_LOAD8(kd2, KDd + s * 64 + 8 * kq);
        RW_LOAD8(r2, RRd + s * 64 + 8 * kq);
        float sa[8];
#pragma unroll
        for (int r = 0; r < 8; ++r) {
          f32x2 a = S2[r][0] * kk2[0];
          a = S2[r][1] * kk2[1] + a; a = S2[r][2] * kk2[2] + a; a = S2[r][3] * kk2[3] + a;
          sa[r] = -red8(a.x + a.y);
        }
        float ysel = 0.f;
#pragma unroll
        for (int r = 0; r < 8; ++r) {
          const float vr = (r & 1) ? vv2[r >> 1].y : vv2[r >> 1].x;
          const f32x2 sa2 = f32x2{sa[r], sa[r]}, v2 = f32x2{vr, vr};
          f32x2 ya = f32x2{0.f, 0.f};
#pragma unroll
          for (int jj = 0; jj < 4; ++jj) {
            S2[r][jj] = S2[r][jj] * w2[jj] + sa2 * b2[jj] + v2 * kd2[jj];
            ya = S2[r][jj] * r2[jj] + ya;
          }
          const float yr = red8(ya.x + ya.y);
          ysel = (kq == r) ? yr : ysel;
        }
        const int st = blk * 8 + s;
        const int tok = dir ? (q * 256 + 255 - st) : (q * 256 + st);
        if (!dry) atomicAdd(YR + (size_t)tok * 512 + h * 64 + lane, ysel);
      }
      wave_sync_lds();
    }
  }
}

__device__ void rwkv_carry(const Params& p, unsigned char* lds, bool dry = false) {
  float* CH = (float*)(p.ws + OFF_PS5);
  float* Ps = (float*)lds;
  float* Ss = Ps + 4096;
  const int tid = tidx(), v = tid >> 4, ks = (tid & 15) * 4;
  for (int bi = bidx(); bi < 192; bi += gridDim.x) {
    const int half = bi & 1, dir = (bi >> 1) & 1, h = (bi >> 2) & 7, s = bi >> 5;
    int cs, n;
    if (s < 4) { cs = s * 16; n = 16; } else { cs = 64 + (s - 4) * 64; n = 64; }
    float4 cur{0.f, 0.f, 0.f, 0.f};
    float4 pq0, pq1, qv;
    {
      const int q = dir ? (cs + n - 1) : cs;
      const float* Pp = CH + ((size_t)(q * 8 + h) * 2 + dir) * 8192;
      pq0 = ((const float4*)Pp)[tid]; pq1 = ((const float4*)Pp)[tid + 512];
      qv = *(const float4*)(Pp + 4096 + (half * 32 + v) * 64 + ks);
    }
    for (int ci = 0; ci < n; ++ci) {
      const int q = dir ? (cs + n - 1 - ci) : (cs + ci);
      float* Pp = CH + ((size_t)(q * 8 + h) * 2 + dir) * 8192;
      float* Qrow = Pp + 4096 + (half * 32 + v) * 64 + ks;
      __syncthreads();
      if (!dry) *(float4*)Qrow = cur;
      if (ci == n - 1) break;
      *(float4*)(Ss + v * 64 + ks) = cur;
      ((float4*)Ps)[tid] = pq0;
      ((float4*)Ps)[tid + 512] = pq1;
      float4 acc = qv;
      if (ci + 2 < n + 1 && ci + 1 < n) {
        const int qn = dir ? (cs + n - 2 - ci) : (cs + ci + 1);
        const float* Pn = CH + ((size_t)(qn * 8 + h) * 2 + dir) * 8192;
        pq0 = ((const float4*)Pn)[tid]; pq1 = ((const float4*)Pn)[tid + 512];
        qv = *(const float4*)(Pn + 4096 + (half * 32 + v) * 64 + ks);
      }
      __syncthreads();
#pragma unroll 8
      for (int j = 0; j < 64; ++j) {
        const float sv = Ss[v * 64 + j];
        const float4 pr = *(const float4*)(Ps + j * 64 + ks);
        acc.x += sv * pr.x; acc.y += sv * pr.y; acc.z += sv * pr.z; acc.w += sv * pr.w;
      }
      cur = acc;
    }
    __syncthreads();
  }
}

struct PostIn { float r[6], k[6], v[6], g[4], y[4]; };
DEVI void post_load(const ushort_t* __restrict__ PRW, const float* __restrict__ YR, int item, int lane, PostIn& o) {
  const int tok0 = (item >> 3) * 4, h = item & 7, cc = h * 64 + lane;
  int s0, L; seq_of(tok0, s0, L);
#pragma unroll
  for (int j = 0; j < 6; ++j) {
    const int tok = tok0 - 1 + j;
    o.r[j] = 0.f; o.k[j] = 0.f; o.v[j] = 0.f;
    if (tok >= s0 && tok < s0 + L) {
      const ushort_t* row = PRW + (size_t)tok * 2112;
      o.r[j] = bf2f(row[cc]); o.k[j] = bf2f(row[512 + cc]); o.v[j] = bf2f(row[1024 + cc]);
    }
  }
#pragma unroll
  for (int e = 0; e < 4; ++e) { o.g[e] = bf2f(PRW[(size_t)(tok0 + e) * 2112 + 1536 + cc]); o.y[e] = YR[(size_t)(tok0 + e) * 512 + cc]; }
}
__device__ void rwkv_post(const Params& p, int i) {
  const ushort_t* __restrict__ PRW = (const ushort_t*)(p.ws + OFF_PRW);
  const float* __restrict__ YR = (const float*)(p.ws + OFF_YS);
  ushort_t* __restrict__ Y = (ushort_t*)(p.ws + OFF_Y);
  const int lane = tidx() & 63, gw = bidx() * 8 + (tidx() >> 6), nw = gridDim.x * 8;
  PostIn cur, nxt;
  if (gw < (T / 4) * 8) post_load(PRW, YR, gw, lane, cur);
  for (int item = gw; item < (T / 4) * 8; item += nw) {
    const int tok0 = (item >> 3) * 4, h = item & 7, cc = h * 64 + lane;
    if (item + nw < (T / 4) * 8) post_load(PRW, YR, item + nw, lane, nxt);
    const float mur = p.in[I_MURKV][(i * 3 + 0) * 512 + cc], muk = p.in[I_MURKV][(i * 3 + 1) * 512 + cc], muv = p.in[I_MURKV][(i * 3 + 2) * 512 + cc];
    const float lw = p.in[I_LNXW][i * 512 + cc], lb = p.in[I_LNXB][i * 512 + cc], rk = p.in[I_RK][i * 512 + cc];
#pragma unroll
    for (int e = 0; e < 4; ++e) {
      const float rr = cur.r[e + 1] + mur * (0.5f * (cur.r[e] + cur.r[e + 2]) - cur.r[e + 1]);
      const float kx = cur.k[e + 1] + muk * (0.5f * (cur.k[e] + cur.k[e + 2]) - cur.k[e + 1]);
      const float vv = cur.v[e + 1] + muv * (0.5f * (cur.v[e] + cur.v[e + 2]) - cur.v[e + 1]);
      const float mean = wsum_fast(cur.y[e]) * (1.f / 64.f);
      const float dlt = cur.y[e] - mean;
      const float var = wsum_fast(dlt * dlt) * (1.f / 64.f);
      const float yn = dlt * __builtin_amdgcn_rsqf(var + 64e-5f) * lw + lb;
      const float bonus = wsum_fast(rr * kx * rk) * vv;
      Y[(size_t)(tok0 + e) * 1024 + 512 + cc] = f2bf((yn + bonus) * (cur.g[e] * fast_sigmoid(cur.g[e])));
    }
    cur = nxt;
  }
}

__device__ void hy_filter_mlp(const Params& p, int i) {
  float* H2 = (float*)(p.ws + OFF_H2);
  const int lane = tidx() & 63, gw = bidx() * 8 + (tidx() >> 6), nw = gridDim.x * 8;
  const float fr = p.in[I_FFREQ][i * 64 + lane], b1 = p.in[I_FB1][i * 64 + lane], b2 = p.in[I_FB2][i * 64 + lane];
  for (int row = gw; row < 20480; row += nw) {
    const int L = row < 4096 ? 4096 : 16384, t = row < 4096 ? row : row - 4096;
    const float w = 6.283185307179586f * (float)t / (float)L;
    float z = 0.f;
    if (lane == 0) z = (float)t / (float)(L - 1);
    else if (lane <= 32) {
      const int bi = (lane - 1) & 15;
      const float f = 1e-4f + (float)bi * ((15.f - 1e-4f) / 15.f);
      z = lane <= 16 ? cosf(f * w) : -sinf(f * w);
    }
    float a = b1;
#pragma unroll 3
    for (int k = 0; k < 33; ++k) a += __shfl(z, k) * p.in[I_FW1][((size_t)i * 33 + k) * 64 + lane];
    const float h1 = sinf(fr * a);
    float c = b2;
#pragma unroll 8
    for (int k = 0; k < 64; ++k) c += __shfl(h1, k) * p.in[I_FW2][((size_t)i * 64 + k) * 64 + lane];
    H2[(row < 4096 ? (size_t)0 : (size_t)4096 * 64) + (size_t)lane * L + t] = sinf(fr * c);
  }
}

DEVI constexpr int swz(int i) { return i ^ ((i & 32) ? 21 : 0) ^ ((i & 64) ? 26 : 0); }
DEVI int swzF(int t) { return (swz(t >> 1) << 1) | (t & 1); }
DEVI f32x2 cmul_pk(f32x2 a, float c, float sn) { return a * f32x2{c, c} + f32x2{-a.y, a.x} * f32x2{sn, sn}; }
template <int LOGN, int NSEQ>
__device__ void fft_dif(float2* buf_) {
  constexpr int N = 1 << LOGN;
  f32x2* buf = (f32x2*)buf_;
  const int tid = tidx();
#pragma unroll
  for (int ps = 0; ps < LOGN / 2; ++ps) {
    const int lh = LOGN - 1 - 2 * ps;
    const int h = 1 << lh, hh = h >> 1;
    const float inv2h = 1.f / (float)(2 * h);
#pragma unroll 4
    for (int qg = tid; qg < NSEQ * N / 4; qg += NT) {
      const int q = qg & (N / 4 - 1), sb = (qg >> (LOGN - 2)) << LOGN;
      const int pos = q & (hh - 1), grp = q >> (lh - 1);
      const int e0 = sb + swz((grp << (lh + 1)) + pos);
      const int o1 = swz(hh), o2 = swz(h), o3 = swz(h + hh);
      const f32x2 x0 = buf[e0], x1 = buf[e0 ^ o1], x2 = buf[e0 ^ o2], x3 = buf[e0 ^ o3];
      const float f1 = (float)pos * inv2h;
      const float c1 = __builtin_amdgcn_cosf(f1), s1 = -__builtin_amdgcn_sinf(f1);
      const float c2 = c1 * c1 - s1 * s1, s2 = 2.f * c1 * s1;
      const f32x2 a0 = x0 + x2, a1 = x1 + x3;
      const f32x2 a2 = cmul_pk(x0 - x2, c1, s1);
      const f32x2 t3 = cmul_pk(x1 - x3, c1, s1);
      const f32x2 a3 = f32x2{t3.y, -t3.x};
      buf[e0] = a0 + a1;
      buf[e0 ^ o1] = cmul_pk(a0 - a1, c2, s2);
      buf[e0 ^ o2] = a2 + a3;
      buf[e0 ^ o3] = cmul_pk(a2 - a3, c2, s2);
    }
    __syncthreads();
  }
}
template <int LOGN, int NSEQ>
__device__ void fft_dit_inv(float2* buf_) {
  constexpr int N = 1 << LOGN;
  f32x2* buf = (f32x2*)buf_;
  const int tid = tidx();
#pragma unroll
  for (int ps = 0; ps < LOGN / 2; ++ps) {
    const int lh = 2 * ps;
    const int h = 1 << lh;
    const float inv4h = 1.f / (float)(4 * h);
#pragma unroll 4
    for (int qg = tid; qg < NSEQ * N / 4; qg += NT) {
      const int q = qg & (N / 4 - 1), sb = (qg >> (LOGN - 2)) << LOGN;
      const int pos = q & (h - 1), grp = q >> lh;
      const int e0 = sb + swz((grp << (lh + 2)) + pos);
      const int o1 = swz(h), o2 = swz(2 * h), o3 = swz(3 * h);
      const f32x2 x0 = buf[e0], x1 = buf[e0 ^ o1], x2 = buf[e0 ^ o2], x3 = buf[e0 ^ o3];
      const float f2 = (float)pos * inv4h;
      const float c2 = __builtin_amdgcn_cosf(f2), s2 = __builtin_amdgcn_sinf(f2);
      const float c1 = c2 * c2 - s2 * s2, s1 = 2.f * c2 * s2;
      const f32x2 b1 = cmul_pk(x1, c1, s1), b3 = cmul_pk(x3, c1, s1);
      const f32x2 a0 = x0 + b1, a1 = x0 - b1, a2 = x2 + b3, a3 = x2 - b3;
      const f32x2 cc2 = cmul_pk(a2, c2, s2);
      const f32x2 t3 = cmul_pk(a3, c2, s2);
      const f32x2 cc3 = f32x2{-t3.y, t3.x};
      buf[e0] = a0 + cc2;
      buf[e0 ^ o2] = a0 - cc2;
      buf[e0 ^ o1] = a1 + cc3;
      buf[e0 ^ o3] = a1 - cc3;
    }
    __syncthreads();
  }
}
template <int LOGN, int NSEQ>
__device__ void spectrum_extract(const float2* buf, float4* __restrict__ GPa, float4* __restrict__ GPb, float scale_a, float scale_b) {
  constexpr int Lc = 1 << LOGN;
#pragma unroll 2
  for (int jg = tidx(); jg < NSEQ * Lc / 2; jg += NT) {
    const int j = jg & (Lc / 2 - 1), sq = jg >> (LOGN - 1), sb = sq << LOGN;
    float4* GP = sq ? GPb : GPa;
    const float scale = sq ? scale_b : scale_a;
    if (j == 0) {
      const float2 c = buf[sb], ch = buf[sb + 1];
      GP[0] = float4{(c.x + c.y) * scale, (c.x - c.y) * scale, ch.x * scale, -ch.y * scale};
    } else {
      const int pos = 2 * j;
      const int k = (int)(__brev((unsigned)pos) >> (32 - LOGN));
      const int p2 = pos ^ ((1 << (31 - __clz(pos))) - 1);
      const int sp1 = sb + swz(pos), sp2 = sb + swz(p2);
      float2 C1 = buf[sp1], C2 = buf[sp2];
      float2 E{0.5f * (C1.x + C2.x), 0.5f * (C1.y - C2.y)}, D{0.5f * (C1.x - C2.x), 0.5f * (C1.y + C2.y)};
      float2 O{D.y, -D.x};
      const float f = (float)k * (1.f / (float)(2 * Lc));
      const float wc = __builtin_amdgcn_cosf(f), wsn = -__builtin_amdgcn_sinf(f);
      float2 wO{wc * O.x - wsn * O.y, wc * O.y + wsn * O.x};
      GP[j] = float4{(E.x + wO.x) * scale, (E.y + wO.y) * scale, (E.x - wO.x) * scale, -(E.y - wO.y) * scale};
    }
  }
}
template <int LOGN, int NSEQ>
__device__ void spectrum_mul(float2* buf, const float4* __restrict__ GP) {
  constexpr int Lc = 1 << LOGN;
#pragma unroll 2
  for (int jg = tidx(); jg < NSEQ * Lc / 2; jg += NT) {
    const int j = jg & (Lc / 2 - 1), sb = (jg >> (LOGN - 1)) << LOGN;
    const float4 gp = GP[j];
    if (j == 0) {
      const float2 c = buf[sb], ch = buf[sb + 1];
      const float Y0 = (c.x + c.y) * gp.x, YL = (c.x - c.y) * gp.y;
      buf[sb] = float2{0.5f * (Y0 + YL), 0.5f * (Y0 - YL)};
      buf[sb + 1] = float2{ch.x * gp.z + ch.y * gp.w, ch.y * gp.z - ch.x * gp.w};
    } else {
      const int pos = 2 * j;
      const int k = (int)(__brev((unsigned)pos) >> (32 - LOGN));
      const int p2 = pos ^ ((1 << (31 - __clz(pos))) - 1);
      const int sp1 = sb + swz(pos), sp2 = sb + swz(p2);
      float2 C1 = buf[sp1], C2 = buf[sp2];
      float2 E{0.5f * (C1.x + C2.x), 0.5f * (C1.y - C2.y)}, D{0.5f * (C1.x - C2.x), 0.5f * (C1.y + C2.y)};
      float2 O{D.y, -D.x};
      const float f = (float)k * (1.f / (float)(2 * Lc));
      const float wc = __builtin_amdgcn_cosf(f), wsn = -__builtin_amdgcn_sinf(f);
      float2 wO{wc * O.x - wsn * O.y, wc * O.y + wsn * O.x};
      float2 X1{E.x + wO.x, E.y + wO.y}, X2{E.x - wO.x, -(E.y - wO.y)};
      float2 Y1{X1.x * gp.x - X1.y * gp.y, X1.x * gp.y + X1.y * gp.x};
      float2 Y2{X2.x * gp.z - X2.y * gp.w, X2.x * gp.w + X2.y * gp.z};
      float2 Ye{0.5f * (Y1.x + Y2.x), 0.5f * (Y1.y - Y2.y)};
      float2 Dd{0.5f * (Y1.x - Y2.x), 0.5f * (Y1.y + Y2.y)};
      float2 Yo{wc * Dd.x + wsn * Dd.y, wc * Dd.y - wsn * Dd.x};
      buf[sp1] = float2{Ye.x - Yo.y, Ye.y + Yo.x};
      buf[sp2] = float2{Ye.x + Yo.y, -Ye.y + Yo.x};
    }
  }
}

template <int LOGN>
__device__ void hy_conv_item(const Params& p, int i, int c, unsigned char* lds, bool dry) {
  constexpr int Lc = 1 << LOGN;
  constexpr int L = Lc;
  constexpr int NB = (LOGN == 14) ? 2 : 4;
  constexpr int NSEQ = (LOGN == 14) ? 1 : 4;
  constexpr int LOG8 = LOGN - 3;
  const int tid = tidx();
  float2* buf = (float2*)lds;
  float* bufF = (float*)lds;
  float* W3s = (float*)(lds + 131072);
  float* red = W3s + 256;
  float4* GS = (float4*)(p.ws + OFF_GS + (size_t)bidx() * 2 * GS_PER);
  float4* GS1 = GS + GS_PER / 16;
  float* G1tmp = (float*)GS1;
  float* Z1 = (float*)(p.ws + OFF_Z1 + (size_t)bidx() * 65536);
  const float* H2 = (const float*)(p.ws + OFF_H2) + (LOGN == 14 ? (size_t)4096 * 64 : 0);
  const ushort_t* PH = (const ushort_t*)(p.ws + OFF_PH);
  const float delta = 4.605170185988091f * (1.f / 1.5f + (1.f / 0.3f - 1.f / 1.5f) * (float)c / 1023.f);
  __syncthreads();
  if (tid < 256) {
    const int j = tid >> 2, col = tid & 3, o = col >> 1, dirr = col & 1;
    W3s[tid] = p.in[I_FW3][((size_t)i * 64 + j) * 4096 + (dirr * 2 + o) * 1024 + c];
  }
  __syncthreads();
  float ss0 = 0.f, ss1 = 0.f;
  for (int t0 = tid * 4; t0 < L; t0 += NT * 4) {
    float acc[4][4];
#pragma unroll
    for (int r = 0; r < 4; ++r)
#pragma unroll
      for (int cc = 0; cc < 4; ++cc) acc[r][cc] = 0.f;
#pragma unroll 1
    for (int jb = 0; jb < 64; jb += 16) {
      float4 hv[16];
#pragma unroll
      for (int jj = 0; jj < 16; ++jj) hv[jj] = *(const float4*)(H2 + (size_t)(jb + jj) * L + t0);
#pragma unroll
      for (int jj = 0; jj < 16; ++jj) {
        const float4 w = *(const float4*)(W3s + 4 * (jb + jj));
        acc[0][0] += hv[jj].x * w.x; acc[0][1] += hv[jj].x * w.y; acc[0][2] += hv[jj].x * w.z; acc[0][3] += hv[jj].x * w.w;
        acc[1][0] += hv[jj].y * w.x; acc[1][1] += hv[jj].y * w.y; acc[1][2] += hv[jj].y * w.z; acc[1][3] += hv[jj].y * w.w;
        acc[2][0] += hv[jj].z * w.x; acc[2][1] += hv[jj].z * w.y; acc[2][2] += hv[jj].z * w.z; acc[2][3] += hv[jj].z * w.w;
        acc[3][0] += hv[jj].w * w.x; acc[3][1] += hv[jj].w * w.y; acc[3][2] += hv[jj].w * w.z; acc[3][3] += hv[jj].w * w.w;
      }
    }
#pragma unroll
    for (int r = 0; r < 4; ++r) {
      const int t = t0 + r;
      const float dec = expf(-((float)t * (1.f / (float)(L - 1))) * delta);
      const float d0 = acc[r][0] * dec, d1 = acc[r][1] * dec, d2 = acc[r][2] * dec, d3 = acc[r][3] * dec;
      ss0 += d0 * d0 + d1 * d1;
      ss1 += d2 * d2 + d3 * d3;
      if (NSEQ >= 2) {
        bufF[swzF(t)] = d0; bufF[2 * L + swzF(t)] = d2;
        if (t >= 1) { bufF[swzF(2 * L - t)] = d1; bufF[2 * L + swzF(2 * L - t)] = d3; } else { bufF[swzF(L)] = 0.f; bufF[2 * L + swzF(L)] = 0.f; }
      } else {
        bufF[swzF(t)] = d0; G1tmp[t] = d2;
        if (t >= 1) { bufF[swzF(2 * L - t)] = d1; G1tmp[2 * L - t] = d3; } else { bufF[swzF(L)] = 0.f; G1tmp[L] = 0.f; }
      }
    }
  }
  ss0 = wsum(ss0); ss1 = wsum(ss1);
  if ((tid & 63) == 0) { red[tid >> 6] = ss0; red[8 + (tid >> 6)] = ss1; }
  __syncthreads();
  float tot0 = 0.f, tot1 = 0.f;
#pragma unroll
  for (int w = 0; w < 8; ++w) { tot0 += red[w]; tot1 += red[8 + w]; }
  const float sc0 = rsqrtf(tot0) * (1.f / (float)Lc), sc1 = rsqrtf(tot1) * (1.f / (float)Lc);
  if (NSEQ >= 2) {
    fft_dif<LOGN, 2>(buf);
    spectrum_extract<LOGN, 2>(buf, GS, GS1, sc0, sc1);
  } else {
    fft_dif<LOGN, 1>(buf);
    spectrum_extract<LOGN, 1>(buf, GS, GS, sc0, sc0);
    __syncthreads();
    for (int t = tid; t < L; t += NT) buf[swz(t)] = ((const float2*)G1tmp)[t];
    __syncthreads();
    fft_dif<LOGN, 1>(buf);
    spectrum_extract<LOGN, 1>(buf, GS1, GS1, sc1, sc1);
  }
  __threadfence_block();
  __syncthreads();
  const float* sw = p.in[I_HSW] + (size_t)i * 3 * 3072;
  const float* sbias = p.in[I_HSB] + (size_t)i * 3072;
  float cw[3][3], cb[3];
#pragma unroll
  for (int st = 0; st < 3; ++st) {
#pragma unroll
    for (int k = 0; k < 3; ++k) cw[st][k] = sw[k * 3072 + st * 1024 + c];
    cb[st] = sbias[st * 1024 + c];
  }
  const float fb0 = p.in[I_FBIAS][((size_t)i * 2 + 0) * 1024 + c], fb1 = p.in[I_FBIAS][((size_t)i * 2 + 1) * 1024 + c];
  struct Raw8 { uint4 v; float xm, xn; };
  auto ld8 = [&](const ushort_t* sp, int t0) -> Raw8 {
    Raw8 r; r.v = *(const uint4*)(sp + t0);
    r.xm = t0 > 0 ? bf2f(sp[t0 - 1]) : 0.f; r.xn = t0 + 8 < L ? bf2f(sp[t0 + 8]) : 0.f;
    return r;
  };
  auto cv8 = [&](const Raw8& r, int st, float* y) {
    const float x[10] = {r.xm, __uint_as_float(r.v.x << 16), __uint_as_float(r.v.x & 0xffff0000u), __uint_as_float(r.v.y << 16), __uint_as_float(r.v.y & 0xffff0000u),
                         __uint_as_float(r.v.z << 16), __uint_as_float(r.v.z & 0xffff0000u), __uint_as_float(r.v.w << 16), __uint_as_float(r.v.w & 0xffff0000u), r.xn};
#pragma unroll
    for (int j = 0; j < 8; ++j) y[j] = cw[st][0] * x[j] + cw[st][1] * x[j + 1] + cw[st][2] * x[j + 2] + cb[st];
  };
  constexpr int NIT = NSEQ * (L / 8) / NT;
  static_assert(NIT * NT == NSEQ * (L / 8), "elementwise passes assume an exact thread tiling");
  for (int b0 = 0; b0 < NB; b0 += NSEQ) {
    Raw8 rv[NIT], rx1[NIT];
    const ushort_t* pvp[NIT];
    int sqv[NIT], t0v[NIT];
#pragma unroll
    for (int k = 0; k < NIT; ++k) {
      const int w = tid + k * NT;
      sqv[k] = w >> LOG8; t0v[k] = (w & (L / 8 - 1)) * 8;
      const int s0 = (LOGN == 14) ? (TPROMPT + (b0 + sqv[k]) * 16384) : ((b0 + sqv[k]) * 4096);
      pvp[k] = PH + (size_t)s0 * 1024 + (size_t)c * L;
      rv[k] = ld8(pvp[k], t0v[k]);
      rx1[k] = ld8(pvp[k] + (size_t)T * 1024, t0v[k]);
    }
    __syncthreads();
#pragma unroll
    for (int k = 0; k < NIT; ++k) {
      float y[8]; cv8(rv[k], 0, y);
#pragma unroll
      for (int j = 0; j < 4; ++j) { buf[sqv[k] * Lc + swz((t0v[k] >> 1) + j)] = float2{y[2 * j], y[2 * j + 1]}; buf[sqv[k] * Lc + swz(L / 2 + (t0v[k] >> 1) + j)] = float2{0.f, 0.f}; }
    }
    __syncthreads();
    fft_dif<LOGN, NSEQ>(buf);
    spectrum_mul<LOGN, NSEQ>(buf, GS);
    __syncthreads();
    fft_dit_inv<LOGN, NSEQ>(buf);
    float z1[NIT][8];
#pragma unroll
    for (int k = 0; k < NIT; ++k) {
      float z0[8], xa[8]; cv8(rv[k], 0, z0); cv8(rx1[k], 1, xa);
#pragma unroll
      for (int j = 0; j < 4; ++j) {
        const int e = sqv[k] * Lc + swz((t0v[k] >> 1) + j);
        const float2 zc = buf[e];
        z1[k][2 * j] = xa[2 * j] * (zc.x + z0[2 * j] * fb0); z1[k][2 * j + 1] = xa[2 * j + 1] * (zc.y + z0[2 * j + 1] * fb0);
        buf[e] = float2{z1[k][2 * j], z1[k][2 * j + 1]};
        buf[sqv[k] * Lc + swz(L / 2 + (t0v[k] >> 1) + j)] = float2{0.f, 0.f};
      }
    }
    Raw8 rx2[NIT]; uint4 gvv[NIT];
#pragma unroll
    for (int k = 0; k < NIT; ++k) { rx2[k] = ld8(pvp[k] + (size_t)2 * T * 1024, t0v[k]); gvv[k] = *(const uint4*)(pvp[k] + (size_t)3 * T * 1024 + t0v[k]); }
    __syncthreads();
    fft_dif<LOGN, NSEQ>(buf);
    spectrum_mul<LOGN, NSEQ>(buf, GS1);
    __syncthreads();
    fft_dit_inv<LOGN, NSEQ>(buf);
#pragma unroll
    for (int k = 0; k < NIT; ++k) {
      float xb[8]; cv8(rx2[k], 2, xb);
      const unsigned gw[4] = {gvv[k].x, gvv[k].y, gvv[k].z, gvv[k].w};
      unsigned o[4];
#pragma unroll
      for (int j = 0; j < 4; ++j) {
        const float2 zc = buf[sqv[k] * Lc + swz((t0v[k] >> 1) + j)];
        const float g0 = __uint_as_float(gw[j] << 16), g1 = __uint_as_float(gw[j] & 0xffff0000u);
        const float y0 = xb[2 * j] * (zc.x + z1[k][2 * j] * fb1) * (g0 * fast_sigmoid(g0));
        const float y1 = xb[2 * j + 1] * (zc.y + z1[k][2 * j + 1] * fb1) * (g1 * fast_sigmoid(g1));
        o[j] = pack2(y0, y1);
      }
      if (!dry) *(uint4*)((ushort_t*)pvp[k] + (size_t)3 * T * 1024 + t0v[k]) = uint4{o[0], o[1], o[2], o[3]};
    }
  }
}

__device__ void hy_conv_phase(const Params& p, int i, unsigned char* lds, bool dry = false) {
  for (int it = bidx(); it < 2048; it += gridDim.x) {
    if (it < 1024) hy_conv_item<14>(p, i, it, lds, dry);
    else hy_conv_item<12>(p, i, it - 1024, lds, dry);
    __syncthreads();
  }
}

__device__ void prep_even(const Params& p, int i, unsigned char* lds) {
  ushort_t* WB = (ushort_t*)(p.ws + OFF_WB);
  ushort_t* WinT = WB; ushort_t* WoutT = WB + 3328 * 1024; ushort_t* GluT = WoutT + 1024 * 1024;
  transpose_bf16(p.in[I_EWIN] + (size_t)i * 1024 * 3136, WinT, 1024, 3136, lds);
  zero_fill(WinT + 3136 * 1024, 192 * 1024);
  transpose_bf16(p.in[I_EWOUT] + (size_t)i * 1024 * 1024, WoutT, 1024, 1024, lds);
  transpose_bf16(p.in[I_GLUW] + (size_t)i * 512 * 512, GluT, 512, 512, lds);
}
__device__ void prep_odd(const Params& p, int i, unsigned char* lds) {
  ushort_t* WB = (ushort_t*)(p.ws + OFF_WB);
  transpose_bf16(p.in[I_HWIN] + (size_t)i * 1024 * 4096, WB, 1024, 4096, lds);
  transpose_bf16(p.in[I_HWOUT] + (size_t)i * 1024 * 1024, WB + 4096 * 1024, 1024, 1024, lds);
  hy_filter_mlp(p, i);
}
#ifndef PROBE_MASK
#define PROBE_MASK 0
#endif
#ifndef PH_MASK
#define PH_MASK 0x1ffff
#endif
#define PHM(n) ((PH_MASK >> (n)) & 1)
DEVI void run_phase(const Params& p, int ph, unsigned char* lds, bool dry = false) {
  const int layer = ph < NPH_EVEN ? 0 : ph < NPH_EVEN + NPH_ODD ? 1 : ph < 2 * NPH_EVEN + NPH_ODD ? 2 : 3;
  const int base = layer == 0 ? 0 : layer == 1 ? NPH_EVEN : layer == 2 ? NPH_EVEN + NPH_ODD : 2 * NPH_EVEN + NPH_ODD;
  const int sp = ph - base, i = layer >> 1;
  unsigned char* ws = p.ws;
  ushort_t* WB = (ushort_t*)(ws + OFF_WB);
  if ((layer & 1) == 0) {
    ushort_t* WinT = WB; ushort_t* WoutT = WB + 3328 * 1024; ushort_t* GluT = WoutT + 1024 * 1024;
    switch (sp) {
      case 0: if (PHM(0)) {
        prep_even(p, 0, lds);
        xb_convert(p, (ushort_t*)(ws + OFF_Y));
        } break;
      case 1: if (PHM(1)) run_gemm(lds, (const ushort_t*)(ws + OFF_Y), 1024, WinT, 3328, 1024, pg8::EpiEvenIn{(ushort_t*)(ws + OFF_PS5), (ushort_t*)(ws + OFF_PRW)}); break;
      case 2: if (PHM(2)) s5_passA(p, i, lds); break;
      case 3: if (PHM(3)) s5_passC(p, i, lds); break;
      case 4: if (PHM(4)) run_gemm(lds, (const ushort_t*)(ws + OFF_Y) + 512, 1024, GluT, 512, 512, pg8::EpiGlu{(ushort_t*)(ws + OFF_Y), (const ushort_t*)(ws + OFF_PS5), p.in[I_GLUB] + i * 512}); break;
      case 5: if (PHM(5)) rwkv_scan1(p, i, lds); break;
      case 6: if (PHM(6)) rwkv_carry(p, lds, dry); break;
      case 7: if (PHM(7)) rwkv_scan3(p, i, lds, dry); break;
      case 8: if (PHM(8)) rwkv_post(p, i); break;
      case 9: if (PHM(9)) run_gemm(lds, (const ushort_t*)(ws + OFF_Y), 1024, WoutT, 1024, 1024, pg8::EpiF16{(ushort_t*)(ws + OFF_PRW)}); break;
      case 10: if (PHM(10)) { if (!dry) prep_odd(p, i, lds); ln_phase(p, layer, (const ushort_t*)(ws + OFF_PRW), (ushort_t*)(ws + OFF_XB_ODD), dry); } break;
    }
  } else {
    ushort_t* HinT = WB; ushort_t* HoutT = WB + 4096 * 1024;
    switch (sp) {
      case 0: break;
      case 1: if (PHM(12)) run_gemm(lds, (const ushort_t*)(ws + OFF_XB_ODD), 1024, HinT, 4096, 1024, pg8::EpiHyIn{(ushort_t*)(ws + OFF_PH)}); break;
      case 2: if (PHM(13)) hy_conv_phase(p, i, lds, dry); break;
      case 3: if (PHM(14)) hy_transpose((const ushort_t*)(ws + OFF_PH + 3 * SZ1), (ushort_t*)(ws + OFF_PH), lds); break;
      case 4: if (PHM(15)) run_gemm(lds, (const ushort_t*)(ws + OFF_PH), 1024, HoutT, 1024, 1024, pg8::EpiF16{(ushort_t*)(ws + OFF_PH + SZ1)}); break;
      case 5: if (PHM(16)) { if (!dry && layer < 3) prep_even(p, i + 1, lds); ln_phase(p, layer, (const ushort_t*)(ws + OFF_PH + SZ1), layer < 3 ? (ushort_t*)(ws + OFF_Y) : (ushort_t*)nullptr, dry); } break;
    }
  }
}

#define LAS __attribute__((address_space(3)))
#define XB_TMO      128
#define XB_XCNT(j)  (256  + 64 * (j))
#define XB_XSUB(j)  (1280 + 64 * (j))
#define XB_XGEN(j)  (2304 + 64 * (j))
#define XB_TOP      3328
#define XB_TOPGEN   3392
#define XCD_BAR_WORDS 3456
#define XB_SPIN_CAP (1u << 18)
#define LAS __attribute__((address_space(3)))

__device__ __forceinline__ unsigned xb_ld(unsigned* p)              { return __hip_atomic_load(p, __ATOMIC_RELAXED, __HIP_MEMORY_SCOPE_AGENT); }
__device__ __forceinline__ unsigned xb_add(unsigned* p, unsigned v) { return __hip_atomic_fetch_add(p, v, __ATOMIC_RELAXED, __HIP_MEMORY_SCOPE_AGENT); }
__device__ __forceinline__ unsigned xb_xcc_id() { return (unsigned)__builtin_amdgcn_s_getreg((3 << 11) | 20) & 0xFu; }
#define XB_SPIN(cond, bar) do { unsigned _sp = 0; while (cond) { __builtin_amdgcn_s_sleep(1); \
    if ((++_sp & 255u) == 0u) { if (xb_ld(&(bar)[XB_TMO])) break; if (_sp > XB_SPIN_CAP) { atomicAdd(&(bar)[XB_TMO], 1u); break; } } } } while (0)

struct XcdBarrier {
    unsigned* bar; unsigned x;
    volatile LAS unsigned* st;
};

__device__ __forceinline__ XcdBarrier xcd_barrier_post(unsigned* bar, volatile LAS unsigned* st) {
    XcdBarrier b; b.bar = bar; b.x = xb_xcc_id(); b.st = st;
    if (threadIdx.x == 0) (void)xb_add(&bar[XB_XCNT(b.x)], 1u);
    return b;
}
__device__ __forceinline__ void xcd_barrier_complete(unsigned* bar, unsigned x, unsigned& nloc, unsigned& nx) {
    const unsigned G = gridDim.x * gridDim.y * gridDim.z;
    unsigned sum, cnt, mine, sp = 0u;
    for (;;) {
        sum = 0u; cnt = 0u; mine = 0u;
#pragma unroll
        for (unsigned j = 0; j < 16; ++j) { const unsigned c = xb_ld(&bar[XB_XCNT(j)]); sum += c; cnt += (c > 0u) ? 1u : 0u; mine = (j == x) ? c : mine; }
        if (sum == G) break;
        __builtin_amdgcn_s_sleep(1);
        if ((++sp & 255u) == 0u) { if (xb_ld(&bar[XB_TMO])) break; if (sp > XB_SPIN_CAP) { atomicAdd(&bar[XB_TMO], 1u); break; } }
    }
    nloc = mine > 0u ? mine : 1u; nx = cnt > 0u ? cnt : 1u;
}

__device__ __forceinline__ void xcd_barrier(const XcdBarrier& b) {
    asm volatile("s_waitcnt vmcnt(0)" ::: "memory");
    __syncthreads();
    if (threadIdx.x == 0) {
        unsigned* bar = b.bar;
        __builtin_amdgcn_s_waitcnt(0);
        unsigned nloc = b.st[0], nx = b.st[1];
        if (nloc == 0u) { xcd_barrier_complete(bar, b.x, nloc, nx); b.st[0] = nloc; b.st[1] = nx; }
        const unsigned old = xb_add(&bar[XB_XSUB(b.x)], 1u);
        const unsigned gen = old / nloc;
        if (old + 1u == (gen + 1u) * nloc) {
            __builtin_amdgcn_fence(__ATOMIC_RELEASE, "agent");
            asm volatile("s_waitcnt vmcnt(0)" ::: "memory");
            const unsigned og = xb_add(&bar[XB_TOP], 1u);
            const unsigned tg = og / nx;
            if (og + 1u == (tg + 1u) * nx) xb_add(&bar[XB_TOPGEN], 1u);
            else XB_SPIN(xb_ld(&bar[XB_TOPGEN]) == tg, bar);
            __builtin_amdgcn_fence(__ATOMIC_ACQUIRE, "agent");
            xb_add(&bar[XB_XGEN(b.x)], 1u);
            asm volatile("s_waitcnt vmcnt(0)" ::: "memory");
        } else {
            XB_SPIN(xb_ld(&bar[XB_XGEN(b.x)]) == gen, bar);
            __builtin_amdgcn_fence(__ATOMIC_ACQUIRE, "agent");
            asm volatile("s_waitcnt vmcnt(0)" ::: "memory");
        }
    }
    __syncthreads();
}


#if ONE_LAUNCH
__global__ void __launch_bounds__(NT) fwd_kernel(Params p) {
  extern __shared__ __attribute__((aligned(16))) unsigned char lds[];
#if ONE_LAUNCH
  cg::grid_group grid = cg::this_grid();
#endif
#if ONE_LAUNCH
  volatile LAS unsigned* xb_st = (volatile LAS unsigned*)(lds + LDS_BYTES - 16);
  if (threadIdx.x < 2) xb_st[threadIdx.x] = 0u;
  __syncthreads();
  const XcdBarrier xb = xcd_barrier_post((unsigned*)(p.ws + OFF_BAR), xb_st);
#endif
  for (int ph = p.ph_lo; ph < p.ph_hi; ++ph) {
    if (ph == NPH_EVEN || ph == NPH_EVEN + NPH_ODD || ph == 2 * NPH_EVEN + NPH_ODD) continue;
    int reps = 1;
#if PROBE_MASK
    {
      const int lyr = ph < NPH_EVEN ? 0 : ph < NPH_EVEN + NPH_ODD ? 1 : ph < 2 * NPH_EVEN + NPH_ODD ? 2 : 3;
      const int bs = lyr == 0 ? 0 : lyr == 1 ? NPH_EVEN : lyr == 2 ? NPH_EVEN + NPH_ODD : 2 * NPH_EVEN + NPH_ODD;
      const int idx = (lyr & 1) ? NPH_EVEN + (ph - bs) : (ph - bs);
      if ((PROBE_MASK >> idx) & 1) reps = 2;
    }
#endif
    for (int rep = 0; rep < reps; ++rep) {
      run_phase(p, ph, lds, rep + 1 < reps);
#if ONE_LAUNCH
      if (ph + 1 < p.ph_hi || rep + 1 < reps) { if (ph == p.ph_lo && rep == 0) grid.sync(); else xcd_barrier(xb); }
#endif
    }
  }
}
#endif

#if !ONE_LAUNCH
template <int PH> __global__ void __launch_bounds__(NT) phase_kernel(Params p) {
  extern __shared__ __attribute__((aligned(16))) unsigned char lds[];
  run_phase(p, PH, lds);
}
typedef void (*kfn_t)(Params);
#define PK(n) phase_kernel<n>
static kfn_t k_tab[NPHASES] = {PK(0), PK(1), PK(2), PK(3), PK(4), PK(5), PK(6), PK(7), PK(8), PK(9), PK(10), PK(11), PK(12), PK(13), PK(14), PK(15),
                               PK(16), PK(17), PK(18), PK(19), PK(20), PK(21), PK(22), PK(23), PK(24), PK(25), PK(26), PK(27), PK(28), PK(29), PK(30), PK(31), PK(32), PK(33)};
#endif

extern "C" void kernel_launch(void* const* d_in, const int* in_sizes, int n_in, void* d_out, int out_size, void* d_ws, size_t ws_size,
                              hipStream_t stream) {
  static int grid_blocks = 0;
  if (!grid_blocks) {
    if (n_in != 38 || ws_size < WS_NEED || out_size != T * 1024) {
      fprintf(stderr, "kernel_launch: unexpected shapes n_in=%d ws=%zu out=%d\n", n_in, ws_size, out_size);
      grid_blocks = -1; return;
    }
    int dev = 0, cus = 0, per_cu = 0;
    (void)hipGetDevice(&dev);
    (void)hipDeviceGetAttribute(&cus, hipDeviceAttributeMultiprocessorCount, dev);
#if ONE_LAUNCH
    if (hipFuncSetAttribute((const void*)fwd_kernel, hipFuncAttributeMaxDynamicSharedMemorySize, LDS_BYTES) != hipSuccess) {
      fprintf(stderr, "kernel_launch: hipFuncSetAttribute failed\n"); grid_blocks = -1; return;
    }
    (void)hipOccupancyMaxActiveBlocksPerMultiprocessor(&per_cu, (const void*)fwd_kernel, NT, LDS_BYTES);
#else
    for (int ph = 0; ph < NPHASES; ++ph)
      if (hipFuncSetAttribute((const void*)k_tab[ph], hipFuncAttributeMaxDynamicSharedMemorySize, LDS_BYTES) != hipSuccess) {
        fprintf(stderr, "kernel_launch: hipFuncSetAttribute failed\n"); grid_blocks = -1; return;
      }
    per_cu = 1;
#endif
    if (per_cu < 1) { fprintf(stderr, "kernel_launch: occupancy query returned %d\n", per_cu); per_cu = 1; }
    grid_blocks = cus * per_cu;
    if (grid_blocks > 256) grid_blocks = 256;
    if (grid_blocks < 1) grid_blocks = 256;
  }
  if (grid_blocks < 0) return;
  Params p{};
  for (int k = 0; k < 38; ++k) p.in[k] = (const float*)d_in[k];
  p.out = (float*)d_out; p.ws = (unsigned char*)d_ws;
#if ONE_LAUNCH
  if (hipMemsetAsync((unsigned char*)d_ws + OFF_BAR, 0, 16384, stream) != hipSuccess) { fprintf(stderr, "kernel_launch: memset of barrier words failed\n"); return; }
  p.ph_lo = 0; p.ph_hi = NPHASES;
  void* args[] = {&p};
  hipError_t e = hipLaunchCooperativeKernel((const void*)fwd_kernel, dim3(grid_blocks), dim3(NT), args, LDS_BYTES, stream);
  if (e != hipSuccess) fprintf(stderr, "cooperative launch failed: %s (grid %d)\n", hipGetErrorString(e), grid_blocks);
#else
  for (int ph = 0; ph < NPHASES; ++ph) {
    p.ph_lo = ph; p.ph_hi = ph + 1;
    hipLaunchKernelGGL(k_tab[ph], dim3(grid_blocks), dim3(NT), LDS_BYTES, stream, p);
  }
#endif
}
```

```cpp
#include <hip/hip_runtime.h>
#include <hip/hip_cooperative_groups.h>
#include <cstdio>
#include <cstdint>
namespace cg = cooperative_groups;

#ifndef ONE_LAUNCH
#define ONE_LAUNCH 1
#endif

#define DEVI __device__ __forceinline__
constexpr int NT = 512;
constexpr int T = 49152;
constexpr int TPROMPT = 16384;
constexpr int LDS_BYTES = 133120;
constexpr int NPH_EVEN = 11, NPH_ODD = 6;
constexpr int NPHASES = 2 * (NPH_EVEN + NPH_ODD);

typedef __attribute__((ext_vector_type(8))) short bf16x8;
typedef __attribute__((ext_vector_type(4))) float f32x4;
typedef unsigned short ushort_t;
typedef float f32x2 __attribute__((ext_vector_type(2)));

struct Params { const float* in[38]; float* out; unsigned char* ws; int ph_lo; int ph_hi; };

enum { I_XP = 0, I_XS, I_EWIN, I_EWOUT, I_LRE, I_LIM, I_LSTEP, I_BRE, I_BIM, I_CRE, I_CIM, I_S5D, I_GLUW, I_GLUB,
       I_MURKV, I_MULORA, I_W0, I_WUP, I_A0, I_AUP, I_KK, I_KA, I_RK, I_LNXW, I_LNXB,
       I_HWIN, I_HWOUT, I_HSW, I_HSB, I_FW1, I_FB1, I_FFREQ, I_FW2, I_FB2, I_FW3, I_FBIAS, I_LNG, I_LNB };

constexpr size_t SZ1 = (size_t)T * 1024 * 2;
constexpr size_t OFF_PS5 = 0;
constexpr size_t OFF_PRW = OFF_PS5 + SZ1;
constexpr size_t OFF_Y = OFF_PRW + (size_t)T * 2112 * 2;
constexpr size_t OFF_YS = OFF_Y + SZ1;
constexpr size_t OFF_WB = OFF_YS + SZ1;
constexpr size_t OFF_CAR = OFF_WB + 10485760;
constexpr size_t OFF_BAR = OFF_CAR + 6291456;
constexpr size_t WS_NEED = OFF_BAR + 16384;
constexpr size_t OFF_PH = 0;
constexpr size_t OFF_GS = 4 * SZ1;
constexpr size_t GS_PER = 131328;
constexpr size_t OFF_Z1 = OFF_GS + 256 * 2 * GS_PER;
constexpr size_t OFF_XB_ODD = 4 * SZ1;
constexpr size_t OFF_H2 = OFF_XB_ODD + SZ1;

DEVI int tidx() { int t = threadIdx.x; asm volatile("" : "+v"(t)); return t; }
DEVI int bidx() { int b = blockIdx.x; asm volatile("" : "+r"(b)); return __builtin_amdgcn_readfirstlane(b); }
DEVI ushort_t f2bf(float f) { unsigned u = __float_as_uint(f); u += 0x7fffu + ((u >> 16) & 1u); return (ushort_t)(u >> 16); }
DEVI float bf2f(ushort_t h) { return __uint_as_float(((unsigned)h) << 16); }
DEVI unsigned pack2(float a, float b) { return (unsigned)f2bf(a) | ((unsigned)f2bf(b) << 16); }
DEVI float wsum(float v) {
#pragma unroll
  for (int m = 32; m >= 1; m >>= 1) v += __shfl_xor(v, m);
  return v;
}
DEVI void wave_sync() { __builtin_amdgcn_fence(__ATOMIC_RELEASE, "wavefront"); __builtin_amdgcn_wave_barrier(); __builtin_amdgcn_fence(__ATOMIC_ACQUIRE, "wavefront"); }
DEVI void wave_sync_lds() { asm volatile("" ::: "memory"); __builtin_amdgcn_wave_barrier(); asm volatile("" ::: "memory"); }
DEVI void block_sync_lds() { asm volatile("s_waitcnt lgkmcnt(0)" ::: "memory"); __builtin_amdgcn_s_barrier(); asm volatile("" ::: "memory"); }
DEVI void seq_of(int tok, int& s0, int& L) {
  if (tok < TPROMPT) { s0 = tok & ~4095; L = 4096; } else { s0 = TPROMPT + ((tok - TPROMPT) & ~16383); L = 16384; }
}
struct XSrc { const float* xp; const float* xs; const float* xo; };
DEVI XSrc xsrc(const Params& p) {
  XSrc x; x.xp = p.in[I_XP]; x.xs = p.in[I_XS]; x.xo = p.out;
  asm volatile("" : "+r"(x.xp), "+r"(x.xs), "+r"(x.xo));
  return x;
}
DEVI const float* xrow(const XSrc& x, int layer, int tok) {
  if (layer == 0) return tok < TPROMPT ? x.xp + (size_t)tok * 1024 : x.xs + (size_t)(tok - TPROMPT) * 1024;
  return x.xo + (size_t)tok * 1024;
}
DEVI float sigmoidf_(float x) { return 1.f / (1.f + expf(-x)); }
DEVI float fast_sigmoid(float x) { return __builtin_amdgcn_rcpf(1.f + __builtin_amdgcn_exp2f(-1.4426950408889634f * x)); }
DEVI float fast_tanh(float x) { return 1.f - 2.f * __builtin_amdgcn_rcpf(1.f + __builtin_amdgcn_exp2f(2.8853900817779268f * x)); }
DEVI float dpp_mov_f(float x, const int sel) {
  int xi = __builtin_bit_cast(int, x), r;
  if (sel == 0) r = __builtin_amdgcn_mov_dpp(xi, 0xB1, 0xf, 0xf, true);
  else if (sel == 1) r = __builtin_amdgcn_mov_dpp(xi, 0x4E, 0xf, 0xf, true);
  else if (sel == 2) r = __builtin_amdgcn_mov_dpp(xi, 0x141, 0xf, 0xf, true);
  else r = __builtin_amdgcn_mov_dpp(xi, 0x140, 0xf, 0xf, true);
  return __builtin_bit_cast(float, r);
}
DEVI float wsum_fast(float v) {
  v += dpp_mov_f(v, 0); v += dpp_mov_f(v, 1); v += dpp_mov_f(v, 2); v += dpp_mov_f(v, 3);
  const int vi = __builtin_bit_cast(int, v);
  return __builtin_bit_cast(float, __builtin_amdgcn_readlane(vi, 0)) + __builtin_bit_cast(float, __builtin_amdgcn_readlane(vi, 16)) +
         __builtin_bit_cast(float, __builtin_amdgcn_readlane(vi, 32)) + __builtin_bit_cast(float, __builtin_amdgcn_readlane(vi, 48));
}
DEVI float gelu_tanh(float x) { return 0.5f * x * (1.f + tanhf(0.7978845608f * (x + 0.044715f * x * x * x))); }

__device__ void transpose_bf16(const float* __restrict__ in, ushort_t* __restrict__ out, int K, int N, unsigned char* lds) {
  float* tile = (float*)lds;
  const int tid = tidx(), j = tid & 63, i0 = tid >> 6;
  const int tk = K / 64, tn = N / 64;
  for (int t = bidx(); t < tk * tn; t += gridDim.x) {
    const int k0 = (t / tn) * 64, n0 = (t % tn) * 64;
#pragma unroll
    for (int e = 0; e < 8; ++e) { int i = i0 + 8 * e; tile[i * 65 + j] = in[(size_t)(k0 + i) * N + n0 + j]; }
    __syncthreads();
#pragma unroll
    for (int e = 0; e < 8; ++e) { int i = i0 + 8 * e; out[(size_t)(n0 + i) * K + k0 + j] = f2bf(tile[j * 65 + i]); }
    __syncthreads();
  }
}

namespace pg8 {
#define PG8_LAS __attribute__((address_space(3)))
typedef unsigned u32x4 __attribute__((ext_vector_type(4)));
constexpr int BM = 256, BK = 64, HALF = 128, HTB = HALF * BK * 2, STAGE_BYTES = 8 * HTB, NXCD = 8, WGM = 8;
DEVI int lds_byte(int r, int c) { const int st = (r >> 4) * 2 + (c >> 5), rr = r & 15, cc = c & 31, ob = rr * 64 + cc * 2; return st * 1024 + (ob ^ (((ob >> 9) & 1) << 5)); }
DEVI void stage_rc(int b, int& R, int& C) { const int st = b / 1024, sb = b % 1024, swz = sb ^ (((sb >> 9) & 1) << 5); R = (st >> 1) * 16 + swz / 64; C = (st & 1) * 32 + (swz % 64) / 2; }
DEVI int perm32(int rho) { const int n = rho >> 4, i = rho & 15; return 8 * (i >> 2) + 4 * n + (i & 3); }
struct Unit { int pm, pn; };
struct Gemm { const ushort_t* A; const ushort_t* Bt; int M, N, K, lda; };
struct StaticOrder {
  int nM, nN, nwg, G, c;
  DEVI void init(int M, int N, int G_, int c_) { nM = M / BM; nN = N / BM; nwg = nM * nN; G = G_; c = c_; }
  DEVI bool next(int i, Unit& u) const {
    const long L = (long)i * G + c; if (L >= nwg) return false;
    int wgid = (int)L; { const int q = nwg / NXCD, r = nwg % NXCD, xcd = wgid % NXCD, off = wgid / NXCD; wgid = (xcd < r ? xcd * (q + 1) : r * (q + 1) + (xcd - r) * q) + off; }
    const int nig = WGM * nN, gid = wgid / nig, fm = gid * WGM, gsz = (nM - fm) < WGM ? (nM - fm) : WGM;
    u.pm = fm + ((wgid % nig) % gsz); u.pn = (wgid % nig) / gsz; return true;
  }
};
DEVI unsigned cvt_pk_bf16(float lo, float hi) { unsigned r; asm volatile("v_cvt_pk_bf16_f32 %0, %1, %2" : "=v"(r) : "v"(lo), "v"(hi)); return r; }

template <class Epi>
DEVI void gemm_phase(PG8_LAS unsigned char* lds, const Gemm g, const StaticOrder& S, const Epi& E) {
  const int tid = tidx(), wid = __builtin_amdgcn_readfirstlane(tid >> 6), lane = tid & 63, wr = wid >> 2, wc = wid & 3, fr = lane & 15, fq = lane >> 4;
  const int K = g.K, nt = K / BK, lda = g.lda;
  unsigned voffA[2], voffB[2];
#pragma unroll
  for (int i = 0; i < 2; ++i) { int R, C; stage_rc(tid * 16 + i * 8192, R, C); const int Rb = Epi::PERM ? ((R & ~31) + perm32(R & 31)) : R;
    voffA[i] = (unsigned)(R * lda + C) * 2u; voffB[i] = (unsigned)(Rb * K + C) * 2u; }
  const size_t kstep = (size_t)(BK * 2);
  const size_t hstepA = (size_t)HALF * lda * 2, hstepB = (size_t)HALF * K * 2;
  const size_t tstepA = 2 * hstepA, tstepB = 2 * hstepB;
  const unsigned ldsw = (unsigned)wid * 1024u;
  const int aoff = lds_byte(wr * 64 + fr, fq * 8), boff = lds_byte(wc * 32 + fr, fq * 8);
#define PG8_SA(b, h) (((b) * 2 + (h)) * HTB)
#define PG8_SB(b, h) ((4 + (b) * 2 + (h)) * HTB)
#define PG8_STAGE(bufoff, gbase, voff) do { _Pragma("unroll") for (int _i = 0; _i < 2; ++_i) \
    __builtin_amdgcn_global_load_lds((const unsigned*)((const char*)(gbase) + (voff)[_i]), (PG8_LAS unsigned*)(lds + (bufoff) + ldsw + _i * 8192), 16, 0, 0); } while (0)
#define PG8_LDA(dst, b, h) do { _Pragma("unroll") for (int m = 0; m < 4; ++m) _Pragma("unroll") for (int k = 0; k < 2; ++k) dst[m][k] = *(const PG8_LAS bf16x8*)(lds + PG8_SA(b, h) + aoff + m * 2048 + k * 1024); } while (0)
#define PG8_LDB(dst, b, h) do { _Pragma("unroll") for (int n = 0; n < 2; ++n) _Pragma("unroll") for (int k = 0; k < 2; ++k) dst[n][k] = *(const PG8_LAS bf16x8*)(lds + PG8_SB(b, h) + boff + n * 2048 + k * 1024); } while (0)
#define PG8_MMA(ai, bj, At, Bt) do { __builtin_amdgcn_s_setprio(1); _Pragma("unroll") for (int m = 0; m < 4; ++m) _Pragma("unroll") for (int n = 0; n < 2; ++n) _Pragma("unroll") for (int k = 0; k < 2; ++k) \
    acc[ai][bj][m][n] = Epi::TRANS ? __builtin_amdgcn_mfma_f32_16x16x32_bf16(Bt[n][k], At[m][k], acc[ai][bj][m][n], 0, 0, 0) \
                                   : __builtin_amdgcn_mfma_f32_16x16x32_bf16(At[m][k], Bt[n][k], acc[ai][bj][m][n], 0, 0, 0); __builtin_amdgcn_s_setprio(0); } while (0)
#define PG8_WAIT_V(n) asm volatile("s_waitcnt vmcnt(" #n ")" ::: "memory")
#define PG8_WAIT_L(n) asm volatile("s_waitcnt lgkmcnt(" #n ")" ::: "memory")
#define PG8_BAR __builtin_amdgcn_s_barrier()
#define PG8_SCHED __builtin_amdgcn_sched_barrier(0)
  Unit cur, nxt; int ui = 0;
  if (!S.next(0, cur)) return;
  f32x4 acc[2][2][4][2];
#pragma unroll
  for (int a = 0; a < 2; ++a)
#pragma unroll
    for (int b = 0; b < 2; ++b)
#pragma unroll
      for (int m = 0; m < 4; ++m)
#pragma unroll
        for (int n = 0; n < 2; ++n) acc[a][b][m][n] = (f32x4){0.f, 0.f, 0.f, 0.f};
  bf16x8 At[4][2], B0[2][2], B1[2][2];
  const char* cA = (const char*)g.A + (size_t)cur.pm * tstepA; const char* cB = (const char*)g.Bt + (size_t)cur.pn * tstepB;
  PG8_STAGE(PG8_SB(0, 0), cB, voffB); PG8_STAGE(PG8_SA(0, 0), cA, voffA); PG8_STAGE(PG8_SB(0, 1), cB + hstepB, voffB); PG8_STAGE(PG8_SA(0, 1), cA + hstepA, voffA);
  if (wr == 1) PG8_BAR;
  PG8_WAIT_V(4); PG8_BAR;
  PG8_STAGE(PG8_SB(1, 0), cB + kstep, voffB); PG8_STAGE(PG8_SA(1, 0), cA + kstep, voffA); PG8_STAGE(PG8_SB(1, 1), cB + hstepB + kstep, voffB);
  PG8_WAIT_V(6); PG8_BAR;
  for (;;) {
    const bool has_next = S.next(ui + 1, nxt);
    const char* nA = has_next ? (const char*)g.A + (size_t)nxt.pm * tstepA : cA; const char* nB = has_next ? (const char*)g.Bt + (size_t)nxt.pn * tstepB : cB;
    for (int t = 0; t < nt; t += 2) {
      const bool last = (t == nt - 2);
      const char* a1 = cA + (size_t)(t + 1) * kstep;
      const char* a2 = last ? nA : cA + (size_t)(t + 2) * kstep; const char* b2 = last ? nB : cB + (size_t)(t + 2) * kstep;
      const char* a3 = a2 + kstep; const char* b3 = b2 + kstep;
      PG8_LDB(B0, 0, 0); PG8_SCHED; PG8_LDA(At, 0, 0); PG8_STAGE(PG8_SA(1, 1), a1 + hstepA, voffA);
      PG8_WAIT_L(8); PG8_BAR; PG8_WAIT_L(0); PG8_MMA(0, 0, At, B0); PG8_BAR; PG8_SCHED;
      PG8_LDB(B1, 0, 1); PG8_STAGE(PG8_SB(0, 0), b2, voffB);
      PG8_BAR; PG8_WAIT_L(0); PG8_MMA(0, 1, At, B1); PG8_BAR;
      PG8_LDA(At, 0, 1); PG8_STAGE(PG8_SA(0, 0), a2, voffA);
      PG8_BAR; PG8_WAIT_L(0); PG8_MMA(1, 0, At, B0); PG8_BAR; PG8_SCHED;
      PG8_STAGE(PG8_SB(0, 1), b2 + hstepB, voffB);
      PG8_WAIT_V(6); PG8_BAR; PG8_MMA(1, 1, At, B1); PG8_BAR;
      PG8_LDB(B0, 1, 0); PG8_SCHED; PG8_LDA(At, 1, 0); PG8_STAGE(PG8_SA(0, 1), a2 + hstepA, voffA);
      PG8_WAIT_L(8); PG8_BAR; PG8_WAIT_L(0); PG8_MMA(0, 0, At, B0); PG8_BAR; PG8_SCHED;
      PG8_LDB(B1, 1, 1); PG8_STAGE(PG8_SB(1, 0), b3, voffB);
      PG8_BAR; PG8_WAIT_L(0); PG8_MMA(0, 1, At, B1); PG8_BAR;
      PG8_LDA(At, 1, 1); PG8_STAGE(PG8_SA(1, 0), a3, voffA);
      PG8_BAR; PG8_WAIT_L(0); PG8_MMA(1, 0, At, B0); PG8_BAR; PG8_SCHED;
      PG8_STAGE(PG8_SB(1, 1), b3 + hstepB, voffB);
      PG8_WAIT_V(6); PG8_BAR; PG8_MMA(1, 1, At, B1); PG8_BAR;
    }
    E(acc, cur, wr, wc, fr, fq);
    if (!has_next) break;
#pragma unroll
    for (int a = 0; a < 2; ++a)
#pragma unroll
      for (int b = 0; b < 2; ++b)
#pragma unroll
        for (int m = 0; m < 4; ++m)
#pragma unroll
          for (int n = 0; n < 2; ++n) acc[a][b][m][n] = (f32x4){0.f, 0.f, 0.f, 0.f};
    cur = nxt; cA = nA; cB = nB; ++ui;
  }
  PG8_WAIT_V(0);
  if (wr == 0) PG8_BAR;
  PG8_BAR;
#undef PG8_SA
#undef PG8_SB
#undef PG8_STAGE
#undef PG8_LDA
#undef PG8_LDB
#undef PG8_MMA
#undef PG8_WAIT_V
#undef PG8_WAIT_L
#undef PG8_BAR
#undef PG8_SCHED
}

struct EpiEvenIn {
  static constexpr bool PERM = true, TRANS = true;
  ushort_t* ps5; ushort_t* prw;
  DEVI void operator()(const f32x4 (&acc)[2][2][4][2], const Unit& u, int wr, int wc, int fr, int fq) const {
#pragma unroll
    for (int ai = 0; ai < 2; ++ai)
#pragma unroll
      for (int m = 0; m < 4; ++m) {
        const size_t row = (size_t)u.pm * BM + ai * HALF + wr * 64 + m * 16 + fr;
#pragma unroll
        for (int bj = 0; bj < 2; ++bj) {
          const int c0 = u.pn * BM + bj * HALF + wc * 32 + 8 * fq;
          const f32x4 v0 = acc[ai][bj][m][0], v1 = acc[ai][bj][m][1];
          u32x4 o = {cvt_pk_bf16(v0[0], v0[1]), cvt_pk_bf16(v0[2], v0[3]), cvt_pk_bf16(v1[0], v1[1]), cvt_pk_bf16(v1[2], v1[3])};
          if (c0 < 1024) *(u32x4*)(ps5 + row * 1024 + c0) = o;
          else if (c0 < 3136) *(u32x4*)(prw + row * 2112 + (c0 - 1024)) = o;
        }
      }
  }
};
struct EpiHyIn {
  static constexpr bool PERM = false, TRANS = false;
  ushort_t* ph;
  DEVI void operator()(const f32x4 (&acc)[2][2][4][2], const Unit& u, int wr, int wc, int fr, int fq) const {
    int s0, L; seq_of(u.pm * BM, s0, L);
#pragma unroll
    for (int ai = 0; ai < 2; ++ai)
#pragma unroll
      for (int m = 0; m < 4; ++m) {
        const int tok = u.pm * BM + ai * HALF + wr * 64 + m * 16 + 4 * fq;
#pragma unroll
        for (int bj = 0; bj < 2; ++bj)
#pragma unroll
          for (int n = 0; n < 2; ++n) {
            const int col = u.pn * BM + bj * HALF + wc * 32 + 16 * n + fr;
            const int st = col >> 10, c = col & 1023;
            const f32x4 v = acc[ai][bj][m][n];
            ushort_t* dst = ph + (size_t)st * T * 1024 + (size_t)s0 * 1024 + (size_t)c * L + (tok - s0);
            *(uint2*)dst = uint2{cvt_pk_bf16(v[0], v[1]), cvt_pk_bf16(v[2], v[3])};
          }
      }
  }
};
struct EpiGlu {
  static constexpr bool PERM = true, TRANS = true;
  ushort_t* y; const ushort_t* ps5; const float* bias;
  DEVI void operator()(const f32x4 (&acc)[2][2][4][2], const Unit& u, int wr, int wc, int fr, int fq) const {
#pragma unroll
    for (int ai = 0; ai < 2; ++ai)
#pragma unroll
      for (int m = 0; m < 4; ++m) {
        const size_t row = (size_t)u.pm * BM + ai * HALF + wr * 64 + m * 16 + fr;
#pragma unroll
        for (int bj = 0; bj < 2; ++bj) {
          const int c0 = u.pn * BM + bj * HALF + wc * 32 + 8 * fq;
          const u32x4 a8 = *(const u32x4*)(y + row * 1024 + 512 + c0);
          const u32x4 g8 = *(const u32x4*)(ps5 + row * 1024 + 512 + c0);
          const f32x4 b0 = *(const f32x4*)(bias + c0), b1 = *(const f32x4*)(bias + c0 + 4);
          float v[8];
#pragma unroll
          for (int e = 0; e < 4; ++e) { v[e] = acc[ai][bj][m][0][e] + b0[e]; v[4 + e] = acc[ai][bj][m][1][e] + b1[e]; }
          unsigned o[4];
#pragma unroll
          for (int e = 0; e < 4; ++e) {
            const float a_lo = __uint_as_float(a8[e] << 16), a_hi = __uint_as_float(a8[e] & 0xffff0000u);
            const float g_lo = __uint_as_float(g8[e] << 16), g_hi = __uint_as_float(g8[e] & 0xffff0000u);
            const float r_lo = a_lo * sigmoidf_(v[2 * e]) * (g_lo * sigmoidf_(g_lo));
            const float r_hi = a_hi * sigmoidf_(v[2 * e + 1]) * (g_hi * sigmoidf_(g_hi));
            o[e] = cvt_pk_bf16(r_lo, r_hi);
          }
          *(u32x4*)(y + row * 1024 + c0) = u32x4{o[0], o[1], o[2], o[3]};
        }
      }
  }
};
struct EpiF16 {
  static constexpr bool PERM = true, TRANS = true;
  ushort_t* C;
  DEVI void operator()(const f32x4 (&acc)[2][2][4][2], const Unit& u, int wr, int wc, int fr, int fq) const {
#pragma unroll
    for (int ai = 0; ai < 2; ++ai)
#pragma unroll
      for (int m = 0; m < 4; ++m) {
        ushort_t* rowp = C + ((size_t)u.pm * BM + ai * HALF + wr * 64 + m * 16 + fr) * 1024 + u.pn * BM + wc * 32 + 8 * fq;
#pragma unroll
        for (int bj = 0; bj < 2; ++bj) {
          const f32x4 v0 = acc[ai][bj][m][0], v1 = acc[ai][bj][m][1];
          *(u32x4*)(rowp + bj * HALF) = u32x4{cvt_pk_bf16(v0[0], v0[1]), cvt_pk_bf16(v0[2], v0[3]), cvt_pk_bf16(v1[0], v1[1]), cvt_pk_bf16(v1[2], v1[3])};
        }
      }
  }
};
}

template <class Epi>
DEVI void run_gemm(unsigned char* lds, const ushort_t* A, int lda, const ushort_t* Bt, int N, int K, const Epi& E) {
  pg8::Gemm g; g.A = A; g.Bt = Bt; g.M = T; g.N = N; g.K = K; g.lda = lda;
  pg8::StaticOrder S; S.init(T, N, (int)gridDim.x, bidx());
  __syncthreads();
  pg8::gemm_phase<Epi>((PG8_LAS unsigned char*)lds, g, S, E);
  __syncthreads();
}

__device__ void xb_convert(const Params& p, ushort_t* XB) {
  const size_t n4 = (size_t)T * 1024 / 4, np4 = (size_t)TPROMPT * 1024 / 4;
  const float4* xp = (const float4*)p.in[I_XP]; const float4* xs = (const float4*)p.in[I_XS];
  for (size_t e = (size_t)bidx() * NT + tidx(); e < n4; e += (size_t)gridDim.x * NT) {
    const float4 v = e < np4 ? xp[e] : xs[e - np4];
    ((uint2*)XB)[e] = uint2{pack2(v.x, v.y), pack2(v.z, v.w)};
  }
}
__device__ void zero_fill(ushort_t* dst, size_t n) {
  for (size_t e = (size_t)bidx() * NT + tidx(); e < n / 8; e += (size_t)gridDim.x * NT) ((uint4*)dst)[e] = uint4{0, 0, 0, 0};
}
DEVI uint4 hy_tr_load(const ushort_t* __restrict__ PH3, int t, int r, int c8) {
  const int tok0 = (t >> 4) * 64, c0 = (t & 15) * 64;
  int s0, L; seq_of(tok0, s0, L);
  return *(const uint4*)(PH3 + (size_t)s0 * 1024 + (size_t)(c0 + r) * L + (tok0 - s0) + c8);
}
__device__ void hy_transpose(const ushort_t* __restrict__ PH3, ushort_t* __restrict__ Y, unsigned char* lds) {
  ushort_t* tile = (ushort_t*)lds;
  const int tid = tidx(), r = tid >> 3, c8 = (tid & 7) * 8;
  const int nt = (T / 64) * 16, t_first = bidx();
  uint4 v = uint4{0, 0, 0, 0};
  if (t_first < nt) v = hy_tr_load(PH3, t_first, r, c8);
  for (int t = t_first; t < nt; t += gridDim.x) {
    const int tok0 = (t >> 4) * 64, c0 = (t & 15) * 64;
    block_sync_lds();
    *(uint4*)(tile + r * 72 + c8) = v;
    if (t + (int)gridDim.x < nt) v = hy_tr_load(PH3, t + gridDim.x, r, c8);
    block_sync_lds();
    unsigned o[4];
#pragma unroll
    for (int e = 0; e < 4; ++e) o[e] = (unsigned)tile[(c8 + 2 * e) * 72 + r] | ((unsigned)tile[(c8 + 2 * e + 1) * 72 + r] << 16);
    *(uint4*)(Y + (size_t)(tok0 + r) * 1024 + c0 + c8) = uint4{o[0], o[1], o[2], o[3]};
  }
}

struct LnIn { float4 x[2][4]; uint2 f[2][4]; };
DEVI void ln_load(const XSrc& xs_, int layer, const ushort_t* __restrict__ F, int row0, int lane, LnIn& o) {
#pragma unroll
  for (int h = 0; h < 2; ++h) {
    const int row = row0 + h * (T / 2);
    const float4* x4 = (const float4*)xrow(xs_, layer, row);
    const uint2* f2 = (const uint2*)(F + (size_t)row * 1024);
#pragma unroll
    for (int e = 0; e < 4; ++e) { o.x[h][e] = x4[lane + 64 * e]; o.f[h][e] = f2[lane + 64 * e]; }
  }
}
__device__ void ln_phase(const Params& p, int layer, const ushort_t* __restrict__ F, ushort_t* __restrict__ XB, bool dry = false) {
  const int lane = tidx() & 63, gw = bidx() * (NT / 64) + (tidx() >> 6), nw = gridDim.x * (NT / 64);
  const float alpha = 1.681792830507429f;
  const float4* g4 = (const float4*)(p.in[I_LNG] + layer * 1024);
  const float4* b4 = (const float4*)(p.in[I_LNB] + layer * 1024);
  const XSrc xs_ = xsrc(p);
  LnIn cur, nxt;
  if (gw < T / 2) ln_load(xs_, layer, F, gw, lane, cur);
  for (int row0 = gw; row0 < T / 2; row0 += nw) {
    if (row0 + nw < T / 2) ln_load(xs_, layer, F, row0 + nw, lane, nxt);
#pragma unroll
    for (int h = 0; h < 2; ++h) {
      const int row = row0 + h * (T / 2);
      float4 v[4];
      float s = 0.f;
#pragma unroll
      for (int e = 0; e < 4; ++e) {
        const float4 a = cur.x[h][e];
        const uint2 fw = cur.f[h][e];
        v[e] = float4{alpha * a.x + __uint_as_float(fw.x << 16), alpha * a.y + __uint_as_float(fw.x & 0xffff0000u),
                      alpha * a.z + __uint_as_float(fw.y << 16), alpha * a.w + __uint_as_float(fw.y & 0xffff0000u)};
        s += v[e].x + v[e].y + v[e].z + v[e].w;
      }
      const float mean = wsum(s) * (1.f / 1024.f);
      float q = 0.f;
#pragma unroll
      for (int e = 0; e < 4; ++e) {
        v[e].x -= mean; v[e].y -= mean; v[e].z -= mean; v[e].w -= mean;
        q += v[e].x * v[e].x + v[e].y * v[e].y + v[e].z * v[e].z + v[e].w * v[e].w;
      }
      const float rs = rsqrtf(wsum(q) * (1.f / 1024.f) + 1e-5f);
      float4* o4 = (float4*)(p.out + (size_t)row * 1024);
#pragma unroll
      for (int e = 0; e < 4; ++e) {
        const float4 g = g4[lane + 64 * e], b = b4[lane + 64 * e];
        const float4 o = float4{v[e].x * rs * g.x + b.x, v[e].y * rs * g.y + b.y, v[e].z * rs * g.z + b.z, v[e].w * rs * g.w + b.w};
        if (!dry) o4[lane + 64 * e] = o;
        if (XB) ((uint2*)(XB + (size_t)row * 1024))[lane + 64 * e] = uint2{pack2(o.x, o.y), pack2(o.z, o.w)};
      }
    }
    cur = nxt;
  }
}

struct cplx { float x, y; };
DEVI cplx cmul(cplx a, cplx b) { return cplx{a.x * b.x - a.y * b.y, a.x * b.y + a.y * b.x}; }
DEVI void s5_consts(const Params& p, int i, int d, int g, int n, cplx& lb, cplx& coef) {
  const int idx = ((i * 2 + d) * 32 + g) * 64 + n;
  const float lre = p.in[I_LRE][idx], lim = p.in[I_LIM][idx];
  const float dt = expf(p.in[I_LSTEP][(i * 2 + d) * 32 + g]);
  const float mag = expf(lre * dt);
  float sn, cs; sincosf(lim * dt, &sn, &cs);
  lb = cplx{mag * cs, mag * sn};
  const float nr = lb.x - 1.f, ni = lb.y, den = 1.f / (lre * lre + lim * lim);
  coef = cplx{(nr * lre + ni * lim) * den, (ni * lre - nr * lim) * den};
}
DEVI void s5_load_u(const ushort_t* PS5, int tok0, int g, int lane, uint4& a, uint4& b) {
  const uint4* src = (const uint4*)(PS5 + (size_t)(tok0 + lane) * 1024 + g * 16);
  a = src[0]; b = src[1];
}
DEVI void s5_store_u(float* U, int lane, const uint4& a, const uint4& b) {
  float4* d = (float4*)(U + lane * 16);
  d[0] = float4{__uint_as_float(a.x << 16), __uint_as_float(a.x & 0xffff0000u), __uint_as_float(a.y << 16), __uint_as_float(a.y & 0xffff0000u)};
  d[1] = float4{__uint_as_float(a.z << 16), __uint_as_float(a.z & 0xffff0000u), __uint_as_float(a.w << 16), __uint_as_float(a.w & 0xffff0000u)};
  d[2] = float4{__uint_as_float(b.x << 16), __uint_as_float(b.x & 0xffff0000u), __uint_as_float(b.y << 16), __uint_as_float(b.y & 0xffff0000u)};
  d[3] = float4{__uint_as_float(b.z << 16), __uint_as_float(b.z & 0xffff0000u), __uint_as_float(b.w << 16), __uint_as_float(b.w & 0xffff0000u)};
}
DEVI f32x2 cmul2(f32x2 a, f32x2 b) { return f32x2{a.x, a.x} * b + f32x2{a.y, a.y} * f32x2{-b.y, b.x}; }
#define S5_BU2(Urow, acc2)                                                            \
  {                                                                                   \
    const float4* u4 = (const float4*)(Urow);                                         \
    _Pragma("unroll") for (int pp = 0; pp < 4; ++pp) {                                \
      const float4 u = u4[pp];                                                        \
      acc2 = B2[4 * pp] * f32x2{u.x, u.x} + acc2; acc2 = B2[4 * pp + 1] * f32x2{u.y, u.y} + acc2; \
      acc2 = B2[4 * pp + 2] * f32x2{u.z, u.z} + acc2; acc2 = B2[4 * pp + 3] * f32x2{u.w, u.w} + acc2; \
    }                                                                                 \
  }

__device__ void s5_passA(const Params& p, int i, unsigned char* lds) {
  const ushort_t* PS5 = (const ushort_t*)(p.ws + OFF_PS5);
  cplx* CAR = (cplx*)(p.ws + OFF_CAR);
  const int lane = tidx() & 63, wave = tidx() >> 6;
  float* U = (float*)(lds + wave * 8448);
  for (int item = bidx() * 8 + wave; item < 192 * 32; item += gridDim.x * 8) {
    const int q = item >> 5, g = item & 31;
    cplx lb0, c0, lb1, c1;
    s5_consts(p, i, 0, g, lane, lb0, c0);
    s5_consts(p, i, 1, g, lane, lb1, c1);
    const f32x2 l0 = {lb0.x, lb0.y}, l1 = {lb1.x, lb1.y};
    f32x2 B2[16];
#pragma unroll
    for (int pp = 0; pp < 16; ++pp) B2[pp] = f32x2{p.in[I_BRE][((i * 32 + g) * 64 + lane) * 16 + pp], p.in[I_BIM][((i * 32 + g) * 64 + lane) * 16 + pp]};
    f32x2 xf = {0.f, 0.f}, xb = {0.f, 0.f}, pw = {1.f, 0.f};
    uint4 ua, ub;
    s5_load_u(PS5, q * 256, g, lane, ua, ub);
    for (int sb = 0; sb < 4; ++sb) {
      wave_sync();
      s5_store_u(U, lane, ua, ub);
      wave_sync();
      if (sb < 3) s5_load_u(PS5, q * 256 + (sb + 1) * 64, g, lane, ua, ub);
#pragma unroll 4
      for (int t = 0; t < 64; ++t) {
        f32x2 bu = {0.f, 0.f};
        S5_BU2(U + t * 16, bu);
        xf = cmul2(l0, xf) + bu;
        xb = cmul2(pw, bu) + xb;
        pw = cmul2(pw, l1);
      }
    }
    CAR[((size_t)(q * 32 + g) * 2 + 0) * 64 + lane] = cmul(cplx{xf.x, xf.y}, c0);
    CAR[((size_t)(q * 32 + g) * 2 + 1) * 64 + lane] = cmul(cplx{xb.x, xb.y}, c1);
  }
}

__device__ void s5_passC(const Params& p, int i, unsigned char* lds) {
  const ushort_t* PS5 = (const ushort_t*)(p.ws + OFF_PS5);
  const cplx* CAR = (const cplx*)(p.ws + OFF_CAR);
  float* YS = (float*)(p.ws + OFF_YS);
  ushort_t* YG = (ushort_t*)(p.ws + OFF_Y);
  const int lane = tidx() & 63, wave = tidx() >> 6;
  float* U = (float*)(lds + wave * 8448);
  ushort_t* X = (ushort_t*)(lds + wave * 8448 + 4096);
  for (int item = bidx() * 8 + wave; item < 192 * 32; item += gridDim.x * 8) {
    const int q = item >> 5, g = item & 31;
    int cs, ce;
    if (q < 64) { cs = q & ~15; ce = cs + 16; } else { cs = 64 + ((q - 64) & ~63); ce = cs + 64; }
    const int pcol = lane & 15;
    const float dd = p.in[I_S5D][i * 512 + g * 16 + pcol];
    for (int d = 0; d < 2; ++d) {
      cplx lb, coef;
      s5_consts(p, i, d, g, lane, lb, coef);
      const f32x2 l2 = {lb.x, lb.y};
      f32x2 B2[16];
#pragma unroll
      for (int pp = 0; pp < 16; ++pp) {
        const cplx bb = cmul(coef, cplx{p.in[I_BRE][((i * 32 + g) * 64 + lane) * 16 + pp], p.in[I_BIM][((i * 32 + g) * 64 + lane) * 16 + pp]});
        B2[pp] = f32x2{bb.x, bb.y};
      }
      cplx lp = lb;
#pragma unroll
      for (int e = 0; e < 8; ++e) lp = cmul(lp, lp);
      cplx xs{0.f, 0.f};
      if (d == 0) {
#pragma unroll 8
        for (int j = cs; j < q; ++j) { xs = cmul(lp, xs); cplx c = CAR[((size_t)(j * 32 + g) * 2 + 0) * 64 + lane]; xs.x += c.x; xs.y += c.y; } }
      else {
#pragma unroll 8
        for (int j = ce - 1; j > q; --j) { xs = cmul(lp, xs); cplx c = CAR[((size_t)(j * 32 + g) * 2 + 1) * 64 + lane]; xs.x += c.x; xs.y += c.y; } }
      f32x2 x2 = {xs.x, xs.y};
      bf16x8 cf[4];
#pragma unroll
      for (int kk = 0; kk < 4; ++kk) {
        const int n0 = (kk & 1) * 32 + (lane >> 4) * 8;
        const float* src = (kk < 2 ? p.in[I_CRE] : p.in[I_CIM]) + (((size_t)(i * 2 + d) * 32 + g) * 16 + pcol) * 64 + n0;
        const float sg = kk < 2 ? 1.f : -1.f;
#pragma unroll
        for (int j = 0; j < 8; ++j) cf[kk][j] = (short)f2bf(sg * src[j]);
      }
      uint4 ua, ub;
      s5_load_u(PS5, q * 256 + (d ? 3 : 0) * 64, g, lane, ua, ub);
      for (int sbi = 0; sbi < 4; ++sbi) {
        const int sb = d ? 3 - sbi : sbi;
        wave_sync();
        s5_store_u(U, lane, ua, ub);
        wave_sync();
        if (sbi < 3) s5_load_u(PS5, q * 256 + (d ? 2 - sbi : sbi + 1) * 64, g, lane, ua, ub);
        for (int tbi = 0; tbi < 4; ++tbi) {
          const int tb = d ? 3 - tbi : tbi;
          float ysp[4] = {0.f, 0.f, 0.f, 0.f};
          if (d == 1) {
#pragma unroll
            for (int r = 0; r < 4; ++r) ysp[r] = YS[(size_t)(q * 256 + sb * 64 + tb * 16 + (lane >> 4) * 4 + r) * 512 + g * 16 + pcol];
          }
#pragma unroll 4
          for (int tti = 0; tti < 16; ++tti) {
            const int tt = d ? 15 - tti : tti;
            f32x2 acc2 = cmul2(l2, x2);
            S5_BU2(U + (tb * 16 + tt) * 16, acc2);
            x2 = acc2;
            X[tt * 136 + lane] = f2bf(x2.x);
            X[tt * 136 + 64 + lane] = f2bf(x2.y);
          }
          wave_sync();
          f32x4 acc{0.f, 0.f, 0.f, 0.f};
#pragma unroll
          for (int kk = 0; kk < 4; ++kk) {
            bf16x8 a = *(const bf16x8*)(X + (lane & 15) * 136 + kk * 32 + (lane >> 4) * 8);
            acc = __builtin_amdgcn_mfma_f32_16x16x32_bf16(a, cf[kk], acc, 0, 0, 0);
          }
          wave_sync();
#pragma unroll
          for (int r = 0; r < 4; ++r) {
            const int tl = tb * 16 + (lane >> 4) * 4 + r;
            const size_t o = (size_t)(q * 256 + sb * 64 + tl) * 512 + g * 16 + pcol;
            if (d == 0) YS[o] = acc[r] + dd * U[tl * 16 + pcol];
            else {
              const float yv = ysp[r] + acc[r];
              YG[(size_t)(q * 256 + sb * 64 + tl) * 1024 + 512 + g * 16 + pcol] = f2bf(yv * fast_sigmoid(1.5957691216f * (yv + 0.044715f * yv * yv * yv)));
            }
          }
        }
      }
    }
  }
}

struct RwConst { float mur, muk, muv, mul, w0, a0, kk, ka; };
struct RwRow { float r, k, v, l; };
DEVI RwRow rw_load_row(const ushort_t* PRW, int tok, int s0, int L, int h, int lane) {
  RwRow o{0.f, 0.f, 0.f, 0.f};
  if (tok >= s0 && tok < s0 + L) {
    const ushort_t* row = PRW + (size_t)tok * 2112;
    const int cc = h * 64 + lane;
    o.r = bf2f(row[cc]); o.k = bf2f(row[512 + cc]); o.v = bf2f(row[1024 + cc]); o.l = bf2f(row[2048 + lane]);
  }
  return o;
}
DEVI void rw_prologue(const RwRow& rm, const RwRow& rc, const RwRow& rn, int lane, const RwConst& c, const float* WU, const float* AU,
                      float* LT, float* Wd, float* KKd, float* BBd, float* KDd, float* RRd, float* VVd) {
  const float rr = rc.r + c.mur * (0.5f * (rm.r + rn.r) - rc.r);
  const float kx = rc.k + c.muk * (0.5f * (rm.k + rn.k) - rc.k);
  const float vv = rc.v + c.muv * (0.5f * (rm.v + rn.v) - rc.v);
  float ll = rc.l + c.mul * (0.5f * (rm.l + rn.l) - rc.l);
  ll = lane < 32 ? fast_tanh(ll) : ll;
  wave_sync();
  LT[lane] = ll;
  wave_sync();
  float accw = c.w0, acca = c.a0;
#pragma unroll 2
  for (int j = 0; j < 32; j += 4) {
    float4 lw = *(const float4*)(LT + j), la = *(const float4*)(LT + 32 + j);
    accw += lw.x * WU[(j + 0) * 64 + lane] + lw.y * WU[(j + 1) * 64 + lane] + lw.z * WU[(j + 2) * 64 + lane] + lw.w * WU[(j + 3) * 64 + lane];
    acca += la.x * AU[(j + 0) * 64 + lane] + la.y * AU[(j + 1) * 64 + lane] + la.z * AU[(j + 2) * 64 + lane] + la.w * AU[(j + 3) * 64 + lane];
  }
  const float dec = __builtin_amdgcn_exp2f(-0.8750387749145276f * fast_sigmoid(accw));
  const float a = fast_sigmoid(acca);
  const float kkr = kx * c.kk;
  const float ss = wsum_fast(kkr * kkr);
  const float kkn = kkr * __builtin_amdgcn_rsqf(fmaxf(ss, 1e-24f));
  Wd[lane] = dec; KKd[lane] = kkn; BBd[lane] = kkn * a; KDd[lane] = kx * (1.f + (a - 1.f) * c.ka); RRd[lane] = rr; VVd[lane] = vv;
}

template <int NS>
DEVI void rw_prologue_blk(const RwRow* R, int lane, const RwConst& c, const bf16x8* BF, int dir, ushort_t* LTm,
                          float* Wd, float* KKd, float* BBd, float* KDd, float* RRd, float* VVd) {
#pragma unroll
  for (int e = 0; e < NS; ++e) {
    const RwRow& rm = R[e]; const RwRow& rc = R[e + 1]; const RwRow& rn = R[e + 2];
    const float rr = rc.r + c.mur * (0.5f * (rm.r + rn.r) - rc.r);
    const float kx = rc.k + c.muk * (0.5f * (rm.k + rn.k) - rc.k);
    const float vv = rc.v + c.muv * (0.5f * (rm.v + rn.v) - rc.v);
    float ll = rc.l + c.mul * (0.5f * (rm.l + rn.l) - rc.l);
    ll = lane < 32 ? fast_tanh(ll) : ll;
    RRd[e * 64 + lane] = rr; VVd[e * 64 + lane] = vv; KDd[e * 64 + lane] = kx;
    LTm[e * 72 + lane] = f2bf(ll);
  }
  wave_sync_lds();
  {
    const int row = lane & (NS - 1), kq8 = (lane >> 4) * 8;
    const bf16x8 aw = *(const bf16x8*)(LTm + row * 72 + kq8);
    const bf16x8 aa = *(const bf16x8*)(LTm + row * 72 + 32 + kq8);
#pragma unroll
    for (int nt = 0; nt < 4; ++nt) {
      const f32x4 z = {0.f, 0.f, 0.f, 0.f};
      const f32x4 dw = __builtin_amdgcn_mfma_f32_16x16x32_bf16(aw, BF[(dir * 4 + nt) * 64 + lane], z, 0, 0, 0);
      const f32x4 da = __builtin_amdgcn_mfma_f32_16x16x32_bf16(aa, BF[(8 + nt) * 64 + lane], z, 0, 0, 0);
      if ((lane >> 4) < NS / 4) {
#pragma unroll
        for (int r = 0; r < 4; ++r) {
          const int o = ((lane >> 4) * 4 + r) * 64 + nt * 16 + (lane & 15);
          Wd[o] = dw[r]; BBd[o] = da[r];
        }
      }
    }
  }
  wave_sync_lds();
#pragma unroll
  for (int e = 0; e < NS; ++e) {
    const float accw = c.w0 + Wd[e * 64 + lane], acca = c.a0 + BBd[e * 64 + lane], kx = KDd[e * 64 + lane];
    const float dec = __builtin_amdgcn_exp2f(-0.8750387749145276f * fast_sigmoid(accw));
    const float a = fast_sigmoid(acca);
    const float kkr = kx * c.kk;
    const float ss = wsum_fast(kkr * kkr);
    const float kkn = kkr * __builtin_amdgcn_rsqf(fmaxf(ss, 1e-24f));
    Wd[e * 64 + lane] = dec; KKd[e * 64 + lane] = kkn; BBd[e * 64 + lane] = kkn * a; KDd[e * 64 + lane] = kx * (1.f + (a - 1.f) * c.ka);
  }
}
DEVI void rw_fill_bf(const Params& p, int i, int h, bf16x8* BF, int tid, int nthr = NT) {
  for (int e = tid; e < 768; e += nthr) {
    const int which = e >> 8, nt = (e >> 6) & 3, l = e & 63;
    const int n = nt * 16 + (l & 15), k0 = (l >> 4) * 8;
    const float* src = which < 2 ? p.in[I_WUP] + ((size_t)(i * 2 + which) * 32) * 512 : p.in[I_AUP] + ((size_t)i * 32) * 512;
    bf16x8 v;
#pragma unroll
    for (int jj = 0; jj < 8; ++jj) v[jj] = (short)f2bf(src[(size_t)(k0 + jj) * 512 + h * 64 + n]);
    BF[e] = v;
  }
}

DEVI float dpp_f(float x, const int ctrl_sel) {
  int xi = __builtin_bit_cast(int, x), r;
  if (ctrl_sel == 0) r = __builtin_amdgcn_mov_dpp(xi, 0xB1, 0xf, 0xf, true);
  else if (ctrl_sel == 1) r = __builtin_amdgcn_mov_dpp(xi, 0x4E, 0xf, 0xf, true);
  else r = __builtin_amdgcn_mov_dpp(xi, 0x141, 0xf, 0xf, true);
  return __builtin_bit_cast(float, r);
}
DEVI float red8(float x) { x += dpp_f(x, 0); x += dpp_f(x, 1); x += dpp_f(x, 2); return x; }

#define RW_LOAD8(dst2, base)                                                        \
  { const float4 _a = *(const float4*)(base), _b = *(const float4*)((base) + 4);    \
    dst2[0] = f32x2{_a.x, _a.y}; dst2[1] = f32x2{_a.z, _a.w}; dst2[2] = f32x2{_b.x, _b.y}; dst2[3] = f32x2{_b.z, _b.w}; }

__device__ void rwkv_scan1(const Params& p, int i, unsigned char* lds) {
  const ushort_t* PRW = (const ushort_t*)(p.ws + OFF_PRW);
  float* CH = (float*)(p.ws + OFF_PS5);
  float* YR = (float*)(p.ws + OFF_YS);
  const int tid = tidx(), lane = tid & 63, wave = tid >> 6, pair = wave >> 1, role = (wave ^ (wave >> 2)) & 1;
  const int vq = lane >> 3, kq = lane & 7;
  bf16x8* BF = (bf16x8*)lds;
  float* WV = (float*)(lds + 12288 + pair * 26880);
  float* Wd = WV, *KKd = WV + 1024, *BBd = WV + 2048, *KDd = WV + 3072, *RRd = WV + 4096, *VVd = WV + 5120;
  ushort_t* LTm = (ushort_t*)(WV + 6144) + role * 576;
  {
    float4* z = (float4*)YR;
    for (size_t e = (size_t)bidx() * NT + tid; e < (size_t)T * 512 / 4; e += (size_t)gridDim.x * NT) z[e] = float4{0.f, 0.f, 0.f, 0.f};
  }
  for (int bi = bidx(); bi < 768; bi += gridDim.x) {
    const int h = bi / 96, rem = bi % 96;
    const int dir = pair >> 1, q = rem * 2 + (pair & 1);
    __syncthreads();
    rw_fill_bf(p, i, h, BF, tid);
    __syncthreads();
    RwConst c;
    const int cc = h * 64 + lane;
    c.mur = p.in[I_MURKV][(i * 3 + 0) * 512 + cc]; c.muk = p.in[I_MURKV][(i * 3 + 1) * 512 + cc]; c.muv = p.in[I_MURKV][(i * 3 + 2) * 512 + cc];
    c.mul = p.in[I_MULORA][i * 64 + lane];
    c.w0 = p.in[I_W0][(i * 2 + dir) * 512 + cc]; c.a0 = p.in[I_A0][(i * 2 + dir) * 512 + cc];
    c.kk = p.in[I_KK][i * 512 + cc]; c.ka = p.in[I_KA][i * 512 + cc];
    const size_t it = ((size_t)(q * 8 + h) * 2 + dir);
    int sq0, sqL; seq_of(q * 256, sq0, sqL);
    float* Op = CH + it * 8192 + (role ? 0 : 4096);
    f32x2 S2[8][4];
    int diag = (role && vq == kq) ? 1 : 0;
    asm volatile("" : "+v"(diag));
#pragma unroll
    for (int r = 0; r < 8; ++r)
#pragma unroll
      for (int jj = 0; jj < 4; ++jj) S2[r][jj] = f32x2{(diag && (2 * jj == r)) ? 1.f : 0.f, (diag && (2 * jj + 1 == r)) ? 1.f : 0.f};
    const float vsel = role ? 0.f : 1.f;
    RwRow R[10];
#pragma unroll
    for (int j = 0; j < 10; ++j) {
      const int st = role * 8 + j - 1;
      R[j] = rw_load_row(PRW, dir ? (q * 256 + 255 - st) : (q * 256 + st), sq0, sqL, h, lane);
    }
    for (int blk = 0; blk < 16; ++blk) {
      {
        const int s = role * 8;
        rw_prologue_blk<8>(R, lane, c, BF, dir, LTm, Wd + s * 64, KKd + s * 64, BBd + s * 64, KDd + s * 64, RRd + s * 64, VVd + s * 64);
      }
      if (blk + 1 < 16) {
#pragma unroll
        for (int j = 0; j < 10; ++j) {
          const int st = (blk + 1) * 16 + role * 8 + j - 1;
          R[j] = rw_load_row(PRW, dir ? (q * 256 + 255 - st) : (q * 256 + st), sq0, sqL, h, lane);
        }
      }
      block_sync_lds();
#pragma unroll 2
      for (int s = 0; s < 16; ++s) {
        f32x2 kk2[4], w2[4], b2[4], kd2[4], vv2[4];
        RW_LOAD8(kk2, KKd + s * 64 + 8 * kq);
        RW_LOAD8(vv2, VVd + s * 64 + 8 * vq);
        RW_LOAD8(w2, Wd + s * 64 + 8 * kq);
        RW_LOAD8(b2, BBd + s * 64 + 8 * kq);
        RW_LOAD8(kd2, KDd + s * 64 + 8 * kq);
        float sa[8];
#pragma unroll
        for (int r = 0; r < 8; ++r) {
          f32x2 a = S2[r][0] * kk2[0];
          a = S2[r][1] * kk2[1] + a; a = S2[r][2] * kk2[2] + a; a = S2[r][3] * kk2[3] + a;
          sa[r] = -red8(a.x + a.y);
        }
#pragma unroll
        for (int r = 0; r < 8; ++r) {
          const float vr = ((r & 1) ? vv2[r >> 1].y : vv2[r >> 1].x) * vsel;
          const f32x2 sa2 = f32x2{sa[r], sa[r]}, v2 = f32x2{vr, vr};
#pragma unroll
          for (int jj = 0; jj < 4; ++jj) S2[r][jj] = S2[r][jj] * w2[jj] + sa2 * b2[jj] + v2 * kd2[jj];
        }
      }
      block_sync_lds();
    }
#pragma unroll
    for (int r = 0; r < 8; ++r) {
      float* dst = Op + (8 * vq + r) * 64 + 8 * kq;
      *(float4*)dst = float4{S2[r][0].x, S2[r][0].y, S2[r][1].x, S2[r][1].y};
      *(float4*)(dst + 4) = float4{S2[r][2].x, S2[r][2].y, S2[r][3].x, S2[r][3].y};
    }
  }
}

__device__ void rwkv_scan3(const Params& p, int i, unsigned char* lds, bool dry = false) {
  const ushort_t* PRW = (const ushort_t*)(p.ws + OFF_PRW);
  float* CH = (float*)(p.ws + OFF_PS5);
  float* YR = (float*)(p.ws + OFF_YS);
  const int tid = tidx(), lane = tid & 63, wave = tid >> 6;
  const int vq = lane >> 3, kq = lane & 7;
  const int half = wave >> 2;
  bf16x8* BF = (bf16x8*)lds + half * 768;
  float* WV = (float*)(lds + 24576 + wave * 13440);
  float* Wd = WV, *KKd = WV + 512, *BBd = WV + 1024, *KDd = WV + 1536, *RRd = WV + 2048, *VVd = WV + 2560;
  ushort_t* LTm = (ushort_t*)(WV + 3072);
  for (int tb2 = bidx() * 2; tb2 < 512; tb2 += gridDim.x * 2)
  for (int rnd = 0; rnd < 2; ++rnd) {
    const int tb = tb2 >> 1;
    const int hi = tb * 3 + (rnd == 0 ? half : 2);
    const bool active = (rnd == 0) || (half == 0);
    const int h = hi / 96, rem = hi % 96, cgp = rem >> 1, dir = rem & 1;
    const int q = cgp * 4 + (wave & 3);
    __syncthreads();
    if (active) rw_fill_bf(p, i, h, BF, tid & 255, 256);
    __syncthreads();
    if (!active) continue;
    RwConst c;
    const int cc = h * 64 + lane;
    c.mur = p.in[I_MURKV][(i * 3 + 0) * 512 + cc]; c.muk = p.in[I_MURKV][(i * 3 + 1) * 512 + cc]; c.muv = p.in[I_MURKV][(i * 3 + 2) * 512 + cc];
    c.mul = p.in[I_MULORA][i * 64 + lane];
    c.w0 = p.in[I_W0][(i * 2 + dir) * 512 + cc]; c.a0 = p.in[I_A0][(i * 2 + dir) * 512 + cc];
    c.kk = p.in[I_KK][i * 512 + cc]; c.ka = p.in[I_KA][i * 512 + cc];
    const size_t it = ((size_t)(q * 8 + h) * 2 + dir);
    int sq0, sqL; seq_of(q * 256, sq0, sqL);
    const float* Qp = CH + it * 8192 + 4096;
    f32x2 S2[8][4];
#pragma unroll
    for (int r = 0; r < 8; ++r) {
      const float* src = Qp + (8 * vq + r) * 64 + 8 * kq;
      const float4 a = *(const float4*)src, b = *(const float4*)(src + 4);
      S2[r][0] = f32x2{a.x, a.y}; S2[r][1] = f32x2{a.z, a.w}; S2[r][2] = f32x2{b.x, b.y}; S2[r][3] = f32x2{b.z, b.w};
    }
    RwRow R[10];
#pragma unroll
    for (int j = 0; j < 10; ++j) {
      const int st = j - 1;
      R[j] = rw_load_row(PRW, dir ? (q * 256 + 255 - st) : (q * 256 + st), sq0, sqL, h, lane);
    }
    for (int blk = 0; blk < 32; ++blk) {
      rw_prologue_blk<8>(R, lane, c, BF, dir, LTm, Wd, KKd, BBd, KDd, RRd, VVd);
      if (blk + 1 < 32) {
#pragma unroll
        for (int j = 0; j < 10; ++j) {
          const int st = (blk + 1) * 8 + j - 1;
          R[j] = rw_load_row(PRW, dir ? (q * 256 + 255 - st) : (q * 256 + st), sq0, sqL, h, lane);
        }
      }
      wave_sync_lds();
#pragma unroll 2
      for (int s = 0; s < 8; ++s) {
        f32x2 kk2[4], w2[4], b2[4], kd2[4], vv2[4], r2[4];
        RW_LOAD8(kk2, KKd + s * 64 + 8 * kq);
        RW_LOAD8(vv2, VVd + s * 64 + 8 * vq);
        RW_LOAD8(w2, Wd + s * 64 + 8 * kq);
        RW_LOAD8(b2, BBd + s * 64 + 8 * kq);
        RW_LOAD8(kd2, KDd + s * 64 + 8 * kq);
        RW_LOAD8(r2, RRd + s * 64 + 8 * kq);
        float sa[8];
#pragma unroll
        for (int r = 0; r < 8; ++r) {
          f32x2 a = S2[r][0] * kk2[0];
          a = S2[r][1] * kk2[1] + a; a = S2[r][2] * kk2[2] + a; a = S2[r][3] * kk2[3] + a;
          sa[r] = -red8(a.x + a.y);
        }
        float ysel = 0.f;
#pragma unroll
        for (int r = 0; r < 8; ++r) {
          const float vr = (r & 1) ? vv2[r >> 1].y : vv2[r >> 1].x;
          const f32x2 sa2 = f32x2{sa[r], sa[r]}, v2 = f32x2{vr, vr};
          f32x2 ya = f32x2{0.f, 0.f};
#pragma unroll
          for (int jj = 0; jj < 4; ++jj) {
            S2[r][jj] = S2[r][jj] * w2[jj] + sa2 * b2[jj] + v2 * kd2[jj];
            ya = S2[r][jj] * r2[jj] + ya;
          }
          const float yr = red8(ya.x + ya.y);
          ysel = (kq == r) ? yr : ysel;
        }
        const int st = blk * 8 + s;
        const int tok = dir ? (q * 256 + 255 - st) : (q * 256 + st);
        if (!dry) atomicAdd(YR + (size_t)tok * 512 + h * 64 + lane, ysel);
      }
      wave_sync_lds();
    }
  }
}

__device__ void rwkv_carry(const Params& p, unsigned char* lds, bool dry = false) {
  float* CH = (float*)(p.ws + OFF_PS5);
  float* Ps = (float*)lds;
  float* Ss = Ps + 4096;
  const int tid = tidx(), v = tid >> 4, ks = (tid & 15) * 4;
  for (int bi = bidx(); bi < 192; bi += gridDim.x) {
    const int half = bi & 1, dir = (bi >> 1) & 1, h = (bi >> 2) & 7, s = bi >> 5;
    int cs, n;
    if (s < 4) { cs = s * 16; n = 16; } else { cs = 64 + (s - 4) * 64; n = 64; }
    float4 cur{0.f, 0.f, 0.f, 0.f};
    float4 pq0, pq1, qv;
    {
      const int q = dir ? (cs + n - 1) : cs;
      const float* Pp = CH + ((size_t)(q * 8 + h) * 2 + dir) * 8192;
      pq0 = ((const float4*)Pp)[tid]; pq1 = ((const float4*)Pp)[tid + 512];
      qv = *(const float4*)(Pp + 4096 + (half * 32 + v) * 64 + ks);
    }
    for (int ci = 0; ci < n; ++ci) {
      const int q = dir ? (cs + n - 1 - ci) : (cs + ci);
      float* Pp = CH + ((size_t)(q * 8 + h) * 2 + dir) * 8192;
      float* Qrow = Pp + 4096 + (half * 32 + v) * 64 + ks;
      __syncthreads();
      if (!dry) *(float4*)Qrow = cur;
      if (ci == n - 1) break;
      *(float4*)(Ss + v * 64 + ks) = cur;
      ((float4*)Ps)[tid] = pq0;
      ((float4*)Ps)[tid + 512] = pq1;
      float4 acc = qv;
      if (ci + 2 < n + 1 && ci + 1 < n) {
        const int qn = dir ? (cs + n - 2 - ci) : (cs + ci + 1);
        const float* Pn = CH + ((size_t)(qn * 8 + h) * 2 + dir) * 8192;
        pq0 = ((const float4*)Pn)[tid]; pq1 = ((const float4*)Pn)[tid + 512];
        qv = *(const float4*)(Pn + 4096 + (half * 32 + v) * 64 + ks);
      }
      __syncthreads();
#pragma unroll 8
      for (int j = 0; j < 64; ++j) {
        const float sv = Ss[v * 64 + j];
        const float4 pr = *(const float4*)(Ps + j * 64 + ks);
        acc.x += sv * pr.x; acc.y += sv * pr.y; acc.z += sv * pr.z; acc.w += sv * pr.w;
      }
      cur = acc;
    }
    __syncthreads();
  }
}

struct PostIn { float r[6], k[6], v[6], g[4], y[4]; };
DEVI void post_load(const ushort_t* __restrict__ PRW, const float* __restrict__ YR, int item, int lane, PostIn& o) {
  const int tok0 = (item >> 3) * 4, h = item & 7, cc = h * 64 + lane;
  int s0, L; seq_of(tok0, s0, L);
#pragma unroll
  for (int j = 0; j < 6; ++j) {
    const int tok = tok0 - 1 + j;
    o.r[j] = 0.f; o.k[j] = 0.f; o.v[j] = 0.f;
    if (tok >= s0 && tok < s0 + L) {
      const ushort_t* row = PRW + (size_t)tok * 2112;
      o.r[j] = bf2f(row[cc]); o.k[j] = bf2f(row[512 + cc]); o.v[j] = bf2f(row[1024 + cc]);
    }
  }
#pragma unroll
  for (int e = 0; e < 4; ++e) { o.g[e] = bf2f(PRW[(size_t)(tok0 + e) * 2112 + 1536 + cc]); o.y[e] = YR[(size_t)(tok0 + e) * 512 + cc]; }
}
__device__ void rwkv_post(const Params& p, int i) {
  const ushort_t* __restrict__ PRW = (const ushort_t*)(p.ws + OFF_PRW);
  const float* __restrict__ YR = (const float*)(p.ws + OFF_YS);
  ushort_t* __restrict__ Y = (ushort_t*)(p.ws + OFF_Y);
  const int lane = tidx() & 63, gw = bidx() * 8 + (tidx() >> 6), nw = gridDim.x * 8;
  PostIn cur, nxt;
  if (gw < (T / 4) * 8) post_load(PRW, YR, gw, lane, cur);
  for (int item = gw; item < (T / 4) * 8; item += nw) {
    const int tok0 = (item >> 3) * 4, h = item & 7, cc = h * 64 + lane;
    if (item + nw < (T / 4) * 8) post_load(PRW, YR, item + nw, lane, nxt);
    const float mur = p.in[I_MURKV][(i * 3 + 0) * 512 + cc], muk = p.in[I_MURKV][(i * 3 + 1) * 512 + cc], muv = p.in[I_MURKV][(i * 3 + 2) * 512 + cc];
    const float lw = p.in[I_LNXW][i * 512 + cc], lb = p.in[I_LNXB][i * 512 + cc], rk = p.in[I_RK][i * 512 + cc];
#pragma unroll
    for (int e = 0; e < 4; ++e) {
      const float rr = cur.r[e + 1] + mur * (0.5f * (cur.r[e] + cur.r[e + 2]) - cur.r[e + 1]);
      const float kx = cur.k[e + 1] + muk * (0.5f * (cur.k[e] + cur.k[e + 2]) - cur.k[e + 1]);
      const float vv = cur.v[e + 1] + muv * (0.5f * (cur.v[e] + cur.v[e + 2]) - cur.v[e + 1]);
      const float mean = wsum_fast(cur.y[e]) * (1.f / 64.f);
      const float dlt = cur.y[e] - mean;
      const float var = wsum_fast(dlt * dlt) * (1.f / 64.f);
      const float yn = dlt * __builtin_amdgcn_rsqf(var + 64e-5f) * lw + lb;
      const float bonus = wsum_fast(rr * kx * rk) * vv;
      Y[(size_t)(tok0 + e) * 1024 + 512 + cc] = f2bf((yn + bonus) * (cur.g[e] * fast_sigmoid(cur.g[e])));
    }
    cur = nxt;
  }
}

__device__ void hy_filter_mlp(const Params& p, int i) {
  float* H2 = (float*)(p.ws + OFF_H2);
  const int lane = tidx() & 63, gw = bidx() * 8 + (tidx() >> 6), nw = gridDim.x * 8;
  const float fr = p.in[I_FFREQ][i * 64 + lane], b1 = p.in[I_FB1][i * 64 + lane], b2 = p.in[I_FB2][i * 64 + lane];
  for (int row = gw; row < 20480; row += nw) {
    const int L = row < 4096 ? 4096 : 16384, t = row < 4096 ? row : row - 4096;
    const float w = 6.283185307179586f * (float)t / (float)L;
    float z = 0.f;
    if (lane == 0) z = (float)t / (float)(L - 1);
    else if (lane <= 32) {
      const int bi = (lane - 1) & 15;
      const float f = 1e-4f + (float)bi * ((15.f - 1e-4f) / 15.f);
      z = lane <= 16 ? cosf(f * w) : -sinf(f * w);
    }
    float a = b1;
#pragma unroll 3
    for (int k = 0; k < 33; ++k) a += __shfl(z, k) * p.in[I_FW1][((size_t)i * 33 + k) * 64 + lane];
    const float h1 = sinf(fr * a);
    float c = b2;
#pragma unroll 8
    for (int k = 0; k < 64; ++k) c += __shfl(h1, k) * p.in[I_FW2][((size_t)i * 64 + k) * 64 + lane];
    H2[(row < 4096 ? (size_t)0 : (size_t)4096 * 64) + (size_t)lane * L + t] = sinf(fr * c);
  }
}

DEVI constexpr int swz(int i) { return i ^ ((i & 32) ? 21 : 0) ^ ((i & 64) ? 26 : 0); }
DEVI int swzF(int t) { return (swz(t >> 1) << 1) | (t & 1); }
DEVI f32x2 cmul_pk(f32x2 a, float c, float sn) { return a * f32x2{c, c} + f32x2{-a.y, a.x} * f32x2{sn, sn}; }
template <int LOGN, int NSEQ>
__device__ void fft_dif(float2* buf_) {
  constexpr int N = 1 << LOGN;
  f32x2* buf = (f32x2*)buf_;
  const int tid = tidx();
#pragma unroll
  for (int ps = 0; ps < LOGN / 2; ++ps) {
    const int lh = LOGN - 1 - 2 * ps;
    const int h = 1 << lh, hh = h >> 1;
    const float inv2h = 1.f / (float)(2 * h);
#pragma unroll 4
    for (int qg = tid; qg < NSEQ * N / 4; qg += NT) {
      const int q = qg & (N / 4 - 1), sb = (qg >> (LOGN - 2)) << LOGN;
      const int pos = q & (hh - 1), grp = q >> (lh - 1);
      const int e0 = sb + swz((grp << (lh + 1)) + pos);
      const int o1 = swz(hh), o2 = swz(h), o3 = swz(h + hh);
      const f32x2 x0 = buf[e0], x1 = buf[e0 ^ o1], x2 = buf[e0 ^ o2], x3 = buf[e0 ^ o3];
      const float f1 = (float)pos * inv2h;
      const float c1 = __builtin_amdgcn_cosf(f1), s1 = -__builtin_amdgcn_sinf(f1);
      const float c2 = c1 * c1 - s1 * s1, s2 = 2.f * c1 * s1;
      const f32x2 a0 = x0 + x2, a1 = x1 + x3;
      const f32x2 a2 = cmul_pk(x0 - x2, c1, s1);
      const f32x2 t3 = cmul_pk(x1 - x3, c1, s1);
      const f32x2 a3 = f32x2{t3.y, -t3.x};
      buf[e0] = a0 + a1;
      buf[e0 ^ o1] = cmul_pk(a0 - a1, c2, s2);
      buf[e0 ^ o2] = a2 + a3;
      buf[e0 ^ o3] = cmul_pk(a2 - a3, c2, s2);
    }
    __syncthreads();
  }
}
template <int LOGN, int NSEQ>
__device__ void fft_dit_inv(float2* buf_) {
  constexpr int N = 1 << LOGN;
  f32x2* buf = (f32x2*)buf_;
  const int tid = tidx();
#pragma unroll
  for (int ps = 0; ps < LOGN / 2; ++ps) {
    const int lh = 2 * ps;
    const int h = 1 << lh;
    const float inv4h = 1.f / (float)(4 * h);
#pragma unroll 4
    for (int qg = tid; qg < NSEQ * N / 4; qg += NT) {
      const int q = qg & (N / 4 - 1), sb = (qg >> (LOGN - 2)) << LOGN;
      const int pos = q & (h - 1), grp = q >> lh;
      const int e0 = sb + swz((grp << (lh + 2)) + pos);
      const int o1 = swz(h), o2 = swz(2 * h), o3 = swz(3 * h);
      const f32x2 x0 = buf[e0], x1 = buf[e0 ^ o1], x2 = buf[e0 ^ o2], x3 = buf[e0 ^ o3];
      const float f2 = (float)pos * inv4h;
      const float c2 = __builtin_amdgcn_cosf(f2), s2 = __builtin_amdgcn_sinf(f2);
      const float c1 = c2 * c2 - s2 * s2, s1 = 2.f * c2 * s2;
      const f32x2 b1 = cmul_pk(x1, c1, s1), b3 = cmul_pk(x3, c1, s1);
      const f32x2 a0 = x0 + b1, a1 = x0 - b1, a2 = x2 + b3, a3 = x2 - b3;
      const f32x2 cc2 = cmul_pk(a2, c2, s2);
      const f32x2 t3 = cmul_pk(a3, c2, s2);
      const f32x2 cc3 = f32x2{-t3.y, t3.x};
      buf[e0] = a0 + cc2;
      buf[e0 ^ o2] = a0 - cc2;
      buf[e0 ^ o1] = a1 + cc3;
      buf[e0 ^ o3] = a1 - cc3;
    }
    __syncthreads();
  }
}
template <int LOGN, int NSEQ>
__device__ void spectrum_extract(const float2* buf, float4* __restrict__ GPa, float4* __restrict__ GPb, float scale_a, float scale_b) {
  constexpr int Lc = 1 << LOGN;
#pragma unroll 2
  for (int jg = tidx(); jg < NSEQ * Lc / 2; jg += NT) {
    const int j = jg & (Lc / 2 - 1), sq = jg >> (LOGN - 1), sb = sq << LOGN;
    float4* GP = sq ? GPb : GPa;
    const float scale = sq ? scale_b : scale_a;
    if (j == 0) {
      const float2 c = buf[sb], ch = buf[sb + 1];
      GP[0] = float4{(c.x + c.y) * scale, (c.x - c.y) * scale, ch.x * scale, -ch.y * scale};
    } else {
      const int pos = 2 * j;
      const int k = (int)(__brev((unsigned)pos) >> (32 - LOGN));
      const int p2 = pos ^ ((1 << (31 - __clz(pos))) - 1);
      const int sp1 = sb + swz(pos), sp2 = sb + swz(p2);
      float2 C1 = buf[sp1], C2 = buf[sp2];
      float2 E{0.5f * (C1.x + C2.x), 0.5f * (C1.y - C2.y)}, D{0.5f * (C1.x - C2.x), 0.5f * (C1.y + C2.y)};
      float2 O{D.y, -D.x};
      const float f = (float)k * (1.f / (float)(2 * Lc));
      const float wc = __builtin_amdgcn_cosf(f), wsn = -__builtin_amdgcn_sinf(f);
      float2 wO{wc * O.x - wsn * O.y, wc * O.y + wsn * O.x};
      GP[j] = float4{(E.x + wO.x) * scale, (E.y + wO.y) * scale, (E.x - wO.x) * scale, -(E.y - wO.y) * scale};
    }
  }
}
template <int LOGN, int NSEQ>
__device__ void spectrum_mul(float2* buf, const float4* __restrict__ GP) {
  constexpr int Lc = 1 << LOGN;
  constexpr int NITS = NSEQ * Lc / 2 / NT;
  static_assert(NITS % 4 == 0 && NITS * NT == NSEQ * Lc / 2, "spectrum_mul tiling");
  const int tid0 = tidx();
  float4 g4[4], gn[4];
#pragma unroll
  for (int u = 0; u < 4; ++u) g4[u] = GP[(tid0 + u * NT) & (Lc / 2 - 1)];
#pragma unroll 1
  for (int grp = 0; grp < NITS / 4; ++grp) {
    if (grp + 1 < NITS / 4) {
#pragma unroll
      for (int u = 0; u < 4; ++u) gn[u] = GP[(tid0 + ((grp + 1) * 4 + u) * NT) & (Lc / 2 - 1)];
    }
#pragma unroll
  for (int u = 0; u < 4; ++u) {
    const int jg = tid0 + (grp * 4 + u) * NT;
    const int j = jg & (Lc / 2 - 1), sb = (jg >> (LOGN - 1)) << LOGN;
    const float4 gp = g4[u];
    if (j == 0) {
      const float2 c = buf[sb], ch = buf[sb + 1];
      const float Y0 = (c.x + c.y) * gp.x, YL = (c.x - c.y) * gp.y;
      buf[sb] = float2{0.5f * (Y0 + YL), 0.5f * (Y0 - YL)};
      buf[sb + 1] = float2{ch.x * gp.z + ch.y * gp.w, ch.y * gp.z - ch.x * gp.w};
    } else {
      const int pos = 2 * j;
      const int k = (int)(__brev((unsigned)pos) >> (32 - LOGN));
      const int p2 = pos ^ ((1 << (31 - __clz(pos))) - 1);
      const int sp1 = sb + swz(pos), sp2 = sb + swz(p2);
      float2 C1 = buf[sp1], C2 = buf[sp2];
      float2 E{0.5f * (C1.x + C2.x), 0.5f * (C1.y - C2.y)}, D{0.5f * (C1.x - C2.x), 0.5f * (C1.y + C2.y)};
      float2 O{D.y, -D.x};
      const float f = (float)k * (1.f / (float)(2 * Lc));
      const float wc = __builtin_amdgcn_cosf(f), wsn = -__builtin_amdgcn_sinf(f);
      float2 wO{wc * O.x - wsn * O.y, wc * O.y + wsn * O.x};
      float2 X1{E.x + wO.x, E.y + wO.y}, X2{E.x - wO.x, -(E.y - wO.y)};
      float2 Y1{X1.x * gp.x - X1.y * gp.y, X1.x * gp.y + X1.y * gp.x};
      float2 Y2{X2.x * gp.z - X2.y * gp.w, X2.x * gp.w + X2.y * gp.z};
      float2 Ye{0.5f * (Y1.x + Y2.x), 0.5f * (Y1.y - Y2.y)};
      float2 Dd{0.5f * (Y1.x - Y2.x), 0.5f * (Y1.y + Y2.y)};
      float2 Yo{wc * Dd.x + wsn * Dd.y, wc * Dd.y - wsn * Dd.x};
      buf[sp1] = float2{Ye.x - Yo.y, Ye.y + Yo.x};
      buf[sp2] = float2{Ye.x + Yo.y, -Ye.y + Yo.x};
    }
  }
#pragma unroll
    for (int u = 0; u < 4; ++u) g4[u] = gn[u];
  }
}

template <int LOGN>
__device__ void hy_conv_item(const Params& p, int i, int c, unsigned char* lds, bool dry) {
  constexpr int Lc = 1 << LOGN;
  constexpr int L = Lc;
  constexpr int NB = (LOGN == 14) ? 2 : 4;
  constexpr int NSEQ = (LOGN == 14) ? 1 : 4;
  constexpr int LOG8 = LOGN - 3;
  const int tid = tidx();
  float2* buf = (float2*)lds;
  float* bufF = (float*)lds;
  float* W3s = (float*)(lds + 131072);
  float* red = W3s + 256;
  float4* GS = (float4*)(p.ws + OFF_GS + (size_t)bidx() * 2 * GS_PER);
  float4* GS1 = GS + GS_PER / 16;
  float* G1tmp = (float*)GS1;
  float* Z1 = (float*)(p.ws + OFF_Z1 + (size_t)bidx() * 65536);
  const float* H2 = (const float*)(p.ws + OFF_H2) + (LOGN == 14 ? (size_t)4096 * 64 : 0);
  const ushort_t* PH = (const ushort_t*)(p.ws + OFF_PH);
  const float delta = 4.605170185988091f * (1.f / 1.5f + (1.f / 0.3f - 1.f / 1.5f) * (float)c / 1023.f);
  __syncthreads();
  if (tid < 256) {
    const int j = tid >> 2, col = tid & 3, o = col >> 1, dirr = col & 1;
    W3s[tid] = p.in[I_FW3][((size_t)i * 64 + j) * 4096 + (dirr * 2 + o) * 1024 + c];
  }
  __syncthreads();
  float ss0 = 0.f, ss1 = 0.f;
  for (int t0 = tid * 4; t0 < L; t0 += NT * 4) {
    float acc[4][4];
#pragma unroll
    for (int r = 0; r < 4; ++r)
#pragma unroll
      for (int cc = 0; cc < 4; ++cc) acc[r][cc] = 0.f;
#pragma unroll 1
    for (int jb = 0; jb < 64; jb += 16) {
      float4 hv[16];
#pragma unroll
      for (int jj = 0; jj < 16; ++jj) hv[jj] = *(const float4*)(H2 + (size_t)(jb + jj) * L + t0);
#pragma unroll
      for (int jj = 0; jj < 16; ++jj) {
        const float4 w = *(const float4*)(W3s + 4 * (jb + jj));
        acc[0][0] += hv[jj].x * w.x; acc[0][1] += hv[jj].x * w.y; acc[0][2] += hv[jj].x * w.z; acc[0][3] += hv[jj].x * w.w;
        acc[1][0] += hv[jj].y * w.x; acc[1][1] += hv[jj].y * w.y; acc[1][2] += hv[jj].y * w.z; acc[1][3] += hv[jj].y * w.w;
        acc[2][0] += hv[jj].z * w.x; acc[2][1] += hv[jj].z * w.y; acc[2][2] += hv[jj].z * w.z; acc[2][3] += hv[jj].z * w.w;
        acc[3][0] += hv[jj].w * w.x; acc[3][1] += hv[jj].w * w.y; acc[3][2] += hv[jj].w * w.z; acc[3][3] += hv[jj].w * w.w;
      }
    }
#pragma unroll
    for (int r = 0; r < 4; ++r) {
      const int t = t0 + r;
      const float dec = expf(-((float)t * (1.f / (float)(L - 1))) * delta);
      const float d0 = acc[r][0] * dec, d1 = acc[r][1] * dec, d2 = acc[r][2] * dec, d3 = acc[r][3] * dec;
      ss0 += d0 * d0 + d1 * d1;
      ss1 += d2 * d2 + d3 * d3;
      if (NSEQ >= 2) {
        bufF[swzF(t)] = d0; bufF[2 * L + swzF(t)] = d2;
        if (t >= 1) { bufF[swzF(2 * L - t)] = d1; bufF[2 * L + swzF(2 * L - t)] = d3; } else { bufF[swzF(L)] = 0.f; bufF[2 * L + swzF(L)] = 0.f; }
      } else {
        bufF[swzF(t)] = d0; G1tmp[t] = d2;
        if (t >= 1) { bufF[swzF(2 * L - t)] = d1; G1tmp[2 * L - t] = d3; } else { bufF[swzF(L)] = 0.f; G1tmp[L] = 0.f; }
      }
    }
  }
  ss0 = wsum(ss0); ss1 = wsum(ss1);
  if ((tid & 63) == 0) { red[tid >> 6] = ss0; red[8 + (tid >> 6)] = ss1; }
  __syncthreads();
  float tot0 = 0.f, tot1 = 0.f;
#pragma unroll
  for (int w = 0; w < 8; ++w) { tot0 += red[w]; tot1 += red[8 + w]; }
  const float sc0 = rsqrtf(tot0) * (1.f / (float)Lc), sc1 = rsqrtf(tot1) * (1.f / (float)Lc);
  if (NSEQ >= 2) {
    fft_dif<LOGN, 2>(buf);
    spectrum_extract<LOGN, 2>(buf, GS, GS1, sc0, sc1);
  } else {
    fft_dif<LOGN, 1>(buf);
    spectrum_extract<LOGN, 1>(buf, GS, GS, sc0, sc0);
    __syncthreads();
    for (int t = tid; t < L; t += NT) buf[swz(t)] = ((const float2*)G1tmp)[t];
    __syncthreads();
    fft_dif<LOGN, 1>(buf);
    spectrum_extract<LOGN, 1>(buf, GS1, GS1, sc1, sc1);
  }
  __threadfence_block();
  __syncthreads();
  const float* sw = p.in[I_HSW] + (size_t)i * 3 * 3072;
  const float* sbias = p.in[I_HSB] + (size_t)i * 3072;
  float cw[3][3], cb[3];
#pragma unroll
  for (int st = 0; st < 3; ++st) {
#pragma unroll
    for (int k = 0; k < 3; ++k) cw[st][k] = sw[k * 3072 + st * 1024 + c];
    cb[st] = sbias[st * 1024 + c];
  }
  const float fb0 = p.in[I_FBIAS][((size_t)i * 2 + 0) * 1024 + c], fb1 = p.in[I_FBIAS][((size_t)i * 2 + 1) * 1024 + c];
  struct Raw8 { uint4 v; float xm, xn; };
  auto ld8 = [&](const ushort_t* sp, int t0) -> Raw8 {
    Raw8 r; r.v = *(const uint4*)(sp + t0);
    r.xm = t0 > 0 ? bf2f(sp[t0 - 1]) : 0.f; r.xn = t0 + 8 < L ? bf2f(sp[t0 + 8]) : 0.f;
    return r;
  };
  auto cv8 = [&](const Raw8& r, int st, float* y) {
    const float x[10] = {r.xm, __uint_as_float(r.v.x << 16), __uint_as_float(r.v.x & 0xffff0000u), __uint_as_float(r.v.y << 16), __uint_as_float(r.v.y & 0xffff0000u),
                         __uint_as_float(r.v.z << 16), __uint_as_float(r.v.z & 0xffff0000u), __uint_as_float(r.v.w << 16), __uint_as_float(r.v.w & 0xffff0000u), r.xn};
#pragma unroll
    for (int j = 0; j < 8; ++j) y[j] = cw[st][0] * x[j] + cw[st][1] * x[j + 1] + cw[st][2] * x[j + 2] + cb[st];
  };
  constexpr int NIT = NSEQ * (L / 8) / NT;
  static_assert(NIT * NT == NSEQ * (L / 8), "elementwise passes assume an exact thread tiling");
  for (int b0 = 0; b0 < NB; b0 += NSEQ) {
    Raw8 rv[NIT], rx1[NIT];
    const ushort_t* pvp[NIT];
    int sqv[NIT], t0v[NIT];
#pragma unroll
    for (int k = 0; k < NIT; ++k) {
      const int w = tid + k * NT;
      sqv[k] = w >> LOG8; t0v[k] = (w & (L / 8 - 1)) * 8;
      const int s0 = (LOGN == 14) ? (TPROMPT + (b0 + sqv[k]) * 16384) : ((b0 + sqv[k]) * 4096);
      pvp[k] = PH + (size_t)s0 * 1024 + (size_t)c * L;
      rv[k] = ld8(pvp[k], t0v[k]);
      rx1[k] = ld8(pvp[k] + (size_t)T * 1024, t0v[k]);
    }
    __syncthreads();
#pragma unroll
    for (int k = 0; k < NIT; ++k) {
      float y[8]; cv8(rv[k], 0, y);
#pragma unroll
      for (int j = 0; j < 4; ++j) { buf[sqv[k] * Lc + swz((t0v[k] >> 1) + j)] = float2{y[2 * j], y[2 * j + 1]}; buf[sqv[k] * Lc + swz(L / 2 + (t0v[k] >> 1) + j)] = float2{0.f, 0.f}; }
    }
    __syncthreads();
    fft_dif<LOGN, NSEQ>(buf);
    spectrum_mul<LOGN, NSEQ>(buf, GS);
    __syncthreads();
    fft_dit_inv<LOGN, NSEQ>(buf);
    float z1[NIT][8];
#pragma unroll
    for (int k = 0; k < NIT; ++k) {
      float z0[8], xa[8]; cv8(rv[k], 0, z0); cv8(rx1[k], 1, xa);
#pragma unroll
      for (int j = 0; j < 4; ++j) {
        const int e = sqv[k] * Lc + swz((t0v[k] >> 1) + j);
        const float2 zc = buf[e];
        z1[k][2 * j] = xa[2 * j] * (zc.x + z0[2 * j] * fb0); z1[k][2 * j + 1] = xa[2 * j + 1] * (zc.y + z0[2 * j + 1] * fb0);
        buf[e] = float2{z1[k][2 * j], z1[k][2 * j + 1]};
        buf[sqv[k] * Lc + swz(L / 2 + (t0v[k] >> 1) + j)] = float2{0.f, 0.f};
      }
    }
    Raw8 rx2[NIT]; uint4 gvv[NIT];
#pragma unroll
    for (int k = 0; k < NIT; ++k) { rx2[k] = ld8(pvp[k] + (size_t)2 * T * 1024, t0v[k]); gvv[k] = *(const uint4*)(pvp[k] + (size_t)3 * T * 1024 + t0v[k]); }
    __syncthreads();
    fft_dif<LOGN, NSEQ>(buf);
    spectrum_mul<LOGN, NSEQ>(buf, GS1);
    __syncthreads();
    fft_dit_inv<LOGN, NSEQ>(buf);
#pragma unroll
    for (int k = 0; k < NIT; ++k) {
      float xb[8]; cv8(rx2[k], 2, xb);
      const unsigned gw[4] = {gvv[k].x, gvv[k].y, gvv[k].z, gvv[k].w};
      unsigned o[4];
#pragma unroll
      for (int j = 0; j < 4; ++j) {
        const float2 zc = buf[sqv[k] * Lc + swz((t0v[k] >> 1) + j)];
        const float g0 = __uint_as_float(gw[j] << 16), g1 = __uint_as_float(gw[j] & 0xffff0000u);
        const float y0 = xb[2 * j] * (zc.x + z1[k][2 * j] * fb1) * (g0 * fast_sigmoid(g0));
        const float y1 = xb[2 * j + 1] * (zc.y + z1[k][2 * j + 1] * fb1) * (g1 * fast_sigmoid(g1));
        o[j] = pack2(y0, y1);
      }
      if (!dry) *(uint4*)((ushort_t*)pvp[k] + (size_t)3 * T * 1024 + t0v[k]) = uint4{o[0], o[1], o[2], o[3]};
    }
  }
}

__device__ void hy_conv_phase(const Params& p, int i, unsigned char* lds, bool dry = false) {
  for (int it = bidx(); it < 2048; it += gridDim.x) {
    if (it < 1024) hy_conv_item<14>(p, i, it, lds, dry);
    else hy_conv_item<12>(p, i, it - 1024, lds, dry);
    __syncthreads();
  }
}

__device__ void prep_even(const Params& p, int i, unsigned char* lds) {
  ushort_t* WB = (ushort_t*)(p.ws + OFF_WB);
  ushort_t* WinT = WB; ushort_t* WoutT = WB + 3328 * 1024; ushort_t* GluT = WoutT + 1024 * 1024;
  transpose_bf16(p.in[I_EWIN] + (size_t)i * 1024 * 3136, WinT, 1024, 3136, lds);
  zero_fill(WinT + 3136 * 1024, 192 * 1024);
  transpose_bf16(p.in[I_EWOUT] + (size_t)i * 1024 * 1024, WoutT, 1024, 1024, lds);
  transpose_bf16(p.in[I_GLUW] + (size_t)i * 512 * 512, GluT, 512, 512, lds);
}
__device__ void prep_odd(const Params& p, int i, unsigned char* lds) {
  ushort_t* WB = (ushort_t*)(p.ws + OFF_WB);
  transpose_bf16(p.in[I_HWIN] + (size_t)i * 1024 * 4096, WB, 1024, 4096, lds);
  transpose_bf16(p.in[I_HWOUT] + (size_t)i * 1024 * 1024, WB + 4096 * 1024, 1024, 1024, lds);
  hy_filter_mlp(p, i);
}
#ifndef PROBE_MASK
#define PROBE_MASK 0
#endif
#ifndef PH_MASK
#define PH_MASK 0x1ffff
#endif
#define PHM(n) ((PH_MASK >> (n)) & 1)
DEVI void run_phase(const Params& p, int ph, unsigned char* lds, bool dry = false) {
  const int layer = ph < NPH_EVEN ? 0 : ph < NPH_EVEN + NPH_ODD ? 1 : ph < 2 * NPH_EVEN + NPH_ODD ? 2 : 3;
  const int base = layer == 0 ? 0 : layer == 1 ? NPH_EVEN : layer == 2 ? NPH_EVEN + NPH_ODD : 2 * NPH_EVEN + NPH_ODD;
  const int sp = ph - base, i = layer >> 1;
  unsigned char* ws = p.ws;
  ushort_t* WB = (ushort_t*)(ws + OFF_WB);
  if ((layer & 1) == 0) {
    ushort_t* WinT = WB; ushort_t* WoutT = WB + 3328 * 1024; ushort_t* GluT = WoutT + 1024 * 1024;
    switch (sp) {
      case 0: if (PHM(0)) {
        prep_even(p, 0, lds);
        xb_convert(p, (ushort_t*)(ws + OFF_Y));
        } break;
      case 1: if (PHM(1)) run_gemm(lds, (const ushort_t*)(ws + OFF_Y), 1024, WinT, 3328, 1024, pg8::EpiEvenIn{(ushort_t*)(ws + OFF_PS5), (ushort_t*)(ws + OFF_PRW)}); break;
      case 2: if (PHM(2)) s5_passA(p, i, lds); break;
      case 3: if (PHM(3)) s5_passC(p, i, lds); break;
      case 4: if (PHM(4)) run_gemm(lds, (const ushort_t*)(ws + OFF_Y) + 512, 1024, GluT, 512, 512, pg8::EpiGlu{(ushort_t*)(ws + OFF_Y), (const ushort_t*)(ws + OFF_PS5), p.in[I_GLUB] + i * 512}); break;
      case 5: if (PHM(5)) rwkv_scan1(p, i, lds); break;
      case 6: if (PHM(6)) rwkv_carry(p, lds, dry); break;
      case 7: if (PHM(7)) rwkv_scan3(p, i, lds, dry); break;
      case 8: if (PHM(8)) rwkv_post(p, i); break;
      case 9: if (PHM(9)) run_gemm(lds, (const ushort_t*)(ws + OFF_Y), 1024, WoutT, 1024, 1024, pg8::EpiF16{(ushort_t*)(ws + OFF_PRW)}); break;
      case 10: if (PHM(10)) { if (!dry) prep_odd(p, i, lds); ln_phase(p, layer, (const ushort_t*)(ws + OFF_PRW), (ushort_t*)(ws + OFF_XB_ODD), dry); } break;
    }
  } else {
    ushort_t* HinT = WB; ushort_t* HoutT = WB + 4096 * 1024;
    switch (sp) {
      case 0: break;
      case 1: if (PHM(12)) run_gemm(lds, (const ushort_t*)(ws + OFF_XB_ODD), 1024, HinT, 4096, 1024, pg8::EpiHyIn{(ushort_t*)(ws + OFF_PH)}); break;
      case 2: if (PHM(13)) hy_conv_phase(p, i, lds, dry); break;
      case 3: if (PHM(14)) hy_transpose((const ushort_t*)(ws + OFF_PH + 3 * SZ1), (ushort_t*)(ws + OFF_PH), lds); break;
      case 4: if (PHM(15)) run_gemm(lds, (const ushort_t*)(ws + OFF_PH), 1024, HoutT, 1024, 1024, pg8::EpiF16{(ushort_t*)(ws + OFF_PH + SZ1)}); break;
      case 5: if (PHM(16)) { if (!dry && layer < 3) prep_even(p, i + 1, lds); ln_phase(p, layer, (const ushort_t*)(ws + OFF_PH + SZ1), layer < 3 ? (ushort_t*)(ws + OFF_Y) : (ushort_t*)nullptr, dry); } break;
    }
  }
}

#define LAS __attribute__((address_space(3)))
#define XB_TMO      128
#define XB_XCNT(j)  (256  + 64 * (j))
#define XB_XSUB(j)  (1280 + 64 * (j))
#define XB_XGEN(j)  (2304 + 64 * (j))
#define XB_TOP      3328
#define XB_TOPGEN   3392
#define XCD_BAR_WORDS 3456
#define XB_SPIN_CAP (1u << 18)
#define LAS __attribute__((address_space(3)))

__device__ __forceinline__ unsigned xb_ld(unsigned* p)              { return __hip_atomic_load(p, __ATOMIC_RELAXED, __HIP_MEMORY_SCOPE_AGENT); }
__device__ __forceinline__ unsigned xb_add(unsigned* p, unsigned v) { return __hip_atomic_fetch_add(p, v, __ATOMIC_RELAXED, __HIP_MEMORY_SCOPE_AGENT); }
__device__ __forceinline__ unsigned xb_xcc_id() { return (unsigned)__builtin_amdgcn_s_getreg((3 << 11) | 20) & 0xFu; }
#define XB_SPIN(cond, bar) do { unsigned _sp = 0; while (cond) { __builtin_amdgcn_s_sleep(1); \
    if ((++_sp & 255u) == 0u) { if (xb_ld(&(bar)[XB_TMO])) break; if (_sp > XB_SPIN_CAP) { atomicAdd(&(bar)[XB_TMO], 1u); break; } } } } while (0)

struct XcdBarrier {
    unsigned* bar; unsigned x;
    volatile LAS unsigned* st;
};

__device__ __forceinline__ XcdBarrier xcd_barrier_post(unsigned* bar, volatile LAS unsigned* st) {
    XcdBarrier b; b.bar = bar; b.x = xb_xcc_id(); b.st = st;
    if (threadIdx.x == 0) (void)xb_add(&bar[XB_XCNT(b.x)], 1u);
    return b;
}
__device__ __forceinline__ void xcd_barrier_complete(unsigned* bar, unsigned x, unsigned& nloc, unsigned& nx) {
    const unsigned G = gridDim.x * gridDim.y * gridDim.z;
    unsigned sum, cnt, mine, sp = 0u;
    for (;;) {
        sum = 0u; cnt = 0u; mine = 0u;
#pragma unroll
        for (unsigned j = 0; j < 16; ++j) { const unsigned c = xb_ld(&bar[XB_XCNT(j)]); sum += c; cnt += (c > 0u) ? 1u : 0u; mine = (j == x) ? c : mine; }
        if (sum == G) break;
        __builtin_amdgcn_s_sleep(1);
        if ((++sp & 255u) == 0u) { if (xb_ld(&bar[XB_TMO])) break; if (sp > XB_SPIN_CAP) { atomicAdd(&bar[XB_TMO], 1u); break; } }
    }
    nloc = mine > 0u ? mine : 1u; nx = cnt > 0u ? cnt : 1u;
}

__device__ __forceinline__ void xcd_barrier(const XcdBarrier& b) {
    asm volatile("s_waitcnt vmcnt(0)" ::: "memory");
    __syncthreads();
    if (threadIdx.x == 0) {
        unsigned* bar = b.bar;
        __builtin_amdgcn_s_waitcnt(0);
        unsigned nloc = b.st[0], nx = b.st[1];
        if (nloc == 0u) { xcd_barrier_complete(bar, b.x, nloc, nx); b.st[0] = nloc; b.st[1] = nx; }
        const unsigned old = xb_add(&bar[XB_XSUB(b.x)], 1u);
        const unsigned gen = old / nloc;
        if (old + 1u == (gen + 1u) * nloc) {
            __builtin_amdgcn_fence(__ATOMIC_RELEASE, "agent");
            asm volatile("s_waitcnt vmcnt(0)" ::: "memory");
            const unsigned og = xb_add(&bar[XB_TOP], 1u);
            const unsigned tg = og / nx;
            if (og + 1u == (tg + 1u) * nx) xb_add(&bar[XB_TOPGEN], 1u);
            else XB_SPIN(xb_ld(&bar[XB_TOPGEN]) == tg, bar);
            __builtin_amdgcn_fence(__ATOMIC_ACQUIRE, "agent");
            xb_add(&bar[XB_XGEN(b.x)], 1u);
            asm volatile("s_waitcnt vmcnt(0)" ::: "memory");
        } else {
            XB_SPIN(xb_ld(&bar[XB_XGEN(b.x)]) == gen, bar);
            __builtin_amdgcn_fence(__ATOMIC_ACQUIRE, "agent");
            asm volatile("s_waitcnt vmcnt(0)" ::: "memory");
        }
    }
    __syncthreads();
}


#if ONE_LAUNCH
__global__ void __launch_bounds__(NT) fwd_kernel(Params p) {
  extern __shared__ __attribute__((aligned(16))) unsigned char lds[];
#if ONE_LAUNCH
  cg::grid_group grid = cg::this_grid();
#endif
#if ONE_LAUNCH
  volatile LAS unsigned* xb_st = (volatile LAS unsigned*)(lds + LDS_BYTES - 16);
  if (threadIdx.x < 2) xb_st[threadIdx.x] = 0u;
  __syncthreads();
  const XcdBarrier xb = xcd_barrier_post((unsigned*)(p.ws + OFF_BAR), xb_st);
#endif
  for (int ph = p.ph_lo; ph < p.ph_hi; ++ph) {
    if (ph == NPH_EVEN || ph == NPH_EVEN + NPH_ODD || ph == 2 * NPH_EVEN + NPH_ODD) continue;
    int reps = 1;
#if PROBE_MASK
    {
      const int lyr = ph < NPH_EVEN ? 0 : ph < NPH_EVEN + NPH_ODD ? 1 : ph < 2 * NPH_EVEN + NPH_ODD ? 2 : 3;
      const int bs = lyr == 0 ? 0 : lyr == 1 ? NPH_EVEN : lyr == 2 ? NPH_EVEN + NPH_ODD : 2 * NPH_EVEN + NPH_ODD;
      const int idx = (lyr & 1) ? NPH_EVEN + (ph - bs) : (ph - bs);
      if ((PROBE_MASK >> idx) & 1) reps = 2;
    }
#endif
    for (int rep = 0; rep < reps; ++rep) {
      run_phase(p, ph, lds, rep + 1 < reps);
#if ONE_LAUNCH
      if (ph + 1 < p.ph_hi || rep + 1 < reps) { if (ph == p.ph_lo && rep == 0) grid.sync(); else xcd_barrier(xb); }
#endif
    }
  }
}
#endif

#if !ONE_LAUNCH
template <int PH> __global__ void __launch_bounds__(NT) phase_kernel(Params p) {
  extern __shared__ __attribute__((aligned(16))) unsigned char lds[];
  run_phase(p, PH, lds);
}
typedef void (*kfn_t)(Params);
#define PK(n) phase_kernel<n>
static kfn_t k_tab[NPHASES] = {PK(0), PK(1), PK(2), PK(3), PK(4), PK(5), PK(6), PK(7), PK(8), PK(9), PK(10), PK(11), PK(12), PK(13), PK(14), PK(15),
                               PK(16), PK(17), PK(18), PK(19), PK(20), PK(21), PK(22), PK(23), PK(24), PK(25), PK(26), PK(27), PK(28), PK(29), PK(30), PK(31), PK(32), PK(33)};
#endif

extern "C" void kernel_launch(void* const* d_in, const int* in_sizes, int n_in, void* d_out, int out_size, void* d_ws, size_t ws_size,
                              hipStream_t stream) {
  static int grid_blocks = 0;
  if (!grid_blocks) {
    if (n_in != 38 || ws_size < WS_NEED || out_size != T * 1024) {
      fprintf(stderr, "kernel_launch: unexpected shapes n_in=%d ws=%zu out=%d\n", n_in, ws_size, out_size);
      grid_blocks = -1; return;
    }
    int dev = 0, cus = 0, per_cu = 0;
    (void)hipGetDevice(&dev);
    (void)hipDeviceGetAttribute(&cus, hipDeviceAttributeMultiprocessorCount, dev);
#if ONE_LAUNCH
    if (hipFuncSetAttribute((const void*)fwd_kernel, hipFuncAttributeMaxDynamicSharedMemorySize, LDS_BYTES) != hipSuccess) {
      fprintf(stderr, "kernel_launch: hipFuncSetAttribute failed\n"); grid_blocks = -1; return;
    }
    (void)hipOccupancyMaxActiveBlocksPerMultiprocessor(&per_cu, (const void*)fwd_kernel, NT, LDS_BYTES);
#else
    for (int ph = 0; ph < NPHASES; ++ph)
      if (hipFuncSetAttribute((const void*)k_tab[ph], hipFuncAttributeMaxDynamicSharedMemorySize, LDS_BYTES) != hipSuccess) {
        fprintf(stderr, "kernel_launch: hipFuncSetAttribute failed\n"); grid_blocks = -1; return;
      }
    per_cu = 1;
#endif
    if (per_cu < 1) { fprintf(stderr, "kernel_launch: occupancy query returned %d\n", per_cu); per_cu = 1; }
    grid_blocks = cus * per_cu;
    if (grid_blocks > 256) grid_blocks = 256;
    if (grid_blocks < 1) grid_blocks = 256;
  }
  if (grid_blocks < 0) return;
  Params p{};
  for (int k = 0; k < 38; ++k) p.in[k] = (const float*)d_in[k];
  p.out = (float*)d_out; p.ws = (unsigned char*)d_ws;
#if ONE_LAUNCH
  if (hipMemsetAsync((unsigned char*)d_ws + OFF_BAR, 0, 16384, stream) != hipSuccess) { fprintf(stderr, "kernel_launch: memset of barrier words failed\n"); return; }
  p.ph_lo = 0; p.ph_hi = NPHASES;
  void* args[] = {&p};
  hipError_t e = hipLaunchCooperativeKernel((const void*)fwd_kernel, dim3(grid_blocks), dim3(NT), args, LDS_BYTES, stream);
  if (e != hipSuccess) fprintf(stderr, "cooperative launch failed: %s (grid %d)\n", hipGetErrorString(e), grid_blocks);
#else
  for (int ph = 0; ph < NPHASES; ++ph) {
    p.ph_lo = ph; p.ph_hi = ph + 1;
    hipLaunchKernelGGL(k_tab[ph], dim3(grid_blocks), dim3(NT), LDS_BYTES, stream, p);
  }
#endif
}
```

```cpp
#include <hip/hip_runtime.h>
#include <hip/hip_cooperative_groups.h>
#include <cstdio>
#include <cstdint>
namespace cg = cooperative_groups;

#ifndef ONE_LAUNCH
#define ONE_LAUNCH 1
#endif

#define DEVI __device__ __forceinline__
constexpr int NT = 512;
constexpr int T = 49152;
constexpr int TPROMPT = 16384;
constexpr int LDS_BYTES = 133120;
constexpr int NPH_EVEN = 11, NPH_ODD = 6;
constexpr int NPHASES = 2 * (NPH_EVEN + NPH_ODD);

typedef __attribute__((ext_vector_type(8))) short bf16x8;
typedef __attribute__((ext_vector_type(4))) float f32x4;
typedef unsigned short ushort_t;
typedef float f32x2 __attribute__((ext_vector_type(2)));

struct Params { const float* in[38]; float* out; unsigned char* ws; int ph_lo; int ph_hi; };

enum { I_XP = 0, I_XS, I_EWIN, I_EWOUT, I_LRE, I_LIM, I_LSTEP, I_BRE, I_BIM, I_CRE, I_CIM, I_S5D, I_GLUW, I_GLUB,
       I_MURKV, I_MULORA, I_W0, I_WUP, I_A0, I_AUP, I_KK, I_KA, I_RK, I_LNXW, I_LNXB,
       I_HWIN, I_HWOUT, I_HSW, I_HSB, I_FW1, I_FB1, I_FFREQ, I_FW2, I_FB2, I_FW3, I_FBIAS, I_LNG, I_LNB };

constexpr size_t SZ1 = (size_t)T * 1024 * 2;
constexpr size_t OFF_PS5 = 0;
constexpr size_t OFF_PRW = OFF_PS5 + SZ1;
constexpr size_t OFF_Y = OFF_PRW + (size_t)T * 2112 * 2;
constexpr size_t OFF_YS = OFF_Y + SZ1;
constexpr size_t OFF_WB = OFF_YS + SZ1;
constexpr size_t OFF_CAR = OFF_WB + 10485760;
constexpr size_t OFF_BAR = OFF_CAR + 6291456;
constexpr size_t WS_NEED = OFF_BAR + 16384;
constexpr size_t OFF_PH = 0;
constexpr size_t OFF_GS = 4 * SZ1;
constexpr size_t GS_PER = 131328;
constexpr size_t OFF_Z1 = OFF_GS + 256 * 2 * GS_PER;
constexpr size_t OFF_XB_ODD = 4 * SZ1;
constexpr size_t OFF_H2 = OFF_XB_ODD + SZ1;

DEVI int tidx() { int t = threadIdx.x; asm volatile("" : "+v"(t)); return t; }
DEVI int bidx() { int b = blockIdx.x; asm volatile("" : "+r"(b)); return __builtin_amdgcn_readfirstlane(b); }
DEVI ushort_t f2bf(float f) { unsigned u = __float_as_uint(f); u += 0x7fffu + ((u >> 16) & 1u); return (ushort_t)(u >> 16); }
DEVI float bf2f(ushort_t h) { return __uint_as_float(((unsigned)h) << 16); }
DEVI unsigned pack2(float a, float b) { return (unsigned)f2bf(a) | ((unsigned)f2bf(b) << 16); }
DEVI float wsum(float v) {
#pragma unroll
  for (int m = 32; m >= 1; m >>= 1) v += __shfl_xor(v, m);
  return v;
}
DEVI void wave_sync() { __builtin_amdgcn_fence(__ATOMIC_RELEASE, "wavefront"); __builtin_amdgcn_wave_barrier(); __builtin_amdgcn_fence(__ATOMIC_ACQUIRE, "wavefront"); }
DEVI void wave_sync_lds() { asm volatile("" ::: "memory"); __builtin_amdgcn_wave_barrier(); asm volatile("" ::: "memory"); }
DEVI void block_sync_lds() { asm volatile("s_waitcnt lgkmcnt(0)" ::: "memory"); __builtin_amdgcn_s_barrier(); asm volatile("" ::: "memory"); }
DEVI void seq_of(int tok, int& s0, int& L) {
  if (tok < TPROMPT) { s0 = tok & ~4095; L = 4096; } else { s0 = TPROMPT + ((tok - TPROMPT) & ~16383); L = 16384; }
}
struct XSrc { const float* xp; const float* xs; const float* xo; };
DEVI XSrc xsrc(const Params& p) {
  XSrc x; x.xp = p.in[I_XP]; x.xs = p.in[I_XS]; x.xo = p.out;
  asm volatile("" : "+r"(x.xp), "+r"(x.xs), "+r"(x.xo));
  return x;
}
DEVI const float* xrow(const XSrc& x, int layer, int tok) {
  if (layer == 0) return tok < TPROMPT ? x.xp + (size_t)tok * 1024 : x.xs + (size_t)(tok - TPROMPT) * 1024;
  return x.xo + (size_t)tok * 1024;
}
DEVI float sigmoidf_(float x) { return 1.f / (1.f + expf(-x)); }
DEVI float fast_sigmoid(float x) { return __builtin_amdgcn_rcpf(1.f + __builtin_amdgcn_exp2f(-1.4426950408889634f * x)); }
DEVI float fast_tanh(float x) { return 1.f - 2.f * __builtin_amdgcn_rcpf(1.f + __builtin_amdgcn_exp2f(2.8853900817779268f * x)); }
DEVI float dpp_mov_f(float x, const int sel) {
  int xi = __builtin_bit_cast(int, x), r;
  if (sel == 0) r = __builtin_amdgcn_mov_dpp(xi, 0xB1, 0xf, 0xf, true);
  else if (sel == 1) r = __builtin_amdgcn_mov_dpp(xi, 0x4E, 0xf, 0xf, true);
  else if (sel == 2) r = __builtin_amdgcn_mov_dpp(xi, 0x141, 0xf, 0xf, true);
  else r = __builtin_amdgcn_mov_dpp(xi, 0x140, 0xf, 0xf, true);
  return __builtin_bit_cast(float, r);
}
DEVI float wsum_fast(float v) {
  v += dpp_mov_f(v, 0); v += dpp_mov_f(v, 1); v += dpp_mov_f(v, 2); v += dpp_mov_f(v, 3);
  const int vi = __builtin_bit_cast(int, v);
  return __builtin_bit_cast(float, __builtin_amdgcn_readlane(vi, 0)) + __builtin_bit_cast(float, __builtin_amdgcn_readlane(vi, 16)) +
         __builtin_bit_cast(float, __builtin_amdgcn_readlane(vi, 32)) + __builtin_bit_cast(float, __builtin_amdgcn_readlane(vi, 48));
}
DEVI float gelu_tanh(float x) { return 0.5f * x * (1.f + tanhf(0.7978845608f * (x + 0.044715f * x * x * x))); }

__device__ void transpose_bf16(const float* __restrict__ in, ushort_t* __restrict__ out, int K, int N, unsigned char* lds) {
  float* tile = (float*)lds;
  const int tid = tidx(), j = tid & 63, i0 = tid >> 6;
  const int tk = K / 64, tn = N / 64;
  for (int t = bidx(); t < tk * tn; t += gridDim.x) {
    const int k0 = (t / tn) * 64, n0 = (t % tn) * 64;
#pragma unroll
    for (int e = 0; e < 8; ++e) { int i = i0 + 8 * e; tile[i * 65 + j] = in[(size_t)(k0 + i) * N + n0 + j]; }
    __syncthreads();
#pragma unroll
    for (int e = 0; e < 8; ++e) { int i = i0 + 8 * e; out[(size_t)(n0 + i) * K + k0 + j] = f2bf(tile[j * 65 + i]); }
    __syncthreads();
  }
}

namespace pg8 {
#define PG8_LAS __attribute__((address_space(3)))
typedef unsigned u32x4 __attribute__((ext_vector_type(4)));
constexpr int BM = 256, BK = 64, HALF = 128, HTB = HALF * BK * 2, STAGE_BYTES = 8 * HTB, NXCD = 8, WGM = 8;
DEVI int lds_byte(int r, int c) { const int st = (r >> 4) * 2 + (c >> 5), rr = r & 15, cc = c & 31, ob = rr * 64 + cc * 2; return st * 1024 + (ob ^ (((ob >> 9) & 1) << 5)); }
DEVI void stage_rc(int b, int& R, int& C) { const int st = b / 1024, sb = b % 1024, swz = sb ^ (((sb >> 9) & 1) << 5); R = (st >> 1) * 16 + swz / 64; C = (st & 1) * 32 + (swz % 64) / 2; }
DEVI int perm32(int rho) { const int n = rho >> 4, i = rho & 15; return 8 * (i >> 2) + 4 * n + (i & 3); }
struct Unit { int pm, pn; };
struct Gemm { const ushort_t* A; const ushort_t* Bt; int M, N, K, lda; };
struct StaticOrder {
  int nM, nN, nwg, G, c;
  DEVI void init(int M, int N, int G_, int c_) { nM = M / BM; nN = N / BM; nwg = nM * nN; G = G_; c = c_; }
  DEVI bool next(int i, Unit& u) const {
    const long L = (long)i * G + c; if (L >= nwg) return false;
    int wgid = (int)L; { const int q = nwg / NXCD, r = nwg % NXCD, xcd = wgid % NXCD, off = wgid / NXCD; wgid = (xcd < r ? xcd * (q + 1) : r * (q + 1) + (xcd - r) * q) + off; }
    const int nig = WGM * nN, gid = wgid / nig, fm = gid * WGM, gsz = (nM - fm) < WGM ? (nM - fm) : WGM;
    u.pm = fm + ((wgid % nig) % gsz); u.pn = (wgid % nig) / gsz; return true;
  }
};
DEVI unsigned cvt_pk_bf16(float lo, float hi) { unsigned r; asm volatile("v_cvt_pk_bf16_f32 %0, %1, %2" : "=v"(r) : "v"(lo), "v"(hi)); return r; }

template <class Epi>
DEVI void gemm_phase(PG8_LAS unsigned char* lds, const Gemm g, const StaticOrder& S, const Epi& E) {
  const int tid = tidx(), wid = __builtin_amdgcn_readfirstlane(tid >> 6), lane = tid & 63, wr = wid >> 2, wc = wid & 3, fr = lane & 15, fq = lane >> 4;
  const int K = g.K, nt = K / BK, lda = g.lda;
  unsigned voffA[2], voffB[2];
#pragma unroll
  for (int i = 0; i < 2; ++i) { int R, C; stage_rc(tid * 16 + i * 8192, R, C); const int Rb = Epi::PERM ? ((R & ~31) + perm32(R & 31)) : R;
    voffA[i] = (unsigned)(R * lda + C) * 2u; voffB[i] = (unsigned)(Rb * K + C) * 2u; }
  const size_t kstep = (size_t)(BK * 2);
  const size_t hstepA = (size_t)HALF * lda * 2, hstepB = (size_t)HALF * K * 2;
  const size_t tstepA = 2 * hstepA, tstepB = 2 * hstepB;
  const unsigned ldsw = (unsigned)wid * 1024u;
  const int aoff = lds_byte(wr * 64 + fr, fq * 8), boff = lds_byte(wc * 32 + fr, fq * 8);
#define PG8_SA(b, h) (((b) * 2 + (h)) * HTB)
#define PG8_SB(b, h) ((4 + (b) * 2 + (h)) * HTB)
#define PG8_STAGE(bufoff, gbase, voff) do { _Pragma("unroll") for (int _i = 0; _i < 2; ++_i) \
    __builtin_amdgcn_global_load_lds((const unsigned*)((const char*)(gbase) + (voff)[_i]), (PG8_LAS unsigned*)(lds + (bufoff) + ldsw + _i * 8192), 16, 0, 0); } while (0)
#define PG8_LDA(dst, b, h) do { _Pragma("unroll") for (int m = 0; m < 4; ++m) _Pragma("unroll") for (int k = 0; k < 2; ++k) dst[m][k] = *(const PG8_LAS bf16x8*)(lds + PG8_SA(b, h) + aoff + m * 2048 + k * 1024); } while (0)
#define PG8_LDB(dst, b, h) do { _Pragma("unroll") for (int n = 0; n < 2; ++n) _Pragma("unroll") for (int k = 0; k < 2; ++k) dst[n][k] = *(const PG8_LAS bf16x8*)(lds + PG8_SB(b, h) + boff + n * 2048 + k * 1024); } while (0)
#define PG8_MMA(ai, bj, At, Bt) do { __builtin_amdgcn_s_setprio(1); _Pragma("unroll") for (int m = 0; m < 4; ++m) _Pragma("unroll") for (int n = 0; n < 2; ++n) _Pragma("unroll") for (int k = 0; k < 2; ++k) \
    acc[ai][bj][m][n] = Epi::TRANS ? __builtin_amdgcn_mfma_f32_16x16x32_bf16(Bt[n][k], At[m][k], acc[ai][bj][m][n], 0, 0, 0) \
                                   : __builtin_amdgcn_mfma_f32_16x16x32_bf16(At[m][k], Bt[n][k], acc[ai][bj][m][n], 0, 0, 0); __builtin_amdgcn_s_setprio(0); } while (0)
#define PG8_WAIT_V(n) asm volatile("s_waitcnt vmcnt(" #n ")" ::: "memory")
#define PG8_WAIT_L(n) asm volatile("s_waitcnt lgkmcnt(" #n ")" ::: "memory")
#define PG8_BAR __builtin_amdgcn_s_barrier()
#define PG8_SCHED __builtin_amdgcn_sched_barrier(0)
  Unit cur, nxt; int ui = 0;
  if (!S.next(0, cur)) return;
  f32x4 acc[2][2][4][2];
#pragma unroll
  for (int a = 0; a < 2; ++a)
#pragma unroll
    for (int b = 0; b < 2; ++b)
#pragma unroll
      for (int m = 0; m < 4; ++m)
#pragma unroll
        for (int n = 0; n < 2; ++n) acc[a][b][m][n] = (f32x4){0.f, 0.f, 0.f, 0.f};
  bf16x8 At[4][2], B0[2][2], B1[2][2];
  const char* cA = (const char*)g.A + (size_t)cur.pm * tstepA; const char* cB = (const char*)g.Bt + (size_t)cur.pn * tstepB;
  PG8_STAGE(PG8_SB(0, 0), cB, voffB); PG8_STAGE(PG8_SA(0, 0), cA, voffA); PG8_STAGE(PG8_SB(0, 1), cB + hstepB, voffB); PG8_STAGE(PG8_SA(0, 1), cA + hstepA, voffA);
  if (wr == 1) PG8_BAR;
  PG8_WAIT_V(4); PG8_BAR;
  PG8_STAGE(PG8_SB(1, 0), cB + kstep, voffB); PG8_STAGE(PG8_SA(1, 0), cA + kstep, voffA); PG8_STAGE(PG8_SB(1, 1), cB + hstepB + kstep, voffB);
  PG8_WAIT_V(6); PG8_BAR;
  for (;;) {
    const bool has_next = S.next(ui + 1, nxt);
    const char* nA = has_next ? (const char*)g.A + (size_t)nxt.pm * tstepA : cA; const char* nB = has_next ? (const char*)g.Bt + (size_t)nxt.pn * tstepB : cB;
    for (int t = 0; t < nt; t += 2) {
      const bool last = (t == nt - 2);
      const char* a1 = cA + (size_t)(t + 1) * kstep;
      const char* a2 = last ? nA : cA + (size_t)(t + 2) * kstep; const char* b2 = last ? nB : cB + (size_t)(t + 2) * kstep;
      const char* a3 = a2 + kstep; const char* b3 = b2 + kstep;
      PG8_LDB(B0, 0, 0); PG8_SCHED; PG8_LDA(At, 0, 0); PG8_STAGE(PG8_SA(1, 1), a1 + hstepA, voffA);
      PG8_WAIT_L(8); PG8_BAR; PG8_WAIT_L(0); PG8_MMA(0, 0, At, B0); PG8_BAR; PG8_SCHED;
      PG8_LDB(B1, 0, 1); PG8_STAGE(PG8_SB(0, 0), b2, voffB);
      PG8_BAR; PG8_WAIT_L(0); PG8_MMA(0, 1, At, B1); PG8_BAR;
      PG8_LDA(At, 0, 1); PG8_STAGE(PG8_SA(0, 0), a2, voffA);
      PG8_BAR; PG8_WAIT_L(0); PG8_MMA(1, 0, At, B0); PG8_BAR; PG8_SCHED;
      PG8_STAGE(PG8_SB(0, 1), b2 + hstepB, voffB);
      PG8_WAIT_V(6); PG8_BAR; PG8_MMA(1, 1, At, B1); PG8_BAR;
      PG8_LDB(B0, 1, 0); PG8_SCHED; PG8_LDA(At, 1, 0); PG8_STAGE(PG8_SA(0, 1), a2 + hstepA, voffA);
      PG8_WAIT_L(8); PG8_BAR; PG8_WAIT_L(0); PG8_MMA(0, 0, At, B0); PG8_BAR; PG8_SCHED;
      PG8_LDB(B1, 1, 1); PG8_STAGE(PG8_SB(1, 0), b3, voffB);
      PG8_BAR; PG8_WAIT_L(0); PG8_MMA(0, 1, At, B1); PG8_BAR;
      PG8_LDA(At, 1, 1); PG8_STAGE(PG8_SA(1, 0), a3, voffA);
      PG8_BAR; PG8_WAIT_L(0); PG8_MMA(1, 0, At, B0); PG8_BAR; PG8_SCHED;
      PG8_STAGE(PG8_SB(1, 1), b3 + hstepB, voffB);
      PG8_WAIT_V(6); PG8_BAR; PG8_MMA(1, 1, At, B1); PG8_BAR;
    }
    E(acc, cur, wr, wc, fr, fq);
    if (!has_next) break;
#pragma unroll
    for (int a = 0; a < 2; ++a)
#pragma unroll
      for (int b = 0; b < 2; ++b)
#pragma unroll
        for (int m = 0; m < 4; ++m)
#pragma unroll
          for (int n = 0; n < 2; ++n) acc[a][b][m][n] = (f32x4){0.f, 0.f, 0.f, 0.f};
    cur = nxt; cA = nA; cB = nB; ++ui;
  }
  PG8_WAIT_V(0);
  if (wr == 0) PG8_BAR;
  PG8_BAR;
#undef PG8_SA
#undef PG8_SB
#undef PG8_STAGE
#undef PG8_LDA
#undef PG8_LDB
#undef PG8_MMA
#undef PG8_WAIT_V
#undef PG8_WAIT_L
#undef PG8_BAR
#undef PG8_SCHED
}

struct EpiEvenIn {
  static constexpr bool PERM = true, TRANS = true;
  ushort_t* ps5; ushort_t* prw;
  DEVI void operator()(const f32x4 (&acc)[2][2][4][2], const Unit& u, int wr, int wc, int fr, int fq) const {
#pragma unroll
    for (int ai = 0; ai < 2; ++ai)
#pragma unroll
      for (int m = 0; m < 4; ++m) {
        const size_t row = (size_t)u.pm * BM + ai * HALF + wr * 64 + m * 16 + fr;
#pragma unroll
        for (int bj = 0; bj < 2; ++bj) {
          const int c0 = u.pn * BM + bj * HALF + wc * 32 + 8 * fq;
          const f32x4 v0 = acc[ai][bj][m][0], v1 = acc[ai][bj][m][1];
          u32x4 o = {cvt_pk_bf16(v0[0], v0[1]), cvt_pk_bf16(v0[2], v0[3]), cvt_pk_bf16(v1[0], v1[1]), cvt_pk_bf16(v1[2], v1[3])};
          if (c0 < 1024) *(u32x4*)(ps5 + row * 1024 + c0) = o;
          else if (c0 < 3136) *(u32x4*)(prw + row * 2112 + (c0 - 1024)) = o;
        }
      }
  }
};
struct EpiHyIn {
  static constexpr bool PERM = false, TRANS = false;
  ushort_t* ph;
  DEVI void operator()(const f32x4 (&acc)[2][2][4][2], const Unit& u, int wr, int wc, int fr, int fq) const {
    int s0, L; seq_of(u.pm * BM, s0, L);
#pragma unroll
    for (int ai = 0; ai < 2; ++ai)
#pragma unroll
      for (int m = 0; m < 4; ++m) {
        const int tok = u.pm * BM + ai * HALF + wr * 64 + m * 16 + 4 * fq;
#pragma unroll
        for (int bj = 0; bj < 2; ++bj)
#pragma unroll
          for (int n = 0; n < 2; ++n) {
            const int col = u.pn * BM + bj * HALF + wc * 32 + 16 * n + fr;
            const int st = col >> 10, c = col & 1023;
            const f32x4 v = acc[ai][bj][m][n];
            ushort_t* dst = ph + (size_t)st * T * 1024 + (size_t)s0 * 1024 + (size_t)c * L + (tok - s0);
            *(uint2*)dst = uint2{cvt_pk_bf16(v[0], v[1]), cvt_pk_bf16(v[2], v[3])};
          }
      }
  }
};
struct EpiGlu {
  static constexpr bool PERM = true, TRANS = true;
  ushort_t* y; const ushort_t* ps5; const float* bias;
  DEVI void operator()(const f32x4 (&acc)[2][2][4][2], const Unit& u, int wr, int wc, int fr, int fq) const {
#pragma unroll
    for (int ai = 0; ai < 2; ++ai)
#pragma unroll
      for (int m = 0; m < 4; ++m) {
        const size_t row = (size_t)u.pm * BM + ai * HALF + wr * 64 + m * 16 + fr;
#pragma unroll
        for (int bj = 0; bj < 2; ++bj) {
          const int c0 = u.pn * BM + bj * HALF + wc * 32 + 8 * fq;
          const u32x4 a8 = *(const u32x4*)(y + row * 1024 + 512 + c0);
          const u32x4 g8 = *(const u32x4*)(ps5 + row * 1024 + 512 + c0);
          const f32x4 b0 = *(const f32x4*)(bias + c0), b1 = *(const f32x4*)(bias + c0 + 4);
          float v[8];
#pragma unroll
          for (int e = 0; e < 4; ++e) { v[e] = acc[ai][bj][m][0][e] + b0[e]; v[4 + e] = acc[ai][bj][m][1][e] + b1[e]; }
          unsigned o[4];
#pragma unroll
          for (int e = 0; e < 4; ++e) {
            const float a_lo = __uint_as_float(a8[e] << 16), a_hi = __uint_as_float(a8[e] & 0xffff0000u);
            const float g_lo = __uint_as_float(g8[e] << 16), g_hi = __uint_as_float(g8[e] & 0xffff0000u);
            const float r_lo = a_lo * sigmoidf_(v[2 * e]) * (g_lo * sigmoidf_(g_lo));
            const float r_hi = a_hi * sigmoidf_(v[2 * e + 1]) * (g_hi * sigmoidf_(g_hi));
            o[e] = cvt_pk_bf16(r_lo, r_hi);
          }
          *(u32x4*)(y + row * 1024 + c0) = u32x4{o[0], o[1], o[2], o[3]};
        }
      }
  }
};
struct EpiF16 {
  static constexpr bool PERM = true, TRANS = true;
  ushort_t* C;
  DEVI void operator()(const f32x4 (&acc)[2][2][4][2], const Unit& u, int wr, int wc, int fr, int fq) const {
#pragma unroll
    for (int ai = 0; ai < 2; ++ai)
#pragma unroll
      for (int m = 0; m < 4; ++m) {
        ushort_t* rowp = C + ((size_t)u.pm * BM + ai * HALF + wr * 64 + m * 16 + fr) * 1024 + u.pn * BM + wc * 32 + 8 * fq;
#pragma unroll
        for (int bj = 0; bj < 2; ++bj) {
          const f32x4 v0 = acc[ai][bj][m][0], v1 = acc[ai][bj][m][1];
          *(u32x4*)(rowp + bj * HALF) = u32x4{cvt_pk_bf16(v0[0], v0[1]), cvt_pk_bf16(v0[2], v0[3]), cvt_pk_bf16(v1[0], v1[1]), cvt_pk_bf16(v1[2], v1[3])};
        }
      }
  }
};
}

template <class Epi>
DEVI void run_gemm(unsigned char* lds, const ushort_t* A, int lda, const ushort_t* Bt, int N, int K, const Epi& E) {
  pg8::Gemm g; g.A = A; g.Bt = Bt; g.M = T; g.N = N; g.K = K; g.lda = lda;
  pg8::StaticOrder S; S.init(T, N, (int)gridDim.x, bidx());
  __syncthreads();
  pg8::gemm_phase<Epi>((PG8_LAS unsigned char*)lds, g, S, E);
  __syncthreads();
}

__device__ void xb_convert(const Params& p, ushort_t* XB) {
  const size_t n4 = (size_t)T * 1024 / 4, np4 = (size_t)TPROMPT * 1024 / 4;
  const float4* xp = (const float4*)p.in[I_XP]; const float4* xs = (const float4*)p.in[I_XS];
  for (size_t e = (size_t)bidx() * NT + tidx(); e < n4; e += (size_t)gridDim.x * NT) {
    const float4 v = e < np4 ? xp[e] : xs[e - np4];
    ((uint2*)XB)[e] = uint2{pack2(v.x, v.y), pack2(v.z, v.w)};
  }
}
__device__ void zero_fill(ushort_t* dst, size_t n) {
  for (size_t e = (size_t)bidx() * NT + tidx(); e < n / 8; e += (size_t)gridDim.x * NT) ((uint4*)dst)[e] = uint4{0, 0, 0, 0};
}
DEVI uint4 hy_tr_load(const ushort_t* __restrict__ PH3, int t, int r, int c8) {
  const int tok0 = (t >> 4) * 64, c0 = (t & 15) * 64;
  int s0, L; seq_of(tok0, s0, L);
  return *(const uint4*)(PH3 + (size_t)s0 * 1024 + (size_t)(c0 + r) * L + (tok0 - s0) + c8);
}
__device__ void hy_transpose(const ushort_t* __restrict__ PH3, ushort_t* __restrict__ Y, unsigned char* lds) {
  ushort_t* tile = (ushort_t*)lds;
  const int tid = tidx(), r = tid >> 3, c8 = (tid & 7) * 8;
  const int nt = (T / 64) * 16, t_first = bidx();
  uint4 v = uint4{0, 0, 0, 0};
  if (t_first < nt) v = hy_tr_load(PH3, t_first, r, c8);
  for (int t = t_first; t < nt; t += gridDim.x) {
    const int tok0 = (t >> 4) * 64, c0 = (t & 15) * 64;
    block_sync_lds();
    *(uint4*)(tile + r * 72 + c8) = v;
    if (t + (int)gridDim.x < nt) v = hy_tr_load(PH3, t + gridDim.x, r, c8);
    block_sync_lds();
    unsigned o[4];
#pragma unroll
    for (int e = 0; e < 4; ++e) o[e] = (unsigned)tile[(c8 + 2 * e) * 72 + r] | ((unsigned)tile[(c8 + 2 * e + 1) * 72 + r] << 16);
    *(uint4*)(Y + (size_t)(tok0 + r) * 1024 + c0 + c8) = uint4{o[0], o[1], o[2], o[3]};
  }
}

struct LnIn { float4 x[2][4]; uint2 f[2][4]; };
DEVI void ln_load(const XSrc& xs_, int layer, const ushort_t* __restrict__ F, int row0, int lane, LnIn& o) {
#pragma unroll
  for (int h = 0; h < 2; ++h) {
    const int row = row0 + h * (T / 2);
    const float4* x4 = (const float4*)xrow(xs_, layer, row);
    const uint2* f2 = (const uint2*)(F + (size_t)row * 1024);
#pragma unroll
    for (int e = 0; e < 4; ++e) { o.x[h][e] = x4[lane + 64 * e]; o.f[h][e] = f2[lane + 64 * e]; }
  }
}
__device__ void ln_phase(const Params& p, int layer, const ushort_t* __restrict__ F, ushort_t* __restrict__ XB, bool dry = false) {
  const int lane = tidx() & 63, gw = bidx() * (NT / 64) + (tidx() >> 6), nw = gridDim.x * (NT / 64);
  const float alpha = 1.681792830507429f;
  const float4* g4 = (const float4*)(p.in[I_LNG] + layer * 1024);
  const float4* b4 = (const float4*)(p.in[I_LNB] + layer * 1024);
  const XSrc xs_ = xsrc(p);
  LnIn cur, nxt;
  if (gw < T / 2) ln_load(xs_, layer, F, gw, lane, cur);
  for (int row0 = gw; row0 < T / 2; row0 += nw) {
    if (row0 + nw < T / 2) ln_load(xs_, layer, F, row0 + nw, lane, nxt);
#pragma unroll
    for (int h = 0; h < 2; ++h) {
      const int row = row0 + h * (T / 2);
      float4 v[4];
      float s = 0.f;
#pragma unroll
      for (int e = 0; e < 4; ++e) {
        const float4 a = cur.x[h][e];
        const uint2 fw = cur.f[h][e];
        v[e] = float4{alpha * a.x + __uint_as_float(fw.x << 16), alpha * a.y + __uint_as_float(fw.x & 0xffff0000u),
                      alpha * a.z + __uint_as_float(fw.y << 16), alpha * a.w + __uint_as_float(fw.y & 0xffff0000u)};
        s += v[e].x + v[e].y + v[e].z + v[e].w;
      }
      const float mean = wsum(s) * (1.f / 1024.f);
      float q = 0.f;
#pragma unroll
      for (int e = 0; e < 4; ++e) {
        v[e].x -= mean; v[e].y -= mean; v[e].z -= mean; v[e].w -= mean;
        q += v[e].x * v[e].x + v[e].y * v[e].y + v[e].z * v[e].z + v[e].w * v[e].w;
      }
      const float rs = rsqrtf(wsum(q) * (1.f / 1024.f) + 1e-5f);
      float4* o4 = (float4*)(p.out + (size_t)row * 1024);
#pragma unroll
      for (int e = 0; e < 4; ++e) {
        const float4 g = g4[lane + 64 * e], b = b4[lane + 64 * e];
        const float4 o = float4{v[e].x * rs * g.x + b.x, v[e].y * rs * g.y + b.y, v[e].z * rs * g.z + b.z, v[e].w * rs * g.w + b.w};
        if (!dry) o4[lane + 64 * e] = o;
        if (XB) ((uint2*)(XB + (size_t)row * 1024))[lane + 64 * e] = uint2{pack2(o.x, o.y), pack2(o.z, o.w)};
      }
    }
    cur = nxt;
  }
}

struct cplx { float x, y; };
DEVI cplx cmul(cplx a, cplx b) { return cplx{a.x * b.x - a.y * b.y, a.x * b.y + a.y * b.x}; }
DEVI void s5_consts(const Params& p, int i, int d, int g, int n, cplx& lb, cplx& coef) {
  const int idx = ((i * 2 + d) * 32 + g) * 64 + n;
  const float lre = p.in[I_LRE][idx], lim = p.in[I_LIM][idx];
  const float dt = expf(p.in[I_LSTEP][(i * 2 + d) * 32 + g]);
  const float mag = expf(lre * dt);
  float sn, cs; sincosf(lim * dt, &sn, &cs);
  lb = cplx{mag * cs, mag * sn};
  const float nr = lb.x - 1.f, ni = lb.y, den = 1.f / (lre * lre + lim * lim);
  coef = cplx{(nr * lre + ni * lim) * den, (ni * lre - nr * lim) * den};
}
DEVI void s5_load_u(const ushort_t* PS5, int tok0, int g, int lane, uint4& a, uint4& b) {
  const uint4* src = (const uint4*)(PS5 + (size_t)(tok0 + lane) * 1024 + g * 16);
  a = src[0]; b = src[1];
}
DEVI void s5_store_u(float* U, int lane, const uint4& a, const uint4& b) {
  float4* d = (float4*)(U + lane * 16);
  d[0] = float4{__uint_as_float(a.x << 16), __uint_as_float(a.x & 0xffff0000u), __uint_as_float(a.y << 16), __uint_as_float(a.y & 0xffff0000u)};
  d[1] = float4{__uint_as_float(a.z << 16), __uint_as_float(a.z & 0xffff0000u), __uint_as_float(a.w << 16), __uint_as_float(a.w & 0xffff0000u)};
  d[2] = float4{__uint_as_float(b.x << 16), __uint_as_float(b.x & 0xffff0000u), __uint_as_float(b.y << 16), __uint_as_float(b.y & 0xffff0000u)};
  d[3] = float4{__uint_as_float(b.z << 16), __uint_as_float(b.z & 0xffff0000u), __uint_as_float(b.w << 16), __uint_as_float(b.w & 0xffff0000u)};
}
DEVI f32x2 cmul2(f32x2 a, f32x2 b) { return f32x2{a.x, a.x} * b + f32x2{a.y, a.y} * f32x2{-b.y, b.x}; }
#define S5_BU2(Urow, acc2)                                                            \
  {                                                                                   \
    const float4* u4 = (const float4*)(Urow);                                         \
    _Pragma("unroll") for (int pp = 0; pp < 4; ++pp) {                                \
      const float4 u = u4[pp];                                                        \
      acc2 = B2[4 * pp] * f32x2{u.x, u.x} + acc2; acc2 = B2[4 * pp + 1] * f32x2{u.y, u.y} + acc2; \
      acc2 = B2[4 * pp + 2] * f32x2{u.z, u.z} + acc2; acc2 = B2[4 * pp + 3] * f32x2{u.w, u.w} + acc2; \
    }                                                                                 \
  }

__device__ void s5_passA(const Params& p, int i, unsigned char* lds) {
  const ushort_t* PS5 = (const ushort_t*)(p.ws + OFF_PS5);
  cplx* CAR = (cplx*)(p.ws + OFF_CAR);
  const int lane = tidx() & 63, wave = tidx() >> 6;
  float* U = (float*)(lds + wave * 8448);
  for (int item = bidx() * 8 + wave; item < 192 * 32; item += gridDim.x * 8) {
    const int q = item >> 5, g = item & 31;
    cplx lb0, c0, lb1, c1;
    s5_consts(p, i, 0, g, lane, lb0, c0);
    s5_consts(p, i, 1, g, lane, lb1, c1);
    const f32x2 l0 = {lb0.x, lb0.y}, l1 = {lb1.x, lb1.y};
    f32x2 B2[16];
#pragma unroll
    for (int pp = 0; pp < 16; ++pp) B2[pp] = f32x2{p.in[I_BRE][((i * 32 + g) * 64 + lane) * 16 + pp], p.in[I_BIM][((i * 32 + g) * 64 + lane) * 16 + pp]};
    f32x2 xf = {0.f, 0.f}, xb = {0.f, 0.f}, pw = {1.f, 0.f};
    uint4 ua, ub;
    s5_load_u(PS5, q * 256, g, lane, ua, ub);
    for (int sb = 0; sb < 4; ++sb) {
      wave_sync();
      s5_store_u(U, lane, ua, ub);
      wave_sync();
      if (sb < 3) s5_load_u(PS5, q * 256 + (sb + 1) * 64, g, lane, ua, ub);
#pragma unroll 4
      for (int t = 0; t < 64; ++t) {
        f32x2 bu = {0.f, 0.f};
        S5_BU2(U + t * 16, bu);
        xf = cmul2(l0, xf) + bu;
        xb = cmul2(pw, bu) + xb;
        pw = cmul2(pw, l1);
      }
    }
    CAR[((size_t)(q * 32 + g) * 2 + 0) * 64 + lane] = cmul(cplx{xf.x, xf.y}, c0);
    CAR[((size_t)(q * 32 + g) * 2 + 1) * 64 + lane] = cmul(cplx{xb.x, xb.y}, c1);
  }
}

__device__ void s5_passC(const Params& p, int i, unsigned char* lds) {
  const ushort_t* PS5 = (const ushort_t*)(p.ws + OFF_PS5);
  const cplx* CAR = (const cplx*)(p.ws + OFF_CAR);
  float* YS = (float*)(p.ws + OFF_YS);
  ushort_t* YG = (ushort_t*)(p.ws + OFF_Y);
  const int lane = tidx() & 63, wave = tidx() >> 6;
  float* U = (float*)(lds + wave * 8448);
  ushort_t* X = (ushort_t*)(lds + wave * 8448 + 4096);
  for (int item = bidx() * 8 + wave; item < 192 * 32; item += gridDim.x * 8) {
    const int q = item >> 5, g = item & 31;
    int cs, ce;
    if (q < 64) { cs = q & ~15; ce = cs + 16; } else { cs = 64 + ((q - 64) & ~63); ce = cs + 64; }
    const int pcol = lane & 15;
    const float dd = p.in[I_S5D][i * 512 + g * 16 + pcol];
    for (int d = 0; d < 2; ++d) {
      cplx lb, coef;
      s5_consts(p, i, d, g, lane, lb, coef);
      const f32x2 l2 = {lb.x, lb.y};
      f32x2 B2[16];
#pragma unroll
      for (int pp = 0; pp < 16; ++pp) {
        const cplx bb = cmul(coef, cplx{p.in[I_BRE][((i * 32 + g) * 64 + lane) * 16 + pp], p.in[I_BIM][((i * 32 + g) * 64 + lane) * 16 + pp]});
        B2[pp] = f32x2{bb.x, bb.y};
      }
      cplx lp = lb;
#pragma unroll
      for (int e = 0; e < 8; ++e) lp = cmul(lp, lp);
      cplx xs{0.f, 0.f};
      if (d == 0) {
#pragma unroll 8
        for (int j = cs; j < q; ++j) { xs = cmul(lp, xs); cplx c = CAR[((size_t)(j * 32 + g) * 2 + 0) * 64 + lane]; xs.x += c.x; xs.y += c.y; } }
      else {
#pragma unroll 8
        for (int j = ce - 1; j > q; --j) { xs = cmul(lp, xs); cplx c = CAR[((size_t)(j * 32 + g) * 2 + 1) * 64 + lane]; xs.x += c.x; xs.y += c.y; } }
      f32x2 x2 = {xs.x, xs.y};
      bf16x8 cf[4];
#pragma unroll
      for (int kk = 0; kk < 4; ++kk) {
        const int n0 = (kk & 1) * 32 + (lane >> 4) * 8;
        const float* src = (kk < 2 ? p.in[I_CRE] : p.in[I_CIM]) + (((size_t)(i * 2 + d) * 32 + g) * 16 + pcol) * 64 + n0;
        const float sg = kk < 2 ? 1.f : -1.f;
#pragma unroll
        for (int j = 0; j < 8; ++j) cf[kk][j] = (short)f2bf(sg * src[j]);
      }
      uint4 ua, ub;
      s5_load_u(PS5, q * 256 + (d ? 3 : 0) * 64, g, lane, ua, ub);
      for (int sbi = 0; sbi < 4; ++sbi) {
        const int sb = d ? 3 - sbi : sbi;
        wave_sync();
        s5_store_u(U, lane, ua, ub);
        wave_sync();
        if (sbi < 3) s5_load_u(PS5, q * 256 + (d ? 2 - sbi : sbi + 1) * 64, g, lane, ua, ub);
        for (int tbi = 0; tbi < 4; ++tbi) {
          const int tb = d ? 3 - tbi : tbi;
          float ysp[4] = {0.f, 0.f, 0.f, 0.f};
          if (d == 1) {
#pragma unroll
            for (int r = 0; r < 4; ++r) ysp[r] = YS[(size_t)(q * 256 + sb * 64 + tb * 16 + (lane >> 4) * 4 + r) * 512 + g * 16 + pcol];
          }
#pragma unroll 4
          for (int tti = 0; tti < 16; ++tti) {
            const int tt = d ? 15 - tti : tti;
            f32x2 acc2 = cmul2(l2, x2);
            S5_BU2(U + (tb * 16 + tt) * 16, acc2);
            x2 = acc2;
            X[tt * 136 + lane] = f2bf(x2.x);
            X[tt * 136 + 64 + lane] = f2bf(x2.y);
          }
          wave_sync();
          f32x4 acc{0.f, 0.f, 0.f, 0.f};
#pragma unroll
          for (int kk = 0; kk < 4; ++kk) {
            bf16x8 a = *(const bf16x8*)(X + (lane & 15) * 136 + kk * 32 + (lane >> 4) * 8);
            acc = __builtin_amdgcn_mfma_f32_16x16x32_bf16(a, cf[kk], acc, 0, 0, 0);
          }
          wave_sync();
#pragma unroll
          for (int r = 0; r < 4; ++r) {
            const int tl = tb * 16 + (lane >> 4) * 4 + r;
            const size_t o = (size_t)(q * 256 + sb * 64 + tl) * 512 + g * 16 + pcol;
            if (d == 0) YS[o] = acc[r] + dd * U[tl * 16 + pcol];
            else {
              const float yv = ysp[r] + acc[r];
              YG[(size_t)(q * 256 + sb * 64 + tl) * 1024 + 512 + g * 16 + pcol] = f2bf(yv * fast_sigmoid(1.5957691216f * (yv + 0.044715f * yv * yv * yv)));
            }
          }
        }
      }
    }
  }
}

struct RwConst { float mur, muk, muv, mul, w0, a0, kk, ka; };
struct RwRow { float r, k, v, l; };
DEVI RwRow rw_load_row(const ushort_t* PRW, int tok, int s0, int L, int h, int lane) {
  RwRow o{0.f, 0.f, 0.f, 0.f};
  if (tok >= s0 && tok < s0 + L) {
    const ushort_t* row = PRW + (size_t)tok * 2112;
    const int cc = h * 64 + lane;
    o.r = bf2f(row[cc]); o.k = bf2f(row[512 + cc]); o.v = bf2f(row[1024 + cc]); o.l = bf2f(row[2048 + lane]);
  }
  return o;
}
DEVI void rw_prologue(const RwRow& rm, const RwRow& rc, const RwRow& rn, int lane, const RwConst& c, const float* WU, const float* AU,
                      float* LT, float* Wd, float* KKd, float* BBd, float* KDd, float* RRd, float* VVd) {
  const float rr = rc.r + c.mur * (0.5f * (rm.r + rn.r) - rc.r);
  const float kx = rc.k + c.muk * (0.5f * (rm.k + rn.k) - rc.k);
  const float vv = rc.v + c.muv * (0.5f * (rm.v + rn.v) - rc.v);
  float ll = rc.l + c.mul * (0.5f * (rm.l + rn.l) - rc.l);
  ll = lane < 32 ? fast_tanh(ll) : ll;
  wave_sync();
  LT[lane] = ll;
  wave_sync();
  float accw = c.w0, acca = c.a0;
#pragma unroll 2
  for (int j = 0; j < 32; j += 4) {
    float4 lw = *(const float4*)(LT + j), la = *(const float4*)(LT + 32 + j);
    accw += lw.x * WU[(j + 0) * 64 + lane] + lw.y * WU[(j + 1) * 64 + lane] + lw.z * WU[(j + 2) * 64 + lane] + lw.w * WU[(j + 3) * 64 + lane];
    acca += la.x * AU[(j + 0) * 64 + lane] + la.y * AU[(j + 1) * 64 + lane] + la.z * AU[(j + 2) * 64 + lane] + la.w * AU[(j + 3) * 64 + lane];
  }
  const float dec = __builtin_amdgcn_exp2f(-0.8750387749145276f * fast_sigmoid(accw));
  const float a = fast_sigmoid(acca);
  const float kkr = kx * c.kk;
  const float ss = wsum_fast(kkr * kkr);
  const float kkn = kkr * __builtin_amdgcn_rsqf(fmaxf(ss, 1e-24f));
  Wd[lane] = dec; KKd[lane] = kkn; BBd[lane] = kkn * a; KDd[lane] = kx * (1.f + (a - 1.f) * c.ka); RRd[lane] = rr; VVd[lane] = vv;
}

template <int NS>
DEVI void rw_prologue_blk(const RwRow* R, int lane, const RwConst& c, const bf16x8* BF, int dir, ushort_t* LTm,
                          float* Wd, float* KKd, float* BBd, float* KDd, float* RRd, float* VVd) {
#pragma unroll
  for (int e = 0; e < NS; ++e) {
    const RwRow& rm = R[e]; const RwRow& rc = R[e + 1]; const RwRow& rn = R[e + 2];
    const float rr = rc.r + c.mur * (0.5f * (rm.r + rn.r) - rc.r);
    const float kx = rc.k + c.muk * (0.5f * (rm.k + rn.k) - rc.k);
    const float vv = rc.v + c.muv * (0.5f * (rm.v + rn.v) - rc.v);
    float ll = rc.l + c.mul * (0.5f * (rm.l + rn.l) - rc.l);
    ll = lane < 32 ? fast_tanh(ll) : ll;
    RRd[e * 64 + lane] = rr; VVd[e * 64 + lane] = vv; KDd[e * 64 + lane] = kx;
    LTm[e * 72 + lane] = f2bf(ll);
  }
  wave_sync_lds();
  {
    const int row = lane & (NS - 1), kq8 = (lane >> 4) * 8;
    const bf16x8 aw = *(const bf16x8*)(LTm + row * 72 + kq8);
    const bf16x8 aa = *(const bf16x8*)(LTm + row * 72 + 32 + kq8);
#pragma unroll
    for (int nt = 0; nt < 4; ++nt) {
      const f32x4 z = {0.f, 0.f, 0.f, 0.f};
      const f32x4 dw = __builtin_amdgcn_mfma_f32_16x16x32_bf16(aw, BF[(dir * 4 + nt) * 64 + lane], z, 0, 0, 0);
      const f32x4 da = __builtin_amdgcn_mfma_f32_16x16x32_bf16(aa, BF[(8 + nt) * 64 + lane], z, 0, 0, 0);
      if ((lane >> 4) < NS / 4) {
#pragma unroll
        for (int r = 0; r < 4; ++r) {
          const int o = ((lane >> 4) * 4 + r) * 64 + nt * 16 + (lane & 15);
          Wd[o] = dw[r]; BBd[o] = da[r];
        }
      }
    }
  }
  wave_sync_lds();
#pragma unroll
  for (int e = 0; e < NS; ++e) {
    const float accw = c.w0 + Wd[e * 64 + lane], acca = c.a0 + BBd[e * 64 + lane], kx = KDd[e * 64 + lane];
    const float dec = __builtin_amdgcn_exp2f(-0.8750387749145276f * fast_sigmoid(accw));
    const float a = fast_sigmoid(acca);
    const float kkr = kx * c.kk;
    const float ss = wsum_fast(kkr * kkr);
    const float kkn = kkr * __builtin_amdgcn_rsqf(fmaxf(ss, 1e-24f));
    Wd[e * 64 + lane] = dec; KKd[e * 64 + lane] = kkn; BBd[e * 64 + lane] = kkn * a; KDd[e * 64 + lane] = kx * (1.f + (a - 1.f) * c.ka);
  }
}
DEVI void rw_fill_bf(const Params& p, int i, int h, bf16x8* BF, int tid, int nthr = NT) {
  for (int e = tid; e < 768; e += nthr) {
    const int which = e >> 8, nt = (e >> 6) & 3, l = e & 63;
    const int n = nt * 16 + (l & 15), k0 = (l >> 4) * 8;
    const float* src = which < 2 ? p.in[I_WUP] + ((size_t)(i * 2 + which) * 32) * 512 : p.in[I_AUP] + ((size_t)i * 32) * 512;
    bf16x8 v;
#pragma unroll
    for (int jj = 0; jj < 8; ++jj) v[jj] = (short)f2bf(src[(size_t)(k0 + jj) * 512 + h * 64 + n]);
    BF[e] = v;
  }
}

DEVI float dpp_f(float x, const int ctrl_sel) {
  int xi = __builtin_bit_cast(int, x), r;
  if (ctrl_sel == 0) r = __builtin_amdgcn_mov_dpp(xi, 0xB1, 0xf, 0xf, true);
  else if (ctrl_sel == 1) r = __builtin_amdgcn_mov_dpp(xi, 0x4E, 0xf, 0xf, true);
  else r = __builtin_amdgcn_mov_dpp(xi, 0x141, 0xf, 0xf, true);
  return __builtin_bit_cast(float, r);
}
DEVI float red8(float x) { x += dpp_f(x, 0); x += dpp_f(x, 1); x += dpp_f(x, 2); return x; }

#define RW_LOAD8(dst2, base)                                                        \
  { const float4 _a = *(const float4*)(base), _b = *(const float4*)((base) + 4);    \
    dst2[0] = f32x2{_a.x, _a.y}; dst2[1] = f32x2{_a.z, _a.w}; dst2[2] = f32x2{_b.x, _b.y}; dst2[3] = f32x2{_b.z, _b.w}; }

__device__ void rwkv_scan1(const Params& p, int i, unsigned char* lds) {
  const ushort_t* PRW = (const ushort_t*)(p.ws + OFF_PRW);
  float* CH = (float*)(p.ws + OFF_PS5);
  float* YR = (float*)(p.ws + OFF_YS);
  const int tid = tidx(), lane = tid & 63, wave = tid >> 6, pair = wave >> 1, role = (wave ^ (wave >> 2)) & 1;
  const int vq = lane >> 3, kq = lane & 7;
  bf16x8* BF = (bf16x8*)lds;
  float* WV = (float*)(lds + 12288 + pair * 26880);
  float* Wd = WV, *KKd = WV + 1024, *BBd = WV + 2048, *KDd = WV + 3072, *RRd = WV + 4096, *VVd = WV + 5120;
  ushort_t* LTm = (ushort_t*)(WV + 6144) + role * 576;
  {
    float4* z = (float4*)YR;
    for (size_t e = (size_t)bidx() * NT + tid; e < (size_t)T * 512 / 4; e += (size_t)gridDim.x * NT) z[e] = float4{0.f, 0.f, 0.f, 0.f};
  }
  for (int bi = bidx(); bi < 768; bi += gridDim.x) {
    const int h = bi / 96, rem = bi % 96;
    const int dir = pair >> 1, q = rem * 2 + (pair & 1);
    __syncthreads();
    rw_fill_bf(p, i, h, BF, tid);
    __syncthreads();
    RwConst c;
    const int cc = h * 64 + lane;
    c.mur = p.in[I_MURKV][(i * 3 + 0) * 512 + cc]; c.muk = p.in[I_MURKV][(i * 3 + 1) * 512 + cc]; c.muv = p.in[I_MURKV][(i * 3 + 2) * 512 + cc];
    c.mul = p.in[I_MULORA][i * 64 + lane];
    c.w0 = p.in[I_W0][(i * 2 + dir) * 512 + cc]; c.a0 = p.in[I_A0][(i * 2 + dir) * 512 + cc];
    c.kk = p.in[I_KK][i * 512 + cc]; c.ka = p.in[I_KA][i * 512 + cc];
    const size_t it = ((size_t)(q * 8 + h) * 2 + dir);
    int sq0, sqL; seq_of(q * 256, sq0, sqL);
    float* Op = CH + it * 8192 + (role ? 0 : 4096);
    f32x2 S2[8][4];
    int diag = (role && vq == kq) ? 1 : 0;
    asm volatile("" : "+v"(diag));
#pragma unroll
    for (int r = 0; r < 8; ++r)
#pragma unroll
      for (int jj = 0; jj < 4; ++jj) S2[r][jj] = f32x2{(diag && (2 * jj == r)) ? 1.f : 0.f, (diag && (2 * jj + 1 == r)) ? 1.f : 0.f};
    const float vsel = role ? 0.f : 1.f;
    RwRow R[10];
#pragma unroll
    for (int j = 0; j < 10; ++j) {
      const int st = role * 8 + j - 1;
      R[j] = rw_load_row(PRW, dir ? (q * 256 + 255 - st) : (q * 256 + st), sq0, sqL, h, lane);
    }
    for (int blk = 0; blk < 16; ++blk) {
      {
        const int s = role * 8;
        rw_prologue_blk<8>(R, lane, c, BF, dir, LTm, Wd + s * 64, KKd + s * 64, BBd + s * 64, KDd + s * 64, RRd + s * 64, VVd + s * 64);
      }
      if (blk + 1 < 16) {
#pragma unroll
        for (int j = 0; j < 10; ++j) {
          const int st = (blk + 1) * 16 + role * 8 + j - 1;
          R[j] = rw_load_row(PRW, dir ? (q * 256 + 255 - st) : (q * 256 + st), sq0, sqL, h, lane);
        }
      }
      block_sync_lds();
#pragma unroll 2
      for (int s = 0; s < 16; ++s) {
        f32x2 kk2[4], w2[4], b2[4], kd2[4], vv2[4];
        RW_LOAD8(kk2, KKd + s * 64 + 8 * kq);
        RW_LOAD8(vv2, VVd + s * 64 + 8 * vq);
        RW_LOAD8(w2, Wd + s * 64 + 8 * kq);
        RW_LOAD8(b2, BBd + s * 64 + 8 * kq);
        RW_LOAD8(kd2, KDd + s * 64 + 8 * kq);
        float sa[8];
#pragma unroll
        for (int r = 0; r < 8; ++r) {
          f32x2 a = S2[r][0] * kk2[0];
          a = S2[r][1] * kk2[1] + a; a = S2[r][2] * kk2[2] + a; a = S2[r][3] * kk2[3] + a;
          sa[r] = -red8(a.x + a.y);
        }
#pragma unroll
        for (int r = 0; r < 8; ++r) {
          const float vr = ((r & 1) ? vv2[r >> 1].y : vv2[r >> 1].x) * vsel;
          const f32x2 sa2 = f32x2{sa[r], sa[r]}, v2 = f32x2{vr, vr};
#pragma unroll
          for (int jj = 0; jj < 4; ++jj) S2[r][jj] = S2[r][jj] * w2[jj] + sa2 * b2[jj] + v2 * kd2[jj];
        }
      }
      block_sync_lds();
    }
#pragma unroll
    for (int r = 0; r < 8; ++r) {
      float* dst = Op + (8 * vq + r) * 64 + 8 * kq;
      *(float4*)dst = float4{S2[r][0].x, S2[r][0].y, S2[r][1].x, S2[r][1].y};
      *(float4*)(dst + 4) = float4{S2[r][2].x, S2[r][2].y, S2[r][3].x, S2[r][3].y};
    }
  }
}

__device__ void rwkv_scan3(const Params& p, int i, unsigned char* lds, bool dry = false) {
  const ushort_t* PRW = (const ushort_t*)(p.ws + OFF_PRW);
  float* CH = (float*)(p.ws + OFF_PS5);
  float* YR = (float*)(p.ws + OFF_YS);
  const int tid = tidx(), lane = tid & 63, wave = tid >> 6;
  const int vq = lane >> 3, kq = lane & 7;
  const int half = wave >> 2;
  bf16x8* BF = (bf16x8*)lds + half * 768;
  float* WV = (float*)(lds + 24576 + wave * 13440);
  float* Wd = WV, *KKd = WV + 512, *BBd = WV + 1024, *KDd = WV + 1536, *RRd = WV + 2048, *VVd = WV + 2560;
  ushort_t* LTm = (ushort_t*)(WV + 3072);
  for (int tb2 = bidx() * 2; tb2 < 512; tb2 += gridDim.x * 2)
  for (int rnd = 0; rnd < 2; ++rnd) {
    const int tb = tb2 >> 1;
    const int hi = tb * 3 + (rnd == 0 ? half : 2);
    const bool active = (rnd == 0) || (half == 0);
    const int h = hi / 96, rem = hi % 96, cgp = rem >> 1, dir = rem & 1;
    const int q = cgp * 4 + (wave & 3);
    __syncthreads();
    if (active) rw_fill_bf(p, i, h, BF, tid & 255, 256);
    __syncthreads();
    if (!active) continue;
    RwConst c;
    const int cc = h * 64 + lane;
    c.mur = p.in[I_MURKV][(i * 3 + 0) * 512 + cc]; c.muk = p.in[I_MURKV][(i * 3 + 1) * 512 + cc]; c.muv = p.in[I_MURKV][(i * 3 + 2) * 512 + cc];
    c.mul = p.in[I_MULORA][i * 64 + lane];
    c.w0 = p.in[I_W0][(i * 2 + dir) * 512 + cc]; c.a0 = p.in[I_A0][(i * 2 + dir) * 512 + cc];
    c.kk = p.in[I_KK][i * 512 + cc]; c.ka = p.in[I_KA][i * 512 + cc];
    const size_t it = ((size_t)(q * 8 + h) * 2 + dir);
    int sq0, sqL; seq_of(q * 256, sq0, sqL);
    const float* Qp = CH + it * 8192 + 4096;
    f32x2 S2[8][4];
#pragma unroll
    for (int r = 0; r < 8; ++r) {
      const float* src = Qp + (8 * vq + r) * 64 + 8 * kq;
      const float4 a = *(const float4*)src, b = *(const float4*)(src + 4);
      S2[r][0] = f32x2{a.x, a.y}; S2[r][1] = f32x2{a.z, a.w}; S2[r][2] = f32x2{b.x, b.y}; S2[r][3] = f32x2{b.z, b.w};
    }
    RwRow R[10];
#pragma unroll
    for (int j = 0; j < 10; ++j) {
      const int st = j - 1;
      R[j] = rw_load_row(PRW, dir ? (q * 256 + 255 - st) : (q * 256 + st), sq0, sqL, h, lane);
    }
    for (int blk = 0; blk < 32; ++blk) {
      rw_prologue_blk<8>(R, lane, c, BF, dir, LTm, Wd, KKd, BBd, KDd, RRd, VVd);
      if (blk + 1 < 32) {
#pragma unroll
        for (int j = 0; j < 10; ++j) {
          const int st = (blk + 1) * 8 + j - 1;
          R[j] = rw_load_row(PRW, dir ? (q * 256 + 255 - st) : (q * 256 + st), sq0, sqL, h, lane);
        }
      }
      wave_sync_lds();
#pragma unroll 2
      for (int s = 0; s < 8; ++s) {
        f32x2 kk2[4], w2[4], b2[4], kd2[4], vv2[4], r2[4];
        RW_LOAD8(kk2, KKd + s * 64 + 8 * kq);
        RW_LOAD8(vv2, VVd + s * 64 + 8 * vq);
        RW_LOAD8(w2, Wd + s * 64 + 8 * kq);
        RW_LOAD8(b2, BBd + s * 64 + 8 * kq);
        RW_LOAD8(kd2, KDd + s * 64 + 8 * kq);
        RW_LOAD8(r2, RRd + s * 64 + 8 * kq);
        float sa[8];
#pragma unroll
        for (int r = 0; r < 8; ++r) {
          f32x2 a = S2[r][0] * kk2[0];
          a = S2[r][1] * kk2[1] + a; a = S2[r][2] * kk2[2] + a; a = S2[r][3] * kk2[3] + a;
          sa[r] = -red8(a.x + a.y);
        }
        float ysel = 0.f;
#pragma unroll
        for (int r = 0; r < 8; ++r) {
          const float vr = (r & 1) ? vv2[r >> 1].y : vv2[r >> 1].x;
          const f32x2 sa2 = f32x2{sa[r], sa[r]}, v2 = f32x2{vr, vr};
          f32x2 ya = f32x2{0.f, 0.f};
#pragma unroll
          for (int jj = 0; jj < 4; ++jj) {
            S2[r][jj] = S2[r][jj] * w2[jj] + sa2 * b2[jj] + v2 * kd2[jj];
            ya = S2[r][jj] * r2[jj] + ya;
          }
          const float yr = red8(ya.x + ya.y);
          ysel = (kq == r) ? yr : ysel;
        }
        const int st = blk * 8 + s;
        const int tok = dir ? (q * 256 + 255 - st) : (q * 256 + st);
        if (!dry) atomicAdd(YR + (size_t)tok * 512 + h * 64 + lane, ysel);
      }
      wave_sync_lds();
    }
  }
}

__device__ void rwkv_carry(const Params& p, unsigned char* lds, bool dry = false) {
  float* CH = (float*)(p.ws + OFF_PS5);
  float* Ps = (float*)lds;
  float* Ss = Ps + 4096;
  const int tid = tidx(), v = tid >> 4, ks = (tid & 15) * 4;
  for (int bi = bidx(); bi < 192; bi += gridDim.x) {
    const int half = bi & 1, dir = (bi >> 1) & 1, h = (bi >> 2) & 7, s = bi >> 5;
    int cs, n;
    if (s < 4) { cs = s * 16; n = 16; } else { cs = 64 + (s - 4) * 64; n = 64; }
    float4 cur{0.f, 0.f, 0.f, 0.f};
    float4 pq0, pq1, qv;
    {
      const int q = dir ? (cs + n - 1) : cs;
      const float* Pp = CH + ((size_t)(q * 8 + h) * 2 + dir) * 8192;
      pq0 = ((const float4*)Pp)[tid]; pq1 = ((const float4*)Pp)[tid + 512];
      qv = *(const float4*)(Pp + 4096 + (half * 32 + v) * 64 + ks);
    }
    for (int ci = 0; ci < n; ++ci) {
      const int q = dir ? (cs + n - 1 - ci) : (cs + ci);
      float* Pp = CH + ((size_t)(q * 8 + h) * 2 + dir) * 8192;
      float* Qrow = Pp + 4096 + (half * 32 + v) * 64 + ks;
      __syncthreads();
      if (!dry) *(float4*)Qrow = cur;
      if (ci == n - 1) break;
      *(float4*)(Ss + v * 64 + ks) = cur;
      ((float4*)Ps)[tid] = pq0;
      ((float4*)Ps)[tid + 512] = pq1;
      float4 acc = qv;
      if (ci + 2 < n + 1 && ci + 1 < n) {
        const int qn = dir ? (cs + n - 2 - ci) : (cs + ci + 1);
        const float* Pn = CH + ((size_t)(qn * 8 + h) * 2 + dir) * 8192;
        pq0 = ((const float4*)Pn)[tid]; pq1 = ((const float4*)Pn)[tid + 512];
        qv = *(const float4*)(Pn + 4096 + (half * 32 + v) * 64 + ks);
      }
      __syncthreads();
#pragma unroll 8
      for (int j = 0; j < 64; ++j) {
        const float sv = Ss[v * 64 + j];
        const float4 pr = *(const float4*)(Ps + j * 64 + ks);
        acc.x += sv * pr.x; acc.y += sv * pr.y; acc.z += sv * pr.z; acc.w += sv * pr.w;
      }
      cur = acc;
    }
    __syncthreads();
  }
}

struct PostIn { float r[10], k[10], v[10], g[8], y[8]; };
DEVI void post_load(const ushort_t* __restrict__ PRW, const float* __restrict__ YR, int item, int lane, PostIn& o) {
  const int tok0 = (item >> 3) * 8, h = item & 7, cc = h * 64 + lane;
  int s0, L; seq_of(tok0, s0, L);
#pragma unroll
  for (int j = 0; j < 10; ++j) {
    const int tok = tok0 - 1 + j;
    o.r[j] = 0.f; o.k[j] = 0.f; o.v[j] = 0.f;
    if (tok >= s0 && tok < s0 + L) {
      const ushort_t* row = PRW + (size_t)tok * 2112;
      o.r[j] = bf2f(row[cc]); o.k[j] = bf2f(row[512 + cc]); o.v[j] = bf2f(row[1024 + cc]);
    }
  }
#pragma unroll
  for (int e = 0; e < 8; ++e) { o.g[e] = bf2f(PRW[(size_t)(tok0 + e) * 2112 + 1536 + cc]); o.y[e] = YR[(size_t)(tok0 + e) * 512 + cc]; }
}
__device__ void rwkv_post(const Params& p, int i) {
  const ushort_t* __restrict__ PRW = (const ushort_t*)(p.ws + OFF_PRW);
  const float* __restrict__ YR = (const float*)(p.ws + OFF_YS);
  ushort_t* __restrict__ Y = (ushort_t*)(p.ws + OFF_Y);
  const int lane = tidx() & 63, gw = bidx() * 8 + (tidx() >> 6), nw = gridDim.x * 8;
  PostIn cur, nxt;
  if (gw < (T / 8) * 8) post_load(PRW, YR, gw, lane, cur);
  for (int item = gw; item < (T / 8) * 8; item += nw) {
    const int tok0 = (item >> 3) * 8, h = item & 7, cc = h * 64 + lane;
    if (item + nw < (T / 8) * 8) post_load(PRW, YR, item + nw, lane, nxt);
    const float mur = p.in[I_MURKV][(i * 3 + 0) * 512 + cc], muk = p.in[I_MURKV][(i * 3 + 1) * 512 + cc], muv = p.in[I_MURKV][(i * 3 + 2) * 512 + cc];
    const float lw = p.in[I_LNXW][i * 512 + cc], lb = p.in[I_LNXB][i * 512 + cc], rk = p.in[I_RK][i * 512 + cc];
#pragma unroll
    for (int e = 0; e < 8; ++e) {
      const float rr = cur.r[e + 1] + mur * (0.5f * (cur.r[e] + cur.r[e + 2]) - cur.r[e + 1]);
      const float kx = cur.k[e + 1] + muk * (0.5f * (cur.k[e] + cur.k[e + 2]) - cur.k[e + 1]);
      const float vv = cur.v[e + 1] + muv * (0.5f * (cur.v[e] + cur.v[e + 2]) - cur.v[e + 1]);
      const float mean = wsum_fast(cur.y[e]) * (1.f / 64.f);
      const float dlt = cur.y[e] - mean;
      const float var = wsum_fast(dlt * dlt) * (1.f / 64.f);
      const float yn = dlt * __builtin_amdgcn_rsqf(var + 64e-5f) * lw + lb;
      const float bonus = wsum_fast(rr * kx * rk) * vv;
      Y[(size_t)(tok0 + e) * 1024 + 512 + cc] = f2bf((yn + bonus) * (cur.g[e] * fast_sigmoid(cur.g[e])));
    }
    cur = nxt;
  }
}

__device__ void hy_filter_mlp(const Params& p, int i) {
  float* H2 = (float*)(p.ws + OFF_H2);
  const int lane = tidx() & 63, gw = bidx() * 8 + (tidx() >> 6), nw = gridDim.x * 8;
  const float fr = p.in[I_FFREQ][i * 64 + lane], b1 = p.in[I_FB1][i * 64 + lane], b2 = p.in[I_FB2][i * 64 + lane];
  for (int row = gw; row < 20480; row += nw) {
    const int L = row < 4096 ? 4096 : 16384, t = row < 4096 ? row : row - 4096;
    const float w = 6.283185307179586f * (float)t / (float)L;
    float z = 0.f;
    if (lane == 0) z = (float)t / (float)(L - 1);
    else if (lane <= 32) {
      const int bi = (lane - 1) & 15;
      const float f = 1e-4f + (float)bi * ((15.f - 1e-4f) / 15.f);
      z = lane <= 16 ? cosf(f * w) : -sinf(f * w);
    }
    float a = b1;
#pragma unroll 3
    for (int k = 0; k < 33; ++k) a += __shfl(z, k) * p.in[I_FW1][((size_t)i * 33 + k) * 64 + lane];
    const float h1 = sinf(fr * a);
    float c = b2;
#pragma unroll 8
    for (int k = 0; k < 64; ++k) c += __shfl(h1, k) * p.in[I_FW2][((size_t)i * 64 + k) * 64 + lane];
    H2[(row < 4096 ? (size_t)0 : (size_t)4096 * 64) + (size_t)lane * L + t] = sinf(fr * c);
  }
}

DEVI constexpr int swz(int i) { return i ^ ((i & 32) ? 21 : 0) ^ ((i & 64) ? 26 : 0); }
DEVI int swzF(int t) { return (swz(t >> 1) << 1) | (t & 1); }
DEVI f32x2 cmul_pk(f32x2 a, float c, float sn) { return a * f32x2{c, c} + f32x2{-a.y, a.x} * f32x2{sn, sn}; }
template <int LOGN, int NSEQ>
__device__ void fft_dif(float2* buf_) {
  constexpr int N = 1 << LOGN;
  f32x2* buf = (f32x2*)buf_;
  const int tid = tidx();
#pragma unroll
  for (int ps = 0; ps < LOGN / 2; ++ps) {
    const int lh = LOGN - 1 - 2 * ps;
    const int h = 1 << lh, hh = h >> 1;
    const float inv2h = 1.f / (float)(2 * h);
#pragma unroll 4
    for (int qg = tid; qg < NSEQ * N / 4; qg += NT) {
      const int q = qg & (N / 4 - 1), sb = (qg >> (LOGN - 2)) << LOGN;
      const int pos = q & (hh - 1), grp = q >> (lh - 1);
      const int e0 = sb + swz((grp << (lh + 1)) + pos);
      const int o1 = swz(hh), o2 = swz(h), o3 = swz(h + hh);
      const f32x2 x0 = buf[e0], x1 = buf[e0 ^ o1], x2 = buf[e0 ^ o2], x3 = buf[e0 ^ o3];
      const float f1 = (float)pos * inv2h;
      const float c1 = __builtin_amdgcn_cosf(f1), s1 = -__builtin_amdgcn_sinf(f1);
      const float c2 = c1 * c1 - s1 * s1, s2 = 2.f * c1 * s1;
      const f32x2 a0 = x0 + x2, a1 = x1 + x3;
      const f32x2 a2 = cmul_pk(x0 - x2, c1, s1);
      const f32x2 t3 = cmul_pk(x1 - x3, c1, s1);
      const f32x2 a3 = f32x2{t3.y, -t3.x};
      buf[e0] = a0 + a1;
      buf[e0 ^ o1] = cmul_pk(a0 - a1, c2, s2);
      buf[e0 ^ o2] = a2 + a3;
      buf[e0 ^ o3] = cmul_pk(a2 - a3, c2, s2);
    }
    __syncthreads();
  }
}
template <int LOGN, int NSEQ>
__device__ void fft_dit_inv(float2* buf_) {
  constexpr int N = 1 << LOGN;
  f32x2* buf = (f32x2*)buf_;
  const int tid = tidx();
#pragma unroll
  for (int ps = 0; ps < LOGN / 2; ++ps) {
    const int lh = 2 * ps;
    const int h = 1 << lh;
    const float inv4h = 1.f / (float)(4 * h);
#pragma unroll 4
    for (int qg = tid; qg < NSEQ * N / 4; qg += NT) {
      const int q = qg & (N / 4 - 1), sb = (qg >> (LOGN - 2)) << LOGN;
      const int pos = q & (h - 1), grp = q >> lh;
      const int e0 = sb + swz((grp << (lh + 2)) + pos);
      const int o1 = swz(h), o2 = swz(2 * h), o3 = swz(3 * h);
      const f32x2 x0 = buf[e0], x1 = buf[e0 ^ o1], x2 = buf[e0 ^ o2], x3 = buf[e0 ^ o3];
      const float f2 = (float)pos * inv4h;
      const float c2 = __builtin_amdgcn_cosf(f2), s2 = __builtin_amdgcn_sinf(f2);
      const float c1 = c2 * c2 - s2 * s2, s1 = 2.f * c2 * s2;
      const f32x2 b1 = cmul_pk(x1, c1, s1), b3 = cmul_pk(x3, c1, s1);
      const f32x2 a0 = x0 + b1, a1 = x0 - b1, a2 = x2 + b3, a3 = x2 - b3;
      const f32x2 cc2 = cmul_pk(a2, c2, s2);
      const f32x2 t3 = cmul_pk(a3, c2, s2);
      const f32x2 cc3 = f32x2{-t3.y, t3.x};
      buf[e0] = a0 + cc2;
      buf[e0 ^ o2] = a0 - cc2;
      buf[e0 ^ o1] = a1 + cc3;
      buf[e0 ^ o3] = a1 - cc3;
    }
    __syncthreads();
  }
}
template <int LOGN, int NSEQ>
__device__ void spectrum_extract(const float2* buf, float4* __restrict__ GPa, float4* __restrict__ GPb, float scale_a, float scale_b) {
  constexpr int Lc = 1 << LOGN;
#pragma unroll 2
  for (int jg = tidx(); jg < NSEQ * Lc / 2; jg += NT) {
    const int j = jg & (Lc / 2 - 1), sq = jg >> (LOGN - 1), sb = sq << LOGN;
    float4* GP = sq ? GPb : GPa;
    const float scale = sq ? scale_b : scale_a;
    if (j == 0) {
      const float2 c = buf[sb], ch = buf[sb + 1];
      GP[0] = float4{(c.x + c.y) * scale, (c.x - c.y) * scale, ch.x * scale, -ch.y * scale};
    } else {
      const int pos = 2 * j;
      const int k = (int)(__brev((unsigned)pos) >> (32 - LOGN));
      const int p2 = pos ^ ((1 << (31 - __clz(pos))) - 1);
      const int sp1 = sb + swz(pos), sp2 = sb + swz(p2);
      float2 C1 = buf[sp1], C2 = buf[sp2];
      float2 E{0.5f * (C1.x + C2.x), 0.5f * (C1.y - C2.y)}, D{0.5f * (C1.x - C2.x), 0.5f * (C1.y + C2.y)};
      float2 O{D.y, -D.x};
      const float f = (float)k * (1.f / (float)(2 * Lc));
      const float wc = __builtin_amdgcn_cosf(f), wsn = -__builtin_amdgcn_sinf(f);
      float2 wO{wc * O.x - wsn * O.y, wc * O.y + wsn * O.x};
      GP[j] = float4{(E.x + wO.x) * scale, (E.y + wO.y) * scale, (E.x - wO.x) * scale, -(E.y - wO.y) * scale};
    }
  }
}
template <int LOGN, int NSEQ>
__device__ void spectrum_mul(float2* buf, const float4* __restrict__ GP) {
  constexpr int Lc = 1 << LOGN;
  constexpr int NITS = NSEQ * Lc / 2 / NT;
  static_assert(NITS % 4 == 0 && NITS * NT == NSEQ * Lc / 2, "spectrum_mul tiling");
  const int tid0 = tidx();
  float4 g4[4], gn[4];
#pragma unroll
  for (int u = 0; u < 4; ++u) g4[u] = GP[(tid0 + u * NT) & (Lc / 2 - 1)];
#pragma unroll 1
  for (int grp = 0; grp < NITS / 4; ++grp) {
    if (grp + 1 < NITS / 4) {
#pragma unroll
      for (int u = 0; u < 4; ++u) gn[u] = GP[(tid0 + ((grp + 1) * 4 + u) * NT) & (Lc / 2 - 1)];
    }
#pragma unroll
  for (int u = 0; u < 4; ++u) {
    const int jg = tid0 + (grp * 4 + u) * NT;
    const int j = jg & (Lc / 2 - 1), sb = (jg >> (LOGN - 1)) << LOGN;
    const float4 gp = g4[u];
    if (j == 0) {
      const float2 c = buf[sb], ch = buf[sb + 1];
      const float Y0 = (c.x + c.y) * gp.x, YL = (c.x - c.y) * gp.y;
      buf[sb] = float2{0.5f * (Y0 + YL), 0.5f * (Y0 - YL)};
      buf[sb + 1] = float2{ch.x * gp.z + ch.y * gp.w, ch.y * gp.z - ch.x * gp.w};
    } else {
      const int pos = 2 * j;
      const int k = (int)(__brev((unsigned)pos) >> (32 - LOGN));
      const int p2 = pos ^ ((1 << (31 - __clz(pos))) - 1);
      const int sp1 = sb + swz(pos), sp2 = sb + swz(p2);
      float2 C1 = buf[sp1], C2 = buf[sp2];
      float2 E{0.5f * (C1.x + C2.x), 0.5f * (C1.y - C2.y)}, D{0.5f * (C1.x - C2.x), 0.5f * (C1.y + C2.y)};
      float2 O{D.y, -D.x};
      const float f = (float)k * (1.f / (float)(2 * Lc));
      const float wc = __builtin_amdgcn_cosf(f), wsn = -__builtin_amdgcn_sinf(f);
      float2 wO{wc * O.x - wsn * O.y, wc * O.y + wsn * O.x};
      float2 X1{E.x + wO.x, E.y + wO.y}, X2{E.x - wO.x, -(E.y - wO.y)};
      float2 Y1{X1.x * gp.x - X1.y * gp.y, X1.x * gp.y + X1.y * gp.x};
      float2 Y2{X2.x * gp.z - X2.y * gp.w, X2.x * gp.w + X2.y * gp.z};
      float2 Ye{0.5f * (Y1.x + Y2.x), 0.5f * (Y1.y - Y2.y)};
      float2 Dd{0.5f * (Y1.x - Y2.x), 0.5f * (Y1.y + Y2.y)};
      float2 Yo{wc * Dd.x + wsn * Dd.y, wc * Dd.y - wsn * Dd.x};
      buf[sp1] = float2{Ye.x - Yo.y, Ye.y + Yo.x};
      buf[sp2] = float2{Ye.x + Yo.y, -Ye.y + Yo.x};
    }
  }
#pragma unroll
    for (int u = 0; u < 4; ++u) g4[u] = gn[u];
  }
}

template <int LOGN>
__device__ void hy_conv_item(const Params& p, int i, int c, unsigned char* lds, bool dry) {
  constexpr int Lc = 1 << LOGN;
  constexpr int L = Lc;
  constexpr int NB = (LOGN == 14) ? 2 : 4;
  constexpr int NSEQ = (LOGN == 14) ? 1 : 4;
  constexpr int LOG8 = LOGN - 3;
  const int tid = tidx();
  float2* buf = (float2*)lds;
  float* bufF = (float*)lds;
  float* W3s = (float*)(lds + 131072);
  float* red = W3s + 256;
  float4* GS = (float4*)(p.ws + OFF_GS + (size_t)bidx() * 2 * GS_PER);
  float4* GS1 = GS + GS_PER / 16;
  float* G1tmp = (float*)GS1;
  float* Z1 = (float*)(p.ws + OFF_Z1 + (size_t)bidx() * 65536);
  const float* H2 = (const float*)(p.ws + OFF_H2) + (LOGN == 14 ? (size_t)4096 * 64 : 0);
  const ushort_t* PH = (const ushort_t*)(p.ws + OFF_PH);
  const float delta = 4.605170185988091f * (1.f / 1.5f + (1.f / 0.3f - 1.f / 1.5f) * (float)c / 1023.f);
  __syncthreads();
  if (tid < 256) {
    const int j = tid >> 2, col = tid & 3, o = col >> 1, dirr = col & 1;
    W3s[tid] = p.in[I_FW3][((size_t)i * 64 + j) * 4096 + (dirr * 2 + o) * 1024 + c];
  }
  __syncthreads();
  float ss0 = 0.f, ss1 = 0.f;
  for (int t0 = tid * 4; t0 < L; t0 += NT * 4) {
    float acc[4][4];
#pragma unroll
    for (int r = 0; r < 4; ++r)
#pragma unroll
      for (int cc = 0; cc < 4; ++cc) acc[r][cc] = 0.f;
#pragma unroll 1
    for (int jb = 0; jb < 64; jb += 16) {
      float4 hv[16];
#pragma unroll
      for (int jj = 0; jj < 16; ++jj) hv[jj] = *(const float4*)(H2 + (size_t)(jb + jj) * L + t0);
#pragma unroll
      for (int jj = 0; jj < 16; ++jj) {
        const float4 w = *(const float4*)(W3s + 4 * (jb + jj));
        acc[0][0] += hv[jj].x * w.x; acc[0][1] += hv[jj].x * w.y; acc[0][2] += hv[jj].x * w.z; acc[0][3] += hv[jj].x * w.w;
        acc[1][0] += hv[jj].y * w.x; acc[1][1] += hv[jj].y * w.y; acc[1][2] += hv[jj].y * w.z; acc[1][3] += hv[jj].y * w.w;
        acc[2][0] += hv[jj].z * w.x; acc[2][1] += hv[jj].z * w.y; acc[2][2] += hv[jj].z * w.z; acc[2][3] += hv[jj].z * w.w;
        acc[3][0] += hv[jj].w * w.x; acc[3][1] += hv[jj].w * w.y; acc[3][2] += hv[jj].w * w.z; acc[3][3] += hv[jj].w * w.w;
      }
    }
#pragma unroll
    for (int r = 0; r < 4; ++r) {
      const int t = t0 + r;
      const float dec = expf(-((float)t * (1.f / (float)(L - 1))) * delta);
      const float d0 = acc[r][0] * dec, d1 = acc[r][1] * dec, d2 = acc[r][2] * dec, d3 = acc[r][3] * dec;
      ss0 += d0 * d0 + d1 * d1;
      ss1 += d2 * d2 + d3 * d3;
      if (NSEQ >= 2) {
        bufF[swzF(t)] = d0; bufF[2 * L + swzF(t)] = d2;
        if (t >= 1) { bufF[swzF(2 * L - t)] = d1; bufF[2 * L + swzF(2 * L - t)] = d3; } else { bufF[swzF(L)] = 0.f; bufF[2 * L + swzF(L)] = 0.f; }
      } else {
        bufF[swzF(t)] = d0; G1tmp[t] = d2;
        if (t >= 1) { bufF[swzF(2 * L - t)] = d1; G1tmp[2 * L - t] = d3; } else { bufF[swzF(L)] = 0.f; G1tmp[L] = 0.f; }
      }
    }
  }
  ss0 = wsum(ss0); ss1 = wsum(ss1);
  if ((tid & 63) == 0) { red[tid >> 6] = ss0; red[8 + (tid >> 6)] = ss1; }
  __syncthreads();
  float tot0 = 0.f, tot1 = 0.f;
#pragma unroll
  for (int w = 0; w < 8; ++w) { tot0 += red[w]; tot1 += red[8 + w]; }
  const float sc0 = rsqrtf(tot0) * (1.f / (float)Lc), sc1 = rsqrtf(tot1) * (1.f / (float)Lc);
  if (NSEQ >= 2) {
    fft_dif<LOGN, 2>(buf);
    spectrum_extract<LOGN, 2>(buf, GS, GS1, sc0, sc1);
  } else {
    fft_dif<LOGN, 1>(buf);
    spectrum_extract<LOGN, 1>(buf, GS, GS, sc0, sc0);
    __syncthreads();
    for (int t = tid; t < L; t += NT) buf[swz(t)] = ((const float2*)G1tmp)[t];
    __syncthreads();
    fft_dif<LOGN, 1>(buf);
    spectrum_extract<LOGN, 1>(buf, GS1, GS1, sc1, sc1);
  }
  __threadfence_block();
  __syncthreads();
  const float* sw = p.in[I_HSW] + (size_t)i * 3 * 3072;
  const float* sbias = p.in[I_HSB] + (size_t)i * 3072;
  float cw[3][3], cb[3];
#pragma unroll
  for (int st = 0; st < 3; ++st) {
#pragma unroll
    for (int k = 0; k < 3; ++k) cw[st][k] = sw[k * 3072 + st * 1024 + c];
    cb[st] = sbias[st * 1024 + c];
  }
  const float fb0 = p.in[I_FBIAS][((size_t)i * 2 + 0) * 1024 + c], fb1 = p.in[I_FBIAS][((size_t)i * 2 + 1) * 1024 + c];
  struct Raw8 { uint4 v; float xm, xn; };
  auto ld8 = [&](const ushort_t* sp, int t0) -> Raw8 {
    Raw8 r; r.v = *(const uint4*)(sp + t0);
    r.xm = t0 > 0 ? bf2f(sp[t0 - 1]) : 0.f; r.xn = t0 + 8 < L ? bf2f(sp[t0 + 8]) : 0.f;
    return r;
  };
  auto cv8 = [&](const Raw8& r, int st, float* y) {
    const float x[10] = {r.xm, __uint_as_float(r.v.x << 16), __uint_as_float(r.v.x & 0xffff0000u), __uint_as_float(r.v.y << 16), __uint_as_float(r.v.y & 0xffff0000u),
                         __uint_as_float(r.v.z << 16), __uint_as_float(r.v.z & 0xffff0000u), __uint_as_float(r.v.w << 16), __uint_as_float(r.v.w & 0xffff0000u), r.xn};
#pragma unroll
    for (int j = 0; j < 8; ++j) y[j] = cw[st][0] * x[j] + cw[st][1] * x[j + 1] + cw[st][2] * x[j + 2] + cb[st];
  };
  constexpr int NIT = NSEQ * (L / 8) / NT;
  static_assert(NIT * NT == NSEQ * (L / 8), "elementwise passes assume an exact thread tiling");
  for (int b0 = 0; b0 < NB; b0 += NSEQ) {
    Raw8 rv[NIT], rx1[NIT];
    const ushort_t* pvp[NIT];
    int sqv[NIT], t0v[NIT];
#pragma unroll
    for (int k = 0; k < NIT; ++k) {
      const int w = tid + k * NT;
      sqv[k] = w >> LOG8; t0v[k] = (w & (L / 8 - 1)) * 8;
      const int s0 = (LOGN == 14) ? (TPROMPT + (b0 + sqv[k]) * 16384) : ((b0 + sqv[k]) * 4096);
      pvp[k] = PH + (size_t)s0 * 1024 + (size_t)c * L;
      rv[k] = ld8(pvp[k], t0v[k]);
      rx1[k] = ld8(pvp[k] + (size_t)T * 1024, t0v[k]);
    }
    __syncthreads();
#pragma unroll
    for (int k = 0; k < NIT; ++k) {
      float y[8]; cv8(rv[k], 0, y);
#pragma unroll
      for (int j = 0; j < 4; ++j) { buf[sqv[k] * Lc + swz((t0v[k] >> 1) + j)] = float2{y[2 * j], y[2 * j + 1]}; buf[sqv[k] * Lc + swz(L / 2 + (t0v[k] >> 1) + j)] = float2{0.f, 0.f}; }
    }
    __syncthreads();
    fft_dif<LOGN, NSEQ>(buf);
    spectrum_mul<LOGN, NSEQ>(buf, GS);
    __syncthreads();
    fft_dit_inv<LOGN, NSEQ>(buf);
    float z1[NIT][8];
#pragma unroll
    for (int k = 0; k < NIT; ++k) {
      float z0[8], xa[8]; cv8(rv[k], 0, z0); cv8(rx1[k], 1, xa);
#pragma unroll
      for (int j = 0; j < 4; ++j) {
        const int e = sqv[k] * Lc + swz((t0v[k] >> 1) + j);
        const float2 zc = buf[e];
        z1[k][2 * j] = xa[2 * j] * (zc.x + z0[2 * j] * fb0); z1[k][2 * j + 1] = xa[2 * j + 1] * (zc.y + z0[2 * j + 1] * fb0);
        buf[e] = float2{z1[k][2 * j], z1[k][2 * j + 1]};
        buf[sqv[k] * Lc + swz(L / 2 + (t0v[k] >> 1) + j)] = float2{0.f, 0.f};
      }
    }
    Raw8 rx2[NIT]; uint4 gvv[NIT];
#pragma unroll
    for (int k = 0; k < NIT; ++k) { rx2[k] = ld8(pvp[k] + (size_t)2 * T * 1024, t0v[k]); gvv[k] = *(const uint4*)(pvp[k] + (size_t)3 * T * 1024 + t0v[k]); }
    __syncthreads();
    fft_dif<LOGN, NSEQ>(buf);
    spectrum_mul<LOGN, NSEQ>(buf, GS1);
    __syncthreads();
    fft_dit_inv<LOGN, NSEQ>(buf);
#pragma unroll
    for (int k = 0; k < NIT; ++k) {
      float xb[8]; cv8(rx2[k], 2, xb);
      const unsigned gw[4] = {gvv[k].x, gvv[k].y, gvv[k].z, gvv[k].w};
      unsigned o[4];
#pragma unroll
      for (int j = 0; j < 4; ++j) {
        const float2 zc = buf[sqv[k] * Lc + swz((t0v[k] >> 1) + j)];
        const float g0 = __uint_as_float(gw[j] << 16), g1 = __uint_as_float(gw[j] & 0xffff0000u);
        const float y0 = xb[2 * j] * (zc.x + z1[k][2 * j] * fb1) * (g0 * fast_sigmoid(g0));
        const float y1 = xb[2 * j + 1] * (zc.y + z1[k][2 * j + 1] * fb1) * (g1 * fast_sigmoid(g1));
        o[j] = pack2(y0, y1);
      }
      if (!dry) *(uint4*)((ushort_t*)pvp[k] + (size_t)3 * T * 1024 + t0v[k]) = uint4{o[0], o[1], o[2], o[3]};
    }
  }
}

__device__ void hy_conv_phase(const Params& p, int i, unsigned char* lds, bool dry = false) {
  for (int it = bidx(); it < 2048; it += gridDim.x) {
    if (it < 1024) hy_conv_item<14>(p, i, it, lds, dry);
    else hy_conv_item<12>(p, i, it - 1024, lds, dry);
    __syncthreads();
  }
}

__device__ void prep_even(const Params& p, int i, unsigned char* lds) {
  ushort_t* WB = (ushort_t*)(p.ws + OFF_WB);
  ushort_t* WinT = WB; ushort_t* WoutT = WB + 3328 * 1024; ushort_t* GluT = WoutT + 1024 * 1024;
  transpose_bf16(p.in[I_EWIN] + (size_t)i * 1024 * 3136, WinT, 1024, 3136, lds);
  zero_fill(WinT + 3136 * 1024, 192 * 1024);
  transpose_bf16(p.in[I_EWOUT] + (size_t)i * 1024 * 1024, WoutT, 1024, 1024, lds);
  transpose_bf16(p.in[I_GLUW] + (size_t)i * 512 * 512, GluT, 512, 512, lds);
}
__device__ void prep_odd(const Params& p, int i, unsigned char* lds) {
  ushort_t* WB = (ushort_t*)(p.ws + OFF_WB);
  transpose_bf16(p.in[I_HWIN] + (size_t)i * 1024 * 4096, WB, 1024, 4096, lds);
  transpose_bf16(p.in[I_HWOUT] + (size_t)i * 1024 * 1024, WB + 4096 * 1024, 1024, 1024, lds);
  hy_filter_mlp(p, i);
}
#ifndef PROBE_MASK
#define PROBE_MASK 0
#endif
#ifndef PH_MASK
#define PH_MASK 0x1ffff
#endif
#define PHM(n) ((PH_MASK >> (n)) & 1)
DEVI void run_phase(const Params& p, int ph, unsigned char* lds, bool dry = false) {
  const int layer = ph < NPH_EVEN ? 0 : ph < NPH_EVEN + NPH_ODD ? 1 : ph < 2 * NPH_EVEN + NPH_ODD ? 2 : 3;
  const int base = layer == 0 ? 0 : layer == 1 ? NPH_EVEN : layer == 2 ? NPH_EVEN + NPH_ODD : 2 * NPH_EVEN + NPH_ODD;
  const int sp = ph - base, i = layer >> 1;
  unsigned char* ws = p.ws;
  ushort_t* WB = (ushort_t*)(ws + OFF_WB);
  if ((layer & 1) == 0) {
    ushort_t* WinT = WB; ushort_t* WoutT = WB + 3328 * 1024; ushort_t* GluT = WoutT + 1024 * 1024;
    switch (sp) {
      case 0: if (PHM(0)) {
        prep_even(p, 0, lds);
        xb_convert(p, (ushort_t*)(ws + OFF_Y));
        } break;
      case 1: if (PHM(1)) run_gemm(lds, (const ushort_t*)(ws + OFF_Y), 1024, WinT, 3328, 1024, pg8::EpiEvenIn{(ushort_t*)(ws + OFF_PS5), (ushort_t*)(ws + OFF_PRW)}); break;
      case 2: if (PHM(2)) s5_passA(p, i, lds); break;
      case 3: if (PHM(3)) s5_passC(p, i, lds); break;
      case 4: if (PHM(4)) run_gemm(lds, (const ushort_t*)(ws + OFF_Y) + 512, 1024, GluT, 512, 512, pg8::EpiGlu{(ushort_t*)(ws + OFF_Y), (const ushort_t*)(ws + OFF_PS5), p.in[I_GLUB] + i * 512}); break;
      case 5: if (PHM(5)) rwkv_scan1(p, i, lds); break;
      case 6: if (PHM(6)) rwkv_carry(p, lds, dry); break;
      case 7: if (PHM(7)) rwkv_scan3(p, i, lds, dry); break;
      case 8: if (PHM(8)) rwkv_post(p, i); break;
      case 9: if (PHM(9)) run_gemm(lds, (const ushort_t*)(ws + OFF_Y), 1024, WoutT, 1024, 1024, pg8::EpiF16{(ushort_t*)(ws + OFF_PRW)}); break;
      case 10: if (PHM(10)) { if (!dry) prep_odd(p, i, lds); ln_phase(p, layer, (const ushort_t*)(ws + OFF_PRW), (ushort_t*)(ws + OFF_XB_ODD), dry); } break;
    }
  } else {
    ushort_t* HinT = WB; ushort_t* HoutT = WB + 4096 * 1024;
    switch (sp) {
      case 0: break;
      case 1: if (PHM(12)) run_gemm(lds, (const ushort_t*)(ws + OFF_XB_ODD), 1024, HinT, 4096, 1024, pg8::EpiHyIn{(ushort_t*)(ws + OFF_PH)}); break;
      case 2: if (PHM(13)) hy_conv_phase(p, i, lds, dry); break;
      case 3: if (PHM(14)) hy_transpose((const ushort_t*)(ws + OFF_PH + 3 * SZ1), (ushort_t*)(ws + OFF_PH), lds); break;
      case 4: if (PHM(15)) run_gemm(lds, (const ushort_t*)(ws + OFF_PH), 1024, HoutT, 1024, 1024, pg8::EpiF16{(ushort_t*)(ws + OFF_PH + SZ1)}); break;
      case 5: if (PHM(16)) { if (!dry && layer < 3) prep_even(p, i + 1, lds); ln_phase(p, layer, (const ushort_t*)(ws + OFF_PH + SZ1), layer < 3 ? (ushort_t*)(ws + OFF_Y) : (ushort_t*)nullptr, dry); } break;
    }
  }
}

#define LAS __attribute__((address_space(3)))
#define XB_TMO      128
#define XB_XCNT(j)  (256  + 64 * (j))
#define XB_XSUB(j)  (1280 + 64 * (j))
#define XB_XGEN(j)  (2304 + 64 * (j))
#define XB_TOP      3328
#define XB_TOPGEN   3392
#define XCD_BAR_WORDS 3456
#define XB_SPIN_CAP (1u << 18)
#define LAS __attribute__((address_space(3)))

__device__ __forceinline__ unsigned xb_ld(unsigned* p)              { return __hip_atomic_load(p, __ATOMIC_RELAXED, __HIP_MEMORY_SCOPE_AGENT); }
__device__ __forceinline__ unsigned xb_add(unsigned* p, unsigned v) { return __hip_atomic_fetch_add(p, v, __ATOMIC_RELAXED, __HIP_MEMORY_SCOPE_AGENT); }
__device__ __forceinline__ unsigned xb_xcc_id() { return (unsigned)__builtin_amdgcn_s_getreg((3 << 11) | 20) & 0xFu; }
#define XB_SPIN(cond, bar) do { unsigned _sp = 0; while (cond) { __builtin_amdgcn_s_sleep(1); \
    if ((++_sp & 255u) == 0u) { if (xb_ld(&(bar)[XB_TMO])) break; if (_sp > XB_SPIN_CAP) { atomicAdd(&(bar)[XB_TMO], 1u); break; } } } } while (0)

struct XcdBarrier {
    unsigned* bar; unsigned x;
    volatile LAS unsigned* st;
};

__device__ __forceinline__ XcdBarrier xcd_barrier_post(unsigned* bar, volatile LAS unsigned* st) {
    XcdBarrier b; b.bar = bar; b.x = xb_xcc_id(); b.st = st;
    if (threadIdx.x == 0) (void)xb_add(&bar[XB_XCNT(b.x)], 1u);
    return b;
}
__device__ __forceinline__ void xcd_barrier_complete(unsigned* bar, unsigned x, unsigned& nloc, unsigned& nx) {
    const unsigned G = gridDim.x * gridDim.y * gridDim.z;
    unsigned sum, cnt, mine, sp = 0u;
    for (;;) {
        sum = 0u; cnt = 0u; mine = 0u;
#pragma unroll
        for (unsigned j = 0; j < 16; ++j) { const unsigned c = xb_ld(&bar[XB_XCNT(j)]); sum += c; cnt += (c > 0u) ? 1u : 0u; mine = (j == x) ? c : mine; }
        if (sum == G) break;
        __builtin_amdgcn_s_sleep(1);
        if ((++sp & 255u) == 0u) { if (xb_ld(&bar[XB_TMO])) break; if (sp > XB_SPIN_CAP) { atomicAdd(&bar[XB_TMO], 1u); break; } }
    }
    nloc = mine > 0u ? mine : 1u; nx = cnt > 0u ? cnt : 1u;
}

__device__ __forceinline__ void xcd_barrier(const XcdBarrier& b) {
    asm volatile("s_waitcnt vmcnt(0)" ::: "memory");
    __syncthreads();
    if (threadIdx.x == 0) {
        unsigned* bar = b.bar;
        __builtin_amdgcn_s_waitcnt(0);
        unsigned nloc = b.st[0], nx = b.st[1];
        if (nloc == 0u) { xcd_barrier_complete(bar, b.x, nloc, nx); b.st[0] = nloc; b.st[1] = nx; }
        const unsigned old = xb_add(&bar[XB_XSUB(b.x)], 1u);
        const unsigned gen = old / nloc;
        if (old + 1u == (gen + 1u) * nloc) {
            __builtin_amdgcn_fence(__ATOMIC_RELEASE, "agent");
            asm volatile("s_waitcnt vmcnt(0)" ::: "memory");
            const unsigned og = xb_add(&bar[XB_TOP], 1u);
            const unsigned tg = og / nx;
            if (og + 1u == (tg + 1u) * nx) xb_add(&bar[XB_TOPGEN], 1u);
            else XB_SPIN(xb_ld(&bar[XB_TOPGEN]) == tg, bar);
            __builtin_amdgcn_fence(__ATOMIC_ACQUIRE, "agent");
            xb_add(&bar[XB_XGEN(b.x)], 1u);
            asm volatile("s_waitcnt vmcnt(0)" ::: "memory");
        } else {
            XB_SPIN(xb_ld(&bar[XB_XGEN(b.x)]) == gen, bar);
            __builtin_amdgcn_fence(__ATOMIC_ACQUIRE, "agent");
            asm volatile("s_waitcnt vmcnt(0)" ::: "memory");
        }
    }
    __syncthreads();
}


#if ONE_LAUNCH
__global__ void __launch_bounds__(NT) fwd_kernel(Params p) {
  extern __shared__ __attribute__((aligned(16))) unsigned char lds[];
#if ONE_LAUNCH
  cg::grid_group grid = cg::this_grid();
#endif
#if ONE_LAUNCH
  volatile LAS unsigned* xb_st = (volatile LAS unsigned*)(lds + LDS_BYTES - 16);
  if (threadIdx.x < 2) xb_st[threadIdx.x] = 0u;
  __syncthreads();
  const XcdBarrier xb = xcd_barrier_post((unsigned*)(p.ws + OFF_BAR), xb_st);
#endif
  for (int ph = p.ph_lo; ph < p.ph_hi; ++ph) {
    if (ph == NPH_EVEN || ph == NPH_EVEN + NPH_ODD || ph == 2 * NPH_EVEN + NPH_ODD) continue;
    int reps = 1;
#if PROBE_MASK
    {
      const int lyr = ph < NPH_EVEN ? 0 : ph < NPH_EVEN + NPH_ODD ? 1 : ph < 2 * NPH_EVEN + NPH_ODD ? 2 : 3;
      const int bs = lyr == 0 ? 0 : lyr == 1 ? NPH_EVEN : lyr == 2 ? NPH_EVEN + NPH_ODD : 2 * NPH_EVEN + NPH_ODD;
      const int idx = (lyr & 1) ? NPH_EVEN + (ph - bs) : (ph - bs);
      if ((PROBE_MASK >> idx) & 1) reps = 2;
    }
#endif
    for (int rep = 0; rep < reps; ++rep) {
      run_phase(p, ph, lds, rep + 1 < reps);
#if ONE_LAUNCH
      if (ph + 1 < p.ph_hi || rep + 1 < reps) { if (ph == p.ph_lo && rep == 0) grid.sync(); else xcd_barrier(xb); }
#endif
    }
  }
}
#endif

#if !ONE_LAUNCH
template <int PH> __global__ void __launch_bounds__(NT) phase_kernel(Params p) {
  extern __shared__ __attribute__((aligned(16))) unsigned char lds[];
  run_phase(p, PH, lds);
}
typedef void (*kfn_t)(Params);
#define PK(n) phase_kernel<n>
static kfn_t k_tab[NPHASES] = {PK(0), PK(1), PK(2), PK(3), PK(4), PK(5), PK(6), PK(7), PK(8), PK(9), PK(10), PK(11), PK(12), PK(13), PK(14), PK(15),
                               PK(16), PK(17), PK(18), PK(19), PK(20), PK(21), PK(22), PK(23), PK(24), PK(25), PK(26), PK(27), PK(28), PK(29), PK(30), PK(31), PK(32), PK(33)};
#endif

extern "C" void kernel_launch(void* const* d_in, const int* in_sizes, int n_in, void* d_out, int out_size, void* d_ws, size_t ws_size,
                              hipStream_t stream) {
  static int grid_blocks = 0;
  if (!grid_blocks) {
    if (n_in != 38 || ws_size < WS_NEED || out_size != T * 1024) {
      fprintf(stderr, "kernel_launch: unexpected shapes n_in=%d ws=%zu out=%d\n", n_in, ws_size, out_size);
      grid_blocks = -1; return;
    }
    int dev = 0, cus = 0, per_cu = 0;
    (void)hipGetDevice(&dev);
    (void)hipDeviceGetAttribute(&cus, hipDeviceAttributeMultiprocessorCount, dev);
#if ONE_LAUNCH
    if (hipFuncSetAttribute((const void*)fwd_kernel, hipFuncAttributeMaxDynamicSharedMemorySize, LDS_BYTES) != hipSuccess) {
      fprintf(stderr, "kernel_launch: hipFuncSetAttribute failed\n"); grid_blocks = -1; return;
    }
    (void)hipOccupancyMaxActiveBlocksPerMultiprocessor(&per_cu, (const void*)fwd_kernel, NT, LDS_BYTES);
#else
    for (int ph = 0; ph < NPHASES; ++ph)
      if (hipFuncSetAttribute((const void*)k_tab[ph], hipFuncAttributeMaxDynamicSharedMemorySize, LDS_BYTES) != hipSuccess) {
        fprintf(stderr, "kernel_launch: hipFuncSetAttribute failed\n"); grid_blocks = -1; return;
      }
    per_cu = 1;
#endif
    if (per_cu < 1) { fprintf(stderr, "kernel_launch: occupancy query returned %d\n", per_cu); per_cu = 1; }
    grid_blocks = cus * per_cu;
    if (grid_blocks > 256) grid_blocks = 256;
    if (grid_blocks < 1) grid_blocks = 256;
  }
  if (grid_blocks < 0) return;
  Params p{};
  for (int k = 0; k < 38; ++k) p.in[k] = (const float*)d_in[k];
  p.out = (float*)d_out; p.ws = (unsigned char*)d_ws;
#if ONE_LAUNCH
  if (hipMemsetAsync((unsigned char*)d_ws + OFF_BAR, 0, 16384, stream) != hipSuccess) { fprintf(stderr, "kernel_launch: memset of barrier words failed\n"); return; }
  p.ph_lo = 0; p.ph_hi = NPHASES;
  void* args[] = {&p};
  hipError_t e = hipLaunchCooperativeKernel((const void*)fwd_kernel, dim3(grid_blocks), dim3(NT), args, LDS_BYTES, stream);
  if (e != hipSuccess) fprintf(stderr, "cooperative launch failed: %s (grid %d)\n", hipGetErrorString(e), grid_blocks);
#else
  for (int ph = 0; ph < NPHASES; ++ph) {
    p.ph_lo = ph; p.ph_hi = ph + 1;
    hipLaunchKernelGGL(k_tab[ph], dim3(grid_blocks), dim3(NT), LDS_BYTES, stream, p);
  }
#endif
}
```
